# Optimizing an MI355X kernel written in HIP

```python
import math
import jax
import jax.numpy as jnp
from jax import lax
import numpy as np

D_MODEL = 1024
BATCH = 2
SEQ = 8192
DEPTH = 2

HEAD_DIM = 64
ROPE_THETA = 10000.0
NORM_EPS = 1e-6
PLE_DIM = 256
BLOCK = 128

A_HEADS = 8
IDX_HEADS = 8
IDX_DIM = 64
TOPK_MAX = 256

B_HEADS = 8
B_KV_HEADS = 2
B_WINDOW = 128

C_HEADS = 8
C_PATTERNS = ((128, 1), (512, 4), (2048, 16))

D_HEADS = 4
D_QK_DIM = 64
D_V_DIM = 128

A_WIDTH = A_HEADS * HEAD_DIM
B_WIDTH = B_HEADS * HEAD_DIM
C_WIDTH = C_HEADS * HEAD_DIM
D_WIDTH = D_HEADS * D_V_DIM

EVEN_SPLITS = (A_WIDTH, HEAD_DIM, HEAD_DIM, IDX_HEADS * IDX_DIM, IDX_DIM, IDX_HEADS, A_WIDTH,
               B_WIDTH, B_KV_HEADS * HEAD_DIM, B_KV_HEADS * HEAD_DIM, B_WIDTH)
ODD_SPLITS = (C_WIDTH, C_WIDTH, C_WIDTH, C_WIDTH,
              D_HEADS * 2 * D_QK_DIM, D_HEADS * 2 * D_QK_DIM, D_WIDTH, D_WIDTH)

kernel_name = 'hybrid_dsa_swa_dilated_diff_trunk'


def _rms_norm(x, gain):
    xf = x.astype(jnp.float32)
    y = xf * lax.rsqrt(jnp.mean(xf * xf, axis=-1, keepdims=True) + NORM_EPS)
    return (y * gain.astype(jnp.float32)).astype(x.dtype)


def _rope(x, pos):
    half = x.shape[-1] // 2
    inv = ROPE_THETA ** (-jnp.arange(half, dtype=jnp.float32) / half)
    ang = pos.astype(jnp.float32)[:, None] * inv[None, :]
    cos = jnp.cos(ang)[None, :, None, :]
    sin = jnp.sin(ang)[None, :, None, :]
    xf = x.astype(jnp.float32)
    x1, x2 = xf[..., :half], xf[..., half:]
    return jnp.concatenate([x1 * cos - x2 * sin, x2 * cos + x1 * sin], axis=-1).astype(x.dtype)


def _split(h, sizes):
    offs = np.cumsum(sizes)[:-1].tolist()
    return jnp.split(h, offs, axis=-1)


def _to_blocks(x):
    b, s = x.shape[:2]
    x = x.reshape((b, s // BLOCK, BLOCK) + x.shape[2:])
    return jnp.moveaxis(x, 1, 0)


def _from_blocks(x):
    x = jnp.moveaxis(x, 0, 1)
    return x.reshape((x.shape[0], x.shape[1] * x.shape[2]) + x.shape[3:])


def _dsa_attention(q, k, v, q_idx, k_idx, w_idx):
    bsz, seq = q.shape[:2]
    top_k = min(TOPK_MAX, seq // 4)
    key_pos = jnp.arange(seq)
    bidx = jnp.arange(bsz)[:, None, None]
    scale = HEAD_DIM ** -0.5
    idx_scale = (IDX_HEADS * IDX_DIM) ** -0.5

    def block(args):
        qb, qib, wib, start = args
        t = start + jnp.arange(BLOCK)
        causal = key_pos[None, :] <= t[:, None]
        rel = jax.nn.relu(jnp.einsum('bqhd,bsd->bqhs', qib, k_idx,
                                     preferred_element_type=jnp.float32))
        score = jnp.einsum('bqhs,bqh->bqs', rel, wib.astype(jnp.float32)) * idx_scale
        score = jnp.where(causal[None], score, -jnp.inf)
        _, sel = lax.top_k(score, top_k)
        valid = sel <= t[None, :, None]
        kg = k[bidx, sel]
        vg = v[bidx, sel]
        s = jnp.einsum('bqhd,bqkd->bqhk', qb, kg, preferred_element_type=jnp.float32) * scale
        s = jnp.where(valid[:, :, None, :], s, -jnp.inf)
        pr = jax.nn.softmax(s, axis=-1).astype(v.dtype)
        return jnp.einsum('bqhk,bqkd->bqhd', pr, vg)

    starts = jnp.arange(seq // BLOCK) * BLOCK
    out = lax.map(block, (_to_blocks(q), _to_blocks(q_idx), _to_blocks(w_idx), starts))
    return _from_blocks(out)


def _sliding_window_sink_attention(q, k, v, sinks):
    bsz, seq = q.shape[:2]
    nb = seq // BLOCK
    grp = B_HEADS // B_KV_HEADS
    scale = HEAD_DIM ** -0.5
    qb = q.reshape(bsz, nb, BLOCK, B_KV_HEADS, grp, HEAD_DIM)

    def band(x):
        xb = x.reshape(bsz, nb, BLOCK, B_KV_HEADS, HEAD_DIM)
        prev = jnp.pad(xb, ((0, 0), (1, 0), (0, 0), (0, 0), (0, 0)))[:, :-1]
        return jnp.concatenate([prev, xb], axis=2)

    kb, vb = band(k), band(v)
    s = jnp.einsum('bnqkgd,bnskd->bnkgqs', qb, kb, preferred_element_type=jnp.float32) * scale
    qi = jnp.arange(BLOCK)[:, None]
    kj = jnp.arange(2 * BLOCK)[None, :]
    dist = qi + BLOCK - kj
    in_win = (dist >= 0) & (dist < B_WINDOW)
    mask = in_win[None] & ((jnp.arange(nb)[:, None, None] > 0) | (kj[None] >= BLOCK))
    s = jnp.where(mask[None, :, None, None], s, -jnp.inf)
    sink = sinks.astype(jnp.float32).reshape(1, 1, B_KV_HEADS, grp, 1, 1)
    m = jnp.maximum(jnp.max(s, axis=-1, keepdims=True), sink)
    e = jnp.exp(s - m)
    denom = jnp.sum(e, axis=-1, keepdims=True) + jnp.exp(sink - m)
    pr = (e / denom).astype(v.dtype)
    o = jnp.einsum('bnkgqs,bnskd->bnqkgd', pr, vb)
    return o.reshape(bsz, seq, B_HEADS, HEAD_DIM)


def _dilated_attention(q, k, v):
    seq = q.shape[1]
    scale = HEAD_DIM ** -0.5

    def block(args):
        qb, start = args
        t = start + jnp.arange(BLOCK)
        lses, outs = [], []
        for window, dilation in C_PATTERNS:
            n_keys = window // dilation + 1
            idx = t[:, None] - dilation * jnp.arange(n_keys)[None, :]
            valid = idx >= 0
            idx = jnp.maximum(idx, 0)
            kg = k[:, idx]
            vg = v[:, idx]
            s = jnp.einsum('bqhd,bqnhd->bqhn', qb, kg, preferred_element_type=jnp.float32) * scale
            s = jnp.where(valid[None, :, None, :], s, -jnp.inf)
            m = jnp.max(s, axis=-1, keepdims=True)
            e = jnp.exp(s - m)
            den = jnp.sum(e, axis=-1, keepdims=True)
            o = jnp.einsum('bqhn,bqnhd->bqhd', e.astype(v.dtype), vg,
                           preferred_element_type=jnp.float32) / den
            lses.append(m[..., 0] + jnp.log(den[..., 0]))
            outs.append(o)
        wts = jax.nn.softmax(jnp.stack(lses, axis=0), axis=0)
        comb = jnp.sum(wts[..., None] * jnp.stack(outs, axis=0), axis=0)
        return comb.astype(q.dtype)

    starts = jnp.arange(seq // BLOCK) * BLOCK
    return _from_blocks(lax.map(block, (_to_blocks(q), starts)))


def _diff_attention(q, k, v, lam, sub_gain, lambda_init):
    seq = q.shape[1]
    key_pos = jnp.arange(seq)
    scale = D_QK_DIM ** -0.5

    def block(args):
        qb, start = args
        t = start + jnp.arange(BLOCK)
        s = jnp.einsum('bqhcd,bshcd->bhcqs', qb, k, preferred_element_type=jnp.float32) * scale
        causal = key_pos[None, :] <= t[:, None]
        s = jnp.where(causal, s, -jnp.inf)
        pr = jax.nn.softmax(s, axis=-1)
        a = pr[:, :, 0] - lam * pr[:, :, 1]
        return jnp.einsum('bhqs,bshd->bqhd', a.astype(v.dtype), v)

    starts = jnp.arange(seq // BLOCK) * BLOCK
    o = _from_blocks(lax.map(block, (_to_blocks(q), starts)))
    return _rms_norm(o, sub_gain) * (1.0 - lambda_init)


def _even_layer(h, pos, w_in, w_out, a_q_gain, a_k_gain, idx_k_gain, b_q_gain, b_k_gain, b_sinks):
    bsz, seq, _ = h.shape
    aq, ak, av, iq, ik, iw, ag, bq, bk, bv, bg = _split(h @ w_in, EVEN_SPLITS)
    aq = _rope(_rms_norm(aq.reshape(bsz, seq, A_HEADS, HEAD_DIM), a_q_gain), pos)
    ak = _rope(_rms_norm(ak.reshape(bsz, seq, 1, HEAD_DIM), a_k_gain), pos)[:, :, 0]
    iq = _rope(iq.reshape(bsz, seq, IDX_HEADS, IDX_DIM), pos)
    ik = _rope(_rms_norm(ik.reshape(bsz, seq, 1, IDX_DIM), idx_k_gain), pos)[:, :, 0]
    oa = _dsa_attention(aq, ak, av, iq, ik, iw)
    bq = _rope(_rms_norm(bq.reshape(bsz, seq, B_HEADS, HEAD_DIM), b_q_gain), pos)
    bk = _rope(_rms_norm(bk.reshape(bsz, seq, B_KV_HEADS, HEAD_DIM), b_k_gain), pos)
    bv = bv.reshape(bsz, seq, B_KV_HEADS, HEAD_DIM)
    ob = _sliding_window_sink_attention(bq, bk, bv, b_sinks)
    ya = oa.reshape(bsz, seq, A_WIDTH) * jax.nn.silu(ag)
    yb = ob.reshape(bsz, seq, B_WIDTH) * jax.nn.silu(bg)
    return jnp.concatenate([ya, yb], axis=-1) @ w_out


def _odd_layer(h, pos, w_in, w_out, c_q_gain, c_k_gain, d_q_gain, d_k_gain,
               lq1, lk1, lq2, lk2, sub_gain, lambda_init):
    bsz, seq, _ = h.shape
    cq, ck, cv, cg, dq, dk, dv, dg = _split(h @ w_in, ODD_SPLITS)
    cq = _rope(_rms_norm(cq.reshape(bsz, seq, C_HEADS, HEAD_DIM), c_q_gain), pos)
    ck = _rope(_rms_norm(ck.reshape(bsz, seq, C_HEADS, HEAD_DIM), c_k_gain), pos)
    cv = cv.reshape(bsz, seq, C_HEADS, HEAD_DIM)
    oc = _dilated_attention(cq, ck, cv)
    dq = _rms_norm(dq.reshape(bsz, seq, 2 * D_HEADS, D_QK_DIM), d_q_gain)
    dk = _rms_norm(dk.reshape(bsz, seq, 2 * D_HEADS, D_QK_DIM), d_k_gain)
    dq = _rope(dq, pos).reshape(bsz, seq, D_HEADS, 2, D_QK_DIM)
    dk = _rope(dk, pos).reshape(bsz, seq, D_HEADS, 2, D_QK_DIM)
    dv = dv.reshape(bsz, seq, D_HEADS, D_V_DIM)
    f32 = jnp.float32
    lam = (jnp.exp(jnp.sum(lq1.astype(f32) * lk1.astype(f32)))
           - jnp.exp(jnp.sum(lq2.astype(f32) * lk2.astype(f32))) + lambda_init)
    od = _diff_attention(dq, dk, dv, lam, sub_gain, lambda_init)
    yc = oc.reshape(bsz, seq, C_WIDTH) * jax.nn.silu(cg)
    yd = od.reshape(bsz, seq, D_WIDTH) * jax.nn.silu(dg)
    return jnp.concatenate([yc, yd], axis=-1) @ w_out


def setup_inputs(seed: int = 0) -> dict:
    key = jax.random.key(seed)
    ks = jax.random.split(key, 25)
    n_even = (DEPTH + 1) // 2
    n_odd = DEPTH // 2

    def nrm(k, shape, scale):
        return jax.random.normal(k, shape, jnp.float32) * scale

    def gain(k, shape):
        return 1.0 + 0.02 * jax.random.normal(k, shape, jnp.float32)

    even_out = A_WIDTH + B_WIDTH
    odd_out = C_WIDTH + D_WIDTH
    return {
        'x': nrm(ks[0], (BATCH, SEQ, D_MODEL), 1.0),
        'p': nrm(ks[1], (DEPTH, BATCH, SEQ, PLE_DIM), 1.0),
        'norm_gain': gain(ks[2], (DEPTH, D_MODEL)),
        'w_in_even': nrm(ks[3], (n_even, D_MODEL, sum(EVEN_SPLITS)), D_MODEL ** -0.5),
        'w_out_even': nrm(ks[4], (n_even, even_out, D_MODEL), even_out ** -0.5),
        'a_q_gain': gain(ks[5], (n_even, HEAD_DIM)),
        'a_k_gain': gain(ks[6], (n_even, HEAD_DIM)),
        'idx_k_gain': gain(ks[7], (n_even, IDX_DIM)),
        'b_q_gain': gain(ks[8], (n_even, HEAD_DIM)),
        'b_k_gain': gain(ks[9], (n_even, HEAD_DIM)),
        'b_sinks': nrm(ks[10], (n_even, B_HEADS), 0.5),
        'w_in_odd': nrm(ks[11], (n_odd, D_MODEL, sum(ODD_SPLITS)), D_MODEL ** -0.5),
        'w_out_odd': nrm(ks[12], (n_odd, odd_out, D_MODEL), odd_out ** -0.5),
        'c_q_gain': gain(ks[13], (n_odd, HEAD_DIM)),
        'c_k_gain': gain(ks[14], (n_odd, HEAD_DIM)),
        'd_q_gain': gain(ks[15], (n_odd, D_QK_DIM)),
        'd_k_gain': gain(ks[16], (n_odd, D_QK_DIM)),
        'd_lambda_q1': nrm(ks[17], (n_odd, D_QK_DIM), 0.1),
        'd_lambda_k1': nrm(ks[18], (n_odd, D_QK_DIM), 0.1),
        'd_lambda_q2': nrm(ks[19], (n_odd, D_QK_DIM), 0.1),
        'd_lambda_k2': nrm(ks[20], (n_odd, D_QK_DIM), 0.1),
        'd_subln_gain': gain(ks[21], (n_odd, D_V_DIM)),
        'ple_norm_gain': gain(ks[22], (DEPTH, D_MODEL)),
        'w_ple_gate': nrm(ks[23], (DEPTH, D_MODEL, D_MODEL), D_MODEL ** -0.5),
        'w_ple_proj': nrm(ks[24], (DEPTH, PLE_DIM, D_MODEL), PLE_DIM ** -0.5),
    }


def reference(x, p, norm_gain, w_in_even, w_out_even, a_q_gain, a_k_gain, idx_k_gain,
              b_q_gain, b_k_gain, b_sinks, w_in_odd, w_out_odd, c_q_gain, c_k_gain,
              d_q_gain, d_k_gain, d_lambda_q1, d_lambda_k1, d_lambda_q2, d_lambda_k2,
              d_subln_gain, ple_norm_gain, w_ple_gate, w_ple_proj):
    pos = jnp.arange(x.shape[1])
    for i in range(DEPTH):
        h = _rms_norm(x, norm_gain[i])
        j = i // 2
        if i % 2 == 0:
            y = _even_layer(h, pos, w_in_even[j], w_out_even[j], a_q_gain[j], a_k_gain[j],
                            idx_k_gain[j], b_q_gain[j], b_k_gain[j], b_sinks[j])
        else:
            lambda_init = 0.8 - 0.6 * math.exp(-0.3 * i)
            y = _odd_layer(h, pos, w_in_odd[j], w_out_odd[j], c_q_gain[j], c_k_gain[j],
                           d_q_gain[j], d_k_gain[j], d_lambda_q1[j], d_lambda_k1[j],
                           d_lambda_q2[j], d_lambda_k2[j], d_subln_gain[j], lambda_init)
        x = x + y
        gate = jax.nn.sigmoid(_rms_norm(x, ple_norm_gain[i]) @ w_ple_gate[i])
        x = x + (p[i] @ w_ple_proj[i]) * gate
    return x
```

```cpp
#include <hip/hip_runtime.h>
#include <hip/hip_cooperative_groups.h>
#include <cstdio>
#include <cmath>
namespace cg = cooperative_groups;

#ifndef EN_A
#define EN_A 1
#endif
#ifndef EN_B
#define EN_B 1
#endif
#ifndef EN_C
#define EN_C 1
#endif
#ifndef EN_D
#define EN_D 1
#endif

typedef unsigned short bf16;
typedef short bf16x8 __attribute__((ext_vector_type(8)));
typedef short s16x4 __attribute__((ext_vector_type(4)));
typedef float f32x4 __attribute__((ext_vector_type(4)));
typedef float f32x16 __attribute__((ext_vector_type(16)));
typedef unsigned u32x4 __attribute__((ext_vector_type(4)));
typedef unsigned u32x2 __attribute__((ext_vector_type(2)));
typedef float f32x2_t __attribute__((ext_vector_type(2)));
typedef __bf16 bf16x2_t __attribute__((ext_vector_type(2)));
#define LAS __attribute__((address_space(3)))
#define DI __device__ __forceinline__

constexpr int SEQ = 8192, NTOK = 16384, DM = 1024;
constexpr int NPE = 3072, NPO = 4096;
constexpr float EPS = 1e-6f;
constexpr float LOG2E = 1.4426950408889634f;
constexpr int NTHREADS = 512;
constexpr int LDS_BYTES = 150 * 1024;

constexpr size_t MiB = 1u << 20;
constexpr size_t WS_PE = 0;
constexpr size_t WS_ACT = 128 * MiB;
constexpr size_t WS_Y = 160 * MiB;
constexpr size_t WS_WINE = 192 * MiB;
constexpr size_t WS_WOUTE = 198 * MiB;
constexpr size_t WS_WINO = 200 * MiB;
constexpr size_t WS_WOUTO = 208 * MiB;
constexpr size_t WS_WG0 = 210 * MiB;
constexpr size_t WS_WG1 = 212 * MiB;
constexpr size_t WS_WP0 = 214 * MiB;
constexpr size_t WS_WP1 = 215 * MiB;
constexpr size_t WS_ROPE = 216 * MiB;
constexpr size_t WS_SEL = 218 * MiB;
constexpr size_t WS_IW = 226 * MiB;
constexpr size_t WS_SS = 227 * MiB;
constexpr size_t WS_LAM = 228 * MiB;

struct Params {
  const float* in[25];
  float* out;
  unsigned char* ws;
  float inv_freq[32];
};
enum { I_X = 0, I_P, I_NORM_GAIN, I_W_IN_EVEN, I_W_OUT_EVEN, I_A_Q_GAIN, I_A_K_GAIN, I_IDX_K_GAIN, I_B_Q_GAIN, I_B_K_GAIN, I_B_SINKS,
       I_W_IN_ODD, I_W_OUT_ODD, I_C_Q_GAIN, I_C_K_GAIN, I_D_Q_GAIN, I_D_K_GAIN, I_LQ1, I_LK1, I_LQ2, I_LK2, I_SUB_GAIN, I_PLE_NORM_GAIN,
       I_W_PLE_GATE, I_W_PLE_PROJ };

DI unsigned cvtpk(float lo, float hi) { f32x2_t v = {lo, hi}; bf16x2_t b = __builtin_convertvector(v, bf16x2_t); return __builtin_bit_cast(unsigned, b); }
DI float bf2f(bf16 b) { return __uint_as_float(((unsigned)b) << 16); }
DI float fexp2(float x) { return __builtin_amdgcn_exp2f(x); }
DI f32x16 mfma32(bf16x8 a, bf16x8 b, f32x16 c) { return __builtin_amdgcn_mfma_f32_32x32x16_bf16(a, b, c, 0, 0, 0); }
DI f32x4 mfma16(bf16x8 a, bf16x8 b, f32x4 c) { return __builtin_amdgcn_mfma_f32_16x16x32_bf16(a, b, c, 0, 0, 0); }
DI int crow(int i, int h) { return (i & 3) + 8 * (i >> 2) + 4 * h; }
DI s16x4 trread(const bf16* p) { return __builtin_bit_cast(s16x4, __builtin_amdgcn_ds_read_tr16_b64_v4i16((LAS s16x4*)p)); }
DI void lds_fence() { asm volatile("s_waitcnt lgkmcnt(0)" ::: "memory"); __builtin_amdgcn_wave_barrier(); }

DI int map_even(int n) { return n < 1216 ? n : (n < 1224 ? 3008 + (n - 1216) : n - 8); }
DI void transpose_tile(const float* W, int K, int N, bf16* WT, int mapmode, int tile, float* scr) {
  const int tid = threadIdx.x;
  const int ntn = (N + 63) >> 6, kt = tile / ntn, nt = tile % ntn, k0 = kt * 64, n0 = nt * 64;
#pragma unroll
  for (int i = 0; i < 8; ++i) {
    const int kk = (tid >> 6) + 8 * i, nn = tid & 63, n = n0 + nn;
    scr[kk * 65 + nn] = (n < N) ? W[(size_t)(k0 + kk) * N + n] : 0.f;
  }
  __syncthreads();
  {
    const int nn = tid >> 3, kc = tid & 7, n = n0 + nn;
    if (n < N) {
      const int dst = mapmode ? map_even(n) : n;
      const float* s = scr + (kc * 8) * 65 + nn;
      u32x4 o; o.x = cvtpk(s[0], s[65]); o.y = cvtpk(s[2 * 65], s[3 * 65]); o.z = cvtpk(s[4 * 65], s[5 * 65]); o.w = cvtpk(s[6 * 65], s[7 * 65]);
      *(u32x4*)(WT + (size_t)dst * K + k0 + kc * 8) = o;
    }
  }
  __syncthreads();
}

DI float wave_sum(float v) {
#pragma unroll
  for (int o = 1; o < 64; o <<= 1) v += __shfl_xor(v, o);
  return v;
}

DI void phase_prologue(const Params& p, char* lds) {
  const int tid = threadIdx.x, lane = tid & 63, wid = tid >> 6;
  const int nb = gridDim.x, bid = blockIdx.x;
  unsigned char* ws = p.ws;
  float* scr = (float*)lds;
  const int T0 = 16 * 48, T1 = 256, T2 = 16 * 64, T3 = 256, T4 = 256, T5 = 256, T6 = 64, T7 = 64;
  const int NT = T0 + T1 + T2 + T3 + T4 + T5 + T6 + T7;
  for (int it = bid; it < NT; it += nb) {
    int r = it;
    if (r < T0) { transpose_tile(p.in[I_W_IN_EVEN], 1024, 3016, (bf16*)(ws + WS_WINE), 1, r, scr); continue; } r -= T0;
    if (r < T1) { transpose_tile(p.in[I_W_OUT_EVEN], 1024, 1024, (bf16*)(ws + WS_WOUTE), 0, r, scr); continue; } r -= T1;
    if (r < T2) { transpose_tile(p.in[I_W_IN_ODD], 1024, 4096, (bf16*)(ws + WS_WINO), 0, r, scr); continue; } r -= T2;
    if (r < T3) { transpose_tile(p.in[I_W_OUT_ODD], 1024, 1024, (bf16*)(ws + WS_WOUTO), 0, r, scr); continue; } r -= T3;
    if (r < T4) { transpose_tile(p.in[I_W_PLE_GATE], 1024, 1024, (bf16*)(ws + WS_WG0), 0, r, scr); continue; } r -= T4;
    if (r < T5) { transpose_tile(p.in[I_W_PLE_GATE] + 1024 * 1024, 1024, 1024, (bf16*)(ws + WS_WG1), 0, r, scr); continue; } r -= T5;
    if (r < T6) { transpose_tile(p.in[I_W_PLE_PROJ], 256, 1024, (bf16*)(ws + WS_WP0), 0, r, scr); continue; } r -= T6;
    transpose_tile(p.in[I_W_PLE_PROJ] + 256 * 1024, 256, 1024, (bf16*)(ws + WS_WP1), 0, r, scr);
  }
  const int gt = bid * NTHREADS + tid, ngt = nb * NTHREADS;
  { unsigned* z = (unsigned*)((bf16*)(ws + WS_WINE) + (size_t)3016 * 1024); for (int i = gt; i < 56 * 512; i += ngt) z[i] = 0u; }
  { float* ss = (float*)(ws + WS_SS); for (int i = gt; i < 3 * NTOK; i += ngt) ss[i] = 0.f; }
  { float2* tab = (float2*)(ws + WS_ROPE);
    for (int i = gt; i < SEQ * 32; i += ngt) {
      const int pos = i >> 5, k = i & 31;
      const float ang = (float)pos * p.inv_freq[k];
      double rev = (double)ang * 0.15915494309189535; rev -= floor(rev);
      const float rf = (float)rev;
      tab[i] = make_float2(__builtin_amdgcn_cosf(rf), __builtin_amdgcn_sinf(rf));
    } }
  if (bid == 0 && wid == 0) {
    const float a = wave_sum(p.in[I_LQ1][lane] * p.in[I_LK1][lane]);
    const float b = wave_sum(p.in[I_LQ2][lane] * p.in[I_LK2][lane]);
    const float lambda_init = 0.8f - 0.6f * expf(-0.3f);
    if (lane == 0) *(float*)(ws + WS_LAM) = expf(a) - expf(b) + lambda_init;
  }
  { const float* x = p.in[I_X]; const float* g = p.in[I_NORM_GAIN]; bf16* H = (bf16*)(ws + WS_ACT);
    const int gw = bid * 8 + wid, ngw = nb * 8;
    for (int m = gw; m < NTOK; m += ngw) {
      const f32x4* xr = (const f32x4*)(x + (size_t)m * DM) + lane;
      f32x4 v[4]; float s = 0.f;
#pragma unroll
      for (int j = 0; j < 4; ++j) { v[j] = xr[64 * j]; s += v[j].x * v[j].x + v[j].y * v[j].y + v[j].z * v[j].z + v[j].w * v[j].w; }
      const float rstd = rsqrtf(wave_sum(s) * (1.f / DM) + EPS);
      u32x2* o = (u32x2*)(H + (size_t)m * DM) + lane;
#pragma unroll
      for (int j = 0; j < 4; ++j) { const f32x4 gg = *((const f32x4*)g + lane + 64 * j); u32x2 w; w.x = cvtpk(v[j].x * rstd * gg.x, v[j].y * rstd * gg.y); w.y = cvtpk(v[j].z * rstd * gg.z, v[j].w * rstd * gg.w); o[64 * j] = w; }
    } }
}

constexpr int GP = 72;
template <int AF32>
DI void gemm_acc(const void* Aptr, int lda, const bf16* Bt, int K, int m0, int n0, char* lds, f32x4 (&acc)[4][4]) {
  bf16* As = (bf16*)lds; bf16* Bs = As + 256 * GP;
  const int tid = threadIdx.x, lane = tid & 63, wid = tid >> 6, wm = wid & 3, wn = wid >> 2, r = lane & 15, q4 = lane >> 4;
  u32x4 ra[4], rb[2];
  const int nk = K >> 6;
#define GLOAD(k0) do { \
    _Pragma("unroll") for (int i = 0; i < 4; ++i) { const int c = tid + 512 * i, row = c >> 3, ch = c & 7; \
      if (AF32) { const float* s_ = (const float*)Aptr + (size_t)(m0 + row) * lda + (k0) + ch * 8; const f32x4 a_ = *(const f32x4*)s_, b_ = *(const f32x4*)(s_ + 4); \
        ra[i].x = cvtpk(a_.x, a_.y); ra[i].y = cvtpk(a_.z, a_.w); ra[i].z = cvtpk(b_.x, b_.y); ra[i].w = cvtpk(b_.z, b_.w); } \
      else ra[i] = *(const u32x4*)((const bf16*)Aptr + (size_t)(m0 + row) * lda + (k0) + ch * 8); } \
    _Pragma("unroll") for (int i = 0; i < 2; ++i) { const int c = tid + 512 * i, row = c >> 3, ch = c & 7; \
      rb[i] = *(const u32x4*)(Bt + (size_t)(n0 + row) * K + (k0) + ch * 8); } } while (0)
  GLOAD(0);
  for (int kt = 0; kt < nk; ++kt) {
    __syncthreads();
#pragma unroll
    for (int i = 0; i < 4; ++i) { const int c = tid + 512 * i, row = c >> 3, ch = c & 7; *(u32x4*)(As + row * GP + ch * 8) = ra[i]; }
#pragma unroll
    for (int i = 0; i < 2; ++i) { const int c = tid + 512 * i, row = c >> 3, ch = c & 7; *(u32x4*)(Bs + row * GP + ch * 8) = rb[i]; }
    __syncthreads();
    if (kt + 1 < nk) GLOAD((kt + 1) * 64);
#pragma unroll
    for (int ks = 0; ks < 2; ++ks) {
      bf16x8 af[4], bfr[4];
#pragma unroll
      for (int i = 0; i < 4; ++i) { af[i] = *(const bf16x8*)(As + (wm * 64 + i * 16 + r) * GP + ks * 32 + q4 * 8); bfr[i] = *(const bf16x8*)(Bs + (wn * 64 + i * 16 + r) * GP + ks * 32 + q4 * 8); }
#pragma unroll
      for (int mi = 0; mi < 4; ++mi)
#pragma unroll
        for (int ni = 0; ni < 4; ++ni) acc[mi][ni] = mfma16(bfr[ni], af[mi], acc[mi][ni]);
    }
  }
#undef GLOAD
}
DI void zero_acc(f32x4 (&acc)[4][4]) {
#pragma unroll
  for (int a = 0; a < 4; ++a)
#pragma unroll
    for (int b = 0; b < 4; ++b) acc[a][b] = (f32x4){0.f, 0.f, 0.f, 0.f};
}

enum { T_PLAIN = 0, T_NR = 1, T_ROPE = 2, T_SILU = 3, T_IW = 4 };
DI void slot_info(const Params& p, int layer, int slot, int& type, const float*& gain) {
  gain = nullptr;
  if (layer == 0) {
    if (slot < 8) { type = T_NR; gain = p.in[I_A_Q_GAIN]; }
    else if (slot == 8) { type = T_NR; gain = p.in[I_A_K_GAIN]; }
    else if (slot == 9) type = T_PLAIN;
    else if (slot < 18) type = T_ROPE;
    else if (slot == 18) { type = T_NR; gain = p.in[I_IDX_K_GAIN]; }
    else if (slot < 27) type = T_SILU;
    else if (slot < 35) { type = T_NR; gain = p.in[I_B_Q_GAIN]; }
    else if (slot < 37) { type = T_NR; gain = p.in[I_B_K_GAIN]; }
    else if (slot < 39) type = T_PLAIN;
    else if (slot < 47) type = T_SILU;
    else type = T_IW;
  } else {
    if (slot < 8) { type = T_NR; gain = p.in[I_C_Q_GAIN]; }
    else if (slot < 16) { type = T_NR; gain = p.in[I_C_K_GAIN]; }
    else if (slot < 24) type = T_PLAIN;
    else if (slot < 32) type = T_SILU;
    else if (slot < 40) { type = T_NR; gain = p.in[I_D_Q_GAIN]; }
    else if (slot < 48) { type = T_NR; gain = p.in[I_D_K_GAIN]; }
    else if (slot < 56) type = T_PLAIN;
    else type = T_SILU;
  }
}
constexpr int E_AQ = 0, E_AK = 512, E_AV = 576, E_IQ = 640, E_IK = 1152, E_AG = 1216, E_BQ = 1728, E_BK = 2240, E_BV = 2368, E_BG = 2496;
constexpr int O_CQ = 0, O_CK = 512, O_CV = 1024, O_CG = 1536, O_DQ = 2048, O_DK = 2560, O_DV = 3072, O_DG = 3584;

DI void phase_inproj(const Params& p, int layer, char* lds) {
  unsigned char* ws = p.ws;
  const int NP = layer == 0 ? NPE : NPO;
  const bf16* A = (const bf16*)(ws + (layer == 0 ? WS_ACT : WS_Y));
  const bf16* Bt = (const bf16*)(ws + (layer == 0 ? WS_WINE : WS_WINO));
  bf16* PE = (bf16*)(ws + WS_PE);
  const float2* rope = (const float2*)(ws + WS_ROPE);
  const float* ss1 = (const float*)(ws + WS_SS);
  float* IW = (float*)(ws + WS_IW);
  const int lane = threadIdx.x & 63, wid = threadIdx.x >> 6, wm = wid & 3, wn = wid >> 2, r = lane & 15, q4 = lane >> 4;
  const int nnt = NP / 128, ntiles = 64 * nnt;
  for (int tile = blockIdx.x; tile < ntiles; tile += gridDim.x) {
    const int nt = tile / 64, mt = tile % 64;
    const int m0 = mt * 256, n0 = nt * 128;
    f32x4 acc[4][4]; zero_acc(acc);
    gemm_acc<0>(A, DM, Bt, DM, m0, n0, lds, acc);
    const int mbase = m0 + wm * 64, nbase = n0 + wn * 64, slot = nbase >> 6;
    int type; const float* gain; slot_info(p, layer, slot, type, gain);
#pragma unroll
    for (int mi = 0; mi < 4; ++mi) {
      const int m = mbase + mi * 16 + r, pos = m & (SEQ - 1);
      float sc = 1.f;
      if (layer == 1) sc = rsqrtf(ss1[m] * (1.f / DM) + EPS);
      f32x4 v[4];
#pragma unroll
      for (int ni = 0; ni < 4; ++ni) v[ni] = acc[mi][ni] * sc;
      if (type == T_NR) {
        float s = 0.f;
#pragma unroll
        for (int ni = 0; ni < 4; ++ni) s += v[ni].x * v[ni].x + v[ni].y * v[ni].y + v[ni].z * v[ni].z + v[ni].w * v[ni].w;
        s += __shfl_xor(s, 16); s += __shfl_xor(s, 32);
        const float rn = rsqrtf(s * (1.f / 64.f) + EPS);
#pragma unroll
        for (int ni = 0; ni < 4; ++ni) { const f32x4 g = *(const f32x4*)(gain + ni * 16 + q4 * 4); v[ni] = v[ni] * rn * g; }
      }
      if (type == T_NR || type == T_ROPE) {
#pragma unroll
        for (int ni = 0; ni < 2; ++ni) {
          const f32x4* cs = (const f32x4*)(rope + (size_t)pos * 32 + ni * 16 + q4 * 4);
          const f32x4 c01 = cs[0], c23 = cs[1];
          const f32x4 x1 = v[ni], x2 = v[ni + 2];
          f32x4 o1, o2;
          o1.x = x1.x * c01.x - x2.x * c01.y; o2.x = x2.x * c01.x + x1.x * c01.y;
          o1.y = x1.y * c01.z - x2.y * c01.w; o2.y = x2.y * c01.z + x1.y * c01.w;
          o1.z = x1.z * c23.x - x2.z * c23.y; o2.z = x2.z * c23.x + x1.z * c23.y;
          o1.w = x1.w * c23.z - x2.w * c23.w; o2.w = x2.w * c23.z + x1.w * c23.w;
          v[ni] = o1; v[ni + 2] = o2;
        }
      }
      if (type == T_SILU) {
#pragma unroll
        for (int ni = 0; ni < 4; ++ni)
#pragma unroll
          for (int j = 0; j < 4; ++j) { const float t = v[ni][j]; v[ni][j] = t / (1.f + __expf(-t)); }
      }
      if (type == T_IW) {
        if (q4 < 2) *(f32x4*)(IW + (size_t)m * 8 + q4 * 4) = v[0];
      } else {
#pragma unroll
        for (int ni = 0; ni < 4; ++ni) { u32x2 w; w.x = cvtpk(v[ni].x, v[ni].y); w.y = cvtpk(v[ni].z, v[ni].w); *(u32x2*)(PE + (size_t)m * NP + nbase + ni * 16 + q4 * 4) = w; }
      }
    }
  }
}

DI void phase_outproj(const Params& p, int layer, char* lds) {
  unsigned char* ws = p.ws;
  const bf16* A = (const bf16*)(ws + WS_Y);
  const bf16* Bt = (const bf16*)(ws + (layer == 0 ? WS_WOUTE : WS_WOUTO));
  const float* xin = layer == 0 ? p.in[I_X] : p.out;
  float* out = p.out;
  bf16* XG = (bf16*)(ws + WS_ACT);
  const float* pg = p.in[I_PLE_NORM_GAIN] + layer * DM;
  float* ss = (float*)(ws + WS_SS) + (layer == 0 ? 1 : 2) * NTOK;
  const int lane = threadIdx.x & 63, wid = threadIdx.x >> 6, wm = wid & 3, wn = wid >> 2, r = lane & 15, q4 = lane >> 4;
  const int ntiles = 64 * 8;
  for (int tile = blockIdx.x; tile < ntiles; tile += gridDim.x) {
    const int nt = tile / 64, mt = tile % 64, m0 = mt * 256, n0 = nt * 128;
    f32x4 acc[4][4]; zero_acc(acc);
    gemm_acc<0>(A, DM, Bt, DM, m0, n0, lds, acc);
    const int mbase = m0 + wm * 64, nbase = n0 + wn * 64;
#pragma unroll
    for (int mi = 0; mi < 4; ++mi) {
      const int m = mbase + mi * 16 + r; float rs = 0.f;
#pragma unroll
      for (int ni = 0; ni < 4; ++ni) {
        const int n = nbase + ni * 16 + q4 * 4; const size_t off = (size_t)m * DM + n;
        const f32x4 xn = *(const f32x4*)(xin + off) + acc[mi][ni];
        *(f32x4*)(out + off) = xn;
        rs += xn.x * xn.x + xn.y * xn.y + xn.z * xn.z + xn.w * xn.w;
        const f32x4 g = *(const f32x4*)(pg + n);
        u32x2 w; w.x = cvtpk(xn.x * g.x, xn.y * g.y); w.y = cvtpk(xn.z * g.z, xn.w * g.w); *(u32x2*)(XG + off) = w;
      }
      rs += __shfl_xor(rs, 16); rs += __shfl_xor(rs, 32);
      if (q4 == 0) atomicAdd(ss + m, rs);
    }
  }
}

DI void phase_ple(const Params& p, int layer, char* lds) {
  unsigned char* ws = p.ws;
  const float* Pin = p.in[I_P] + (size_t)layer * NTOK * 256;
  const bf16* Wp = (const bf16*)(ws + (layer == 0 ? WS_WP0 : WS_WP1));
  const bf16* Wg = (const bf16*)(ws + (layer == 0 ? WS_WG0 : WS_WG1));
  const bf16* XG = (const bf16*)(ws + WS_ACT);
  float* out = p.out;
  const float* ssx = (const float*)(ws + WS_SS) + (layer == 0 ? 1 : 2) * NTOK;
  float* ss1 = (float*)(ws + WS_SS);
  bf16* H = (bf16*)(ws + WS_Y);
  float* PT = (float*)(ws + WS_PE);
  const float* ng1 = p.in[I_NORM_GAIN] + DM;
  const int lane = threadIdx.x & 63, wid = threadIdx.x >> 6, wm = wid & 3, wn = wid >> 2, r = lane & 15, q4 = lane >> 4;
  const int ntiles = 64 * 8;
  for (int tile = blockIdx.x; tile < ntiles; tile += gridDim.x) {
    const int nt = tile / 64, mt = tile % 64, m0 = mt * 256, n0 = nt * 128;
    const int mbase = m0 + wm * 64, nbase = n0 + wn * 64;
    f32x4 acc[4][4]; zero_acc(acc);
    gemm_acc<1>(Pin, 256, Wp, 256, m0, n0, lds, acc);
#pragma unroll
    for (int mi = 0; mi < 4; ++mi)
#pragma unroll
      for (int ni = 0; ni < 4; ++ni) *(f32x4*)(PT + (size_t)(mbase + mi * 16 + r) * DM + nbase + ni * 16 + q4 * 4) = acc[mi][ni];
    zero_acc(acc);
    gemm_acc<0>(XG, DM, Wg, DM, m0, n0, lds, acc);
#pragma unroll
    for (int mi = 0; mi < 4; ++mi) {
      const int m = mbase + mi * 16 + r; float rs = 0.f;
      const float rstd = rsqrtf(ssx[m] * (1.f / DM) + EPS);
#pragma unroll
      for (int ni = 0; ni < 4; ++ni) {
        const int n = nbase + ni * 16 + q4 * 4; const size_t off = (size_t)m * DM + n;
        f32x4 g;
#pragma unroll
        for (int j = 0; j < 4; ++j) g[j] = 1.f / (1.f + __expf(-rstd * acc[mi][ni][j]));
        const f32x4 xn = *(const f32x4*)(out + off) + *(const f32x4*)(PT + off) * g;
        *(f32x4*)(out + off) = xn;
        if (layer == 0) {
          rs += xn.x * xn.x + xn.y * xn.y + xn.z * xn.z + xn.w * xn.w;
          const f32x4 gg = *(const f32x4*)(ng1 + n);
          u32x2 w; w.x = cvtpk(xn.x * gg.x, xn.y * gg.y); w.y = cvtpk(xn.z * gg.z, xn.w * gg.w); *(u32x2*)(H + off) = w;
        }
      }
      if (layer == 0) { rs += __shfl_xor(rs, 16); rs += __shfl_xor(rs, 32); if (q4 == 0) atomicAdd(ss1 + m, rs); }
    }
  }
}

template <int DVB>
DI void attn_step32(const bf16* Kt, int KP, const bf16* Vt, int VP, const bf16x8 (&qf)[4], f32x16 (&o)[DVB], float& m, float& l, unsigned vmask, float c2, int lane) {
  const int r32 = lane & 31, h = lane >> 5;
  f32x16 s;
#pragma unroll
  for (int i = 0; i < 16; ++i) s[i] = 0.f;
#pragma unroll
  for (int t = 0; t < 4; ++t) { const bf16x8 kf = *(const bf16x8*)(Kt + r32 * KP + t * 16 + h * 8); s = mfma32(kf, qf[t], s); }
  float mx = -INFINITY;
#pragma unroll
  for (int i = 0; i < 16; ++i) { const float v = ((vmask >> i) & 1u) ? s[i] * c2 : -INFINITY; s[i] = v; mx = fmaxf(mx, v); }
  mx = fmaxf(mx, __shfl_xor(mx, 32));
  const float mn = fmaxf(m, mx);
  if (__any(mn > m)) {
    const float alpha = fexp2(m - mn); l *= alpha;
#pragma unroll
    for (int d = 0; d < DVB; ++d)
#pragma unroll
      for (int i = 0; i < 16; ++i) o[d][i] *= alpha;
    m = mn;
  }
  float ps = 0.f;
#pragma unroll
  for (int i = 0; i < 16; ++i) { const float pv = fexp2(s[i] - m); s[i] = pv; ps += pv; }
  l += ps;
  bf16x8 pf[2];
  { u32x4 a, b; a.x = cvtpk(s[0], s[1]); a.y = cvtpk(s[2], s[3]); a.z = cvtpk(s[4], s[5]); a.w = cvtpk(s[6], s[7]);
    b.x = cvtpk(s[8], s[9]); b.y = cvtpk(s[10], s[11]); b.z = cvtpk(s[12], s[13]); b.w = cvtpk(s[14], s[15]);
    pf[0] = __builtin_bit_cast(bf16x8, a); pf[1] = __builtin_bit_cast(bf16x8, b); }
  const int i16 = lane & 15, q = i16 >> 2, pp = i16 & 3, blk = (lane >> 4) & 1;
#pragma unroll
  for (int d = 0; d < DVB; ++d)
#pragma unroll
    for (int sk = 0; sk < 2; ++sk) {
      const s16x4 lo = trread(Vt + (16 * sk + 4 * h + q) * VP + 32 * d + 16 * blk + 4 * pp);
      const s16x4 hi = trread(Vt + (16 * sk + 8 + 4 * h + q) * VP + 32 * d + 16 * blk + 4 * pp);
      const bf16x8 vf = __builtin_shufflevector(lo, hi, 0, 1, 2, 3, 4, 5, 6, 7);
      o[d] = mfma32(vf, pf[sk], o[d]);
    }
}

constexpr int WP = 72;
constexpr int WAVE_LDS = 2 * 32 * WP * 2;

struct KVRegs { u32x4 k[4], v[4]; };
DI void kv_store(const KVRegs& R, bf16* Ks, bf16* Vs, int lane) {
#pragma unroll
  for (int i = 0; i < 4; ++i) { const int row = (lane >> 3) + 8 * i, ch = lane & 7; *(u32x4*)(Ks + row * WP + ch * 8) = R.k[i]; *(u32x4*)(Vs + row * WP + ch * 8) = R.v[i]; }
}

DI void band_load(KVRegs& R, const bf16* Kg, const bf16* Vg, int NP, int kstart, int dil, int roff, int lane) {
#pragma unroll
  for (int i = 0; i < 4; ++i) {
    const int row = (lane >> 3) + 8 * i, ch = lane & 7; int k = kstart + row; if (k < 0) k = 0;
    const size_t off = (size_t)(dil * k + roff) * NP + ch * 8;
    R.k[i] = *(const u32x4*)(Kg + off); R.v[i] = *(const u32x4*)(Vg + off);
  }
}
template <int DVB>
DI void band_run(const bf16* Kg, const bf16* Vg, int NP, int kbase, int nsteps, int dil, int roff, int qidx, int win,
                 const bf16x8 (&qf)[4], f32x16 (&o)[DVB], float& m, float& l, float c2, bf16* Ks, bf16* Vs, int lane) {
  const int h = lane >> 5;
  KVRegs R; band_load(R, Kg, Vg, NP, kbase, dil, roff, lane);
  for (int j = 0; j < nsteps; ++j) {
    lds_fence();
    kv_store(R, Ks, Vs, lane);
    lds_fence();
    if (j + 1 < nsteps) band_load(R, Kg, Vg, NP, kbase + 32 * (j + 1), dil, roff, lane);
    unsigned vm = 0;
#pragma unroll
    for (int i = 0; i < 16; ++i) { const int k = kbase + 32 * j + crow(i, h); const int dlt = qidx - k; if (k >= 0 && dlt >= 0 && dlt <= win) vm |= (1u << i); }
    attn_step32<DVB>(Ks, WP, Vs, WP, qf, o, m, l, vm, c2, lane);
  }
}

DI void write_o64(const f32x16 (&o)[2], float linv, const bf16* gate_row, bf16* y_row, int h) {
#pragma unroll
  for (int d = 0; d < 2; ++d)
#pragma unroll
    for (int g = 0; g < 4; ++g) {
      const int dd = 32 * d + 8 * g + 4 * h;
      const u32x2 gv = *(const u32x2*)(gate_row + dd);
      const float g0 = __uint_as_float(gv.x << 16), g1 = __uint_as_float(gv.x & 0xffff0000u), g2 = __uint_as_float(gv.y << 16), g3 = __uint_as_float(gv.y & 0xffff0000u);
      u32x2 w; w.x = cvtpk(o[d][4 * g] * linv * g0, o[d][4 * g + 1] * linv * g1); w.y = cvtpk(o[d][4 * g + 2] * linv * g2, o[d][4 * g + 3] * linv * g3);
      *(u32x2*)(y_row + dd) = w;
    }
}

DI void load_q(bf16x8 (&qf)[4], const bf16* qrow, int h) {
#pragma unroll
  for (int t = 0; t < 4; ++t) qf[t] = *(const bf16x8*)(qrow + t * 16 + h * 8);
}
template <int DVB> DI void zero_o(f32x16 (&o)[DVB]) {
#pragma unroll
  for (int d = 0; d < DVB; ++d)
#pragma unroll
    for (int i = 0; i < 16; ++i) o[d][i] = 0.f;
}

DI void mixerB_tile(const Params& p, int item, bf16* Ks, bf16* Vs, int lane) {
  const bf16* PE = (const bf16*)(p.ws + WS_PE); bf16* Y = (bf16*)(p.ws + WS_Y);
  const int qblk = item & 255, head = (item >> 8) & 7, b = item >> 11;
  const int r32 = lane & 31, h = lane >> 5, q0 = qblk * 32, kvh = head >> 2;
  const size_t rowb = (size_t)b * SEQ;
  bf16x8 qf[4]; load_q(qf, PE + (rowb + q0 + r32) * NPE + E_BQ + head * 64, h);
  f32x16 o[2]; zero_o<2>(o);
  const float sink2 = p.in[I_B_SINKS][head] * LOG2E;
  float m = sink2, l = (h == 0) ? 1.f : 0.f;
  band_run<2>(PE + rowb * NPE + E_BK + kvh * 64, PE + rowb * NPE + E_BV + kvh * 64, NPE, q0 - 128, 5, 1, 0, q0 + r32, 127, qf, o, m, l, 0.125f * LOG2E, Ks, Vs, lane);
  l += __shfl_xor(l, 32);
  const size_t tok = rowb + q0 + r32;
  write_o64(o, 1.f / l, PE + tok * NPE + E_BG + head * 64, Y + tok * DM + 512 + head * 64, h);
}

DI void mixerC_tile(const Params& p, int item, bf16* Ks, bf16* Vs, int lane) {
  const bf16* PO = (const bf16*)(p.ws + WS_PE); bf16* Y = (bf16*)(p.ws + WS_Y);
  const int qt = item & 15, r16 = (item >> 4) & 15, head = (item >> 8) & 7, b = item >> 11;
  const int r32 = lane & 31, h = lane >> 5, qi0 = qt * 32;
  const size_t rowb = (size_t)b * SEQ;
  const int t = 16 * (qi0 + r32) + r16;
  bf16x8 qf[4]; load_q(qf, PO + (rowb + t) * NPO + O_CQ + head * 64, h);
  f32x16 o[2]; zero_o<2>(o);
  float m = -1e30f, l = 0.f;
  const bf16* Kg = PO + rowb * NPO + O_CK + head * 64; const bf16* Vg = PO + rowb * NPO + O_CV + head * 64;
  const float c2 = 0.125f * LOG2E;
  band_run<2>(Kg, Vg, NPO, qi0 - 128, 5, 16, r16, qi0 + r32, 128, qf, o, m, l, c2, Ks, Vs, lane);
  band_run<2>(Kg, Vg, NPO, 4 * qi0 + (r16 >> 2) - 128, 8, 4, r16 & 3, 4 * (qi0 + r32) + (r16 >> 2), 128, qf, o, m, l, c2, Ks, Vs, lane);
  band_run<2>(Kg, Vg, NPO, 16 * qi0 + r16 - 128, 20, 1, 0, t, 128, qf, o, m, l, c2, Ks, Vs, lane);
  l += __shfl_xor(l, 32);
  const size_t tok = rowb + t;
  write_o64(o, 1.f / l, PO + tok * NPO + O_CG + head * 64, Y + tok * DM + head * 64, h);
}

DI void mixerA_item(const Params& p, int item, bf16* Ks, bf16* Vs, int lane) {
  const bf16* PE = (const bf16*)(p.ws + WS_PE); bf16* Y = (bf16*)(p.ws + WS_Y);
  const unsigned short* SEL = (const unsigned short*)(p.ws + WS_SEL) + (size_t)item * 256;
  const int t = item & (SEQ - 1), b = item >> 13;
  const int r32 = lane & 31, h = lane >> 5, head = r32 & 7;
  const size_t rowb = (size_t)b * SEQ;
  const int count = (t + 1 < 256) ? t + 1 : 256, nsteps = (count + 31) >> 5;
  bf16x8 qf[4]; load_q(qf, PE + (size_t)item * NPE + E_AQ + head * 64, h);
  f32x16 o[2]; zero_o<2>(o);
  float m = -1e30f, l = 0.f;
  const bf16* Kg = PE + rowb * NPE + E_AK; const bf16* Vg = PE + rowb * NPE + E_AV;
  KVRegs R;
#define A_LOAD(j) do { _Pragma("unroll") for (int i = 0; i < 4; ++i) { const int row = (lane >> 3) + 8 * i, ch = lane & 7, e = 32 * (j) + row; \
      const int tokk = (e < count) ? (int)SEL[e] : 0; const size_t off = (size_t)tokk * NPE + ch * 8; R.k[i] = *(const u32x4*)(Kg + off); R.v[i] = *(const u32x4*)(Vg + off); } } while (0)
  A_LOAD(0);
  for (int j = 0; j < nsteps; ++j) {
    lds_fence();
    kv_store(R, Ks, Vs, lane);
    lds_fence();
    if (j + 1 < nsteps) A_LOAD(j + 1);
    unsigned vm = 0;
#pragma unroll
    for (int i = 0; i < 16; ++i) if (32 * j + crow(i, h) < count) vm |= (1u << i);
    attn_step32<2>(Ks, WP, Vs, WP, qf, o, m, l, vm, 0.125f * LOG2E, lane);
  }
#undef A_LOAD
  l += __shfl_xor(l, 32);
  if (r32 < 8) write_o64(o, 1.f / l, PE + (size_t)item * NPE + E_AG + head * 64, Y + (size_t)item * DM + head * 64, h);
}

DI unsigned f2ord(float f) { f += 0.f; const unsigned u = __float_as_uint(f); return (u & 0x80000000u) ? ~u : (u | 0x80000000u); }
DI int block_excl_scan(int v, int* tmp, int* tot) {
  const int lane = threadIdx.x & 63, wid = threadIdx.x >> 6;
  int inc = v;
#pragma unroll
  for (int o = 1; o < 64; o <<= 1) { const int u = __shfl_up(inc, o); if (lane >= o) inc += u; }
  __syncthreads();
  if (lane == 63) tmp[wid] = inc;
  __syncthreads();
  int base = 0, total = 0;
#pragma unroll
  for (int w = 0; w < 8; ++w) { const int x = tmp[w]; if (w < wid) base += x; total += x; }
  *tot = total;
  return base + inc - v;
}

DI void selectA_item(const Params& p, int item, char* lds) {
  const bf16* PE = (const bf16*)(p.ws + WS_PE);
  const float* IW = (const float*)(p.ws + WS_IW);
  unsigned short* SEL = (unsigned short*)(p.ws + WS_SEL);
  unsigned* sc = (unsigned*)lds;
  int* hist = (int*)(lds + 4 * 8192 * 4);
  int* misc = hist + 4096;
  const int tid = threadIdx.x, lane = tid & 63, wid = tid >> 6, r32 = lane & 31, h = lane >> 5;
  const int b = item >> 11, t0 = (item & 2047) * 4;
  const size_t rowb = (size_t)b * SEQ;
  const int nk = t0 + 4, ntile = (nk + 31) >> 5;
  const int cq = r32 >> 3, chd = r32 & 7;
  bf16x8 qf[4]; load_q(qf, PE + (rowb + t0 + cq) * NPE + E_IQ + chd * 64, h);
  const float w = IW[(rowb + t0 + cq) * 8 + chd] * 0.04419417382415922f;
  const bf16* Kg = PE + rowb * NPE + E_IK;
  for (int kt = wid; kt < ntile; kt += 8) {
    f32x16 s;
#pragma unroll
    for (int i = 0; i < 16; ++i) s[i] = 0.f;
#pragma unroll
    for (int t = 0; t < 4; ++t) { const bf16x8 kf = *(const bf16x8*)(Kg + (size_t)(kt * 32 + r32) * NPE + t * 16 + h * 8); s = mfma32(kf, qf[t], s); }
#pragma unroll
    for (int i = 0; i < 16; ++i) {
      float v = w * fmaxf(s[i], 0.f);
      v += __shfl_xor(v, 1); v += __shfl_xor(v, 2); v += __shfl_xor(v, 4);
      if (chd == 0) { const int key = kt * 32 + crow(i, h); sc[cq * 8192 + key] = (key <= t0 + cq) ? f2ord(v) : 0u; }
    }
  }
  __syncthreads();
  for (int q = 0; q < 4; ++q) {
    const int t = t0 + q, n = t + 1;
    unsigned short* out = SEL + (rowb + t) * 256;
    if (n <= 256) { if (tid < n) out[tid] = (unsigned short)tid; continue; }
    const unsigned* scq = sc + q * 8192;
    unsigned long long cmp[16];
#pragma unroll
    for (int i = 0; i < 16; ++i) { const int idx = tid + 512 * i; cmp[i] = (idx < n) ? (((unsigned long long)scq[idx] << 16) | ((unsigned long long)(8191 - idx) << 3)) : 0ull; }
    unsigned long long prefix = 0ull; int shift = 36, need = 256;
    for (int pass = 0; pass < 4; ++pass) {
      for (int i = tid; i < 4096; i += 512) hist[i] = 0;
      __syncthreads();
#pragma unroll
      for (int i = 0; i < 16; ++i) { const int idx = tid + 512 * i; if (idx < n && (pass == 0 || (cmp[i] >> (shift + 12)) == prefix)) atomicAdd(&hist[(int)((cmp[i] >> shift) & 4095ull)], 1); }
      __syncthreads();
      int hh[8], tot = 0;
#pragma unroll
      for (int k = 0; k < 8; ++k) { hh[k] = hist[tid * 8 + k]; tot += hh[k]; }
      int total; const int ex = block_excl_scan(tot, misc, &total);
      int above = total - ex - tot;
#pragma unroll
      for (int k = 7; k >= 0; --k) { const int c = hh[k]; if (above < need && above + c >= need) { misc[16] = tid * 8 + k; misc[17] = need - above; misc[18] = c; } above += c; }
      __syncthreads();
      const int digit = misc[16], nneed = misc[17], cnt = misc[18];
      prefix = (prefix << 12) | (unsigned long long)digit; need = nneed;
      __syncthreads();
      if (cnt == need) break;
      shift -= 12;
    }
    int mycnt = 0;
#pragma unroll
    for (int i = 0; i < 16; ++i) { const int idx = tid + 512 * i; if (idx < n && (cmp[i] >> shift) >= prefix) ++mycnt; }
    int total; int pos = block_excl_scan(mycnt, misc, &total);
#pragma unroll
    for (int i = 0; i < 16; ++i) { const int idx = tid + 512 * i; if (idx < n && (cmp[i] >> shift) >= prefix) { if (pos < 256) out[pos] = (unsigned short)idx; ++pos; } }
    __syncthreads();
  }
  __syncthreads();
}

constexpr int DKP = 72, DVP = 136;
constexpr int D_STAGE = (64 * DKP * 2 + 64 * DVP) * 2;
DI void mixerD_unit(const Params& p, int b, int head, int qb, char* lds) {
  const bf16* PO = (const bf16*)(p.ws + WS_PE); bf16* Y = (bf16*)(p.ws + WS_Y);
  const int tid = threadIdx.x, lane = tid & 63, wid = tid >> 6, r32 = lane & 31, h = lane >> 5;
  const int map = wid & 1, qsub = wid >> 1;
  const size_t rowb = (size_t)b * SEQ;
  const int qpos = 128 * qb + 32 * qsub + r32;
  bf16x8 qf[4]; load_q(qf, PO + (rowb + qpos) * NPO + O_DQ + (2 * head + map) * 64, h);
  f32x16 o[4]; zero_o<4>(o);
  float m = -1e30f, l = 0.f;
  const int nsteps = 2 * qb + 2;
  const bf16* K1g = PO + rowb * NPO + O_DK + (2 * head) * 64;
  const bf16* K2g = K1g + 64;
  const bf16* Vg = PO + rowb * NPO + O_DV + head * 128;
  u32x4 rk1, rk2, rv[2];
#define D_LOAD(j) do { const int row = tid >> 3, ch = tid & 7; const size_t off = (size_t)((j) * 64 + row) * NPO + ch * 8; rk1 = *(const u32x4*)(K1g + off); rk2 = *(const u32x4*)(K2g + off); \
    _Pragma("unroll") for (int i = 0; i < 2; ++i) { const int c = tid + 512 * i, vr = c >> 4, vc = c & 15; rv[i] = *(const u32x4*)(Vg + (size_t)((j) * 64 + vr) * NPO + vc * 8); } } while (0)
  __syncthreads();
  D_LOAD(0);
  for (int j = 0; j < nsteps; ++j) {
    char* st = lds + (j & 1) * D_STAGE;
    bf16* K1s = (bf16*)st; bf16* K2s = K1s + 64 * DKP; bf16* Vs = K2s + 64 * DKP;
    { const int row = tid >> 3, ch = tid & 7; *(u32x4*)(K1s + row * DKP + ch * 8) = rk1; *(u32x4*)(K2s + row * DKP + ch * 8) = rk2;
#pragma unroll
      for (int i = 0; i < 2; ++i) { const int c = tid + 512 * i, vr = c >> 4, vc = c & 15; *(u32x4*)(Vs + vr * DVP + vc * 8) = rv[i]; } }
    __syncthreads();
    if (j + 1 < nsteps) D_LOAD(j + 1);
    const bf16* Ks = map ? K2s : K1s;
#pragma unroll
    for (int sub = 0; sub < 2; ++sub) {
      const int k0 = j * 64 + sub * 32;
      if (k0 <= 128 * qb + 32 * qsub + 31) {
        unsigned vm = 0;
#pragma unroll
        for (int i = 0; i < 16; ++i) if (k0 + crow(i, h) <= qpos) vm |= (1u << i);
        attn_step32<4>(Ks + sub * 32 * DKP, DKP, Vs + sub * 32 * DVP, DVP, qf, o, m, l, vm, 0.125f * LOG2E, lane);
      }
    }
  }
#undef D_LOAD
  l += __shfl_xor(l, 32);
  const float linv = 1.f / l;
  __syncthreads();
  float* xch = (float*)lds + qsub * 4096;
  if (map == 1) {
#pragma unroll
    for (int d = 0; d < 4; ++d)
#pragma unroll
      for (int i = 0; i < 16; ++i) xch[(d * 16 + i) * 64 + lane] = o[d][i] * linv;
  }
  __syncthreads();
  if (map == 0) {
    const float lam = *(const float*)(p.ws + WS_LAM);
    float ssq = 0.f;
#pragma unroll
    for (int d = 0; d < 4; ++d)
#pragma unroll
      for (int i = 0; i < 16; ++i) { const float a = o[d][i] * linv - lam * xch[(d * 16 + i) * 64 + lane]; o[d][i] = a; ssq += a * a; }
    ssq += __shfl_xor(ssq, 32);
    const float lambda_init = 0.8f - 0.6f * expf(-0.3f);
    const float rn = rsqrtf(ssq * (1.f / 128.f) + EPS) * (1.f - lambda_init);
    const size_t tok = rowb + qpos;
    const bf16* gate = PO + tok * NPO + O_DG + head * 128;
    bf16* y = Y + tok * DM + 512 + head * 128;
    const float* sg = p.in[I_SUB_GAIN];
#pragma unroll
    for (int d = 0; d < 4; ++d)
#pragma unroll
      for (int g = 0; g < 4; ++g) {
        const int dd = 32 * d + 8 * g + 4 * h;
        const u32x2 gv = *(const u32x2*)(gate + dd); const f32x4 s4 = *(const f32x4*)(sg + dd);
        const float g0 = __uint_as_float(gv.x << 16), g1 = __uint_as_float(gv.x & 0xffff0000u), g2 = __uint_as_float(gv.y << 16), g3 = __uint_as_float(gv.y & 0xffff0000u);
        u32x2 w; w.x = cvtpk(o[d][4 * g] * rn * s4.x * g0, o[d][4 * g + 1] * rn * s4.y * g1); w.y = cvtpk(o[d][4 * g + 2] * rn * s4.z * g2, o[d][4 * g + 3] * rn * s4.w * g3);
        *(u32x2*)(y + dd) = w;
      }
  }
  __syncthreads();
}

__global__ void __launch_bounds__(NTHREADS) fwd_kernel(Params p) {
  extern __shared__ __attribute__((aligned(16))) char smem[];
  cg::grid_group grid = cg::this_grid();
  char* lds = smem;
  const int tid = threadIdx.x, lane = tid & 63, wid = tid >> 6;
  const int gw = blockIdx.x * 8 + wid, ngw = gridDim.x * 8;
  bf16* Ks = (bf16*)(lds + wid * WAVE_LDS); bf16* Vs = Ks + 32 * WP;

  phase_prologue(p, lds);
  grid.sync();
  phase_inproj(p, 0, lds);
  grid.sync();
#if EN_A
  for (int it = blockIdx.x; it < 2 * 2048; it += gridDim.x) selectA_item(p, it, lds);
  grid.sync();
  for (int it = gw; it < NTOK; it += ngw) mixerA_item(p, it, Ks, Vs, lane);
#else
  { unsigned* y = (unsigned*)(p.ws + WS_Y); for (int i = blockIdx.x * NTHREADS + tid; i < NTOK * 256; i += gridDim.x * NTHREADS) { const int row = i >> 8, c = i & 255; y[row * 512 + c] = 0u; } }
#endif
#if EN_B
  for (int it = gw; it < 4096; it += ngw) mixerB_tile(p, it, Ks, Vs, lane);
#else
  { unsigned* y = (unsigned*)(p.ws + WS_Y); for (int i = blockIdx.x * NTHREADS + tid; i < NTOK * 256; i += gridDim.x * NTHREADS) { const int row = i >> 8, c = i & 255; y[row * 512 + 256 + c] = 0u; } }
#endif
  grid.sync();
  phase_outproj(p, 0, lds);
  grid.sync();
  phase_ple(p, 0, lds);
  grid.sync();
  phase_inproj(p, 1, lds);
  grid.sync();
#if EN_D
  { const int j = blockIdx.x; if (gridDim.x == 256) { const int bh = j >> 5, pr = j & 31; mixerD_unit(p, bh >> 2, bh & 3, pr, lds); mixerD_unit(p, bh >> 2, bh & 3, 63 - pr, lds); }
    else { for (int u = j; u < 512; u += gridDim.x) mixerD_unit(p, u >> 8, (u >> 6) & 3, u & 63, lds); } }
#else
  { unsigned* y = (unsigned*)(p.ws + WS_Y); for (int i = blockIdx.x * NTHREADS + tid; i < NTOK * 256; i += gridDim.x * NTHREADS) { const int row = i >> 8, c = i & 255; y[row * 512 + 256 + c] = 0u; } }
#endif
#if EN_C
  __syncthreads();
  for (int it = gw; it < 4096; it += ngw) mixerC_tile(p, it, Ks, Vs, lane);
#else
  { unsigned* y = (unsigned*)(p.ws + WS_Y); for (int i = blockIdx.x * NTHREADS + tid; i < NTOK * 256; i += gridDim.x * NTHREADS) { const int row = i >> 8, c = i & 255; y[row * 512 + c] = 0u; } }
#endif
  grid.sync();
  phase_outproj(p, 1, lds);
  grid.sync();
  phase_ple(p, 1, lds);
}

extern "C" void kernel_launch(void* const* d_in, const int* in_sizes, int n_in, void* d_out, int out_size, void* d_ws, size_t ws_size, hipStream_t stream) {
  static int grid_blocks = 0;
  if (!grid_blocks) {
    int dev = 0, cus = 0, per_cu = 0;
    hipGetDevice(&dev);
    hipDeviceGetAttribute(&cus, hipDeviceAttributeMultiprocessorCount, dev);
    hipFuncSetAttribute((const void*)fwd_kernel, hipFuncAttributeMaxDynamicSharedMemorySize, LDS_BYTES);
    hipOccupancyMaxActiveBlocksPerMultiprocessor(&per_cu, (const void*)fwd_kernel, NTHREADS, LDS_BYTES);
    if (per_cu < 1) per_cu = 1;
    grid_blocks = cus * per_cu;
    if (grid_blocks > 256) grid_blocks = 256;
  }
  Params p{};
  for (int i = 0; i < 25; ++i) p.in[i] = (const float*)d_in[i];
  p.out = (float*)d_out; p.ws = (unsigned char*)d_ws;
  for (int i = 0; i < 32; ++i) p.inv_freq[i] = (float)pow(10000.0, -(double)i / 32.0);
  void* args[] = {&p};
  hipError_t e = hipLaunchCooperativeKernel((const void*)fwd_kernel, dim3(grid_blocks), dim3(NTHREADS), args, LDS_BYTES, stream);
  if (e != hipSuccess) fprintf(stderr, "cooperative launch failed: %s (grid %d)\n", hipGetErrorString(e), grid_blocks);
}
```

```cpp
#include <hip/hip_runtime.h>
#include <hip/hip_cooperative_groups.h>
#include <cstdio>
#include <cmath>
namespace cg = cooperative_groups;

#ifndef REP_GEMM
#define REP_GEMM 1
#endif
#ifndef REP_SELA
#define REP_SELA 1
#endif
#ifndef REP_D
#define REP_D 1
#endif
#ifndef REP_C
#define REP_C 1
#endif
#ifndef REP_AATT
#define REP_AATT 1
#endif
#ifndef EN_A
#define EN_A 1
#endif
#ifndef EN_B
#define EN_B 1
#endif
#ifndef EN_C
#define EN_C 1
#endif
#ifndef EN_D
#define EN_D 1
#endif

typedef unsigned short bf16;
typedef short bf16x8 __attribute__((ext_vector_type(8)));
typedef short s16x4 __attribute__((ext_vector_type(4)));
typedef float f32x4 __attribute__((ext_vector_type(4)));
typedef float f32x16 __attribute__((ext_vector_type(16)));
typedef unsigned u32x4 __attribute__((ext_vector_type(4)));
typedef unsigned u32x2 __attribute__((ext_vector_type(2)));
typedef float f32x2_t __attribute__((ext_vector_type(2)));
typedef __bf16 bf16x2_t __attribute__((ext_vector_type(2)));
#define LAS __attribute__((address_space(3)))
#define DI __device__ __forceinline__

constexpr int SEQ = 8192, NTOK = 16384, DM = 1024;
constexpr int NPE = 3072, NPO = 4096;
constexpr float EPS = 1e-6f;
constexpr float LOG2E = 1.4426950408889634f;
constexpr int NTHREADS = 512;
constexpr int LDS_BYTES = 150 * 1024;

constexpr size_t MiB = 1u << 20;
constexpr size_t WS_PE = 0;
constexpr size_t WS_ACT = 128 * MiB;
constexpr size_t WS_Y = 160 * MiB;
constexpr size_t WS_WINE = 192 * MiB;
constexpr size_t WS_WOUTE = 198 * MiB;
constexpr size_t WS_WINO = 200 * MiB;
constexpr size_t WS_WOUTO = 208 * MiB;
constexpr size_t WS_WG0 = 210 * MiB;
constexpr size_t WS_WG1 = 212 * MiB;
constexpr size_t WS_WP0 = 214 * MiB;
constexpr size_t WS_WP1 = 215 * MiB;
constexpr size_t WS_ROPE = 216 * MiB;
constexpr size_t WS_SEL = 218 * MiB;
constexpr size_t WS_IW = 226 * MiB;
constexpr size_t WS_SS = 227 * MiB;
constexpr size_t WS_LAM = 228 * MiB;
constexpr size_t WS_IKS = 229 * MiB;

struct Params {
  const float* in[25];
  float* out;
  unsigned char* ws;
  float inv_freq[32];
};
enum { I_X = 0, I_P, I_NORM_GAIN, I_W_IN_EVEN, I_W_OUT_EVEN, I_A_Q_GAIN, I_A_K_GAIN, I_IDX_K_GAIN, I_B_Q_GAIN, I_B_K_GAIN, I_B_SINKS,
       I_W_IN_ODD, I_W_OUT_ODD, I_C_Q_GAIN, I_C_K_GAIN, I_D_Q_GAIN, I_D_K_GAIN, I_LQ1, I_LK1, I_LQ2, I_LK2, I_SUB_GAIN, I_PLE_NORM_GAIN,
       I_W_PLE_GATE, I_W_PLE_PROJ };

DI unsigned cvtpk(float lo, float hi) { f32x2_t v = {lo, hi}; bf16x2_t b = __builtin_convertvector(v, bf16x2_t); return __builtin_bit_cast(unsigned, b); }
DI float bf2f(bf16 b) { return __uint_as_float(((unsigned)b) << 16); }
DI float fexp2(float x) { return __builtin_amdgcn_exp2f(x); }
DI f32x16 mfma32(bf16x8 a, bf16x8 b, f32x16 c) { return __builtin_amdgcn_mfma_f32_32x32x16_bf16(a, b, c, 0, 0, 0); }
DI f32x4 mfma16(bf16x8 a, bf16x8 b, f32x4 c) { return __builtin_amdgcn_mfma_f32_16x16x32_bf16(a, b, c, 0, 0, 0); }
DI int crow(int i, int h) { return (i & 3) + 8 * (i >> 2) + 4 * h; }
DI s16x4 trread(const bf16* p) { return __builtin_bit_cast(s16x4, __builtin_amdgcn_ds_read_tr16_b64_v4i16((LAS s16x4*)p)); }
DI void lds_fence() { asm volatile("s_waitcnt lgkmcnt(0)" ::: "memory"); __builtin_amdgcn_wave_barrier(); }

DI int map_even(int n) { return n < 1216 ? n : (n < 1224 ? 3008 + (n - 1216) : n - 8); }
DI void transpose_tile(const float* W, int K, int N, bf16* WT, int mapmode, int tile, float* scr) {
  const int tid = threadIdx.x;
  const int ntn = (N + 63) >> 6, kt = tile / ntn, nt = tile % ntn, k0 = kt * 64, n0 = nt * 64;
#pragma unroll
  for (int i = 0; i < 8; ++i) {
    const int kk = (tid >> 6) + 8 * i, nn = tid & 63, n = n0 + nn;
    scr[kk * 65 + nn] = (n < N) ? W[(size_t)(k0 + kk) * N + n] : 0.f;
  }
  __syncthreads();
  {
    const int nn = tid >> 3, kc = tid & 7, n = n0 + nn;
    if (n < N) {
      const int dst = mapmode ? map_even(n) : n;
      const float* s = scr + (kc * 8) * 65 + nn;
      u32x4 o; o.x = cvtpk(s[0], s[65]); o.y = cvtpk(s[2 * 65], s[3 * 65]); o.z = cvtpk(s[4 * 65], s[5 * 65]); o.w = cvtpk(s[6 * 65], s[7 * 65]);
      *(u32x4*)(WT + (size_t)dst * K + k0 + kc * 8) = o;
    }
  }
  __syncthreads();
}

DI float wave_sum(float v) {
#pragma unroll
  for (int o = 1; o < 64; o <<= 1) v += __shfl_xor(v, o);
  return v;
}

DI void phase_prologue(const Params& p, char* lds) {
  const int tid = threadIdx.x, lane = tid & 63, wid = tid >> 6;
  const int nb = gridDim.x, bid = blockIdx.x;
  unsigned char* ws = p.ws;
  float* scr = (float*)lds;
  const int T0 = 16 * 48, T1 = 256, T2 = 16 * 64, T3 = 256, T4 = 256, T5 = 256, T6 = 64, T7 = 64;
  const int NT = T0 + T1 + T2 + T3 + T4 + T5 + T6 + T7;
  for (int it = bid; it < NT; it += nb) {
    int r = it;
    if (r < T0) { transpose_tile(p.in[I_W_IN_EVEN], 1024, 3016, (bf16*)(ws + WS_WINE), 1, r, scr); continue; } r -= T0;
    if (r < T1) { transpose_tile(p.in[I_W_OUT_EVEN], 1024, 1024, (bf16*)(ws + WS_WOUTE), 0, r, scr); continue; } r -= T1;
    if (r < T2) { transpose_tile(p.in[I_W_IN_ODD], 1024, 4096, (bf16*)(ws + WS_WINO), 0, r, scr); continue; } r -= T2;
    if (r < T3) { transpose_tile(p.in[I_W_OUT_ODD], 1024, 1024, (bf16*)(ws + WS_WOUTO), 0, r, scr); continue; } r -= T3;
    if (r < T4) { transpose_tile(p.in[I_W_PLE_GATE], 1024, 1024, (bf16*)(ws + WS_WG0), 0, r, scr); continue; } r -= T4;
    if (r < T5) { transpose_tile(p.in[I_W_PLE_GATE] + 1024 * 1024, 1024, 1024, (bf16*)(ws + WS_WG1), 0, r, scr); continue; } r -= T5;
    if (r < T6) { transpose_tile(p.in[I_W_PLE_PROJ], 256, 1024, (bf16*)(ws + WS_WP0), 0, r, scr); continue; } r -= T6;
    transpose_tile(p.in[I_W_PLE_PROJ] + 256 * 1024, 256, 1024, (bf16*)(ws + WS_WP1), 0, r, scr);
  }
  const int gt = bid * NTHREADS + tid, ngt = nb * NTHREADS;
  { unsigned* z = (unsigned*)((bf16*)(ws + WS_WINE) + (size_t)3016 * 1024); for (int i = gt; i < 56 * 512; i += ngt) z[i] = 0u; }
  { float* ss = (float*)(ws + WS_SS); for (int i = gt; i < 3 * NTOK; i += ngt) ss[i] = 0.f; }
  { float2* tab = (float2*)(ws + WS_ROPE);
    for (int i = gt; i < SEQ * 32; i += ngt) {
      const int pos = i >> 5, k = i & 31;
      const float ang = (float)pos * p.inv_freq[k];
      double rev = (double)ang * 0.15915494309189535; rev -= floor(rev);
      const float rf = (float)rev;
      tab[i] = make_float2(__builtin_amdgcn_cosf(rf), __builtin_amdgcn_sinf(rf));
    } }
  if (bid == 0 && wid == 0) {
    const float a = wave_sum(p.in[I_LQ1][lane] * p.in[I_LK1][lane]);
    const float b = wave_sum(p.in[I_LQ2][lane] * p.in[I_LK2][lane]);
    const float lambda_init = 0.8f - 0.6f * expf(-0.3f);
    if (lane == 0) *(float*)(ws + WS_LAM) = expf(a) - expf(b) + lambda_init;
  }
  { const float* x = p.in[I_X]; const float* g = p.in[I_NORM_GAIN]; bf16* H = (bf16*)(ws + WS_ACT);
    const int gw = bid * 8 + wid, ngw = nb * 8;
    for (int m = gw; m < NTOK; m += ngw) {
      const f32x4* xr = (const f32x4*)(x + (size_t)m * DM) + lane;
      f32x4 v[4]; float s = 0.f;
#pragma unroll
      for (int j = 0; j < 4; ++j) { v[j] = xr[64 * j]; s += v[j].x * v[j].x + v[j].y * v[j].y + v[j].z * v[j].z + v[j].w * v[j].w; }
      const float rstd = rsqrtf(wave_sum(s) * (1.f / DM) + EPS);
      u32x2* o = (u32x2*)(H + (size_t)m * DM) + lane;
#pragma unroll
      for (int j = 0; j < 4; ++j) { const f32x4 gg = *((const f32x4*)g + lane + 64 * j); u32x2 w; w.x = cvtpk(v[j].x * rstd * gg.x, v[j].y * rstd * gg.y); w.y = cvtpk(v[j].z * rstd * gg.z, v[j].w * rstd * gg.w); o[64 * j] = w; }
    } }
}

constexpr int GP = 72;
template <int AF32>
DI void gemm_acc(const void* Aptr, int lda, const bf16* Bt, int K, int m0, int n0, char* lds, f32x4 (&acc)[4][4]) {
  bf16* As = (bf16*)lds; bf16* Bs = As + 256 * GP;
  const int tid = threadIdx.x, lane = tid & 63, wid = tid >> 6, wm = wid & 3, wn = wid >> 2, r = lane & 15, q4 = lane >> 4;
  u32x4 ra[4], rb[2];
  const int nk = K >> 6;
#define GLOAD(k0) do { \
    _Pragma("unroll") for (int i = 0; i < 4; ++i) { const int c = tid + 512 * i, row = c >> 3, ch = c & 7; \
      if (AF32) { const float* s_ = (const float*)Aptr + (size_t)(m0 + row) * lda + (k0) + ch * 8; const f32x4 a_ = *(const f32x4*)s_, b_ = *(const f32x4*)(s_ + 4); \
        ra[i].x = cvtpk(a_.x, a_.y); ra[i].y = cvtpk(a_.z, a_.w); ra[i].z = cvtpk(b_.x, b_.y); ra[i].w = cvtpk(b_.z, b_.w); } \
      else ra[i] = *(const u32x4*)((const bf16*)Aptr + (size_t)(m0 + row) * lda + (k0) + ch * 8); } \
    _Pragma("unroll") for (int i = 0; i < 2; ++i) { const int c = tid + 512 * i, row = c >> 3, ch = c & 7; \
      rb[i] = *(const u32x4*)(Bt + (size_t)(n0 + row) * K + (k0) + ch * 8); } } while (0)
  GLOAD(0);
  for (int kt = 0; kt < nk; ++kt) {
    __syncthreads();
#pragma unroll
    for (int i = 0; i < 4; ++i) { const int c = tid + 512 * i, row = c >> 3, ch = c & 7; *(u32x4*)(As + row * GP + ch * 8) = ra[i]; }
#pragma unroll
    for (int i = 0; i < 2; ++i) { const int c = tid + 512 * i, row = c >> 3, ch = c & 7; *(u32x4*)(Bs + row * GP + ch * 8) = rb[i]; }
    __syncthreads();
    if (kt + 1 < nk) GLOAD((kt + 1) * 64);
#pragma unroll
    for (int ks = 0; ks < 2; ++ks) {
      bf16x8 af[4], bfr[4];
#pragma unroll
      for (int i = 0; i < 4; ++i) { af[i] = *(const bf16x8*)(As + (wm * 64 + i * 16 + r) * GP + ks * 32 + q4 * 8); bfr[i] = *(const bf16x8*)(Bs + (wn * 64 + i * 16 + r) * GP + ks * 32 + q4 * 8); }
#pragma unroll
      for (int mi = 0; mi < 4; ++mi)
#pragma unroll
        for (int ni = 0; ni < 4; ++ni) acc[mi][ni] = mfma16(bfr[ni], af[mi], acc[mi][ni]);
    }
  }
#undef GLOAD
}
DI void zero_acc(f32x4 (&acc)[4][4]) {
#pragma unroll
  for (int a = 0; a < 4; ++a)
#pragma unroll
    for (int b = 0; b < 4; ++b) acc[a][b] = (f32x4){0.f, 0.f, 0.f, 0.f};
}

enum { T_PLAIN = 0, T_NR = 1, T_ROPE = 2, T_SILU = 3, T_IW = 4 };
DI void slot_info(const Params& p, int layer, int slot, int& type, const float*& gain) {
  gain = nullptr;
  if (layer == 0) {
    if (slot < 8) { type = T_NR; gain = p.in[I_A_Q_GAIN]; }
    else if (slot == 8) { type = T_NR; gain = p.in[I_A_K_GAIN]; }
    else if (slot == 9) type = T_PLAIN;
    else if (slot < 18) type = T_ROPE;
    else if (slot == 18) { type = T_NR; gain = p.in[I_IDX_K_GAIN]; }
    else if (slot < 27) type = T_SILU;
    else if (slot < 35) { type = T_NR; gain = p.in[I_B_Q_GAIN]; }
    else if (slot < 37) { type = T_NR; gain = p.in[I_B_K_GAIN]; }
    else if (slot < 39) type = T_PLAIN;
    else if (slot < 47) type = T_SILU;
    else type = T_IW;
  } else {
    if (slot < 8) { type = T_NR; gain = p.in[I_C_Q_GAIN]; }
    else if (slot < 16) { type = T_NR; gain = p.in[I_C_K_GAIN]; }
    else if (slot < 24) type = T_PLAIN;
    else if (slot < 32) type = T_SILU;
    else if (slot < 40) { type = T_NR; gain = p.in[I_D_Q_GAIN]; }
    else if (slot < 48) { type = T_NR; gain = p.in[I_D_K_GAIN]; }
    else if (slot < 56) type = T_PLAIN;
    else type = T_SILU;
  }
}
constexpr int E_AQ = 0, E_AK = 512, E_AV = 576, E_IQ = 640, E_IK = 1152, E_AG = 1216, E_BQ = 1728, E_BK = 2240, E_BV = 2368, E_BG = 2496;
constexpr int O_CQ = 0, O_CK = 512, O_CV = 1024, O_CG = 1536, O_DQ = 2048, O_DK = 2560, O_DV = 3072, O_DG = 3584;

DI void phase_inproj(const Params& p, int layer, char* lds) {
  unsigned char* ws = p.ws;
  const int NP = layer == 0 ? NPE : NPO;
  const bf16* A = (const bf16*)(ws + (layer == 0 ? WS_ACT : WS_Y));
  const bf16* Bt = (const bf16*)(ws + (layer == 0 ? WS_WINE : WS_WINO));
  bf16* PE = (bf16*)(ws + WS_PE);
  const float2* rope = (const float2*)(ws + WS_ROPE);
  const float* ss1 = (const float*)(ws + WS_SS);
  float* IW = (float*)(ws + WS_IW);
  const int lane = threadIdx.x & 63, wid = threadIdx.x >> 6, wm = wid & 3, wn = wid >> 2, r = lane & 15, q4 = lane >> 4;
  const int nnt = NP / 128, ntiles = 64 * nnt;
  for (int tile = blockIdx.x; tile < ntiles; tile += gridDim.x) {
    const int nt = tile / 64, mt = tile % 64;
    const int m0 = mt * 256, n0 = nt * 128;
    f32x4 acc[4][4]; zero_acc(acc);
    gemm_acc<0>(A, DM, Bt, DM, m0, n0, lds, acc);
    const int mbase = m0 + wm * 64, nbase = n0 + wn * 64, slot = nbase >> 6;
    int type; const float* gain; slot_info(p, layer, slot, type, gain);
#pragma unroll
    for (int mi = 0; mi < 4; ++mi) {
      const int m = mbase + mi * 16 + r, pos = m & (SEQ - 1);
      float sc = 1.f;
      if (layer == 1) sc = rsqrtf(ss1[m] * (1.f / DM) + EPS);
      f32x4 v[4];
#pragma unroll
      for (int ni = 0; ni < 4; ++ni) v[ni] = acc[mi][ni] * sc;
      if (type == T_NR) {
        float s = 0.f;
#pragma unroll
        for (int ni = 0; ni < 4; ++ni) s += v[ni].x * v[ni].x + v[ni].y * v[ni].y + v[ni].z * v[ni].z + v[ni].w * v[ni].w;
        s += __shfl_xor(s, 16); s += __shfl_xor(s, 32);
        const float rn = rsqrtf(s * (1.f / 64.f) + EPS);
#pragma unroll
        for (int ni = 0; ni < 4; ++ni) { const f32x4 g = *(const f32x4*)(gain + ni * 16 + q4 * 4); v[ni] = v[ni] * rn * g; }
      }
      if (type == T_NR || type == T_ROPE) {
#pragma unroll
        for (int ni = 0; ni < 2; ++ni) {
          const f32x4* cs = (const f32x4*)(rope + (size_t)pos * 32 + ni * 16 + q4 * 4);
          const f32x4 c01 = cs[0], c23 = cs[1];
          const f32x4 x1 = v[ni], x2 = v[ni + 2];
          f32x4 o1, o2;
          o1.x = x1.x * c01.x - x2.x * c01.y; o2.x = x2.x * c01.x + x1.x * c01.y;
          o1.y = x1.y * c01.z - x2.y * c01.w; o2.y = x2.y * c01.z + x1.y * c01.w;
          o1.z = x1.z * c23.x - x2.z * c23.y; o2.z = x2.z * c23.x + x1.z * c23.y;
          o1.w = x1.w * c23.z - x2.w * c23.w; o2.w = x2.w * c23.z + x1.w * c23.w;
          v[ni] = o1; v[ni + 2] = o2;
        }
      }
      if (type == T_SILU) {
#pragma unroll
        for (int ni = 0; ni < 4; ++ni)
#pragma unroll
          for (int j = 0; j < 4; ++j) { const float t = v[ni][j]; v[ni][j] = t / (1.f + __expf(-t)); }
      }
      if (type == T_IW) {
        if (q4 < 2) *(f32x4*)(IW + (size_t)m * 8 + q4 * 4) = v[0];
      } else {
#pragma unroll
        for (int ni = 0; ni < 4; ++ni) { u32x2 w; w.x = cvtpk(v[ni].x, v[ni].y); w.y = cvtpk(v[ni].z, v[ni].w); *(u32x2*)(PE + (size_t)m * NP + nbase + ni * 16 + q4 * 4) = w;
          if (layer == 0 && slot == 18) { bf16* IKS = (bf16*)(ws + WS_IKS); const int key = m & (SEQ - 1);
            *(u32x2*)(IKS + ((((size_t)(m >> 13) * 256 + (key >> 5)) * 4 + ni) * 64 + (q4 >> 1) * 32 + (key & 31)) * 8 + (q4 & 1) * 4) = w; } }
      }
    }
  }
}

DI void phase_outproj(const Params& p, int layer, char* lds) {
  unsigned char* ws = p.ws;
  const bf16* A = (const bf16*)(ws + WS_Y);
  const bf16* Bt = (const bf16*)(ws + (layer == 0 ? WS_WOUTE : WS_WOUTO));
  const float* xin = layer == 0 ? p.in[I_X] : p.out;
  float* out = p.out;
  bf16* XG = (bf16*)(ws + WS_ACT);
  const float* pg = p.in[I_PLE_NORM_GAIN] + layer * DM;
  float* ss = (float*)(ws + WS_SS) + (layer == 0 ? 1 : 2) * NTOK;
  const int lane = threadIdx.x & 63, wid = threadIdx.x >> 6, wm = wid & 3, wn = wid >> 2, r = lane & 15, q4 = lane >> 4;
  const int ntiles = 64 * 8;
  for (int tile = blockIdx.x; tile < ntiles; tile += gridDim.x) {
    const int nt = tile / 64, mt = tile % 64, m0 = mt * 256, n0 = nt * 128;
    f32x4 acc[4][4]; zero_acc(acc);
    gemm_acc<0>(A, DM, Bt, DM, m0, n0, lds, acc);
    const int mbase = m0 + wm * 64, nbase = n0 + wn * 64;
#pragma unroll
    for (int mi = 0; mi < 4; ++mi) {
      const int m = mbase + mi * 16 + r; float rs = 0.f;
#pragma unroll
      for (int ni = 0; ni < 4; ++ni) {
        const int n = nbase + ni * 16 + q4 * 4; const size_t off = (size_t)m * DM + n;
        const f32x4 xn = *(const f32x4*)(xin + off) + acc[mi][ni];
        *(f32x4*)(out + off) = xn;
        rs += xn.x * xn.x + xn.y * xn.y + xn.z * xn.z + xn.w * xn.w;
        const f32x4 g = *(const f32x4*)(pg + n);
        u32x2 w; w.x = cvtpk(xn.x * g.x, xn.y * g.y); w.y = cvtpk(xn.z * g.z, xn.w * g.w); *(u32x2*)(XG + off) = w;
      }
      rs += __shfl_xor(rs, 16); rs += __shfl_xor(rs, 32);
      if (q4 == 0) atomicAdd(ss + m, rs);
    }
  }
}

DI void phase_ple(const Params& p, int layer, char* lds) {
  unsigned char* ws = p.ws;
  const float* Pin = p.in[I_P] + (size_t)layer * NTOK * 256;
  const bf16* Wp = (const bf16*)(ws + (layer == 0 ? WS_WP0 : WS_WP1));
  const bf16* Wg = (const bf16*)(ws + (layer == 0 ? WS_WG0 : WS_WG1));
  const bf16* XG = (const bf16*)(ws + WS_ACT);
  float* out = p.out;
  const float* ssx = (const float*)(ws + WS_SS) + (layer == 0 ? 1 : 2) * NTOK;
  float* ss1 = (float*)(ws + WS_SS);
  bf16* H = (bf16*)(ws + WS_Y);
  float* PT = (float*)(ws + WS_PE);
  const float* ng1 = p.in[I_NORM_GAIN] + DM;
  const int lane = threadIdx.x & 63, wid = threadIdx.x >> 6, wm = wid & 3, wn = wid >> 2, r = lane & 15, q4 = lane >> 4;
  const int ntiles = 64 * 8;
  for (int tile = blockIdx.x; tile < ntiles; tile += gridDim.x) {
    const int nt = tile / 64, mt = tile % 64, m0 = mt * 256, n0 = nt * 128;
    const int mbase = m0 + wm * 64, nbase = n0 + wn * 64;
    f32x4 acc[4][4]; zero_acc(acc);
    gemm_acc<1>(Pin, 256, Wp, 256, m0, n0, lds, acc);
#pragma unroll
    for (int mi = 0; mi < 4; ++mi)
#pragma unroll
      for (int ni = 0; ni < 4; ++ni) *(f32x4*)(PT + (size_t)(mbase + mi * 16 + r) * DM + nbase + ni * 16 + q4 * 4) = acc[mi][ni];
    zero_acc(acc);
    gemm_acc<0>(XG, DM, Wg, DM, m0, n0, lds, acc);
#pragma unroll
    for (int mi = 0; mi < 4; ++mi) {
      const int m = mbase + mi * 16 + r; float rs = 0.f;
      const float rstd = rsqrtf(ssx[m] * (1.f / DM) + EPS);
#pragma unroll
      for (int ni = 0; ni < 4; ++ni) {
        const int n = nbase + ni * 16 + q4 * 4; const size_t off = (size_t)m * DM + n;
        f32x4 g;
#pragma unroll
        for (int j = 0; j < 4; ++j) g[j] = 1.f / (1.f + __expf(-rstd * acc[mi][ni][j]));
        const f32x4 xn = *(const f32x4*)(out + off) + *(const f32x4*)(PT + off) * g;
        *(f32x4*)(out + off) = xn;
        if (layer == 0) {
          rs += xn.x * xn.x + xn.y * xn.y + xn.z * xn.z + xn.w * xn.w;
          const f32x4 gg = *(const f32x4*)(ng1 + n);
          u32x2 w; w.x = cvtpk(xn.x * gg.x, xn.y * gg.y); w.y = cvtpk(xn.z * gg.z, xn.w * gg.w); *(u32x2*)(H + off) = w;
        }
      }
      if (layer == 0) { rs += __shfl_xor(rs, 16); rs += __shfl_xor(rs, 32); if (q4 == 0) atomicAdd(ss1 + m, rs); }
    }
  }
}

template <int DVB>
DI void attn_step32(const bf16* Kt, int KP, const bf16* Vt, int VP, const bf16x8 (&qf)[4], f32x16 (&o)[DVB], float& m, float& l, unsigned vmask, float c2, int lane) {
  const int r32 = lane & 31, h = lane >> 5;
  f32x16 s;
#pragma unroll
  for (int i = 0; i < 16; ++i) s[i] = 0.f;
#pragma unroll
  for (int t = 0; t < 4; ++t) { const bf16x8 kf = *(const bf16x8*)(Kt + r32 * KP + t * 16 + h * 8); s = mfma32(kf, qf[t], s); }
  float mx = -INFINITY;
#pragma unroll
  for (int i = 0; i < 16; ++i) { const float v = ((vmask >> i) & 1u) ? s[i] * c2 : -INFINITY; s[i] = v; mx = fmaxf(mx, v); }
  mx = fmaxf(mx, __shfl_xor(mx, 32));
  const float mn = fmaxf(m, mx);
  if (__any(mn > m)) {
    const float alpha = fexp2(m - mn); l *= alpha;
#pragma unroll
    for (int d = 0; d < DVB; ++d)
#pragma unroll
      for (int i = 0; i < 16; ++i) o[d][i] *= alpha;
    m = mn;
  }
  float ps = 0.f;
#pragma unroll
  for (int i = 0; i < 16; ++i) { const float pv = fexp2(s[i] - m); s[i] = pv; ps += pv; }
  l += ps;
  bf16x8 pf[2];
  { u32x4 a, b; a.x = cvtpk(s[0], s[1]); a.y = cvtpk(s[2], s[3]); a.z = cvtpk(s[4], s[5]); a.w = cvtpk(s[6], s[7]);
    b.x = cvtpk(s[8], s[9]); b.y = cvtpk(s[10], s[11]); b.z = cvtpk(s[12], s[13]); b.w = cvtpk(s[14], s[15]);
    pf[0] = __builtin_bit_cast(bf16x8, a); pf[1] = __builtin_bit_cast(bf16x8, b); }
  const int i16 = lane & 15, q = i16 >> 2, pp = i16 & 3, blk = (lane >> 4) & 1;
#pragma unroll
  for (int d = 0; d < DVB; ++d)
#pragma unroll
    for (int sk = 0; sk < 2; ++sk) {
      const s16x4 lo = trread(Vt + (16 * sk + 4 * h + q) * VP + 32 * d + 16 * blk + 4 * pp);
      const s16x4 hi = trread(Vt + (16 * sk + 8 + 4 * h + q) * VP + 32 * d + 16 * blk + 4 * pp);
      const bf16x8 vf = __builtin_shufflevector(lo, hi, 0, 1, 2, 3, 4, 5, 6, 7);
      o[d] = mfma32(vf, pf[sk], o[d]);
    }
}

constexpr int WP = 72;
constexpr int WAVE_LDS = 2 * 32 * WP * 2;

struct KVRegs { u32x4 k[4], v[4]; };
DI void kv_store(const KVRegs& R, bf16* Ks, bf16* Vs, int lane) {
#pragma unroll
  for (int i = 0; i < 4; ++i) { const int row = (lane >> 3) + 8 * i, ch = lane & 7; *(u32x4*)(Ks + row * WP + ch * 8) = R.k[i]; *(u32x4*)(Vs + row * WP + ch * 8) = R.v[i]; }
}

DI void band_load(KVRegs& R, const bf16* Kg, const bf16* Vg, int NP, int kstart, int dil, int roff, int lane) {
#pragma unroll
  for (int i = 0; i < 4; ++i) {
    const int row = (lane >> 3) + 8 * i, ch = lane & 7; int k = kstart + row; if (k < 0) k = 0;
    const size_t off = (size_t)(dil * k + roff) * NP + ch * 8;
    R.k[i] = *(const u32x4*)(Kg + off); R.v[i] = *(const u32x4*)(Vg + off);
  }
}
template <int DVB>
DI void band_run(const bf16* Kg, const bf16* Vg, int NP, int kbase, int nsteps, int dil, int roff, int qidx, int win,
                 const bf16x8 (&qf)[4], f32x16 (&o)[DVB], float& m, float& l, float c2, bf16* Ks, bf16* Vs, int lane) {
  const int h = lane >> 5;
  KVRegs R; band_load(R, Kg, Vg, NP, kbase, dil, roff, lane);
  for (int j = 0; j < nsteps; ++j) {
    lds_fence();
    kv_store(R, Ks, Vs, lane);
    lds_fence();
    if (j + 1 < nsteps) band_load(R, Kg, Vg, NP, kbase + 32 * (j + 1), dil, roff, lane);
    unsigned vm = 0;
#pragma unroll
    for (int i = 0; i < 16; ++i) { const int k = kbase + 32 * j + crow(i, h); const int dlt = qidx - k; if (k >= 0 && dlt >= 0 && dlt <= win) vm |= (1u << i); }
    attn_step32<DVB>(Ks, WP, Vs, WP, qf, o, m, l, vm, c2, lane);
  }
}

DI void write_o64(const f32x16 (&o)[2], float linv, const bf16* gate_row, bf16* y_row, int h) {
#pragma unroll
  for (int d = 0; d < 2; ++d)
#pragma unroll
    for (int g = 0; g < 4; ++g) {
      const int dd = 32 * d + 8 * g + 4 * h;
      const u32x2 gv = *(const u32x2*)(gate_row + dd);
      const float g0 = __uint_as_float(gv.x << 16), g1 = __uint_as_float(gv.x & 0xffff0000u), g2 = __uint_as_float(gv.y << 16), g3 = __uint_as_float(gv.y & 0xffff0000u);
      u32x2 w; w.x = cvtpk(o[d][4 * g] * linv * g0, o[d][4 * g + 1] * linv * g1); w.y = cvtpk(o[d][4 * g + 2] * linv * g2, o[d][4 * g + 3] * linv * g3);
      *(u32x2*)(y_row + dd) = w;
    }
}

DI void load_q(bf16x8 (&qf)[4], const bf16* qrow, int h) {
#pragma unroll
  for (int t = 0; t < 4; ++t) qf[t] = *(const bf16x8*)(qrow + t * 16 + h * 8);
}
template <int DVB> DI void zero_o(f32x16 (&o)[DVB]) {
#pragma unroll
  for (int d = 0; d < DVB; ++d)
#pragma unroll
    for (int i = 0; i < 16; ++i) o[d][i] = 0.f;
}

DI void mixerB_tile(const Params& p, int item, bf16* Ks, bf16* Vs, int lane) {
  const bf16* PE = (const bf16*)(p.ws + WS_PE); bf16* Y = (bf16*)(p.ws + WS_Y);
  const int qblk = item & 255, head = (item >> 8) & 7, b = item >> 11;
  const int r32 = lane & 31, h = lane >> 5, q0 = qblk * 32, kvh = head >> 2;
  const size_t rowb = (size_t)b * SEQ;
  bf16x8 qf[4]; load_q(qf, PE + (rowb + q0 + r32) * NPE + E_BQ + head * 64, h);
  f32x16 o[2]; zero_o<2>(o);
  const float sink2 = p.in[I_B_SINKS][head] * LOG2E;
  float m = sink2, l = (h == 0) ? 1.f : 0.f;
  band_run<2>(PE + rowb * NPE + E_BK + kvh * 64, PE + rowb * NPE + E_BV + kvh * 64, NPE, q0 - 128, 5, 1, 0, q0 + r32, 127, qf, o, m, l, 0.125f * LOG2E, Ks, Vs, lane);
  l += __shfl_xor(l, 32);
  const size_t tok = rowb + q0 + r32;
  write_o64(o, 1.f / l, PE + tok * NPE + E_BG + head * 64, Y + tok * DM + 512 + head * 64, h);
}

DI void mixerC_tile(const Params& p, int item, bf16* Ks, bf16* Vs, int lane) {
  const bf16* PO = (const bf16*)(p.ws + WS_PE); bf16* Y = (bf16*)(p.ws + WS_Y);
  const int qt = item & 15, r16 = (item >> 4) & 15, head = (item >> 8) & 7, b = item >> 11;
  const int r32 = lane & 31, h = lane >> 5, qi0 = qt * 32;
  const size_t rowb = (size_t)b * SEQ;
  const int t = 16 * (qi0 + r32) + r16;
  bf16x8 qf[4]; load_q(qf, PO + (rowb + t) * NPO + O_CQ + head * 64, h);
  f32x16 o[2]; zero_o<2>(o);
  float m = -1e30f, l = 0.f;
  const bf16* Kg = PO + rowb * NPO + O_CK + head * 64; const bf16* Vg = PO + rowb * NPO + O_CV + head * 64;
  const float c2 = 0.125f * LOG2E;
  band_run<2>(Kg, Vg, NPO, qi0 - 128, 5, 16, r16, qi0 + r32, 128, qf, o, m, l, c2, Ks, Vs, lane);
  band_run<2>(Kg, Vg, NPO, 4 * qi0 + (r16 >> 2) - 128, 8, 4, r16 & 3, 4 * (qi0 + r32) + (r16 >> 2), 128, qf, o, m, l, c2, Ks, Vs, lane);
  band_run<2>(Kg, Vg, NPO, 16 * qi0 + r16 - 128, 20, 1, 0, t, 128, qf, o, m, l, c2, Ks, Vs, lane);
  l += __shfl_xor(l, 32);
  const size_t tok = rowb + t;
  write_o64(o, 1.f / l, PO + tok * NPO + O_CG + head * 64, Y + tok * DM + head * 64, h);
}

DI void mixerA_item(const Params& p, int item, bf16* Ks, bf16* Vs, int lane) {
  const bf16* PE = (const bf16*)(p.ws + WS_PE); bf16* Y = (bf16*)(p.ws + WS_Y);
  const unsigned short* SEL = (const unsigned short*)(p.ws + WS_SEL) + (size_t)item * 256;
  const int t = item & (SEQ - 1), b = item >> 13;
  const int r32 = lane & 31, h = lane >> 5, head = r32 & 7;
  const size_t rowb = (size_t)b * SEQ;
  const int count = (t + 1 < 256) ? t + 1 : 256, nsteps = (count + 31) >> 5;
  bf16x8 qf[4]; load_q(qf, PE + (size_t)item * NPE + E_AQ + head * 64, h);
  f32x16 o[2]; zero_o<2>(o);
  float m = -1e30f, l = 0.f;
  const bf16* Kg = PE + rowb * NPE + E_AK; const bf16* Vg = PE + rowb * NPE + E_AV;
  KVRegs R;
#define A_LOAD(j) do { _Pragma("unroll") for (int i = 0; i < 4; ++i) { const int row = (lane >> 3) + 8 * i, ch = lane & 7, e = 32 * (j) + row; \
      const int tokk = (e < count) ? (int)SEL[e] : 0; const size_t off = (size_t)tokk * NPE + ch * 8; R.k[i] = *(const u32x4*)(Kg + off); R.v[i] = *(const u32x4*)(Vg + off); } } while (0)
  A_LOAD(0);
  for (int j = 0; j < nsteps; ++j) {
    lds_fence();
    kv_store(R, Ks, Vs, lane);
    lds_fence();
    if (j + 1 < nsteps) A_LOAD(j + 1);
    unsigned vm = 0;
#pragma unroll
    for (int i = 0; i < 16; ++i) if (32 * j + crow(i, h) < count) vm |= (1u << i);
    attn_step32<2>(Ks, WP, Vs, WP, qf, o, m, l, vm, 0.125f * LOG2E, lane);
  }
#undef A_LOAD
  l += __shfl_xor(l, 32);
  if (r32 < 8) write_o64(o, 1.f / l, PE + (size_t)item * NPE + E_AG + head * 64, Y + (size_t)item * DM + head * 64, h);
}

DI unsigned f2ord(float f) { f += 0.f; const unsigned u = __float_as_uint(f); return (u & 0x80000000u) ? ~u : (u | 0x80000000u); }
DI int block_excl_scan(int v, int* tmp, int* tot) {
  const int lane = threadIdx.x & 63, wid = threadIdx.x >> 6;
  int inc = v;
#pragma unroll
  for (int o = 1; o < 64; o <<= 1) { const int u = __shfl_up(inc, o); if (lane >= o) inc += u; }
  __syncthreads();
  if (lane == 63) tmp[wid] = inc;
  __syncthreads();
  int base = 0, total = 0;
#pragma unroll
  for (int w = 0; w < 8; ++w) { const int x = tmp[w]; if (w < wid) base += x; total += x; }
  *tot = total;
  return base + inc - v;
}

DI float dpp_sum8(float v) {
  v += __builtin_bit_cast(float, __builtin_amdgcn_mov_dpp(__builtin_bit_cast(int, v), 0xB1, 0xF, 0xF, true));
  v += __builtin_bit_cast(float, __builtin_amdgcn_mov_dpp(__builtin_bit_cast(int, v), 0x4E, 0xF, 0xF, true));
  v += __builtin_bit_cast(float, __builtin_amdgcn_mov_dpp(__builtin_bit_cast(int, v), 0x141, 0xF, 0xF, true));
  return v;
}
DI void hist_find(const int* hist, int* misc, int need, int& digit, int& nneed, int& cnt) {
  const int tid = threadIdx.x;
  typedef int i32x4 __attribute__((ext_vector_type(4)));
  const i32x4 h0 = *(const i32x4*)(hist + tid * 8), h1 = *(const i32x4*)(hist + tid * 8 + 4);
  int hh[8] = {h0.x, h0.y, h0.z, h0.w, h1.x, h1.y, h1.z, h1.w}; int tot = 0;
#pragma unroll
  for (int k = 0; k < 8; ++k) tot += hh[k];
  int total; const int ex = block_excl_scan(tot, misc, &total);
  int above = total - ex - tot;
#pragma unroll
  for (int k = 7; k >= 0; --k) { const int c = hh[k]; if (above < need && above + c >= need) { misc[16] = tid * 8 + k; misc[17] = need - above; misc[18] = c; } above += c; }
  __syncthreads();
  digit = misc[16]; nneed = misc[17]; cnt = misc[18];
  __syncthreads();
}
DI unsigned long long mkcmp(float v, int idx) { return ((unsigned long long)f2ord(v) << 16) | ((unsigned long long)(8191 - idx) << 3); }
DI float ord2f(unsigned k) { return __uint_as_float((k & 0x80000000u) ? (k ^ 0x80000000u) : ~k); }
DI float half_sum(float v) { auto rr = __builtin_amdgcn_permlane32_swap(__float_as_uint(v), __float_as_uint(v), false, false); return __uint_as_float(rr[0]) + __uint_as_float(rr[1]); }

constexpr int CL_CAP = 512;
DI void selectA_item(const Params& p, int item, char* lds) {
  const bf16* PE = (const bf16*)(p.ws + WS_PE);
  const float* IW = (const float*)(p.ws + WS_IW);
  unsigned short* SEL = (unsigned short*)(p.ws + WS_SEL);
  float* sc = (float*)lds;
  int* hist = (int*)(lds + 4 * 8192 * 4);
  int* misc = hist + 4096;
  unsigned* mm = (unsigned*)(misc + 24);
  unsigned long long* clist = (unsigned long long*)(misc + 64);
  const int tid = threadIdx.x, lane = tid & 63, wid = tid >> 6, r32 = lane & 31, h = lane >> 5;
  const int b = item >> 11, t0 = (item & 2047) * 4;
  const size_t rowb = (size_t)b * SEQ;
  const int nk = t0 + 4, ntile = (nk + 31) >> 5;
  if (tid < 4) { mm[tid * 2] = 0xFFFFFFFFu; mm[tid * 2 + 1] = 0u; }
  __syncthreads();
  bf16x8 qf[4]; load_q(qf, PE + (rowb + t0 + (r32 >> 3)) * NPE + E_IQ + (r32 & 7) * 64, h);
  float wq[16];
#pragma unroll
  for (int i = 0; i < 16; ++i) wq[i] = IW[(rowb + t0 + (i >> 2)) * 8 + (i & 3) + 4 * h] * 0.04419417382415922f;
  const bf16* Kt = (const bf16*)(p.ws + WS_IKS) + (size_t)b * 256 * 2048 + lane * 8;
  {
    bf16x8 kf[4], kn[4];
#pragma unroll
    for (int t = 0; t < 4; ++t) { kf[t] = (bf16x8){0, 0, 0, 0, 0, 0, 0, 0}; kn[t] = kf[t]; }
    if (wid < ntile) {
#pragma unroll
      for (int t = 0; t < 4; ++t) kf[t] = *(const bf16x8*)(Kt + (size_t)wid * 2048 + t * 512);
    }
    float lo0 = INFINITY, hi0 = -INFINITY, lo1 = INFINITY, hi1 = -INFINITY;
    for (int kt = wid; kt < ntile; kt += 8) {
      if (kt + 8 < ntile) {
#pragma unroll
        for (int t = 0; t < 4; ++t) kn[t] = *(const bf16x8*)(Kt + (size_t)(kt + 8) * 2048 + t * 512);
      }
      f32x16 s;
#pragma unroll
      for (int i = 0; i < 16; ++i) s[i] = 0.f;
#pragma unroll
      for (int t = 0; t < 4; ++t) s = mfma32(qf[t], kf[t], s);
      float v[4];
#pragma unroll
      for (int q = 0; q < 4; ++q) {
        float a = wq[4 * q] * fmaxf(s[4 * q], 0.f);
#pragma unroll
        for (int jj = 1; jj < 4; ++jj) a += wq[4 * q + jj] * fmaxf(s[4 * q + jj], 0.f);
        v[q] = half_sum(a) + 0.f;
      }
      const float va = h ? v[2] : v[0], vb = h ? v[3] : v[1];
      const int key = kt * 32 + r32;
      sc[(2 * h) * 8192 + key] = va; sc[(2 * h + 1) * 8192 + key] = vb;
      lo0 = fminf(lo0, va); hi0 = fmaxf(hi0, va); lo1 = fminf(lo1, vb); hi1 = fmaxf(hi1, vb);
#pragma unroll
      for (int t = 0; t < 4; ++t) kf[t] = kn[t];
    }
    if (wid < ntile) {
#pragma unroll
      for (int o = 1; o < 32; o <<= 1) { lo0 = fminf(lo0, __shfl_xor(lo0, o)); hi0 = fmaxf(hi0, __shfl_xor(hi0, o)); lo1 = fminf(lo1, __shfl_xor(lo1, o)); hi1 = fmaxf(hi1, __shfl_xor(hi1, o)); }
      if (r32 == 0) { atomicMin(&mm[(2 * h) * 2], f2ord(lo0)); atomicMax(&mm[(2 * h) * 2 + 1], f2ord(hi0)); atomicMin(&mm[(2 * h + 1) * 2], f2ord(lo1)); atomicMax(&mm[(2 * h + 1) * 2 + 1], f2ord(hi1)); }
    }
  }
  __syncthreads();
  for (int q = 0; q < 4; ++q) {
    const int t = t0 + q, n = t + 1;
    unsigned short* out = SEL + (rowb + t) * 256;
    if (n <= 256) { if (tid < n) out[tid] = (unsigned short)tid; continue; }
    const float* scq = sc + q * 8192;
    const float lo = ord2f(mm[q * 2]), hi = ord2f(mm[q * 2 + 1]);
    const float scale = (hi > lo) ? 4095.f / (hi - lo) : 0.f;
    for (int i = tid; i < 4096; i += 512) hist[i] = 0;
    if (tid == 0) misc[20] = 0;
    __syncthreads();
    float val[16]; int bin[16];
#pragma unroll
    for (int i = 0; i < 16; ++i) { const int idx = tid + 512 * i; const float v = (idx < n) ? scq[idx] : lo; val[i] = v;
      int bb = (int)((v - lo) * scale); bb = bb < 0 ? 0 : (bb > 4095 ? 4095 : bb); bin[i] = bb; if (idx < n) atomicAdd(&hist[bb], 1); }
    __syncthreads();
    int bstar, need, cnt;
    hist_find(hist, misc, 256, bstar, need, cnt);
    unsigned long long T = 0ull;
    if (cnt != need) {
      if (cnt <= CL_CAP) {
#pragma unroll
        for (int i = 0; i < 16; ++i) { const int idx = tid + 512 * i; if (idx < n && bin[i] == bstar) { const int slot = atomicAdd(&misc[20], 1); clist[slot] = mkcmp(val[i], idx); } }
        __syncthreads();
        if (tid < cnt) { const unsigned long long c = clist[tid]; int rank = 0; for (int jx = 0; jx < cnt; ++jx) rank += (clist[jx] > c) ? 1 : 0;
          if (rank == need - 1) { misc[21] = (int)(unsigned)(c & 0xffffffffull); misc[22] = (int)(unsigned)(c >> 32); } }
        __syncthreads();
        T = ((unsigned long long)(unsigned)misc[22] << 32) | (unsigned long long)(unsigned)misc[21];
      } else {
        unsigned long long prefix = 0ull; int shift = 36;
        for (int pass = 0; pass < 4; ++pass) {
          for (int i = tid; i < 4096; i += 512) hist[i] = 0;
          __syncthreads();
#pragma unroll
          for (int i = 0; i < 16; ++i) { const int idx = tid + 512 * i; if (idx < n && bin[i] == bstar) { const unsigned long long c = mkcmp(val[i], idx); if (pass == 0 || (c >> (shift + 12)) == prefix) atomicAdd(&hist[(int)((c >> shift) & 4095ull)], 1); } }
          __syncthreads();
          int digit, nneed, c2;
          hist_find(hist, misc, need, digit, nneed, c2);
          prefix = (prefix << 12) | (unsigned long long)digit; need = nneed;
          if (c2 == need) break;
          shift -= 12;
        }
        T = prefix << shift;
      }
    }
    int mycnt = 0; unsigned selm = 0;
#pragma unroll
    for (int i = 0; i < 16; ++i) { const int idx = tid + 512 * i;
      bool sel = false;
      if (idx < n) { if (bin[i] > bstar) sel = true; else if (bin[i] == bstar) sel = (mkcmp(val[i], idx) >= T); }
      if (sel) { ++mycnt; selm |= (1u << i); } }
    int total; int pos = block_excl_scan(mycnt, misc, &total);
#pragma unroll
    for (int i = 0; i < 16; ++i) { if ((selm >> i) & 1u) { if (pos < 256) out[pos] = (unsigned short)(tid + 512 * i); ++pos; } }
    __syncthreads();
  }
  __syncthreads();
}

constexpr int DKP = 72, DVP = 136;
constexpr int D_STAGE = (64 * DKP * 2 + 64 * DVP) * 2;
DI void mixerD_unit(const Params& p, int b, int head, int qb, char* lds) {
  const bf16* PO = (const bf16*)(p.ws + WS_PE); bf16* Y = (bf16*)(p.ws + WS_Y);
  const int tid = threadIdx.x, lane = tid & 63, wid = tid >> 6, r32 = lane & 31, h = lane >> 5;
  const int map = wid & 1, qsub = wid >> 1;
  const size_t rowb = (size_t)b * SEQ;
  const int qpos = 128 * qb + 32 * qsub + r32;
  bf16x8 qf[4]; load_q(qf, PO + (rowb + qpos) * NPO + O_DQ + (2 * head + map) * 64, h);
  f32x16 o[4]; zero_o<4>(o);
  float m = -1e30f, l = 0.f;
  const int nsteps = 2 * qb + 2;
  const bf16* K1g = PO + rowb * NPO + O_DK + (2 * head) * 64;
  const bf16* K2g = K1g + 64;
  const bf16* Vg = PO + rowb * NPO + O_DV + head * 128;
  u32x4 rk1, rk2, rv[2];
#define D_LOAD(j) do { const int row = tid >> 3, ch = tid & 7; const size_t off = (size_t)((j) * 64 + row) * NPO + ch * 8; rk1 = *(const u32x4*)(K1g + off); rk2 = *(const u32x4*)(K2g + off); \
    _Pragma("unroll") for (int i = 0; i < 2; ++i) { const int c = tid + 512 * i, vr = c >> 4, vc = c & 15; rv[i] = *(const u32x4*)(Vg + (size_t)((j) * 64 + vr) * NPO + vc * 8); } } while (0)
  __syncthreads();
  D_LOAD(0);
  for (int j = 0; j < nsteps; ++j) {
    char* st = lds + (j & 1) * D_STAGE;
    bf16* K1s = (bf16*)st; bf16* K2s = K1s + 64 * DKP; bf16* Vs = K2s + 64 * DKP;
    { const int row = tid >> 3, ch = tid & 7; *(u32x4*)(K1s + row * DKP + ch * 8) = rk1; *(u32x4*)(K2s + row * DKP + ch * 8) = rk2;
#pragma unroll
      for (int i = 0; i < 2; ++i) { const int c = tid + 512 * i, vr = c >> 4, vc = c & 15; *(u32x4*)(Vs + vr * DVP + vc * 8) = rv[i]; } }
    __syncthreads();
    if (j + 1 < nsteps) D_LOAD(j + 1);
    const bf16* Ks = map ? K2s : K1s;
#pragma unroll
    for (int sub = 0; sub < 2; ++sub) {
      const int k0 = j * 64 + sub * 32;
      if (k0 <= 128 * qb + 32 * qsub + 31) {
        unsigned vm = 0;
#pragma unroll
        for (int i = 0; i < 16; ++i) if (k0 + crow(i, h) <= qpos) vm |= (1u << i);
        attn_step32<4>(Ks + sub * 32 * DKP, DKP, Vs + sub * 32 * DVP, DVP, qf, o, m, l, vm, 0.125f * LOG2E, lane);
      }
    }
  }
#undef D_LOAD
  l += __shfl_xor(l, 32);
  const float linv = 1.f / l;
  __syncthreads();
  float* xch = (float*)lds + qsub * 4096;
  if (map == 1) {
#pragma unroll
    for (int d = 0; d < 4; ++d)
#pragma unroll
      for (int i = 0; i < 16; ++i) xch[(d * 16 + i) * 64 + lane] = o[d][i] * linv;
  }
  __syncthreads();
  if (map == 0) {
    const float lam = *(const float*)(p.ws + WS_LAM);
    float ssq = 0.f;
#pragma unroll
    for (int d = 0; d < 4; ++d)
#pragma unroll
      for (int i = 0; i < 16; ++i) { const float a = o[d][i] * linv - lam * xch[(d * 16 + i) * 64 + lane]; o[d][i] = a; ssq += a * a; }
    ssq += __shfl_xor(ssq, 32);
    const float lambda_init = 0.8f - 0.6f * expf(-0.3f);
    const float rn = rsqrtf(ssq * (1.f / 128.f) + EPS) * (1.f - lambda_init);
    const size_t tok = rowb + qpos;
    const bf16* gate = PO + tok * NPO + O_DG + head * 128;
    bf16* y = Y + tok * DM + 512 + head * 128;
    const float* sg = p.in[I_SUB_GAIN];
#pragma unroll
    for (int d = 0; d < 4; ++d)
#pragma unroll
      for (int g = 0; g < 4; ++g) {
        const int dd = 32 * d + 8 * g + 4 * h;
        const u32x2 gv = *(const u32x2*)(gate + dd); const f32x4 s4 = *(const f32x4*)(sg + dd);
        const float g0 = __uint_as_float(gv.x << 16), g1 = __uint_as_float(gv.x & 0xffff0000u), g2 = __uint_as_float(gv.y << 16), g3 = __uint_as_float(gv.y & 0xffff0000u);
        u32x2 w; w.x = cvtpk(o[d][4 * g] * rn * s4.x * g0, o[d][4 * g + 1] * rn * s4.y * g1); w.y = cvtpk(o[d][4 * g + 2] * rn * s4.z * g2, o[d][4 * g + 3] * rn * s4.w * g3);
        *(u32x2*)(y + dd) = w;
      }
  }
  __syncthreads();
}

__global__ void __launch_bounds__(NTHREADS) fwd_kernel(Params p) {
  extern __shared__ __attribute__((aligned(16))) char smem[];
  cg::grid_group grid = cg::this_grid();
  char* lds = smem;
  const int tid = threadIdx.x, lane = tid & 63, wid = tid >> 6;
  const int gw = blockIdx.x * 8 + wid, ngw = gridDim.x * 8;
  bf16* Ks = (bf16*)(lds + wid * WAVE_LDS); bf16* Vs = Ks + 32 * WP;

  phase_prologue(p, lds);
  grid.sync();
  for (int rep = 0; rep < REP_GEMM; ++rep) phase_inproj(p, 0, lds);
  grid.sync();
#if EN_A
  for (int rep = 0; rep < REP_SELA; ++rep) for (int it = blockIdx.x; it < 2 * 2048; it += gridDim.x) selectA_item(p, it, lds);
  grid.sync();
  for (int rep = 0; rep < REP_AATT; ++rep) for (int it = gw; it < NTOK; it += ngw) mixerA_item(p, it, Ks, Vs, lane);
#else
  { unsigned* y = (unsigned*)(p.ws + WS_Y); for (int i = blockIdx.x * NTHREADS + tid; i < NTOK * 256; i += gridDim.x * NTHREADS) { const int row = i >> 8, c = i & 255; y[row * 512 + c] = 0u; } }
#endif
#if EN_B
  for (int it = gw; it < 4096; it += ngw) mixerB_tile(p, it, Ks, Vs, lane);
#else
  { unsigned* y = (unsigned*)(p.ws + WS_Y); for (int i = blockIdx.x * NTHREADS + tid; i < NTOK * 256; i += gridDim.x * NTHREADS) { const int row = i >> 8, c = i & 255; y[row * 512 + 256 + c] = 0u; } }
#endif
  grid.sync();
  phase_outproj(p, 0, lds);
  grid.sync();
  phase_ple(p, 0, lds);
  grid.sync();
  phase_inproj(p, 1, lds);
  grid.sync();
#if EN_D
  for (int rep = 0; rep < REP_D; ++rep) { const int j = blockIdx.x; if (gridDim.x == 256) { const int bh = j >> 5, pr = j & 31; mixerD_unit(p, bh >> 2, bh & 3, pr, lds); mixerD_unit(p, bh >> 2, bh & 3, 63 - pr, lds); }
    else { for (int u = j; u < 512; u += gridDim.x) mixerD_unit(p, u >> 8, (u >> 6) & 3, u & 63, lds); } }
#else
  { unsigned* y = (unsigned*)(p.ws + WS_Y); for (int i = blockIdx.x * NTHREADS + tid; i < NTOK * 256; i += gridDim.x * NTHREADS) { const int row = i >> 8, c = i & 255; y[row * 512 + 256 + c] = 0u; } }
#endif
#if EN_C
  __syncthreads();
  for (int rep = 0; rep < REP_C; ++rep) for (int it = gw; it < 4096; it += ngw) mixerC_tile(p, it, Ks, Vs, lane);
#else
  { unsigned* y = (unsigned*)(p.ws + WS_Y); for (int i = blockIdx.x * NTHREADS + tid; i < NTOK * 256; i += gridDim.x * NTHREADS) { const int row = i >> 8, c = i & 255; y[row * 512 + c] = 0u; } }
#endif
  grid.sync();
  phase_outproj(p, 1, lds);
  grid.sync();
  phase_ple(p, 1, lds);
}

extern "C" void kernel_launch(void* const* d_in, const int* in_sizes, int n_in, void* d_out, int out_size, void* d_ws, size_t ws_size, hipStream_t stream) {
  static int grid_blocks = 0;
  if (!grid_blocks) {
    int dev = 0, cus = 0, per_cu = 0;
    hipGetDevice(&dev);
    hipDeviceGetAttribute(&cus, hipDeviceAttributeMultiprocessorCount, dev);
    hipFuncSetAttribute((const void*)fwd_kernel, hipFuncAttributeMaxDynamicSharedMemorySize, LDS_BYTES);
    hipOccupancyMaxActiveBlocksPerMultiprocessor(&per_cu, (const void*)fwd_kernel, NTHREADS, LDS_BYTES);
    if (per_cu < 1) per_cu = 1;
    grid_blocks = cus * per_cu;
    if (grid_blocks > 256) grid_blocks = 256;
  }
  Params p{};
  for (int i = 0; i < 25; ++i) p.in[i] = (const float*)d_in[i];
  p.out = (float*)d_out; p.ws = (unsigned char*)d_ws;
  for (int i = 0; i < 32; ++i) p.inv_freq[i] = (float)pow(10000.0, -(double)i / 32.0);
  void* args[] = {&p};
  hipError_t e = hipLaunchCooperativeKernel((const void*)fwd_kernel, dim3(grid_blocks), dim3(NTHREADS), args, LDS_BYTES, stream);
  if (e != hipSuccess) fprintf(stderr, "cooperative launch failed: %s (grid %d)\n", hipGetErrorString(e), grid_blocks);
}
```

```cpp
#include <hip/hip_runtime.h>
#include <hip/hip_cooperative_groups.h>
#include <cstdio>
#include <cmath>
namespace cg = cooperative_groups;

#ifndef REP_GEMM
#define REP_GEMM 1
#endif
#ifndef REP_SELA
#define REP_SELA 1
#endif
#ifndef REP_D
#define REP_D 1
#endif
#ifndef REP_C
#define REP_C 1
#endif
#ifndef REP_AATT
#define REP_AATT 1
#endif
#ifndef EN_A
#define EN_A 1
#endif
#ifndef EN_B
#define EN_B 1
#endif
#ifndef EN_C
#define EN_C 1
#endif
#ifndef EN_D
#define EN_D 1
#endif

typedef unsigned short bf16;
typedef short bf16x8 __attribute__((ext_vector_type(8)));
typedef short s16x4 __attribute__((ext_vector_type(4)));
typedef float f32x4 __attribute__((ext_vector_type(4)));
typedef float f32x16 __attribute__((ext_vector_type(16)));
typedef unsigned u32x4 __attribute__((ext_vector_type(4)));
typedef unsigned u32x2 __attribute__((ext_vector_type(2)));
typedef float f32x2_t __attribute__((ext_vector_type(2)));
typedef __bf16 bf16x2_t __attribute__((ext_vector_type(2)));
#define LAS __attribute__((address_space(3)))
#define DI __device__ __forceinline__

constexpr int SEQ = 8192, NTOK = 16384, DM = 1024;
constexpr int NPE = 3072, NPO = 4096;
constexpr float EPS = 1e-6f;
constexpr float LOG2E = 1.4426950408889634f;
constexpr int NTHREADS = 512;
constexpr int LDS_BYTES = 150 * 1024;

constexpr size_t MiB = 1u << 20;
constexpr size_t WS_PE = 0;
constexpr size_t WS_ACT = 128 * MiB;
constexpr size_t WS_Y = 160 * MiB;
constexpr size_t WS_WINE = 192 * MiB;
constexpr size_t WS_WOUTE = 198 * MiB;
constexpr size_t WS_WINO = 200 * MiB;
constexpr size_t WS_WOUTO = 208 * MiB;
constexpr size_t WS_WG0 = 210 * MiB;
constexpr size_t WS_WG1 = 212 * MiB;
constexpr size_t WS_WP0 = 214 * MiB;
constexpr size_t WS_WP1 = 215 * MiB;
constexpr size_t WS_ROPE = 216 * MiB;
constexpr size_t WS_SEL = 218 * MiB;
constexpr size_t WS_IW = 226 * MiB;
constexpr size_t WS_SS = 227 * MiB;
constexpr size_t WS_LAM = 228 * MiB;
constexpr size_t WS_IKS = 229 * MiB;

struct Params {
  const float* in[25];
  float* out;
  unsigned char* ws;
  float inv_freq[32];
};
enum { I_X = 0, I_P, I_NORM_GAIN, I_W_IN_EVEN, I_W_OUT_EVEN, I_A_Q_GAIN, I_A_K_GAIN, I_IDX_K_GAIN, I_B_Q_GAIN, I_B_K_GAIN, I_B_SINKS,
       I_W_IN_ODD, I_W_OUT_ODD, I_C_Q_GAIN, I_C_K_GAIN, I_D_Q_GAIN, I_D_K_GAIN, I_LQ1, I_LK1, I_LQ2, I_LK2, I_SUB_GAIN, I_PLE_NORM_GAIN,
       I_W_PLE_GATE, I_W_PLE_PROJ };

DI unsigned cvtpk(float lo, float hi) { f32x2_t v = {lo, hi}; bf16x2_t b = __builtin_convertvector(v, bf16x2_t); return __builtin_bit_cast(unsigned, b); }
DI float bf2f(bf16 b) { return __uint_as_float(((unsigned)b) << 16); }
DI float fexp2(float x) { return __builtin_amdgcn_exp2f(x); }
DI f32x16 mfma32(bf16x8 a, bf16x8 b, f32x16 c) { return __builtin_amdgcn_mfma_f32_32x32x16_bf16(a, b, c, 0, 0, 0); }
DI f32x4 mfma16(bf16x8 a, bf16x8 b, f32x4 c) { return __builtin_amdgcn_mfma_f32_16x16x32_bf16(a, b, c, 0, 0, 0); }
DI int crow(int i, int h) { return (i & 3) + 8 * (i >> 2) + 4 * h; }
DI s16x4 trread(const bf16* p) { return __builtin_bit_cast(s16x4, __builtin_amdgcn_ds_read_tr16_b64_v4i16((LAS s16x4*)p)); }
DI void lds_fence() { asm volatile("s_waitcnt lgkmcnt(0)" ::: "memory"); __builtin_amdgcn_wave_barrier(); }

DI int map_even(int n) { return n < 1216 ? n : (n < 1224 ? 3008 + (n - 1216) : n - 8); }
DI void transpose_tile(const float* W, int K, int N, bf16* WT, int mapmode, int tile, float* scr) {
  const int tid = threadIdx.x;
  const int ntn = (N + 63) >> 6, kt = tile / ntn, nt = tile % ntn, k0 = kt * 64, n0 = nt * 64;
#pragma unroll
  for (int i = 0; i < 8; ++i) {
    const int kk = (tid >> 6) + 8 * i, nn = tid & 63, n = n0 + nn;
    scr[kk * 65 + nn] = (n < N) ? W[(size_t)(k0 + kk) * N + n] : 0.f;
  }
  __syncthreads();
  {
    const int nn = tid >> 3, kc = tid & 7, n = n0 + nn;
    if (n < N) {
      const int dst = mapmode ? map_even(n) : n;
      const float* s = scr + (kc * 8) * 65 + nn;
      u32x4 o; o.x = cvtpk(s[0], s[65]); o.y = cvtpk(s[2 * 65], s[3 * 65]); o.z = cvtpk(s[4 * 65], s[5 * 65]); o.w = cvtpk(s[6 * 65], s[7 * 65]);
      *(u32x4*)(WT + (size_t)dst * K + k0 + kc * 8) = o;
    }
  }
  __syncthreads();
}

DI float wave_sum(float v) {
#pragma unroll
  for (int o = 1; o < 64; o <<= 1) v += __shfl_xor(v, o);
  return v;
}

DI void phase_prologue(const Params& p, char* lds) {
  const int tid = threadIdx.x, lane = tid & 63, wid = tid >> 6;
  const int nb = gridDim.x, bid = blockIdx.x;
  unsigned char* ws = p.ws;
  float* scr = (float*)lds;
  const int T0 = 16 * 48, T1 = 256, T2 = 16 * 64, T3 = 256, T4 = 256, T5 = 256, T6 = 64, T7 = 64;
  const int NT = T0 + T1 + T2 + T3 + T4 + T5 + T6 + T7;
  for (int it = bid; it < NT; it += nb) {
    int r = it;
    if (r < T0) { transpose_tile(p.in[I_W_IN_EVEN], 1024, 3016, (bf16*)(ws + WS_WINE), 1, r, scr); continue; } r -= T0;
    if (r < T1) { transpose_tile(p.in[I_W_OUT_EVEN], 1024, 1024, (bf16*)(ws + WS_WOUTE), 0, r, scr); continue; } r -= T1;
    if (r < T2) { transpose_tile(p.in[I_W_IN_ODD], 1024, 4096, (bf16*)(ws + WS_WINO), 0, r, scr); continue; } r -= T2;
    if (r < T3) { transpose_tile(p.in[I_W_OUT_ODD], 1024, 1024, (bf16*)(ws + WS_WOUTO), 0, r, scr); continue; } r -= T3;
    if (r < T4) { transpose_tile(p.in[I_W_PLE_GATE], 1024, 1024, (bf16*)(ws + WS_WG0), 0, r, scr); continue; } r -= T4;
    if (r < T5) { transpose_tile(p.in[I_W_PLE_GATE] + 1024 * 1024, 1024, 1024, (bf16*)(ws + WS_WG1), 0, r, scr); continue; } r -= T5;
    if (r < T6) { transpose_tile(p.in[I_W_PLE_PROJ], 256, 1024, (bf16*)(ws + WS_WP0), 0, r, scr); continue; } r -= T6;
    transpose_tile(p.in[I_W_PLE_PROJ] + 256 * 1024, 256, 1024, (bf16*)(ws + WS_WP1), 0, r, scr);
  }
  const int gt = bid * NTHREADS + tid, ngt = nb * NTHREADS;
  { unsigned* z = (unsigned*)((bf16*)(ws + WS_WINE) + (size_t)3016 * 1024); for (int i = gt; i < 56 * 512; i += ngt) z[i] = 0u; }
  { float* ss = (float*)(ws + WS_SS); for (int i = gt; i < 3 * NTOK; i += ngt) ss[i] = 0.f; }
  { float2* tab = (float2*)(ws + WS_ROPE);
    for (int i = gt; i < SEQ * 32; i += ngt) {
      const int pos = i >> 5, k = i & 31;
      const float ang = (float)pos * p.inv_freq[k];
      double rev = (double)ang * 0.15915494309189535; rev -= floor(rev);
      const float rf = (float)rev;
      tab[i] = make_float2(__builtin_amdgcn_cosf(rf), __builtin_amdgcn_sinf(rf));
    } }
  if (bid == 0 && wid == 0) {
    const float a = wave_sum(p.in[I_LQ1][lane] * p.in[I_LK1][lane]);
    const float b = wave_sum(p.in[I_LQ2][lane] * p.in[I_LK2][lane]);
    const float lambda_init = 0.8f - 0.6f * expf(-0.3f);
    if (lane == 0) *(float*)(ws + WS_LAM) = expf(a) - expf(b) + lambda_init;
  }
  { const float* x = p.in[I_X]; const float* g = p.in[I_NORM_GAIN]; bf16* H = (bf16*)(ws + WS_ACT);
    const int gw = bid * 8 + wid, ngw = nb * 8;
    for (int m = gw; m < NTOK; m += ngw) {
      const f32x4* xr = (const f32x4*)(x + (size_t)m * DM) + lane;
      f32x4 v[4]; float s = 0.f;
#pragma unroll
      for (int j = 0; j < 4; ++j) { v[j] = xr[64 * j]; s += v[j].x * v[j].x + v[j].y * v[j].y + v[j].z * v[j].z + v[j].w * v[j].w; }
      const float rstd = rsqrtf(wave_sum(s) * (1.f / DM) + EPS);
      u32x2* o = (u32x2*)(H + (size_t)m * DM) + lane;
#pragma unroll
      for (int j = 0; j < 4; ++j) { const f32x4 gg = *((const f32x4*)g + lane + 64 * j); u32x2 w; w.x = cvtpk(v[j].x * rstd * gg.x, v[j].y * rstd * gg.y); w.y = cvtpk(v[j].z * rstd * gg.z, v[j].w * rstd * gg.w); o[64 * j] = w; }
    } }
}

constexpr int GP = 72;
constexpr int NH = 1;
constexpr int TN = 128 * NH;
constexpr int GBUF = (256 + TN) * GP * 2;
template <int AF32>
DI void gemm_acc(const void* Aptr, int lda, const bf16* Bt, int K, int m0, int n0, char* lds, f32x4 (&acc)[4][4 * NH]) {
  const int tid = threadIdx.x, lane = tid & 63, wid = tid >> 6, wm = wid & 3, wn = wid >> 2, r = lane & 15, q4 = lane >> 4;
  u32x4 ra[4], rb[2 * NH];
  const int nk = K >> 6;
#define GLOAD(k0) do { \
    _Pragma("unroll") for (int i = 0; i < 4; ++i) { const int c = tid + 512 * i, row = c >> 3, ch = c & 7; \
      if (AF32) { const float* s_ = (const float*)Aptr + (size_t)(m0 + row) * lda + (k0) + ch * 8; const f32x4 a_ = *(const f32x4*)s_, b_ = *(const f32x4*)(s_ + 4); \
        ra[i].x = cvtpk(a_.x, a_.y); ra[i].y = cvtpk(a_.z, a_.w); ra[i].z = cvtpk(b_.x, b_.y); ra[i].w = cvtpk(b_.z, b_.w); if (i & 1) asm volatile("" ::: "memory"); } \
      else ra[i] = *(const u32x4*)((const bf16*)Aptr + (size_t)(m0 + row) * lda + (k0) + ch * 8); \
      if (i < 2 * NH) rb[i] = *(const u32x4*)(Bt + (size_t)(n0 + row) * K + (k0) + ch * 8); } } while (0)
#define GSTORE(buf) do { bf16* As_ = (bf16*)(lds + (buf) * GBUF); bf16* Bs_ = As_ + 256 * GP; \
    _Pragma("unroll") for (int i = 0; i < 4; ++i) { const int c = tid + 512 * i, row = c >> 3, ch = c & 7; *(u32x4*)(As_ + row * GP + ch * 8) = ra[i]; if (i < 2 * NH) *(u32x4*)(Bs_ + row * GP + ch * 8) = rb[i]; } } while (0)
  __syncthreads();
  GLOAD(0);
  GSTORE(0);
  __syncthreads();
#pragma unroll 1
  for (int kt = 0; kt < nk; ++kt) {
    if (kt + 1 < nk) GLOAD((kt + 1) * 64);
    const bf16* As = (const bf16*)(lds + (kt & 1) * GBUF); const bf16* Bs = As + 256 * GP;
#pragma unroll
    for (int ks = 0; ks < 2; ++ks) {
      bf16x8 af[4];
#pragma unroll
      for (int i = 0; i < 4; ++i) af[i] = *(const bf16x8*)(As + (wm * 64 + i * 16 + r) * GP + ks * 32 + q4 * 8);
#pragma unroll
      for (int nh = 0; nh < NH; ++nh) {
        bf16x8 bfr[4];
#pragma unroll
        for (int i = 0; i < 4; ++i) bfr[i] = *(const bf16x8*)(Bs + (wn * 64 * NH + nh * 64 + i * 16 + r) * GP + ks * 32 + q4 * 8);
#pragma unroll
        for (int mi = 0; mi < 4; ++mi)
#pragma unroll
          for (int ni = 0; ni < 4; ++ni) acc[mi][nh * 4 + ni] = mfma16(bfr[ni], af[mi], acc[mi][nh * 4 + ni]);
      }
    }
    if (kt + 1 < nk) GSTORE((kt + 1) & 1);
    __syncthreads();
  }
#undef GLOAD
#undef GSTORE
}
DI void zero_acc(f32x4 (&acc)[4][4 * NH]) {
#pragma unroll
  for (int a = 0; a < 4; ++a)
#pragma unroll
    for (int b = 0; b < 4 * NH; ++b) acc[a][b] = (f32x4){0.f, 0.f, 0.f, 0.f};
}

enum { T_PLAIN = 0, T_NR = 1, T_ROPE = 2, T_SILU = 3, T_IW = 4 };
DI void slot_info(const Params& p, int layer, int slot, int& type, const float*& gain) {
  gain = nullptr;
  if (layer == 0) {
    if (slot < 8) { type = T_NR; gain = p.in[I_A_Q_GAIN]; }
    else if (slot == 8) { type = T_NR; gain = p.in[I_A_K_GAIN]; }
    else if (slot == 9) type = T_PLAIN;
    else if (slot < 18) type = T_ROPE;
    else if (slot == 18) { type = T_NR; gain = p.in[I_IDX_K_GAIN]; }
    else if (slot < 27) type = T_SILU;
    else if (slot < 35) { type = T_NR; gain = p.in[I_B_Q_GAIN]; }
    else if (slot < 37) { type = T_NR; gain = p.in[I_B_K_GAIN]; }
    else if (slot < 39) type = T_PLAIN;
    else if (slot < 47) type = T_SILU;
    else type = T_IW;
  } else {
    if (slot < 8) { type = T_NR; gain = p.in[I_C_Q_GAIN]; }
    else if (slot < 16) { type = T_NR; gain = p.in[I_C_K_GAIN]; }
    else if (slot < 24) type = T_PLAIN;
    else if (slot < 32) type = T_SILU;
    else if (slot < 40) { type = T_NR; gain = p.in[I_D_Q_GAIN]; }
    else if (slot < 48) { type = T_NR; gain = p.in[I_D_K_GAIN]; }
    else if (slot < 56) type = T_PLAIN;
    else type = T_SILU;
  }
}
constexpr int E_AQ = 0, E_AK = 512, E_AV = 576, E_IQ = 640, E_IK = 1152, E_AG = 1216, E_BQ = 1728, E_BK = 2240, E_BV = 2368, E_BG = 2496;
constexpr int O_CQ = 0, O_CK = 512, O_CV = 1024, O_CG = 1536, O_DQ = 2048, O_DK = 2560, O_DV = 3072, O_DG = 3584;

DI void phase_inproj(const Params& p, int layer, char* lds) {
  unsigned char* ws = p.ws;
  const int NP = layer == 0 ? NPE : NPO;
  const bf16* A = (const bf16*)(ws + (layer == 0 ? WS_ACT : WS_Y));
  const bf16* Bt = (const bf16*)(ws + (layer == 0 ? WS_WINE : WS_WINO));
  bf16* PE = (bf16*)(ws + WS_PE);
  const float2* rope = (const float2*)(ws + WS_ROPE);
  const float* ss1 = (const float*)(ws + WS_SS);
  float* IW = (float*)(ws + WS_IW);
  const int lane = threadIdx.x & 63, wid = threadIdx.x >> 6, wm = wid & 3, wn = wid >> 2, r = lane & 15, q4 = lane >> 4;
  const int nnt = NP / TN, ntiles = 64 * nnt;
  for (int tile = blockIdx.x; tile < ntiles; tile += gridDim.x) {
    const int nt = tile / 64, mt = tile % 64;
    const int m0 = mt * 256, n0 = nt * TN;
    f32x4 acc[4][4 * NH]; zero_acc(acc);
    gemm_acc<0>(A, DM, Bt, DM, m0, n0, lds, acc);
#pragma unroll
    for (int nh = 0; nh < NH; ++nh) {
    const int mbase = m0 + wm * 64, nbase = n0 + wn * 64 * NH + nh * 64, slot = nbase >> 6;
    int type; const float* gain; slot_info(p, layer, slot, type, gain);
#pragma unroll
    for (int mi = 0; mi < 4; ++mi) {
      const int m = mbase + mi * 16 + r, pos = m & (SEQ - 1);
      float sc = 1.f;
      if (layer == 1) sc = rsqrtf(ss1[m] * (1.f / DM) + EPS);
      f32x4 v[4];
#pragma unroll
      for (int ni = 0; ni < 4; ++ni) v[ni] = acc[mi][nh * 4 + ni] * sc;
      if (type == T_NR) {
        float s = 0.f;
#pragma unroll
        for (int ni = 0; ni < 4; ++ni) s += v[ni].x * v[ni].x + v[ni].y * v[ni].y + v[ni].z * v[ni].z + v[ni].w * v[ni].w;
        s += __shfl_xor(s, 16); s += __shfl_xor(s, 32);
        const float rn = rsqrtf(s * (1.f / 64.f) + EPS);
#pragma unroll
        for (int ni = 0; ni < 4; ++ni) { const f32x4 g = *(const f32x4*)(gain + ni * 16 + q4 * 4); v[ni] = v[ni] * rn * g; }
      }
      if (type == T_NR || type == T_ROPE) {
#pragma unroll
        for (int ni = 0; ni < 2; ++ni) {
          const f32x4* cs = (const f32x4*)(rope + (size_t)pos * 32 + ni * 16 + q4 * 4);
          const f32x4 c01 = cs[0], c23 = cs[1];
          const f32x4 x1 = v[ni], x2 = v[ni + 2];
          f32x4 o1, o2;
          o1.x = x1.x * c01.x - x2.x * c01.y; o2.x = x2.x * c01.x + x1.x * c01.y;
          o1.y = x1.y * c01.z - x2.y * c01.w; o2.y = x2.y * c01.z + x1.y * c01.w;
          o1.z = x1.z * c23.x - x2.z * c23.y; o2.z = x2.z * c23.x + x1.z * c23.y;
          o1.w = x1.w * c23.z - x2.w * c23.w; o2.w = x2.w * c23.z + x1.w * c23.w;
          v[ni] = o1; v[ni + 2] = o2;
        }
      }
      if (type == T_SILU) {
#pragma unroll
        for (int ni = 0; ni < 4; ++ni)
#pragma unroll
          for (int j = 0; j < 4; ++j) { const float t = v[ni][j]; v[ni][j] = t / (1.f + __expf(-t)); }
      }
      if (type == T_IW) {
        if (q4 < 2) *(f32x4*)(IW + (size_t)m * 8 + q4 * 4) = v[0];
      } else {
#pragma unroll
        for (int ni = 0; ni < 4; ++ni) { u32x2 w; w.x = cvtpk(v[ni].x, v[ni].y); w.y = cvtpk(v[ni].z, v[ni].w); *(u32x2*)(PE + (size_t)m * NP + nbase + ni * 16 + q4 * 4) = w;
          if (layer == 0 && slot == 18) { bf16* IKS = (bf16*)(ws + WS_IKS); const int key = m & (SEQ - 1);
            *(u32x2*)(IKS + ((((size_t)(m >> 13) * 256 + (key >> 5)) * 4 + ni) * 64 + (q4 >> 1) * 32 + (key & 31)) * 8 + (q4 & 1) * 4) = w; } }
      }
    }
    }
  }
}

DI void phase_outproj(const Params& p, int layer, char* lds) {
  unsigned char* ws = p.ws;
  const bf16* A = (const bf16*)(ws + WS_Y);
  const bf16* Bt = (const bf16*)(ws + (layer == 0 ? WS_WOUTE : WS_WOUTO));
  const float* xin = layer == 0 ? p.in[I_X] : p.out;
  float* out = p.out;
  bf16* XG = (bf16*)(ws + WS_ACT);
  const float* pg = p.in[I_PLE_NORM_GAIN] + layer * DM;
  float* ss = (float*)(ws + WS_SS) + (layer == 0 ? 1 : 2) * NTOK;
  const int lane = threadIdx.x & 63, wid = threadIdx.x >> 6, wm = wid & 3, wn = wid >> 2, r = lane & 15, q4 = lane >> 4;
  const int ntiles = 64 * (DM / TN);
  for (int tile = blockIdx.x; tile < ntiles; tile += gridDim.x) {
    const int nt = tile / 64, mt = tile % 64, m0 = mt * 256, n0 = nt * TN;
    f32x4 acc[4][4 * NH]; zero_acc(acc);
    gemm_acc<0>(A, DM, Bt, DM, m0, n0, lds, acc);
    const int mbase = m0 + wm * 64, nbase = n0 + wn * 64 * NH;
#pragma unroll
    for (int mi = 0; mi < 4; ++mi) {
      const int m = mbase + mi * 16 + r; float rs = 0.f;
#pragma unroll
      for (int ni = 0; ni < 4 * NH; ++ni) {
        const int n = nbase + ni * 16 + q4 * 4; const size_t off = (size_t)m * DM + n;
        const f32x4 xn = *(const f32x4*)(xin + off) + acc[mi][ni];
        *(f32x4*)(out + off) = xn;
        rs += xn.x * xn.x + xn.y * xn.y + xn.z * xn.z + xn.w * xn.w;
        const f32x4 g = *(const f32x4*)(pg + n);
        u32x2 w; w.x = cvtpk(xn.x * g.x, xn.y * g.y); w.y = cvtpk(xn.z * g.z, xn.w * g.w); *(u32x2*)(XG + off) = w;
        if (ni & 1) asm volatile("" ::: "memory");
      }
      rs += __shfl_xor(rs, 16); rs += __shfl_xor(rs, 32);
      if (q4 == 0) atomicAdd(ss + m, rs);
    }
  }
}

DI void phase_ple(const Params& p, int layer, char* lds) {
  unsigned char* ws = p.ws;
  const float* Pin = p.in[I_P] + (size_t)layer * NTOK * 256;
  const bf16* Wp = (const bf16*)(ws + (layer == 0 ? WS_WP0 : WS_WP1));
  const bf16* Wg = (const bf16*)(ws + (layer == 0 ? WS_WG0 : WS_WG1));
  const bf16* XG = (const bf16*)(ws + WS_ACT);
  float* out = p.out;
  const float* ssx = (const float*)(ws + WS_SS) + (layer == 0 ? 1 : 2) * NTOK;
  float* ss1 = (float*)(ws + WS_SS);
  bf16* H = (bf16*)(ws + WS_Y);
  float* PT = (float*)(ws + WS_PE);
  const float* ng1 = p.in[I_NORM_GAIN] + DM;
  const int lane = threadIdx.x & 63, wid = threadIdx.x >> 6, wm = wid & 3, wn = wid >> 2, r = lane & 15, q4 = lane >> 4;
  const int ntiles = 64 * (DM / TN);
  for (int tile = blockIdx.x; tile < ntiles; tile += gridDim.x) {
    const int nt = tile / 64, mt = tile % 64, m0 = mt * 256, n0 = nt * TN;
    const int mbase = m0 + wm * 64, nbase = n0 + wn * 64 * NH;
    f32x4 acc[4][4 * NH]; zero_acc(acc);
    gemm_acc<1>(Pin, 256, Wp, 256, m0, n0, lds, acc);
#pragma unroll
    for (int mi = 0; mi < 4; ++mi)
#pragma unroll
      for (int ni = 0; ni < 4 * NH; ++ni) *(f32x4*)(PT + (size_t)(mbase + mi * 16 + r) * DM + nbase + ni * 16 + q4 * 4) = acc[mi][ni];
    zero_acc(acc);
    gemm_acc<0>(XG, DM, Wg, DM, m0, n0, lds, acc);
#pragma unroll
    for (int mi = 0; mi < 4; ++mi) {
      const int m = mbase + mi * 16 + r; float rs = 0.f;
      const float rstd = rsqrtf(ssx[m] * (1.f / DM) + EPS);
#pragma unroll
      for (int ni = 0; ni < 4 * NH; ++ni) {
        const int n = nbase + ni * 16 + q4 * 4; const size_t off = (size_t)m * DM + n;
        f32x4 g;
#pragma unroll
        for (int j = 0; j < 4; ++j) g[j] = 1.f / (1.f + __expf(-rstd * acc[mi][ni][j]));
        const f32x4 xn = *(const f32x4*)(out + off) + *(const f32x4*)(PT + off) * g;
        *(f32x4*)(out + off) = xn;
        if (layer == 0) {
          rs += xn.x * xn.x + xn.y * xn.y + xn.z * xn.z + xn.w * xn.w;
          const f32x4 gg = *(const f32x4*)(ng1 + n);
          u32x2 w; w.x = cvtpk(xn.x * gg.x, xn.y * gg.y); w.y = cvtpk(xn.z * gg.z, xn.w * gg.w); *(u32x2*)(H + off) = w;
        }
        if (ni & 1) asm volatile("" ::: "memory");
      }
      if (layer == 0) { rs += __shfl_xor(rs, 16); rs += __shfl_xor(rs, 32); if (q4 == 0) atomicAdd(ss1 + m, rs); }
    }
  }
}

template <int DVB, bool MASKED = true>
DI void attn_step32(const bf16* Kt, int KP, const bf16* Vt, int VP, const bf16x8 (&qf)[4], f32x16 (&o)[DVB], float& m, float& l, unsigned vmask, float c2, int lane) {
  const int r32 = lane & 31, h = lane >> 5;
  f32x16 s;
#pragma unroll
  for (int i = 0; i < 16; ++i) s[i] = 0.f;
#pragma unroll
  for (int t = 0; t < 4; ++t) { const bf16x8 kf = *(const bf16x8*)(Kt + r32 * KP + t * 16 + h * 8); s = mfma32(kf, qf[t], s); }
  float mx = -INFINITY;
#pragma unroll
  for (int i = 0; i < 16; ++i) { if (MASKED) { s[i] = ((vmask >> i) & 1u) ? s[i] : -INFINITY; } mx = fmaxf(mx, s[i]); }
  mx = fmaxf(mx, __shfl_xor(mx, 32));
  const float mn = fmaxf(m, mx * c2);
  if (__any(mn > m)) {
    const float alpha = fexp2(m - mn); l *= alpha;
#pragma unroll
    for (int d = 0; d < DVB; ++d)
#pragma unroll
      for (int i = 0; i < 16; ++i) o[d][i] *= alpha;
    m = mn;
  }
  float ps = 0.f; const float negm = -m;
#pragma unroll
  for (int i = 0; i < 16; ++i) { const float pv = fexp2(__builtin_fmaf(s[i], c2, negm)); s[i] = pv; ps += pv; }
  l += ps;
  bf16x8 pf[2];
  { u32x4 a, b; a.x = cvtpk(s[0], s[1]); a.y = cvtpk(s[2], s[3]); a.z = cvtpk(s[4], s[5]); a.w = cvtpk(s[6], s[7]);
    b.x = cvtpk(s[8], s[9]); b.y = cvtpk(s[10], s[11]); b.z = cvtpk(s[12], s[13]); b.w = cvtpk(s[14], s[15]);
    pf[0] = __builtin_bit_cast(bf16x8, a); pf[1] = __builtin_bit_cast(bf16x8, b); }
  const int i16 = lane & 15, q = i16 >> 2, pp = i16 & 3, blk = (lane >> 4) & 1;
#pragma unroll
  for (int d = 0; d < DVB; ++d)
#pragma unroll
    for (int sk = 0; sk < 2; ++sk) {
      const s16x4 lo = trread(Vt + (16 * sk + 4 * h + q) * VP + 32 * d + 16 * blk + 4 * pp);
      const s16x4 hi = trread(Vt + (16 * sk + 8 + 4 * h + q) * VP + 32 * d + 16 * blk + 4 * pp);
      const bf16x8 vf = __builtin_shufflevector(lo, hi, 0, 1, 2, 3, 4, 5, 6, 7);
      o[d] = mfma32(vf, pf[sk], o[d]);
    }
}

constexpr int WP = 72;
constexpr int WAVE_LDS = 2 * 32 * WP * 2;

struct KVRegs { u32x4 k[4], v[4]; };
DI void kv_store(const KVRegs& R, bf16* Ks, bf16* Vs, int lane) {
#pragma unroll
  for (int i = 0; i < 4; ++i) { const int row = (lane >> 3) + 8 * i, ch = lane & 7; *(u32x4*)(Ks + row * WP + ch * 8) = R.k[i]; *(u32x4*)(Vs + row * WP + ch * 8) = R.v[i]; }
}

DI void band_load(KVRegs& R, const bf16* Kg, const bf16* Vg, int NP, int kstart, int dil, int roff, int lane) {
#pragma unroll
  for (int i = 0; i < 4; ++i) {
    const int row = (lane >> 3) + 8 * i, ch = lane & 7; int k = kstart + row; if (k < 0) k = 0;
    const size_t off = (size_t)(dil * k + roff) * NP + ch * 8;
    R.k[i] = *(const u32x4*)(Kg + off); R.v[i] = *(const u32x4*)(Vg + off);
  }
}
template <int DVB>
DI void band_run(const bf16* Kg, const bf16* Vg, int NP, int kbase, int nsteps, int dil, int roff, int qidx, int win,
                 const bf16x8 (&qf)[4], f32x16 (&o)[DVB], float& m, float& l, float c2, bf16* Ks, bf16* Vs, int lane) {
  const int h = lane >> 5;
  KVRegs R; band_load(R, Kg, Vg, NP, kbase, dil, roff, lane);
  for (int j = 0; j < nsteps; ++j) {
    lds_fence();
    kv_store(R, Ks, Vs, lane);
    lds_fence();
    if (j + 1 < nsteps) band_load(R, Kg, Vg, NP, kbase + 32 * (j + 1), dil, roff, lane);
    unsigned vm = 0;
#pragma unroll
    for (int i = 0; i < 16; ++i) { const int k = kbase + 32 * j + crow(i, h); const int dlt = qidx - k; if (k >= 0 && dlt >= 0 && dlt <= win) vm |= (1u << i); }
    attn_step32<DVB>(Ks, WP, Vs, WP, qf, o, m, l, vm, c2, lane);
  }
}

DI void write_o64(const f32x16 (&o)[2], float linv, const bf16* gate_row, bf16* y_row, int h) {
#pragma unroll
  for (int d = 0; d < 2; ++d)
#pragma unroll
    for (int g = 0; g < 4; ++g) {
      const int dd = 32 * d + 8 * g + 4 * h;
      const u32x2 gv = *(const u32x2*)(gate_row + dd);
      const float g0 = __uint_as_float(gv.x << 16), g1 = __uint_as_float(gv.x & 0xffff0000u), g2 = __uint_as_float(gv.y << 16), g3 = __uint_as_float(gv.y & 0xffff0000u);
      u32x2 w; w.x = cvtpk(o[d][4 * g] * linv * g0, o[d][4 * g + 1] * linv * g1); w.y = cvtpk(o[d][4 * g + 2] * linv * g2, o[d][4 * g + 3] * linv * g3);
      *(u32x2*)(y_row + dd) = w;
    }
}

DI void load_q(bf16x8 (&qf)[4], const bf16* qrow, int h) {
#pragma unroll
  for (int t = 0; t < 4; ++t) qf[t] = *(const bf16x8*)(qrow + t * 16 + h * 8);
}
template <int DVB> DI void zero_o(f32x16 (&o)[DVB]) {
#pragma unroll
  for (int d = 0; d < DVB; ++d)
#pragma unroll
    for (int i = 0; i < 16; ++i) o[d][i] = 0.f;
}

DI void mixerB_tile(const Params& p, int item, bf16* Ks, bf16* Vs, int lane) {
  const bf16* PE = (const bf16*)(p.ws + WS_PE); bf16* Y = (bf16*)(p.ws + WS_Y);
  const int qblk = item & 255, head = (item >> 8) & 7, b = item >> 11;
  const int r32 = lane & 31, h = lane >> 5, q0 = qblk * 32, kvh = head >> 2;
  const size_t rowb = (size_t)b * SEQ;
  bf16x8 qf[4]; load_q(qf, PE + (rowb + q0 + r32) * NPE + E_BQ + head * 64, h);
  f32x16 o[2]; zero_o<2>(o);
  const float sink2 = p.in[I_B_SINKS][head] * LOG2E;
  float m = sink2, l = (h == 0) ? 1.f : 0.f;
  band_run<2>(PE + rowb * NPE + E_BK + kvh * 64, PE + rowb * NPE + E_BV + kvh * 64, NPE, q0 - 128, 5, 1, 0, q0 + r32, 127, qf, o, m, l, 0.125f * LOG2E, Ks, Vs, lane);
  l += __shfl_xor(l, 32);
  const size_t tok = rowb + q0 + r32;
  write_o64(o, 1.f / l, PE + tok * NPE + E_BG + head * 64, Y + tok * DM + 512 + head * 64, h);
}

DI void mixerC_tile(const Params& p, int item, bf16* Ks, bf16* Vs, int lane) {
  const bf16* PO = (const bf16*)(p.ws + WS_PE); bf16* Y = (bf16*)(p.ws + WS_Y);
  const int qt = item & 15, r16 = (item >> 4) & 15, head = (item >> 8) & 7, b = item >> 11;
  const int r32 = lane & 31, h = lane >> 5, qi0 = qt * 32;
  const size_t rowb = (size_t)b * SEQ;
  const int t = 16 * (qi0 + r32) + r16;
  bf16x8 qf[4]; load_q(qf, PO + (rowb + t) * NPO + O_CQ + head * 64, h);
  f32x16 o[2]; zero_o<2>(o);
  float m = -1e30f, l = 0.f;
  const bf16* Kg = PO + rowb * NPO + O_CK + head * 64; const bf16* Vg = PO + rowb * NPO + O_CV + head * 64;
  const float c2 = 0.125f * LOG2E;
  band_run<2>(Kg, Vg, NPO, qi0 - 128, 5, 16, r16, qi0 + r32, 128, qf, o, m, l, c2, Ks, Vs, lane);
  band_run<2>(Kg, Vg, NPO, 4 * qi0 + (r16 >> 2) - 128, 8, 4, r16 & 3, 4 * (qi0 + r32) + (r16 >> 2), 128, qf, o, m, l, c2, Ks, Vs, lane);
  band_run<2>(Kg, Vg, NPO, 16 * qi0 + r16 - 128, 20, 1, 0, t, 128, qf, o, m, l, c2, Ks, Vs, lane);
  l += __shfl_xor(l, 32);
  const size_t tok = rowb + t;
  write_o64(o, 1.f / l, PO + tok * NPO + O_CG + head * 64, Y + tok * DM + head * 64, h);
}

DI void mixerA_item(const Params& p, int item, bf16* Ks, bf16* Vs, int lane) {
  const bf16* PE = (const bf16*)(p.ws + WS_PE); bf16* Y = (bf16*)(p.ws + WS_Y);
  const unsigned short* SEL = (const unsigned short*)(p.ws + WS_SEL) + (size_t)item * 256;
  const int t = item & (SEQ - 1), b = item >> 13;
  const int r32 = lane & 31, h = lane >> 5, head = r32 & 7;
  const size_t rowb = (size_t)b * SEQ;
  const int count = (t + 1 < 256) ? t + 1 : 256, nsteps = (count + 31) >> 5;
  bf16x8 qf[4]; load_q(qf, PE + (size_t)item * NPE + E_AQ + head * 64, h);
  f32x16 o[2]; zero_o<2>(o);
  float m = -1e30f, l = 0.f;
  const bf16* Kg = PE + rowb * NPE + E_AK; const bf16* Vg = PE + rowb * NPE + E_AV;
  KVRegs R;
#define A_LOAD(j) do { _Pragma("unroll") for (int i = 0; i < 4; ++i) { const int row = (lane >> 3) + 8 * i, ch = lane & 7, e = 32 * (j) + row; \
      const int tokk = (e < count) ? (int)SEL[e] : 0; const size_t off = (size_t)tokk * NPE + ch * 8; R.k[i] = *(const u32x4*)(Kg + off); R.v[i] = *(const u32x4*)(Vg + off); } } while (0)
  A_LOAD(0);
  for (int j = 0; j < nsteps; ++j) {
    lds_fence();
    kv_store(R, Ks, Vs, lane);
    lds_fence();
    if (j + 1 < nsteps) A_LOAD(j + 1);
    unsigned vm = 0;
#pragma unroll
    for (int i = 0; i < 16; ++i) if (32 * j + crow(i, h) < count) vm |= (1u << i);
    attn_step32<2>(Ks, WP, Vs, WP, qf, o, m, l, vm, 0.125f * LOG2E, lane);
  }
#undef A_LOAD
  l += __shfl_xor(l, 32);
  if (r32 < 8) write_o64(o, 1.f / l, PE + (size_t)item * NPE + E_AG + head * 64, Y + (size_t)item * DM + head * 64, h);
}

DI unsigned f2ord(float f) { f += 0.f; const unsigned u = __float_as_uint(f); return (u & 0x80000000u) ? ~u : (u | 0x80000000u); }
DI int block_excl_scan(int v, int* tmp, int* tot) {
  const int lane = threadIdx.x & 63, wid = threadIdx.x >> 6;
  int inc = v;
#pragma unroll
  for (int o = 1; o < 64; o <<= 1) { const int u = __shfl_up(inc, o); if (lane >= o) inc += u; }
  __syncthreads();
  if (lane == 63) tmp[wid] = inc;
  __syncthreads();
  int base = 0, total = 0;
#pragma unroll
  for (int w = 0; w < 8; ++w) { const int x = tmp[w]; if (w < wid) base += x; total += x; }
  *tot = total;
  return base + inc - v;
}

DI float dpp_sum8(float v) {
  v += __builtin_bit_cast(float, __builtin_amdgcn_mov_dpp(__builtin_bit_cast(int, v), 0xB1, 0xF, 0xF, true));
  v += __builtin_bit_cast(float, __builtin_amdgcn_mov_dpp(__builtin_bit_cast(int, v), 0x4E, 0xF, 0xF, true));
  v += __builtin_bit_cast(float, __builtin_amdgcn_mov_dpp(__builtin_bit_cast(int, v), 0x141, 0xF, 0xF, true));
  return v;
}
DI void hist_find(const int* hist, int* misc, int need, int& digit, int& nneed, int& cnt) {
  const int tid = threadIdx.x;
  typedef int i32x4 __attribute__((ext_vector_type(4)));
  const i32x4 h0 = *(const i32x4*)(hist + tid * 8), h1 = *(const i32x4*)(hist + tid * 8 + 4);
  int hh[8] = {h0.x, h0.y, h0.z, h0.w, h1.x, h1.y, h1.z, h1.w}; int tot = 0;
#pragma unroll
  for (int k = 0; k < 8; ++k) tot += hh[k];
  int total; const int ex = block_excl_scan(tot, misc, &total);
  int above = total - ex - tot;
#pragma unroll
  for (int k = 7; k >= 0; --k) { const int c = hh[k]; if (above < need && above + c >= need) { misc[16] = tid * 8 + k; misc[17] = need - above; misc[18] = c; } above += c; }
  __syncthreads();
  digit = misc[16]; nneed = misc[17]; cnt = misc[18];
  __syncthreads();
}
DI unsigned long long mkcmp(float v, int idx) { return ((unsigned long long)f2ord(v) << 16) | ((unsigned long long)(8191 - idx) << 3); }
DI float ord2f(unsigned k) { return __uint_as_float((k & 0x80000000u) ? (k ^ 0x80000000u) : ~k); }
DI float half_sum(float v) { auto rr = __builtin_amdgcn_permlane32_swap(__float_as_uint(v), __float_as_uint(v), false, false); return __uint_as_float(rr[0]) + __uint_as_float(rr[1]); }

constexpr int CL_CAP = 512;
DI void selectA_item(const Params& p, int item, char* lds) {
  const bf16* PE = (const bf16*)(p.ws + WS_PE);
  const float* IW = (const float*)(p.ws + WS_IW);
  unsigned short* SEL = (unsigned short*)(p.ws + WS_SEL);
  float* sc = (float*)lds;
  int* hist = (int*)(lds + 4 * 8192 * 4);
  int* misc = hist + 4096;
  unsigned* mm = (unsigned*)(misc + 24);
  unsigned long long* clist = (unsigned long long*)(misc + 64);
  const int tid = threadIdx.x, lane = tid & 63, wid = tid >> 6, r32 = lane & 31, h = lane >> 5;
  const int b = item >> 11, t0 = (item & 2047) * 4;
  const size_t rowb = (size_t)b * SEQ;
  const int nk = t0 + 4, ntile = (nk + 31) >> 5;
  if (tid < 4) { mm[tid * 2] = 0xFFFFFFFFu; mm[tid * 2 + 1] = 0u; }
  __syncthreads();
  bf16x8 qf[4]; load_q(qf, PE + (rowb + t0 + (r32 >> 3)) * NPE + E_IQ + (r32 & 7) * 64, h);
  float wq[16];
#pragma unroll
  for (int i = 0; i < 16; ++i) wq[i] = IW[(rowb + t0 + (i >> 2)) * 8 + (i & 3) + 4 * h] * 0.04419417382415922f;
  const bf16* Kt = (const bf16*)(p.ws + WS_IKS) + (size_t)b * 256 * 2048 + lane * 8;
  {
    bf16x8 kf[4], kn[4];
#pragma unroll
    for (int t = 0; t < 4; ++t) { kf[t] = (bf16x8){0, 0, 0, 0, 0, 0, 0, 0}; kn[t] = kf[t]; }
    if (wid < ntile) {
#pragma unroll
      for (int t = 0; t < 4; ++t) kf[t] = *(const bf16x8*)(Kt + (size_t)wid * 2048 + t * 512);
    }
    float lo0 = INFINITY, hi0 = -INFINITY, lo1 = INFINITY, hi1 = -INFINITY;
    for (int kt = wid; kt < ntile; kt += 8) {
      if (kt + 8 < ntile) {
#pragma unroll
        for (int t = 0; t < 4; ++t) kn[t] = *(const bf16x8*)(Kt + (size_t)(kt + 8) * 2048 + t * 512);
      }
      f32x16 s;
#pragma unroll
      for (int i = 0; i < 16; ++i) s[i] = 0.f;
#pragma unroll
      for (int t = 0; t < 4; ++t) s = mfma32(qf[t], kf[t], s);
      float v[4];
#pragma unroll
      for (int q = 0; q < 4; ++q) {
        float a = wq[4 * q] * fmaxf(s[4 * q], 0.f);
#pragma unroll
        for (int jj = 1; jj < 4; ++jj) a += wq[4 * q + jj] * fmaxf(s[4 * q + jj], 0.f);
        v[q] = half_sum(a) + 0.f;
      }
      const float va = h ? v[2] : v[0], vb = h ? v[3] : v[1];
      const int key = kt * 32 + r32;
      sc[(2 * h) * 8192 + key] = va; sc[(2 * h + 1) * 8192 + key] = vb;
      lo0 = fminf(lo0, va); hi0 = fmaxf(hi0, va); lo1 = fminf(lo1, vb); hi1 = fmaxf(hi1, vb);
#pragma unroll
      for (int t = 0; t < 4; ++t) kf[t] = kn[t];
    }
    if (wid < ntile) {
#pragma unroll
      for (int o = 1; o < 32; o <<= 1) { lo0 = fminf(lo0, __shfl_xor(lo0, o)); hi0 = fmaxf(hi0, __shfl_xor(hi0, o)); lo1 = fminf(lo1, __shfl_xor(lo1, o)); hi1 = fmaxf(hi1, __shfl_xor(hi1, o)); }
      if (r32 == 0) { atomicMin(&mm[(2 * h) * 2], f2ord(lo0)); atomicMax(&mm[(2 * h) * 2 + 1], f2ord(hi0)); atomicMin(&mm[(2 * h + 1) * 2], f2ord(lo1)); atomicMax(&mm[(2 * h + 1) * 2 + 1], f2ord(hi1)); }
    }
  }
  __syncthreads();
  for (int q = 0; q < 4; ++q) {
    const int t = t0 + q, n = t + 1;
    unsigned short* out = SEL + (rowb + t) * 256;
    if (n <= 256) { if (tid < n) out[tid] = (unsigned short)tid; continue; }
    const float* scq = sc + q * 8192;
    const float lo = ord2f(mm[q * 2]), hi = ord2f(mm[q * 2 + 1]);
    const float scale = (hi > lo) ? 4095.f / (hi - lo) : 0.f;
    for (int i = tid; i < 4096; i += 512) hist[i] = 0;
    if (tid == 0) misc[20] = 0;
    __syncthreads();
    float val[16]; int bin[16];
#pragma unroll
    for (int i = 0; i < 16; ++i) { const int idx = tid + 512 * i; const float v = (idx < n) ? scq[idx] : lo; val[i] = v;
      int bb = (int)((v - lo) * scale); bb = bb < 0 ? 0 : (bb > 4095 ? 4095 : bb); bin[i] = bb; if (idx < n) atomicAdd(&hist[bb], 1); }
    __syncthreads();
    int bstar, need, cnt;
    hist_find(hist, misc, 256, bstar, need, cnt);
    unsigned long long T = 0ull;
    if (cnt != need) {
      if (cnt <= CL_CAP) {
#pragma unroll
        for (int i = 0; i < 16; ++i) { const int idx = tid + 512 * i; if (idx < n && bin[i] == bstar) { const int slot = atomicAdd(&misc[20], 1); clist[slot] = mkcmp(val[i], idx); } }
        __syncthreads();
        if (tid < cnt) { const unsigned long long c = clist[tid]; int rank = 0; for (int jx = 0; jx < cnt; ++jx) rank += (clist[jx] > c) ? 1 : 0;
          if (rank == need - 1) { misc[21] = (int)(unsigned)(c & 0xffffffffull); misc[22] = (int)(unsigned)(c >> 32); } }
        __syncthreads();
        T = ((unsigned long long)(unsigned)misc[22] << 32) | (unsigned long long)(unsigned)misc[21];
      } else {
        unsigned long long prefix = 0ull; int shift = 36;
        for (int pass = 0; pass < 4; ++pass) {
          for (int i = tid; i < 4096; i += 512) hist[i] = 0;
          __syncthreads();
#pragma unroll
          for (int i = 0; i < 16; ++i) { const int idx = tid + 512 * i; if (idx < n && bin[i] == bstar) { const unsigned long long c = mkcmp(val[i], idx); if (pass == 0 || (c >> (shift + 12)) == prefix) atomicAdd(&hist[(int)((c >> shift) & 4095ull)], 1); } }
          __syncthreads();
          int digit, nneed, c2;
          hist_find(hist, misc, need, digit, nneed, c2);
          prefix = (prefix << 12) | (unsigned long long)digit; need = nneed;
          if (c2 == need) break;
          shift -= 12;
        }
        T = prefix << shift;
      }
    }
    int mycnt = 0; unsigned selm = 0;
#pragma unroll
    for (int i = 0; i < 16; ++i) { const int idx = tid + 512 * i;
      bool sel = false;
      if (idx < n) { if (bin[i] > bstar) sel = true; else if (bin[i] == bstar) sel = (mkcmp(val[i], idx) >= T); }
      if (sel) { ++mycnt; selm |= (1u << i); } }
    int total; int pos = block_excl_scan(mycnt, misc, &total);
#pragma unroll
    for (int i = 0; i < 16; ++i) { if ((selm >> i) & 1u) { if (pos < 256) out[pos] = (unsigned short)(tid + 512 * i); ++pos; } }
    __syncthreads();
  }
  __syncthreads();
}

constexpr int DKP = 72, DVP = 136;
constexpr int D_STAGE = (64 * DKP * 2 + 64 * DVP) * 2;
DI void mixerD_unit(const Params& p, int b, int head, int qb, char* lds) {
  const bf16* PO = (const bf16*)(p.ws + WS_PE); bf16* Y = (bf16*)(p.ws + WS_Y);
  const int tid = threadIdx.x, lane = tid & 63, wid = tid >> 6, r32 = lane & 31, h = lane >> 5;
  const int map = wid & 1, qsub = wid >> 1;
  const size_t rowb = (size_t)b * SEQ;
  const int qpos = 128 * qb + 32 * qsub + r32;
  bf16x8 qf[4]; load_q(qf, PO + (rowb + qpos) * NPO + O_DQ + (2 * head + map) * 64, h);
  f32x16 o[4]; zero_o<4>(o);
  float m = -1e30f, l = 0.f;
  const int nsteps = 2 * qb + 2;
  const bf16* K1g = PO + rowb * NPO + O_DK + (2 * head) * 64;
  const bf16* K2g = K1g + 64;
  const bf16* Vg = PO + rowb * NPO + O_DV + head * 128;
  u32x4 rk1, rk2, rv[2];
#define D_LOAD(j) do { const int row = tid >> 3, ch = tid & 7; const size_t off = (size_t)((j) * 64 + row) * NPO + ch * 8; rk1 = *(const u32x4*)(K1g + off); rk2 = *(const u32x4*)(K2g + off); \
    _Pragma("unroll") for (int i = 0; i < 2; ++i) { const int c = tid + 512 * i, vr = c >> 4, vc = c & 15; rv[i] = *(const u32x4*)(Vg + (size_t)((j) * 64 + vr) * NPO + vc * 8); } } while (0)
  __syncthreads();
  D_LOAD(0);
  for (int j = 0; j < nsteps; ++j) {
    char* st = lds + (j & 1) * D_STAGE;
    bf16* K1s = (bf16*)st; bf16* K2s = K1s + 64 * DKP; bf16* Vs = K2s + 64 * DKP;
    { const int row = tid >> 3, ch = tid & 7; *(u32x4*)(K1s + row * DKP + ch * 8) = rk1; *(u32x4*)(K2s + row * DKP + ch * 8) = rk2;
#pragma unroll
      for (int i = 0; i < 2; ++i) { const int c = tid + 512 * i, vr = c >> 4, vc = c & 15; *(u32x4*)(Vs + vr * DVP + vc * 8) = rv[i]; } }
    __syncthreads();
    if (j + 1 < nsteps) D_LOAD(j + 1);
    const bf16* Ks = map ? K2s : K1s;
#pragma unroll
    for (int sub = 0; sub < 2; ++sub) {
      const int k0 = j * 64 + sub * 32;
      if (k0 <= 128 * qb + 32 * qsub + 31) {
        if (k0 + 31 <= 128 * qb + 32 * qsub) {
          attn_step32<4, false>(Ks + sub * 32 * DKP, DKP, Vs + sub * 32 * DVP, DVP, qf, o, m, l, 0xffffu, 0.125f * LOG2E, lane);
        } else {
          unsigned vm = 0;
#pragma unroll
          for (int i = 0; i < 16; ++i) if (k0 + crow(i, h) <= qpos) vm |= (1u << i);
          attn_step32<4, true>(Ks + sub * 32 * DKP, DKP, Vs + sub * 32 * DVP, DVP, qf, o, m, l, vm, 0.125f * LOG2E, lane);
        }
      }
    }
  }
#undef D_LOAD
  l += __shfl_xor(l, 32);
  const float linv = 1.f / l;
  __syncthreads();
  float* xch = (float*)lds + qsub * 4096;
  if (map == 1) {
#pragma unroll
    for (int d = 0; d < 4; ++d)
#pragma unroll
      for (int i = 0; i < 16; ++i) xch[(d * 16 + i) * 64 + lane] = o[d][i] * linv;
  }
  __syncthreads();
  if (map == 0) {
    const float lam = *(const float*)(p.ws + WS_LAM);
    float ssq = 0.f;
#pragma unroll
    for (int d = 0; d < 4; ++d)
#pragma unroll
      for (int i = 0; i < 16; ++i) { const float a = o[d][i] * linv - lam * xch[(d * 16 + i) * 64 + lane]; o[d][i] = a; ssq += a * a; }
    ssq += __shfl_xor(ssq, 32);
    const float lambda_init = 0.8f - 0.6f * expf(-0.3f);
    const float rn = rsqrtf(ssq * (1.f / 128.f) + EPS) * (1.f - lambda_init);
    const size_t tok = rowb + qpos;
    const bf16* gate = PO + tok * NPO + O_DG + head * 128;
    bf16* y = Y + tok * DM + 512 + head * 128;
    const float* sg = p.in[I_SUB_GAIN];
#pragma unroll
    for (int d = 0; d < 4; ++d)
#pragma unroll
      for (int g = 0; g < 4; ++g) {
        const int dd = 32 * d + 8 * g + 4 * h;
        const u32x2 gv = *(const u32x2*)(gate + dd); const f32x4 s4 = *(const f32x4*)(sg + dd);
        const float g0 = __uint_as_float(gv.x << 16), g1 = __uint_as_float(gv.x & 0xffff0000u), g2 = __uint_as_float(gv.y << 16), g3 = __uint_as_float(gv.y & 0xffff0000u);
        u32x2 w; w.x = cvtpk(o[d][4 * g] * rn * s4.x * g0, o[d][4 * g + 1] * rn * s4.y * g1); w.y = cvtpk(o[d][4 * g + 2] * rn * s4.z * g2, o[d][4 * g + 3] * rn * s4.w * g3);
        *(u32x2*)(y + dd) = w;
      }
  }
  __syncthreads();
}

__global__ void __launch_bounds__(NTHREADS) fwd_kernel(Params p) {
  extern __shared__ __attribute__((aligned(16))) char smem[];
  cg::grid_group grid = cg::this_grid();
  char* lds = smem;
  const int tid = threadIdx.x, lane = tid & 63, wid = tid >> 6;
  const int gw = blockIdx.x * 8 + wid, ngw = gridDim.x * 8;
  bf16* Ks = (bf16*)(lds + wid * WAVE_LDS); bf16* Vs = Ks + 32 * WP;

  phase_prologue(p, lds);
  grid.sync();
  for (int rep = 0; rep < REP_GEMM; ++rep) phase_inproj(p, 0, lds);
  grid.sync();
#if EN_A
  for (int rep = 0; rep < REP_SELA; ++rep) for (int it = blockIdx.x; it < 2 * 2048; it += gridDim.x) selectA_item(p, it, lds);
  grid.sync();
  for (int rep = 0; rep < REP_AATT; ++rep) for (int it = gw; it < NTOK; it += ngw) mixerA_item(p, it, Ks, Vs, lane);
#else
  { unsigned* y = (unsigned*)(p.ws + WS_Y); for (int i = blockIdx.x * NTHREADS + tid; i < NTOK * 256; i += gridDim.x * NTHREADS) { const int row = i >> 8, c = i & 255; y[row * 512 + c] = 0u; } }
#endif
#if EN_B
  for (int it = gw; it < 4096; it += ngw) mixerB_tile(p, it, Ks, Vs, lane);
#else
  { unsigned* y = (unsigned*)(p.ws + WS_Y); for (int i = blockIdx.x * NTHREADS + tid; i < NTOK * 256; i += gridDim.x * NTHREADS) { const int row = i >> 8, c = i & 255; y[row * 512 + 256 + c] = 0u; } }
#endif
  grid.sync();
  phase_outproj(p, 0, lds);
  grid.sync();
  phase_ple(p, 0, lds);
  grid.sync();
  phase_inproj(p, 1, lds);
  grid.sync();
#if EN_D
  for (int rep = 0; rep < REP_D; ++rep) {
#pragma unroll 1
    for (int u2 = blockIdx.x * 2; u2 < 512; u2 += gridDim.x * 2) {
#pragma unroll 1
      for (int k = 0; k < 2; ++k) { const int u = u2 >> 1, bh = u >> 5, pr = u & 31; mixerD_unit(p, bh >> 2, bh & 3, k ? 63 - pr : pr, lds); }
    }
  }
#else
  { unsigned* y = (unsigned*)(p.ws + WS_Y); for (int i = blockIdx.x * NTHREADS + tid; i < NTOK * 256; i += gridDim.x * NTHREADS) { const int row = i >> 8, c = i & 255; y[row * 512 + 256 + c] = 0u; } }
#endif
#if EN_C
  __syncthreads();
  for (int rep = 0; rep < REP_C; ++rep) for (int it = gw; it < 4096; it += ngw) mixerC_tile(p, it, Ks, Vs, lane);
#else
  { unsigned* y = (unsigned*)(p.ws + WS_Y); for (int i = blockIdx.x * NTHREADS + tid; i < NTOK * 256; i += gridDim.x * NTHREADS) { const int row = i >> 8, c = i & 255; y[row * 512 + c] = 0u; } }
#endif
  grid.sync();
  phase_outproj(p, 1, lds);
  grid.sync();
  phase_ple(p, 1, lds);
}

extern "C" void kernel_launch(void* const* d_in, const int* in_sizes, int n_in, void* d_out, int out_size, void* d_ws, size_t ws_size, hipStream_t stream) {
  static int grid_blocks = 0;
  if (!grid_blocks) {
    int dev = 0, cus = 0, per_cu = 0;
    hipGetDevice(&dev);
    hipDeviceGetAttribute(&cus, hipDeviceAttributeMultiprocessorCount, dev);
    hipFuncSetAttribute((const void*)fwd_kernel, hipFuncAttributeMaxDynamicSharedMemorySize, LDS_BYTES);
    hipOccupancyMaxActiveBlocksPerMultiprocessor(&per_cu, (const void*)fwd_kernel, NTHREADS, LDS_BYTES);
    if (per_cu < 1) per_cu = 1;
    grid_blocks = cus * per_cu;
    if (grid_blocks > 256) grid_blocks = 256;
  }
  Params p{};
  for (int i = 0; i < 25; ++i) p.in[i] = (const float*)d_in[i];
  p.out = (float*)d_out; p.ws = (unsigned char*)d_ws;
  for (int i = 0; i < 32; ++i) p.inv_freq[i] = (float)pow(10000.0, -(double)i / 32.0);
  void* args[] = {&p};
  hipError_t e = hipLaunchCooperativeKernel((const void*)fwd_kernel, dim3(grid_blocks), dim3(NTHREADS), args, LDS_BYTES, stream);
  if (e != hipSuccess) fprintf(stderr, "cooperative launch failed: %s (grid %d)\n", hipGetErrorString(e), grid_blocks);
}
```

```cpp
#include <hip/hip_runtime.h>
#include <hip/hip_cooperative_groups.h>
#include <cstdio>
#include <cmath>
namespace cg = cooperative_groups;

#ifndef REP_GEMM
#define REP_GEMM 1
#endif
#ifndef REP_SELA
#define REP_SELA 1
#endif
#ifndef REP_D
#define REP_D 1
#endif
#ifndef REP_C
#define REP_C 1
#endif
#ifndef REP_AATT
#define REP_AATT 1
#endif
#ifndef EN_A
#define EN_A 1
#endif
#ifndef EN_B
#define EN_B 1
#endif
#ifndef EN_C
#define EN_C 1
#endif
#ifndef EN_D
#define EN_D 1
#endif

typedef unsigned short bf16;
typedef short bf16x8 __attribute__((ext_vector_type(8)));
typedef short s16x4 __attribute__((ext_vector_type(4)));
typedef float f32x4 __attribute__((ext_vector_type(4)));
typedef float f32x16 __attribute__((ext_vector_type(16)));
typedef unsigned u32x4 __attribute__((ext_vector_type(4)));
typedef unsigned u32x2 __attribute__((ext_vector_type(2)));
typedef float f32x2_t __attribute__((ext_vector_type(2)));
typedef __bf16 bf16x2_t __attribute__((ext_vector_type(2)));
#define LAS __attribute__((address_space(3)))
#define DI __device__ __forceinline__

constexpr int SEQ = 8192, NTOK = 16384, DM = 1024;
constexpr int NPE = 3072, NPO = 4096;
constexpr float EPS = 1e-6f;
constexpr float LOG2E = 1.4426950408889634f;
constexpr int NTHREADS = 512;
constexpr int LDS_BYTES = 150 * 1024;

constexpr size_t MiB = 1u << 20;
constexpr size_t WS_PE = 0;
constexpr size_t WS_ACT = 128 * MiB;
constexpr size_t WS_Y = 160 * MiB;
constexpr size_t WS_WINE = 192 * MiB;
constexpr size_t WS_WOUTE = 198 * MiB;
constexpr size_t WS_WINO = 200 * MiB;
constexpr size_t WS_WOUTO = 208 * MiB;
constexpr size_t WS_WG0 = 210 * MiB;
constexpr size_t WS_WG1 = 212 * MiB;
constexpr size_t WS_WP0 = 214 * MiB;
constexpr size_t WS_WP1 = 215 * MiB;
constexpr size_t WS_ROPE = 216 * MiB;
constexpr size_t WS_SEL = 218 * MiB;
constexpr size_t WS_IW = 226 * MiB;
constexpr size_t WS_SS = 227 * MiB;
constexpr size_t WS_LAM = 228 * MiB;
constexpr size_t WS_IKS = 229 * MiB;

struct Params {
  const float* in[25];
  float* out;
  unsigned char* ws;
  float inv_freq[32];
};
enum { I_X = 0, I_P, I_NORM_GAIN, I_W_IN_EVEN, I_W_OUT_EVEN, I_A_Q_GAIN, I_A_K_GAIN, I_IDX_K_GAIN, I_B_Q_GAIN, I_B_K_GAIN, I_B_SINKS,
       I_W_IN_ODD, I_W_OUT_ODD, I_C_Q_GAIN, I_C_K_GAIN, I_D_Q_GAIN, I_D_K_GAIN, I_LQ1, I_LK1, I_LQ2, I_LK2, I_SUB_GAIN, I_PLE_NORM_GAIN,
       I_W_PLE_GATE, I_W_PLE_PROJ };

DI unsigned cvtpk(float lo, float hi) { f32x2_t v = {lo, hi}; bf16x2_t b = __builtin_convertvector(v, bf16x2_t); return __builtin_bit_cast(unsigned, b); }
DI float bf2f(bf16 b) { return __uint_as_float(((unsigned)b) << 16); }
DI float fexp2(float x) { return __builtin_amdgcn_exp2f(x); }
DI f32x16 mfma32(bf16x8 a, bf16x8 b, f32x16 c) { return __builtin_amdgcn_mfma_f32_32x32x16_bf16(a, b, c, 0, 0, 0); }
DI f32x4 mfma16(bf16x8 a, bf16x8 b, f32x4 c) { return __builtin_amdgcn_mfma_f32_16x16x32_bf16(a, b, c, 0, 0, 0); }
DI int crow(int i, int h) { return (i & 3) + 8 * (i >> 2) + 4 * h; }
DI s16x4 trread(const bf16* p) { return __builtin_bit_cast(s16x4, __builtin_amdgcn_ds_read_tr16_b64_v4i16((LAS s16x4*)p)); }
DI void lds_fence() { asm volatile("s_waitcnt lgkmcnt(0)" ::: "memory"); __builtin_amdgcn_wave_barrier(); }

DI int map_even(int n) { return n < 1216 ? n : (n < 1224 ? 3008 + (n - 1216) : n - 8); }
DI void transpose_tile(const float* W, int K, int N, bf16* WT, int mapmode, int tile, float* scr) {
  const int tid = threadIdx.x;
  const int ntn = (N + 63) >> 6, kt = tile / ntn, nt = tile % ntn, k0 = kt * 64, n0 = nt * 64;
#pragma unroll
  for (int i = 0; i < 8; ++i) {
    const int kk = (tid >> 6) + 8 * i, nn = tid & 63, n = n0 + nn;
    scr[kk * 65 + nn] = (n < N) ? W[(size_t)(k0 + kk) * N + n] : 0.f;
  }
  __syncthreads();
  {
    const int nn = tid >> 3, kc = tid & 7, n = n0 + nn;
    if (n < N) {
      const int dst = mapmode ? map_even(n) : n;
      const float* s = scr + (kc * 8) * 65 + nn;
      u32x4 o; o.x = cvtpk(s[0], s[65]); o.y = cvtpk(s[2 * 65], s[3 * 65]); o.z = cvtpk(s[4 * 65], s[5 * 65]); o.w = cvtpk(s[6 * 65], s[7 * 65]);
      *(u32x4*)(WT + (size_t)dst * K + k0 + kc * 8) = o;
    }
  }
  __syncthreads();
}

DI float wave_sum(float v) {
#pragma unroll
  for (int o = 1; o < 64; o <<= 1) v += __shfl_xor(v, o);
  return v;
}

DI void phase_prologue(const Params& p, char* lds) {
  const int tid = threadIdx.x, lane = tid & 63, wid = tid >> 6;
  const int nb = gridDim.x, bid = blockIdx.x;
  unsigned char* ws = p.ws;
  float* scr = (float*)lds;
  const int T0 = 16 * 48, T1 = 256, T2 = 16 * 64, T3 = 256, T4 = 256, T5 = 256, T6 = 64, T7 = 64;
  const int NT = T0 + T1 + T2 + T3 + T4 + T5 + T6 + T7;
  for (int it = bid; it < NT; it += nb) {
    int r = it;
    if (r < T0) { transpose_tile(p.in[I_W_IN_EVEN], 1024, 3016, (bf16*)(ws + WS_WINE), 1, r, scr); continue; } r -= T0;
    if (r < T1) { transpose_tile(p.in[I_W_OUT_EVEN], 1024, 1024, (bf16*)(ws + WS_WOUTE), 0, r, scr); continue; } r -= T1;
    if (r < T2) { transpose_tile(p.in[I_W_IN_ODD], 1024, 4096, (bf16*)(ws + WS_WINO), 0, r, scr); continue; } r -= T2;
    if (r < T3) { transpose_tile(p.in[I_W_OUT_ODD], 1024, 1024, (bf16*)(ws + WS_WOUTO), 0, r, scr); continue; } r -= T3;
    if (r < T4) { transpose_tile(p.in[I_W_PLE_GATE], 1024, 1024, (bf16*)(ws + WS_WG0), 0, r, scr); continue; } r -= T4;
    if (r < T5) { transpose_tile(p.in[I_W_PLE_GATE] + 1024 * 1024, 1024, 1024, (bf16*)(ws + WS_WG1), 0, r, scr); continue; } r -= T5;
    if (r < T6) { transpose_tile(p.in[I_W_PLE_PROJ], 256, 1024, (bf16*)(ws + WS_WP0), 0, r, scr); continue; } r -= T6;
    transpose_tile(p.in[I_W_PLE_PROJ] + 256 * 1024, 256, 1024, (bf16*)(ws + WS_WP1), 0, r, scr);
  }
  const int gt = bid * NTHREADS + tid, ngt = nb * NTHREADS;
  { unsigned* z = (unsigned*)((bf16*)(ws + WS_WINE) + (size_t)3016 * 1024); for (int i = gt; i < 56 * 512; i += ngt) z[i] = 0u; }
  { float* ss = (float*)(ws + WS_SS); for (int i = gt; i < 3 * NTOK; i += ngt) ss[i] = 0.f; }
  { float2* tab = (float2*)(ws + WS_ROPE);
    for (int i = gt; i < SEQ * 32; i += ngt) {
      const int pos = i >> 5, k = i & 31;
      const float ang = (float)pos * p.inv_freq[k];
      double rev = (double)ang * 0.15915494309189535; rev -= floor(rev);
      const float rf = (float)rev;
      tab[i] = make_float2(__builtin_amdgcn_cosf(rf), __builtin_amdgcn_sinf(rf));
    } }
  if (bid == 0 && wid == 0) {
    const float a = wave_sum(p.in[I_LQ1][lane] * p.in[I_LK1][lane]);
    const float b = wave_sum(p.in[I_LQ2][lane] * p.in[I_LK2][lane]);
    const float lambda_init = 0.8f - 0.6f * expf(-0.3f);
    if (lane == 0) *(float*)(ws + WS_LAM) = expf(a) - expf(b) + lambda_init;
  }
  { const float* x = p.in[I_X]; const float* g = p.in[I_NORM_GAIN]; bf16* H = (bf16*)(ws + WS_ACT);
    const int gw = bid * 8 + wid, ngw = nb * 8;
    for (int m = gw; m < NTOK; m += ngw) {
      const f32x4* xr = (const f32x4*)(x + (size_t)m * DM) + lane;
      f32x4 v[4]; float s = 0.f;
#pragma unroll
      for (int j = 0; j < 4; ++j) { v[j] = xr[64 * j]; s += v[j].x * v[j].x + v[j].y * v[j].y + v[j].z * v[j].z + v[j].w * v[j].w; }
      const float rstd = rsqrtf(wave_sum(s) * (1.f / DM) + EPS);
      u32x2* o = (u32x2*)(H + (size_t)m * DM) + lane;
#pragma unroll
      for (int j = 0; j < 4; ++j) { const f32x4 gg = *((const f32x4*)g + lane + 64 * j); u32x2 w; w.x = cvtpk(v[j].x * rstd * gg.x, v[j].y * rstd * gg.y); w.y = cvtpk(v[j].z * rstd * gg.z, v[j].w * rstd * gg.w); o[64 * j] = w; }
    } }
}

constexpr int GP = 72;
constexpr int NH = 1;
constexpr int TN = 128 * NH;
constexpr int GBUF = (256 + TN) * GP * 2;
template <int AF32>
DI void gemm_acc(const void* Aptr, int lda, const bf16* Bt, int K, int m0, int n0, char* lds, f32x4 (&acc)[4][4 * NH]) {
  const int tid = threadIdx.x, lane = tid & 63, wid = tid >> 6, wm = wid & 3, wn = wid >> 2, r = lane & 15, q4 = lane >> 4;
  u32x4 ra[4], rb[2 * NH];
  const int nk = K >> 6;
#define GLOAD(k0) do { \
    _Pragma("unroll") for (int i = 0; i < 4; ++i) { const int c = tid + 512 * i, row = c >> 3, ch = c & 7; \
      if (AF32) { const float* s_ = (const float*)Aptr + (size_t)(m0 + row) * lda + (k0) + ch * 8; const f32x4 a_ = *(const f32x4*)s_, b_ = *(const f32x4*)(s_ + 4); \
        ra[i].x = cvtpk(a_.x, a_.y); ra[i].y = cvtpk(a_.z, a_.w); ra[i].z = cvtpk(b_.x, b_.y); ra[i].w = cvtpk(b_.z, b_.w); if (i & 1) asm volatile("" ::: "memory"); } \
      else ra[i] = *(const u32x4*)((const bf16*)Aptr + (size_t)(m0 + row) * lda + (k0) + ch * 8); \
      if (i < 2 * NH) rb[i] = *(const u32x4*)(Bt + (size_t)(n0 + row) * K + (k0) + ch * 8); } } while (0)
#define GSTORE(buf) do { bf16* As_ = (bf16*)(lds + (buf) * GBUF); bf16* Bs_ = As_ + 256 * GP; \
    _Pragma("unroll") for (int i = 0; i < 4; ++i) { const int c = tid + 512 * i, row = c >> 3, ch = c & 7; *(u32x4*)(As_ + row * GP + ch * 8) = ra[i]; if (i < 2 * NH) *(u32x4*)(Bs_ + row * GP + ch * 8) = rb[i]; } } while (0)
  __syncthreads();
  GLOAD(0);
  GSTORE(0);
  __syncthreads();
#pragma unroll 1
  for (int kt = 0; kt < nk; ++kt) {
    if (kt + 1 < nk) GLOAD((kt + 1) * 64);
    const bf16* As = (const bf16*)(lds + (kt & 1) * GBUF); const bf16* Bs = As + 256 * GP;
#pragma unroll
    for (int ks = 0; ks < 2; ++ks) {
      bf16x8 af[4];
#pragma unroll
      for (int i = 0; i < 4; ++i) af[i] = *(const bf16x8*)(As + (wm * 64 + i * 16 + r) * GP + ks * 32 + q4 * 8);
#pragma unroll
      for (int nh = 0; nh < NH; ++nh) {
        bf16x8 bfr[4];
#pragma unroll
        for (int i = 0; i < 4; ++i) bfr[i] = *(const bf16x8*)(Bs + (wn * 64 * NH + nh * 64 + i * 16 + r) * GP + ks * 32 + q4 * 8);
#pragma unroll
        for (int mi = 0; mi < 4; ++mi)
#pragma unroll
          for (int ni = 0; ni < 4; ++ni) acc[mi][nh * 4 + ni] = mfma16(bfr[ni], af[mi], acc[mi][nh * 4 + ni]);
      }
    }
    if (kt + 1 < nk) GSTORE((kt + 1) & 1);
    __syncthreads();
  }
#undef GLOAD
#undef GSTORE
}
DI void zero_acc(f32x4 (&acc)[4][4 * NH]) {
#pragma unroll
  for (int a = 0; a < 4; ++a)
#pragma unroll
    for (int b = 0; b < 4 * NH; ++b) acc[a][b] = (f32x4){0.f, 0.f, 0.f, 0.f};
}

enum { T_PLAIN = 0, T_NR = 1, T_ROPE = 2, T_SILU = 3, T_IW = 4 };
DI void slot_info(const Params& p, int layer, int slot, int& type, const float*& gain) {
  gain = nullptr;
  if (layer == 0) {
    if (slot < 8) { type = T_NR; gain = p.in[I_A_Q_GAIN]; }
    else if (slot == 8) { type = T_NR; gain = p.in[I_A_K_GAIN]; }
    else if (slot == 9) type = T_PLAIN;
    else if (slot < 18) type = T_ROPE;
    else if (slot == 18) { type = T_NR; gain = p.in[I_IDX_K_GAIN]; }
    else if (slot < 27) type = T_SILU;
    else if (slot < 35) { type = T_NR; gain = p.in[I_B_Q_GAIN]; }
    else if (slot < 37) { type = T_NR; gain = p.in[I_B_K_GAIN]; }
    else if (slot < 39) type = T_PLAIN;
    else if (slot < 47) type = T_SILU;
    else type = T_IW;
  } else {
    if (slot < 8) { type = T_NR; gain = p.in[I_C_Q_GAIN]; }
    else if (slot < 16) { type = T_NR; gain = p.in[I_C_K_GAIN]; }
    else if (slot < 24) type = T_PLAIN;
    else if (slot < 32) type = T_SILU;
    else if (slot < 40) { type = T_NR; gain = p.in[I_D_Q_GAIN]; }
    else if (slot < 48) { type = T_NR; gain = p.in[I_D_K_GAIN]; }
    else if (slot < 56) type = T_PLAIN;
    else type = T_SILU;
  }
}
constexpr int E_AQ = 0, E_AK = 512, E_AV = 576, E_IQ = 640, E_IK = 1152, E_AG = 1216, E_BQ = 1728, E_BK = 2240, E_BV = 2368, E_BG = 2496;
constexpr int O_CQ = 0, O_CK = 512, O_CV = 1024, O_CG = 1536, O_DQ = 2048, O_DK = 2560, O_DV = 3072, O_DG = 3584;

DI void phase_inproj(const Params& p, int layer, char* lds) {
  unsigned char* ws = p.ws;
  const int NP = layer == 0 ? NPE : NPO;
  const bf16* A = (const bf16*)(ws + (layer == 0 ? WS_ACT : WS_Y));
  const bf16* Bt = (const bf16*)(ws + (layer == 0 ? WS_WINE : WS_WINO));
  bf16* PE = (bf16*)(ws + WS_PE);
  const float2* rope = (const float2*)(ws + WS_ROPE);
  const float* ss1 = (const float*)(ws + WS_SS);
  float* IW = (float*)(ws + WS_IW);
  const int lane = threadIdx.x & 63, wid = threadIdx.x >> 6, wm = wid & 3, wn = wid >> 2, r = lane & 15, q4 = lane >> 4;
  const int nnt = NP / TN, ntiles = 64 * nnt;
  for (int tile = blockIdx.x; tile < ntiles; tile += gridDim.x) {
    const int nt = tile / 64, mt = tile % 64;
    const int m0 = mt * 256, n0 = nt * TN;
    f32x4 acc[4][4 * NH]; zero_acc(acc);
    gemm_acc<0>(A, DM, Bt, DM, m0, n0, lds, acc);
#pragma unroll
    for (int nh = 0; nh < NH; ++nh) {
    const int mbase = m0 + wm * 64, nbase = n0 + wn * 64 * NH + nh * 64, slot = nbase >> 6;
    int type; const float* gain; slot_info(p, layer, slot, type, gain);
#pragma unroll
    for (int mi = 0; mi < 4; ++mi) {
      const int m = mbase + mi * 16 + r, pos = m & (SEQ - 1);
      float sc = 1.f;
      if (layer == 1) sc = rsqrtf(ss1[m] * (1.f / DM) + EPS);
      f32x4 v[4];
#pragma unroll
      for (int ni = 0; ni < 4; ++ni) v[ni] = acc[mi][nh * 4 + ni] * sc;
      if (type == T_NR) {
        float s = 0.f;
#pragma unroll
        for (int ni = 0; ni < 4; ++ni) s += v[ni].x * v[ni].x + v[ni].y * v[ni].y + v[ni].z * v[ni].z + v[ni].w * v[ni].w;
        s += __shfl_xor(s, 16); s += __shfl_xor(s, 32);
        const float rn = rsqrtf(s * (1.f / 64.f) + EPS);
#pragma unroll
        for (int ni = 0; ni < 4; ++ni) { const f32x4 g = *(const f32x4*)(gain + ni * 16 + q4 * 4); v[ni] = v[ni] * rn * g; }
      }
      if (type == T_NR || type == T_ROPE) {
#pragma unroll
        for (int ni = 0; ni < 2; ++ni) {
          const f32x4* cs = (const f32x4*)(rope + (size_t)pos * 32 + ni * 16 + q4 * 4);
          const f32x4 c01 = cs[0], c23 = cs[1];
          const f32x4 x1 = v[ni], x2 = v[ni + 2];
          f32x4 o1, o2;
          o1.x = x1.x * c01.x - x2.x * c01.y; o2.x = x2.x * c01.x + x1.x * c01.y;
          o1.y = x1.y * c01.z - x2.y * c01.w; o2.y = x2.y * c01.z + x1.y * c01.w;
          o1.z = x1.z * c23.x - x2.z * c23.y; o2.z = x2.z * c23.x + x1.z * c23.y;
          o1.w = x1.w * c23.z - x2.w * c23.w; o2.w = x2.w * c23.z + x1.w * c23.w;
          v[ni] = o1; v[ni + 2] = o2;
        }
      }
      if (type == T_SILU) {
#pragma unroll
        for (int ni = 0; ni < 4; ++ni)
#pragma unroll
          for (int j = 0; j < 4; ++j) { const float t = v[ni][j]; v[ni][j] = t / (1.f + __expf(-t)); }
      }
      if (type == T_IW) {
        if (q4 < 2) *(f32x4*)(IW + (size_t)m * 8 + q4 * 4) = v[0];
      } else {
#pragma unroll
        for (int ni = 0; ni < 4; ++ni) { u32x2 w; w.x = cvtpk(v[ni].x, v[ni].y); w.y = cvtpk(v[ni].z, v[ni].w); *(u32x2*)(PE + (size_t)m * NP + nbase + ni * 16 + q4 * 4) = w;
          if (layer == 0 && slot == 18) { bf16* IKS = (bf16*)(ws + WS_IKS); const int key = m & (SEQ - 1);
            *(u32x2*)(IKS + ((((size_t)(m >> 13) * 256 + (key >> 5)) * 4 + ni) * 64 + (q4 >> 1) * 32 + (key & 31)) * 8 + (q4 & 1) * 4) = w; } }
      }
    }
    }
  }
}

DI void phase_outproj(const Params& p, int layer, char* lds) {
  unsigned char* ws = p.ws;
  const bf16* A = (const bf16*)(ws + WS_Y);
  const bf16* Bt = (const bf16*)(ws + (layer == 0 ? WS_WOUTE : WS_WOUTO));
  const float* xin = layer == 0 ? p.in[I_X] : p.out;
  float* out = p.out;
  bf16* XG = (bf16*)(ws + WS_ACT);
  const float* pg = p.in[I_PLE_NORM_GAIN] + layer * DM;
  float* ss = (float*)(ws + WS_SS) + (layer == 0 ? 1 : 2) * NTOK;
  const int lane = threadIdx.x & 63, wid = threadIdx.x >> 6, wm = wid & 3, wn = wid >> 2, r = lane & 15, q4 = lane >> 4;
  const int ntiles = 64 * (DM / TN);
  for (int tile = blockIdx.x; tile < ntiles; tile += gridDim.x) {
    const int nt = tile / 64, mt = tile % 64, m0 = mt * 256, n0 = nt * TN;
    f32x4 acc[4][4 * NH]; zero_acc(acc);
    gemm_acc<0>(A, DM, Bt, DM, m0, n0, lds, acc);
    const int mbase = m0 + wm * 64, nbase = n0 + wn * 64 * NH;
#pragma unroll
    for (int mi = 0; mi < 4; ++mi) {
      const int m = mbase + mi * 16 + r; float rs = 0.f;
#pragma unroll
      for (int ni = 0; ni < 4 * NH; ++ni) {
        const int n = nbase + ni * 16 + q4 * 4; const size_t off = (size_t)m * DM + n;
        const f32x4 xn = *(const f32x4*)(xin + off) + acc[mi][ni];
        *(f32x4*)(out + off) = xn;
        rs += xn.x * xn.x + xn.y * xn.y + xn.z * xn.z + xn.w * xn.w;
        const f32x4 g = *(const f32x4*)(pg + n);
        u32x2 w; w.x = cvtpk(xn.x * g.x, xn.y * g.y); w.y = cvtpk(xn.z * g.z, xn.w * g.w); *(u32x2*)(XG + off) = w;
        if (ni & 1) asm volatile("" ::: "memory");
      }
      rs += __shfl_xor(rs, 16); rs += __shfl_xor(rs, 32);
      if (q4 == 0) atomicAdd(ss + m, rs);
    }
  }
}

DI void phase_ple(const Params& p, int layer, char* lds) {
  unsigned char* ws = p.ws;
  const float* Pin = p.in[I_P] + (size_t)layer * NTOK * 256;
  const bf16* Wp = (const bf16*)(ws + (layer == 0 ? WS_WP0 : WS_WP1));
  const bf16* Wg = (const bf16*)(ws + (layer == 0 ? WS_WG0 : WS_WG1));
  const bf16* XG = (const bf16*)(ws + WS_ACT);
  float* out = p.out;
  const float* ssx = (const float*)(ws + WS_SS) + (layer == 0 ? 1 : 2) * NTOK;
  float* ss1 = (float*)(ws + WS_SS);
  bf16* H = (bf16*)(ws + WS_Y);
  float* PT = (float*)(ws + WS_PE);
  const float* ng1 = p.in[I_NORM_GAIN] + DM;
  const int lane = threadIdx.x & 63, wid = threadIdx.x >> 6, wm = wid & 3, wn = wid >> 2, r = lane & 15, q4 = lane >> 4;
  const int ntiles = 64 * (DM / TN);
  for (int tile = blockIdx.x; tile < ntiles; tile += gridDim.x) {
    const int nt = tile / 64, mt = tile % 64, m0 = mt * 256, n0 = nt * TN;
    const int mbase = m0 + wm * 64, nbase = n0 + wn * 64 * NH;
    f32x4 acc[4][4 * NH]; zero_acc(acc);
    gemm_acc<1>(Pin, 256, Wp, 256, m0, n0, lds, acc);
#pragma unroll
    for (int mi = 0; mi < 4; ++mi)
#pragma unroll
      for (int ni = 0; ni < 4 * NH; ++ni) *(f32x4*)(PT + (size_t)(mbase + mi * 16 + r) * DM + nbase + ni * 16 + q4 * 4) = acc[mi][ni];
    zero_acc(acc);
    gemm_acc<0>(XG, DM, Wg, DM, m0, n0, lds, acc);
#pragma unroll
    for (int mi = 0; mi < 4; ++mi) {
      const int m = mbase + mi * 16 + r; float rs = 0.f;
      const float rstd = rsqrtf(ssx[m] * (1.f / DM) + EPS);
#pragma unroll
      for (int ni = 0; ni < 4 * NH; ++ni) {
        const int n = nbase + ni * 16 + q4 * 4; const size_t off = (size_t)m * DM + n;
        f32x4 g;
#pragma unroll
        for (int j = 0; j < 4; ++j) g[j] = 1.f / (1.f + __expf(-rstd * acc[mi][ni][j]));
        const f32x4 xn = *(const f32x4*)(out + off) + *(const f32x4*)(PT + off) * g;
        *(f32x4*)(out + off) = xn;
        if (layer == 0) {
          rs += xn.x * xn.x + xn.y * xn.y + xn.z * xn.z + xn.w * xn.w;
          const f32x4 gg = *(const f32x4*)(ng1 + n);
          u32x2 w; w.x = cvtpk(xn.x * gg.x, xn.y * gg.y); w.y = cvtpk(xn.z * gg.z, xn.w * gg.w); *(u32x2*)(H + off) = w;
        }
        if (ni & 1) asm volatile("" ::: "memory");
      }
      if (layer == 0) { rs += __shfl_xor(rs, 16); rs += __shfl_xor(rs, 32); if (q4 == 0) atomicAdd(ss1 + m, rs); }
    }
  }
}

template <int DVB, bool MASKED = true>
DI void attn_step32(const bf16* Kt, int KP, const bf16* Vt, int VP, const bf16x8 (&qf)[4], f32x16 (&o)[DVB], float& m, float& l, unsigned vmask, float c2, int lane) {
  const int r32 = lane & 31, h = lane >> 5;
  f32x16 s;
#pragma unroll
  for (int i = 0; i < 16; ++i) s[i] = 0.f;
#pragma unroll
  for (int t = 0; t < 4; ++t) { const bf16x8 kf = *(const bf16x8*)(Kt + r32 * KP + t * 16 + h * 8); s = mfma32(kf, qf[t], s); }
  float mx = -INFINITY;
#pragma unroll
  for (int i = 0; i < 16; ++i) { if (MASKED) { s[i] = ((vmask >> i) & 1u) ? s[i] : -INFINITY; } mx = fmaxf(mx, s[i]); }
  mx = fmaxf(mx, __shfl_xor(mx, 32));
  const float mn = fmaxf(m, mx * c2);
  if (__any(mn > m)) {
    const float alpha = fexp2(m - mn); l *= alpha;
#pragma unroll
    for (int d = 0; d < DVB; ++d)
#pragma unroll
      for (int i = 0; i < 16; ++i) o[d][i] *= alpha;
    m = mn;
  }
  float ps = 0.f; const float negm = -m;
#pragma unroll
  for (int i = 0; i < 16; ++i) { const float pv = fexp2(__builtin_fmaf(s[i], c2, negm)); s[i] = pv; ps += pv; }
  l += ps;
  bf16x8 pf[2];
  { u32x4 a, b; a.x = cvtpk(s[0], s[1]); a.y = cvtpk(s[2], s[3]); a.z = cvtpk(s[4], s[5]); a.w = cvtpk(s[6], s[7]);
    b.x = cvtpk(s[8], s[9]); b.y = cvtpk(s[10], s[11]); b.z = cvtpk(s[12], s[13]); b.w = cvtpk(s[14], s[15]);
    pf[0] = __builtin_bit_cast(bf16x8, a); pf[1] = __builtin_bit_cast(bf16x8, b); }
  const int i16 = lane & 15, q = i16 >> 2, pp = i16 & 3, blk = (lane >> 4) & 1;
#pragma unroll
  for (int d = 0; d < DVB; ++d)
#pragma unroll
    for (int sk = 0; sk < 2; ++sk) {
      const s16x4 lo = trread(Vt + (16 * sk + 4 * h + q) * VP + 32 * d + 16 * blk + 4 * pp);
      const s16x4 hi = trread(Vt + (16 * sk + 8 + 4 * h + q) * VP + 32 * d + 16 * blk + 4 * pp);
      const bf16x8 vf = __builtin_shufflevector(lo, hi, 0, 1, 2, 3, 4, 5, 6, 7);
      o[d] = mfma32(vf, pf[sk], o[d]);
    }
}

constexpr int WP = 72;
constexpr int WAVE_LDS = 2 * 32 * WP * 2;

struct KVRegs { u32x4 k[4], v[4]; };
DI void kv_store(const KVRegs& R, bf16* Ks, bf16* Vs, int lane) {
#pragma unroll
  for (int i = 0; i < 4; ++i) { const int row = (lane >> 3) + 8 * i, ch = lane & 7; *(u32x4*)(Ks + row * WP + ch * 8) = R.k[i]; *(u32x4*)(Vs + row * WP + ch * 8) = R.v[i]; }
}

DI void band_load(KVRegs& R, const bf16* Kg, const bf16* Vg, int NP, int kstart, int dil, int roff, int lane) {
#pragma unroll
  for (int i = 0; i < 4; ++i) {
    const int row = (lane >> 3) + 8 * i, ch = lane & 7; int k = kstart + row; if (k < 0) k = 0;
    const size_t off = (size_t)(dil * k + roff) * NP + ch * 8;
    R.k[i] = *(const u32x4*)(Kg + off); R.v[i] = *(const u32x4*)(Vg + off);
  }
}
template <int DVB>
DI void band_run(const bf16* Kg, const bf16* Vg, int NP, int kbase, int nsteps, int dil, int roff, int qidx, int win,
                 const bf16x8 (&qf)[4], f32x16 (&o)[DVB], float& m, float& l, float c2, bf16* Ks, bf16* Vs, int lane) {
  const int h = lane >> 5;
  KVRegs R; band_load(R, Kg, Vg, NP, kbase, dil, roff, lane);
  for (int j = 0; j < nsteps; ++j) {
    lds_fence();
    kv_store(R, Ks, Vs, lane);
    lds_fence();
    if (j + 1 < nsteps) band_load(R, Kg, Vg, NP, kbase + 32 * (j + 1), dil, roff, lane);
    unsigned vm = 0;
#pragma unroll
    for (int i = 0; i < 16; ++i) { const int k = kbase + 32 * j + crow(i, h); const int dlt = qidx - k; if (k >= 0 && dlt >= 0 && dlt <= win) vm |= (1u << i); }
    attn_step32<DVB>(Ks, WP, Vs, WP, qf, o, m, l, vm, c2, lane);
  }
}

DI void write_o64(const f32x16 (&o)[2], float linv, const bf16* gate_row, bf16* y_row, int h) {
#pragma unroll
  for (int d = 0; d < 2; ++d)
#pragma unroll
    for (int g = 0; g < 4; ++g) {
      const int dd = 32 * d + 8 * g + 4 * h;
      const u32x2 gv = *(const u32x2*)(gate_row + dd);
      const float g0 = __uint_as_float(gv.x << 16), g1 = __uint_as_float(gv.x & 0xffff0000u), g2 = __uint_as_float(gv.y << 16), g3 = __uint_as_float(gv.y & 0xffff0000u);
      u32x2 w; w.x = cvtpk(o[d][4 * g] * linv * g0, o[d][4 * g + 1] * linv * g1); w.y = cvtpk(o[d][4 * g + 2] * linv * g2, o[d][4 * g + 3] * linv * g3);
      *(u32x2*)(y_row + dd) = w;
    }
}

DI void load_q(bf16x8 (&qf)[4], const bf16* qrow, int h) {
#pragma unroll
  for (int t = 0; t < 4; ++t) qf[t] = *(const bf16x8*)(qrow + t * 16 + h * 8);
}
template <int DVB> DI void zero_o(f32x16 (&o)[DVB]) {
#pragma unroll
  for (int d = 0; d < DVB; ++d)
#pragma unroll
    for (int i = 0; i < 16; ++i) o[d][i] = 0.f;
}

DI void mixerB_tile(const Params& p, int item, bf16* Ks, bf16* Vs, int lane) {
  const bf16* PE = (const bf16*)(p.ws + WS_PE); bf16* Y = (bf16*)(p.ws + WS_Y);
  const int qblk = item & 255, head = (item >> 8) & 7, b = item >> 11;
  const int r32 = lane & 31, h = lane >> 5, q0 = qblk * 32, kvh = head >> 2;
  const size_t rowb = (size_t)b * SEQ;
  bf16x8 qf[4]; load_q(qf, PE + (rowb + q0 + r32) * NPE + E_BQ + head * 64, h);
  f32x16 o[2]; zero_o<2>(o);
  const float sink2 = p.in[I_B_SINKS][head] * LOG2E;
  float m = sink2, l = (h == 0) ? 1.f : 0.f;
  band_run<2>(PE + rowb * NPE + E_BK + kvh * 64, PE + rowb * NPE + E_BV + kvh * 64, NPE, q0 - 128, 5, 1, 0, q0 + r32, 127, qf, o, m, l, 0.125f * LOG2E, Ks, Vs, lane);
  l += __shfl_xor(l, 32);
  const size_t tok = rowb + q0 + r32;
  write_o64(o, 1.f / l, PE + tok * NPE + E_BG + head * 64, Y + tok * DM + 512 + head * 64, h);
}

DI void mixerC_tile(const Params& p, int item, bf16* Ks, bf16* Vs, int lane) {
  const bf16* PO = (const bf16*)(p.ws + WS_PE); bf16* Y = (bf16*)(p.ws + WS_Y);
  const int qt = item & 15, r16 = (item >> 4) & 15, head = (item >> 8) & 7, b = item >> 11;
  const int r32 = lane & 31, h = lane >> 5, qi0 = qt * 32;
  const size_t rowb = (size_t)b * SEQ;
  const int t = 16 * (qi0 + r32) + r16;
  bf16x8 qf[4]; load_q(qf, PO + (rowb + t) * NPO + O_CQ + head * 64, h);
  f32x16 o[2]; zero_o<2>(o);
  float m = -1e30f, l = 0.f;
  const bf16* Kg = PO + rowb * NPO + O_CK + head * 64; const bf16* Vg = PO + rowb * NPO + O_CV + head * 64;
  const float c2 = 0.125f * LOG2E;
  band_run<2>(Kg, Vg, NPO, qi0 - 128, 5, 16, r16, qi0 + r32, 128, qf, o, m, l, c2, Ks, Vs, lane);
  band_run<2>(Kg, Vg, NPO, 4 * qi0 + (r16 >> 2) - 128, 8, 4, r16 & 3, 4 * (qi0 + r32) + (r16 >> 2), 128, qf, o, m, l, c2, Ks, Vs, lane);
  band_run<2>(Kg, Vg, NPO, 16 * qi0 + r16 - 128, 20, 1, 0, t, 128, qf, o, m, l, c2, Ks, Vs, lane);
  l += __shfl_xor(l, 32);
  const size_t tok = rowb + t;
  write_o64(o, 1.f / l, PO + tok * NPO + O_CG + head * 64, Y + tok * DM + head * 64, h);
}

DI void mixerA_item(const Params& p, int item, bf16* Ks, bf16* Vs, int lane) {
  const bf16* PE = (const bf16*)(p.ws + WS_PE); bf16* Y = (bf16*)(p.ws + WS_Y);
  const unsigned short* SEL = (const unsigned short*)(p.ws + WS_SEL) + (size_t)item * 256;
  const int t = item & (SEQ - 1), b = item >> 13;
  const int r32 = lane & 31, h = lane >> 5, head = r32 & 7;
  const size_t rowb = (size_t)b * SEQ;
  const int count = (t + 1 < 256) ? t + 1 : 256, nsteps = (count + 31) >> 5;
  bf16x8 qf[4]; load_q(qf, PE + (size_t)item * NPE + E_AQ + head * 64, h);
  f32x16 o[2]; zero_o<2>(o);
  float m = -1e30f, l = 0.f;
  const bf16* Kg = PE + rowb * NPE + E_AK; const bf16* Vg = PE + rowb * NPE + E_AV;
  KVRegs R;
#define A_LOAD(j) do { _Pragma("unroll") for (int i = 0; i < 4; ++i) { const int row = (lane >> 3) + 8 * i, ch = lane & 7, e = 32 * (j) + row; \
      const int tokk = (e < count) ? (int)SEL[e] : 0; const size_t off = (size_t)tokk * NPE + ch * 8; R.k[i] = *(const u32x4*)(Kg + off); R.v[i] = *(const u32x4*)(Vg + off); } } while (0)
  A_LOAD(0);
  for (int j = 0; j < nsteps; ++j) {
    lds_fence();
    kv_store(R, Ks, Vs, lane);
    lds_fence();
    if (j + 1 < nsteps) A_LOAD(j + 1);
    unsigned vm = 0;
#pragma unroll
    for (int i = 0; i < 16; ++i) if (32 * j + crow(i, h) < count) vm |= (1u << i);
    attn_step32<2>(Ks, WP, Vs, WP, qf, o, m, l, vm, 0.125f * LOG2E, lane);
  }
#undef A_LOAD
  l += __shfl_xor(l, 32);
  if (r32 < 8) write_o64(o, 1.f / l, PE + (size_t)item * NPE + E_AG + head * 64, Y + (size_t)item * DM + head * 64, h);
}

DI unsigned f2ord(float f) { f += 0.f; const unsigned u = __float_as_uint(f); return (u & 0x80000000u) ? ~u : (u | 0x80000000u); }
DI int block_excl_scan(int v, int* tmp, int* tot) {
  const int lane = threadIdx.x & 63, wid = threadIdx.x >> 6;
  int inc = v;
#pragma unroll
  for (int o = 1; o < 64; o <<= 1) { const int u = __shfl_up(inc, o); if (lane >= o) inc += u; }
  if (lane == 63) tmp[wid] = inc;
  __syncthreads();
  int base = 0, total = 0;
#pragma unroll
  for (int w = 0; w < 8; ++w) { const int x = tmp[w]; if (w < wid) base += x; total += x; }
  *tot = total;
  return base + inc - v;
}

DI float dpp_sum8(float v) {
  v += __builtin_bit_cast(float, __builtin_amdgcn_mov_dpp(__builtin_bit_cast(int, v), 0xB1, 0xF, 0xF, true));
  v += __builtin_bit_cast(float, __builtin_amdgcn_mov_dpp(__builtin_bit_cast(int, v), 0x4E, 0xF, 0xF, true));
  v += __builtin_bit_cast(float, __builtin_amdgcn_mov_dpp(__builtin_bit_cast(int, v), 0x141, 0xF, 0xF, true));
  return v;
}
DI void hist_find(const int* hist, int* misc, int need, int& digit, int& nneed, int& cnt) {
  const int tid = threadIdx.x;
  typedef int i32x4 __attribute__((ext_vector_type(4)));
  const i32x4 h0 = *(const i32x4*)(hist + tid * 8), h1 = *(const i32x4*)(hist + tid * 8 + 4);
  int hh[8] = {h0.x, h0.y, h0.z, h0.w, h1.x, h1.y, h1.z, h1.w}; int tot = 0;
#pragma unroll
  for (int k = 0; k < 8; ++k) tot += hh[k];
  int total; const int ex = block_excl_scan(tot, misc, &total);
  int above = total - ex - tot;
#pragma unroll
  for (int k = 7; k >= 0; --k) { const int c = hh[k]; if (above < need && above + c >= need) { misc[16] = tid * 8 + k; misc[17] = need - above; misc[18] = c; } above += c; }
  __syncthreads();
  digit = misc[16]; nneed = misc[17]; cnt = misc[18];
  __syncthreads();
}
DI unsigned long long mkcmp(float v, int idx) { return ((unsigned long long)f2ord(v) << 16) | ((unsigned long long)(8191 - idx) << 3); }
DI float ord2f(unsigned k) { return __uint_as_float((k & 0x80000000u) ? (k ^ 0x80000000u) : ~k); }
DI float half_sum(float v) { auto rr = __builtin_amdgcn_permlane32_swap(__float_as_uint(v), __float_as_uint(v), false, false); return __uint_as_float(rr[0]) + __uint_as_float(rr[1]); }

constexpr int CL_CAP = 512;
DI void selectA_item(const Params& p, int item, char* lds) {
  const bf16* PE = (const bf16*)(p.ws + WS_PE);
  const float* IW = (const float*)(p.ws + WS_IW);
  unsigned short* SEL = (unsigned short*)(p.ws + WS_SEL);
  float* sc = (float*)lds;
  int* hist = (int*)(lds + 4 * 8192 * 4);
  int* misc = hist + 4096;
  unsigned* mm = (unsigned*)(misc + 24);
  unsigned long long* clist = (unsigned long long*)(misc + 64);
  const int tid = threadIdx.x, lane = tid & 63, wid = tid >> 6, r32 = lane & 31, h = lane >> 5;
  const int b = item >> 11, t0 = (item & 2047) * 4;
  const size_t rowb = (size_t)b * SEQ;
  const int nk = t0 + 4, ntile = (nk + 31) >> 5;
  if (tid < 4) { mm[tid * 2] = 0xFFFFFFFFu; mm[tid * 2 + 1] = 0u; }
  __syncthreads();
  bf16x8 qf[4]; load_q(qf, PE + (rowb + t0 + (r32 >> 3)) * NPE + E_IQ + (r32 & 7) * 64, h);
  float wq[16];
#pragma unroll
  for (int i = 0; i < 16; ++i) wq[i] = IW[(rowb + t0 + (i >> 2)) * 8 + (i & 3) + 4 * h] * 0.04419417382415922f;
  const bf16* Kt = (const bf16*)(p.ws + WS_IKS) + (size_t)b * 256 * 2048 + lane * 8;
  {
    bf16x8 kf[4], kn[4];
#pragma unroll
    for (int t = 0; t < 4; ++t) { kf[t] = (bf16x8){0, 0, 0, 0, 0, 0, 0, 0}; kn[t] = kf[t]; }
    if (wid < ntile) {
#pragma unroll
      for (int t = 0; t < 4; ++t) kf[t] = *(const bf16x8*)(Kt + (size_t)wid * 2048 + t * 512);
    }
    float lo0 = INFINITY, hi0 = -INFINITY, lo1 = INFINITY, hi1 = -INFINITY;
    for (int kt = wid; kt < ntile; kt += 8) {
      if (kt + 8 < ntile) {
#pragma unroll
        for (int t = 0; t < 4; ++t) kn[t] = *(const bf16x8*)(Kt + (size_t)(kt + 8) * 2048 + t * 512);
      }
      f32x16 s;
#pragma unroll
      for (int i = 0; i < 16; ++i) s[i] = 0.f;
#pragma unroll
      for (int t = 0; t < 4; ++t) s = mfma32(qf[t], kf[t], s);
      float v[4];
#pragma unroll
      for (int q = 0; q < 4; ++q) {
        float a = wq[4 * q] * fmaxf(s[4 * q], 0.f);
#pragma unroll
        for (int jj = 1; jj < 4; ++jj) a += wq[4 * q + jj] * fmaxf(s[4 * q + jj], 0.f);
        v[q] = half_sum(a) + 0.f;
      }
      const float va = h ? v[2] : v[0], vb = h ? v[3] : v[1];
      const int key = kt * 32 + r32;
      sc[(2 * h) * 8192 + key] = va; sc[(2 * h + 1) * 8192 + key] = vb;
      lo0 = fminf(lo0, va); hi0 = fmaxf(hi0, va); lo1 = fminf(lo1, vb); hi1 = fmaxf(hi1, vb);
#pragma unroll
      for (int t = 0; t < 4; ++t) kf[t] = kn[t];
    }
    if (wid < ntile) {
#pragma unroll
      for (int o = 1; o < 32; o <<= 1) { lo0 = fminf(lo0, __shfl_xor(lo0, o)); hi0 = fmaxf(hi0, __shfl_xor(hi0, o)); lo1 = fminf(lo1, __shfl_xor(lo1, o)); hi1 = fmaxf(hi1, __shfl_xor(hi1, o)); }
      if (r32 == 0) { atomicMin(&mm[(2 * h) * 2], f2ord(lo0)); atomicMax(&mm[(2 * h) * 2 + 1], f2ord(hi0)); atomicMin(&mm[(2 * h + 1) * 2], f2ord(lo1)); atomicMax(&mm[(2 * h + 1) * 2 + 1], f2ord(hi1)); }
    }
  }
  __syncthreads();
  for (int q = 0; q < 4; ++q) {
    const int t = t0 + q, n = t + 1;
    unsigned short* out = SEL + (rowb + t) * 256;
    if (n <= 256) { if (tid < n) out[tid] = (unsigned short)tid; continue; }
    const float* scq = sc + q * 8192;
    const float lo = ord2f(mm[q * 2]), hi = ord2f(mm[q * 2 + 1]);
    const float scale = (hi > lo) ? 4095.f / (hi - lo) : 0.f;
    for (int i = tid; i < 4096; i += 512) hist[i] = 0;
    if (tid == 0) misc[20] = 0;
    __syncthreads();
    float val[16]; int bin[16];
#pragma unroll
    for (int i = 0; i < 16; ++i) { const int idx = tid + 512 * i; const float v = (idx < n) ? scq[idx] : lo; val[i] = v;
      int bb = (int)((v - lo) * scale); bb = bb < 0 ? 0 : (bb > 4095 ? 4095 : bb); bin[i] = bb; if (idx < n) atomicAdd(&hist[bb], 1); }
    __syncthreads();
    int bstar, need, cnt;
    hist_find(hist, misc, 256, bstar, need, cnt);
    unsigned long long T = 0ull;
    if (cnt != need) {
      if (cnt <= CL_CAP) {
#pragma unroll
        for (int i = 0; i < 16; ++i) { const int idx = tid + 512 * i; if (idx < n && bin[i] == bstar) { const int slot = atomicAdd(&misc[20], 1); clist[slot] = mkcmp(val[i], idx); } }
        __syncthreads();
        if (tid < cnt) { const unsigned long long c = clist[tid]; int rank = 0; for (int jx = 0; jx < cnt; ++jx) rank += (clist[jx] > c) ? 1 : 0;
          if (rank == need - 1) { misc[21] = (int)(unsigned)(c & 0xffffffffull); misc[22] = (int)(unsigned)(c >> 32); } }
        __syncthreads();
        T = ((unsigned long long)(unsigned)misc[22] << 32) | (unsigned long long)(unsigned)misc[21];
      } else {
        unsigned long long prefix = 0ull; int shift = 36;
        for (int pass = 0; pass < 4; ++pass) {
          for (int i = tid; i < 4096; i += 512) hist[i] = 0;
          __syncthreads();
#pragma unroll
          for (int i = 0; i < 16; ++i) { const int idx = tid + 512 * i; if (idx < n && bin[i] == bstar) { const unsigned long long c = mkcmp(val[i], idx); if (pass == 0 || (c >> (shift + 12)) == prefix) atomicAdd(&hist[(int)((c >> shift) & 4095ull)], 1); } }
          __syncthreads();
          int digit, nneed, c2;
          hist_find(hist, misc, need, digit, nneed, c2);
          prefix = (prefix << 12) | (unsigned long long)digit; need = nneed;
          if (c2 == need) break;
          shift -= 12;
        }
        T = prefix << shift;
      }
    }
    int mycnt = 0; unsigned selm = 0;
#pragma unroll
    for (int i = 0; i < 16; ++i) { const int idx = tid + 512 * i;
      bool sel = false;
      if (idx < n) { if (bin[i] > bstar) sel = true; else if (bin[i] == bstar) sel = (mkcmp(val[i], idx) >= T); }
      if (sel) { ++mycnt; selm |= (1u << i); } }
    int total; int pos = block_excl_scan(mycnt, misc + 8, &total);
#pragma unroll
    for (int i = 0; i < 16; ++i) { if ((selm >> i) & 1u) { if (pos < 256) out[pos] = (unsigned short)(tid + 512 * i); ++pos; } }
    __syncthreads();
  }
  __syncthreads();
}

constexpr int DKP = 72, DVP = 136;
constexpr int D_STAGE = (64 * DKP * 2 + 64 * DVP) * 2;
DI void mixerD_unit(const Params& p, int b, int head, int qb, char* lds) {
  const bf16* PO = (const bf16*)(p.ws + WS_PE); bf16* Y = (bf16*)(p.ws + WS_Y);
  const int tid = threadIdx.x, lane = tid & 63, wid = tid >> 6, r32 = lane & 31, h = lane >> 5;
  const int map = wid & 1, qsub = wid >> 1;
  const size_t rowb = (size_t)b * SEQ;
  const int qpos = 128 * qb + 32 * qsub + r32;
  bf16x8 qf[4]; load_q(qf, PO + (rowb + qpos) * NPO + O_DQ + (2 * head + map) * 64, h);
  f32x16 o[4]; zero_o<4>(o);
  float m = -1e30f, l = 0.f;
  const int nsteps = 2 * qb + 2;
  const bf16* K1g = PO + rowb * NPO + O_DK + (2 * head) * 64;
  const bf16* K2g = K1g + 64;
  const bf16* Vg = PO + rowb * NPO + O_DV + head * 128;
  u32x4 rk1, rk2, rv[2];
#define D_LOAD(j) do { const int row = tid >> 3, ch = tid & 7; const size_t off = (size_t)((j) * 64 + row) * NPO + ch * 8; rk1 = *(const u32x4*)(K1g + off); rk2 = *(const u32x4*)(K2g + off); \
    _Pragma("unroll") for (int i = 0; i < 2; ++i) { const int c = tid + 512 * i, vr = c >> 4, vc = c & 15; rv[i] = *(const u32x4*)(Vg + (size_t)((j) * 64 + vr) * NPO + vc * 8); } } while (0)
  __syncthreads();
  D_LOAD(0);
  for (int j = 0; j < nsteps; ++j) {
    char* st = lds + (j & 1) * D_STAGE;
    bf16* K1s = (bf16*)st; bf16* K2s = K1s + 64 * DKP; bf16* Vs = K2s + 64 * DKP;
    { const int row = tid >> 3, ch = tid & 7; *(u32x4*)(K1s + row * DKP + ch * 8) = rk1; *(u32x4*)(K2s + row * DKP + ch * 8) = rk2;
#pragma unroll
      for (int i = 0; i < 2; ++i) { const int c = tid + 512 * i, vr = c >> 4, vc = c & 15; *(u32x4*)(Vs + vr * DVP + vc * 8) = rv[i]; } }
    __syncthreads();
    if (j + 1 < nsteps) D_LOAD(j + 1);
    const bf16* Ks = map ? K2s : K1s;
#pragma unroll
    for (int sub = 0; sub < 2; ++sub) {
      const int k0 = j * 64 + sub * 32;
      if (k0 <= 128 * qb + 32 * qsub + 31) {
        if (k0 + 31 <= 128 * qb + 32 * qsub) {
          attn_step32<4, false>(Ks + sub * 32 * DKP, DKP, Vs + sub * 32 * DVP, DVP, qf, o, m, l, 0xffffu, 0.125f * LOG2E, lane);
        } else {
          unsigned vm = 0;
#pragma unroll
          for (int i = 0; i < 16; ++i) if (k0 + crow(i, h) <= qpos) vm |= (1u << i);
          attn_step32<4, true>(Ks + sub * 32 * DKP, DKP, Vs + sub * 32 * DVP, DVP, qf, o, m, l, vm, 0.125f * LOG2E, lane);
        }
      }
    }
  }
#undef D_LOAD
  l += __shfl_xor(l, 32);
  const float linv = 1.f / l;
  __syncthreads();
  float* xch = (float*)lds + qsub * 4096;
  if (map == 1) {
#pragma unroll
    for (int d = 0; d < 4; ++d)
#pragma unroll
      for (int i = 0; i < 16; ++i) xch[(d * 16 + i) * 64 + lane] = o[d][i] * linv;
  }
  __syncthreads();
  if (map == 0) {
    const float lam = *(const float*)(p.ws + WS_LAM);
    float ssq = 0.f;
#pragma unroll
    for (int d = 0; d < 4; ++d)
#pragma unroll
      for (int i = 0; i < 16; ++i) { const float a = o[d][i] * linv - lam * xch[(d * 16 + i) * 64 + lane]; o[d][i] = a; ssq += a * a; }
    ssq += __shfl_xor(ssq, 32);
    const float lambda_init = 0.8f - 0.6f * expf(-0.3f);
    const float rn = rsqrtf(ssq * (1.f / 128.f) + EPS) * (1.f - lambda_init);
    const size_t tok = rowb + qpos;
    const bf16* gate = PO + tok * NPO + O_DG + head * 128;
    bf16* y = Y + tok * DM + 512 + head * 128;
    const float* sg = p.in[I_SUB_GAIN];
#pragma unroll
    for (int d = 0; d < 4; ++d)
#pragma unroll
      for (int g = 0; g < 4; ++g) {
        const int dd = 32 * d + 8 * g + 4 * h;
        const u32x2 gv = *(const u32x2*)(gate + dd); const f32x4 s4 = *(const f32x4*)(sg + dd);
        const float g0 = __uint_as_float(gv.x << 16), g1 = __uint_as_float(gv.x & 0xffff0000u), g2 = __uint_as_float(gv.y << 16), g3 = __uint_as_float(gv.y & 0xffff0000u);
        u32x2 w; w.x = cvtpk(o[d][4 * g] * rn * s4.x * g0, o[d][4 * g + 1] * rn * s4.y * g1); w.y = cvtpk(o[d][4 * g + 2] * rn * s4.z * g2, o[d][4 * g + 3] * rn * s4.w * g3);
        *(u32x2*)(y + dd) = w;
      }
  }
  __syncthreads();
}

__global__ void __launch_bounds__(NTHREADS) fwd_kernel(Params p) {
  extern __shared__ __attribute__((aligned(16))) char smem[];
  cg::grid_group grid = cg::this_grid();
  char* lds = smem;
  const int tid = threadIdx.x, lane = tid & 63, wid = tid >> 6;
  const int gw = blockIdx.x * 8 + wid, ngw = gridDim.x * 8;
  bf16* Ks = (bf16*)(lds + wid * WAVE_LDS); bf16* Vs = Ks + 32 * WP;

  phase_prologue(p, lds);
  grid.sync();
  for (int rep = 0; rep < REP_GEMM; ++rep) phase_inproj(p, 0, lds);
  grid.sync();
#if EN_A
  for (int rep = 0; rep < REP_SELA; ++rep) for (int it = blockIdx.x; it < 2 * 2048; it += gridDim.x) selectA_item(p, it, lds);
  grid.sync();
  for (int rep = 0; rep < REP_AATT; ++rep) for (int it = gw; it < NTOK; it += ngw) mixerA_item(p, it, Ks, Vs, lane);
#else
  { unsigned* y = (unsigned*)(p.ws + WS_Y); for (int i = blockIdx.x * NTHREADS + tid; i < NTOK * 256; i += gridDim.x * NTHREADS) { const int row = i >> 8, c = i & 255; y[row * 512 + c] = 0u; } }
#endif
#if EN_B
  for (int it = gw; it < 4096; it += ngw) mixerB_tile(p, it, Ks, Vs, lane);
#else
  { unsigned* y = (unsigned*)(p.ws + WS_Y); for (int i = blockIdx.x * NTHREADS + tid; i < NTOK * 256; i += gridDim.x * NTHREADS) { const int row = i >> 8, c = i & 255; y[row * 512 + 256 + c] = 0u; } }
#endif
  grid.sync();
  phase_outproj(p, 0, lds);
  grid.sync();
  phase_ple(p, 0, lds);
  grid.sync();
  phase_inproj(p, 1, lds);
  grid.sync();
#if EN_D
  for (int rep = 0; rep < REP_D; ++rep) {
#pragma unroll 1
    for (int u2 = blockIdx.x * 2; u2 < 512; u2 += gridDim.x * 2) {
#pragma unroll 1
      for (int k = 0; k < 2; ++k) { const int u = u2 >> 1, bh = u >> 5, pr = u & 31; mixerD_unit(p, bh >> 2, bh & 3, k ? 63 - pr : pr, lds); }
    }
  }
#else
  { unsigned* y = (unsigned*)(p.ws + WS_Y); for (int i = blockIdx.x * NTHREADS + tid; i < NTOK * 256; i += gridDim.x * NTHREADS) { const int row = i >> 8, c = i & 255; y[row * 512 + 256 + c] = 0u; } }
#endif
#if EN_C
  __syncthreads();
  for (int rep = 0; rep < REP_C; ++rep) for (int it = gw; it < 4096; it += ngw) mixerC_tile(p, it, Ks, Vs, lane);
#else
  { unsigned* y = (unsigned*)(p.ws + WS_Y); for (int i = blockIdx.x * NTHREADS + tid; i < NTOK * 256; i += gridDim.x * NTHREADS) { const int row = i >> 8, c = i & 255; y[row * 512 + c] = 0u; } }
#endif
  grid.sync();
  phase_outproj(p, 1, lds);
  grid.sync();
  phase_ple(p, 1, lds);
}

extern "C" void kernel_launch(void* const* d_in, const int* in_sizes, int n_in, void* d_out, int out_size, void* d_ws, size_t ws_size, hipStream_t stream) {
  static int grid_blocks = 0;
  if (!grid_blocks) {
    int dev = 0, cus = 0, per_cu = 0;
    hipGetDevice(&dev);
    hipDeviceGetAttribute(&cus, hipDeviceAttributeMultiprocessorCount, dev);
    hipFuncSetAttribute((const void*)fwd_kernel, hipFuncAttributeMaxDynamicSharedMemorySize, LDS_BYTES);
    hipOccupancyMaxActiveBlocksPerMultiprocessor(&per_cu, (const void*)fwd_kernel, NTHREADS, LDS_BYTES);
    if (per_cu < 1) per_cu = 1;
    grid_blocks = cus * per_cu;
    if (grid_blocks > 256) grid_blocks = 256;
  }
  Params p{};
  for (int i = 0; i < 25; ++i) p.in[i] = (const float*)d_in[i];
  p.out = (float*)d_out; p.ws = (unsigned char*)d_ws;
  for (int i = 0; i < 32; ++i) p.inv_freq[i] = (float)pow(10000.0, -(double)i / 32.0);
  void* args[] = {&p};
  hipError_t e = hipLaunchCooperativeKernel((const void*)fwd_kernel, dim3(grid_blocks), dim3(NTHREADS), args, LDS_BYTES, stream);
  if (e != hipSuccess) fprintf(stderr, "cooperative launch failed: %s (grid %d)\n", hipGetErrorString(e), grid_blocks);
}
```

```cpp
#include <hip/hip_runtime.h>
#include <hip/hip_cooperative_groups.h>
#include <cstdio>
#include <cmath>
namespace cg = cooperative_groups;

#ifndef REP_GEMM
#define REP_GEMM 1
#endif
#ifndef REP_SELA
#define REP_SELA 1
#endif
#ifndef REP_D
#define REP_D 1
#endif
#ifndef REP_C
#define REP_C 1
#endif
#ifndef REP_AATT
#define REP_AATT 1
#endif
#ifndef EN_A
#define EN_A 1
#endif
#ifndef EN_B
#define EN_B 1
#endif
#ifndef EN_C
#define EN_C 1
#endif
#ifndef EN_D
#define EN_D 1
#endif

typedef unsigned short bf16;
typedef short bf16x8 __attribute__((ext_vector_type(8)));
typedef short s16x4 __attribute__((ext_vector_type(4)));
typedef float f32x4 __attribute__((ext_vector_type(4)));
typedef float f32x16 __attribute__((ext_vector_type(16)));
typedef unsigned u32x4 __attribute__((ext_vector_type(4)));
typedef unsigned u32x2 __attribute__((ext_vector_type(2)));
typedef float f32x2_t __attribute__((ext_vector_type(2)));
typedef __bf16 bf16x2_t __attribute__((ext_vector_type(2)));
#define LAS __attribute__((address_space(3)))
#define DI __device__ __forceinline__

constexpr int SEQ = 8192, NTOK = 16384, DM = 1024;
constexpr int NPE = 3072, NPO = 4096;
constexpr float EPS = 1e-6f;
constexpr float LOG2E = 1.4426950408889634f;
constexpr int NTHREADS = 512;
constexpr int LDS_BYTES = 150 * 1024;

constexpr size_t MiB = 1u << 20;
constexpr size_t WS_PE = 0;
constexpr size_t WS_ACT = 128 * MiB;
constexpr size_t WS_Y = 160 * MiB;
constexpr size_t WS_WINE = 192 * MiB;
constexpr size_t WS_WOUTE = 198 * MiB;
constexpr size_t WS_WINO = 200 * MiB;
constexpr size_t WS_WOUTO = 208 * MiB;
constexpr size_t WS_WG0 = 210 * MiB;
constexpr size_t WS_WG1 = 212 * MiB;
constexpr size_t WS_WP0 = 214 * MiB;
constexpr size_t WS_WP1 = 215 * MiB;
constexpr size_t WS_ROPE = 216 * MiB;
constexpr size_t WS_SEL = 218 * MiB;
constexpr size_t WS_IW = 226 * MiB;
constexpr size_t WS_SS = 227 * MiB;
constexpr size_t WS_LAM = 228 * MiB;
constexpr size_t WS_PBF = 232 * MiB;
constexpr size_t WS_IKS = 229 * MiB;

struct Params {
  const float* in[25];
  float* out;
  unsigned char* ws;
  float inv_freq[32];
};
enum { I_X = 0, I_P, I_NORM_GAIN, I_W_IN_EVEN, I_W_OUT_EVEN, I_A_Q_GAIN, I_A_K_GAIN, I_IDX_K_GAIN, I_B_Q_GAIN, I_B_K_GAIN, I_B_SINKS,
       I_W_IN_ODD, I_W_OUT_ODD, I_C_Q_GAIN, I_C_K_GAIN, I_D_Q_GAIN, I_D_K_GAIN, I_LQ1, I_LK1, I_LQ2, I_LK2, I_SUB_GAIN, I_PLE_NORM_GAIN,
       I_W_PLE_GATE, I_W_PLE_PROJ };

DI unsigned cvtpk(float lo, float hi) { f32x2_t v = {lo, hi}; bf16x2_t b = __builtin_convertvector(v, bf16x2_t); return __builtin_bit_cast(unsigned, b); }
DI float bf2f(bf16 b) { return __uint_as_float(((unsigned)b) << 16); }
DI float fexp2(float x) { return __builtin_amdgcn_exp2f(x); }
DI f32x16 mfma32(bf16x8 a, bf16x8 b, f32x16 c) { return __builtin_amdgcn_mfma_f32_32x32x16_bf16(a, b, c, 0, 0, 0); }
DI f32x4 mfma16(bf16x8 a, bf16x8 b, f32x4 c) { return __builtin_amdgcn_mfma_f32_16x16x32_bf16(a, b, c, 0, 0, 0); }
DI int crow(int i, int h) { return (i & 3) + 8 * (i >> 2) + 4 * h; }
DI s16x4 trread(const bf16* p) { return __builtin_bit_cast(s16x4, __builtin_amdgcn_ds_read_tr16_b64_v4i16((LAS s16x4*)p)); }
DI int opaque_tid() { int t = threadIdx.x; asm volatile("" : "+v"(t)); return t; }
DI void lds_fence() { asm volatile("s_waitcnt lgkmcnt(0)" ::: "memory"); __builtin_amdgcn_wave_barrier(); }

__host__ __device__ __forceinline__ int phys_col(int n) { return (n & ~255) + 128 * ((n >> 5) & 1) + 32 * ((n >> 6) & 3) + (n & 31); }
DI int map_even(int n) { return n < 1216 ? n : (n < 1224 ? 3008 + (n - 1216) : n - 8); }
DI void transpose_tile(const float* W, int K, int N, bf16* WT, int mapmode, int tile, float* scr) {
  const int tid = opaque_tid();
  const int ntn = (N + 63) >> 6, kt = tile / ntn, nt = tile % ntn, k0 = kt * 64, n0 = nt * 64;
#pragma unroll
  for (int i = 0; i < 8; ++i) {
    const int kk = (tid >> 6) + 8 * i, nn = tid & 63, n = n0 + nn;
    scr[kk * 65 + nn] = (n < N) ? W[(size_t)(k0 + kk) * N + n] : 0.f;
  }
  __syncthreads();
  {
    const int nn = tid >> 3, kc = tid & 7, n = n0 + nn;
    if (n < N) {
      const int dst = mapmode == 1 ? phys_col(map_even(n)) : (mapmode == 2 ? phys_col(n) : n);
      const float* s = scr + (kc * 8) * 65 + nn;
      u32x4 o; o.x = cvtpk(s[0], s[65]); o.y = cvtpk(s[2 * 65], s[3 * 65]); o.z = cvtpk(s[4 * 65], s[5 * 65]); o.w = cvtpk(s[6 * 65], s[7 * 65]);
      *(u32x4*)(WT + (size_t)dst * K + k0 + kc * 8) = o;
    }
  }
  __syncthreads();
}

DI float wave_sum(float v) {
#pragma unroll
  for (int o = 1; o < 64; o <<= 1) v += __shfl_xor(v, o);
  return v;
}

DI void phase_prologue(const Params& p, char* lds) {
  const int tid = opaque_tid(), lane = tid & 63, wid = tid >> 6;
  const int nb = gridDim.x, bid = blockIdx.x;
  unsigned char* ws = p.ws;
  float* scr = (float*)lds;
  const int T0 = 16 * 48, T1 = 256, T2 = 16 * 64, T3 = 256, T4 = 256, T5 = 256, T6 = 64, T7 = 64;
  const int NT = T0 + T1 + T2 + T3 + T4 + T5 + T6 + T7;
  for (int it = bid; it < NT; it += nb) {
    int r = it;
    if (r < T0) { transpose_tile(p.in[I_W_IN_EVEN], 1024, 3016, (bf16*)(ws + WS_WINE), 1, r, scr); continue; } r -= T0;
    if (r < T1) { transpose_tile(p.in[I_W_OUT_EVEN], 1024, 1024, (bf16*)(ws + WS_WOUTE), 0, r, scr); continue; } r -= T1;
    if (r < T2) { transpose_tile(p.in[I_W_IN_ODD], 1024, 4096, (bf16*)(ws + WS_WINO), 2, r, scr); continue; } r -= T2;
    if (r < T3) { transpose_tile(p.in[I_W_OUT_ODD], 1024, 1024, (bf16*)(ws + WS_WOUTO), 0, r, scr); continue; } r -= T3;
    if (r < T4) { transpose_tile(p.in[I_W_PLE_GATE], 1024, 1024, (bf16*)(ws + WS_WG0), 0, r, scr); continue; } r -= T4;
    if (r < T5) { transpose_tile(p.in[I_W_PLE_GATE] + 1024 * 1024, 1024, 1024, (bf16*)(ws + WS_WG1), 0, r, scr); continue; } r -= T5;
    if (r < T6) { transpose_tile(p.in[I_W_PLE_PROJ], 256, 1024, (bf16*)(ws + WS_WP0), 0, r, scr); continue; } r -= T6;
    transpose_tile(p.in[I_W_PLE_PROJ] + 256 * 1024, 256, 1024, (bf16*)(ws + WS_WP1), 0, r, scr);
  }
  const int gt = bid * NTHREADS + tid, ngt = nb * NTHREADS;
  { unsigned* z = (unsigned*)(ws + WS_WINE); for (int i = gt; i < 56 * 512; i += ngt) z[(size_t)phys_col(3016 + (i >> 9)) * 512 + (i & 511)] = 0u; }
  { const f32x4* src = (const f32x4*)p.in[I_P]; u32x2* dst = (u32x2*)(ws + WS_PBF); for (int i = gt; i < 2 * NTOK * 256 / 4; i += ngt) { const f32x4 v = src[i]; u32x2 w; w.x = cvtpk(v.x, v.y); w.y = cvtpk(v.z, v.w); dst[i] = w; } }
  { float* ss = (float*)(ws + WS_SS); for (int i = gt; i < 3 * NTOK; i += ngt) ss[i] = 0.f; }
  { float2* tab = (float2*)(ws + WS_ROPE);
    for (int i = gt; i < SEQ * 32; i += ngt) {
      const int pos = i >> 5, k = i & 31;
      const float ang = (float)pos * p.inv_freq[k];
      double rev = (double)ang * 0.15915494309189535; rev -= floor(rev);
      const float rf = (float)rev;
      tab[i] = make_float2(__builtin_amdgcn_cosf(rf), __builtin_amdgcn_sinf(rf));
    } }
  if (bid == 0 && wid == 0) {
    const float a = wave_sum(p.in[I_LQ1][lane] * p.in[I_LK1][lane]);
    const float b = wave_sum(p.in[I_LQ2][lane] * p.in[I_LK2][lane]);
    const float lambda_init = 0.8f - 0.6f * expf(-0.3f);
    if (lane == 0) *(float*)(ws + WS_LAM) = expf(a) - expf(b) + lambda_init;
  }
  { const float* x = p.in[I_X]; const float* g = p.in[I_NORM_GAIN]; bf16* H = (bf16*)(ws + WS_ACT);
    const int gw = bid * 8 + wid, ngw = nb * 8;
    for (int m = gw; m < NTOK; m += ngw) {
      const f32x4* xr = (const f32x4*)(x + (size_t)m * DM) + lane;
      f32x4 v[4]; float s = 0.f;
#pragma unroll
      for (int j = 0; j < 4; ++j) { v[j] = xr[64 * j]; s += v[j].x * v[j].x + v[j].y * v[j].y + v[j].z * v[j].z + v[j].w * v[j].w; }
      const float rstd = rsqrtf(wave_sum(s) * (1.f / DM) + EPS);
      u32x2* o = (u32x2*)(H + (size_t)m * DM) + lane;
#pragma unroll
      for (int j = 0; j < 4; ++j) { const f32x4 gg = *((const f32x4*)g + lane + 64 * j); u32x2 w; w.x = cvtpk(v[j].x * rstd * gg.x, v[j].y * rstd * gg.y); w.y = cvtpk(v[j].z * rstd * gg.z, v[j].w * rstd * gg.w); o[64 * j] = w; }
    } }
}

namespace pg8 {
#define PG8_LAS __attribute__((address_space(3)))
typedef unsigned short bf16_t;
typedef short bf16x8 __attribute__((ext_vector_type(8)));
typedef float f32x4 __attribute__((ext_vector_type(4)));
typedef unsigned u32x4 __attribute__((ext_vector_type(4)));
constexpr int BM = 256, BK = 64, HALF = 128, HTB = HALF * BK * 2  , STAGE_BYTES = 8 * HTB, NXCD = 8, WGM = 8;

__host__ __device__ __forceinline__ int lds_byte(int r, int c) { const int st = (r >> 4) * 2 + (c >> 5), rr = r & 15, cc = c & 31, ob = rr * 64 + cc * 2; return st * 1024 + (ob ^ (((ob >> 9) & 1) << 5)); }
__host__ __device__ __forceinline__ void stage_rc(int b, int& R, int& C) { const int st = b / 1024, sb = b % 1024, swz = sb ^ (((sb >> 9) & 1) << 5); R = (st >> 1) * 16 + swz / 64; C = (st & 1) * 32 + (swz % 64) / 2; }
__host__ __device__ __forceinline__ int perm32(int rho) { const int n = rho >> 4, i = rho & 15; return 8 * (i >> 2) + 4 * n + (i & 3); }

struct Unit { int pm, pn; };
struct Gemm { const bf16_t* A; const bf16_t* Bt; int M, N, K; };

struct StaticOrder {
    int nM, nN, nwg, G, c;
    __host__ __device__ void init(int M, int N, int G_, int c_) { nM = M / BM; nN = N / BM; nwg = nM * nN; G = G_; c = c_; }
    __host__ __device__ bool next(int i, Unit& u) const {
        const long L = (long)i * G + c; if (L >= nwg) return false;
        int wgid = (int)L; { const int q = nwg / NXCD, r = nwg % NXCD, xcd = wgid % NXCD, off = wgid / NXCD; wgid = (xcd < r ? xcd * (q + 1) : r * (q + 1) + (xcd - r) * q) + off; }
        const int nig = WGM * nN, gid = wgid / nig, fm = gid * WGM, gsz = (nM - fm) < WGM ? (nM - fm) : WGM;
        u.pm = fm + ((wgid % nig) % gsz); u.pn = (wgid % nig) / gsz; return true;
    }
    __device__ __forceinline__ void a_ready(const Unit&) const {}
    __device__ __forceinline__ void done(const Unit&) const {}
};
__device__ __forceinline__ unsigned cvt_pk_bf16(float lo, float hi) { unsigned r; asm volatile("v_cvt_pk_bf16_f32 %0, %1, %2" : "=v"(r) : "v"(lo), "v"(hi)); return r; }
template <class Epi, class Sched, bool ALIGN_EPI = false, bool SP2 = false>
__device__ __forceinline__ void gemm_phase(PG8_LAS unsigned char* lds, const Gemm g, const Sched& S, const Epi& E) {
    int tid_ = threadIdx.x; asm volatile("" : "+v"(tid_));
    const int tid = tid_, wid = __builtin_amdgcn_readfirstlane(tid >> 6), lane = tid & 63, wr = wid >> 2, wc = wid & 3, fr = lane & 15, fq = lane >> 4;
    const int K = g.K, nt = K / BK;
    unsigned voffA[2], voffB[2];
#pragma unroll
    for (int i = 0; i < 2; ++i) { int R, C; stage_rc(tid * 16 + i * 8192, R, C); const int Rb = Epi::PERM ? ((R & ~31) + perm32(R & 31)) : R;
        voffA[i] = (unsigned)(R * K + C) * 2u; voffB[i] = (unsigned)(Rb * K + C) * 2u; }
    const size_t kstep = (size_t)(BK * 2);
    const size_t hstep = (size_t)HALF * K * 2;
    const size_t tstep = 2 * hstep;
    const unsigned ldsw = (unsigned)wid * 1024u;
    const int aoff = lds_byte(wr * 64 + fr, fq * 8), boff = lds_byte(wc * 32 + fr, fq * 8);
#define PG8_SA(b, h) (((b) * 2 + (h)) * HTB)
#define PG8_SB(b, h) ((4 + (b) * 2 + (h)) * HTB)
#define PG8_STAGE(bufoff, gbase, voff) do { _Pragma("unroll") for (int _i = 0; _i < 2; ++_i) \
        __builtin_amdgcn_global_load_lds((const unsigned*)((const char*)(gbase) + (voff)[_i]), (PG8_LAS unsigned*)(lds + (bufoff) + ldsw + _i * 8192), 16, 0, 0); } while (0)
#define PG8_LDA(dst, b, h) do { _Pragma("unroll") for (int m = 0; m < 4; ++m) _Pragma("unroll") for (int k = 0; k < 2; ++k) dst[m][k] = *(const PG8_LAS bf16x8*)(lds + PG8_SA(b, h) + aoff + m * 2048 + k * 1024); } while (0)
#define PG8_LDB(dst, b, h) do { _Pragma("unroll") for (int n = 0; n < 2; ++n) _Pragma("unroll") for (int k = 0; k < 2; ++k) dst[n][k] = *(const PG8_LAS bf16x8*)(lds + PG8_SB(b, h) + boff + n * 2048 + k * 1024); } while (0)
#define PG8_MMA(ai, bj, At, Bt) do { __builtin_amdgcn_s_setprio(1); _Pragma("unroll") for (int m = 0; m < 4; ++m) _Pragma("unroll") for (int n = 0; n < 2; ++n) _Pragma("unroll") for (int k = 0; k < 2; ++k) \
        acc[ai][bj][m][n] = __builtin_amdgcn_mfma_f32_16x16x32_bf16(Bt[n][k], At[m][k], acc[ai][bj][m][n], 0, 0, 0); __builtin_amdgcn_s_setprio(0); } while (0)
#define PG8_WAIT_V(n) asm volatile("s_waitcnt vmcnt(" #n ")" ::: "memory")
#define PG8_WAIT_L(n) asm volatile("s_waitcnt lgkmcnt(" #n ")" ::: "memory")
#define PG8_BAR __builtin_amdgcn_s_barrier()
#define PG8_SCHED __builtin_amdgcn_sched_barrier(0)
    Unit cur, nxt; int ui = 0;
    if (!S.next(0, cur)) return;
    f32x4 acc[2][2][4][2];
#pragma unroll
    for (int a = 0; a < 2; ++a)
#pragma unroll
        for (int b = 0; b < 2; ++b)
#pragma unroll
            for (int m = 0; m < 4; ++m)
#pragma unroll
                for (int n = 0; n < 2; ++n) acc[a][b][m][n] = (f32x4){0.f, 0.f, 0.f, 0.f};
    bf16x8 At[4][2], B0[2][2], B1[2][2];
    const char* cA = (const char*)g.A + (size_t)cur.pm * tstep; const char* cB = (const char*)g.Bt + (size_t)cur.pn * tstep;
    S.a_ready(cur);
    if constexpr (SP2) {
        PG8_STAGE(PG8_SB(0, 0), cB, voffB); PG8_STAGE(PG8_SB(0, 1), cB + hstep, voffB); PG8_STAGE(PG8_SA(0, 0), cA, voffA); PG8_STAGE(PG8_SA(0, 1), cA + hstep, voffA);
        if (wr == 1) PG8_BAR;
        PG8_WAIT_V(2); PG8_BAR;
        PG8_STAGE(PG8_SB(1, 0), cB + kstep, voffB); PG8_STAGE(PG8_SA(1, 0), cA + kstep, voffA); PG8_STAGE(PG8_SB(1, 1), cB + hstep + kstep, voffB);
        PG8_WAIT_V(6); PG8_BAR;
    } else {
        PG8_STAGE(PG8_SB(0, 0), cB, voffB); PG8_STAGE(PG8_SA(0, 0), cA, voffA); PG8_STAGE(PG8_SB(0, 1), cB + hstep, voffB); PG8_STAGE(PG8_SA(0, 1), cA + hstep, voffA);
        if (wr == 1) PG8_BAR;
        PG8_WAIT_V(4); PG8_BAR;
        PG8_STAGE(PG8_SB(1, 0), cB + kstep, voffB); PG8_STAGE(PG8_SA(1, 0), cA + kstep, voffA); PG8_STAGE(PG8_SB(1, 1), cB + hstep + kstep, voffB);
        PG8_WAIT_V(6); PG8_BAR;
    }
    for (;;) {
        const bool has_next = S.next(ui + 1, nxt);
        const char* nA = has_next ? (const char*)g.A + (size_t)nxt.pm * tstep : cA; const char* nB = has_next ? (const char*)g.Bt + (size_t)nxt.pn * tstep : cB;
        for (int t = 0; t < nt; t += 2) {
            const bool last = (t == nt - 2);
            const char* a1 = cA + (size_t)(t + 1) * kstep;
            const char* a2 = last ? nA : cA + (size_t)(t + 2) * kstep; const char* b2 = last ? nB : cB + (size_t)(t + 2) * kstep;
            const char* a3 = a2 + kstep; const char* b3 = b2 + kstep;
            if (last && has_next) S.a_ready(nxt);
            if constexpr (SP2) {
            PG8_LDB(B0, 0, 0); PG8_LDB(B1, 0, 1); PG8_SCHED; PG8_LDA(At, 0, 0); PG8_STAGE(PG8_SA(1, 1), a1 + hstep, voffA);
            PG8_WAIT_V(8); PG8_WAIT_L(0); PG8_BAR; PG8_MMA(0, 0, At, B0); PG8_MMA(0, 1, At, B1); PG8_BAR; PG8_SCHED;
            PG8_LDA(At, 0, 1); PG8_STAGE(PG8_SB(0, 0), b2, voffB); PG8_STAGE(PG8_SB(0, 1), b2 + hstep, voffB); PG8_STAGE(PG8_SA(0, 0), a2, voffA);
            PG8_WAIT_V(8); PG8_WAIT_L(0); PG8_BAR; PG8_MMA(1, 0, At, B0); PG8_MMA(1, 1, At, B1); PG8_BAR; PG8_SCHED;
            PG8_LDB(B0, 1, 0); PG8_LDB(B1, 1, 1); PG8_SCHED; PG8_LDA(At, 1, 0); PG8_STAGE(PG8_SA(0, 1), a2 + hstep, voffA);
            PG8_WAIT_V(8); PG8_WAIT_L(0); PG8_BAR; PG8_MMA(0, 0, At, B0); PG8_MMA(0, 1, At, B1); PG8_BAR; PG8_SCHED;
            PG8_LDA(At, 1, 1); PG8_STAGE(PG8_SB(1, 0), b3, voffB); PG8_STAGE(PG8_SB(1, 1), b3 + hstep, voffB); PG8_STAGE(PG8_SA(1, 0), a3, voffA);
            PG8_WAIT_V(8); PG8_WAIT_L(0); PG8_BAR; PG8_MMA(1, 0, At, B0); PG8_MMA(1, 1, At, B1); PG8_BAR; PG8_SCHED;
            } else {
            PG8_LDB(B0, 0, 0); PG8_SCHED; PG8_LDA(At, 0, 0); PG8_STAGE(PG8_SA(1, 1), a1 + hstep, voffA);
            PG8_WAIT_L(8); PG8_BAR; PG8_WAIT_L(0); PG8_MMA(0, 0, At, B0); PG8_BAR; PG8_SCHED;
            PG8_LDB(B1, 0, 1); PG8_STAGE(PG8_SB(0, 0), b2, voffB);
            PG8_BAR; PG8_WAIT_L(0); PG8_MMA(0, 1, At, B1); PG8_BAR;
            PG8_LDA(At, 0, 1); PG8_STAGE(PG8_SA(0, 0), a2, voffA);
            PG8_BAR; PG8_WAIT_L(0); PG8_MMA(1, 0, At, B0); PG8_BAR; PG8_SCHED;
            PG8_STAGE(PG8_SB(0, 1), b2 + hstep, voffB);
            PG8_WAIT_V(6); PG8_BAR; PG8_MMA(1, 1, At, B1); PG8_BAR;
            PG8_LDB(B0, 1, 0); PG8_SCHED; PG8_LDA(At, 1, 0); PG8_STAGE(PG8_SA(0, 1), a2 + hstep, voffA);
            PG8_WAIT_L(8); PG8_BAR; PG8_WAIT_L(0); PG8_MMA(0, 0, At, B0); PG8_BAR; PG8_SCHED;
            PG8_LDB(B1, 1, 1); PG8_STAGE(PG8_SB(1, 0), b3, voffB);
            PG8_BAR; PG8_WAIT_L(0); PG8_MMA(0, 1, At, B1); PG8_BAR;
            PG8_LDA(At, 1, 1); PG8_STAGE(PG8_SA(1, 0), a3, voffA);
            PG8_BAR; PG8_WAIT_L(0); PG8_MMA(1, 0, At, B0); PG8_BAR; PG8_SCHED;
            PG8_STAGE(PG8_SB(1, 1), b3 + hstep, voffB);
            PG8_WAIT_V(6); PG8_BAR; PG8_MMA(1, 1, At, B1); PG8_BAR;
            }
        }
        if constexpr (ALIGN_EPI) { if (wr == 0) PG8_BAR; }
        if constexpr (!Epi::AFTER_DRAIN) { E(acc, cur, wr, wc, fr, fq); S.done(cur); }
        if (!has_next) break;
#pragma unroll
        for (int a = 0; a < 2; ++a)
#pragma unroll
            for (int b = 0; b < 2; ++b)
#pragma unroll
                for (int m = 0; m < 4; ++m)
#pragma unroll
                    for (int n = 0; n < 2; ++n) acc[a][b][m][n] = (f32x4){0.f, 0.f, 0.f, 0.f};
        cur = nxt; cA = nA; cB = nB; ++ui;
        if constexpr (ALIGN_EPI) { if (wr == 1) PG8_BAR; }
    }
    PG8_WAIT_V(0);
    if constexpr (!ALIGN_EPI) { if (wr == 0) PG8_BAR; }
    PG8_BAR;
    if constexpr (Epi::AFTER_DRAIN) { E.fused(acc, cur, wr, wc, fr, fq, lds, wid, lane); S.done(cur); }
#undef PG8_SA
#undef PG8_SB
#undef PG8_STAGE
#undef PG8_LDA
#undef PG8_LDB
#undef PG8_MMA
#undef PG8_WAIT_V
#undef PG8_WAIT_L
#undef PG8_BAR
#undef PG8_SCHED
}
}

enum { T_PLAIN = 0, T_NR = 1, T_ROPE = 2, T_SILU = 3, T_IW = 4 };
DI void slot_info(const Params& p, int layer, int slot, int& type, const float*& gain) {
  gain = nullptr;
  if (layer == 0) {
    if (slot < 8) { type = T_NR; gain = p.in[I_A_Q_GAIN]; }
    else if (slot == 8) { type = T_NR; gain = p.in[I_A_K_GAIN]; }
    else if (slot == 9) type = T_PLAIN;
    else if (slot < 18) type = T_ROPE;
    else if (slot == 18) { type = T_NR; gain = p.in[I_IDX_K_GAIN]; }
    else if (slot < 27) type = T_SILU;
    else if (slot < 35) { type = T_NR; gain = p.in[I_B_Q_GAIN]; }
    else if (slot < 37) { type = T_NR; gain = p.in[I_B_K_GAIN]; }
    else if (slot < 39) type = T_PLAIN;
    else if (slot < 47) type = T_SILU;
    else type = T_IW;
  } else {
    if (slot < 8) { type = T_NR; gain = p.in[I_C_Q_GAIN]; }
    else if (slot < 16) { type = T_NR; gain = p.in[I_C_K_GAIN]; }
    else if (slot < 24) type = T_PLAIN;
    else if (slot < 32) type = T_SILU;
    else if (slot < 40) { type = T_NR; gain = p.in[I_D_Q_GAIN]; }
    else if (slot < 48) { type = T_NR; gain = p.in[I_D_K_GAIN]; }
    else if (slot < 56) type = T_PLAIN;
    else type = T_SILU;
  }
}
constexpr int E_AQ = 0, E_AK = 512, E_AV = 576, E_IQ = 640, E_IK = 1152, E_AG = 1216, E_BQ = 1728, E_BK = 2240, E_BV = 2368, E_BG = 2496;
constexpr int O_CQ = 0, O_CK = 512, O_CV = 1024, O_CG = 1536, O_DQ = 2048, O_DK = 2560, O_DV = 3072, O_DG = 3584;

typedef pg8::f32x4 (AccT)[2][2][4][2];

struct EpiInProj {
  static constexpr bool PERM = false, AFTER_DRAIN = false;
  const Params& p; int layer;
  DI void operator()(const f32x4 (&acc)[2][2][4][2], const pg8::Unit& u, int wr, int wc, int fr, int fq) const {
    unsigned char* ws = p.ws;
    const int NP = layer == 0 ? NPE : NPO;
    bf16* PE = (bf16*)(ws + WS_PE);
    const float2* rope = (const float2*)(ws + WS_ROPE);
    const float* ss1 = (const float*)(ws + WS_SS);
    float* IW = (float*)(ws + WS_IW);
    const int slot = u.pn * 4 + wc;
    int type; const float* gain; slot_info(p, layer, slot, type, gain);
#pragma unroll
    for (int ai = 0; ai < 2; ++ai)
#pragma unroll
      for (int m = 0; m < 4; ++m) {
        const int row = u.pm * 256 + ai * 128 + wr * 64 + m * 16 + fr, pos = row & (SEQ - 1);
        float sc = 1.f;
        if (layer == 1) sc = rsqrtf(ss1[row] * (1.f / DM) + EPS);
        f32x4 v1[2], v2[2];
#pragma unroll
        for (int n = 0; n < 2; ++n) { v1[n] = acc[ai][0][m][n] * sc; v2[n] = acc[ai][1][m][n] * sc; }
        if (type == T_NR) {
          float s = 0.f;
#pragma unroll
          for (int n = 0; n < 2; ++n) s += v1[n].x * v1[n].x + v1[n].y * v1[n].y + v1[n].z * v1[n].z + v1[n].w * v1[n].w + v2[n].x * v2[n].x + v2[n].y * v2[n].y + v2[n].z * v2[n].z + v2[n].w * v2[n].w;
          s += __shfl_xor(s, 16); s += __shfl_xor(s, 32);
          const float rn = rsqrtf(s * (1.f / 64.f) + EPS);
#pragma unroll
          for (int n = 0; n < 2; ++n) { const f32x4 g1 = *(const f32x4*)(gain + n * 16 + fq * 4), g2 = *(const f32x4*)(gain + 32 + n * 16 + fq * 4); v1[n] = v1[n] * rn * g1; v2[n] = v2[n] * rn * g2; }
        }
        if (type == T_NR || type == T_ROPE) {
#pragma unroll
          for (int n = 0; n < 2; ++n) {
            const f32x4* cs = (const f32x4*)(rope + (size_t)pos * 32 + n * 16 + fq * 4);
            const f32x4 c01 = cs[0], c23 = cs[1];
            const f32x4 x1 = v1[n], x2 = v2[n];
            f32x4 o1, o2;
            o1.x = x1.x * c01.x - x2.x * c01.y; o2.x = x2.x * c01.x + x1.x * c01.y;
            o1.y = x1.y * c01.z - x2.y * c01.w; o2.y = x2.y * c01.z + x1.y * c01.w;
            o1.z = x1.z * c23.x - x2.z * c23.y; o2.z = x2.z * c23.x + x1.z * c23.y;
            o1.w = x1.w * c23.z - x2.w * c23.w; o2.w = x2.w * c23.z + x1.w * c23.w;
            v1[n] = o1; v2[n] = o2;
          }
        }
        if (type == T_SILU) {
#pragma unroll
          for (int n = 0; n < 2; ++n)
#pragma unroll
            for (int j = 0; j < 4; ++j) { const float a = v1[n][j]; v1[n][j] = a / (1.f + __expf(-a)); const float b = v2[n][j]; v2[n][j] = b / (1.f + __expf(-b)); }
        }
        if (type == T_IW) {
          if (fq < 2) *(f32x4*)(IW + (size_t)row * 8 + fq * 4) = v1[0];
        } else {
          bf16* dst = PE + (size_t)row * NP + slot * 64 + fq * 4;
#pragma unroll
          for (int n = 0; n < 2; ++n) {
            u32x2 w1, w2; w1.x = cvtpk(v1[n].x, v1[n].y); w1.y = cvtpk(v1[n].z, v1[n].w); w2.x = cvtpk(v2[n].x, v2[n].y); w2.y = cvtpk(v2[n].z, v2[n].w);
            *(u32x2*)(dst + n * 16) = w1; *(u32x2*)(dst + 32 + n * 16) = w2;
            if (layer == 0 && slot == 18) { bf16* IKS = (bf16*)(ws + WS_IKS); const int key = row & (SEQ - 1);
              bf16* base = IKS + (((size_t)(row >> 13) * 256 + (key >> 5)) * 4) * 512 + ((fq >> 1) * 32 + (key & 31)) * 8 + (fq & 1) * 4;
              *(u32x2*)(base + (size_t)n * 512) = w1; *(u32x2*)(base + (size_t)(n + 2) * 512) = w2; }
          }
        }
        asm volatile("" ::: "memory");
      }
  }
};

DI void phase_inproj(const Params& p, int layer, char* lds) {
  unsigned char* ws = p.ws;
  const int NP = layer == 0 ? NPE : NPO;
  pg8::Gemm g{(const bf16*)(ws + (layer == 0 ? WS_ACT : WS_Y)), (const bf16*)(ws + (layer == 0 ? WS_WINE : WS_WINO)), NTOK, NP, DM};
  pg8::StaticOrder S; S.init(NTOK, NP, (int)gridDim.x, (int)blockIdx.x);
  EpiInProj E{p, layer};
  pg8::gemm_phase<EpiInProj, pg8::StaticOrder, true, true>((PG8_LAS unsigned char*)lds, g, S, E);
}

struct EpiOutProj {
  static constexpr bool PERM = false, AFTER_DRAIN = false;
  const float* xin; float* out; bf16* XG; const float* pg; float* ss;
  DI void operator()(const f32x4 (&acc)[2][2][4][2], const pg8::Unit& u, int wr, int wc, int fr, int fq) const {
#pragma unroll
    for (int ai = 0; ai < 2; ++ai)
#pragma unroll
      for (int m = 0; m < 4; ++m) {
        const int row = u.pm * 256 + ai * 128 + wr * 64 + m * 16 + fr; float rs = 0.f;
#pragma unroll
        for (int bj = 0; bj < 2; ++bj)
#pragma unroll
          for (int n = 0; n < 2; ++n) {
            const int col = u.pn * 256 + bj * 128 + wc * 32 + n * 16 + fq * 4; const size_t off = (size_t)row * DM + col;
            const f32x4 xn = *(const f32x4*)(xin + off) + acc[ai][bj][m][n];
            *(f32x4*)(out + off) = xn;
            rs += xn.x * xn.x + xn.y * xn.y + xn.z * xn.z + xn.w * xn.w;
            const f32x4 gg = *(const f32x4*)(pg + col);
            u32x2 w; w.x = cvtpk(xn.x * gg.x, xn.y * gg.y); w.y = cvtpk(xn.z * gg.z, xn.w * gg.w); *(u32x2*)(XG + off) = w;
          }
        rs += __shfl_xor(rs, 16); rs += __shfl_xor(rs, 32);
        if (fq == 0) atomicAdd(ss + row, rs);
        asm volatile("" ::: "memory");
      }
  }
};
DI void phase_outproj(const Params& p, int layer, char* lds) {
  unsigned char* ws = p.ws;
  pg8::Gemm g{(const bf16*)(ws + WS_Y), (const bf16*)(ws + (layer == 0 ? WS_WOUTE : WS_WOUTO)), NTOK, DM, DM};
  pg8::StaticOrder S; S.init(NTOK, DM, (int)gridDim.x, (int)blockIdx.x);
  EpiOutProj E{layer == 0 ? p.in[I_X] : p.out, p.out, (bf16*)(ws + WS_ACT), p.in[I_PLE_NORM_GAIN] + layer * DM, (float*)(ws + WS_SS) + (layer == 0 ? 1 : 2) * NTOK};
  pg8::gemm_phase<EpiOutProj, pg8::StaticOrder, true, true>((PG8_LAS unsigned char*)lds, g, S, E);
}

struct EpiPleProj {
  static constexpr bool PERM = false, AFTER_DRAIN = false;
  float* PT;
  DI void operator()(const f32x4 (&acc)[2][2][4][2], const pg8::Unit& u, int wr, int wc, int fr, int fq) const {
#pragma unroll
    for (int ai = 0; ai < 2; ++ai)
#pragma unroll
      for (int m = 0; m < 4; ++m) {
        const int row = u.pm * 256 + ai * 128 + wr * 64 + m * 16 + fr;
#pragma unroll
        for (int bj = 0; bj < 2; ++bj)
#pragma unroll
          for (int n = 0; n < 2; ++n) *(f32x4*)(PT + (size_t)row * DM + u.pn * 256 + bj * 128 + wc * 32 + n * 16 + fq * 4) = acc[ai][bj][m][n];
      }
  }
};
struct EpiPleGate {
  static constexpr bool PERM = false, AFTER_DRAIN = false;
  const float* PT; float* out; const float* ssx; float* ss1; bf16* H; const float* ng1; int layer;
  DI void operator()(const f32x4 (&acc)[2][2][4][2], const pg8::Unit& u, int wr, int wc, int fr, int fq) const {
#pragma unroll
    for (int ai = 0; ai < 2; ++ai)
#pragma unroll
      for (int m = 0; m < 4; ++m) {
        const int row = u.pm * 256 + ai * 128 + wr * 64 + m * 16 + fr; float rs = 0.f;
        const float rstd = rsqrtf(ssx[row] * (1.f / DM) + EPS);
#pragma unroll
        for (int bj = 0; bj < 2; ++bj)
#pragma unroll
          for (int n = 0; n < 2; ++n) {
            const int col = u.pn * 256 + bj * 128 + wc * 32 + n * 16 + fq * 4; const size_t off = (size_t)row * DM + col;
            f32x4 g;
#pragma unroll
            for (int j = 0; j < 4; ++j) g[j] = 1.f / (1.f + __expf(-rstd * acc[ai][bj][m][n][j]));
            const f32x4 xn = *(const f32x4*)(out + off) + *(const f32x4*)(PT + off) * g;
            *(f32x4*)(out + off) = xn;
            if (layer == 0) {
              rs += xn.x * xn.x + xn.y * xn.y + xn.z * xn.z + xn.w * xn.w;
              const f32x4 gg = *(const f32x4*)(ng1 + col);
              u32x2 w; w.x = cvtpk(xn.x * gg.x, xn.y * gg.y); w.y = cvtpk(xn.z * gg.z, xn.w * gg.w); *(u32x2*)(H + off) = w;
            }
          }
        if (layer == 0) { rs += __shfl_xor(rs, 16); rs += __shfl_xor(rs, 32); if (fq == 0) atomicAdd(ss1 + row, rs); }
        asm volatile("" ::: "memory");
      }
  }
};
DI void phase_ple(const Params& p, int layer, char* lds) {
  unsigned char* ws = p.ws;
  float* PT = (float*)(ws + WS_PE);
  pg8::StaticOrder S; S.init(NTOK, DM, (int)gridDim.x, (int)blockIdx.x);
  { pg8::Gemm g{(const bf16*)(ws + WS_PBF) + (size_t)layer * NTOK * 256, (const bf16*)(ws + (layer == 0 ? WS_WP0 : WS_WP1)), NTOK, DM, 256};
    EpiPleProj E{PT};
    pg8::gemm_phase<EpiPleProj, pg8::StaticOrder, true, true>((PG8_LAS unsigned char*)lds, g, S, E); }
  { pg8::Gemm g{(const bf16*)(ws + WS_ACT), (const bf16*)(ws + (layer == 0 ? WS_WG0 : WS_WG1)), NTOK, DM, DM};
    EpiPleGate E{PT, p.out, (const float*)(ws + WS_SS) + (layer == 0 ? 1 : 2) * NTOK, (float*)(ws + WS_SS), (bf16*)(ws + WS_Y), p.in[I_NORM_GAIN] + DM, layer};
    pg8::gemm_phase<EpiPleGate, pg8::StaticOrder, true, true>((PG8_LAS unsigned char*)lds, g, S, E); }
}

template <int DVB, bool MASKED = true>
DI void attn_step32(const bf16* Kt, int KP, const bf16* Vt, int VP, const bf16x8 (&qf)[4], f32x16 (&o)[DVB], float& m, float& l, unsigned vmask, float c2, int lane) {
  const int r32 = lane & 31, h = lane >> 5;
  f32x16 s;
#pragma unroll
  for (int i = 0; i < 16; ++i) s[i] = 0.f;
#pragma unroll
  for (int t = 0; t < 4; ++t) { const bf16x8 kf = *(const bf16x8*)(Kt + r32 * KP + t * 16 + h * 8); s = mfma32(kf, qf[t], s); }
  float mx = -INFINITY;
#pragma unroll
  for (int i = 0; i < 16; ++i) { if (MASKED) { s[i] = ((vmask >> i) & 1u) ? s[i] : -INFINITY; } mx = fmaxf(mx, s[i]); }
  mx = fmaxf(mx, __shfl_xor(mx, 32));
  const float mn = fmaxf(m, mx * c2);
  if (__any(mn > m)) {
    const float alpha = fexp2(m - mn); l *= alpha;
#pragma unroll
    for (int d = 0; d < DVB; ++d)
#pragma unroll
      for (int i = 0; i < 16; ++i) o[d][i] *= alpha;
    m = mn;
  }
  float ps = 0.f; const float negm = -m;
#pragma unroll
  for (int i = 0; i < 16; ++i) { const float pv = fexp2(__builtin_fmaf(s[i], c2, negm)); s[i] = pv; ps += pv; }
  l += ps;
  bf16x8 pf[2];
  { u32x4 a, b; a.x = cvtpk(s[0], s[1]); a.y = cvtpk(s[2], s[3]); a.z = cvtpk(s[4], s[5]); a.w = cvtpk(s[6], s[7]);
    b.x = cvtpk(s[8], s[9]); b.y = cvtpk(s[10], s[11]); b.z = cvtpk(s[12], s[13]); b.w = cvtpk(s[14], s[15]);
    pf[0] = __builtin_bit_cast(bf16x8, a); pf[1] = __builtin_bit_cast(bf16x8, b); }
  const int i16 = lane & 15, q = i16 >> 2, pp = i16 & 3, blk = (lane >> 4) & 1;
#pragma unroll
  for (int d = 0; d < DVB; ++d)
#pragma unroll
    for (int sk = 0; sk < 2; ++sk) {
      const s16x4 lo = trread(Vt + (16 * sk + 4 * h + q) * VP + 32 * d + 16 * blk + 4 * pp);
      const s16x4 hi = trread(Vt + (16 * sk + 8 + 4 * h + q) * VP + 32 * d + 16 * blk + 4 * pp);
      const bf16x8 vf = __builtin_shufflevector(lo, hi, 0, 1, 2, 3, 4, 5, 6, 7);
      o[d] = mfma32(vf, pf[sk], o[d]);
    }
}

constexpr int WP = 72;
constexpr int WAVE_LDS = 2 * 32 * WP * 2;

struct KVRegs { u32x4 k[4], v[4]; };
DI void kv_store(const KVRegs& R, bf16* Ks, bf16* Vs, int lane) {
#pragma unroll
  for (int i = 0; i < 4; ++i) { const int row = (lane >> 3) + 8 * i, ch = lane & 7; *(u32x4*)(Ks + row * WP + ch * 8) = R.k[i]; *(u32x4*)(Vs + row * WP + ch * 8) = R.v[i]; }
}

DI void band_load(KVRegs& R, const bf16* Kg, const bf16* Vg, int NP, int kstart, int dil, int roff, int lane) {
#pragma unroll
  for (int i = 0; i < 4; ++i) {
    const int row = (lane >> 3) + 8 * i, ch = lane & 7; int k = kstart + row; if (k < 0) k = 0;
    const size_t off = (size_t)(dil * k + roff) * NP + ch * 8;
    R.k[i] = *(const u32x4*)(Kg + off); R.v[i] = *(const u32x4*)(Vg + off);
  }
}
template <int DVB>
DI void band_run(const bf16* Kg, const bf16* Vg, int NP, int kbase, int nsteps, int dil, int roff, int qidx, int win,
                 const bf16x8 (&qf)[4], f32x16 (&o)[DVB], float& m, float& l, float c2, bf16* Ks, bf16* Vs, int lane) {
  const int h = lane >> 5;
  KVRegs R; band_load(R, Kg, Vg, NP, kbase, dil, roff, lane);
  for (int j = 0; j < nsteps; ++j) {
    lds_fence();
    kv_store(R, Ks, Vs, lane);
    lds_fence();
    if (j + 1 < nsteps) band_load(R, Kg, Vg, NP, kbase + 32 * (j + 1), dil, roff, lane);
    unsigned vm = 0;
#pragma unroll
    for (int i = 0; i < 16; ++i) { const int k = kbase + 32 * j + crow(i, h); const int dlt = qidx - k; if (k >= 0 && dlt >= 0 && dlt <= win) vm |= (1u << i); }
    attn_step32<DVB>(Ks, WP, Vs, WP, qf, o, m, l, vm, c2, lane);
  }
}

DI void write_o64(const f32x16 (&o)[2], float linv, const bf16* gate_row, bf16* y_row, int h) {
#pragma unroll
  for (int d = 0; d < 2; ++d)
#pragma unroll
    for (int g = 0; g < 4; ++g) {
      const int dd = 32 * d + 8 * g + 4 * h;
      const u32x2 gv = *(const u32x2*)(gate_row + dd);
      const float g0 = __uint_as_float(gv.x << 16), g1 = __uint_as_float(gv.x & 0xffff0000u), g2 = __uint_as_float(gv.y << 16), g3 = __uint_as_float(gv.y & 0xffff0000u);
      u32x2 w; w.x = cvtpk(o[d][4 * g] * linv * g0, o[d][4 * g + 1] * linv * g1); w.y = cvtpk(o[d][4 * g + 2] * linv * g2, o[d][4 * g + 3] * linv * g3);
      *(u32x2*)(y_row + dd) = w;
    }
}

DI void load_q(bf16x8 (&qf)[4], const bf16* qrow, int h) {
#pragma unroll
  for (int t = 0; t < 4; ++t) qf[t] = *(const bf16x8*)(qrow + t * 16 + h * 8);
}
template <int DVB> DI void zero_o(f32x16 (&o)[DVB]) {
#pragma unroll
  for (int d = 0; d < DVB; ++d)
#pragma unroll
    for (int i = 0; i < 16; ++i) o[d][i] = 0.f;
}

DI void mixerB_tile(const Params& p, int item, bf16* Ks, bf16* Vs, int lane) {
  const bf16* PE = (const bf16*)(p.ws + WS_PE); bf16* Y = (bf16*)(p.ws + WS_Y);
  const int qblk = item & 255, head = (item >> 8) & 7, b = item >> 11;
  const int r32 = lane & 31, h = lane >> 5, q0 = qblk * 32, kvh = head >> 2;
  const size_t rowb = (size_t)b * SEQ;
  bf16x8 qf[4]; load_q(qf, PE + (rowb + q0 + r32) * NPE + E_BQ + head * 64, h);
  f32x16 o[2]; zero_o<2>(o);
  const float sink2 = p.in[I_B_SINKS][head] * LOG2E;
  float m = sink2, l = (h == 0) ? 1.f : 0.f;
  band_run<2>(PE + rowb * NPE + E_BK + kvh * 64, PE + rowb * NPE + E_BV + kvh * 64, NPE, q0 - 128, 5, 1, 0, q0 + r32, 127, qf, o, m, l, 0.125f * LOG2E, Ks, Vs, lane);
  l += __shfl_xor(l, 32);
  const size_t tok = rowb + q0 + r32;
  write_o64(o, 1.f / l, PE + tok * NPE + E_BG + head * 64, Y + tok * DM + 512 + head * 64, h);
}

DI void mixerC_tile(const Params& p, int item, bf16* Ks, bf16* Vs, int lane) {
  const bf16* PO = (const bf16*)(p.ws + WS_PE); bf16* Y = (bf16*)(p.ws + WS_Y);
  const int qt = item & 15, r16 = (item >> 4) & 15, head = (item >> 8) & 7, b = item >> 11;
  const int r32 = lane & 31, h = lane >> 5, qi0 = qt * 32;
  const size_t rowb = (size_t)b * SEQ;
  const int t = 16 * (qi0 + r32) + r16;
  bf16x8 qf[4]; load_q(qf, PO + (rowb + t) * NPO + O_CQ + head * 64, h);
  f32x16 o[2]; zero_o<2>(o);
  float m = -1e30f, l = 0.f;
  const bf16* Kg = PO + rowb * NPO + O_CK + head * 64; const bf16* Vg = PO + rowb * NPO + O_CV + head * 64;
  const float c2 = 0.125f * LOG2E;
  band_run<2>(Kg, Vg, NPO, qi0 - 128, 5, 16, r16, qi0 + r32, 128, qf, o, m, l, c2, Ks, Vs, lane);
  band_run<2>(Kg, Vg, NPO, 4 * qi0 + (r16 >> 2) - 128, 8, 4, r16 & 3, 4 * (qi0 + r32) + (r16 >> 2), 128, qf, o, m, l, c2, Ks, Vs, lane);
  band_run<2>(Kg, Vg, NPO, 16 * qi0 + r16 - 128, 20, 1, 0, t, 128, qf, o, m, l, c2, Ks, Vs, lane);
  l += __shfl_xor(l, 32);
  const size_t tok = rowb + t;
  write_o64(o, 1.f / l, PO + tok * NPO + O_CG + head * 64, Y + tok * DM + head * 64, h);
}

DI void mixerA_item(const Params& p, int item, bf16* Ks, bf16* Vs, int lane) {
  const bf16* PE = (const bf16*)(p.ws + WS_PE); bf16* Y = (bf16*)(p.ws + WS_Y);
  const unsigned short* SEL = (const unsigned short*)(p.ws + WS_SEL) + (size_t)item * 256;
  const int t = item & (SEQ - 1), b = item >> 13;
  const int r32 = lane & 31, h = lane >> 5, head = r32 & 7;
  const size_t rowb = (size_t)b * SEQ;
  const int count = (t + 1 < 256) ? t + 1 : 256, nsteps = (count + 31) >> 5;
  bf16x8 qf[4]; load_q(qf, PE + (size_t)item * NPE + E_AQ + head * 64, h);
  f32x16 o[2]; zero_o<2>(o);
  float m = -1e30f, l = 0.f;
  const bf16* Kg = PE + rowb * NPE + E_AK; const bf16* Vg = PE + rowb * NPE + E_AV;
  KVRegs R;
#define A_LOAD(j) do { _Pragma("unroll") for (int i = 0; i < 4; ++i) { const int row = (lane >> 3) + 8 * i, ch = lane & 7, e = 32 * (j) + row; \
      const int tokk = (e < count) ? (int)SEL[e] : 0; const size_t off = (size_t)tokk * NPE + ch * 8; R.k[i] = *(const u32x4*)(Kg + off); R.v[i] = *(const u32x4*)(Vg + off); } } while (0)
  A_LOAD(0);
  for (int j = 0; j < nsteps; ++j) {
    lds_fence();
    kv_store(R, Ks, Vs, lane);
    lds_fence();
    if (j + 1 < nsteps) A_LOAD(j + 1);
    unsigned vm = 0;
#pragma unroll
    for (int i = 0; i < 16; ++i) if (32 * j + crow(i, h) < count) vm |= (1u << i);
    attn_step32<2>(Ks, WP, Vs, WP, qf, o, m, l, vm, 0.125f * LOG2E, lane);
  }
#undef A_LOAD
  l += __shfl_xor(l, 32);
  if (r32 < 8) write_o64(o, 1.f / l, PE + (size_t)item * NPE + E_AG + head * 64, Y + (size_t)item * DM + head * 64, h);
}

DI unsigned f2ord(float f) { f += 0.f; const unsigned u = __float_as_uint(f); return (u & 0x80000000u) ? ~u : (u | 0x80000000u); }
DI int block_excl_scan(int v, int* tmp, int* tot) {
  const int lane = threadIdx.x & 63, wid = threadIdx.x >> 6;
  int inc = v;
#pragma unroll
  for (int o = 1; o < 64; o <<= 1) { const int u = __shfl_up(inc, o); if (lane >= o) inc += u; }
  if (lane == 63) tmp[wid] = inc;
  __syncthreads();
  int base = 0, total = 0;
#pragma unroll
  for (int w = 0; w < 8; ++w) { const int x = tmp[w]; if (w < wid) base += x; total += x; }
  *tot = total;
  return base + inc - v;
}

DI float dpp_sum8(float v) {
  v += __builtin_bit_cast(float, __builtin_amdgcn_mov_dpp(__builtin_bit_cast(int, v), 0xB1, 0xF, 0xF, true));
  v += __builtin_bit_cast(float, __builtin_amdgcn_mov_dpp(__builtin_bit_cast(int, v), 0x4E, 0xF, 0xF, true));
  v += __builtin_bit_cast(float, __builtin_amdgcn_mov_dpp(__builtin_bit_cast(int, v), 0x141, 0xF, 0xF, true));
  return v;
}
DI void hist_find(const int* hist, int* misc, int need, int& digit, int& nneed, int& cnt) {
  const int tid = threadIdx.x;
  typedef int i32x4 __attribute__((ext_vector_type(4)));
  const i32x4 h0 = *(const i32x4*)(hist + tid * 8), h1 = *(const i32x4*)(hist + tid * 8 + 4);
  int hh[8] = {h0.x, h0.y, h0.z, h0.w, h1.x, h1.y, h1.z, h1.w}; int tot = 0;
#pragma unroll
  for (int k = 0; k < 8; ++k) tot += hh[k];
  int total; const int ex = block_excl_scan(tot, misc, &total);
  int above = total - ex - tot;
#pragma unroll
  for (int k = 7; k >= 0; --k) { const int c = hh[k]; if (above < need && above + c >= need) { misc[16] = tid * 8 + k; misc[17] = need - above; misc[18] = c; } above += c; }
  __syncthreads();
  digit = misc[16]; nneed = misc[17]; cnt = misc[18];
  __syncthreads();
}
DI unsigned long long mkcmp(float v, int idx) { return ((unsigned long long)f2ord(v) << 16) | ((unsigned long long)(8191 - idx) << 3); }
DI float ord2f(unsigned k) { return __uint_as_float((k & 0x80000000u) ? (k ^ 0x80000000u) : ~k); }
DI float half_sum(float v) { auto rr = __builtin_amdgcn_permlane32_swap(__float_as_uint(v), __float_as_uint(v), false, false); return __uint_as_float(rr[0]) + __uint_as_float(rr[1]); }

constexpr int CL_CAP = 512;
DI void selectA_item(const Params& p, int item, char* lds) {
  const bf16* PE = (const bf16*)(p.ws + WS_PE);
  const float* IW = (const float*)(p.ws + WS_IW);
  unsigned short* SEL = (unsigned short*)(p.ws + WS_SEL);
  float* sc = (float*)lds;
  int* hist = (int*)(lds + 4 * 8192 * 4);
  int* misc = hist + 4096;
  unsigned* mm = (unsigned*)(misc + 24);
  unsigned long long* clist = (unsigned long long*)(misc + 64);
  const int tid = opaque_tid(), lane = tid & 63, wid = tid >> 6, r32 = lane & 31, h = lane >> 5;
  const int b = item >> 11, t0 = (item & 2047) * 4;
  const size_t rowb = (size_t)b * SEQ;
  const int nk = t0 + 4, ntile = (nk + 31) >> 5;
  if (tid < 4) { mm[tid * 2] = 0xFFFFFFFFu; mm[tid * 2 + 1] = 0u; }
  __syncthreads();
  bf16x8 qf[4]; load_q(qf, PE + (rowb + t0 + (r32 >> 3)) * NPE + E_IQ + (r32 & 7) * 64, h);
  float wq[16];
#pragma unroll
  for (int i = 0; i < 16; ++i) wq[i] = IW[(rowb + t0 + (i >> 2)) * 8 + (i & 3) + 4 * h] * 0.04419417382415922f;
  const bf16* Kt = (const bf16*)(p.ws + WS_IKS) + (size_t)b * 256 * 2048 + lane * 8;
  {
    bf16x8 kf[4], kn[4];
#pragma unroll
    for (int t = 0; t < 4; ++t) { kf[t] = (bf16x8){0, 0, 0, 0, 0, 0, 0, 0}; kn[t] = kf[t]; }
    if (wid < ntile) {
#pragma unroll
      for (int t = 0; t < 4; ++t) kf[t] = *(const bf16x8*)(Kt + (size_t)wid * 2048 + t * 512);
    }
    float lo0 = INFINITY, hi0 = -INFINITY, lo1 = INFINITY, hi1 = -INFINITY;
    for (int kt = wid; kt < ntile; kt += 8) {
      if (kt + 8 < ntile) {
#pragma unroll
        for (int t = 0; t < 4; ++t) kn[t] = *(const bf16x8*)(Kt + (size_t)(kt + 8) * 2048 + t * 512);
      }
      f32x16 s;
#pragma unroll
      for (int i = 0; i < 16; ++i) s[i] = 0.f;
#pragma unroll
      for (int t = 0; t < 4; ++t) s = mfma32(qf[t], kf[t], s);
      float v[4];
#pragma unroll
      for (int q = 0; q < 4; ++q) {
        float a = wq[4 * q] * fmaxf(s[4 * q], 0.f);
#pragma unroll
        for (int jj = 1; jj < 4; ++jj) a += wq[4 * q + jj] * fmaxf(s[4 * q + jj], 0.f);
        v[q] = half_sum(a) + 0.f;
      }
      const float va = h ? v[2] : v[0], vb = h ? v[3] : v[1];
      const int key = kt * 32 + r32;
      sc[(2 * h) * 8192 + key] = va; sc[(2 * h + 1) * 8192 + key] = vb;
      lo0 = fminf(lo0, va); hi0 = fmaxf(hi0, va); lo1 = fminf(lo1, vb); hi1 = fmaxf(hi1, vb);
#pragma unroll
      for (int t = 0; t < 4; ++t) kf[t] = kn[t];
    }
    if (wid < ntile) {
#pragma unroll
      for (int o = 1; o < 32; o <<= 1) { lo0 = fminf(lo0, __shfl_xor(lo0, o)); hi0 = fmaxf(hi0, __shfl_xor(hi0, o)); lo1 = fminf(lo1, __shfl_xor(lo1, o)); hi1 = fmaxf(hi1, __shfl_xor(hi1, o)); }
      if (r32 == 0) { atomicMin(&mm[(2 * h) * 2], f2ord(lo0)); atomicMax(&mm[(2 * h) * 2 + 1], f2ord(hi0)); atomicMin(&mm[(2 * h + 1) * 2], f2ord(lo1)); atomicMax(&mm[(2 * h + 1) * 2 + 1], f2ord(hi1)); }
    }
  }
  __syncthreads();
  for (int q = 0; q < 4; ++q) {
    const int t = t0 + q, n = t + 1;
    unsigned short* out = SEL + (rowb + t) * 256;
    if (n <= 256) { if (tid < n) out[tid] = (unsigned short)tid; continue; }
    const float* scq = sc + q * 8192;
    const float lo = ord2f(mm[q * 2]), hi = ord2f(mm[q * 2 + 1]);
    const float scale = (hi > lo) ? 4095.f / (hi - lo) : 0.f;
    for (int i = tid; i < 4096; i += 512) hist[i] = 0;
    if (tid == 0) misc[20] = 0;
    __syncthreads();
    float val[16]; int bin[16];
#pragma unroll
    for (int i = 0; i < 16; ++i) { const int idx = tid + 512 * i; const float v = (idx < n) ? scq[idx] : lo; val[i] = v;
      int bb = (int)((v - lo) * scale); bb = bb < 0 ? 0 : (bb > 4095 ? 4095 : bb); bin[i] = bb; if (idx < n) atomicAdd(&hist[bb], 1); }
    __syncthreads();
    int bstar, need, cnt;
    hist_find(hist, misc, 256, bstar, need, cnt);
    unsigned long long T = 0ull;
    if (cnt != need) {
      if (cnt <= CL_CAP) {
#pragma unroll
        for (int i = 0; i < 16; ++i) { const int idx = tid + 512 * i; if (idx < n && bin[i] == bstar) { const int slot = atomicAdd(&misc[20], 1); clist[slot] = mkcmp(val[i], idx); } }
        __syncthreads();
        if (tid < cnt) { const unsigned long long c = clist[tid]; int rank = 0; for (int jx = 0; jx < cnt; ++jx) rank += (clist[jx] > c) ? 1 : 0;
          if (rank == need - 1) { misc[21] = (int)(unsigned)(c & 0xffffffffull); misc[22] = (int)(unsigned)(c >> 32); } }
        __syncthreads();
        T = ((unsigned long long)(unsigned)misc[22] << 32) | (unsigned long long)(unsigned)misc[21];
      } else {
        unsigned long long prefix = 0ull; int shift = 36;
        for (int pass = 0; pass < 4; ++pass) {
          for (int i = tid; i < 4096; i += 512) hist[i] = 0;
          __syncthreads();
#pragma unroll
          for (int i = 0; i < 16; ++i) { const int idx = tid + 512 * i; if (idx < n && bin[i] == bstar) { const unsigned long long c = mkcmp(val[i], idx); if (pass == 0 || (c >> (shift + 12)) == prefix) atomicAdd(&hist[(int)((c >> shift) & 4095ull)], 1); } }
          __syncthreads();
          int digit, nneed, c2;
          hist_find(hist, misc, need, digit, nneed, c2);
          prefix = (prefix << 12) | (unsigned long long)digit; need = nneed;
          if (c2 == need) break;
          shift -= 12;
        }
        T = prefix << shift;
      }
    }
    int mycnt = 0; unsigned selm = 0;
#pragma unroll
    for (int i = 0; i < 16; ++i) { const int idx = tid + 512 * i;
      bool sel = false;
      if (idx < n) { if (bin[i] > bstar) sel = true; else if (bin[i] == bstar) sel = (mkcmp(val[i], idx) >= T); }
      if (sel) { ++mycnt; selm |= (1u << i); } }
    int total; int pos = block_excl_scan(mycnt, misc + 8, &total);
#pragma unroll
    for (int i = 0; i < 16; ++i) { if ((selm >> i) & 1u) { if (pos < 256) out[pos] = (unsigned short)(tid + 512 * i); ++pos; } }
    __syncthreads();
  }
  __syncthreads();
}

constexpr int DKP = 72, DVP = 136;
constexpr int D_STAGE = (64 * DKP * 2 + 64 * DVP) * 2;
DI void mixerD_unit(const Params& p, int b, int head, int qb, char* lds) {
  const bf16* PO = (const bf16*)(p.ws + WS_PE); bf16* Y = (bf16*)(p.ws + WS_Y);
  const int tid = opaque_tid(), lane = tid & 63, wid = tid >> 6, r32 = lane & 31, h = lane >> 5;
  const int map = wid & 1, qsub = wid >> 1;
  const size_t rowb = (size_t)b * SEQ;
  const int qpos = 128 * qb + 32 * qsub + r32;
  bf16x8 qf[4]; load_q(qf, PO + (rowb + qpos) * NPO + O_DQ + (2 * head + map) * 64, h);
  f32x16 o[4]; zero_o<4>(o);
  float m = -1e30f, l = 0.f;
  const int nsteps = 2 * qb + 2;
  const bf16* K1g = PO + rowb * NPO + O_DK + (2 * head) * 64;
  const bf16* K2g = K1g + 64;
  const bf16* Vg = PO + rowb * NPO + O_DV + head * 128;
  u32x4 rk1, rk2, rv[2];
#define D_LOAD(j) do { const int row = tid >> 3, ch = tid & 7; const size_t off = (size_t)((j) * 64 + row) * NPO + ch * 8; rk1 = *(const u32x4*)(K1g + off); rk2 = *(const u32x4*)(K2g + off); \
    _Pragma("unroll") for (int i = 0; i < 2; ++i) { const int c = tid + 512 * i, vr = c >> 4, vc = c & 15; rv[i] = *(const u32x4*)(Vg + (size_t)((j) * 64 + vr) * NPO + vc * 8); } } while (0)
  __syncthreads();
  D_LOAD(0);
  for (int j = 0; j < nsteps; ++j) {
    char* st = lds + (j & 1) * D_STAGE;
    bf16* K1s = (bf16*)st; bf16* K2s = K1s + 64 * DKP; bf16* Vs = K2s + 64 * DKP;
    { const int row = tid >> 3, ch = tid & 7; *(u32x4*)(K1s + row * DKP + ch * 8) = rk1; *(u32x4*)(K2s + row * DKP + ch * 8) = rk2;
#pragma unroll
      for (int i = 0; i < 2; ++i) { const int c = tid + 512 * i, vr = c >> 4, vc = c & 15; *(u32x4*)(Vs + vr * DVP + vc * 8) = rv[i]; } }
    __syncthreads();
    if (j + 1 < nsteps) D_LOAD(j + 1);
    const bf16* Ks = map ? K2s : K1s;
#pragma unroll
    for (int sub = 0; sub < 2; ++sub) {
      const int k0 = j * 64 + sub * 32;
      if (k0 <= 128 * qb + 32 * qsub + 31) {
        if (k0 + 31 <= 128 * qb + 32 * qsub) {
          attn_step32<4, false>(Ks + sub * 32 * DKP, DKP, Vs + sub * 32 * DVP, DVP, qf, o, m, l, 0xffffu, 0.125f * LOG2E, lane);
        } else {
          unsigned vm = 0;
#pragma unroll
          for (int i = 0; i < 16; ++i) if (k0 + crow(i, h) <= qpos) vm |= (1u << i);
          attn_step32<4, true>(Ks + sub * 32 * DKP, DKP, Vs + sub * 32 * DVP, DVP, qf, o, m, l, vm, 0.125f * LOG2E, lane);
        }
      }
    }
  }
#undef D_LOAD
  l += __shfl_xor(l, 32);
  const float linv = 1.f / l;
  __syncthreads();
  float* xch = (float*)lds + qsub * 4096;
  if (map == 1) {
#pragma unroll
    for (int d = 0; d < 4; ++d)
#pragma unroll
      for (int i = 0; i < 16; ++i) xch[(d * 16 + i) * 64 + lane] = o[d][i] * linv;
  }
  __syncthreads();
  if (map == 0) {
    const float lam = *(const float*)(p.ws + WS_LAM);
    float ssq = 0.f;
#pragma unroll
    for (int d = 0; d < 4; ++d)
#pragma unroll
      for (int i = 0; i < 16; ++i) { const float a = o[d][i] * linv - lam * xch[(d * 16 + i) * 64 + lane]; o[d][i] = a; ssq += a * a; }
    ssq += __shfl_xor(ssq, 32);
    const float lambda_init = 0.8f - 0.6f * expf(-0.3f);
    const float rn = rsqrtf(ssq * (1.f / 128.f) + EPS) * (1.f - lambda_init);
    const size_t tok = rowb + qpos;
    const bf16* gate = PO + tok * NPO + O_DG + head * 128;
    bf16* y = Y + tok * DM + 512 + head * 128;
    const float* sg = p.in[I_SUB_GAIN];
#pragma unroll
    for (int d = 0; d < 4; ++d)
#pragma unroll
      for (int g = 0; g < 4; ++g) {
        const int dd = 32 * d + 8 * g + 4 * h;
        const u32x2 gv = *(const u32x2*)(gate + dd); const f32x4 s4 = *(const f32x4*)(sg + dd);
        const float g0 = __uint_as_float(gv.x << 16), g1 = __uint_as_float(gv.x & 0xffff0000u), g2 = __uint_as_float(gv.y << 16), g3 = __uint_as_float(gv.y & 0xffff0000u);
        u32x2 w; w.x = cvtpk(o[d][4 * g] * rn * s4.x * g0, o[d][4 * g + 1] * rn * s4.y * g1); w.y = cvtpk(o[d][4 * g + 2] * rn * s4.z * g2, o[d][4 * g + 3] * rn * s4.w * g3);
        *(u32x2*)(y + dd) = w;
      }
  }
  __syncthreads();
}

__global__ void __launch_bounds__(NTHREADS) fwd_kernel(Params p) {
  extern __shared__ __attribute__((aligned(16))) char smem[];
  cg::grid_group grid = cg::this_grid();
  char* lds = smem;
#define FRESH_IDS const int tid = opaque_tid(), lane = tid & 63, wid = tid >> 6; const int gw = blockIdx.x * 8 + wid, ngw = gridDim.x * 8; bf16* Ks = (bf16*)(lds + wid * WAVE_LDS); bf16* Vs = Ks + 32 * WP; (void)gw; (void)ngw; (void)Ks; (void)Vs; (void)lane;

  phase_prologue(p, lds);
  grid.sync();
  for (int rep = 0; rep < REP_GEMM; ++rep) phase_inproj(p, 0, lds);
  grid.sync();
#if EN_A
  for (int rep = 0; rep < REP_SELA; ++rep) for (int it = blockIdx.x; it < 2 * 2048; it += gridDim.x) selectA_item(p, it, lds);
  grid.sync();
  { FRESH_IDS for (int rep = 0; rep < REP_AATT; ++rep) for (int it = gw; it < NTOK; it += ngw) mixerA_item(p, it, Ks, Vs, lane); }
#else
  { unsigned* y = (unsigned*)(p.ws + WS_Y); for (int i = blockIdx.x * NTHREADS + (int)threadIdx.x; i < NTOK * 256; i += gridDim.x * NTHREADS) { const int row = i >> 8, c = i & 255; y[row * 512 + c] = 0u; } }
#endif
#if EN_B
  { FRESH_IDS for (int it = gw; it < 4096; it += ngw) mixerB_tile(p, it, Ks, Vs, lane); }
#else
  { unsigned* y = (unsigned*)(p.ws + WS_Y); for (int i = blockIdx.x * NTHREADS + (int)threadIdx.x; i < NTOK * 256; i += gridDim.x * NTHREADS) { const int row = i >> 8, c = i & 255; y[row * 512 + 256 + c] = 0u; } }
#endif
  grid.sync();
  phase_outproj(p, 0, lds);
  grid.sync();
  phase_ple(p, 0, lds);
  grid.sync();
  phase_inproj(p, 1, lds);
  grid.sync();
#if EN_D
  for (int rep = 0; rep < REP_D; ++rep) {
#pragma unroll 1
    for (int u2 = blockIdx.x * 2; u2 < 512; u2 += gridDim.x * 2) {
#pragma unroll 1
      for (int k = 0; k < 2; ++k) { const int u = u2 >> 1, bh = u >> 5, pr = u & 31; mixerD_unit(p, bh >> 2, bh & 3, k ? 63 - pr : pr, lds); }
    }
  }
#else
  { unsigned* y = (unsigned*)(p.ws + WS_Y); for (int i = blockIdx.x * NTHREADS + (int)threadIdx.x; i < NTOK * 256; i += gridDim.x * NTHREADS) { const int row = i >> 8, c = i & 255; y[row * 512 + 256 + c] = 0u; } }
#endif
#if EN_C
  __syncthreads();
  { FRESH_IDS for (int rep = 0; rep < REP_C; ++rep) for (int it = gw; it < 4096; it += ngw) mixerC_tile(p, it, Ks, Vs, lane); }
#else
  { unsigned* y = (unsigned*)(p.ws + WS_Y); for (int i = blockIdx.x * NTHREADS + (int)threadIdx.x; i < NTOK * 256; i += gridDim.x * NTHREADS) { const int row = i >> 8, c = i & 255; y[row * 512 + c] = 0u; } }
#endif
  grid.sync();
  phase_outproj(p, 1, lds);
  grid.sync();
  phase_ple(p, 1, lds);
}

extern "C" void kernel_launch(void* const* d_in, const int* in_sizes, int n_in, void* d_out, int out_size, void* d_ws, size_t ws_size, hipStream_t stream) {
  static int grid_blocks = 0;
  if (!grid_blocks) {
    int dev = 0, cus = 0, per_cu = 0;
    hipGetDevice(&dev);
    hipDeviceGetAttribute(&cus, hipDeviceAttributeMultiprocessorCount, dev);
    hipFuncSetAttribute((const void*)fwd_kernel, hipFuncAttributeMaxDynamicSharedMemorySize, LDS_BYTES);
    hipOccupancyMaxActiveBlocksPerMultiprocessor(&per_cu, (const void*)fwd_kernel, NTHREADS, LDS_BYTES);
    if (per_cu < 1) per_cu = 1;
    grid_blocks = cus * per_cu;
    if (grid_blocks > 256) grid_blocks = 256;
  }
  Params p{};
  for (int i = 0; i < 25; ++i) p.in[i] = (const float*)d_in[i];
  p.out = (float*)d_out; p.ws = (unsigned char*)d_ws;
  for (int i = 0; i < 32; ++i) p.inv_freq[i] = (float)pow(10000.0, -(double)i / 32.0);
  void* args[] = {&p};
  hipError_t e = hipLaunchCooperativeKernel((const void*)fwd_kernel, dim3(grid_blocks), dim3(NTHREADS), args, LDS_BYTES, stream);
  if (e != hipSuccess) fprintf(stderr, "cooperative launch failed: %s (grid %d)\n", hipGetErrorString(e), grid_blocks);
}
```

```cpp
#include <hip/hip_runtime.h>
#include <hip/hip_cooperative_groups.h>
#include <cstdio>
#include <cmath>
namespace cg = cooperative_groups;

#ifndef REP_GEMM
#define REP_GEMM 1
#endif
#ifndef REP_SELA
#define REP_SELA 1
#endif
#ifndef REP_D
#define REP_D 1
#endif
#ifndef REP_C
#define REP_C 1
#endif
#ifndef REP_AATT
#define REP_AATT 1
#endif
#ifndef EN_A
#define EN_A 1
#endif
#ifndef EN_B
#define EN_B 1
#endif
#ifndef EN_C
#define EN_C 1
#endif
#ifndef EN_D
#define EN_D 1
#endif

typedef unsigned short bf16;
typedef short bf16x8 __attribute__((ext_vector_type(8)));
typedef short s16x4 __attribute__((ext_vector_type(4)));
typedef float f32x4 __attribute__((ext_vector_type(4)));
typedef float f32x16 __attribute__((ext_vector_type(16)));
typedef unsigned u32x4 __attribute__((ext_vector_type(4)));
typedef unsigned u32x2 __attribute__((ext_vector_type(2)));
typedef float f32x2_t __attribute__((ext_vector_type(2)));
typedef __bf16 bf16x2_t __attribute__((ext_vector_type(2)));
#define LAS __attribute__((address_space(3)))
#define DI __device__ __forceinline__

constexpr int SEQ = 8192, NTOK = 16384, DM = 1024;
constexpr int NPE = 3072, NPO = 4096;
constexpr float EPS = 1e-6f;
constexpr float LOG2E = 1.4426950408889634f;
constexpr int NTHREADS = 512;
constexpr int LDS_BYTES = 150 * 1024;

constexpr size_t MiB = 1u << 20;
constexpr size_t WS_PE = 0;
constexpr size_t WS_ACT = 128 * MiB;
constexpr size_t WS_Y = 160 * MiB;
constexpr size_t WS_WINE = 192 * MiB;
constexpr size_t WS_WOUTE = 198 * MiB;
constexpr size_t WS_WINO = 200 * MiB;
constexpr size_t WS_WOUTO = 208 * MiB;
constexpr size_t WS_WG0 = 210 * MiB;
constexpr size_t WS_WG1 = 212 * MiB;
constexpr size_t WS_WP0 = 214 * MiB;
constexpr size_t WS_WP1 = 215 * MiB;
constexpr size_t WS_ROPE = 216 * MiB;
constexpr size_t WS_SEL = 218 * MiB;
constexpr size_t WS_IW = 226 * MiB;
constexpr size_t WS_SS = 227 * MiB;
constexpr size_t WS_LAM = 228 * MiB;
constexpr size_t WS_BAR = 250 * MiB;
constexpr size_t WS_PBF = 232 * MiB;
constexpr size_t WS_IKS = 229 * MiB;

struct Params {
  const float* in[25];
  float* out;
  unsigned char* ws;
  float inv_freq[32];
};
enum { I_X = 0, I_P, I_NORM_GAIN, I_W_IN_EVEN, I_W_OUT_EVEN, I_A_Q_GAIN, I_A_K_GAIN, I_IDX_K_GAIN, I_B_Q_GAIN, I_B_K_GAIN, I_B_SINKS,
       I_W_IN_ODD, I_W_OUT_ODD, I_C_Q_GAIN, I_C_K_GAIN, I_D_Q_GAIN, I_D_K_GAIN, I_LQ1, I_LK1, I_LQ2, I_LK2, I_SUB_GAIN, I_PLE_NORM_GAIN,
       I_W_PLE_GATE, I_W_PLE_PROJ };

DI unsigned cvtpk(float lo, float hi) { f32x2_t v = {lo, hi}; bf16x2_t b = __builtin_convertvector(v, bf16x2_t); return __builtin_bit_cast(unsigned, b); }
DI float bf2f(bf16 b) { return __uint_as_float(((unsigned)b) << 16); }
DI float fexp2(float x) { return __builtin_amdgcn_exp2f(x); }
DI f32x16 mfma32(bf16x8 a, bf16x8 b, f32x16 c) { return __builtin_amdgcn_mfma_f32_32x32x16_bf16(a, b, c, 0, 0, 0); }
DI f32x4 mfma16(bf16x8 a, bf16x8 b, f32x4 c) { return __builtin_amdgcn_mfma_f32_16x16x32_bf16(a, b, c, 0, 0, 0); }
DI int crow(int i, int h) { return (i & 3) + 8 * (i >> 2) + 4 * h; }
DI s16x4 trread(const bf16* p) { return __builtin_bit_cast(s16x4, __builtin_amdgcn_ds_read_tr16_b64_v4i16((LAS s16x4*)p)); }
DI int opaque_tid() { int t = threadIdx.x; asm volatile("" : "+v"(t)); return t; }
DI void lds_fence() { asm volatile("s_waitcnt lgkmcnt(0)" ::: "memory"); __builtin_amdgcn_wave_barrier(); }

__host__ __device__ __forceinline__ int phys_col(int n) { return (n & ~255) + 128 * ((n >> 5) & 1) + 32 * ((n >> 6) & 3) + (n & 31); }
DI int map_even(int n) { return n < 1216 ? n : (n < 1224 ? 3008 + (n - 1216) : n - 8); }
DI void transpose_tile(const float* W, int K, int N, bf16* WT, int mapmode, int tile, float* scr) {
  const int tid = opaque_tid();
  const int ntn = (N + 63) >> 6, kt = tile / ntn, nt = tile % ntn, k0 = kt * 64, n0 = nt * 64;
#pragma unroll
  for (int i = 0; i < 8; ++i) {
    const int kk = (tid >> 6) + 8 * i, nn = tid & 63, n = n0 + nn;
    scr[kk * 65 + nn] = (n < N) ? W[(size_t)(k0 + kk) * N + n] : 0.f;
  }
  __syncthreads();
  {
    const int nn = tid >> 3, kc = tid & 7, n = n0 + nn;
    if (n < N) {
      const int dst = mapmode == 1 ? phys_col(map_even(n)) : (mapmode == 2 ? phys_col(n) : n);
      const float* s = scr + (kc * 8) * 65 + nn;
      u32x4 o; o.x = cvtpk(s[0], s[65]); o.y = cvtpk(s[2 * 65], s[3 * 65]); o.z = cvtpk(s[4 * 65], s[5 * 65]); o.w = cvtpk(s[6 * 65], s[7 * 65]);
      *(u32x4*)(WT + (size_t)dst * K + k0 + kc * 8) = o;
    }
  }
  __syncthreads();
}

DI float wave_sum(float v) {
#pragma unroll
  for (int o = 1; o < 64; o <<= 1) v += __shfl_xor(v, o);
  return v;
}

DI void phase_prologue(const Params& p, char* lds) {
  const int tid = opaque_tid(), lane = tid & 63, wid = tid >> 6;
  const int nb = gridDim.x, bid = blockIdx.x;
  unsigned char* ws = p.ws;
  float* scr = (float*)lds;
  const int T0 = 16 * 48, T1 = 256, T2 = 16 * 64, T3 = 256, T4 = 256, T5 = 256, T6 = 64, T7 = 64;
  const int NT = T0 + T1 + T2 + T3 + T4 + T5 + T6 + T7;
  for (int it = bid; it < NT; it += nb) {
    int r = it;
    if (r < T0) { transpose_tile(p.in[I_W_IN_EVEN], 1024, 3016, (bf16*)(ws + WS_WINE), 1, r, scr); continue; } r -= T0;
    if (r < T1) { transpose_tile(p.in[I_W_OUT_EVEN], 1024, 1024, (bf16*)(ws + WS_WOUTE), 0, r, scr); continue; } r -= T1;
    if (r < T2) { transpose_tile(p.in[I_W_IN_ODD], 1024, 4096, (bf16*)(ws + WS_WINO), 2, r, scr); continue; } r -= T2;
    if (r < T3) { transpose_tile(p.in[I_W_OUT_ODD], 1024, 1024, (bf16*)(ws + WS_WOUTO), 0, r, scr); continue; } r -= T3;
    if (r < T4) { transpose_tile(p.in[I_W_PLE_GATE], 1024, 1024, (bf16*)(ws + WS_WG0), 0, r, scr); continue; } r -= T4;
    if (r < T5) { transpose_tile(p.in[I_W_PLE_GATE] + 1024 * 1024, 1024, 1024, (bf16*)(ws + WS_WG1), 0, r, scr); continue; } r -= T5;
    if (r < T6) { transpose_tile(p.in[I_W_PLE_PROJ], 256, 1024, (bf16*)(ws + WS_WP0), 0, r, scr); continue; } r -= T6;
    transpose_tile(p.in[I_W_PLE_PROJ] + 256 * 1024, 256, 1024, (bf16*)(ws + WS_WP1), 0, r, scr);
  }
  const int gt = bid * NTHREADS + tid, ngt = nb * NTHREADS;
  { unsigned* z = (unsigned*)(ws + WS_WINE); for (int i = gt; i < 56 * 512; i += ngt) z[(size_t)phys_col(3016 + (i >> 9)) * 512 + (i & 511)] = 0u; }
  { const f32x4* src = (const f32x4*)p.in[I_P]; u32x2* dst = (u32x2*)(ws + WS_PBF); for (int i = gt; i < 2 * NTOK * 256 / 4; i += ngt) { const f32x4 v = src[i]; u32x2 w; w.x = cvtpk(v.x, v.y); w.y = cvtpk(v.z, v.w); dst[i] = w; } }
  { float* ss = (float*)(ws + WS_SS); for (int i = gt; i < 3 * NTOK; i += ngt) ss[i] = 0.f; }
  { float2* tab = (float2*)(ws + WS_ROPE);
    for (int i = gt; i < SEQ * 32; i += ngt) {
      const int pos = i >> 5, k = i & 31;
      const float ang = (float)pos * p.inv_freq[k];
      double rev = (double)ang * 0.15915494309189535; rev -= floor(rev);
      const float rf = (float)rev;
      tab[i] = make_float2(__builtin_amdgcn_cosf(rf), __builtin_amdgcn_sinf(rf));
    } }
  if (bid == 0 && wid == 0) {
    const float a = wave_sum(p.in[I_LQ1][lane] * p.in[I_LK1][lane]);
    const float b = wave_sum(p.in[I_LQ2][lane] * p.in[I_LK2][lane]);
    const float lambda_init = 0.8f - 0.6f * expf(-0.3f);
    if (lane == 0) *(float*)(ws + WS_LAM) = expf(a) - expf(b) + lambda_init;
  }
  { const float* x = p.in[I_X]; const float* g = p.in[I_NORM_GAIN]; bf16* H = (bf16*)(ws + WS_ACT);
    const int gw = bid * 8 + wid, ngw = nb * 8;
    for (int m = gw; m < NTOK; m += ngw) {
      const f32x4* xr = (const f32x4*)(x + (size_t)m * DM) + lane;
      f32x4 v[4]; float s = 0.f;
#pragma unroll
      for (int j = 0; j < 4; ++j) { v[j] = xr[64 * j]; s += v[j].x * v[j].x + v[j].y * v[j].y + v[j].z * v[j].z + v[j].w * v[j].w; }
      const float rstd = rsqrtf(wave_sum(s) * (1.f / DM) + EPS);
      u32x2* o = (u32x2*)(H + (size_t)m * DM) + lane;
#pragma unroll
      for (int j = 0; j < 4; ++j) { const f32x4 gg = *((const f32x4*)g + lane + 64 * j); u32x2 w; w.x = cvtpk(v[j].x * rstd * gg.x, v[j].y * rstd * gg.y); w.y = cvtpk(v[j].z * rstd * gg.z, v[j].w * rstd * gg.w); o[64 * j] = w; }
    } }
}

namespace pg8 {
#define PG8_LAS __attribute__((address_space(3)))
typedef unsigned short bf16_t;
typedef short bf16x8 __attribute__((ext_vector_type(8)));
typedef float f32x4 __attribute__((ext_vector_type(4)));
typedef unsigned u32x4 __attribute__((ext_vector_type(4)));
constexpr int BM = 256, BK = 64, HALF = 128, HTB = HALF * BK * 2  , STAGE_BYTES = 8 * HTB, NXCD = 8, WGM = 8;

__host__ __device__ __forceinline__ int lds_byte(int r, int c) { const int st = (r >> 4) * 2 + (c >> 5), rr = r & 15, cc = c & 31, ob = rr * 64 + cc * 2; return st * 1024 + (ob ^ (((ob >> 9) & 1) << 5)); }
__host__ __device__ __forceinline__ void stage_rc(int b, int& R, int& C) { const int st = b / 1024, sb = b % 1024, swz = sb ^ (((sb >> 9) & 1) << 5); R = (st >> 1) * 16 + swz / 64; C = (st & 1) * 32 + (swz % 64) / 2; }
__host__ __device__ __forceinline__ int perm32(int rho) { const int n = rho >> 4, i = rho & 15; return 8 * (i >> 2) + 4 * n + (i & 3); }

struct Unit { int pm, pn; };
struct Gemm { const bf16_t* A; const bf16_t* Bt; int M, N, K; };

struct StaticOrder {
    int nM, nN, nwg, G, c;
    __host__ __device__ void init(int M, int N, int G_, int c_) { nM = M / BM; nN = N / BM; nwg = nM * nN; G = G_; c = c_; }
    __host__ __device__ bool next(int i, Unit& u) const {
        const long L = (long)i * G + c; if (L >= nwg) return false;
        int wgid = (int)L; { const int q = nwg / NXCD, r = nwg % NXCD, xcd = wgid % NXCD, off = wgid / NXCD; wgid = (xcd < r ? xcd * (q + 1) : r * (q + 1) + (xcd - r) * q) + off; }
        const int nig = WGM * nN, gid = wgid / nig, fm = gid * WGM, gsz = (nM - fm) < WGM ? (nM - fm) : WGM;
        u.pm = fm + ((wgid % nig) % gsz); u.pn = (wgid % nig) / gsz; return true;
    }
    __device__ __forceinline__ void a_ready(const Unit&) const {}
    __device__ __forceinline__ void done(const Unit&) const {}
};
__device__ __forceinline__ unsigned cvt_pk_bf16(float lo, float hi) { unsigned r; asm volatile("v_cvt_pk_bf16_f32 %0, %1, %2" : "=v"(r) : "v"(lo), "v"(hi)); return r; }
template <class Epi, class Sched, bool ALIGN_EPI = false, bool SP2 = false>
__device__ __forceinline__ void gemm_phase(PG8_LAS unsigned char* lds, const Gemm g, const Sched& S, const Epi& E) {
    int tid_ = threadIdx.x; asm volatile("" : "+v"(tid_));
    const int tid = tid_, wid = __builtin_amdgcn_readfirstlane(tid >> 6), lane = tid & 63, wr = wid >> 2, wc = wid & 3, fr = lane & 15, fq = lane >> 4;
    const int K = g.K, nt = K / BK;
    unsigned voffA[2], voffB[2];
#pragma unroll
    for (int i = 0; i < 2; ++i) { int R, C; stage_rc(tid * 16 + i * 8192, R, C); const int Rb = Epi::PERM ? ((R & ~31) + perm32(R & 31)) : R;
        voffA[i] = (unsigned)(R * K + C) * 2u; voffB[i] = (unsigned)(Rb * K + C) * 2u; }
    const size_t kstep = (size_t)(BK * 2);
    const size_t hstep = (size_t)HALF * K * 2;
    const size_t tstep = 2 * hstep;
    const unsigned ldsw = (unsigned)wid * 1024u;
    const int aoff = lds_byte(wr * 64 + fr, fq * 8), boff = lds_byte(wc * 32 + fr, fq * 8);
#define PG8_SA(b, h) (((b) * 2 + (h)) * HTB)
#define PG8_SB(b, h) ((4 + (b) * 2 + (h)) * HTB)
#define PG8_STAGE(bufoff, gbase, voff) do { _Pragma("unroll") for (int _i = 0; _i < 2; ++_i) \
        __builtin_amdgcn_global_load_lds((const unsigned*)((const char*)(gbase) + (voff)[_i]), (PG8_LAS unsigned*)(lds + (bufoff) + ldsw + _i * 8192), 16, 0, 0); } while (0)
#define PG8_LDA(dst, b, h) do { _Pragma("unroll") for (int m = 0; m < 4; ++m) _Pragma("unroll") for (int k = 0; k < 2; ++k) dst[m][k] = *(const PG8_LAS bf16x8*)(lds + PG8_SA(b, h) + aoff + m * 2048 + k * 1024); } while (0)
#define PG8_LDB(dst, b, h) do { _Pragma("unroll") for (int n = 0; n < 2; ++n) _Pragma("unroll") for (int k = 0; k < 2; ++k) dst[n][k] = *(const PG8_LAS bf16x8*)(lds + PG8_SB(b, h) + boff + n * 2048 + k * 1024); } while (0)
#define PG8_MMA(ai, bj, At, Bt) do { __builtin_amdgcn_s_setprio(1); _Pragma("unroll") for (int m = 0; m < 4; ++m) _Pragma("unroll") for (int n = 0; n < 2; ++n) _Pragma("unroll") for (int k = 0; k < 2; ++k) \
        acc[ai][bj][m][n] = __builtin_amdgcn_mfma_f32_16x16x32_bf16(Bt[n][k], At[m][k], acc[ai][bj][m][n], 0, 0, 0); __builtin_amdgcn_s_setprio(0); } while (0)
#define PG8_WAIT_V(n) asm volatile("s_waitcnt vmcnt(" #n ")" ::: "memory")
#define PG8_WAIT_L(n) asm volatile("s_waitcnt lgkmcnt(" #n ")" ::: "memory")
#define PG8_BAR __builtin_amdgcn_s_barrier()
#define PG8_SCHED __builtin_amdgcn_sched_barrier(0)
    Unit cur, nxt; int ui = 0;
    if (!S.next(0, cur)) return;
    f32x4 acc[2][2][4][2];
#pragma unroll
    for (int a = 0; a < 2; ++a)
#pragma unroll
        for (int b = 0; b < 2; ++b)
#pragma unroll
            for (int m = 0; m < 4; ++m)
#pragma unroll
                for (int n = 0; n < 2; ++n) acc[a][b][m][n] = (f32x4){0.f, 0.f, 0.f, 0.f};
    bf16x8 At[4][2], B0[2][2], B1[2][2];
    const char* cA = (const char*)g.A + (size_t)cur.pm * tstep; const char* cB = (const char*)g.Bt + (size_t)cur.pn * tstep;
    S.a_ready(cur);
    if constexpr (SP2) {
        PG8_STAGE(PG8_SB(0, 0), cB, voffB); PG8_STAGE(PG8_SB(0, 1), cB + hstep, voffB); PG8_STAGE(PG8_SA(0, 0), cA, voffA); PG8_STAGE(PG8_SA(0, 1), cA + hstep, voffA);
        if (wr == 1) PG8_BAR;
        PG8_WAIT_V(2); PG8_BAR;
        PG8_STAGE(PG8_SB(1, 0), cB + kstep, voffB); PG8_STAGE(PG8_SA(1, 0), cA + kstep, voffA); PG8_STAGE(PG8_SB(1, 1), cB + hstep + kstep, voffB);
        PG8_WAIT_V(6); PG8_BAR;
    } else {
        PG8_STAGE(PG8_SB(0, 0), cB, voffB); PG8_STAGE(PG8_SA(0, 0), cA, voffA); PG8_STAGE(PG8_SB(0, 1), cB + hstep, voffB); PG8_STAGE(PG8_SA(0, 1), cA + hstep, voffA);
        if (wr == 1) PG8_BAR;
        PG8_WAIT_V(4); PG8_BAR;
        PG8_STAGE(PG8_SB(1, 0), cB + kstep, voffB); PG8_STAGE(PG8_SA(1, 0), cA + kstep, voffA); PG8_STAGE(PG8_SB(1, 1), cB + hstep + kstep, voffB);
        PG8_WAIT_V(6); PG8_BAR;
    }
    for (;;) {
        const bool has_next = S.next(ui + 1, nxt);
        const char* nA = has_next ? (const char*)g.A + (size_t)nxt.pm * tstep : cA; const char* nB = has_next ? (const char*)g.Bt + (size_t)nxt.pn * tstep : cB;
        for (int t = 0; t < nt; t += 2) {
            const bool last = (t == nt - 2);
            const char* a1 = cA + (size_t)(t + 1) * kstep;
            const char* a2 = last ? nA : cA + (size_t)(t + 2) * kstep; const char* b2 = last ? nB : cB + (size_t)(t + 2) * kstep;
            const char* a3 = a2 + kstep; const char* b3 = b2 + kstep;
            if (last && has_next) S.a_ready(nxt);
            if constexpr (SP2) {
            PG8_LDB(B0, 0, 0); PG8_LDB(B1, 0, 1); PG8_SCHED; PG8_LDA(At, 0, 0); PG8_STAGE(PG8_SA(1, 1), a1 + hstep, voffA);
            PG8_WAIT_V(8); PG8_WAIT_L(0); PG8_BAR; PG8_MMA(0, 0, At, B0); PG8_MMA(0, 1, At, B1); PG8_BAR; PG8_SCHED;
            PG8_LDA(At, 0, 1); PG8_STAGE(PG8_SB(0, 0), b2, voffB); PG8_STAGE(PG8_SB(0, 1), b2 + hstep, voffB); PG8_STAGE(PG8_SA(0, 0), a2, voffA);
            PG8_WAIT_V(8); PG8_WAIT_L(0); PG8_BAR; PG8_MMA(1, 0, At, B0); PG8_MMA(1, 1, At, B1); PG8_BAR; PG8_SCHED;
            PG8_LDB(B0, 1, 0); PG8_LDB(B1, 1, 1); PG8_SCHED; PG8_LDA(At, 1, 0); PG8_STAGE(PG8_SA(0, 1), a2 + hstep, voffA);
            PG8_WAIT_V(8); PG8_WAIT_L(0); PG8_BAR; PG8_MMA(0, 0, At, B0); PG8_MMA(0, 1, At, B1); PG8_BAR; PG8_SCHED;
            PG8_LDA(At, 1, 1); PG8_STAGE(PG8_SB(1, 0), b3, voffB); PG8_STAGE(PG8_SB(1, 1), b3 + hstep, voffB); PG8_STAGE(PG8_SA(1, 0), a3, voffA);
            PG8_WAIT_V(8); PG8_WAIT_L(0); PG8_BAR; PG8_MMA(1, 0, At, B0); PG8_MMA(1, 1, At, B1); PG8_BAR; PG8_SCHED;
            } else {
            PG8_LDB(B0, 0, 0); PG8_SCHED; PG8_LDA(At, 0, 0); PG8_STAGE(PG8_SA(1, 1), a1 + hstep, voffA);
            PG8_WAIT_L(8); PG8_BAR; PG8_WAIT_L(0); PG8_MMA(0, 0, At, B0); PG8_BAR; PG8_SCHED;
            PG8_LDB(B1, 0, 1); PG8_STAGE(PG8_SB(0, 0), b2, voffB);
            PG8_BAR; PG8_WAIT_L(0); PG8_MMA(0, 1, At, B1); PG8_BAR;
            PG8_LDA(At, 0, 1); PG8_STAGE(PG8_SA(0, 0), a2, voffA);
            PG8_BAR; PG8_WAIT_L(0); PG8_MMA(1, 0, At, B0); PG8_BAR; PG8_SCHED;
            PG8_STAGE(PG8_SB(0, 1), b2 + hstep, voffB);
            PG8_WAIT_V(6); PG8_BAR; PG8_MMA(1, 1, At, B1); PG8_BAR;
            PG8_LDB(B0, 1, 0); PG8_SCHED; PG8_LDA(At, 1, 0); PG8_STAGE(PG8_SA(0, 1), a2 + hstep, voffA);
            PG8_WAIT_L(8); PG8_BAR; PG8_WAIT_L(0); PG8_MMA(0, 0, At, B0); PG8_BAR; PG8_SCHED;
            PG8_LDB(B1, 1, 1); PG8_STAGE(PG8_SB(1, 0), b3, voffB);
            PG8_BAR; PG8_WAIT_L(0); PG8_MMA(0, 1, At, B1); PG8_BAR;
            PG8_LDA(At, 1, 1); PG8_STAGE(PG8_SA(1, 0), a3, voffA);
            PG8_BAR; PG8_WAIT_L(0); PG8_MMA(1, 0, At, B0); PG8_BAR; PG8_SCHED;
            PG8_STAGE(PG8_SB(1, 1), b3 + hstep, voffB);
            PG8_WAIT_V(6); PG8_BAR; PG8_MMA(1, 1, At, B1); PG8_BAR;
            }
        }
        if constexpr (ALIGN_EPI) { if (wr == 0) PG8_BAR; }
        if constexpr (!Epi::AFTER_DRAIN) { E(acc, cur, wr, wc, fr, fq); S.done(cur); }
        if (!has_next) break;
#pragma unroll
        for (int a = 0; a < 2; ++a)
#pragma unroll
            for (int b = 0; b < 2; ++b)
#pragma unroll
                for (int m = 0; m < 4; ++m)
#pragma unroll
                    for (int n = 0; n < 2; ++n) acc[a][b][m][n] = (f32x4){0.f, 0.f, 0.f, 0.f};
        cur = nxt; cA = nA; cB = nB; ++ui;
        if constexpr (ALIGN_EPI) { if (wr == 1) PG8_BAR; }
    }
    PG8_WAIT_V(0);
    if constexpr (!ALIGN_EPI) { if (wr == 0) PG8_BAR; }
    PG8_BAR;
    if constexpr (Epi::AFTER_DRAIN) { E.fused(acc, cur, wr, wc, fr, fq, lds, wid, lane); S.done(cur); }
#undef PG8_SA
#undef PG8_SB
#undef PG8_STAGE
#undef PG8_LDA
#undef PG8_LDB
#undef PG8_MMA
#undef PG8_WAIT_V
#undef PG8_WAIT_L
#undef PG8_BAR
#undef PG8_SCHED
}
}

enum { T_PLAIN = 0, T_NR = 1, T_ROPE = 2, T_SILU = 3, T_IW = 4 };
DI void slot_info(const Params& p, int layer, int slot, int& type, const float*& gain) {
  gain = nullptr;
  if (layer == 0) {
    if (slot < 8) { type = T_NR; gain = p.in[I_A_Q_GAIN]; }
    else if (slot == 8) { type = T_NR; gain = p.in[I_A_K_GAIN]; }
    else if (slot == 9) type = T_PLAIN;
    else if (slot < 18) type = T_ROPE;
    else if (slot == 18) { type = T_NR; gain = p.in[I_IDX_K_GAIN]; }
    else if (slot < 27) type = T_SILU;
    else if (slot < 35) { type = T_NR; gain = p.in[I_B_Q_GAIN]; }
    else if (slot < 37) { type = T_NR; gain = p.in[I_B_K_GAIN]; }
    else if (slot < 39) type = T_PLAIN;
    else if (slot < 47) type = T_SILU;
    else type = T_IW;
  } else {
    if (slot < 8) { type = T_NR; gain = p.in[I_C_Q_GAIN]; }
    else if (slot < 16) { type = T_NR; gain = p.in[I_C_K_GAIN]; }
    else if (slot < 24) type = T_PLAIN;
    else if (slot < 32) type = T_SILU;
    else if (slot < 40) { type = T_NR; gain = p.in[I_D_Q_GAIN]; }
    else if (slot < 48) { type = T_NR; gain = p.in[I_D_K_GAIN]; }
    else if (slot < 56) type = T_PLAIN;
    else type = T_SILU;
  }
}
constexpr int E_AQ = 0, E_AK = 512, E_AV = 576, E_IQ = 640, E_IK = 1152, E_AG = 1216, E_BQ = 1728, E_BK = 2240, E_BV = 2368, E_BG = 2496;
constexpr int O_CQ = 0, O_CK = 512, O_CV = 1024, O_CG = 1536, O_DQ = 2048, O_DK = 2560, O_DV = 3072, O_DG = 3584;

typedef pg8::f32x4 (AccT)[2][2][4][2];

struct EpiInProj {
  static constexpr bool PERM = false, AFTER_DRAIN = false;
  const Params& p; int layer;
  DI void operator()(const f32x4 (&acc)[2][2][4][2], const pg8::Unit& u, int wr, int wc, int fr, int fq) const {
    unsigned char* ws = p.ws;
    const int NP = layer == 0 ? NPE : NPO;
    bf16* PE = (bf16*)(ws + WS_PE);
    const float2* rope = (const float2*)(ws + WS_ROPE);
    const float* ss1 = (const float*)(ws + WS_SS);
    float* IW = (float*)(ws + WS_IW);
    const int slot = u.pn * 4 + wc;
    int type; const float* gain; slot_info(p, layer, slot, type, gain);
#pragma unroll
    for (int ai = 0; ai < 2; ++ai)
#pragma unroll
      for (int m = 0; m < 4; ++m) {
        const int row = u.pm * 256 + ai * 128 + wr * 64 + m * 16 + fr, pos = row & (SEQ - 1);
        float sc = 1.f;
        if (layer == 1) sc = rsqrtf(ss1[row] * (1.f / DM) + EPS);
        f32x4 v1[2], v2[2];
#pragma unroll
        for (int n = 0; n < 2; ++n) { v1[n] = acc[ai][0][m][n] * sc; v2[n] = acc[ai][1][m][n] * sc; }
        if (type == T_NR) {
          float s = 0.f;
#pragma unroll
          for (int n = 0; n < 2; ++n) s += v1[n].x * v1[n].x + v1[n].y * v1[n].y + v1[n].z * v1[n].z + v1[n].w * v1[n].w + v2[n].x * v2[n].x + v2[n].y * v2[n].y + v2[n].z * v2[n].z + v2[n].w * v2[n].w;
          s += __shfl_xor(s, 16); s += __shfl_xor(s, 32);
          const float rn = rsqrtf(s * (1.f / 64.f) + EPS);
#pragma unroll
          for (int n = 0; n < 2; ++n) { const f32x4 g1 = *(const f32x4*)(gain + n * 16 + fq * 4), g2 = *(const f32x4*)(gain + 32 + n * 16 + fq * 4); v1[n] = v1[n] * rn * g1; v2[n] = v2[n] * rn * g2; }
        }
        if (type == T_NR || type == T_ROPE) {
#pragma unroll
          for (int n = 0; n < 2; ++n) {
            const f32x4* cs = (const f32x4*)(rope + (size_t)pos * 32 + n * 16 + fq * 4);
            const f32x4 c01 = cs[0], c23 = cs[1];
            const f32x4 x1 = v1[n], x2 = v2[n];
            f32x4 o1, o2;
            o1.x = x1.x * c01.x - x2.x * c01.y; o2.x = x2.x * c01.x + x1.x * c01.y;
            o1.y = x1.y * c01.z - x2.y * c01.w; o2.y = x2.y * c01.z + x1.y * c01.w;
            o1.z = x1.z * c23.x - x2.z * c23.y; o2.z = x2.z * c23.x + x1.z * c23.y;
            o1.w = x1.w * c23.z - x2.w * c23.w; o2.w = x2.w * c23.z + x1.w * c23.w;
            v1[n] = o1; v2[n] = o2;
          }
        }
        if (type == T_SILU) {
#pragma unroll
          for (int n = 0; n < 2; ++n)
#pragma unroll
            for (int j = 0; j < 4; ++j) { const float a = v1[n][j]; v1[n][j] = a / (1.f + __expf(-a)); const float b = v2[n][j]; v2[n][j] = b / (1.f + __expf(-b)); }
        }
        if (type == T_IW) {
          if (fq < 2) *(f32x4*)(IW + (size_t)row * 8 + fq * 4) = v1[0];
        } else {
          bf16* dst = PE + (size_t)row * NP + slot * 64 + fq * 4;
#pragma unroll
          for (int n = 0; n < 2; ++n) {
            u32x2 w1, w2; w1.x = cvtpk(v1[n].x, v1[n].y); w1.y = cvtpk(v1[n].z, v1[n].w); w2.x = cvtpk(v2[n].x, v2[n].y); w2.y = cvtpk(v2[n].z, v2[n].w);
            *(u32x2*)(dst + n * 16) = w1; *(u32x2*)(dst + 32 + n * 16) = w2;
            if (layer == 0 && slot == 18) { bf16* IKS = (bf16*)(ws + WS_IKS); const int key = row & (SEQ - 1);
              bf16* base = IKS + (((size_t)(row >> 13) * 256 + (key >> 5)) * 4) * 512 + ((fq >> 1) * 32 + (key & 31)) * 8 + (fq & 1) * 4;
              *(u32x2*)(base + (size_t)n * 512) = w1; *(u32x2*)(base + (size_t)(n + 2) * 512) = w2; }
          }
        }
        asm volatile("" ::: "memory");
      }
  }
};

DI void phase_inproj(const Params& p, int layer, char* lds) {
  unsigned char* ws = p.ws;
  const int NP = layer == 0 ? NPE : NPO;
  pg8::Gemm g{(const bf16*)(ws + (layer == 0 ? WS_ACT : WS_Y)), (const bf16*)(ws + (layer == 0 ? WS_WINE : WS_WINO)), NTOK, NP, DM};
  pg8::StaticOrder S; S.init(NTOK, NP, (int)gridDim.x, (int)blockIdx.x);
  EpiInProj E{p, layer};
  pg8::gemm_phase<EpiInProj, pg8::StaticOrder, true, true>((PG8_LAS unsigned char*)lds, g, S, E);
}

struct EpiOutProj {
  static constexpr bool PERM = false, AFTER_DRAIN = false;
  const float* xin; float* out; bf16* XG; const float* pg; float* ss;
  DI void operator()(const f32x4 (&acc)[2][2][4][2], const pg8::Unit& u, int wr, int wc, int fr, int fq) const {
#pragma unroll
    for (int ai = 0; ai < 2; ++ai)
#pragma unroll
      for (int m = 0; m < 4; ++m) {
        const int row = u.pm * 256 + ai * 128 + wr * 64 + m * 16 + fr; float rs = 0.f;
#pragma unroll
        for (int bj = 0; bj < 2; ++bj)
#pragma unroll
          for (int n = 0; n < 2; ++n) {
            const int col = u.pn * 256 + bj * 128 + wc * 32 + n * 16 + fq * 4; const size_t off = (size_t)row * DM + col;
            const f32x4 xn = *(const f32x4*)(xin + off) + acc[ai][bj][m][n];
            *(f32x4*)(out + off) = xn;
            rs += xn.x * xn.x + xn.y * xn.y + xn.z * xn.z + xn.w * xn.w;
            const f32x4 gg = *(const f32x4*)(pg + col);
            u32x2 w; w.x = cvtpk(xn.x * gg.x, xn.y * gg.y); w.y = cvtpk(xn.z * gg.z, xn.w * gg.w); *(u32x2*)(XG + off) = w;
          }
        rs += __shfl_xor(rs, 16); rs += __shfl_xor(rs, 32);
        if (fq == 0) atomicAdd(ss + row, rs);
        asm volatile("" ::: "memory");
      }
  }
};
DI void phase_outproj(const Params& p, int layer, char* lds) {
  unsigned char* ws = p.ws;
  pg8::Gemm g{(const bf16*)(ws + WS_Y), (const bf16*)(ws + (layer == 0 ? WS_WOUTE : WS_WOUTO)), NTOK, DM, DM};
  pg8::StaticOrder S; S.init(NTOK, DM, (int)gridDim.x, (int)blockIdx.x);
  EpiOutProj E{layer == 0 ? p.in[I_X] : p.out, p.out, (bf16*)(ws + WS_ACT), p.in[I_PLE_NORM_GAIN] + layer * DM, (float*)(ws + WS_SS) + (layer == 0 ? 1 : 2) * NTOK};
  pg8::gemm_phase<EpiOutProj, pg8::StaticOrder, true, true>((PG8_LAS unsigned char*)lds, g, S, E);
}

struct EpiPleProj {
  static constexpr bool PERM = false, AFTER_DRAIN = false;
  float* PT;
  DI void operator()(const f32x4 (&acc)[2][2][4][2], const pg8::Unit& u, int wr, int wc, int fr, int fq) const {
#pragma unroll
    for (int ai = 0; ai < 2; ++ai)
#pragma unroll
      for (int m = 0; m < 4; ++m) {
        const int row = u.pm * 256 + ai * 128 + wr * 64 + m * 16 + fr;
#pragma unroll
        for (int bj = 0; bj < 2; ++bj)
#pragma unroll
          for (int n = 0; n < 2; ++n) *(f32x4*)(PT + (size_t)row * DM + u.pn * 256 + bj * 128 + wc * 32 + n * 16 + fq * 4) = acc[ai][bj][m][n];
      }
  }
};
struct EpiPleGate {
  static constexpr bool PERM = false, AFTER_DRAIN = false;
  const float* PT; float* out; const float* ssx; float* ss1; bf16* H; const float* ng1; int layer;
  DI void operator()(const f32x4 (&acc)[2][2][4][2], const pg8::Unit& u, int wr, int wc, int fr, int fq) const {
#pragma unroll
    for (int ai = 0; ai < 2; ++ai)
#pragma unroll
      for (int m = 0; m < 4; ++m) {
        const int row = u.pm * 256 + ai * 128 + wr * 64 + m * 16 + fr; float rs = 0.f;
        const float rstd = rsqrtf(ssx[row] * (1.f / DM) + EPS);
#pragma unroll
        for (int bj = 0; bj < 2; ++bj)
#pragma unroll
          for (int n = 0; n < 2; ++n) {
            const int col = u.pn * 256 + bj * 128 + wc * 32 + n * 16 + fq * 4; const size_t off = (size_t)row * DM + col;
            f32x4 g;
#pragma unroll
            for (int j = 0; j < 4; ++j) g[j] = 1.f / (1.f + __expf(-rstd * acc[ai][bj][m][n][j]));
            const f32x4 xn = *(const f32x4*)(out + off) + *(const f32x4*)(PT + off) * g;
            *(f32x4*)(out + off) = xn;
            if (layer == 0) {
              rs += xn.x * xn.x + xn.y * xn.y + xn.z * xn.z + xn.w * xn.w;
              const f32x4 gg = *(const f32x4*)(ng1 + col);
              u32x2 w; w.x = cvtpk(xn.x * gg.x, xn.y * gg.y); w.y = cvtpk(xn.z * gg.z, xn.w * gg.w); *(u32x2*)(H + off) = w;
            }
          }
        if (layer == 0) { rs += __shfl_xor(rs, 16); rs += __shfl_xor(rs, 32); if (fq == 0) atomicAdd(ss1 + row, rs); }
        asm volatile("" ::: "memory");
      }
  }
};
DI void phase_ple(const Params& p, int layer, char* lds) {
  unsigned char* ws = p.ws;
  float* PT = (float*)(ws + WS_PE);
  pg8::StaticOrder S; S.init(NTOK, DM, (int)gridDim.x, (int)blockIdx.x);
  { pg8::Gemm g{(const bf16*)(ws + WS_PBF) + (size_t)layer * NTOK * 256, (const bf16*)(ws + (layer == 0 ? WS_WP0 : WS_WP1)), NTOK, DM, 256};
    EpiPleProj E{PT};
    pg8::gemm_phase<EpiPleProj, pg8::StaticOrder, true, true>((PG8_LAS unsigned char*)lds, g, S, E); }
  { pg8::Gemm g{(const bf16*)(ws + WS_ACT), (const bf16*)(ws + (layer == 0 ? WS_WG0 : WS_WG1)), NTOK, DM, DM};
    EpiPleGate E{PT, p.out, (const float*)(ws + WS_SS) + (layer == 0 ? 1 : 2) * NTOK, (float*)(ws + WS_SS), (bf16*)(ws + WS_Y), p.in[I_NORM_GAIN] + DM, layer};
    pg8::gemm_phase<EpiPleGate, pg8::StaticOrder, true, true>((PG8_LAS unsigned char*)lds, g, S, E); }
}

template <int DVB, bool MASKED = true>
DI void attn_step32(const bf16* Kt, int KP, const bf16* Vt, int VP, const bf16x8 (&qf)[4], f32x16 (&o)[DVB], float& m, float& l, unsigned vmask, float c2, int lane) {
  const int r32 = lane & 31, h = lane >> 5;
  f32x16 s;
#pragma unroll
  for (int i = 0; i < 16; ++i) s[i] = 0.f;
#pragma unroll
  for (int t = 0; t < 4; ++t) { const bf16x8 kf = *(const bf16x8*)(Kt + r32 * KP + t * 16 + h * 8); s = mfma32(kf, qf[t], s); }
  float mx = -INFINITY;
#pragma unroll
  for (int i = 0; i < 16; ++i) { if (MASKED) { s[i] = ((vmask >> i) & 1u) ? s[i] : -INFINITY; } mx = fmaxf(mx, s[i]); }
  mx = fmaxf(mx, __shfl_xor(mx, 32));
  const float mn = fmaxf(m, mx * c2);
  if (__any(mn > m)) {
    const float alpha = fexp2(m - mn); l *= alpha;
#pragma unroll
    for (int d = 0; d < DVB; ++d)
#pragma unroll
      for (int i = 0; i < 16; ++i) o[d][i] *= alpha;
    m = mn;
  }
  float ps = 0.f; const float negm = -m;
#pragma unroll
  for (int i = 0; i < 16; ++i) { const float pv = fexp2(__builtin_fmaf(s[i], c2, negm)); s[i] = pv; ps += pv; }
  l += ps;
  bf16x8 pf[2];
  { u32x4 a, b; a.x = cvtpk(s[0], s[1]); a.y = cvtpk(s[2], s[3]); a.z = cvtpk(s[4], s[5]); a.w = cvtpk(s[6], s[7]);
    b.x = cvtpk(s[8], s[9]); b.y = cvtpk(s[10], s[11]); b.z = cvtpk(s[12], s[13]); b.w = cvtpk(s[14], s[15]);
    pf[0] = __builtin_bit_cast(bf16x8, a); pf[1] = __builtin_bit_cast(bf16x8, b); }
  const int i16 = lane & 15, q = i16 >> 2, pp = i16 & 3, blk = (lane >> 4) & 1;
#pragma unroll
  for (int d = 0; d < DVB; ++d)
#pragma unroll
    for (int sk = 0; sk < 2; ++sk) {
      const s16x4 lo = trread(Vt + (16 * sk + 4 * h + q) * VP + 32 * d + 16 * blk + 4 * pp);
      const s16x4 hi = trread(Vt + (16 * sk + 8 + 4 * h + q) * VP + 32 * d + 16 * blk + 4 * pp);
      const bf16x8 vf = __builtin_shufflevector(lo, hi, 0, 1, 2, 3, 4, 5, 6, 7);
      o[d] = mfma32(vf, pf[sk], o[d]);
    }
}

DI unsigned row_range_mask(int lo, int hi) {
  lo = lo < 0 ? 0 : lo; hi = hi > 31 ? 31 : hi;
  if (hi < lo) return 0u;
  const unsigned upto_hi = (hi >= 31) ? 0xffffffffu : ((1u << (hi + 1)) - 1u);
  return upto_hi & ~((1u << lo) - 1u);
}
DI unsigned lane_rows(unsigned m32, int h) {
  const unsigned t = m32 >> (4 * h);
  return (t & 0xFu) | ((t >> 4) & 0xF0u) | ((t >> 8) & 0xF00u) | ((t >> 12) & 0xF000u);
}
constexpr int WP = 72;
constexpr int WAVE_LDS = 2 * 32 * WP * 2;

struct KVRegs { u32x4 k[4], v[4]; };
DI void kv_store(const KVRegs& R, bf16* Ks, bf16* Vs, int lane) {
#pragma unroll
  for (int i = 0; i < 4; ++i) { const int row = (lane >> 3) + 8 * i, ch = lane & 7; *(u32x4*)(Ks + row * WP + ch * 8) = R.k[i]; *(u32x4*)(Vs + row * WP + ch * 8) = R.v[i]; }
}

DI void band_load(KVRegs& R, const bf16* Kg, const bf16* Vg, int NP, int kstart, int dil, int roff, int lane) {
#pragma unroll
  for (int i = 0; i < 4; ++i) {
    const int row = (lane >> 3) + 8 * i, ch = lane & 7; int k = kstart + row; if (k < 0) k = 0;
    const size_t off = (size_t)(dil * k + roff) * NP + ch * 8;
    R.k[i] = *(const u32x4*)(Kg + off); R.v[i] = *(const u32x4*)(Vg + off);
  }
}
template <int DVB>
DI void band_run(const bf16* Kg, const bf16* Vg, int NP, int kbase, int nsteps, int dil, int roff, int qidx, int win,
                 const bf16x8 (&qf)[4], f32x16 (&o)[DVB], float& m, float& l, float c2, bf16* Ks, bf16* Vs, int lane) {
  const int h = lane >> 5;
  KVRegs R; band_load(R, Kg, Vg, NP, kbase, dil, roff, lane);
  for (int j = 0; j < nsteps; ++j) {
    lds_fence();
    kv_store(R, Ks, Vs, lane);
    lds_fence();
    if (j + 1 < nsteps) band_load(R, Kg, Vg, NP, kbase + 32 * (j + 1), dil, roff, lane);
    const int kb = kbase + 32 * j, lo_r = (qidx - win > 0 ? qidx - win : 0) - kb;
    const unsigned vm = lane_rows(row_range_mask(lo_r, qidx - kb), h);
    attn_step32<DVB>(Ks, WP, Vs, WP, qf, o, m, l, vm, c2, lane);
  }
}

DI void write_o64(const f32x16 (&o)[2], float linv, const bf16* gate_row, bf16* y_row, int h) {
#pragma unroll
  for (int d = 0; d < 2; ++d)
#pragma unroll
    for (int g = 0; g < 4; ++g) {
      const int dd = 32 * d + 8 * g + 4 * h;
      const u32x2 gv = *(const u32x2*)(gate_row + dd);
      const float g0 = __uint_as_float(gv.x << 16), g1 = __uint_as_float(gv.x & 0xffff0000u), g2 = __uint_as_float(gv.y << 16), g3 = __uint_as_float(gv.y & 0xffff0000u);
      u32x2 w; w.x = cvtpk(o[d][4 * g] * linv * g0, o[d][4 * g + 1] * linv * g1); w.y = cvtpk(o[d][4 * g + 2] * linv * g2, o[d][4 * g + 3] * linv * g3);
      *(u32x2*)(y_row + dd) = w;
    }
}

DI void load_q(bf16x8 (&qf)[4], const bf16* qrow, int h) {
#pragma unroll
  for (int t = 0; t < 4; ++t) qf[t] = *(const bf16x8*)(qrow + t * 16 + h * 8);
}
template <int DVB> DI void zero_o(f32x16 (&o)[DVB]) {
#pragma unroll
  for (int d = 0; d < DVB; ++d)
#pragma unroll
    for (int i = 0; i < 16; ++i) o[d][i] = 0.f;
}

DI void mixerB_tile(const Params& p, int item, bf16* Ks, bf16* Vs, int lane) {
  const bf16* PE = (const bf16*)(p.ws + WS_PE); bf16* Y = (bf16*)(p.ws + WS_Y);
  const int qblk = item & 255, head = (item >> 8) & 7, b = item >> 11;
  const int r32 = lane & 31, h = lane >> 5, q0 = qblk * 32, kvh = head >> 2;
  const size_t rowb = (size_t)b * SEQ;
  bf16x8 qf[4]; load_q(qf, PE + (rowb + q0 + r32) * NPE + E_BQ + head * 64, h);
  f32x16 o[2]; zero_o<2>(o);
  const float sink2 = p.in[I_B_SINKS][head] * LOG2E;
  float m = sink2, l = (h == 0) ? 1.f : 0.f;
  band_run<2>(PE + rowb * NPE + E_BK + kvh * 64, PE + rowb * NPE + E_BV + kvh * 64, NPE, q0 - 128, 5, 1, 0, q0 + r32, 127, qf, o, m, l, 0.125f * LOG2E, Ks, Vs, lane);
  l += __shfl_xor(l, 32);
  const size_t tok = rowb + q0 + r32;
  write_o64(o, 1.f / l, PE + tok * NPE + E_BG + head * 64, Y + tok * DM + 512 + head * 64, h);
}

DI void mixerC_tile(const Params& p, int item, bf16* Ks, bf16* Vs, int lane) {
  const bf16* PO = (const bf16*)(p.ws + WS_PE); bf16* Y = (bf16*)(p.ws + WS_Y);
  const int qt = item & 15, r16 = (item >> 4) & 15, head = (item >> 8) & 7, b = item >> 11;
  const int r32 = lane & 31, h = lane >> 5, qi0 = qt * 32;
  const size_t rowb = (size_t)b * SEQ;
  const int t = 16 * (qi0 + r32) + r16;
  bf16x8 qf[4]; load_q(qf, PO + (rowb + t) * NPO + O_CQ + head * 64, h);
  f32x16 o[2]; zero_o<2>(o);
  float m = -1e30f, l = 0.f;
  const bf16* Kg = PO + rowb * NPO + O_CK + head * 64; const bf16* Vg = PO + rowb * NPO + O_CV + head * 64;
  const float c2 = 0.125f * LOG2E;
  band_run<2>(Kg, Vg, NPO, qi0 - 128, 5, 16, r16, qi0 + r32, 128, qf, o, m, l, c2, Ks, Vs, lane);
  band_run<2>(Kg, Vg, NPO, 4 * qi0 + (r16 >> 2) - 128, 8, 4, r16 & 3, 4 * (qi0 + r32) + (r16 >> 2), 128, qf, o, m, l, c2, Ks, Vs, lane);
  band_run<2>(Kg, Vg, NPO, 16 * qi0 + r16 - 128, 20, 1, 0, t, 128, qf, o, m, l, c2, Ks, Vs, lane);
  l += __shfl_xor(l, 32);
  const size_t tok = rowb + t;
  write_o64(o, 1.f / l, PO + tok * NPO + O_CG + head * 64, Y + tok * DM + head * 64, h);
}

DI void mixerA_item(const Params& p, int item, bf16* Ks, bf16* Vs, int lane) {
  const bf16* PE = (const bf16*)(p.ws + WS_PE); bf16* Y = (bf16*)(p.ws + WS_Y);
  const unsigned short* SEL = (const unsigned short*)(p.ws + WS_SEL) + (size_t)item * 256;
  const int t = item & (SEQ - 1), b = item >> 13;
  const int r32 = lane & 31, h = lane >> 5, head = r32 & 7;
  const size_t rowb = (size_t)b * SEQ;
  const int count = (t + 1 < 256) ? t + 1 : 256, nsteps = (count + 31) >> 5;
  bf16x8 qf[4]; load_q(qf, PE + (size_t)item * NPE + E_AQ + head * 64, h);
  f32x16 o[2]; zero_o<2>(o);
  float m = -1e30f, l = 0.f;
  const bf16* Kg = PE + rowb * NPE + E_AK; const bf16* Vg = PE + rowb * NPE + E_AV;
  KVRegs R;
#define A_LOAD(j) do { _Pragma("unroll") for (int i = 0; i < 4; ++i) { const int row = (lane >> 3) + 8 * i, ch = lane & 7, e = 32 * (j) + row; \
      const int tokk = (e < count) ? (int)SEL[e] : 0; const size_t off = (size_t)tokk * NPE + ch * 8; R.k[i] = *(const u32x4*)(Kg + off); R.v[i] = *(const u32x4*)(Vg + off); } } while (0)
  A_LOAD(0);
  for (int j = 0; j < nsteps; ++j) {
    lds_fence();
    kv_store(R, Ks, Vs, lane);
    lds_fence();
    if (j + 1 < nsteps) A_LOAD(j + 1);
    const unsigned vm = lane_rows(row_range_mask(0, count - 1 - 32 * j), h);
    attn_step32<2>(Ks, WP, Vs, WP, qf, o, m, l, vm, 0.125f * LOG2E, lane);
  }
#undef A_LOAD
  l += __shfl_xor(l, 32);
  if (r32 < 8) write_o64(o, 1.f / l, PE + (size_t)item * NPE + E_AG + head * 64, Y + (size_t)item * DM + head * 64, h);
}

DI unsigned f2ord(float f) { f += 0.f; const unsigned u = __float_as_uint(f); return (u & 0x80000000u) ? ~u : (u | 0x80000000u); }
DI int block_excl_scan(int v, int* tmp, int* tot) {
  const int lane = threadIdx.x & 63, wid = threadIdx.x >> 6;
  int inc = v;
#pragma unroll
  for (int o = 1; o < 64; o <<= 1) { const int u = __shfl_up(inc, o); if (lane >= o) inc += u; }
  if (lane == 63) tmp[wid] = inc;
  __syncthreads();
  int base = 0, total = 0;
#pragma unroll
  for (int w = 0; w < 8; ++w) { const int x = tmp[w]; if (w < wid) base += x; total += x; }
  *tot = total;
  return base + inc - v;
}

DI float dpp_sum8(float v) {
  v += __builtin_bit_cast(float, __builtin_amdgcn_mov_dpp(__builtin_bit_cast(int, v), 0xB1, 0xF, 0xF, true));
  v += __builtin_bit_cast(float, __builtin_amdgcn_mov_dpp(__builtin_bit_cast(int, v), 0x4E, 0xF, 0xF, true));
  v += __builtin_bit_cast(float, __builtin_amdgcn_mov_dpp(__builtin_bit_cast(int, v), 0x141, 0xF, 0xF, true));
  return v;
}
DI void hist_find(const int* hist, int* misc, int need, int& digit, int& nneed, int& cnt) {
  const int tid = threadIdx.x;
  typedef int i32x4 __attribute__((ext_vector_type(4)));
  const i32x4 h0 = *(const i32x4*)(hist + tid * 8), h1 = *(const i32x4*)(hist + tid * 8 + 4);
  int hh[8] = {h0.x, h0.y, h0.z, h0.w, h1.x, h1.y, h1.z, h1.w}; int tot = 0;
#pragma unroll
  for (int k = 0; k < 8; ++k) tot += hh[k];
  int total; const int ex = block_excl_scan(tot, misc, &total);
  int above = total - ex - tot;
#pragma unroll
  for (int k = 7; k >= 0; --k) { const int c = hh[k]; if (above < need && above + c >= need) { misc[16] = tid * 8 + k; misc[17] = need - above; misc[18] = c; } above += c; }
  __syncthreads();
  digit = misc[16]; nneed = misc[17]; cnt = misc[18];
  __syncthreads();
}
DI unsigned long long mkcmp(float v, int idx) { return ((unsigned long long)f2ord(v) << 16) | ((unsigned long long)(8191 - idx) << 3); }
DI float ord2f(unsigned k) { return __uint_as_float((k & 0x80000000u) ? (k ^ 0x80000000u) : ~k); }
DI float half_sum(float v) { auto rr = __builtin_amdgcn_permlane32_swap(__float_as_uint(v), __float_as_uint(v), false, false); return __uint_as_float(rr[0]) + __uint_as_float(rr[1]); }

constexpr int CL_CAP = 512;
DI void select_slow(const float* scq, int n, unsigned short* out, float lo, float hi, int* hist, int* misc, unsigned long long* clist) {
  const int tid = opaque_tid();
    const float scale = (hi > lo) ? 4095.f / (hi - lo) : 0.f;
    for (int i = tid; i < 4096; i += 512) hist[i] = 0;
    if (tid == 0) misc[20] = 0;
    __syncthreads();
    float val[16]; int bin[16];
#pragma unroll
    for (int i = 0; i < 16; ++i) { const int idx = tid + 512 * i; const float v = (idx < n) ? scq[idx] : lo; val[i] = v;
      int bb = (int)((v - lo) * scale); bb = bb < 0 ? 0 : (bb > 4095 ? 4095 : bb); bin[i] = bb; if (idx < n) atomicAdd(&hist[bb], 1); }
    __syncthreads();
    int bstar, need, cnt;
    hist_find(hist, misc, 256, bstar, need, cnt);
    unsigned long long T = 0ull;
    if (cnt != need) {
      if (cnt <= CL_CAP) {
#pragma unroll
        for (int i = 0; i < 16; ++i) { const int idx = tid + 512 * i; if (idx < n && bin[i] == bstar) { const int slot = atomicAdd(&misc[20], 1); clist[slot] = mkcmp(val[i], idx); } }
        __syncthreads();
        if (tid < cnt) { const unsigned long long c = clist[tid]; int rank = 0; for (int jx = 0; jx < cnt; ++jx) rank += (clist[jx] > c) ? 1 : 0;
          if (rank == need - 1) { misc[21] = (int)(unsigned)(c & 0xffffffffull); misc[22] = (int)(unsigned)(c >> 32); } }
        __syncthreads();
        T = ((unsigned long long)(unsigned)misc[22] << 32) | (unsigned long long)(unsigned)misc[21];
      } else {
        unsigned long long prefix = 0ull; int shift = 36;
        for (int pass = 0; pass < 4; ++pass) {
          for (int i = tid; i < 4096; i += 512) hist[i] = 0;
          __syncthreads();
#pragma unroll
          for (int i = 0; i < 16; ++i) { const int idx = tid + 512 * i; if (idx < n && bin[i] == bstar) { const unsigned long long c = mkcmp(val[i], idx); if (pass == 0 || (c >> (shift + 12)) == prefix) atomicAdd(&hist[(int)((c >> shift) & 4095ull)], 1); } }
          __syncthreads();
          int digit, nneed, c2;
          hist_find(hist, misc, need, digit, nneed, c2);
          prefix = (prefix << 12) | (unsigned long long)digit; need = nneed;
          if (c2 == need) break;
          shift -= 12;
        }
        T = prefix << shift;
      }
    }
    int mycnt = 0; unsigned selm = 0;
#pragma unroll
    for (int i = 0; i < 16; ++i) { const int idx = tid + 512 * i;
      bool sel = false;
      if (idx < n) { if (bin[i] > bstar) sel = true; else if (bin[i] == bstar) sel = (mkcmp(val[i], idx) >= T); }
      if (sel) { ++mycnt; selm |= (1u << i); } }
    int total; int pos = block_excl_scan(mycnt, misc + 8, &total);
#pragma unroll
    for (int i = 0; i < 16; ++i) { if ((selm >> i) & 1u) { if (pos < 256) out[pos] = (unsigned short)(tid + 512 * i); ++pos; } }
    __syncthreads();
}

DI void selectA_item(const Params& p, int item, char* lds) {
  const bf16* PE = (const bf16*)(p.ws + WS_PE);
  const float* IW = (const float*)(p.ws + WS_IW);
  unsigned short* SEL = (unsigned short*)(p.ws + WS_SEL);
  float* sc = (float*)lds;
  int* hist = (int*)(lds + 4 * 8192 * 4);
  int* misc = hist + 4096;
  unsigned* mm = (unsigned*)(misc + 24);
  unsigned long long* clist = (unsigned long long*)(misc + 96);
  const int tid = opaque_tid(), lane = tid & 63, wid = tid >> 6, r32 = lane & 31, h = lane >> 5;
  const int b = item >> 11, t0 = (item & 2047) * 4;
  const size_t rowb = (size_t)b * SEQ;
  const int nk = t0 + 4, ntile = (nk + 31) >> 5;
  if (tid < 4) { mm[tid * 2] = 0xFFFFFFFFu; mm[tid * 2 + 1] = 0u; }
  __syncthreads();
  bf16x8 qf[4]; load_q(qf, PE + (rowb + t0 + (r32 >> 3)) * NPE + E_IQ + (r32 & 7) * 64, h);
  float wq[16];
#pragma unroll
  for (int i = 0; i < 16; ++i) wq[i] = IW[(rowb + t0 + (i >> 2)) * 8 + (i & 3) + 4 * h] * 0.04419417382415922f;
  const bf16* Kt = (const bf16*)(p.ws + WS_IKS) + (size_t)b * 256 * 2048 + lane * 8;
  {
    bf16x8 kf[4], kn[4];
#pragma unroll
    for (int t = 0; t < 4; ++t) { kf[t] = (bf16x8){0, 0, 0, 0, 0, 0, 0, 0}; kn[t] = kf[t]; }
    if (wid < ntile) {
#pragma unroll
      for (int t = 0; t < 4; ++t) kf[t] = *(const bf16x8*)(Kt + (size_t)wid * 2048 + t * 512);
    }
    float lo0 = INFINITY, hi0 = -INFINITY, lo1 = INFINITY, hi1 = -INFINITY;
    for (int kt = wid; kt < ntile; kt += 8) {
      if (kt + 8 < ntile) {
#pragma unroll
        for (int t = 0; t < 4; ++t) kn[t] = *(const bf16x8*)(Kt + (size_t)(kt + 8) * 2048 + t * 512);
      }
      f32x16 s;
#pragma unroll
      for (int i = 0; i < 16; ++i) s[i] = 0.f;
#pragma unroll
      for (int t = 0; t < 4; ++t) s = mfma32(qf[t], kf[t], s);
      float v[4];
#pragma unroll
      for (int q = 0; q < 4; ++q) {
        float a = wq[4 * q] * fmaxf(s[4 * q], 0.f);
#pragma unroll
        for (int jj = 1; jj < 4; ++jj) a += wq[4 * q + jj] * fmaxf(s[4 * q + jj], 0.f);
        v[q] = half_sum(a) + 0.f;
      }
      const float va = h ? v[2] : v[0], vb = h ? v[3] : v[1];
      const int key = kt * 32 + r32;
      sc[(2 * h) * 8192 + key] = va; sc[(2 * h + 1) * 8192 + key] = vb;
      lo0 = fminf(lo0, va); hi0 = fmaxf(hi0, va); lo1 = fminf(lo1, vb); hi1 = fmaxf(hi1, vb);
#pragma unroll
      for (int t = 0; t < 4; ++t) kf[t] = kn[t];
    }
    if (wid < ntile) {
#pragma unroll
      for (int o = 1; o < 32; o <<= 1) { lo0 = fminf(lo0, __shfl_xor(lo0, o)); hi0 = fmaxf(hi0, __shfl_xor(hi0, o)); lo1 = fminf(lo1, __shfl_xor(lo1, o)); hi1 = fmaxf(hi1, __shfl_xor(hi1, o)); }
      if (r32 == 0) { atomicMin(&mm[(2 * h) * 2], f2ord(lo0)); atomicMax(&mm[(2 * h) * 2 + 1], f2ord(hi0)); atomicMin(&mm[(2 * h + 1) * 2], f2ord(lo1)); atomicMax(&mm[(2 * h + 1) * 2 + 1], f2ord(hi1)); }
    }
  }
  __syncthreads();
  {
    const int g = wid >> 1, gt = tid & 127, upper = wid & 1;
    const int t = t0 + g, n = t + 1;
    const bool big = n > 256;
    const float* scq = sc + g * 8192;
    unsigned short* out = SEL + (rowb + t) * 256;
    int* histq = hist + g * 1024;
    unsigned long long* clq = clist + g * 128;
    int* mq = misc + 32 + g * 8;
    const float lo = ord2f(mm[g * 2]), hi = ord2f(mm[g * 2 + 1]);
    const float scale = (hi > lo) ? 1023.f / (hi - lo) : 0.f;
    for (int i = gt; i < 1024; i += 128) histq[i] = 0;
    if (gt == 0) { mq[0] = 0; mq[6] = 0; }
    __syncthreads();
    float uu[64];
#pragma unroll
    for (int i = 0; i < 64; ++i) { const int idx = gt + 128 * i; const float v = (idx < n) ? scq[idx] : lo; const float u = (v - lo) * scale; uu[i] = u;
      if (big && idx < n) { int bb = (int)u; bb = bb > 1023 ? 1023 : bb; atomicAdd(&histq[bb], 1); } }
    __syncthreads();
    typedef int i32x4 __attribute__((ext_vector_type(4)));
    const i32x4 h0 = *(const i32x4*)(histq + gt * 8), h1 = *(const i32x4*)(histq + gt * 8 + 4);
    const int hh[8] = {h0.x, h0.y, h0.z, h0.w, h1.x, h1.y, h1.z, h1.w};
    int tot = 0;
#pragma unroll
    for (int k = 0; k < 8; ++k) tot += hh[k];
    int inc = tot;
#pragma unroll
    for (int o = 1; o < 64; o <<= 1) { const int ux = __shfl_down(inc, o); if (lane + o < 64) inc += ux; }
    if (lane == 0) misc[wid] = inc;
    __syncthreads();
    {
      int above = inc - tot + (upper ? 0 : misc[wid + 1]);
      if (big) {
#pragma unroll
        for (int k = 7; k >= 0; --k) { const int c = hh[k]; if (above < 256 && above + c >= 256) { mq[1] = gt * 8 + k; mq[2] = 256 - above; mq[3] = c; } above += c; }
      }
    }
    __syncthreads();
    const int bstar = mq[1], need = mq[2], cnt = mq[3];
    const float flo = (float)bstar, fhi = (bstar >= 1023) ? INFINITY : (float)(bstar + 1);
    const bool tie = big && cnt != need;
    if (tie) {
      if (cnt <= 128) {
#pragma unroll
        for (int i = 0; i < 64; ++i) { const int idx = gt + 128 * i; if (idx < n && uu[i] >= flo && uu[i] < fhi) { const int slot = atomicAdd(&mq[0], 1); clq[slot] = mkcmp(scq[idx], idx); } }
      } else if (gt == 0) mq[6] = 1;
    }
    __syncthreads();
    if (tie && cnt <= 128 && gt < cnt) { const unsigned long long c = clq[gt]; int rank = 0; for (int jx = 0; jx < cnt; ++jx) rank += (clq[jx] > c) ? 1 : 0;
      if (rank == need - 1) { mq[4] = (int)(unsigned)(c & 0xffffffffull); mq[5] = (int)(unsigned)(c >> 32); } }
    __syncthreads();
    const unsigned long long T = tie ? (((unsigned long long)(unsigned)mq[5] << 32) | (unsigned long long)(unsigned)mq[4]) : 0ull;
    const bool fast = big && !(tie && cnt > 128);
    unsigned long long selm = 0ull;
    if (fast) {
#pragma unroll
      for (int i = 0; i < 64; ++i) { const int idx = gt + 128 * i;
        if (idx < n) { const float u = uu[i]; bool sel = u >= fhi; if (!sel && u >= flo) sel = !tie || (mkcmp(scq[idx], idx) >= T); if (sel) selm |= (1ull << i); } }
    }
    const int mycnt = __popcll(selm);
    int pinc = mycnt;
#pragma unroll
    for (int o = 1; o < 64; o <<= 1) { const int ux = __shfl_up(pinc, o); if (lane >= o) pinc += ux; }
    if (lane == 63) misc[8 + wid] = pinc;
    __syncthreads();
    if (fast) {
      int pos = pinc - mycnt + (upper ? misc[8 + wid - 1] : 0);
      while (selm) { const int i = __ffsll((long long)selm) - 1; selm &= selm - 1ull; if (pos < 256) out[pos] = (unsigned short)(gt + 128 * i); ++pos; }
    } else if (!big) {
      for (int i = gt; i < n; i += 128) out[i] = (unsigned short)i;
    }
    __syncthreads();
  }
  for (int q = 0; q < 4; ++q) {
    if (misc[32 + q * 8 + 6]) { const int t = t0 + q; select_slow(sc + q * 8192, t + 1, SEL + (rowb + t) * 256, ord2f(mm[q * 2]), ord2f(mm[q * 2 + 1]), hist, misc, clist); }
  }
  __syncthreads();
}

constexpr int DKP = 72, DVP = 136;
constexpr int D_STAGE = (64 * DKP * 2 + 64 * DVP) * 2;
DI void mixerD_unit(const Params& p, int b, int head, int qb, char* lds) {
  const bf16* PO = (const bf16*)(p.ws + WS_PE); bf16* Y = (bf16*)(p.ws + WS_Y);
  const int tid = opaque_tid(), lane = tid & 63, wid = tid >> 6, r32 = lane & 31, h = lane >> 5;
  const int map = wid & 1, qsub = wid >> 1;
  const size_t rowb = (size_t)b * SEQ;
  const int qpos = 128 * qb + 32 * qsub + r32;
  bf16x8 qf[4]; load_q(qf, PO + (rowb + qpos) * NPO + O_DQ + (2 * head + map) * 64, h);
  f32x16 o[4]; zero_o<4>(o);
  float m = -1e30f, l = 0.f;
  const int nsteps = 2 * qb + 2;
  const bf16* K1g = PO + rowb * NPO + O_DK + (2 * head) * 64;
  const bf16* K2g = K1g + 64;
  const bf16* Vg = PO + rowb * NPO + O_DV + head * 128;
  u32x4 rk1, rk2, rv[2];
#define D_LOAD(j) do { const int row = tid >> 3, ch = tid & 7; const size_t off = (size_t)((j) * 64 + row) * NPO + ch * 8; rk1 = *(const u32x4*)(K1g + off); rk2 = *(const u32x4*)(K2g + off); \
    _Pragma("unroll") for (int i = 0; i < 2; ++i) { const int c = tid + 512 * i, vr = c >> 4, vc = c & 15; rv[i] = *(const u32x4*)(Vg + (size_t)((j) * 64 + vr) * NPO + vc * 8); } } while (0)
  __syncthreads();
  D_LOAD(0);
  for (int j = 0; j < nsteps; ++j) {
    char* st = lds + (j & 1) * D_STAGE;
    bf16* K1s = (bf16*)st; bf16* K2s = K1s + 64 * DKP; bf16* Vs = K2s + 64 * DKP;
    { const int row = tid >> 3, ch = tid & 7; *(u32x4*)(K1s + row * DKP + ch * 8) = rk1; *(u32x4*)(K2s + row * DKP + ch * 8) = rk2;
#pragma unroll
      for (int i = 0; i < 2; ++i) { const int c = tid + 512 * i, vr = c >> 4, vc = c & 15; *(u32x4*)(Vs + vr * DVP + vc * 8) = rv[i]; } }
    __syncthreads();
    if (j + 1 < nsteps) D_LOAD(j + 1);
    const bf16* Ks = map ? K2s : K1s;
#pragma unroll
    for (int sub = 0; sub < 2; ++sub) {
      const int k0 = j * 64 + sub * 32;
      if (k0 <= 128 * qb + 32 * qsub + 31) {
        if (k0 + 31 <= 128 * qb + 32 * qsub) {
          attn_step32<4, false>(Ks + sub * 32 * DKP, DKP, Vs + sub * 32 * DVP, DVP, qf, o, m, l, 0xffffu, 0.125f * LOG2E, lane);
        } else {
          unsigned vm = 0;
#pragma unroll
          for (int i = 0; i < 16; ++i) if (k0 + crow(i, h) <= qpos) vm |= (1u << i);
          attn_step32<4, true>(Ks + sub * 32 * DKP, DKP, Vs + sub * 32 * DVP, DVP, qf, o, m, l, vm, 0.125f * LOG2E, lane);
        }
      }
    }
  }
#undef D_LOAD
  l += __shfl_xor(l, 32);
  const float linv = 1.f / l;
  __syncthreads();
  float* xch = (float*)lds + qsub * 4096;
  if (map == 1) {
#pragma unroll
    for (int d = 0; d < 4; ++d)
#pragma unroll
      for (int i = 0; i < 16; ++i) xch[(d * 16 + i) * 64 + lane] = o[d][i] * linv;
  }
  __syncthreads();
  if (map == 0) {
    const float lam = *(const float*)(p.ws + WS_LAM);
    float ssq = 0.f;
#pragma unroll
    for (int d = 0; d < 4; ++d)
#pragma unroll
      for (int i = 0; i < 16; ++i) { const float a = o[d][i] * linv - lam * xch[(d * 16 + i) * 64 + lane]; o[d][i] = a; ssq += a * a; }
    ssq += __shfl_xor(ssq, 32);
    const float lambda_init = 0.8f - 0.6f * expf(-0.3f);
    const float rn = rsqrtf(ssq * (1.f / 128.f) + EPS) * (1.f - lambda_init);
    const size_t tok = rowb + qpos;
    const bf16* gate = PO + tok * NPO + O_DG + head * 128;
    bf16* y = Y + tok * DM + 512 + head * 128;
    const float* sg = p.in[I_SUB_GAIN];
#pragma unroll
    for (int d = 0; d < 4; ++d)
#pragma unroll
      for (int g = 0; g < 4; ++g) {
        const int dd = 32 * d + 8 * g + 4 * h;
        const u32x2 gv = *(const u32x2*)(gate + dd); const f32x4 s4 = *(const f32x4*)(sg + dd);
        const float g0 = __uint_as_float(gv.x << 16), g1 = __uint_as_float(gv.x & 0xffff0000u), g2 = __uint_as_float(gv.y << 16), g3 = __uint_as_float(gv.y & 0xffff0000u);
        u32x2 w; w.x = cvtpk(o[d][4 * g] * rn * s4.x * g0, o[d][4 * g + 1] * rn * s4.y * g1); w.y = cvtpk(o[d][4 * g + 2] * rn * s4.z * g2, o[d][4 * g + 3] * rn * s4.w * g3);
        *(u32x2*)(y + dd) = w;
      }
  }
  __syncthreads();
}

#define XB_TMO      128
#define XB_XCNT(j)  (256  + 64 * (j))
#define XB_XSUB(j)  (1280 + 64 * (j))
#define XB_XGEN(j)  (2304 + 64 * (j))
#define XB_TOP      3328
#define XB_TOPGEN   3392
#define XCD_BAR_WORDS 3456
#define XB_SPIN_CAP (1u << 18)

__device__ __forceinline__ unsigned xb_ld(unsigned* p)              { return __hip_atomic_load(p, __ATOMIC_RELAXED, __HIP_MEMORY_SCOPE_AGENT); }
__device__ __forceinline__ unsigned xb_add(unsigned* p, unsigned v) { return __hip_atomic_fetch_add(p, v, __ATOMIC_RELAXED, __HIP_MEMORY_SCOPE_AGENT); }
__device__ __forceinline__ unsigned xb_xcc_id() { return (unsigned)__builtin_amdgcn_s_getreg((3 << 11) | 20) & 0xFu; }
#define XB_SPIN(cond, bar) do { unsigned _sp = 0; while (cond) { __builtin_amdgcn_s_sleep(1); \
    if ((++_sp & 255u) == 0u) { if (xb_ld(&(bar)[XB_TMO])) break; if (_sp > XB_SPIN_CAP) { atomicAdd(&(bar)[XB_TMO], 1u); break; } } } } while (0)

struct XcdBarrier {
    unsigned* bar; unsigned x;
    volatile LAS unsigned* st;
};

__device__ __forceinline__ XcdBarrier xcd_barrier_post(unsigned* bar, volatile LAS unsigned* st) {
    XcdBarrier b; b.bar = bar; b.x = xb_xcc_id(); b.st = st;
    if (threadIdx.x == 0) (void)xb_add(&bar[XB_XCNT(b.x)], 1u);
    return b;
}
__device__ __forceinline__ void xcd_barrier_complete(unsigned* bar, unsigned x, unsigned& nloc, unsigned& nx) {
    const unsigned G = gridDim.x * gridDim.y * gridDim.z;
    unsigned sum, cnt, mine, sp = 0u;
    for (;;) {
        sum = 0u; cnt = 0u; mine = 0u;
#pragma unroll
        for (unsigned j = 0; j < 16; ++j) { const unsigned c = xb_ld(&bar[XB_XCNT(j)]); sum += c; cnt += (c > 0u) ? 1u : 0u; mine = (j == x) ? c : mine; }
        if (sum == G) break;
        __builtin_amdgcn_s_sleep(1);
        if ((++sp & 255u) == 0u) { if (xb_ld(&bar[XB_TMO])) break; if (sp > XB_SPIN_CAP) { atomicAdd(&bar[XB_TMO], 1u); break; } }
    }
    nloc = mine > 0u ? mine : 1u; nx = cnt > 0u ? cnt : 1u;
}

__device__ __forceinline__ void xcd_barrier(const XcdBarrier& b) {
    asm volatile("s_waitcnt vmcnt(0)" ::: "memory");
    __syncthreads();
    if (threadIdx.x == 0) {
        unsigned* bar = b.bar;
        __builtin_amdgcn_s_waitcnt(0);
        unsigned nloc = b.st[0], nx = b.st[1];
        if (nloc == 0u) { xcd_barrier_complete(bar, b.x, nloc, nx); b.st[0] = nloc; b.st[1] = nx; }
        const unsigned old = xb_add(&bar[XB_XSUB(b.x)], 1u);
        const unsigned gen = old / nloc;
        if (old + 1u == (gen + 1u) * nloc) {
            __builtin_amdgcn_fence(__ATOMIC_RELEASE, "agent");
            asm volatile("s_waitcnt vmcnt(0)" ::: "memory");
            const unsigned og = xb_add(&bar[XB_TOP], 1u);
            const unsigned tg = og / nx;
            if (og + 1u == (tg + 1u) * nx) xb_add(&bar[XB_TOPGEN], 1u);
            else XB_SPIN(xb_ld(&bar[XB_TOPGEN]) == tg, bar);
            __builtin_amdgcn_fence(__ATOMIC_ACQUIRE, "agent");
            xb_add(&bar[XB_XGEN(b.x)], 1u);
            asm volatile("s_waitcnt vmcnt(0)" ::: "memory");
        } else {
            XB_SPIN(xb_ld(&bar[XB_XGEN(b.x)]) == gen, bar);
            __builtin_amdgcn_fence(__ATOMIC_ACQUIRE, "agent");
            asm volatile("s_waitcnt vmcnt(0)" ::: "memory");
        }
    }
    __syncthreads();
}


__global__ void __launch_bounds__(NTHREADS) fwd_kernel(Params p) {
  extern __shared__ __attribute__((aligned(16))) char smem[];
  cg::grid_group grid = cg::this_grid();
  char* lds = smem;
  volatile LAS unsigned* xb_st = (volatile LAS unsigned*)((LAS char*)smem + (LDS_BYTES - 16));
  if (threadIdx.x < 2) xb_st[threadIdx.x] = 0u;
  __syncthreads();
  const XcdBarrier xbar = xcd_barrier_post((unsigned*)(p.ws + WS_BAR), xb_st);
#define FRESH_IDS const int tid = opaque_tid(), lane = tid & 63, wid = tid >> 6; const int gw = blockIdx.x * 8 + wid, ngw = gridDim.x * 8; bf16* Ks = (bf16*)(lds + wid * WAVE_LDS); bf16* Vs = Ks + 32 * WP; (void)gw; (void)ngw; (void)Ks; (void)Vs; (void)lane;

  phase_prologue(p, lds);
  grid.sync();
  for (int rep = 0; rep < REP_GEMM; ++rep) phase_inproj(p, 0, lds);
  xcd_barrier(xbar);
#if EN_A
  for (int rep = 0; rep < REP_SELA; ++rep) for (int it = blockIdx.x; it < 2 * 2048; it += gridDim.x) selectA_item(p, it, lds);
  xcd_barrier(xbar);
  { FRESH_IDS for (int rep = 0; rep < REP_AATT; ++rep) for (int it = gw; it < NTOK; it += ngw) mixerA_item(p, it, Ks, Vs, lane); }
#else
  { unsigned* y = (unsigned*)(p.ws + WS_Y); for (int i = blockIdx.x * NTHREADS + (int)threadIdx.x; i < NTOK * 256; i += gridDim.x * NTHREADS) { const int row = i >> 8, c = i & 255; y[row * 512 + c] = 0u; } }
#endif
#if EN_B
  { FRESH_IDS for (int it = gw; it < 4096; it += ngw) mixerB_tile(p, it, Ks, Vs, lane); }
#else
  { unsigned* y = (unsigned*)(p.ws + WS_Y); for (int i = blockIdx.x * NTHREADS + (int)threadIdx.x; i < NTOK * 256; i += gridDim.x * NTHREADS) { const int row = i >> 8, c = i & 255; y[row * 512 + 256 + c] = 0u; } }
#endif
  xcd_barrier(xbar);
  phase_outproj(p, 0, lds);
  xcd_barrier(xbar);
  phase_ple(p, 0, lds);
  xcd_barrier(xbar);
  phase_inproj(p, 1, lds);
  xcd_barrier(xbar);
#if EN_D
  for (int rep = 0; rep < REP_D; ++rep) {
#pragma unroll 1
    for (int u2 = blockIdx.x * 2; u2 < 512; u2 += gridDim.x * 2) {
#pragma unroll 1
      for (int k = 0; k < 2; ++k) { const int u = u2 >> 1, bh = u >> 5, pr = u & 31; mixerD_unit(p, bh >> 2, bh & 3, k ? 63 - pr : pr, lds); }
    }
  }
#else
  { unsigned* y = (unsigned*)(p.ws + WS_Y); for (int i = blockIdx.x * NTHREADS + (int)threadIdx.x; i < NTOK * 256; i += gridDim.x * NTHREADS) { const int row = i >> 8, c = i & 255; y[row * 512 + 256 + c] = 0u; } }
#endif
#if EN_C
  __syncthreads();
  { FRESH_IDS for (int rep = 0; rep < REP_C; ++rep) for (int it = gw; it < 4096; it += ngw) mixerC_tile(p, it, Ks, Vs, lane); }
#else
  { unsigned* y = (unsigned*)(p.ws + WS_Y); for (int i = blockIdx.x * NTHREADS + (int)threadIdx.x; i < NTOK * 256; i += gridDim.x * NTHREADS) { const int row = i >> 8, c = i & 255; y[row * 512 + c] = 0u; } }
#endif
  xcd_barrier(xbar);
  phase_outproj(p, 1, lds);
  xcd_barrier(xbar);
  phase_ple(p, 1, lds);
}

extern "C" void kernel_launch(void* const* d_in, const int* in_sizes, int n_in, void* d_out, int out_size, void* d_ws, size_t ws_size, hipStream_t stream) {
  static int grid_blocks = 0;
  if (!grid_blocks) {
    int dev = 0, cus = 0, per_cu = 0;
    hipGetDevice(&dev);
    hipDeviceGetAttribute(&cus, hipDeviceAttributeMultiprocessorCount, dev);
    hipFuncSetAttribute((const void*)fwd_kernel, hipFuncAttributeMaxDynamicSharedMemorySize, LDS_BYTES);
    hipOccupancyMaxActiveBlocksPerMultiprocessor(&per_cu, (const void*)fwd_kernel, NTHREADS, LDS_BYTES);
    if (per_cu < 1) per_cu = 1;
    grid_blocks = cus * per_cu;
    if (grid_blocks > 256) grid_blocks = 256;
  }
  Params p{};
  for (int i = 0; i < 25; ++i) p.in[i] = (const float*)d_in[i];
  p.out = (float*)d_out; p.ws = (unsigned char*)d_ws;
  for (int i = 0; i < 32; ++i) p.inv_freq[i] = (float)pow(10000.0, -(double)i / 32.0);
  (void)hipMemsetAsync((char*)d_ws + WS_BAR, 0, 16384, stream);
  void* args[] = {&p};
  hipError_t e = hipLaunchCooperativeKernel((const void*)fwd_kernel, dim3(grid_blocks), dim3(NTHREADS), args, LDS_BYTES, stream);
  if (e != hipSuccess) fprintf(stderr, "cooperative launch failed: %s (grid %d)\n", hipGetErrorString(e), grid_blocks);
}
```

```cpp
#include <hip/hip_runtime.h>
#include <hip/hip_cooperative_groups.h>
#include <cstdio>
#include <cmath>
namespace cg = cooperative_groups;

#ifndef REP_GEMM
#define REP_GEMM 1
#endif
#ifndef REP_SELA
#define REP_SELA 1
#endif
#ifndef REP_D
#define REP_D 1
#endif
#ifndef REP_C
#define REP_C 1
#endif
#ifndef REP_AATT
#define REP_AATT 1
#endif
#ifndef EN_A
#define EN_A 1
#endif
#ifndef EN_B
#define EN_B 1
#endif
#ifndef EN_C
#define EN_C 1
#endif
#ifndef EN_D
#define EN_D 1
#endif

typedef unsigned short bf16;
typedef short bf16x8 __attribute__((ext_vector_type(8)));
typedef short s16x4 __attribute__((ext_vector_type(4)));
typedef float f32x4 __attribute__((ext_vector_type(4)));
typedef float f32x16 __attribute__((ext_vector_type(16)));
typedef unsigned u32x4 __attribute__((ext_vector_type(4)));
typedef unsigned u32x2 __attribute__((ext_vector_type(2)));
typedef float f32x2_t __attribute__((ext_vector_type(2)));
typedef __bf16 bf16x2_t __attribute__((ext_vector_type(2)));
#define LAS __attribute__((address_space(3)))
#define DI __device__ __forceinline__

constexpr int SEQ = 8192, NTOK = 16384, DM = 1024;
constexpr int NPE = 3072, NPO = 4096;
constexpr float EPS = 1e-6f;
constexpr float LOG2E = 1.4426950408889634f;
constexpr int NTHREADS = 512;
constexpr int LDS_BYTES = 150 * 1024;

constexpr size_t MiB = 1u << 20;
constexpr size_t WS_PE = 0;
constexpr size_t WS_ACT = 128 * MiB;
constexpr size_t WS_Y = 160 * MiB;
constexpr size_t WS_WINE = 192 * MiB;
constexpr size_t WS_WOUTE = 198 * MiB;
constexpr size_t WS_WINO = 200 * MiB;
constexpr size_t WS_WOUTO = 208 * MiB;
constexpr size_t WS_WG0 = 210 * MiB;
constexpr size_t WS_WG1 = 212 * MiB;
constexpr size_t WS_WP0 = 214 * MiB;
constexpr size_t WS_WP1 = 215 * MiB;
constexpr size_t WS_ROPE = 216 * MiB;
constexpr size_t WS_SEL = 218 * MiB;
constexpr size_t WS_IW = 226 * MiB;
constexpr size_t WS_SS = 227 * MiB;
constexpr size_t WS_LAM = 228 * MiB;
constexpr size_t WS_BAR = 250 * MiB;
constexpr size_t WS_PBF = 232 * MiB;
constexpr size_t WS_IKS = 229 * MiB;

struct Params {
  const float* in[25];
  float* out;
  unsigned char* ws;
  float inv_freq[32];
};
enum { I_X = 0, I_P, I_NORM_GAIN, I_W_IN_EVEN, I_W_OUT_EVEN, I_A_Q_GAIN, I_A_K_GAIN, I_IDX_K_GAIN, I_B_Q_GAIN, I_B_K_GAIN, I_B_SINKS,
       I_W_IN_ODD, I_W_OUT_ODD, I_C_Q_GAIN, I_C_K_GAIN, I_D_Q_GAIN, I_D_K_GAIN, I_LQ1, I_LK1, I_LQ2, I_LK2, I_SUB_GAIN, I_PLE_NORM_GAIN,
       I_W_PLE_GATE, I_W_PLE_PROJ };

DI unsigned cvtpk(float lo, float hi) { f32x2_t v = {lo, hi}; bf16x2_t b = __builtin_convertvector(v, bf16x2_t); return __builtin_bit_cast(unsigned, b); }
DI float bf2f(bf16 b) { return __uint_as_float(((unsigned)b) << 16); }
DI float fexp2(float x) { return __builtin_amdgcn_exp2f(x); }
DI f32x16 mfma32(bf16x8 a, bf16x8 b, f32x16 c) { return __builtin_amdgcn_mfma_f32_32x32x16_bf16(a, b, c, 0, 0, 0); }
DI f32x4 mfma16(bf16x8 a, bf16x8 b, f32x4 c) { return __builtin_amdgcn_mfma_f32_16x16x32_bf16(a, b, c, 0, 0, 0); }
DI int crow(int i, int h) { return (i & 3) + 8 * (i >> 2) + 4 * h; }
DI s16x4 trread(const bf16* p) { return __builtin_bit_cast(s16x4, __builtin_amdgcn_ds_read_tr16_b64_v4i16((LAS s16x4*)p)); }
DI int opaque_tid() { int t = threadIdx.x; asm volatile("" : "+v"(t)); return t; }
DI void lds_fence() { asm volatile("s_waitcnt lgkmcnt(0)" ::: "memory"); __builtin_amdgcn_wave_barrier(); }

__host__ __device__ __forceinline__ int phys_col(int n) { return (n & ~255) + 128 * ((n >> 5) & 1) + 32 * ((n >> 6) & 3) + (n & 31); }
DI int map_even(int n) { return n < 1216 ? n : (n < 1224 ? 3008 + (n - 1216) : n - 8); }
DI void transpose_tile(const float* W, int K, int N, bf16* WT, int mapmode, int tile, float* scr) {
  const int tid = opaque_tid();
  const int ntn = (N + 63) >> 6, kt = tile / ntn, nt = tile % ntn, k0 = kt * 64, n0 = nt * 64;
#pragma unroll
  for (int i = 0; i < 8; ++i) {
    const int kk = (tid >> 6) + 8 * i, nn = tid & 63, n = n0 + nn;
    scr[kk * 65 + nn] = (n < N) ? W[(size_t)(k0 + kk) * N + n] : 0.f;
  }
  __syncthreads();
  {
    const int nn = tid >> 3, kc = tid & 7, n = n0 + nn;
    if (n < N) {
      const int dst = mapmode == 1 ? phys_col(map_even(n)) : (mapmode == 2 ? phys_col(n) : n);
      const float* s = scr + (kc * 8) * 65 + nn;
      u32x4 o; o.x = cvtpk(s[0], s[65]); o.y = cvtpk(s[2 * 65], s[3 * 65]); o.z = cvtpk(s[4 * 65], s[5 * 65]); o.w = cvtpk(s[6 * 65], s[7 * 65]);
      *(u32x4*)(WT + (size_t)dst * K + k0 + kc * 8) = o;
    }
  }
  __syncthreads();
}

DI float wave_sum(float v) {
#pragma unroll
  for (int o = 1; o < 64; o <<= 1) v += __shfl_xor(v, o);
  return v;
}

DI void phase_prologue(const Params& p, char* lds) {
  const int tid = opaque_tid(), lane = tid & 63, wid = tid >> 6;
  const int nb = gridDim.x, bid = blockIdx.x;
  unsigned char* ws = p.ws;
  float* scr = (float*)lds;
  const int T0 = 16 * 48, T1 = 256, T2 = 16 * 64, T3 = 256, T4 = 256, T5 = 256, T6 = 64, T7 = 64;
  const int NT = T0 + T1 + T2 + T3 + T4 + T5 + T6 + T7;
  for (int it = bid; it < NT; it += nb) {
    int r = it;
    if (r < T0) { transpose_tile(p.in[I_W_IN_EVEN], 1024, 3016, (bf16*)(ws + WS_WINE), 1, r, scr); continue; } r -= T0;
    if (r < T1) { transpose_tile(p.in[I_W_OUT_EVEN], 1024, 1024, (bf16*)(ws + WS_WOUTE), 0, r, scr); continue; } r -= T1;
    if (r < T2) { transpose_tile(p.in[I_W_IN_ODD], 1024, 4096, (bf16*)(ws + WS_WINO), 2, r, scr); continue; } r -= T2;
    if (r < T3) { transpose_tile(p.in[I_W_OUT_ODD], 1024, 1024, (bf16*)(ws + WS_WOUTO), 0, r, scr); continue; } r -= T3;
    if (r < T4) { transpose_tile(p.in[I_W_PLE_GATE], 1024, 1024, (bf16*)(ws + WS_WG0), 0, r, scr); continue; } r -= T4;
    if (r < T5) { transpose_tile(p.in[I_W_PLE_GATE] + 1024 * 1024, 1024, 1024, (bf16*)(ws + WS_WG1), 0, r, scr); continue; } r -= T5;
    if (r < T6) { transpose_tile(p.in[I_W_PLE_PROJ], 256, 1024, (bf16*)(ws + WS_WP0), 0, r, scr); continue; } r -= T6;
    transpose_tile(p.in[I_W_PLE_PROJ] + 256 * 1024, 256, 1024, (bf16*)(ws + WS_WP1), 0, r, scr);
  }
  const int gt = bid * NTHREADS + tid, ngt = nb * NTHREADS;
  { unsigned* z = (unsigned*)(ws + WS_WINE); for (int i = gt; i < 56 * 512; i += ngt) z[(size_t)phys_col(3016 + (i >> 9)) * 512 + (i & 511)] = 0u; }
  { const f32x4* src = (const f32x4*)p.in[I_P]; u32x2* dst = (u32x2*)(ws + WS_PBF); for (int i = gt; i < 2 * NTOK * 256 / 4; i += ngt) { const f32x4 v = src[i]; u32x2 w; w.x = cvtpk(v.x, v.y); w.y = cvtpk(v.z, v.w); dst[i] = w; } }
  { float* ss = (float*)(ws + WS_SS); for (int i = gt; i < 3 * NTOK; i += ngt) ss[i] = 0.f; }
  { float2* tab = (float2*)(ws + WS_ROPE);
    for (int i = gt; i < SEQ * 32; i += ngt) {
      const int pos = i >> 5, k = i & 31;
      const float ang = (float)pos * p.inv_freq[k];
      double rev = (double)ang * 0.15915494309189535; rev -= floor(rev);
      const float rf = (float)rev;
      tab[i] = make_float2(__builtin_amdgcn_cosf(rf), __builtin_amdgcn_sinf(rf));
    } }
  if (bid == 0 && wid == 0) {
    const float a = wave_sum(p.in[I_LQ1][lane] * p.in[I_LK1][lane]);
    const float b = wave_sum(p.in[I_LQ2][lane] * p.in[I_LK2][lane]);
    const float lambda_init = 0.8f - 0.6f * expf(-0.3f);
    if (lane == 0) *(float*)(ws + WS_LAM) = expf(a) - expf(b) + lambda_init;
  }
  { const float* x = p.in[I_X]; const float* g = p.in[I_NORM_GAIN]; bf16* H = (bf16*)(ws + WS_ACT);
    const int gw = bid * 8 + wid, ngw = nb * 8;
    for (int m = gw; m < NTOK; m += ngw) {
      const f32x4* xr = (const f32x4*)(x + (size_t)m * DM) + lane;
      f32x4 v[4]; float s = 0.f;
#pragma unroll
      for (int j = 0; j < 4; ++j) { v[j] = xr[64 * j]; s += v[j].x * v[j].x + v[j].y * v[j].y + v[j].z * v[j].z + v[j].w * v[j].w; }
      const float rstd = rsqrtf(wave_sum(s) * (1.f / DM) + EPS);
      u32x2* o = (u32x2*)(H + (size_t)m * DM) + lane;
#pragma unroll
      for (int j = 0; j < 4; ++j) { const f32x4 gg = *((const f32x4*)g + lane + 64 * j); u32x2 w; w.x = cvtpk(v[j].x * rstd * gg.x, v[j].y * rstd * gg.y); w.y = cvtpk(v[j].z * rstd * gg.z, v[j].w * rstd * gg.w); o[64 * j] = w; }
    } }
}

namespace pg8 {
#define PG8_LAS __attribute__((address_space(3)))
typedef unsigned short bf16_t;
typedef short bf16x8 __attribute__((ext_vector_type(8)));
typedef float f32x4 __attribute__((ext_vector_type(4)));
typedef unsigned u32x4 __attribute__((ext_vector_type(4)));
constexpr int BM = 256, BK = 64, HALF = 128, HTB = HALF * BK * 2  , STAGE_BYTES = 8 * HTB, NXCD = 8, WGM = 8;

__host__ __device__ __forceinline__ int lds_byte(int r, int c) { const int st = (r >> 4) * 2 + (c >> 5), rr = r & 15, cc = c & 31, ob = rr * 64 + cc * 2; return st * 1024 + (ob ^ (((ob >> 9) & 1) << 5)); }
__host__ __device__ __forceinline__ void stage_rc(int b, int& R, int& C) { const int st = b / 1024, sb = b % 1024, swz = sb ^ (((sb >> 9) & 1) << 5); R = (st >> 1) * 16 + swz / 64; C = (st & 1) * 32 + (swz % 64) / 2; }
__host__ __device__ __forceinline__ int perm32(int rho) { const int n = rho >> 4, i = rho & 15; return 8 * (i >> 2) + 4 * n + (i & 3); }

struct Unit { int pm, pn; };
struct Gemm { const bf16_t* A; const bf16_t* Bt; int M, N, K; };

struct StaticOrder {
    int nM, nN, nwg, G, c;
    __host__ __device__ void init(int M, int N, int G_, int c_) { nM = M / BM; nN = N / BM; nwg = nM * nN; G = G_; c = c_; }
    __host__ __device__ bool next(int i, Unit& u) const {
        const long L = (long)i * G + c; if (L >= nwg) return false;
        int wgid = (int)L; { const int q = nwg / NXCD, r = nwg % NXCD, xcd = wgid % NXCD, off = wgid / NXCD; wgid = (xcd < r ? xcd * (q + 1) : r * (q + 1) + (xcd - r) * q) + off; }
        const int nig = WGM * nN, gid = wgid / nig, fm = gid * WGM, gsz = (nM - fm) < WGM ? (nM - fm) : WGM;
        u.pm = fm + ((wgid % nig) % gsz); u.pn = (wgid % nig) / gsz; return true;
    }
    __device__ __forceinline__ void a_ready(const Unit&) const {}
    __device__ __forceinline__ void done(const Unit&) const {}
};
__device__ __forceinline__ unsigned cvt_pk_bf16(float lo, float hi) { unsigned r; asm volatile("v_cvt_pk_bf16_f32 %0, %1, %2" : "=v"(r) : "v"(lo), "v"(hi)); return r; }
template <class Epi, class Sched, bool ALIGN_EPI = false, bool SP2 = false>
__device__ __forceinline__ void gemm_phase(PG8_LAS unsigned char* lds, const Gemm g, const Sched& S, const Epi& E) {
    int tid_ = threadIdx.x; asm volatile("" : "+v"(tid_));
    const int tid = tid_, wid = __builtin_amdgcn_readfirstlane(tid >> 6), lane = tid & 63, wr = wid >> 2, wc = wid & 3, fr = lane & 15, fq = lane >> 4;
    const int K = g.K, nt = K / BK;
    unsigned voffA[2], voffB[2];
#pragma unroll
    for (int i = 0; i < 2; ++i) { int R, C; stage_rc(tid * 16 + i * 8192, R, C); const int Rb = Epi::PERM ? ((R & ~31) + perm32(R & 31)) : R;
        voffA[i] = (unsigned)(R * K + C) * 2u; voffB[i] = (unsigned)(Rb * K + C) * 2u; }
    const size_t kstep = (size_t)(BK * 2);
    const size_t hstep = (size_t)HALF * K * 2;
    const size_t tstep = 2 * hstep;
    const unsigned ldsw = (unsigned)wid * 1024u;
    const int aoff = lds_byte(wr * 64 + fr, fq * 8), boff = lds_byte(wc * 32 + fr, fq * 8);
#define PG8_SA(b, h) (((b) * 2 + (h)) * HTB)
#define PG8_SB(b, h) ((4 + (b) * 2 + (h)) * HTB)
#define PG8_STAGE(bufoff, gbase, voff) do { _Pragma("unroll") for (int _i = 0; _i < 2; ++_i) \
        __builtin_amdgcn_global_load_lds((const unsigned*)((const char*)(gbase) + (voff)[_i]), (PG8_LAS unsigned*)(lds + (bufoff) + ldsw + _i * 8192), 16, 0, 0); } while (0)
#define PG8_LDA(dst, b, h) do { _Pragma("unroll") for (int m = 0; m < 4; ++m) _Pragma("unroll") for (int k = 0; k < 2; ++k) dst[m][k] = *(const PG8_LAS bf16x8*)(lds + PG8_SA(b, h) + aoff + m * 2048 + k * 1024); } while (0)
#define PG8_LDB(dst, b, h) do { _Pragma("unroll") for (int n = 0; n < 2; ++n) _Pragma("unroll") for (int k = 0; k < 2; ++k) dst[n][k] = *(const PG8_LAS bf16x8*)(lds + PG8_SB(b, h) + boff + n * 2048 + k * 1024); } while (0)
#define PG8_MMA(ai, bj, At, Bt) do { __builtin_amdgcn_s_setprio(1); _Pragma("unroll") for (int m = 0; m < 4; ++m) _Pragma("unroll") for (int n = 0; n < 2; ++n) _Pragma("unroll") for (int k = 0; k < 2; ++k) \
        acc[ai][bj][m][n] = __builtin_amdgcn_mfma_f32_16x16x32_bf16(Bt[n][k], At[m][k], acc[ai][bj][m][n], 0, 0, 0); __builtin_amdgcn_s_setprio(0); } while (0)
#define PG8_WAIT_V(n) asm volatile("s_waitcnt vmcnt(" #n ")" ::: "memory")
#define PG8_WAIT_L(n) asm volatile("s_waitcnt lgkmcnt(" #n ")" ::: "memory")
#define PG8_BAR __builtin_amdgcn_s_barrier()
#define PG8_SCHED __builtin_amdgcn_sched_barrier(0)
    Unit cur, nxt; int ui = 0;
    if (!S.next(0, cur)) return;
    f32x4 acc[2][2][4][2];
#pragma unroll
    for (int a = 0; a < 2; ++a)
#pragma unroll
        for (int b = 0; b < 2; ++b)
#pragma unroll
            for (int m = 0; m < 4; ++m)
#pragma unroll
                for (int n = 0; n < 2; ++n) acc[a][b][m][n] = (f32x4){0.f, 0.f, 0.f, 0.f};
    bf16x8 At[4][2], B0[2][2], B1[2][2];
    const char* cA = (const char*)g.A + (size_t)cur.pm * tstep; const char* cB = (const char*)g.Bt + (size_t)cur.pn * tstep;
    S.a_ready(cur);
    if constexpr (SP2) {
        PG8_STAGE(PG8_SB(0, 0), cB, voffB); PG8_STAGE(PG8_SB(0, 1), cB + hstep, voffB); PG8_STAGE(PG8_SA(0, 0), cA, voffA); PG8_STAGE(PG8_SA(0, 1), cA + hstep, voffA);
        if (wr == 1) PG8_BAR;
        PG8_WAIT_V(2); PG8_BAR;
        PG8_STAGE(PG8_SB(1, 0), cB + kstep, voffB); PG8_STAGE(PG8_SA(1, 0), cA + kstep, voffA); PG8_STAGE(PG8_SB(1, 1), cB + hstep + kstep, voffB);
        PG8_WAIT_V(6); PG8_BAR;
    } else {
        PG8_STAGE(PG8_SB(0, 0), cB, voffB); PG8_STAGE(PG8_SA(0, 0), cA, voffA); PG8_STAGE(PG8_SB(0, 1), cB + hstep, voffB); PG8_STAGE(PG8_SA(0, 1), cA + hstep, voffA);
        if (wr == 1) PG8_BAR;
        PG8_WAIT_V(4); PG8_BAR;
        PG8_STAGE(PG8_SB(1, 0), cB + kstep, voffB); PG8_STAGE(PG8_SA(1, 0), cA + kstep, voffA); PG8_STAGE(PG8_SB(1, 1), cB + hstep + kstep, voffB);
        PG8_WAIT_V(6); PG8_BAR;
    }
    for (;;) {
        const bool has_next = S.next(ui + 1, nxt);
        const char* nA = has_next ? (const char*)g.A + (size_t)nxt.pm * tstep : cA; const char* nB = has_next ? (const char*)g.Bt + (size_t)nxt.pn * tstep : cB;
        for (int t = 0; t < nt; t += 2) {
            const bool last = (t == nt - 2);
            const char* a1 = cA + (size_t)(t + 1) * kstep;
            const char* a2 = last ? nA : cA + (size_t)(t + 2) * kstep; const char* b2 = last ? nB : cB + (size_t)(t + 2) * kstep;
            const char* a3 = a2 + kstep; const char* b3 = b2 + kstep;
            if (last && has_next) S.a_ready(nxt);
            if constexpr (SP2) {
            PG8_LDB(B0, 0, 0); PG8_LDB(B1, 0, 1); PG8_SCHED; PG8_LDA(At, 0, 0); PG8_STAGE(PG8_SA(1, 1), a1 + hstep, voffA);
            PG8_WAIT_V(8); PG8_WAIT_L(0); PG8_BAR; PG8_MMA(0, 0, At, B0); PG8_MMA(0, 1, At, B1); PG8_BAR; PG8_SCHED;
            PG8_LDA(At, 0, 1); PG8_STAGE(PG8_SB(0, 0), b2, voffB); PG8_STAGE(PG8_SB(0, 1), b2 + hstep, voffB); PG8_STAGE(PG8_SA(0, 0), a2, voffA);
            PG8_WAIT_V(8); PG8_WAIT_L(0); PG8_BAR; PG8_MMA(1, 0, At, B0); PG8_MMA(1, 1, At, B1); PG8_BAR; PG8_SCHED;
            PG8_LDB(B0, 1, 0); PG8_LDB(B1, 1, 1); PG8_SCHED; PG8_LDA(At, 1, 0); PG8_STAGE(PG8_SA(0, 1), a2 + hstep, voffA);
            PG8_WAIT_V(8); PG8_WAIT_L(0); PG8_BAR; PG8_MMA(0, 0, At, B0); PG8_MMA(0, 1, At, B1); PG8_BAR; PG8_SCHED;
            PG8_LDA(At, 1, 1); PG8_STAGE(PG8_SB(1, 0), b3, voffB); PG8_STAGE(PG8_SB(1, 1), b3 + hstep, voffB); PG8_STAGE(PG8_SA(1, 0), a3, voffA);
            PG8_WAIT_V(8); PG8_WAIT_L(0); PG8_BAR; PG8_MMA(1, 0, At, B0); PG8_MMA(1, 1, At, B1); PG8_BAR; PG8_SCHED;
            } else {
            PG8_LDB(B0, 0, 0); PG8_SCHED; PG8_LDA(At, 0, 0); PG8_STAGE(PG8_SA(1, 1), a1 + hstep, voffA);
            PG8_WAIT_L(8); PG8_BAR; PG8_WAIT_L(0); PG8_MMA(0, 0, At, B0); PG8_BAR; PG8_SCHED;
            PG8_LDB(B1, 0, 1); PG8_STAGE(PG8_SB(0, 0), b2, voffB);
            PG8_BAR; PG8_WAIT_L(0); PG8_MMA(0, 1, At, B1); PG8_BAR;
            PG8_LDA(At, 0, 1); PG8_STAGE(PG8_SA(0, 0), a2, voffA);
            PG8_BAR; PG8_WAIT_L(0); PG8_MMA(1, 0, At, B0); PG8_BAR; PG8_SCHED;
            PG8_STAGE(PG8_SB(0, 1), b2 + hstep, voffB);
            PG8_WAIT_V(6); PG8_BAR; PG8_MMA(1, 1, At, B1); PG8_BAR;
            PG8_LDB(B0, 1, 0); PG8_SCHED; PG8_LDA(At, 1, 0); PG8_STAGE(PG8_SA(0, 1), a2 + hstep, voffA);
            PG8_WAIT_L(8); PG8_BAR; PG8_WAIT_L(0); PG8_MMA(0, 0, At, B0); PG8_BAR; PG8_SCHED;
            PG8_LDB(B1, 1, 1); PG8_STAGE(PG8_SB(1, 0), b3, voffB);
            PG8_BAR; PG8_WAIT_L(0); PG8_MMA(0, 1, At, B1); PG8_BAR;
            PG8_LDA(At, 1, 1); PG8_STAGE(PG8_SA(1, 0), a3, voffA);
            PG8_BAR; PG8_WAIT_L(0); PG8_MMA(1, 0, At, B0); PG8_BAR; PG8_SCHED;
            PG8_STAGE(PG8_SB(1, 1), b3 + hstep, voffB);
            PG8_WAIT_V(6); PG8_BAR; PG8_MMA(1, 1, At, B1); PG8_BAR;
            }
        }
        if constexpr (ALIGN_EPI) { if (wr == 0) PG8_BAR; }
        if constexpr (!Epi::AFTER_DRAIN) { E(acc, cur, wr, wc, fr, fq); S.done(cur); }
        if (!has_next) break;
#pragma unroll
        for (int a = 0; a < 2; ++a)
#pragma unroll
            for (int b = 0; b < 2; ++b)
#pragma unroll
                for (int m = 0; m < 4; ++m)
#pragma unroll
                    for (int n = 0; n < 2; ++n) acc[a][b][m][n] = (f32x4){0.f, 0.f, 0.f, 0.f};
        cur = nxt; cA = nA; cB = nB; ++ui;
        if constexpr (ALIGN_EPI) { if (wr == 1) PG8_BAR; }
    }
    PG8_WAIT_V(0);
    if constexpr (!ALIGN_EPI) { if (wr == 0) PG8_BAR; }
    PG8_BAR;
    if constexpr (Epi::AFTER_DRAIN) { E.fused(acc, cur, wr, wc, fr, fq, lds, wid, lane); S.done(cur); }
#undef PG8_SA
#undef PG8_SB
#undef PG8_STAGE
#undef PG8_LDA
#undef PG8_LDB
#undef PG8_MMA
#undef PG8_WAIT_V
#undef PG8_WAIT_L
#undef PG8_BAR
#undef PG8_SCHED
}
}

enum { T_PLAIN = 0, T_NR = 1, T_ROPE = 2, T_SILU = 3, T_IW = 4 };
DI void slot_info(const Params& p, int layer, int slot, int& type, const float*& gain) {
  gain = nullptr;
  if (layer == 0) {
    if (slot < 8) { type = T_NR; gain = p.in[I_A_Q_GAIN]; }
    else if (slot == 8) { type = T_NR; gain = p.in[I_A_K_GAIN]; }
    else if (slot == 9) type = T_PLAIN;
    else if (slot < 18) type = T_ROPE;
    else if (slot == 18) { type = T_NR; gain = p.in[I_IDX_K_GAIN]; }
    else if (slot < 27) type = T_SILU;
    else if (slot < 35) { type = T_NR; gain = p.in[I_B_Q_GAIN]; }
    else if (slot < 37) { type = T_NR; gain = p.in[I_B_K_GAIN]; }
    else if (slot < 39) type = T_PLAIN;
    else if (slot < 47) type = T_SILU;
    else type = T_IW;
  } else {
    if (slot < 8) { type = T_NR; gain = p.in[I_C_Q_GAIN]; }
    else if (slot < 16) { type = T_NR; gain = p.in[I_C_K_GAIN]; }
    else if (slot < 24) type = T_PLAIN;
    else if (slot < 32) type = T_SILU;
    else if (slot < 40) { type = T_NR; gain = p.in[I_D_Q_GAIN]; }
    else if (slot < 48) { type = T_NR; gain = p.in[I_D_K_GAIN]; }
    else if (slot < 56) type = T_PLAIN;
    else type = T_SILU;
  }
}
constexpr int E_AQ = 0, E_AK = 512, E_AV = 576, E_IQ = 640, E_IK = 1152, E_AG = 1216, E_BQ = 1728, E_BK = 2240, E_BV = 2368, E_BG = 2496;
constexpr int O_CQ = 0, O_CK = 512, O_CV = 1024, O_CG = 1536, O_DQ = 2048, O_DK = 2560, O_DV = 3072, O_DG = 3584;

typedef pg8::f32x4 (AccT)[2][2][4][2];

struct EpiInProj {
  static constexpr bool PERM = false, AFTER_DRAIN = false;
  const Params& p; int layer;
  DI void operator()(const f32x4 (&acc)[2][2][4][2], const pg8::Unit& u, int wr, int wc, int fr, int fq) const {
    unsigned char* ws = p.ws;
    const int NP = layer == 0 ? NPE : NPO;
    bf16* PE = (bf16*)(ws + WS_PE);
    const float2* rope = (const float2*)(ws + WS_ROPE);
    const float* ss1 = (const float*)(ws + WS_SS);
    float* IW = (float*)(ws + WS_IW);
    const int slot = u.pn * 4 + wc;
    int type; const float* gain; slot_info(p, layer, slot, type, gain);
#pragma unroll
    for (int ai = 0; ai < 2; ++ai)
#pragma unroll
      for (int m = 0; m < 4; ++m) {
        const int row = u.pm * 256 + ai * 128 + wr * 64 + m * 16 + fr, pos = row & (SEQ - 1);
        float sc = 1.f;
        if (layer == 1) sc = rsqrtf(ss1[row] * (1.f / DM) + EPS);
        f32x4 v1[2], v2[2];
#pragma unroll
        for (int n = 0; n < 2; ++n) { v1[n] = acc[ai][0][m][n] * sc; v2[n] = acc[ai][1][m][n] * sc; }
        if (type == T_NR) {
          float s = 0.f;
#pragma unroll
          for (int n = 0; n < 2; ++n) s += v1[n].x * v1[n].x + v1[n].y * v1[n].y + v1[n].z * v1[n].z + v1[n].w * v1[n].w + v2[n].x * v2[n].x + v2[n].y * v2[n].y + v2[n].z * v2[n].z + v2[n].w * v2[n].w;
          s += __shfl_xor(s, 16); s += __shfl_xor(s, 32);
          const float rn = rsqrtf(s * (1.f / 64.f) + EPS);
#pragma unroll
          for (int n = 0; n < 2; ++n) { const f32x4 g1 = *(const f32x4*)(gain + n * 16 + fq * 4), g2 = *(const f32x4*)(gain + 32 + n * 16 + fq * 4); v1[n] = v1[n] * rn * g1; v2[n] = v2[n] * rn * g2; }
        }
        if (type == T_NR || type == T_ROPE) {
#pragma unroll
          for (int n = 0; n < 2; ++n) {
            const f32x4* cs = (const f32x4*)(rope + (size_t)pos * 32 + n * 16 + fq * 4);
            const f32x4 c01 = cs[0], c23 = cs[1];
            const f32x4 x1 = v1[n], x2 = v2[n];
            f32x4 o1, o2;
            o1.x = x1.x * c01.x - x2.x * c01.y; o2.x = x2.x * c01.x + x1.x * c01.y;
            o1.y = x1.y * c01.z - x2.y * c01.w; o2.y = x2.y * c01.z + x1.y * c01.w;
            o1.z = x1.z * c23.x - x2.z * c23.y; o2.z = x2.z * c23.x + x1.z * c23.y;
            o1.w = x1.w * c23.z - x2.w * c23.w; o2.w = x2.w * c23.z + x1.w * c23.w;
            v1[n] = o1; v2[n] = o2;
          }
        }
        if (type == T_SILU) {
#pragma unroll
          for (int n = 0; n < 2; ++n)
#pragma unroll
            for (int j = 0; j < 4; ++j) { const float a = v1[n][j]; v1[n][j] = a / (1.f + __expf(-a)); const float b = v2[n][j]; v2[n][j] = b / (1.f + __expf(-b)); }
        }
        if (type == T_IW) {
          if (fq < 2) *(f32x4*)(IW + (size_t)row * 8 + fq * 4) = v1[0];
        } else {
          bf16* dst = PE + (size_t)row * NP + slot * 64 + fq * 4;
#pragma unroll
          for (int n = 0; n < 2; ++n) {
            u32x2 w1, w2; w1.x = cvtpk(v1[n].x, v1[n].y); w1.y = cvtpk(v1[n].z, v1[n].w); w2.x = cvtpk(v2[n].x, v2[n].y); w2.y = cvtpk(v2[n].z, v2[n].w);
            *(u32x2*)(dst + n * 16) = w1; *(u32x2*)(dst + 32 + n * 16) = w2;
            if (layer == 0 && slot == 18) { bf16* IKS = (bf16*)(ws + WS_IKS); const int key = row & (SEQ - 1);
              bf16* base = IKS + (((size_t)(row >> 13) * 256 + (key >> 5)) * 4) * 512 + ((fq >> 1) * 32 + (key & 31)) * 8 + (fq & 1) * 4;
              *(u32x2*)(base + (size_t)n * 512) = w1; *(u32x2*)(base + (size_t)(n + 2) * 512) = w2; }
          }
        }
        asm volatile("" ::: "memory");
      }
  }
};

DI void phase_inproj(const Params& p, int layer, char* lds) {
  unsigned char* ws = p.ws;
  const int NP = layer == 0 ? NPE : NPO;
  pg8::Gemm g{(const bf16*)(ws + (layer == 0 ? WS_ACT : WS_Y)), (const bf16*)(ws + (layer == 0 ? WS_WINE : WS_WINO)), NTOK, NP, DM};
  pg8::StaticOrder S; S.init(NTOK, NP, (int)gridDim.x, (int)blockIdx.x);
  EpiInProj E{p, layer};
  pg8::gemm_phase<EpiInProj, pg8::StaticOrder, true, true>((PG8_LAS unsigned char*)lds, g, S, E);
}

struct EpiOutProj {
  static constexpr bool PERM = false, AFTER_DRAIN = false;
  const float* xin; float* out; bf16* XG; const float* pg; float* ss;
  DI void operator()(const f32x4 (&acc)[2][2][4][2], const pg8::Unit& u, int wr, int wc, int fr, int fq) const {
#pragma unroll
    for (int ai = 0; ai < 2; ++ai)
#pragma unroll
      for (int m = 0; m < 4; ++m) {
        const int row = u.pm * 256 + ai * 128 + wr * 64 + m * 16 + fr; float rs = 0.f;
#pragma unroll
        for (int bj = 0; bj < 2; ++bj)
#pragma unroll
          for (int n = 0; n < 2; ++n) {
            const int col = u.pn * 256 + bj * 128 + wc * 32 + n * 16 + fq * 4; const size_t off = (size_t)row * DM + col;
            const f32x4 xn = *(const f32x4*)(xin + off) + acc[ai][bj][m][n];
            *(f32x4*)(out + off) = xn;
            rs += xn.x * xn.x + xn.y * xn.y + xn.z * xn.z + xn.w * xn.w;
            const f32x4 gg = *(const f32x4*)(pg + col);
            u32x2 w; w.x = cvtpk(xn.x * gg.x, xn.y * gg.y); w.y = cvtpk(xn.z * gg.z, xn.w * gg.w); *(u32x2*)(XG + off) = w;
          }
        rs += __shfl_xor(rs, 16); rs += __shfl_xor(rs, 32);
        if (fq == 0) atomicAdd(ss + row, rs);
        asm volatile("" ::: "memory");
      }
  }
};
DI void phase_outproj(const Params& p, int layer, char* lds) {
  unsigned char* ws = p.ws;
  pg8::Gemm g{(const bf16*)(ws + WS_Y), (const bf16*)(ws + (layer == 0 ? WS_WOUTE : WS_WOUTO)), NTOK, DM, DM};
  pg8::StaticOrder S; S.init(NTOK, DM, (int)gridDim.x, (int)blockIdx.x);
  EpiOutProj E{layer == 0 ? p.in[I_X] : p.out, p.out, (bf16*)(ws + WS_ACT), p.in[I_PLE_NORM_GAIN] + layer * DM, (float*)(ws + WS_SS) + (layer == 0 ? 1 : 2) * NTOK};
  pg8::gemm_phase<EpiOutProj, pg8::StaticOrder, true, true>((PG8_LAS unsigned char*)lds, g, S, E);
}

struct EpiPleProj {
  static constexpr bool PERM = false, AFTER_DRAIN = false;
  bf16* PT;
  DI void operator()(const f32x4 (&acc)[2][2][4][2], const pg8::Unit& u, int wr, int wc, int fr, int fq) const {
#pragma unroll
    for (int ai = 0; ai < 2; ++ai)
#pragma unroll
      for (int m = 0; m < 4; ++m) {
        const int row = u.pm * 256 + ai * 128 + wr * 64 + m * 16 + fr;
#pragma unroll
        for (int bj = 0; bj < 2; ++bj)
#pragma unroll
          for (int n = 0; n < 2; ++n) { const f32x4 a = acc[ai][bj][m][n]; u32x2 w; w.x = cvtpk(a.x, a.y); w.y = cvtpk(a.z, a.w); *(u32x2*)(PT + (size_t)row * DM + u.pn * 256 + bj * 128 + wc * 32 + n * 16 + fq * 4) = w; }
      }
  }
};
struct EpiPleGate {
  static constexpr bool PERM = false, AFTER_DRAIN = false;
  const bf16* PT; float* out; const float* ssx; float* ss1; bf16* H; const float* ng1; int layer;
  DI void operator()(const f32x4 (&acc)[2][2][4][2], const pg8::Unit& u, int wr, int wc, int fr, int fq) const {
#pragma unroll
    for (int ai = 0; ai < 2; ++ai)
#pragma unroll
      for (int m = 0; m < 4; ++m) {
        const int row = u.pm * 256 + ai * 128 + wr * 64 + m * 16 + fr; float rs = 0.f;
        const float rstd = rsqrtf(ssx[row] * (1.f / DM) + EPS);
#pragma unroll
        for (int bj = 0; bj < 2; ++bj)
#pragma unroll
          for (int n = 0; n < 2; ++n) {
            const int col = u.pn * 256 + bj * 128 + wc * 32 + n * 16 + fq * 4; const size_t off = (size_t)row * DM + col;
            f32x4 g;
#pragma unroll
            for (int j = 0; j < 4; ++j) g[j] = 1.f / (1.f + __expf(-rstd * acc[ai][bj][m][n][j]));
            const u32x2 pw = *(const u32x2*)(PT + off); f32x4 pp; pp.x = __uint_as_float(pw.x << 16); pp.y = __uint_as_float(pw.x & 0xffff0000u); pp.z = __uint_as_float(pw.y << 16); pp.w = __uint_as_float(pw.y & 0xffff0000u);
            const f32x4 xn = *(const f32x4*)(out + off) + pp * g;
            *(f32x4*)(out + off) = xn;
            if (layer == 0) {
              rs += xn.x * xn.x + xn.y * xn.y + xn.z * xn.z + xn.w * xn.w;
              const f32x4 gg = *(const f32x4*)(ng1 + col);
              u32x2 w; w.x = cvtpk(xn.x * gg.x, xn.y * gg.y); w.y = cvtpk(xn.z * gg.z, xn.w * gg.w); *(u32x2*)(H + off) = w;
            }
          }
        if (layer == 0) { rs += __shfl_xor(rs, 16); rs += __shfl_xor(rs, 32); if (fq == 0) atomicAdd(ss1 + row, rs); }
        asm volatile("" ::: "memory");
      }
  }
};
DI void phase_ple(const Params& p, int layer, char* lds) {
  unsigned char* ws = p.ws;
  bf16* PT = (bf16*)(ws + WS_PE);
  pg8::StaticOrder S; S.init(NTOK, DM, (int)gridDim.x, (int)blockIdx.x);
  { pg8::Gemm g{(const bf16*)(ws + WS_PBF) + (size_t)layer * NTOK * 256, (const bf16*)(ws + (layer == 0 ? WS_WP0 : WS_WP1)), NTOK, DM, 256};
    EpiPleProj E{PT};
    pg8::gemm_phase<EpiPleProj, pg8::StaticOrder, true, true>((PG8_LAS unsigned char*)lds, g, S, E); }
  { pg8::Gemm g{(const bf16*)(ws + WS_ACT), (const bf16*)(ws + (layer == 0 ? WS_WG0 : WS_WG1)), NTOK, DM, DM};
    EpiPleGate E{PT, p.out, (const float*)(ws + WS_SS) + (layer == 0 ? 1 : 2) * NTOK, (float*)(ws + WS_SS), (bf16*)(ws + WS_Y), p.in[I_NORM_GAIN] + DM, layer};
    pg8::gemm_phase<EpiPleGate, pg8::StaticOrder, true, true>((PG8_LAS unsigned char*)lds, g, S, E); }
}

template <int DVB, bool MASKED = true>
DI void attn_step32(const bf16* Kt, int KP, const bf16* Vt, int VP, const bf16x8 (&qf)[4], f32x16 (&o)[DVB], float& m, float& l, unsigned vmask, float c2, int lane) {
  const int r32 = lane & 31, h = lane >> 5;
  f32x16 s;
#pragma unroll
  for (int i = 0; i < 16; ++i) s[i] = 0.f;
#pragma unroll
  for (int t = 0; t < 4; ++t) { const bf16x8 kf = *(const bf16x8*)(Kt + r32 * KP + t * 16 + h * 8); s = mfma32(kf, qf[t], s); }
  float mx = -INFINITY;
#pragma unroll
  for (int i = 0; i < 16; ++i) { if (MASKED) { s[i] = ((vmask >> i) & 1u) ? s[i] : -INFINITY; } mx = fmaxf(mx, s[i]); }
  mx = fmaxf(mx, __shfl_xor(mx, 32));
  const float mn = fmaxf(m, mx * c2);
  if (__any(mn > m)) {
    const float alpha = fexp2(m - mn); l *= alpha;
#pragma unroll
    for (int d = 0; d < DVB; ++d)
#pragma unroll
      for (int i = 0; i < 16; ++i) o[d][i] *= alpha;
    m = mn;
  }
  float ps = 0.f; const float negm = -m;
#pragma unroll
  for (int i = 0; i < 16; ++i) { const float pv = fexp2(__builtin_fmaf(s[i], c2, negm)); s[i] = pv; ps += pv; }
  l += ps;
  bf16x8 pf[2];
  { u32x4 a, b; a.x = cvtpk(s[0], s[1]); a.y = cvtpk(s[2], s[3]); a.z = cvtpk(s[4], s[5]); a.w = cvtpk(s[6], s[7]);
    b.x = cvtpk(s[8], s[9]); b.y = cvtpk(s[10], s[11]); b.z = cvtpk(s[12], s[13]); b.w = cvtpk(s[14], s[15]);
    pf[0] = __builtin_bit_cast(bf16x8, a); pf[1] = __builtin_bit_cast(bf16x8, b); }
  const int i16 = lane & 15, q = i16 >> 2, pp = i16 & 3, blk = (lane >> 4) & 1;
#pragma unroll
  for (int d = 0; d < DVB; ++d)
#pragma unroll
    for (int sk = 0; sk < 2; ++sk) {
      const s16x4 lo = trread(Vt + (16 * sk + 4 * h + q) * VP + 32 * d + 16 * blk + 4 * pp);
      const s16x4 hi = trread(Vt + (16 * sk + 8 + 4 * h + q) * VP + 32 * d + 16 * blk + 4 * pp);
      const bf16x8 vf = __builtin_shufflevector(lo, hi, 0, 1, 2, 3, 4, 5, 6, 7);
      o[d] = mfma32(vf, pf[sk], o[d]);
    }
}

DI unsigned row_range_mask(int lo, int hi) {
  lo = lo < 0 ? 0 : lo; hi = hi > 31 ? 31 : hi;
  if (hi < lo) return 0u;
  const unsigned upto_hi = (hi >= 31) ? 0xffffffffu : ((1u << (hi + 1)) - 1u);
  return upto_hi & ~((1u << lo) - 1u);
}
DI unsigned lane_rows(unsigned m32, int h) {
  const unsigned t = m32 >> (4 * h);
  return (t & 0xFu) | ((t >> 4) & 0xF0u) | ((t >> 8) & 0xF00u) | ((t >> 12) & 0xF000u);
}
constexpr int WP = 72;
constexpr int WAVE_LDS = 2 * 32 * WP * 2;

struct KVRegs { u32x4 k[4], v[4]; };
DI void kv_store(const KVRegs& R, bf16* Ks, bf16* Vs, int lane) {
#pragma unroll
  for (int i = 0; i < 4; ++i) { const int row = (lane >> 3) + 8 * i, ch = lane & 7; *(u32x4*)(Ks + row * WP + ch * 8) = R.k[i]; *(u32x4*)(Vs + row * WP + ch * 8) = R.v[i]; }
}

DI void band_load(KVRegs& R, const bf16* Kg, const bf16* Vg, int NP, int kstart, int dil, int roff, int lane) {
#pragma unroll
  for (int i = 0; i < 4; ++i) {
    const int row = (lane >> 3) + 8 * i, ch = lane & 7; int k = kstart + row; if (k < 0) k = 0;
    const size_t off = (size_t)(dil * k + roff) * NP + ch * 8;
    R.k[i] = *(const u32x4*)(Kg + off); R.v[i] = *(const u32x4*)(Vg + off);
  }
}
template <int DVB>
DI void band_run(const bf16* Kg, const bf16* Vg, int NP, int kbase, int nsteps, int dil, int roff, int qidx, int win,
                 const bf16x8 (&qf)[4], f32x16 (&o)[DVB], float& m, float& l, float c2, bf16* Ks, bf16* Vs, int lane) {
  const int h = lane >> 5;
  KVRegs R; band_load(R, Kg, Vg, NP, kbase, dil, roff, lane);
  for (int j = 0; j < nsteps; ++j) {
    lds_fence();
    kv_store(R, Ks, Vs, lane);
    lds_fence();
    if (j + 1 < nsteps) band_load(R, Kg, Vg, NP, kbase + 32 * (j + 1), dil, roff, lane);
    const int kb = kbase + 32 * j, lo_r = (qidx - win > 0 ? qidx - win : 0) - kb;
    const unsigned vm = lane_rows(row_range_mask(lo_r, qidx - kb), h);
    attn_step32<DVB>(Ks, WP, Vs, WP, qf, o, m, l, vm, c2, lane);
  }
}

DI void write_o64(const f32x16 (&o)[2], float linv, const bf16* gate_row, bf16* y_row, int h) {
#pragma unroll
  for (int d = 0; d < 2; ++d)
#pragma unroll
    for (int g = 0; g < 4; ++g) {
      const int dd = 32 * d + 8 * g + 4 * h;
      const u32x2 gv = *(const u32x2*)(gate_row + dd);
      const float g0 = __uint_as_float(gv.x << 16), g1 = __uint_as_float(gv.x & 0xffff0000u), g2 = __uint_as_float(gv.y << 16), g3 = __uint_as_float(gv.y & 0xffff0000u);
      u32x2 w; w.x = cvtpk(o[d][4 * g] * linv * g0, o[d][4 * g + 1] * linv * g1); w.y = cvtpk(o[d][4 * g + 2] * linv * g2, o[d][4 * g + 3] * linv * g3);
      *(u32x2*)(y_row + dd) = w;
    }
}

DI void load_q(bf16x8 (&qf)[4], const bf16* qrow, int h) {
#pragma unroll
  for (int t = 0; t < 4; ++t) qf[t] = *(const bf16x8*)(qrow + t * 16 + h * 8);
}
template <int DVB> DI void zero_o(f32x16 (&o)[DVB]) {
#pragma unroll
  for (int d = 0; d < DVB; ++d)
#pragma unroll
    for (int i = 0; i < 16; ++i) o[d][i] = 0.f;
}

DI void mixerB_tile(const Params& p, int item, bf16* Ks, bf16* Vs, int lane) {
  const bf16* PE = (const bf16*)(p.ws + WS_PE); bf16* Y = (bf16*)(p.ws + WS_Y);
  const int qblk = item & 255, head = (item >> 8) & 7, b = item >> 11;
  const int r32 = lane & 31, h = lane >> 5, q0 = qblk * 32, kvh = head >> 2;
  const size_t rowb = (size_t)b * SEQ;
  bf16x8 qf[4]; load_q(qf, PE + (rowb + q0 + r32) * NPE + E_BQ + head * 64, h);
  f32x16 o[2]; zero_o<2>(o);
  const float sink2 = p.in[I_B_SINKS][head] * LOG2E;
  float m = sink2, l = (h == 0) ? 1.f : 0.f;
  band_run<2>(PE + rowb * NPE + E_BK + kvh * 64, PE + rowb * NPE + E_BV + kvh * 64, NPE, q0 - 128, 5, 1, 0, q0 + r32, 127, qf, o, m, l, 0.125f * LOG2E, Ks, Vs, lane);
  l += __shfl_xor(l, 32);
  const size_t tok = rowb + q0 + r32;
  write_o64(o, 1.f / l, PE + tok * NPE + E_BG + head * 64, Y + tok * DM + 512 + head * 64, h);
}

DI void mixerC_tile(const Params& p, int item, bf16* Ks, bf16* Vs, int lane) {
  const bf16* PO = (const bf16*)(p.ws + WS_PE); bf16* Y = (bf16*)(p.ws + WS_Y);
  const int qt = item & 15, r16 = (item >> 4) & 15, head = (item >> 8) & 7, b = item >> 11;
  const int r32 = lane & 31, h = lane >> 5, qi0 = qt * 32;
  const size_t rowb = (size_t)b * SEQ;
  const int t = 16 * (qi0 + r32) + r16;
  bf16x8 qf[4]; load_q(qf, PO + (rowb + t) * NPO + O_CQ + head * 64, h);
  f32x16 o[2]; zero_o<2>(o);
  float m = -1e30f, l = 0.f;
  const bf16* Kg = PO + rowb * NPO + O_CK + head * 64; const bf16* Vg = PO + rowb * NPO + O_CV + head * 64;
  const float c2 = 0.125f * LOG2E;
  band_run<2>(Kg, Vg, NPO, qi0 - 128, 5, 16, r16, qi0 + r32, 128, qf, o, m, l, c2, Ks, Vs, lane);
  band_run<2>(Kg, Vg, NPO, 4 * qi0 + (r16 >> 2) - 128, 8, 4, r16 & 3, 4 * (qi0 + r32) + (r16 >> 2), 128, qf, o, m, l, c2, Ks, Vs, lane);
  band_run<2>(Kg, Vg, NPO, 16 * qi0 + r16 - 128, 20, 1, 0, t, 128, qf, o, m, l, c2, Ks, Vs, lane);
  l += __shfl_xor(l, 32);
  const size_t tok = rowb + t;
  write_o64(o, 1.f / l, PO + tok * NPO + O_CG + head * 64, Y + tok * DM + head * 64, h);
}

DI void mixerA_item(const Params& p, int item, bf16* Ks, bf16* Vs, int lane) {
  const bf16* PE = (const bf16*)(p.ws + WS_PE); bf16* Y = (bf16*)(p.ws + WS_Y);
  const unsigned short* SEL = (const unsigned short*)(p.ws + WS_SEL) + (size_t)item * 256;
  const int t = item & (SEQ - 1), b = item >> 13;
  const int r32 = lane & 31, h = lane >> 5, head = r32 & 7;
  const size_t rowb = (size_t)b * SEQ;
  const int count = (t + 1 < 256) ? t + 1 : 256, nsteps = (count + 31) >> 5;
  bf16x8 qf[4]; load_q(qf, PE + (size_t)item * NPE + E_AQ + head * 64, h);
  f32x16 o[2]; zero_o<2>(o);
  float m = -1e30f, l = 0.f;
  const bf16* Kg = PE + rowb * NPE + E_AK; const bf16* Vg = PE + rowb * NPE + E_AV;
  KVRegs R;
#define A_LOAD(j) do { _Pragma("unroll") for (int i = 0; i < 4; ++i) { const int row = (lane >> 3) + 8 * i, ch = lane & 7, e = 32 * (j) + row; \
      const int tokk = (e < count) ? (int)SEL[e] : 0; const size_t off = (size_t)tokk * NPE + ch * 8; R.k[i] = *(const u32x4*)(Kg + off); R.v[i] = *(const u32x4*)(Vg + off); } } while (0)
  A_LOAD(0);
  for (int j = 0; j < nsteps; ++j) {
    lds_fence();
    kv_store(R, Ks, Vs, lane);
    lds_fence();
    if (j + 1 < nsteps) A_LOAD(j + 1);
    const unsigned vm = lane_rows(row_range_mask(0, count - 1 - 32 * j), h);
    attn_step32<2>(Ks, WP, Vs, WP, qf, o, m, l, vm, 0.125f * LOG2E, lane);
  }
#undef A_LOAD
  l += __shfl_xor(l, 32);
  if (r32 < 8) write_o64(o, 1.f / l, PE + (size_t)item * NPE + E_AG + head * 64, Y + (size_t)item * DM + head * 64, h);
}

DI unsigned f2ord(float f) { f += 0.f; const unsigned u = __float_as_uint(f); return (u & 0x80000000u) ? ~u : (u | 0x80000000u); }
DI int block_excl_scan(int v, int* tmp, int* tot) {
  const int lane = threadIdx.x & 63, wid = threadIdx.x >> 6;
  int inc = v;
#pragma unroll
  for (int o = 1; o < 64; o <<= 1) { const int u = __shfl_up(inc, o); if (lane >= o) inc += u; }
  if (lane == 63) tmp[wid] = inc;
  __syncthreads();
  int base = 0, total = 0;
#pragma unroll
  for (int w = 0; w < 8; ++w) { const int x = tmp[w]; if (w < wid) base += x; total += x; }
  *tot = total;
  return base + inc - v;
}

DI float dpp_sum8(float v) {
  v += __builtin_bit_cast(float, __builtin_amdgcn_mov_dpp(__builtin_bit_cast(int, v), 0xB1, 0xF, 0xF, true));
  v += __builtin_bit_cast(float, __builtin_amdgcn_mov_dpp(__builtin_bit_cast(int, v), 0x4E, 0xF, 0xF, true));
  v += __builtin_bit_cast(float, __builtin_amdgcn_mov_dpp(__builtin_bit_cast(int, v), 0x141, 0xF, 0xF, true));
  return v;
}
DI void hist_find(const int* hist, int* misc, int need, int& digit, int& nneed, int& cnt) {
  const int tid = threadIdx.x;
  typedef int i32x4 __attribute__((ext_vector_type(4)));
  const i32x4 h0 = *(const i32x4*)(hist + tid * 8), h1 = *(const i32x4*)(hist + tid * 8 + 4);
  int hh[8] = {h0.x, h0.y, h0.z, h0.w, h1.x, h1.y, h1.z, h1.w}; int tot = 0;
#pragma unroll
  for (int k = 0; k < 8; ++k) tot += hh[k];
  int total; const int ex = block_excl_scan(tot, misc, &total);
  int above = total - ex - tot;
#pragma unroll
  for (int k = 7; k >= 0; --k) { const int c = hh[k]; if (above < need && above + c >= need) { misc[16] = tid * 8 + k; misc[17] = need - above; misc[18] = c; } above += c; }
  __syncthreads();
  digit = misc[16]; nneed = misc[17]; cnt = misc[18];
  __syncthreads();
}
DI unsigned long long mkcmp(float v, int idx) { return ((unsigned long long)f2ord(v) << 16) | ((unsigned long long)(8191 - idx) << 3); }
DI float ord2f(unsigned k) { return __uint_as_float((k & 0x80000000u) ? (k ^ 0x80000000u) : ~k); }
DI float half_sum(float v) { auto rr = __builtin_amdgcn_permlane32_swap(__float_as_uint(v), __float_as_uint(v), false, false); return __uint_as_float(rr[0]) + __uint_as_float(rr[1]); }

constexpr int CL_CAP = 512;
DI void select_slow(const float* scq, int n, unsigned short* out, float lo, float hi, int* hist, int* misc, unsigned long long* clist) {
  const int tid = opaque_tid();
    const float scale = (hi > lo) ? 4095.f / (hi - lo) : 0.f;
    for (int i = tid; i < 4096; i += 512) hist[i] = 0;
    if (tid == 0) misc[20] = 0;
    __syncthreads();
    float val[16]; int bin[16];
#pragma unroll
    for (int i = 0; i < 16; ++i) { const int idx = tid + 512 * i; const float v = (idx < n) ? scq[idx] : lo; val[i] = v;
      int bb = (int)((v - lo) * scale); bb = bb < 0 ? 0 : (bb > 4095 ? 4095 : bb); bin[i] = bb; if (idx < n) atomicAdd(&hist[bb], 1); }
    __syncthreads();
    int bstar, need, cnt;
    hist_find(hist, misc, 256, bstar, need, cnt);
    unsigned long long T = 0ull;
    if (cnt != need) {
      if (cnt <= CL_CAP) {
#pragma unroll
        for (int i = 0; i < 16; ++i) { const int idx = tid + 512 * i; if (idx < n && bin[i] == bstar) { const int slot = atomicAdd(&misc[20], 1); clist[slot] = mkcmp(val[i], idx); } }
        __syncthreads();
        if (tid < cnt) { const unsigned long long c = clist[tid]; int rank = 0; for (int jx = 0; jx < cnt; ++jx) rank += (clist[jx] > c) ? 1 : 0;
          if (rank == need - 1) { misc[21] = (int)(unsigned)(c & 0xffffffffull); misc[22] = (int)(unsigned)(c >> 32); } }
        __syncthreads();
        T = ((unsigned long long)(unsigned)misc[22] << 32) | (unsigned long long)(unsigned)misc[21];
      } else {
        unsigned long long prefix = 0ull; int shift = 36;
        for (int pass = 0; pass < 4; ++pass) {
          for (int i = tid; i < 4096; i += 512) hist[i] = 0;
          __syncthreads();
#pragma unroll
          for (int i = 0; i < 16; ++i) { const int idx = tid + 512 * i; if (idx < n && bin[i] == bstar) { const unsigned long long c = mkcmp(val[i], idx); if (pass == 0 || (c >> (shift + 12)) == prefix) atomicAdd(&hist[(int)((c >> shift) & 4095ull)], 1); } }
          __syncthreads();
          int digit, nneed, c2;
          hist_find(hist, misc, need, digit, nneed, c2);
          prefix = (prefix << 12) | (unsigned long long)digit; need = nneed;
          if (c2 == need) break;
          shift -= 12;
        }
        T = prefix << shift;
      }
    }
    int mycnt = 0; unsigned selm = 0;
#pragma unroll
    for (int i = 0; i < 16; ++i) { const int idx = tid + 512 * i;
      bool sel = false;
      if (idx < n) { if (bin[i] > bstar) sel = true; else if (bin[i] == bstar) sel = (mkcmp(val[i], idx) >= T); }
      if (sel) { ++mycnt; selm |= (1u << i); } }
    int total; int pos = block_excl_scan(mycnt, misc + 8, &total);
#pragma unroll
    for (int i = 0; i < 16; ++i) { if ((selm >> i) & 1u) { if (pos < 256) out[pos] = (unsigned short)(tid + 512 * i); ++pos; } }
    __syncthreads();
}

DI void selectA_item(const Params& p, int item, char* lds) {
  const bf16* PE = (const bf16*)(p.ws + WS_PE);
  const float* IW = (const float*)(p.ws + WS_IW);
  unsigned short* SEL = (unsigned short*)(p.ws + WS_SEL);
  float* sc = (float*)lds;
  int* hist = (int*)(lds + 4 * 8192 * 4);
  int* misc = hist + 4096;
  unsigned* mm = (unsigned*)(misc + 24);
  unsigned long long* clist = (unsigned long long*)(misc + 96);
  const int tid = opaque_tid(), lane = tid & 63, wid = tid >> 6, r32 = lane & 31, h = lane >> 5;
  const int b = item >> 11, t0 = (item & 2047) * 4;
  const size_t rowb = (size_t)b * SEQ;
  const int nk = t0 + 4, ntile = (nk + 31) >> 5;
  if (tid < 4) { mm[tid * 2] = 0xFFFFFFFFu; mm[tid * 2 + 1] = 0u; }
  __syncthreads();
  bf16x8 qf[4]; load_q(qf, PE + (rowb + t0 + (r32 >> 3)) * NPE + E_IQ + (r32 & 7) * 64, h);
  float wq[16];
#pragma unroll
  for (int i = 0; i < 16; ++i) wq[i] = IW[(rowb + t0 + (i >> 2)) * 8 + (i & 3) + 4 * h] * 0.04419417382415922f;
  const bf16* Kt = (const bf16*)(p.ws + WS_IKS) + (size_t)b * 256 * 2048 + lane * 8;
  {
    bf16x8 kf[4], kn[4];
#pragma unroll
    for (int t = 0; t < 4; ++t) { kf[t] = (bf16x8){0, 0, 0, 0, 0, 0, 0, 0}; kn[t] = kf[t]; }
    if (wid < ntile) {
#pragma unroll
      for (int t = 0; t < 4; ++t) kf[t] = *(const bf16x8*)(Kt + (size_t)wid * 2048 + t * 512);
    }
    float lo0 = INFINITY, hi0 = -INFINITY, lo1 = INFINITY, hi1 = -INFINITY;
    for (int kt = wid; kt < ntile; kt += 8) {
      if (kt + 8 < ntile) {
#pragma unroll
        for (int t = 0; t < 4; ++t) kn[t] = *(const bf16x8*)(Kt + (size_t)(kt + 8) * 2048 + t * 512);
      }
      f32x16 s;
#pragma unroll
      for (int i = 0; i < 16; ++i) s[i] = 0.f;
#pragma unroll
      for (int t = 0; t < 4; ++t) s = mfma32(qf[t], kf[t], s);
      float v[4];
#pragma unroll
      for (int q = 0; q < 4; ++q) {
        float a = wq[4 * q] * fmaxf(s[4 * q], 0.f);
#pragma unroll
        for (int jj = 1; jj < 4; ++jj) a += wq[4 * q + jj] * fmaxf(s[4 * q + jj], 0.f);
        v[q] = half_sum(a) + 0.f;
      }
      const float va = h ? v[2] : v[0], vb = h ? v[3] : v[1];
      const int key = kt * 32 + r32;
      sc[(2 * h) * 8192 + key] = va; sc[(2 * h + 1) * 8192 + key] = vb;
      lo0 = fminf(lo0, va); hi0 = fmaxf(hi0, va); lo1 = fminf(lo1, vb); hi1 = fmaxf(hi1, vb);
#pragma unroll
      for (int t = 0; t < 4; ++t) kf[t] = kn[t];
    }
    if (wid < ntile) {
#pragma unroll
      for (int o = 1; o < 32; o <<= 1) { lo0 = fminf(lo0, __shfl_xor(lo0, o)); hi0 = fmaxf(hi0, __shfl_xor(hi0, o)); lo1 = fminf(lo1, __shfl_xor(lo1, o)); hi1 = fmaxf(hi1, __shfl_xor(hi1, o)); }
      if (r32 == 0) { atomicMin(&mm[(2 * h) * 2], f2ord(lo0)); atomicMax(&mm[(2 * h) * 2 + 1], f2ord(hi0)); atomicMin(&mm[(2 * h + 1) * 2], f2ord(lo1)); atomicMax(&mm[(2 * h + 1) * 2 + 1], f2ord(hi1)); }
    }
  }
  __syncthreads();
  {
    const int g = wid >> 1, gt = tid & 127, upper = wid & 1;
    const int t = t0 + g, n = t + 1;
    const bool big = n > 256;
    const float* scq = sc + g * 8192;
    unsigned short* out = SEL + (rowb + t) * 256;
    int* histq = hist + g * 1024;
    unsigned long long* clq = clist + g * 128;
    int* mq = misc + 32 + g * 8;
    const float lo = ord2f(mm[g * 2]), hi = ord2f(mm[g * 2 + 1]);
    const float scale = (hi > lo) ? 1023.f / (hi - lo) : 0.f;
    for (int i = gt; i < 1024; i += 128) histq[i] = 0;
    if (gt == 0) { mq[0] = 0; mq[6] = 0; }
    __syncthreads();
    float uu[64];
#pragma unroll
    for (int i = 0; i < 64; ++i) { const int idx = gt + 128 * i; const float v = (idx < n) ? scq[idx] : lo; const float u = (v - lo) * scale; uu[i] = u;
      if (big && idx < n) { int bb = (int)u; bb = bb > 1023 ? 1023 : bb; atomicAdd(&histq[bb], 1); } }
    __syncthreads();
    typedef int i32x4 __attribute__((ext_vector_type(4)));
    const i32x4 h0 = *(const i32x4*)(histq + gt * 8), h1 = *(const i32x4*)(histq + gt * 8 + 4);
    const int hh[8] = {h0.x, h0.y, h0.z, h0.w, h1.x, h1.y, h1.z, h1.w};
    int tot = 0;
#pragma unroll
    for (int k = 0; k < 8; ++k) tot += hh[k];
    int inc = tot;
#pragma unroll
    for (int o = 1; o < 64; o <<= 1) { const int ux = __shfl_down(inc, o); if (lane + o < 64) inc += ux; }
    if (lane == 0) misc[wid] = inc;
    __syncthreads();
    {
      int above = inc - tot + (upper ? 0 : misc[wid + 1]);
      if (big) {
#pragma unroll
        for (int k = 7; k >= 0; --k) { const int c = hh[k]; if (above < 256 && above + c >= 256) { mq[1] = gt * 8 + k; mq[2] = 256 - above; mq[3] = c; } above += c; }
      }
    }
    __syncthreads();
    const int bstar = mq[1], need = mq[2], cnt = mq[3];
    const float flo = (float)bstar, fhi = (bstar >= 1023) ? INFINITY : (float)(bstar + 1);
    const bool tie = big && cnt != need;
    if (tie) {
      if (cnt <= 128) {
#pragma unroll
        for (int i = 0; i < 64; ++i) { const int idx = gt + 128 * i; if (idx < n && uu[i] >= flo && uu[i] < fhi) { const int slot = atomicAdd(&mq[0], 1); clq[slot] = mkcmp(scq[idx], idx); } }
      } else if (gt == 0) mq[6] = 1;
    }
    __syncthreads();
    if (tie && cnt <= 128 && gt < cnt) { const unsigned long long c = clq[gt]; int rank = 0; for (int jx = 0; jx < cnt; ++jx) rank += (clq[jx] > c) ? 1 : 0;
      if (rank == need - 1) { mq[4] = (int)(unsigned)(c & 0xffffffffull); mq[5] = (int)(unsigned)(c >> 32); } }
    __syncthreads();
    const unsigned long long T = tie ? (((unsigned long long)(unsigned)mq[5] << 32) | (unsigned long long)(unsigned)mq[4]) : 0ull;
    const bool fast = big && !(tie && cnt > 128);
    unsigned long long selm = 0ull;
    if (fast) {
#pragma unroll
      for (int i = 0; i < 64; ++i) { const int idx = gt + 128 * i;
        if (idx < n) { const float u = uu[i]; bool sel = u >= fhi; if (!sel && u >= flo) sel = !tie || (mkcmp(scq[idx], idx) >= T); if (sel) selm |= (1ull << i); } }
    }
    const int mycnt = __popcll(selm);
    int pinc = mycnt;
#pragma unroll
    for (int o = 1; o < 64; o <<= 1) { const int ux = __shfl_up(pinc, o); if (lane >= o) pinc += ux; }
    if (lane == 63) misc[8 + wid] = pinc;
    __syncthreads();
    if (fast) {
      int pos = pinc - mycnt + (upper ? misc[8 + wid - 1] : 0);
      while (selm) { const int i = __ffsll((long long)selm) - 1; selm &= selm - 1ull; if (pos < 256) out[pos] = (unsigned short)(gt + 128 * i); ++pos; }
    } else if (!big) {
      for (int i = gt; i < n; i += 128) out[i] = (unsigned short)i;
    }
    __syncthreads();
  }
  for (int q = 0; q < 4; ++q) {
    if (misc[32 + q * 8 + 6]) { const int t = t0 + q; select_slow(sc + q * 8192, t + 1, SEL + (rowb + t) * 256, ord2f(mm[q * 2]), ord2f(mm[q * 2 + 1]), hist, misc, clist); }
  }
  __syncthreads();
}

constexpr int DKP = 72, DVP = 136;
constexpr int D_STAGE = (64 * DKP * 2 + 64 * DVP) * 2;
DI void mixerD_unit(const Params& p, int b, int head, int qb, char* lds) {
  const bf16* PO = (const bf16*)(p.ws + WS_PE); bf16* Y = (bf16*)(p.ws + WS_Y);
  const int tid = opaque_tid(), lane = tid & 63, wid = tid >> 6, r32 = lane & 31, h = lane >> 5;
  const int map = wid & 1, qsub = wid >> 1;
  const size_t rowb = (size_t)b * SEQ;
  const int qpos = 128 * qb + 32 * qsub + r32;
  bf16x8 qf[4]; load_q(qf, PO + (rowb + qpos) * NPO + O_DQ + (2 * head + map) * 64, h);
  f32x16 o[4]; zero_o<4>(o);
  float m = -1e30f, l = 0.f;
  const int nsteps = 2 * qb + 2;
  const bf16* K1g = PO + rowb * NPO + O_DK + (2 * head) * 64;
  const bf16* K2g = K1g + 64;
  const bf16* Vg = PO + rowb * NPO + O_DV + head * 128;
  u32x4 rk1, rk2, rv[2];
#define D_LOAD(j) do { const int row = tid >> 3, ch = tid & 7; const size_t off = (size_t)((j) * 64 + row) * NPO + ch * 8; rk1 = *(const u32x4*)(K1g + off); rk2 = *(const u32x4*)(K2g + off); \
    _Pragma("unroll") for (int i = 0; i < 2; ++i) { const int c = tid + 512 * i, vr = c >> 4, vc = c & 15; rv[i] = *(const u32x4*)(Vg + (size_t)((j) * 64 + vr) * NPO + vc * 8); } } while (0)
  __syncthreads();
  D_LOAD(0);
  for (int j = 0; j < nsteps; ++j) {
    char* st = lds + (j & 1) * D_STAGE;
    bf16* K1s = (bf16*)st; bf16* K2s = K1s + 64 * DKP; bf16* Vs = K2s + 64 * DKP;
    { const int row = tid >> 3, ch = tid & 7; *(u32x4*)(K1s + row * DKP + ch * 8) = rk1; *(u32x4*)(K2s + row * DKP + ch * 8) = rk2;
#pragma unroll
      for (int i = 0; i < 2; ++i) { const int c = tid + 512 * i, vr = c >> 4, vc = c & 15; *(u32x4*)(Vs + vr * DVP + vc * 8) = rv[i]; } }
    __syncthreads();
    if (j + 1 < nsteps) D_LOAD(j + 1);
    const bf16* Ks = map ? K2s : K1s;
#pragma unroll
    for (int sub = 0; sub < 2; ++sub) {
      const int k0 = j * 64 + sub * 32;
      if (k0 <= 128 * qb + 32 * qsub + 31) {
        if (k0 + 31 <= 128 * qb + 32 * qsub) {
          attn_step32<4, false>(Ks + sub * 32 * DKP, DKP, Vs + sub * 32 * DVP, DVP, qf, o, m, l, 0xffffu, 0.125f * LOG2E, lane);
        } else {
          unsigned vm = 0;
#pragma unroll
          for (int i = 0; i < 16; ++i) if (k0 + crow(i, h) <= qpos) vm |= (1u << i);
          attn_step32<4, true>(Ks + sub * 32 * DKP, DKP, Vs + sub * 32 * DVP, DVP, qf, o, m, l, vm, 0.125f * LOG2E, lane);
        }
      }
    }
  }
#undef D_LOAD
  l += __shfl_xor(l, 32);
  const float linv = 1.f / l;
  __syncthreads();
  float* xch = (float*)lds + qsub * 4096;
  if (map == 1) {
#pragma unroll
    for (int d = 0; d < 4; ++d)
#pragma unroll
      for (int i = 0; i < 16; ++i) xch[(d * 16 + i) * 64 + lane] = o[d][i] * linv;
  }
  __syncthreads();
  if (map == 0) {
    const float lam = *(const float*)(p.ws + WS_LAM);
    float ssq = 0.f;
#pragma unroll
    for (int d = 0; d < 4; ++d)
#pragma unroll
      for (int i = 0; i < 16; ++i) { const float a = o[d][i] * linv - lam * xch[(d * 16 + i) * 64 + lane]; o[d][i] = a; ssq += a * a; }
    ssq += __shfl_xor(ssq, 32);
    const float lambda_init = 0.8f - 0.6f * expf(-0.3f);
    const float rn = rsqrtf(ssq * (1.f / 128.f) + EPS) * (1.f - lambda_init);
    const size_t tok = rowb + qpos;
    const bf16* gate = PO + tok * NPO + O_DG + head * 128;
    bf16* y = Y + tok * DM + 512 + head * 128;
    const float* sg = p.in[I_SUB_GAIN];
#pragma unroll
    for (int d = 0; d < 4; ++d)
#pragma unroll
      for (int g = 0; g < 4; ++g) {
        const int dd = 32 * d + 8 * g + 4 * h;
        const u32x2 gv = *(const u32x2*)(gate + dd); const f32x4 s4 = *(const f32x4*)(sg + dd);
        const float g0 = __uint_as_float(gv.x << 16), g1 = __uint_as_float(gv.x & 0xffff0000u), g2 = __uint_as_float(gv.y << 16), g3 = __uint_as_float(gv.y & 0xffff0000u);
        u32x2 w; w.x = cvtpk(o[d][4 * g] * rn * s4.x * g0, o[d][4 * g + 1] * rn * s4.y * g1); w.y = cvtpk(o[d][4 * g + 2] * rn * s4.z * g2, o[d][4 * g + 3] * rn * s4.w * g3);
        *(u32x2*)(y + dd) = w;
      }
  }
  __syncthreads();
}

#define XB_TMO      128
#define XB_XCNT(j)  (256  + 64 * (j))
#define XB_XSUB(j)  (1280 + 64 * (j))
#define XB_XGEN(j)  (2304 + 64 * (j))
#define XB_TOP      3328
#define XB_TOPGEN   3392
#define XCD_BAR_WORDS 3456
#define XB_SPIN_CAP (1u << 18)

__device__ __forceinline__ unsigned xb_ld(unsigned* p)              { return __hip_atomic_load(p, __ATOMIC_RELAXED, __HIP_MEMORY_SCOPE_AGENT); }
__device__ __forceinline__ unsigned xb_add(unsigned* p, unsigned v) { return __hip_atomic_fetch_add(p, v, __ATOMIC_RELAXED, __HIP_MEMORY_SCOPE_AGENT); }
__device__ __forceinline__ unsigned xb_xcc_id() { return (unsigned)__builtin_amdgcn_s_getreg((3 << 11) | 20) & 0xFu; }
#define XB_SPIN(cond, bar) do { unsigned _sp = 0; while (cond) { __builtin_amdgcn_s_sleep(1); \
    if ((++_sp & 255u) == 0u) { if (xb_ld(&(bar)[XB_TMO])) break; if (_sp > XB_SPIN_CAP) { atomicAdd(&(bar)[XB_TMO], 1u); break; } } } } while (0)

struct XcdBarrier {
    unsigned* bar; unsigned x;
    volatile LAS unsigned* st;
};

__device__ __forceinline__ XcdBarrier xcd_barrier_post(unsigned* bar, volatile LAS unsigned* st) {
    XcdBarrier b; b.bar = bar; b.x = xb_xcc_id(); b.st = st;
    if (threadIdx.x == 0) (void)xb_add(&bar[XB_XCNT(b.x)], 1u);
    return b;
}
__device__ __forceinline__ void xcd_barrier_complete(unsigned* bar, unsigned x, unsigned& nloc, unsigned& nx) {
    const unsigned G = gridDim.x * gridDim.y * gridDim.z;
    unsigned sum, cnt, mine, sp = 0u;
    for (;;) {
        sum = 0u; cnt = 0u; mine = 0u;
#pragma unroll
        for (unsigned j = 0; j < 16; ++j) { const unsigned c = xb_ld(&bar[XB_XCNT(j)]); sum += c; cnt += (c > 0u) ? 1u : 0u; mine = (j == x) ? c : mine; }
        if (sum == G) break;
        __builtin_amdgcn_s_sleep(1);
        if ((++sp & 255u) == 0u) { if (xb_ld(&bar[XB_TMO])) break; if (sp > XB_SPIN_CAP) { atomicAdd(&bar[XB_TMO], 1u); break; } }
    }
    nloc = mine > 0u ? mine : 1u; nx = cnt > 0u ? cnt : 1u;
}

__device__ __forceinline__ void xcd_barrier(const XcdBarrier& b) {
    asm volatile("s_waitcnt vmcnt(0)" ::: "memory");
    __syncthreads();
    if (threadIdx.x == 0) {
        unsigned* bar = b.bar;
        __builtin_amdgcn_s_waitcnt(0);
        unsigned nloc = b.st[0], nx = b.st[1];
        if (nloc == 0u) { xcd_barrier_complete(bar, b.x, nloc, nx); b.st[0] = nloc; b.st[1] = nx; }
        const unsigned old = xb_add(&bar[XB_XSUB(b.x)], 1u);
        const unsigned gen = old / nloc;
        if (old + 1u == (gen + 1u) * nloc) {
            __builtin_amdgcn_fence(__ATOMIC_RELEASE, "agent");
            asm volatile("s_waitcnt vmcnt(0)" ::: "memory");
            const unsigned og = xb_add(&bar[XB_TOP], 1u);
            const unsigned tg = og / nx;
            if (og + 1u == (tg + 1u) * nx) xb_add(&bar[XB_TOPGEN], 1u);
            else XB_SPIN(xb_ld(&bar[XB_TOPGEN]) == tg, bar);
            __builtin_amdgcn_fence(__ATOMIC_ACQUIRE, "agent");
            xb_add(&bar[XB_XGEN(b.x)], 1u);
            asm volatile("s_waitcnt vmcnt(0)" ::: "memory");
        } else {
            XB_SPIN(xb_ld(&bar[XB_XGEN(b.x)]) == gen, bar);
            __builtin_amdgcn_fence(__ATOMIC_ACQUIRE, "agent");
            asm volatile("s_waitcnt vmcnt(0)" ::: "memory");
        }
    }
    __syncthreads();
}


__global__ void __launch_bounds__(NTHREADS) fwd_kernel(Params p) {
  extern __shared__ __attribute__((aligned(16))) char smem[];
  cg::grid_group grid = cg::this_grid();
  char* lds = smem;
  volatile LAS unsigned* xb_st = (volatile LAS unsigned*)((LAS char*)smem + (LDS_BYTES - 16));
  if (threadIdx.x < 2) xb_st[threadIdx.x] = 0u;
  __syncthreads();
  const XcdBarrier xbar = xcd_barrier_post((unsigned*)(p.ws + WS_BAR), xb_st);
#define FRESH_IDS const int tid = opaque_tid(), lane = tid & 63, wid = tid >> 6; const int gw = blockIdx.x * 8 + wid, ngw = gridDim.x * 8; bf16* Ks = (bf16*)(lds + wid * WAVE_LDS); bf16* Vs = Ks + 32 * WP; (void)gw; (void)ngw; (void)Ks; (void)Vs; (void)lane;

  phase_prologue(p, lds);
  if (p.ws == nullptr) grid.sync();
  xcd_barrier(xbar);
  for (int rep = 0; rep < REP_GEMM; ++rep) phase_inproj(p, 0, lds);
  xcd_barrier(xbar);
#if EN_A
  for (int rep = 0; rep < REP_SELA; ++rep) for (int it = blockIdx.x; it < 2 * 2048; it += gridDim.x) selectA_item(p, it, lds);
  xcd_barrier(xbar);
  { FRESH_IDS for (int rep = 0; rep < REP_AATT; ++rep) for (int it = gw; it < NTOK; it += ngw) mixerA_item(p, it, Ks, Vs, lane); }
#else
  { unsigned* y = (unsigned*)(p.ws + WS_Y); for (int i = blockIdx.x * NTHREADS + (int)threadIdx.x; i < NTOK * 256; i += gridDim.x * NTHREADS) { const int row = i >> 8, c = i & 255; y[row * 512 + c] = 0u; } }
#endif
#if EN_B
  { FRESH_IDS for (int it = gw; it < 4096; it += ngw) mixerB_tile(p, it, Ks, Vs, lane); }
#else
  { unsigned* y = (unsigned*)(p.ws + WS_Y); for (int i = blockIdx.x * NTHREADS + (int)threadIdx.x; i < NTOK * 256; i += gridDim.x * NTHREADS) { const int row = i >> 8, c = i & 255; y[row * 512 + 256 + c] = 0u; } }
#endif
  xcd_barrier(xbar);
  phase_outproj(p, 0, lds);
  xcd_barrier(xbar);
  phase_ple(p, 0, lds);
  xcd_barrier(xbar);
  phase_inproj(p, 1, lds);
  xcd_barrier(xbar);
#if EN_D
  for (int rep = 0; rep < REP_D; ++rep) {
#pragma unroll 1
    for (int u2 = blockIdx.x * 2; u2 < 512; u2 += gridDim.x * 2) {
#pragma unroll 1
      for (int k = 0; k < 2; ++k) { const int u = u2 >> 1, bh = u >> 5, pr = u & 31; mixerD_unit(p, bh >> 2, bh & 3, k ? 63 - pr : pr, lds); }
    }
  }
#else
  { unsigned* y = (unsigned*)(p.ws + WS_Y); for (int i = blockIdx.x * NTHREADS + (int)threadIdx.x; i < NTOK * 256; i += gridDim.x * NTHREADS) { const int row = i >> 8, c = i & 255; y[row * 512 + 256 + c] = 0u; } }
#endif
#if EN_C
  __syncthreads();
  { FRESH_IDS for (int rep = 0; rep < REP_C; ++rep) for (int it = gw; it < 4096; it += ngw) mixerC_tile(p, it, Ks, Vs, lane); }
#else
  { unsigned* y = (unsigned*)(p.ws + WS_Y); for (int i = blockIdx.x * NTHREADS + (int)threadIdx.x; i < NTOK * 256; i += gridDim.x * NTHREADS) { const int row = i >> 8, c = i & 255; y[row * 512 + c] = 0u; } }
#endif
  xcd_barrier(xbar);
  phase_outproj(p, 1, lds);
  xcd_barrier(xbar);
  phase_ple(p, 1, lds);
}

extern "C" void kernel_launch(void* const* d_in, const int* in_sizes, int n_in, void* d_out, int out_size, void* d_ws, size_t ws_size, hipStream_t stream) {
  static int grid_blocks = 0;
  if (!grid_blocks) {
    int dev = 0, cus = 0, per_cu = 0;
    hipGetDevice(&dev);
    hipDeviceGetAttribute(&cus, hipDeviceAttributeMultiprocessorCount, dev);
    hipFuncSetAttribute((const void*)fwd_kernel, hipFuncAttributeMaxDynamicSharedMemorySize, LDS_BYTES);
    hipOccupancyMaxActiveBlocksPerMultiprocessor(&per_cu, (const void*)fwd_kernel, NTHREADS, LDS_BYTES);
    if (per_cu < 1) per_cu = 1;
    grid_blocks = cus * per_cu;
    if (grid_blocks > 256) grid_blocks = 256;
  }
  Params p{};
  for (int i = 0; i < 25; ++i) p.in[i] = (const float*)d_in[i];
  p.out = (float*)d_out; p.ws = (unsigned char*)d_ws;
  for (int i = 0; i < 32; ++i) p.inv_freq[i] = (float)pow(10000.0, -(double)i / 32.0);
  (void)hipMemsetAsync((char*)d_ws + WS_BAR, 0, 16384, stream);
  void* args[] = {&p};
  hipError_t e = hipLaunchCooperativeKernel((const void*)fwd_kernel, dim3(grid_blocks), dim3(NTHREADS), args, LDS_BYTES, stream);
  if (e != hipSuccess) fprintf(stderr, "cooperative launch failed: %s (grid %d)\n", hipGetErrorString(e), grid_blocks);
}
```

```cpp
#include <hip/hip_runtime.h>
#include <hip/hip_cooperative_groups.h>
#include <cstdio>
#include <cmath>
namespace cg = cooperative_groups;

#ifndef REP_GEMM
#define REP_GEMM 1
#endif
#ifndef REP_SELA
#define REP_SELA 1
#endif
#ifndef REP_D
#define REP_D 1
#endif
#ifndef REP_C
#define REP_C 1
#endif
#ifndef REP_AATT
#define REP_AATT 1
#endif
#ifndef EN_A
#define EN_A 1
#endif
#ifndef EN_B
#define EN_B 1
#endif
#ifndef EN_C
#define EN_C 1
#endif
#ifndef EN_D
#define EN_D 1
#endif

typedef unsigned short bf16;
typedef short bf16x8 __attribute__((ext_vector_type(8)));
typedef short s16x4 __attribute__((ext_vector_type(4)));
typedef float f32x4 __attribute__((ext_vector_type(4)));
typedef float f32x16 __attribute__((ext_vector_type(16)));
typedef unsigned u32x4 __attribute__((ext_vector_type(4)));
typedef unsigned u32x2 __attribute__((ext_vector_type(2)));
typedef float f32x2_t __attribute__((ext_vector_type(2)));
typedef __bf16 bf16x2_t __attribute__((ext_vector_type(2)));
#define LAS __attribute__((address_space(3)))
#define DI __device__ __forceinline__

constexpr int SEQ = 8192, NTOK = 16384, DM = 1024;
constexpr int NPE = 3072, NPO = 4096;
constexpr float EPS = 1e-6f;
constexpr float LOG2E = 1.4426950408889634f;
constexpr int NTHREADS = 512;
constexpr int LDS_BYTES = 150 * 1024;

constexpr size_t MiB = 1u << 20;
constexpr size_t WS_PE = 0;
constexpr size_t WS_ACT = 128 * MiB;
constexpr size_t WS_Y = 160 * MiB;
constexpr size_t WS_WINE = 192 * MiB;
constexpr size_t WS_WOUTE = 198 * MiB;
constexpr size_t WS_WINO = 200 * MiB;
constexpr size_t WS_WOUTO = 208 * MiB;
constexpr size_t WS_WG0 = 210 * MiB;
constexpr size_t WS_WG1 = 212 * MiB;
constexpr size_t WS_WP0 = 214 * MiB;
constexpr size_t WS_WP1 = 215 * MiB;
constexpr size_t WS_ROPE = 216 * MiB;
constexpr size_t WS_SEL = 218 * MiB;
constexpr size_t WS_IW = 226 * MiB;
constexpr size_t WS_SS = 227 * MiB;
constexpr size_t WS_LAM = 228 * MiB;
constexpr size_t WS_BAR = 250 * MiB;
constexpr size_t WS_PBF = 232 * MiB;
constexpr size_t WS_IKS = 229 * MiB;

struct Params {
  const float* in[25];
  float* out;
  unsigned char* ws;
  float inv_freq[32];
};
enum { I_X = 0, I_P, I_NORM_GAIN, I_W_IN_EVEN, I_W_OUT_EVEN, I_A_Q_GAIN, I_A_K_GAIN, I_IDX_K_GAIN, I_B_Q_GAIN, I_B_K_GAIN, I_B_SINKS,
       I_W_IN_ODD, I_W_OUT_ODD, I_C_Q_GAIN, I_C_K_GAIN, I_D_Q_GAIN, I_D_K_GAIN, I_LQ1, I_LK1, I_LQ2, I_LK2, I_SUB_GAIN, I_PLE_NORM_GAIN,
       I_W_PLE_GATE, I_W_PLE_PROJ };

DI unsigned cvtpk(float lo, float hi) { f32x2_t v = {lo, hi}; bf16x2_t b = __builtin_convertvector(v, bf16x2_t); return __builtin_bit_cast(unsigned, b); }
DI float bf2f(bf16 b) { return __uint_as_float(((unsigned)b) << 16); }
DI float fexp2(float x) { return __builtin_amdgcn_exp2f(x); }
DI f32x16 mfma32(bf16x8 a, bf16x8 b, f32x16 c) { return __builtin_amdgcn_mfma_f32_32x32x16_bf16(a, b, c, 0, 0, 0); }
DI f32x4 mfma16(bf16x8 a, bf16x8 b, f32x4 c) { return __builtin_amdgcn_mfma_f32_16x16x32_bf16(a, b, c, 0, 0, 0); }
DI int crow(int i, int h) { return (i & 3) + 8 * (i >> 2) + 4 * h; }
DI s16x4 trread(const bf16* p) { return __builtin_bit_cast(s16x4, __builtin_amdgcn_ds_read_tr16_b64_v4i16((LAS s16x4*)p)); }
DI int opaque_tid() { int t = threadIdx.x; asm volatile("" : "+v"(t)); return t; }
DI void lds_barrier() { asm volatile("s_waitcnt lgkmcnt(0)" ::: "memory"); __builtin_amdgcn_s_barrier(); asm volatile("" ::: "memory"); }
DI void lds_fence() { asm volatile("s_waitcnt lgkmcnt(0)" ::: "memory"); __builtin_amdgcn_wave_barrier(); }

__host__ __device__ __forceinline__ int phys_col(int n) { return (n & ~255) + 128 * ((n >> 5) & 1) + 32 * ((n >> 6) & 3) + (n & 31); }
DI int map_even(int n) { return n < 1216 ? n : (n < 1224 ? 3008 + (n - 1216) : n - 8); }
DI void transpose_tile(const float* W, int K, int N, bf16* WT, int mapmode, int tile, float* scr) {
  const int tid = opaque_tid();
  const int ntn = (N + 63) >> 6, kt = tile / ntn, nt = tile % ntn, k0 = kt * 64, n0 = nt * 64;
#pragma unroll
  for (int i = 0; i < 8; ++i) {
    const int kk = (tid >> 6) + 8 * i, nn = tid & 63, n = n0 + nn;
    scr[kk * 65 + nn] = (n < N) ? W[(size_t)(k0 + kk) * N + n] : 0.f;
  }
  __syncthreads();
  {
    const int nn = tid >> 3, kc = tid & 7, n = n0 + nn;
    if (n < N) {
      const int dst = mapmode == 1 ? phys_col(map_even(n)) : (mapmode == 2 ? phys_col(n) : n);
      const float* s = scr + (kc * 8) * 65 + nn;
      u32x4 o; o.x = cvtpk(s[0], s[65]); o.y = cvtpk(s[2 * 65], s[3 * 65]); o.z = cvtpk(s[4 * 65], s[5 * 65]); o.w = cvtpk(s[6 * 65], s[7 * 65]);
      *(u32x4*)(WT + (size_t)dst * K + k0 + kc * 8) = o;
    }
  }
  __syncthreads();
}

DI float wave_sum(float v) {
#pragma unroll
  for (int o = 1; o < 64; o <<= 1) v += __shfl_xor(v, o);
  return v;
}

DI void phase_prologue(const Params& p, char* lds) {
  const int tid = opaque_tid(), lane = tid & 63, wid = tid >> 6;
  const int nb = gridDim.x, bid = blockIdx.x;
  unsigned char* ws = p.ws;
  float* scr = (float*)lds;
  const int T0 = 16 * 48, T1 = 256, T2 = 16 * 64, T3 = 256, T4 = 256, T5 = 256, T6 = 64, T7 = 64;
  const int NT = T0 + T1 + T2 + T3 + T4 + T5 + T6 + T7;
  for (int it = bid; it < NT; it += nb) {
    int r = it;
    if (r < T0) { transpose_tile(p.in[I_W_IN_EVEN], 1024, 3016, (bf16*)(ws + WS_WINE), 1, r, scr); continue; } r -= T0;
    if (r < T1) { transpose_tile(p.in[I_W_OUT_EVEN], 1024, 1024, (bf16*)(ws + WS_WOUTE), 0, r, scr); continue; } r -= T1;
    if (r < T2) { transpose_tile(p.in[I_W_IN_ODD], 1024, 4096, (bf16*)(ws + WS_WINO), 2, r, scr); continue; } r -= T2;
    if (r < T3) { transpose_tile(p.in[I_W_OUT_ODD], 1024, 1024, (bf16*)(ws + WS_WOUTO), 0, r, scr); continue; } r -= T3;
    if (r < T4) { transpose_tile(p.in[I_W_PLE_GATE], 1024, 1024, (bf16*)(ws + WS_WG0), 0, r, scr); continue; } r -= T4;
    if (r < T5) { transpose_tile(p.in[I_W_PLE_GATE] + 1024 * 1024, 1024, 1024, (bf16*)(ws + WS_WG1), 0, r, scr); continue; } r -= T5;
    if (r < T6) { transpose_tile(p.in[I_W_PLE_PROJ], 256, 1024, (bf16*)(ws + WS_WP0), 0, r, scr); continue; } r -= T6;
    transpose_tile(p.in[I_W_PLE_PROJ] + 256 * 1024, 256, 1024, (bf16*)(ws + WS_WP1), 0, r, scr);
  }
  const int gt = bid * NTHREADS + tid, ngt = nb * NTHREADS;
  { unsigned* z = (unsigned*)(ws + WS_WINE); for (int i = gt; i < 56 * 512; i += ngt) z[(size_t)phys_col(3016 + (i >> 9)) * 512 + (i & 511)] = 0u; }
  { const f32x4* src = (const f32x4*)p.in[I_P]; u32x2* dst = (u32x2*)(ws + WS_PBF); for (int i = gt; i < 2 * NTOK * 256 / 4; i += ngt) { const f32x4 v = src[i]; u32x2 w; w.x = cvtpk(v.x, v.y); w.y = cvtpk(v.z, v.w); dst[i] = w; } }
  { float* ss = (float*)(ws + WS_SS); for (int i = gt; i < 3 * NTOK; i += ngt) ss[i] = 0.f; }
  { float2* tab = (float2*)(ws + WS_ROPE);
    for (int i = gt; i < SEQ * 32; i += ngt) {
      const int pos = i >> 5, k = i & 31;
      const float ang = (float)pos * p.inv_freq[k];
      double rev = (double)ang * 0.15915494309189535; rev -= floor(rev);
      const float rf = (float)rev;
      tab[i] = make_float2(__builtin_amdgcn_cosf(rf), __builtin_amdgcn_sinf(rf));
    } }
  if (bid == 0 && wid == 0) {
    const float a = wave_sum(p.in[I_LQ1][lane] * p.in[I_LK1][lane]);
    const float b = wave_sum(p.in[I_LQ2][lane] * p.in[I_LK2][lane]);
    const float lambda_init = 0.8f - 0.6f * expf(-0.3f);
    if (lane == 0) *(float*)(ws + WS_LAM) = expf(a) - expf(b) + lambda_init;
  }
  { const float* x = p.in[I_X]; const float* g = p.in[I_NORM_GAIN]; bf16* H = (bf16*)(ws + WS_ACT);
    const int gw = bid * 8 + wid, ngw = nb * 8;
    for (int m = gw; m < NTOK; m += ngw) {
      const f32x4* xr = (const f32x4*)(x + (size_t)m * DM) + lane;
      f32x4 v[4]; float s = 0.f;
#pragma unroll
      for (int j = 0; j < 4; ++j) { v[j] = xr[64 * j]; s += v[j].x * v[j].x + v[j].y * v[j].y + v[j].z * v[j].z + v[j].w * v[j].w; }
      const float rstd = rsqrtf(wave_sum(s) * (1.f / DM) + EPS);
      u32x2* o = (u32x2*)(H + (size_t)m * DM) + lane;
#pragma unroll
      for (int j = 0; j < 4; ++j) { const f32x4 gg = *((const f32x4*)g + lane + 64 * j); u32x2 w; w.x = cvtpk(v[j].x * rstd * gg.x, v[j].y * rstd * gg.y); w.y = cvtpk(v[j].z * rstd * gg.z, v[j].w * rstd * gg.w); o[64 * j] = w; }
    } }
}

namespace pg8 {
#define PG8_LAS __attribute__((address_space(3)))
typedef unsigned short bf16_t;
typedef short bf16x8 __attribute__((ext_vector_type(8)));
typedef float f32x4 __attribute__((ext_vector_type(4)));
typedef unsigned u32x4 __attribute__((ext_vector_type(4)));
constexpr int BM = 256, BK = 64, HALF = 128, HTB = HALF * BK * 2  , STAGE_BYTES = 8 * HTB, NXCD = 8, WGM = 8;

__host__ __device__ __forceinline__ int lds_byte(int r, int c) { const int st = (r >> 4) * 2 + (c >> 5), rr = r & 15, cc = c & 31, ob = rr * 64 + cc * 2; return st * 1024 + (ob ^ (((ob >> 9) & 1) << 5)); }
__host__ __device__ __forceinline__ void stage_rc(int b, int& R, int& C) { const int st = b / 1024, sb = b % 1024, swz = sb ^ (((sb >> 9) & 1) << 5); R = (st >> 1) * 16 + swz / 64; C = (st & 1) * 32 + (swz % 64) / 2; }
__host__ __device__ __forceinline__ int perm32(int rho) { const int n = rho >> 4, i = rho & 15; return 8 * (i >> 2) + 4 * n + (i & 3); }

struct Unit { int pm, pn; };
struct Gemm { const bf16_t* A; const bf16_t* Bt; int M, N, K; };

struct StaticOrder {
    int nM, nN, nwg, G, c;
    __host__ __device__ void init(int M, int N, int G_, int c_) { nM = M / BM; nN = N / BM; nwg = nM * nN; G = G_; c = c_; }
    __host__ __device__ bool next(int i, Unit& u) const {
        const long L = (long)i * G + c; if (L >= nwg) return false;
        int wgid = (int)L; { const int q = nwg / NXCD, r = nwg % NXCD, xcd = wgid % NXCD, off = wgid / NXCD; wgid = (xcd < r ? xcd * (q + 1) : r * (q + 1) + (xcd - r) * q) + off; }
        const int nig = WGM * nN, gid = wgid / nig, fm = gid * WGM, gsz = (nM - fm) < WGM ? (nM - fm) : WGM;
        u.pm = fm + ((wgid % nig) % gsz); u.pn = (wgid % nig) / gsz; return true;
    }
    __device__ __forceinline__ void a_ready(const Unit&) const {}
    __device__ __forceinline__ void done(const Unit&) const {}
};
__device__ __forceinline__ unsigned cvt_pk_bf16(float lo, float hi) { unsigned r; asm volatile("v_cvt_pk_bf16_f32 %0, %1, %2" : "=v"(r) : "v"(lo), "v"(hi)); return r; }
template <class Epi, class Sched, bool ALIGN_EPI = false, bool SP2 = false>
__device__ __forceinline__ void gemm_phase(PG8_LAS unsigned char* lds, const Gemm g, const Sched& S, const Epi& E) {
    int tid_ = threadIdx.x; asm volatile("" : "+v"(tid_));
    const int tid = tid_, wid = __builtin_amdgcn_readfirstlane(tid >> 6), lane = tid & 63, wr = wid >> 2, wc = wid & 3, fr = lane & 15, fq = lane >> 4;
    const int K = g.K, nt = K / BK;
    unsigned voffA[2], voffB[2];
#pragma unroll
    for (int i = 0; i < 2; ++i) { int R, C; stage_rc(tid * 16 + i * 8192, R, C); const int Rb = Epi::PERM ? ((R & ~31) + perm32(R & 31)) : R;
        voffA[i] = (unsigned)(R * K + C) * 2u; voffB[i] = (unsigned)(Rb * K + C) * 2u; }
    const size_t kstep = (size_t)(BK * 2);
    const size_t hstep = (size_t)HALF * K * 2;
    const size_t tstep = 2 * hstep;
    const unsigned ldsw = (unsigned)wid * 1024u;
    const int aoff = lds_byte(wr * 64 + fr, fq * 8), boff = lds_byte(wc * 32 + fr, fq * 8);
#define PG8_SA(b, h) (((b) * 2 + (h)) * HTB)
#define PG8_SB(b, h) ((4 + (b) * 2 + (h)) * HTB)
#define PG8_STAGE(bufoff, gbase, voff) do { _Pragma("unroll") for (int _i = 0; _i < 2; ++_i) \
        __builtin_amdgcn_global_load_lds((const unsigned*)((const char*)(gbase) + (voff)[_i]), (PG8_LAS unsigned*)(lds + (bufoff) + ldsw + _i * 8192), 16, 0, 0); } while (0)
#define PG8_LDA(dst, b, h) do { _Pragma("unroll") for (int m = 0; m < 4; ++m) _Pragma("unroll") for (int k = 0; k < 2; ++k) dst[m][k] = *(const PG8_LAS bf16x8*)(lds + PG8_SA(b, h) + aoff + m * 2048 + k * 1024); } while (0)
#define PG8_LDB(dst, b, h) do { _Pragma("unroll") for (int n = 0; n < 2; ++n) _Pragma("unroll") for (int k = 0; k < 2; ++k) dst[n][k] = *(const PG8_LAS bf16x8*)(lds + PG8_SB(b, h) + boff + n * 2048 + k * 1024); } while (0)
#define PG8_MMA(ai, bj, At, Bt) do { __builtin_amdgcn_s_setprio(1); _Pragma("unroll") for (int m = 0; m < 4; ++m) _Pragma("unroll") for (int n = 0; n < 2; ++n) _Pragma("unroll") for (int k = 0; k < 2; ++k) \
        acc[ai][bj][m][n] = __builtin_amdgcn_mfma_f32_16x16x32_bf16(Bt[n][k], At[m][k], acc[ai][bj][m][n], 0, 0, 0); __builtin_amdgcn_s_setprio(0); } while (0)
#define PG8_WAIT_V(n) asm volatile("s_waitcnt vmcnt(" #n ")" ::: "memory")
#define PG8_WAIT_L(n) asm volatile("s_waitcnt lgkmcnt(" #n ")" ::: "memory")
#define PG8_BAR __builtin_amdgcn_s_barrier()
#define PG8_SCHED __builtin_amdgcn_sched_barrier(0)
    Unit cur, nxt; int ui = 0;
    if (!S.next(0, cur)) return;
    f32x4 acc[2][2][4][2];
#pragma unroll
    for (int a = 0; a < 2; ++a)
#pragma unroll
        for (int b = 0; b < 2; ++b)
#pragma unroll
            for (int m = 0; m < 4; ++m)
#pragma unroll
                for (int n = 0; n < 2; ++n) acc[a][b][m][n] = (f32x4){0.f, 0.f, 0.f, 0.f};
    bf16x8 At[4][2], B0[2][2], B1[2][2];
    const char* cA = (const char*)g.A + (size_t)cur.pm * tstep; const char* cB = (const char*)g.Bt + (size_t)cur.pn * tstep;
    S.a_ready(cur);
    if constexpr (SP2) {
        PG8_STAGE(PG8_SB(0, 0), cB, voffB); PG8_STAGE(PG8_SB(0, 1), cB + hstep, voffB); PG8_STAGE(PG8_SA(0, 0), cA, voffA); PG8_STAGE(PG8_SA(0, 1), cA + hstep, voffA);
        if (wr == 1) PG8_BAR;
        PG8_WAIT_V(2); PG8_BAR;
        PG8_STAGE(PG8_SB(1, 0), cB + kstep, voffB); PG8_STAGE(PG8_SA(1, 0), cA + kstep, voffA); PG8_STAGE(PG8_SB(1, 1), cB + hstep + kstep, voffB);
        PG8_WAIT_V(6); PG8_BAR;
    } else {
        PG8_STAGE(PG8_SB(0, 0), cB, voffB); PG8_STAGE(PG8_SA(0, 0), cA, voffA); PG8_STAGE(PG8_SB(0, 1), cB + hstep, voffB); PG8_STAGE(PG8_SA(0, 1), cA + hstep, voffA);
        if (wr == 1) PG8_BAR;
        PG8_WAIT_V(4); PG8_BAR;
        PG8_STAGE(PG8_SB(1, 0), cB + kstep, voffB); PG8_STAGE(PG8_SA(1, 0), cA + kstep, voffA); PG8_STAGE(PG8_SB(1, 1), cB + hstep + kstep, voffB);
        PG8_WAIT_V(6); PG8_BAR;
    }
    for (;;) {
        const bool has_next = S.next(ui + 1, nxt);
        const char* nA = has_next ? (const char*)g.A + (size_t)nxt.pm * tstep : cA; const char* nB = has_next ? (const char*)g.Bt + (size_t)nxt.pn * tstep : cB;
        for (int t = 0; t < nt; t += 2) {
            const bool last = (t == nt - 2);
            const char* a1 = cA + (size_t)(t + 1) * kstep;
            const char* a2 = last ? nA : cA + (size_t)(t + 2) * kstep; const char* b2 = last ? nB : cB + (size_t)(t + 2) * kstep;
            const char* a3 = a2 + kstep; const char* b3 = b2 + kstep;
            if (last && has_next) S.a_ready(nxt);
            if constexpr (SP2) {
            PG8_LDB(B0, 0, 0); PG8_LDB(B1, 0, 1); PG8_SCHED; PG8_LDA(At, 0, 0); PG8_STAGE(PG8_SA(1, 1), a1 + hstep, voffA);
            PG8_WAIT_V(8); PG8_WAIT_L(0); PG8_BAR; PG8_MMA(0, 0, At, B0); PG8_MMA(0, 1, At, B1); PG8_BAR; PG8_SCHED;
            PG8_LDA(At, 0, 1); PG8_STAGE(PG8_SB(0, 0), b2, voffB); PG8_STAGE(PG8_SB(0, 1), b2 + hstep, voffB); PG8_STAGE(PG8_SA(0, 0), a2, voffA);
            PG8_WAIT_V(8); PG8_WAIT_L(0); PG8_BAR; PG8_MMA(1, 0, At, B0); PG8_MMA(1, 1, At, B1); PG8_BAR; PG8_SCHED;
            PG8_LDB(B0, 1, 0); PG8_LDB(B1, 1, 1); PG8_SCHED; PG8_LDA(At, 1, 0); PG8_STAGE(PG8_SA(0, 1), a2 + hstep, voffA);
            PG8_WAIT_V(8); PG8_WAIT_L(0); PG8_BAR; PG8_MMA(0, 0, At, B0); PG8_MMA(0, 1, At, B1); PG8_BAR; PG8_SCHED;
            PG8_LDA(At, 1, 1); PG8_STAGE(PG8_SB(1, 0), b3, voffB); PG8_STAGE(PG8_SB(1, 1), b3 + hstep, voffB); PG8_STAGE(PG8_SA(1, 0), a3, voffA);
            PG8_WAIT_V(8); PG8_WAIT_L(0); PG8_BAR; PG8_MMA(1, 0, At, B0); PG8_MMA(1, 1, At, B1); PG8_BAR; PG8_SCHED;
            } else {
            PG8_LDB(B0, 0, 0); PG8_SCHED; PG8_LDA(At, 0, 0); PG8_STAGE(PG8_SA(1, 1), a1 + hstep, voffA);
            PG8_WAIT_L(8); PG8_BAR; PG8_WAIT_L(0); PG8_MMA(0, 0, At, B0); PG8_BAR; PG8_SCHED;
            PG8_LDB(B1, 0, 1); PG8_STAGE(PG8_SB(0, 0), b2, voffB);
            PG8_BAR; PG8_WAIT_L(0); PG8_MMA(0, 1, At, B1); PG8_BAR;
            PG8_LDA(At, 0, 1); PG8_STAGE(PG8_SA(0, 0), a2, voffA);
            PG8_BAR; PG8_WAIT_L(0); PG8_MMA(1, 0, At, B0); PG8_BAR; PG8_SCHED;
            PG8_STAGE(PG8_SB(0, 1), b2 + hstep, voffB);
            PG8_WAIT_V(6); PG8_BAR; PG8_MMA(1, 1, At, B1); PG8_BAR;
            PG8_LDB(B0, 1, 0); PG8_SCHED; PG8_LDA(At, 1, 0); PG8_STAGE(PG8_SA(0, 1), a2 + hstep, voffA);
            PG8_WAIT_L(8); PG8_BAR; PG8_WAIT_L(0); PG8_MMA(0, 0, At, B0); PG8_BAR; PG8_SCHED;
            PG8_LDB(B1, 1, 1); PG8_STAGE(PG8_SB(1, 0), b3, voffB);
            PG8_BAR; PG8_WAIT_L(0); PG8_MMA(0, 1, At, B1); PG8_BAR;
            PG8_LDA(At, 1, 1); PG8_STAGE(PG8_SA(1, 0), a3, voffA);
            PG8_BAR; PG8_WAIT_L(0); PG8_MMA(1, 0, At, B0); PG8_BAR; PG8_SCHED;
            PG8_STAGE(PG8_SB(1, 1), b3 + hstep, voffB);
            PG8_WAIT_V(6); PG8_BAR; PG8_MMA(1, 1, At, B1); PG8_BAR;
            }
        }
        if constexpr (ALIGN_EPI) { if (wr == 0) PG8_BAR; }
        if constexpr (!Epi::AFTER_DRAIN) { E(acc, cur, wr, wc, fr, fq); S.done(cur); }
        if (!has_next) break;
#pragma unroll
        for (int a = 0; a < 2; ++a)
#pragma unroll
            for (int b = 0; b < 2; ++b)
#pragma unroll
                for (int m = 0; m < 4; ++m)
#pragma unroll
                    for (int n = 0; n < 2; ++n) acc[a][b][m][n] = (f32x4){0.f, 0.f, 0.f, 0.f};
        cur = nxt; cA = nA; cB = nB; ++ui;
        if constexpr (ALIGN_EPI) { if (wr == 1) PG8_BAR; }
    }
    PG8_WAIT_V(0);
    if constexpr (!ALIGN_EPI) { if (wr == 0) PG8_BAR; }
    PG8_BAR;
    if constexpr (Epi::AFTER_DRAIN) { E.fused(acc, cur, wr, wc, fr, fq, lds, wid, lane); S.done(cur); }
#undef PG8_SA
#undef PG8_SB
#undef PG8_STAGE
#undef PG8_LDA
#undef PG8_LDB
#undef PG8_MMA
#undef PG8_WAIT_V
#undef PG8_WAIT_L
#undef PG8_BAR
#undef PG8_SCHED
}
}

enum { T_PLAIN = 0, T_NR = 1, T_ROPE = 2, T_SILU = 3, T_IW = 4 };
DI void slot_info(const Params& p, int layer, int slot, int& type, const float*& gain) {
  gain = nullptr;
  if (layer == 0) {
    if (slot < 8) { type = T_NR; gain = p.in[I_A_Q_GAIN]; }
    else if (slot == 8) { type = T_NR; gain = p.in[I_A_K_GAIN]; }
    else if (slot == 9) type = T_PLAIN;
    else if (slot < 18) type = T_ROPE;
    else if (slot == 18) { type = T_NR; gain = p.in[I_IDX_K_GAIN]; }
    else if (slot < 27) type = T_SILU;
    else if (slot < 35) { type = T_NR; gain = p.in[I_B_Q_GAIN]; }
    else if (slot < 37) { type = T_NR; gain = p.in[I_B_K_GAIN]; }
    else if (slot < 39) type = T_PLAIN;
    else if (slot < 47) type = T_SILU;
    else type = T_IW;
  } else {
    if (slot < 8) { type = T_NR; gain = p.in[I_C_Q_GAIN]; }
    else if (slot < 16) { type = T_NR; gain = p.in[I_C_K_GAIN]; }
    else if (slot < 24) type = T_PLAIN;
    else if (slot < 32) type = T_SILU;
    else if (slot < 40) { type = T_NR; gain = p.in[I_D_Q_GAIN]; }
    else if (slot < 48) { type = T_NR; gain = p.in[I_D_K_GAIN]; }
    else if (slot < 56) type = T_PLAIN;
    else type = T_SILU;
  }
}
constexpr int E_AQ = 0, E_AK = 512, E_AV = 576, E_IQ = 640, E_IK = 1152, E_AG = 1216, E_BQ = 1728, E_BK = 2240, E_BV = 2368, E_BG = 2496;
constexpr int O_CQ = 0, O_CK = 512, O_CV = 1024, O_CG = 1536, O_DQ = 2048, O_DK = 2560, O_DV = 3072, O_DG = 3584;

typedef pg8::f32x4 (AccT)[2][2][4][2];

struct EpiInProj {
  static constexpr bool PERM = false, AFTER_DRAIN = false;
  const Params& p; int layer;
  DI void operator()(const f32x4 (&acc)[2][2][4][2], const pg8::Unit& u, int wr, int wc, int fr, int fq) const {
    unsigned char* ws = p.ws;
    const int NP = layer == 0 ? NPE : NPO;
    bf16* PE = (bf16*)(ws + WS_PE);
    const float2* rope = (const float2*)(ws + WS_ROPE);
    const float* ss1 = (const float*)(ws + WS_SS);
    float* IW = (float*)(ws + WS_IW);
    const int slot = u.pn * 4 + wc;
    int type; const float* gain; slot_info(p, layer, slot, type, gain);
#pragma unroll
    for (int ai = 0; ai < 2; ++ai)
#pragma unroll
      for (int m = 0; m < 4; ++m) {
        const int row = u.pm * 256 + ai * 128 + wr * 64 + m * 16 + fr, pos = row & (SEQ - 1);
        float sc = 1.f;
        if (layer == 1) sc = rsqrtf(ss1[row] * (1.f / DM) + EPS);
        f32x4 v1[2], v2[2];
#pragma unroll
        for (int n = 0; n < 2; ++n) { v1[n] = acc[ai][0][m][n] * sc; v2[n] = acc[ai][1][m][n] * sc; }
        if (type == T_NR) {
          float s = 0.f;
#pragma unroll
          for (int n = 0; n < 2; ++n) s += v1[n].x * v1[n].x + v1[n].y * v1[n].y + v1[n].z * v1[n].z + v1[n].w * v1[n].w + v2[n].x * v2[n].x + v2[n].y * v2[n].y + v2[n].z * v2[n].z + v2[n].w * v2[n].w;
          s += __shfl_xor(s, 16); s += __shfl_xor(s, 32);
          const float rn = rsqrtf(s * (1.f / 64.f) + EPS);
#pragma unroll
          for (int n = 0; n < 2; ++n) { const f32x4 g1 = *(const f32x4*)(gain + n * 16 + fq * 4), g2 = *(const f32x4*)(gain + 32 + n * 16 + fq * 4); v1[n] = v1[n] * rn * g1; v2[n] = v2[n] * rn * g2; }
        }
        if (type == T_NR || type == T_ROPE) {
#pragma unroll
          for (int n = 0; n < 2; ++n) {
            const f32x4* cs = (const f32x4*)(rope + (size_t)pos * 32 + n * 16 + fq * 4);
            const f32x4 c01 = cs[0], c23 = cs[1];
            const f32x4 x1 = v1[n], x2 = v2[n];
            f32x4 o1, o2;
            o1.x = x1.x * c01.x - x2.x * c01.y; o2.x = x2.x * c01.x + x1.x * c01.y;
            o1.y = x1.y * c01.z - x2.y * c01.w; o2.y = x2.y * c01.z + x1.y * c01.w;
            o1.z = x1.z * c23.x - x2.z * c23.y; o2.z = x2.z * c23.x + x1.z * c23.y;
            o1.w = x1.w * c23.z - x2.w * c23.w; o2.w = x2.w * c23.z + x1.w * c23.w;
            v1[n] = o1; v2[n] = o2;
          }
        }
        if (type == T_SILU) {
#pragma unroll
          for (int n = 0; n < 2; ++n)
#pragma unroll
            for (int j = 0; j < 4; ++j) { const float a = v1[n][j]; v1[n][j] = a / (1.f + __expf(-a)); const float b = v2[n][j]; v2[n][j] = b / (1.f + __expf(-b)); }
        }
        if (type == T_IW) {
          if (fq < 2) *(f32x4*)(IW + (size_t)row * 8 + fq * 4) = v1[0];
        } else {
          bf16* dst = PE + (size_t)row * NP + slot * 64 + fq * 4;
#pragma unroll
          for (int n = 0; n < 2; ++n) {
            u32x2 w1, w2; w1.x = cvtpk(v1[n].x, v1[n].y); w1.y = cvtpk(v1[n].z, v1[n].w); w2.x = cvtpk(v2[n].x, v2[n].y); w2.y = cvtpk(v2[n].z, v2[n].w);
            *(u32x2*)(dst + n * 16) = w1; *(u32x2*)(dst + 32 + n * 16) = w2;
            if (layer == 0 && slot == 18) { bf16* IKS = (bf16*)(ws + WS_IKS); const int key = row & (SEQ - 1);
              bf16* base = IKS + (((size_t)(row >> 13) * 256 + (key >> 5)) * 4) * 512 + ((fq >> 1) * 32 + (key & 31)) * 8 + (fq & 1) * 4;
              *(u32x2*)(base + (size_t)n * 512) = w1; *(u32x2*)(base + (size_t)(n + 2) * 512) = w2; }
          }
        }
        asm volatile("" ::: "memory");
      }
  }
};

DI void phase_inproj(const Params& p, int layer, char* lds) {
  unsigned char* ws = p.ws;
  const int NP = layer == 0 ? NPE : NPO;
  pg8::Gemm g{(const bf16*)(ws + (layer == 0 ? WS_ACT : WS_Y)), (const bf16*)(ws + (layer == 0 ? WS_WINE : WS_WINO)), NTOK, NP, DM};
  pg8::StaticOrder S; S.init(NTOK, NP, (int)gridDim.x, (int)blockIdx.x);
  EpiInProj E{p, layer};
  pg8::gemm_phase<EpiInProj, pg8::StaticOrder, true, true>((PG8_LAS unsigned char*)lds, g, S, E);
}

struct EpiOutProj {
  static constexpr bool PERM = false, AFTER_DRAIN = false;
  const float* xin; float* out; bf16* XG; const float* pg; float* ss;
  DI void operator()(const f32x4 (&acc)[2][2][4][2], const pg8::Unit& u, int wr, int wc, int fr, int fq) const {
#pragma unroll
    for (int ai = 0; ai < 2; ++ai)
#pragma unroll
      for (int m = 0; m < 4; ++m) {
        const int row = u.pm * 256 + ai * 128 + wr * 64 + m * 16 + fr; float rs = 0.f;
#pragma unroll
        for (int bj = 0; bj < 2; ++bj)
#pragma unroll
          for (int n = 0; n < 2; ++n) {
            const int col = u.pn * 256 + bj * 128 + wc * 32 + n * 16 + fq * 4; const size_t off = (size_t)row * DM + col;
            const f32x4 xn = *(const f32x4*)(xin + off) + acc[ai][bj][m][n];
            *(f32x4*)(out + off) = xn;
            rs += xn.x * xn.x + xn.y * xn.y + xn.z * xn.z + xn.w * xn.w;
            const f32x4 gg = *(const f32x4*)(pg + col);
            u32x2 w; w.x = cvtpk(xn.x * gg.x, xn.y * gg.y); w.y = cvtpk(xn.z * gg.z, xn.w * gg.w); *(u32x2*)(XG + off) = w;
          }
        rs += __shfl_xor(rs, 16); rs += __shfl_xor(rs, 32);
        if (fq == 0) atomicAdd(ss + row, rs);
        asm volatile("" ::: "memory");
      }
  }
};
DI void phase_outproj(const Params& p, int layer, char* lds) {
  unsigned char* ws = p.ws;
  pg8::Gemm g{(const bf16*)(ws + WS_Y), (const bf16*)(ws + (layer == 0 ? WS_WOUTE : WS_WOUTO)), NTOK, DM, DM};
  pg8::StaticOrder S; S.init(NTOK, DM, (int)gridDim.x, (int)blockIdx.x);
  EpiOutProj E{layer == 0 ? p.in[I_X] : p.out, p.out, (bf16*)(ws + WS_ACT), p.in[I_PLE_NORM_GAIN] + layer * DM, (float*)(ws + WS_SS) + (layer == 0 ? 1 : 2) * NTOK};
  pg8::gemm_phase<EpiOutProj, pg8::StaticOrder, true, true>((PG8_LAS unsigned char*)lds, g, S, E);
}

struct EpiPleProj {
  static constexpr bool PERM = false, AFTER_DRAIN = false;
  bf16* PT;
  DI void operator()(const f32x4 (&acc)[2][2][4][2], const pg8::Unit& u, int wr, int wc, int fr, int fq) const {
#pragma unroll
    for (int ai = 0; ai < 2; ++ai)
#pragma unroll
      for (int m = 0; m < 4; ++m) {
        const int row = u.pm * 256 + ai * 128 + wr * 64 + m * 16 + fr;
#pragma unroll
        for (int bj = 0; bj < 2; ++bj)
#pragma unroll
          for (int n = 0; n < 2; ++n) { const f32x4 a = acc[ai][bj][m][n]; u32x2 w; w.x = cvtpk(a.x, a.y); w.y = cvtpk(a.z, a.w); *(u32x2*)(PT + (size_t)row * DM + u.pn * 256 + bj * 128 + wc * 32 + n * 16 + fq * 4) = w; }
      }
  }
};
struct EpiPleGate {
  static constexpr bool PERM = false, AFTER_DRAIN = false;
  const bf16* PT; float* out; const float* ssx; float* ss1; bf16* H; const float* ng1; int layer;
  DI void operator()(const f32x4 (&acc)[2][2][4][2], const pg8::Unit& u, int wr, int wc, int fr, int fq) const {
#pragma unroll
    for (int ai = 0; ai < 2; ++ai)
#pragma unroll
      for (int m = 0; m < 4; ++m) {
        const int row = u.pm * 256 + ai * 128 + wr * 64 + m * 16 + fr; float rs = 0.f;
        const float rstd = rsqrtf(ssx[row] * (1.f / DM) + EPS);
#pragma unroll
        for (int bj = 0; bj < 2; ++bj)
#pragma unroll
          for (int n = 0; n < 2; ++n) {
            const int col = u.pn * 256 + bj * 128 + wc * 32 + n * 16 + fq * 4; const size_t off = (size_t)row * DM + col;
            f32x4 g;
#pragma unroll
            for (int j = 0; j < 4; ++j) g[j] = 1.f / (1.f + __expf(-rstd * acc[ai][bj][m][n][j]));
            const u32x2 pw = *(const u32x2*)(PT + off); f32x4 pp; pp.x = __uint_as_float(pw.x << 16); pp.y = __uint_as_float(pw.x & 0xffff0000u); pp.z = __uint_as_float(pw.y << 16); pp.w = __uint_as_float(pw.y & 0xffff0000u);
            const f32x4 xn = *(const f32x4*)(out + off) + pp * g;
            *(f32x4*)(out + off) = xn;
            if (layer == 0) {
              rs += xn.x * xn.x + xn.y * xn.y + xn.z * xn.z + xn.w * xn.w;
              const f32x4 gg = *(const f32x4*)(ng1 + col);
              u32x2 w; w.x = cvtpk(xn.x * gg.x, xn.y * gg.y); w.y = cvtpk(xn.z * gg.z, xn.w * gg.w); *(u32x2*)(H + off) = w;
            }
          }
        if (layer == 0) { rs += __shfl_xor(rs, 16); rs += __shfl_xor(rs, 32); if (fq == 0) atomicAdd(ss1 + row, rs); }
        asm volatile("" ::: "memory");
      }
  }
};
DI void phase_ple(const Params& p, int layer, char* lds) {
  unsigned char* ws = p.ws;
  bf16* PT = (bf16*)(ws + WS_PE);
  pg8::StaticOrder S; S.init(NTOK, DM, (int)gridDim.x, (int)blockIdx.x);
  { pg8::Gemm g{(const bf16*)(ws + WS_PBF) + (size_t)layer * NTOK * 256, (const bf16*)(ws + (layer == 0 ? WS_WP0 : WS_WP1)), NTOK, DM, 256};
    EpiPleProj E{PT};
    pg8::gemm_phase<EpiPleProj, pg8::StaticOrder, true, true>((PG8_LAS unsigned char*)lds, g, S, E); }
  { pg8::Gemm g{(const bf16*)(ws + WS_ACT), (const bf16*)(ws + (layer == 0 ? WS_WG0 : WS_WG1)), NTOK, DM, DM};
    EpiPleGate E{PT, p.out, (const float*)(ws + WS_SS) + (layer == 0 ? 1 : 2) * NTOK, (float*)(ws + WS_SS), (bf16*)(ws + WS_Y), p.in[I_NORM_GAIN] + DM, layer};
    pg8::gemm_phase<EpiPleGate, pg8::StaticOrder, true, true>((PG8_LAS unsigned char*)lds, g, S, E); }
}

template <int DVB, bool MASKED = true>
DI void attn_step32(const bf16* Kt, int KP, const bf16* Vt, int VP, const bf16x8 (&qf)[4], f32x16 (&o)[DVB], float& m, float& l, unsigned vmask, float c2, int lane) {
  const int r32 = lane & 31, h = lane >> 5;
  f32x16 s;
#pragma unroll
  for (int i = 0; i < 16; ++i) s[i] = 0.f;
#pragma unroll
  for (int t = 0; t < 4; ++t) { const bf16x8 kf = *(const bf16x8*)(Kt + r32 * KP + t * 16 + h * 8); s = mfma32(kf, qf[t], s); }
  float mx = -INFINITY;
#pragma unroll
  for (int i = 0; i < 16; ++i) { if (MASKED) { s[i] = ((vmask >> i) & 1u) ? s[i] : -INFINITY; } mx = fmaxf(mx, s[i]); }
  mx = fmaxf(mx, __shfl_xor(mx, 32));
  const float mn = fmaxf(m, mx * c2);
  if (__any(mn > m)) {
    const float alpha = fexp2(m - mn); l *= alpha;
#pragma unroll
    for (int d = 0; d < DVB; ++d)
#pragma unroll
      for (int i = 0; i < 16; ++i) o[d][i] *= alpha;
    m = mn;
  }
  float ps = 0.f; const float negm = -m;
#pragma unroll
  for (int i = 0; i < 16; ++i) { const float pv = fexp2(__builtin_fmaf(s[i], c2, negm)); s[i] = pv; ps += pv; }
  l += ps;
  bf16x8 pf[2];
  { u32x4 a, b; a.x = cvtpk(s[0], s[1]); a.y = cvtpk(s[2], s[3]); a.z = cvtpk(s[4], s[5]); a.w = cvtpk(s[6], s[7]);
    b.x = cvtpk(s[8], s[9]); b.y = cvtpk(s[10], s[11]); b.z = cvtpk(s[12], s[13]); b.w = cvtpk(s[14], s[15]);
    pf[0] = __builtin_bit_cast(bf16x8, a); pf[1] = __builtin_bit_cast(bf16x8, b); }
  const int i16 = lane & 15, q = i16 >> 2, pp = i16 & 3, blk = (lane >> 4) & 1;
#pragma unroll
  for (int d = 0; d < DVB; ++d)
#pragma unroll
    for (int sk = 0; sk < 2; ++sk) {
      const s16x4 lo = trread(Vt + (16 * sk + 4 * h + q) * VP + 32 * d + 16 * blk + 4 * pp);
      const s16x4 hi = trread(Vt + (16 * sk + 8 + 4 * h + q) * VP + 32 * d + 16 * blk + 4 * pp);
      const bf16x8 vf = __builtin_shufflevector(lo, hi, 0, 1, 2, 3, 4, 5, 6, 7);
      o[d] = mfma32(vf, pf[sk], o[d]);
    }
}

DI unsigned row_range_mask(int lo, int hi) {
  lo = lo < 0 ? 0 : lo; hi = hi > 31 ? 31 : hi;
  if (hi < lo) return 0u;
  const unsigned upto_hi = (hi >= 31) ? 0xffffffffu : ((1u << (hi + 1)) - 1u);
  return upto_hi & ~((1u << lo) - 1u);
}
DI unsigned lane_rows(unsigned m32, int h) {
  const unsigned t = m32 >> (4 * h);
  return (t & 0xFu) | ((t >> 4) & 0xF0u) | ((t >> 8) & 0xF00u) | ((t >> 12) & 0xF000u);
}
constexpr int WP = 72;
constexpr int WAVE_LDS = 2 * 32 * WP * 2 + 512;

struct KVRegs { u32x4 k[4], v[4]; };
DI void kv_store(const KVRegs& R, bf16* Ks, bf16* Vs, int lane) {
#pragma unroll
  for (int i = 0; i < 4; ++i) { const int row = (lane >> 3) + 8 * i, ch = lane & 7; *(u32x4*)(Ks + row * WP + ch * 8) = R.k[i]; *(u32x4*)(Vs + row * WP + ch * 8) = R.v[i]; }
}

DI void band_load(KVRegs& R, const bf16* Kg, const bf16* Vg, int NP, int kstart, int dil, int roff, int lane) {
#pragma unroll
  for (int i = 0; i < 4; ++i) {
    const int row = (lane >> 3) + 8 * i, ch = lane & 7; int k = kstart + row; if (k < 0) k = 0;
    const size_t off = (size_t)(dil * k + roff) * NP + ch * 8;
    R.k[i] = *(const u32x4*)(Kg + off); R.v[i] = *(const u32x4*)(Vg + off);
  }
}
template <int DVB>
DI void band_run(const bf16* Kg, const bf16* Vg, int NP, int kbase, int nsteps, int dil, int roff, int qidx, int win,
                 const bf16x8 (&qf)[4], f32x16 (&o)[DVB], float& m, float& l, float c2, bf16* Ks, bf16* Vs, int lane) {
  const int h = lane >> 5;
  KVRegs R; band_load(R, Kg, Vg, NP, kbase, dil, roff, lane);
  for (int j = 0; j < nsteps; ++j) {
    lds_fence();
    kv_store(R, Ks, Vs, lane);
    lds_fence();
    if (j + 1 < nsteps) band_load(R, Kg, Vg, NP, kbase + 32 * (j + 1), dil, roff, lane);
    const int kb = kbase + 32 * j, lo_r = (qidx - win > 0 ? qidx - win : 0) - kb;
    const unsigned vm = lane_rows(row_range_mask(lo_r, qidx - kb), h);
    attn_step32<DVB>(Ks, WP, Vs, WP, qf, o, m, l, vm, c2, lane);
  }
}

DI void write_o64(const f32x16 (&o)[2], float linv, const bf16* gate_row, bf16* y_row, int h) {
#pragma unroll
  for (int d = 0; d < 2; ++d)
#pragma unroll
    for (int g = 0; g < 4; ++g) {
      const int dd = 32 * d + 8 * g + 4 * h;
      const u32x2 gv = *(const u32x2*)(gate_row + dd);
      const float g0 = __uint_as_float(gv.x << 16), g1 = __uint_as_float(gv.x & 0xffff0000u), g2 = __uint_as_float(gv.y << 16), g3 = __uint_as_float(gv.y & 0xffff0000u);
      u32x2 w; w.x = cvtpk(o[d][4 * g] * linv * g0, o[d][4 * g + 1] * linv * g1); w.y = cvtpk(o[d][4 * g + 2] * linv * g2, o[d][4 * g + 3] * linv * g3);
      *(u32x2*)(y_row + dd) = w;
    }
}

DI void load_q(bf16x8 (&qf)[4], const bf16* qrow, int h) {
#pragma unroll
  for (int t = 0; t < 4; ++t) qf[t] = *(const bf16x8*)(qrow + t * 16 + h * 8);
}
template <int DVB> DI void zero_o(f32x16 (&o)[DVB]) {
#pragma unroll
  for (int d = 0; d < DVB; ++d)
#pragma unroll
    for (int i = 0; i < 16; ++i) o[d][i] = 0.f;
}

DI void mixerB_tile(const Params& p, int item, bf16* Ks, bf16* Vs, int lane) {
  const bf16* PE = (const bf16*)(p.ws + WS_PE); bf16* Y = (bf16*)(p.ws + WS_Y);
  const int qblk = item & 255, head = (item >> 8) & 7, b = item >> 11;
  const int r32 = lane & 31, h = lane >> 5, q0 = qblk * 32, kvh = head >> 2;
  const size_t rowb = (size_t)b * SEQ;
  bf16x8 qf[4]; load_q(qf, PE + (rowb + q0 + r32) * NPE + E_BQ + head * 64, h);
  f32x16 o[2]; zero_o<2>(o);
  const float sink2 = p.in[I_B_SINKS][head] * LOG2E;
  float m = sink2, l = (h == 0) ? 1.f : 0.f;
  band_run<2>(PE + rowb * NPE + E_BK + kvh * 64, PE + rowb * NPE + E_BV + kvh * 64, NPE, q0 - 128, 5, 1, 0, q0 + r32, 127, qf, o, m, l, 0.125f * LOG2E, Ks, Vs, lane);
  l += __shfl_xor(l, 32);
  const size_t tok = rowb + q0 + r32;
  write_o64(o, 1.f / l, PE + tok * NPE + E_BG + head * 64, Y + tok * DM + 512 + head * 64, h);
}

DI void mixerC_tile(const Params& p, int item, bf16* Ks, bf16* Vs, int lane) {
  const bf16* PO = (const bf16*)(p.ws + WS_PE); bf16* Y = (bf16*)(p.ws + WS_Y);
  const int qt = item & 15, r16 = (item >> 4) & 15, head = (item >> 8) & 7, b = item >> 11;
  const int r32 = lane & 31, h = lane >> 5, qi0 = qt * 32;
  const size_t rowb = (size_t)b * SEQ;
  const int t = 16 * (qi0 + r32) + r16;
  bf16x8 qf[4]; load_q(qf, PO + (rowb + t) * NPO + O_CQ + head * 64, h);
  f32x16 o[2]; zero_o<2>(o);
  float m = -1e30f, l = 0.f;
  const bf16* Kg = PO + rowb * NPO + O_CK + head * 64; const bf16* Vg = PO + rowb * NPO + O_CV + head * 64;
  const float c2 = 0.125f * LOG2E;
  band_run<2>(Kg, Vg, NPO, qi0 - 128, 5, 16, r16, qi0 + r32, 128, qf, o, m, l, c2, Ks, Vs, lane);
  band_run<2>(Kg, Vg, NPO, 4 * qi0 + (r16 >> 2) - 128, 8, 4, r16 & 3, 4 * (qi0 + r32) + (r16 >> 2), 128, qf, o, m, l, c2, Ks, Vs, lane);
  band_run<2>(Kg, Vg, NPO, 16 * qi0 + r16 - 128, 20, 1, 0, t, 128, qf, o, m, l, c2, Ks, Vs, lane);
  l += __shfl_xor(l, 32);
  const size_t tok = rowb + t;
  write_o64(o, 1.f / l, PO + tok * NPO + O_CG + head * 64, Y + tok * DM + head * 64, h);
}

DI void mixerA_item(const Params& p, int item, bf16* Ks, bf16* Vs, int lane) {
  const bf16* PE = (const bf16*)(p.ws + WS_PE); bf16* Y = (bf16*)(p.ws + WS_Y);
  const unsigned short* SEL = (const unsigned short*)(p.ws + WS_SEL) + (size_t)item * 256;
  const int t = item & (SEQ - 1), b = item >> 13;
  const int r32 = lane & 31, h = lane >> 5, head = r32 & 7;
  const size_t rowb = (size_t)b * SEQ;
  const int count = (t + 1 < 256) ? t + 1 : 256, nsteps = (count + 31) >> 5;
  bf16x8 qf[4]; load_q(qf, PE + (size_t)item * NPE + E_AQ + head * 64, h);
  f32x16 o[2]; zero_o<2>(o);
  float m = -1e30f, l = 0.f;
  const bf16* Kg = PE + rowb * NPE + E_AK; const bf16* Vg = PE + rowb * NPE + E_AV;
  KVRegs R;
  unsigned short* sel_l = (unsigned short*)(Vs + 32 * WP);
  lds_fence();
  *(u32x2*)(sel_l + 4 * lane) = *(const u32x2*)(SEL + 4 * lane);
  lds_fence();
#define A_LOAD(j) do { _Pragma("unroll") for (int i = 0; i < 4; ++i) { const int row = (lane >> 3) + 8 * i, ch = lane & 7, e = 32 * (j) + row; \
      const int tokk = (e < count) ? (int)sel_l[e] : 0; const size_t off = (size_t)tokk * NPE + ch * 8; R.k[i] = *(const u32x4*)(Kg + off); R.v[i] = *(const u32x4*)(Vg + off); } } while (0)
  A_LOAD(0);
  for (int j = 0; j < nsteps; ++j) {
    lds_fence();
    kv_store(R, Ks, Vs, lane);
    lds_fence();
    if (j + 1 < nsteps) A_LOAD(j + 1);
    const unsigned vm = lane_rows(row_range_mask(0, count - 1 - 32 * j), h);
    attn_step32<2>(Ks, WP, Vs, WP, qf, o, m, l, vm, 0.125f * LOG2E, lane);
  }
#undef A_LOAD
  l += __shfl_xor(l, 32);
  if (r32 < 8) write_o64(o, 1.f / l, PE + (size_t)item * NPE + E_AG + head * 64, Y + (size_t)item * DM + head * 64, h);
}

DI unsigned f2ord(float f) { f += 0.f; const unsigned u = __float_as_uint(f); return (u & 0x80000000u) ? ~u : (u | 0x80000000u); }
DI int block_excl_scan(int v, int* tmp, int* tot) {
  const int lane = threadIdx.x & 63, wid = threadIdx.x >> 6;
  int inc = v;
#pragma unroll
  for (int o = 1; o < 64; o <<= 1) { const int u = __shfl_up(inc, o); if (lane >= o) inc += u; }
  if (lane == 63) tmp[wid] = inc;
  __syncthreads();
  int base = 0, total = 0;
#pragma unroll
  for (int w = 0; w < 8; ++w) { const int x = tmp[w]; if (w < wid) base += x; total += x; }
  *tot = total;
  return base + inc - v;
}

DI float dpp_sum8(float v) {
  v += __builtin_bit_cast(float, __builtin_amdgcn_mov_dpp(__builtin_bit_cast(int, v), 0xB1, 0xF, 0xF, true));
  v += __builtin_bit_cast(float, __builtin_amdgcn_mov_dpp(__builtin_bit_cast(int, v), 0x4E, 0xF, 0xF, true));
  v += __builtin_bit_cast(float, __builtin_amdgcn_mov_dpp(__builtin_bit_cast(int, v), 0x141, 0xF, 0xF, true));
  return v;
}
DI void hist_find(const int* hist, int* misc, int need, int& digit, int& nneed, int& cnt) {
  const int tid = threadIdx.x;
  typedef int i32x4 __attribute__((ext_vector_type(4)));
  const i32x4 h0 = *(const i32x4*)(hist + tid * 8), h1 = *(const i32x4*)(hist + tid * 8 + 4);
  int hh[8] = {h0.x, h0.y, h0.z, h0.w, h1.x, h1.y, h1.z, h1.w}; int tot = 0;
#pragma unroll
  for (int k = 0; k < 8; ++k) tot += hh[k];
  int total; const int ex = block_excl_scan(tot, misc, &total);
  int above = total - ex - tot;
#pragma unroll
  for (int k = 7; k >= 0; --k) { const int c = hh[k]; if (above < need && above + c >= need) { misc[16] = tid * 8 + k; misc[17] = need - above; misc[18] = c; } above += c; }
  __syncthreads();
  digit = misc[16]; nneed = misc[17]; cnt = misc[18];
  __syncthreads();
}
DI unsigned long long mkcmp(float v, int idx) { return ((unsigned long long)f2ord(v) << 16) | ((unsigned long long)(8191 - idx) << 3); }
DI float ord2f(unsigned k) { return __uint_as_float((k & 0x80000000u) ? (k ^ 0x80000000u) : ~k); }
DI float half_sum(float v) { auto rr = __builtin_amdgcn_permlane32_swap(__float_as_uint(v), __float_as_uint(v), false, false); return __uint_as_float(rr[0]) + __uint_as_float(rr[1]); }

constexpr int CL_CAP = 512;
DI void select_slow(const float* scq, int n, unsigned short* out, float lo, float hi, int* hist, int* misc, unsigned long long* clist) {
  const int tid = opaque_tid();
    const float scale = (hi > lo) ? 4095.f / (hi - lo) : 0.f;
    for (int i = tid; i < 4096; i += 512) hist[i] = 0;
    if (tid == 0) misc[20] = 0;
    __syncthreads();
    float val[16]; int bin[16];
#pragma unroll
    for (int i = 0; i < 16; ++i) { const int idx = tid + 512 * i; const float v = (idx < n) ? scq[idx] : lo; val[i] = v;
      int bb = (int)((v - lo) * scale); bb = bb < 0 ? 0 : (bb > 4095 ? 4095 : bb); bin[i] = bb; if (idx < n) atomicAdd(&hist[bb], 1); }
    __syncthreads();
    int bstar, need, cnt;
    hist_find(hist, misc, 256, bstar, need, cnt);
    unsigned long long T = 0ull;
    if (cnt != need) {
      if (cnt <= CL_CAP) {
#pragma unroll
        for (int i = 0; i < 16; ++i) { const int idx = tid + 512 * i; if (idx < n && bin[i] == bstar) { const int slot = atomicAdd(&misc[20], 1); clist[slot] = mkcmp(val[i], idx); } }
        __syncthreads();
        if (tid < cnt) { const unsigned long long c = clist[tid]; int rank = 0; for (int jx = 0; jx < cnt; ++jx) rank += (clist[jx] > c) ? 1 : 0;
          if (rank == need - 1) { misc[21] = (int)(unsigned)(c & 0xffffffffull); misc[22] = (int)(unsigned)(c >> 32); } }
        __syncthreads();
        T = ((unsigned long long)(unsigned)misc[22] << 32) | (unsigned long long)(unsigned)misc[21];
      } else {
        unsigned long long prefix = 0ull; int shift = 36;
        for (int pass = 0; pass < 4; ++pass) {
          for (int i = tid; i < 4096; i += 512) hist[i] = 0;
          __syncthreads();
#pragma unroll
          for (int i = 0; i < 16; ++i) { const int idx = tid + 512 * i; if (idx < n && bin[i] == bstar) { const unsigned long long c = mkcmp(val[i], idx); if (pass == 0 || (c >> (shift + 12)) == prefix) atomicAdd(&hist[(int)((c >> shift) & 4095ull)], 1); } }
          __syncthreads();
          int digit, nneed, c2;
          hist_find(hist, misc, need, digit, nneed, c2);
          prefix = (prefix << 12) | (unsigned long long)digit; need = nneed;
          if (c2 == need) break;
          shift -= 12;
        }
        T = prefix << shift;
      }
    }
    int mycnt = 0; unsigned selm = 0;
#pragma unroll
    for (int i = 0; i < 16; ++i) { const int idx = tid + 512 * i;
      bool sel = false;
      if (idx < n) { if (bin[i] > bstar) sel = true; else if (bin[i] == bstar) sel = (mkcmp(val[i], idx) >= T); }
      if (sel) { ++mycnt; selm |= (1u << i); } }
    int total; int pos = block_excl_scan(mycnt, misc + 8, &total);
#pragma unroll
    for (int i = 0; i < 16; ++i) { if ((selm >> i) & 1u) { if (pos < 256) out[pos] = (unsigned short)(tid + 512 * i); ++pos; } }
    __syncthreads();
}

DI void selectA_item(const Params& p, int item, char* lds) {
  const bf16* PE = (const bf16*)(p.ws + WS_PE);
  const float* IW = (const float*)(p.ws + WS_IW);
  unsigned short* SEL = (unsigned short*)(p.ws + WS_SEL);
  float* sc = (float*)lds;
  int* hist = (int*)(lds + 4 * 8192 * 4);
  int* misc = hist + 4096;
  unsigned* mm = (unsigned*)(misc + 24);
  unsigned long long* clist = (unsigned long long*)(misc + 96);
  const int tid = opaque_tid(), lane = tid & 63, wid = tid >> 6, r32 = lane & 31, h = lane >> 5;
  const int b = item >> 11, t0 = (item & 2047) * 4;
  const size_t rowb = (size_t)b * SEQ;
  const int nk = t0 + 4, ntile = (nk + 31) >> 5;
  if (tid < 4) { mm[tid * 2] = 0xFFFFFFFFu; mm[tid * 2 + 1] = 0u; }
  lds_barrier();
  bf16x8 qf[4]; load_q(qf, PE + (rowb + t0 + (r32 >> 3)) * NPE + E_IQ + (r32 & 7) * 64, h);
  float wq[16];
#pragma unroll
  for (int i = 0; i < 16; ++i) wq[i] = IW[(rowb + t0 + (i >> 2)) * 8 + (i & 3) + 4 * h] * 0.04419417382415922f;
  const bf16* Kt = (const bf16*)(p.ws + WS_IKS) + (size_t)b * 256 * 2048 + lane * 8;
  {
    bf16x8 kf[4], kn[4];
#pragma unroll
    for (int t = 0; t < 4; ++t) { kf[t] = (bf16x8){0, 0, 0, 0, 0, 0, 0, 0}; kn[t] = kf[t]; }
    if (wid < ntile) {
#pragma unroll
      for (int t = 0; t < 4; ++t) kf[t] = *(const bf16x8*)(Kt + (size_t)wid * 2048 + t * 512);
    }
    float lo0 = INFINITY, hi0 = -INFINITY, lo1 = INFINITY, hi1 = -INFINITY;
    for (int kt = wid; kt < ntile; kt += 8) {
      if (kt + 8 < ntile) {
#pragma unroll
        for (int t = 0; t < 4; ++t) kn[t] = *(const bf16x8*)(Kt + (size_t)(kt + 8) * 2048 + t * 512);
      }
      f32x16 s;
#pragma unroll
      for (int i = 0; i < 16; ++i) s[i] = 0.f;
#pragma unroll
      for (int t = 0; t < 4; ++t) s = mfma32(qf[t], kf[t], s);
      float v[4];
#pragma unroll
      for (int q = 0; q < 4; ++q) {
        float a = wq[4 * q] * fmaxf(s[4 * q], 0.f);
#pragma unroll
        for (int jj = 1; jj < 4; ++jj) a += wq[4 * q + jj] * fmaxf(s[4 * q + jj], 0.f);
        v[q] = half_sum(a) + 0.f;
      }
      const float va = h ? v[2] : v[0], vb = h ? v[3] : v[1];
      const int key = kt * 32 + r32;
      sc[(2 * h) * 8192 + key] = va; sc[(2 * h + 1) * 8192 + key] = vb;
      lo0 = fminf(lo0, va); hi0 = fmaxf(hi0, va); lo1 = fminf(lo1, vb); hi1 = fmaxf(hi1, vb);
#pragma unroll
      for (int t = 0; t < 4; ++t) kf[t] = kn[t];
    }
    if (wid < ntile) {
#pragma unroll
      for (int o = 1; o < 32; o <<= 1) { lo0 = fminf(lo0, __shfl_xor(lo0, o)); hi0 = fmaxf(hi0, __shfl_xor(hi0, o)); lo1 = fminf(lo1, __shfl_xor(lo1, o)); hi1 = fmaxf(hi1, __shfl_xor(hi1, o)); }
      if (r32 == 0) { atomicMin(&mm[(2 * h) * 2], f2ord(lo0)); atomicMax(&mm[(2 * h) * 2 + 1], f2ord(hi0)); atomicMin(&mm[(2 * h + 1) * 2], f2ord(lo1)); atomicMax(&mm[(2 * h + 1) * 2 + 1], f2ord(hi1)); }
    }
  }
  lds_barrier();
  {
    const int g = wid >> 1, gt = tid & 127, upper = wid & 1;
    const int t = t0 + g, n = t + 1;
    const bool big = n > 256;
    const float* scq = sc + g * 8192;
    unsigned short* out = SEL + (rowb + t) * 256;
    int* histq = hist + g * 1024;
    unsigned long long* clq = clist + g * 128;
    int* mq = misc + 32 + g * 8;
    const float lo = ord2f(mm[g * 2]), hi = ord2f(mm[g * 2 + 1]);
    const float scale = (hi > lo) ? 1023.f / (hi - lo) : 0.f;
    for (int i = gt; i < 1024; i += 128) histq[i] = 0;
    if (gt == 0) { mq[0] = 0; mq[6] = 0; }
    lds_barrier();
    float uu[64];
#pragma unroll
    for (int i = 0; i < 64; ++i) { const int idx = gt + 128 * i; const float v = (idx < n) ? scq[idx] : lo; const float u = (v - lo) * scale; uu[i] = u;
      if (big && idx < n) { int bb = (int)u; bb = bb > 1023 ? 1023 : bb; atomicAdd(&histq[bb], 1); } }
    lds_barrier();
    typedef int i32x4 __attribute__((ext_vector_type(4)));
    const i32x4 h0 = *(const i32x4*)(histq + gt * 8), h1 = *(const i32x4*)(histq + gt * 8 + 4);
    const int hh[8] = {h0.x, h0.y, h0.z, h0.w, h1.x, h1.y, h1.z, h1.w};
    int tot = 0;
#pragma unroll
    for (int k = 0; k < 8; ++k) tot += hh[k];
    int inc = tot;
#pragma unroll
    for (int o = 1; o < 64; o <<= 1) { const int ux = __shfl_down(inc, o); if (lane + o < 64) inc += ux; }
    if (lane == 0) misc[wid] = inc;
    lds_barrier();
    {
      int above = inc - tot + (upper ? 0 : misc[wid + 1]);
      if (big) {
#pragma unroll
        for (int k = 7; k >= 0; --k) { const int c = hh[k]; if (above < 256 && above + c >= 256) { mq[1] = gt * 8 + k; mq[2] = 256 - above; mq[3] = c; } above += c; }
      }
    }
    lds_barrier();
    const int bstar = mq[1], need = mq[2], cnt = mq[3];
    const float flo = (float)bstar, fhi = (bstar >= 1023) ? INFINITY : (float)(bstar + 1);
    const bool tie = big && cnt != need;
    if (tie) {
      if (cnt <= 128) {
#pragma unroll
        for (int i = 0; i < 64; ++i) { const int idx = gt + 128 * i; if (idx < n && uu[i] >= flo && uu[i] < fhi) { const int slot = atomicAdd(&mq[0], 1); clq[slot] = mkcmp(scq[idx], idx); } }
      } else if (gt == 0) mq[6] = 1;
    }
    lds_barrier();
    if (tie && cnt <= 128 && gt < cnt) { const unsigned long long c = clq[gt]; int rank = 0; for (int jx = 0; jx < cnt; ++jx) rank += (clq[jx] > c) ? 1 : 0;
      if (rank == need - 1) { mq[4] = (int)(unsigned)(c & 0xffffffffull); mq[5] = (int)(unsigned)(c >> 32); } }
    lds_barrier();
    const unsigned long long T = tie ? (((unsigned long long)(unsigned)mq[5] << 32) | (unsigned long long)(unsigned)mq[4]) : 0ull;
    const bool fast = big && !(tie && cnt > 128);
    unsigned long long selm = 0ull;
    if (fast) {
#pragma unroll
      for (int i = 0; i < 64; ++i) { const int idx = gt + 128 * i;
        if (idx < n) { const float u = uu[i]; bool sel = u >= fhi; if (!sel && u >= flo) sel = !tie || (mkcmp(scq[idx], idx) >= T); if (sel) selm |= (1ull << i); } }
    }
    const int mycnt = __popcll(selm);
    int pinc = mycnt;
#pragma unroll
    for (int o = 1; o < 64; o <<= 1) { const int ux = __shfl_up(pinc, o); if (lane >= o) pinc += ux; }
    if (lane == 63) misc[8 + wid] = pinc;
    lds_barrier();
    if (fast) {
      int pos = pinc - mycnt + (upper ? misc[8 + wid - 1] : 0);
      while (selm) { const int i = __ffsll((long long)selm) - 1; selm &= selm - 1ull; if (pos < 256) out[pos] = (unsigned short)(gt + 128 * i); ++pos; }
    } else if (!big) {
      for (int i = gt; i < n; i += 128) out[i] = (unsigned short)i;
    }
    lds_barrier();
  }
  for (int q = 0; q < 4; ++q) {
    if (misc[32 + q * 8 + 6]) { const int t = t0 + q; select_slow(sc + q * 8192, t + 1, SEL + (rowb + t) * 256, ord2f(mm[q * 2]), ord2f(mm[q * 2 + 1]), hist, misc, clist); }
  }
  lds_barrier();
}

constexpr int DKP = 72, DVP = 136;
constexpr int D_STAGE = (64 * DKP * 2 + 64 * DVP) * 2;
DI void mixerD_unit(const Params& p, int b, int head, int qb, char* lds) {
  const bf16* PO = (const bf16*)(p.ws + WS_PE); bf16* Y = (bf16*)(p.ws + WS_Y);
  const int tid = opaque_tid(), lane = tid & 63, wid = tid >> 6, r32 = lane & 31, h = lane >> 5;
  const int map = wid & 1, qsub = wid >> 1;
  const size_t rowb = (size_t)b * SEQ;
  const int qpos = 128 * qb + 32 * qsub + r32;
  bf16x8 qf[4]; load_q(qf, PO + (rowb + qpos) * NPO + O_DQ + (2 * head + map) * 64, h);
  f32x16 o[4]; zero_o<4>(o);
  float m = -1e30f, l = 0.f;
  const int nsteps = 2 * qb + 2;
  const bf16* K1g = PO + rowb * NPO + O_DK + (2 * head) * 64;
  const bf16* K2g = K1g + 64;
  const bf16* Vg = PO + rowb * NPO + O_DV + head * 128;
  u32x4 rk1, rk2, rv[2];
#define D_LOAD(j) do { const int row = tid >> 3, ch = tid & 7; const size_t off = (size_t)((j) * 64 + row) * NPO + ch * 8; rk1 = *(const u32x4*)(K1g + off); rk2 = *(const u32x4*)(K2g + off); \
    _Pragma("unroll") for (int i = 0; i < 2; ++i) { const int c = tid + 512 * i, vr = c >> 4, vc = c & 15; rv[i] = *(const u32x4*)(Vg + (size_t)((j) * 64 + vr) * NPO + vc * 8); } } while (0)
  __syncthreads();
  D_LOAD(0);
  for (int j = 0; j < nsteps; ++j) {
    char* st = lds + (j & 1) * D_STAGE;
    bf16* K1s = (bf16*)st; bf16* K2s = K1s + 64 * DKP; bf16* Vs = K2s + 64 * DKP;
    { const int row = tid >> 3, ch = tid & 7; *(u32x4*)(K1s + row * DKP + ch * 8) = rk1; *(u32x4*)(K2s + row * DKP + ch * 8) = rk2;
#pragma unroll
      for (int i = 0; i < 2; ++i) { const int c = tid + 512 * i, vr = c >> 4, vc = c & 15; *(u32x4*)(Vs + vr * DVP + vc * 8) = rv[i]; } }
    __syncthreads();
    if (j + 1 < nsteps) D_LOAD(j + 1);
    const bf16* Ks = map ? K2s : K1s;
#pragma unroll
    for (int sub = 0; sub < 2; ++sub) {
      const int k0 = j * 64 + sub * 32;
      if (k0 <= 128 * qb + 32 * qsub + 31) {
        if (k0 + 31 <= 128 * qb + 32 * qsub) {
          attn_step32<4, false>(Ks + sub * 32 * DKP, DKP, Vs + sub * 32 * DVP, DVP, qf, o, m, l, 0xffffu, 0.125f * LOG2E, lane);
        } else {
          unsigned vm = 0;
#pragma unroll
          for (int i = 0; i < 16; ++i) if (k0 + crow(i, h) <= qpos) vm |= (1u << i);
          attn_step32<4, true>(Ks + sub * 32 * DKP, DKP, Vs + sub * 32 * DVP, DVP, qf, o, m, l, vm, 0.125f * LOG2E, lane);
        }
      }
    }
  }
#undef D_LOAD
  l += __shfl_xor(l, 32);
  const float linv = 1.f / l;
  __syncthreads();
  float* xch = (float*)lds + qsub * 4096;
  if (map == 1) {
#pragma unroll
    for (int d = 0; d < 4; ++d)
#pragma unroll
      for (int i = 0; i < 16; ++i) xch[(d * 16 + i) * 64 + lane] = o[d][i] * linv;
  }
  __syncthreads();
  if (map == 0) {
    const float lam = *(const float*)(p.ws + WS_LAM);
    float ssq = 0.f;
#pragma unroll
    for (int d = 0; d < 4; ++d)
#pragma unroll
      for (int i = 0; i < 16; ++i) { const float a = o[d][i] * linv - lam * xch[(d * 16 + i) * 64 + lane]; o[d][i] = a; ssq += a * a; }
    ssq += __shfl_xor(ssq, 32);
    const float lambda_init = 0.8f - 0.6f * expf(-0.3f);
    const float rn = rsqrtf(ssq * (1.f / 128.f) + EPS) * (1.f - lambda_init);
    const size_t tok = rowb + qpos;
    const bf16* gate = PO + tok * NPO + O_DG + head * 128;
    bf16* y = Y + tok * DM + 512 + head * 128;
    const float* sg = p.in[I_SUB_GAIN];
#pragma unroll
    for (int d = 0; d < 4; ++d)
#pragma unroll
      for (int g = 0; g < 4; ++g) {
        const int dd = 32 * d + 8 * g + 4 * h;
        const u32x2 gv = *(const u32x2*)(gate + dd); const f32x4 s4 = *(const f32x4*)(sg + dd);
        const float g0 = __uint_as_float(gv.x << 16), g1 = __uint_as_float(gv.x & 0xffff0000u), g2 = __uint_as_float(gv.y << 16), g3 = __uint_as_float(gv.y & 0xffff0000u);
        u32x2 w; w.x = cvtpk(o[d][4 * g] * rn * s4.x * g0, o[d][4 * g + 1] * rn * s4.y * g1); w.y = cvtpk(o[d][4 * g + 2] * rn * s4.z * g2, o[d][4 * g + 3] * rn * s4.w * g3);
        *(u32x2*)(y + dd) = w;
      }
  }
  __syncthreads();
}

#define XB_TMO      128
#define XB_XCNT(j)  (256  + 64 * (j))
#define XB_XSUB(j)  (1280 + 64 * (j))
#define XB_XGEN(j)  (2304 + 64 * (j))
#define XB_TOP      3328
#define XB_TOPGEN   3392
#define XCD_BAR_WORDS 3456
#define XB_SPIN_CAP (1u << 18)

__device__ __forceinline__ unsigned xb_ld(unsigned* p)              { return __hip_atomic_load(p, __ATOMIC_RELAXED, __HIP_MEMORY_SCOPE_AGENT); }
__device__ __forceinline__ unsigned xb_add(unsigned* p, unsigned v) { return __hip_atomic_fetch_add(p, v, __ATOMIC_RELAXED, __HIP_MEMORY_SCOPE_AGENT); }
__device__ __forceinline__ unsigned xb_xcc_id() { return (unsigned)__builtin_amdgcn_s_getreg((3 << 11) | 20) & 0xFu; }
#define XB_SPIN(cond, bar) do { unsigned _sp = 0; while (cond) { __builtin_amdgcn_s_sleep(1); \
    if ((++_sp & 255u) == 0u) { if (xb_ld(&(bar)[XB_TMO])) break; if (_sp > XB_SPIN_CAP) { atomicAdd(&(bar)[XB_TMO], 1u); break; } } } } while (0)

struct XcdBarrier {
    unsigned* bar; unsigned x;
    volatile LAS unsigned* st;
};

__device__ __forceinline__ XcdBarrier xcd_barrier_post(unsigned* bar, volatile LAS unsigned* st) {
    XcdBarrier b; b.bar = bar; b.x = xb_xcc_id(); b.st = st;
    if (threadIdx.x == 0) (void)xb_add(&bar[XB_XCNT(b.x)], 1u);
    return b;
}
__device__ __forceinline__ void xcd_barrier_complete(unsigned* bar, unsigned x, unsigned& nloc, unsigned& nx) {
    const unsigned G = gridDim.x * gridDim.y * gridDim.z;
    unsigned sum, cnt, mine, sp = 0u;
    for (;;) {
        sum = 0u; cnt = 0u; mine = 0u;
#pragma unroll
        for (unsigned j = 0; j < 16; ++j) { const unsigned c = xb_ld(&bar[XB_XCNT(j)]); sum += c; cnt += (c > 0u) ? 1u : 0u; mine = (j == x) ? c : mine; }
        if (sum == G) break;
        __builtin_amdgcn_s_sleep(1);
        if ((++sp & 255u) == 0u) { if (xb_ld(&bar[XB_TMO])) break; if (sp > XB_SPIN_CAP) { atomicAdd(&bar[XB_TMO], 1u); break; } }
    }
    nloc = mine > 0u ? mine : 1u; nx = cnt > 0u ? cnt : 1u;
}

__device__ __forceinline__ void xcd_barrier(const XcdBarrier& b) {
    asm volatile("s_waitcnt vmcnt(0)" ::: "memory");
    __syncthreads();
    if (threadIdx.x == 0) {
        unsigned* bar = b.bar;
        __builtin_amdgcn_s_waitcnt(0);
        unsigned nloc = b.st[0], nx = b.st[1];
        if (nloc == 0u) { xcd_barrier_complete(bar, b.x, nloc, nx); b.st[0] = nloc; b.st[1] = nx; }
        const unsigned old = xb_add(&bar[XB_XSUB(b.x)], 1u);
        const unsigned gen = old / nloc;
        if (old + 1u == (gen + 1u) * nloc) {
            __builtin_amdgcn_fence(__ATOMIC_RELEASE, "agent");
            asm volatile("s_waitcnt vmcnt(0)" ::: "memory");
            const unsigned og = xb_add(&bar[XB_TOP], 1u);
            const unsigned tg = og / nx;
            if (og + 1u == (tg + 1u) * nx) xb_add(&bar[XB_TOPGEN], 1u);
            else XB_SPIN(xb_ld(&bar[XB_TOPGEN]) == tg, bar);
            __builtin_amdgcn_fence(__ATOMIC_ACQUIRE, "agent");
            xb_add(&bar[XB_XGEN(b.x)], 1u);
            asm volatile("s_waitcnt vmcnt(0)" ::: "memory");
        } else {
            XB_SPIN(xb_ld(&bar[XB_XGEN(b.x)]) == gen, bar);
            __builtin_amdgcn_fence(__ATOMIC_ACQUIRE, "agent");
            asm volatile("s_waitcnt vmcnt(0)" ::: "memory");
        }
    }
    __syncthreads();
}


__global__ void __launch_bounds__(NTHREADS) fwd_kernel(Params p) {
  extern __shared__ __attribute__((aligned(16))) char smem[];
  cg::grid_group grid = cg::this_grid();
  char* lds = smem;
  volatile LAS unsigned* xb_st = (volatile LAS unsigned*)((LAS char*)smem + (LDS_BYTES - 16));
  if (threadIdx.x < 2) xb_st[threadIdx.x] = 0u;
  __syncthreads();
  const XcdBarrier xbar = xcd_barrier_post((unsigned*)(p.ws + WS_BAR), xb_st);
#define FRESH_IDS const int tid = opaque_tid(), lane = tid & 63, wid = tid >> 6; const int gw = blockIdx.x * 8 + wid, ngw = gridDim.x * 8; bf16* Ks = (bf16*)(lds + wid * WAVE_LDS); bf16* Vs = Ks + 32 * WP; (void)gw; (void)ngw; (void)Ks; (void)Vs; (void)lane;

  phase_prologue(p, lds);
  if (p.ws == nullptr) grid.sync();
  xcd_barrier(xbar);
  for (int rep = 0; rep < REP_GEMM; ++rep) phase_inproj(p, 0, lds);
  xcd_barrier(xbar);
#if EN_A
  for (int rep = 0; rep < REP_SELA; ++rep) for (int k = 0; k * (int)gridDim.x < 2 * 2048; ++k) { const int it = k * (int)gridDim.x + ((k & 1) ? (int)gridDim.x - 1 - (int)blockIdx.x : (int)blockIdx.x); if (it < 2 * 2048) selectA_item(p, it, lds); }
  xcd_barrier(xbar);
  { FRESH_IDS for (int rep = 0; rep < REP_AATT; ++rep) for (int it = gw; it < NTOK; it += ngw) mixerA_item(p, it, Ks, Vs, lane); }
#else
  { unsigned* y = (unsigned*)(p.ws + WS_Y); for (int i = blockIdx.x * NTHREADS + (int)threadIdx.x; i < NTOK * 256; i += gridDim.x * NTHREADS) { const int row = i >> 8, c = i & 255; y[row * 512 + c] = 0u; } }
#endif
#if EN_B
  { FRESH_IDS for (int it = gw; it < 4096; it += ngw) mixerB_tile(p, it, Ks, Vs, lane); }
#else
  { unsigned* y = (unsigned*)(p.ws + WS_Y); for (int i = blockIdx.x * NTHREADS + (int)threadIdx.x; i < NTOK * 256; i += gridDim.x * NTHREADS) { const int row = i >> 8, c = i & 255; y[row * 512 + 256 + c] = 0u; } }
#endif
  xcd_barrier(xbar);
  phase_outproj(p, 0, lds);
  xcd_barrier(xbar);
  phase_ple(p, 0, lds);
  xcd_barrier(xbar);
  phase_inproj(p, 1, lds);
  xcd_barrier(xbar);
#if EN_D
  for (int rep = 0; rep < REP_D; ++rep) {
#pragma unroll 1
    for (int u2 = blockIdx.x * 2; u2 < 512; u2 += gridDim.x * 2) {
#pragma unroll 1
      for (int k = 0; k < 2; ++k) { const int u = u2 >> 1, bh = u >> 5, pr = u & 31; mixerD_unit(p, bh >> 2, bh & 3, k ? 63 - pr : pr, lds); }
    }
  }
#else
  { unsigned* y = (unsigned*)(p.ws + WS_Y); for (int i = blockIdx.x * NTHREADS + (int)threadIdx.x; i < NTOK * 256; i += gridDim.x * NTHREADS) { const int row = i >> 8, c = i & 255; y[row * 512 + 256 + c] = 0u; } }
#endif
#if EN_C
  __syncthreads();
  { FRESH_IDS for (int rep = 0; rep < REP_C; ++rep) for (int it = gw; it < 4096; it += ngw) mixerC_tile(p, it, Ks, Vs, lane); }
#else
  { unsigned* y = (unsigned*)(p.ws + WS_Y); for (int i = blockIdx.x * NTHREADS + (int)threadIdx.x; i < NTOK * 256; i += gridDim.x * NTHREADS) { const int row = i >> 8, c = i & 255; y[row * 512 + c] = 0u; } }
#endif
  xcd_barrier(xbar);
  phase_outproj(p, 1, lds);
  xcd_barrier(xbar);
  phase_ple(p, 1, lds);
}

extern "C" void kernel_launch(void* const* d_in, const int* in_sizes, int n_in, void* d_out, int out_size, void* d_ws, size_t ws_size, hipStream_t stream) {
  static int grid_blocks = 0;
  if (!grid_blocks) {
    int dev = 0, cus = 0, per_cu = 0;
    hipGetDevice(&dev);
    hipDeviceGetAttribute(&cus, hipDeviceAttributeMultiprocessorCount, dev);
    hipFuncSetAttribute((const void*)fwd_kernel, hipFuncAttributeMaxDynamicSharedMemorySize, LDS_BYTES);
    hipOccupancyMaxActiveBlocksPerMultiprocessor(&per_cu, (const void*)fwd_kernel, NTHREADS, LDS_BYTES);
    if (per_cu < 1) per_cu = 1;
    grid_blocks = cus * per_cu;
    if (grid_blocks > 256) grid_blocks = 256;
  }
  Params p{};
  for (int i = 0; i < 25; ++i) p.in[i] = (const float*)d_in[i];
  p.out = (float*)d_out; p.ws = (unsigned char*)d_ws;
  for (int i = 0; i < 32; ++i) p.inv_freq[i] = (float)pow(10000.0, -(double)i / 32.0);
  (void)hipMemsetAsync((char*)d_ws + WS_BAR, 0, 16384, stream);
  void* args[] = {&p};
  hipError_t e = hipLaunchCooperativeKernel((const void*)fwd_kernel, dim3(grid_blocks), dim3(NTHREADS), args, LDS_BYTES, stream);
  if (e != hipSuccess) fprintf(stderr, "cooperative launch failed: %s (grid %d)\n", hipGetErrorString(e), grid_blocks);
}
```

```cpp
#include <hip/hip_runtime.h>
#include <hip/hip_cooperative_groups.h>
#include <cstdio>
#include <cmath>
namespace cg = cooperative_groups;

#ifndef REP_GEMM
#define REP_GEMM 1
#endif
#ifndef REP_SELA
#define REP_SELA 1
#endif
#ifndef REP_D
#define REP_D 1
#endif
#ifndef REP_C
#define REP_C 1
#endif
#ifndef REP_AATT
#define REP_AATT 1
#endif
#ifndef EN_A
#define EN_A 1
#endif
#ifndef EN_B
#define EN_B 1
#endif
#ifndef EN_C
#define EN_C 1
#endif
#ifndef EN_D
#define EN_D 1
#endif

typedef unsigned short bf16;
typedef short bf16x8 __attribute__((ext_vector_type(8)));
typedef short s16x4 __attribute__((ext_vector_type(4)));
typedef float f32x4 __attribute__((ext_vector_type(4)));
typedef float f32x16 __attribute__((ext_vector_type(16)));
typedef unsigned u32x4 __attribute__((ext_vector_type(4)));
typedef unsigned u32x2 __attribute__((ext_vector_type(2)));
typedef float f32x2_t __attribute__((ext_vector_type(2)));
typedef __bf16 bf16x2_t __attribute__((ext_vector_type(2)));
#define LAS __attribute__((address_space(3)))
#define DI __device__ __forceinline__

constexpr int SEQ = 8192, NTOK = 16384, DM = 1024;
constexpr int NPE = 3072, NPO = 4096;
constexpr float EPS = 1e-6f;
constexpr float LOG2E = 1.4426950408889634f;
constexpr int NTHREADS = 512;
constexpr int LDS_BYTES = 150 * 1024;

constexpr size_t MiB = 1u << 20;
constexpr size_t WS_PE = 0;
constexpr size_t WS_ACT = 128 * MiB;
constexpr size_t WS_Y = 160 * MiB;
constexpr size_t WS_WINE = 192 * MiB;
constexpr size_t WS_WOUTE = 198 * MiB;
constexpr size_t WS_WINO = 200 * MiB;
constexpr size_t WS_WOUTO = 208 * MiB;
constexpr size_t WS_WG0 = 210 * MiB;
constexpr size_t WS_WG1 = 212 * MiB;
constexpr size_t WS_WP0 = 214 * MiB;
constexpr size_t WS_WP1 = 215 * MiB;
constexpr size_t WS_ROPE = 216 * MiB;
constexpr size_t WS_SEL = 218 * MiB;
constexpr size_t WS_IW = 226 * MiB;
constexpr size_t WS_SS = 227 * MiB;
constexpr size_t WS_LAM = 228 * MiB;
constexpr size_t WS_BAR = 250 * MiB;
constexpr size_t WS_PBF = 232 * MiB;
constexpr size_t WS_IKS = 229 * MiB;

struct Params {
  const float* in[25];
  float* out;
  unsigned char* ws;
  float inv_freq[32];
};
enum { I_X = 0, I_P, I_NORM_GAIN, I_W_IN_EVEN, I_W_OUT_EVEN, I_A_Q_GAIN, I_A_K_GAIN, I_IDX_K_GAIN, I_B_Q_GAIN, I_B_K_GAIN, I_B_SINKS,
       I_W_IN_ODD, I_W_OUT_ODD, I_C_Q_GAIN, I_C_K_GAIN, I_D_Q_GAIN, I_D_K_GAIN, I_LQ1, I_LK1, I_LQ2, I_LK2, I_SUB_GAIN, I_PLE_NORM_GAIN,
       I_W_PLE_GATE, I_W_PLE_PROJ };

DI unsigned cvtpk(float lo, float hi) { f32x2_t v = {lo, hi}; bf16x2_t b = __builtin_convertvector(v, bf16x2_t); return __builtin_bit_cast(unsigned, b); }
DI float bf2f(bf16 b) { return __uint_as_float(((unsigned)b) << 16); }
DI float fexp2(float x) { return __builtin_amdgcn_exp2f(x); }
DI f32x16 mfma32(bf16x8 a, bf16x8 b, f32x16 c) { return __builtin_amdgcn_mfma_f32_32x32x16_bf16(a, b, c, 0, 0, 0); }
DI f32x4 mfma16(bf16x8 a, bf16x8 b, f32x4 c) { return __builtin_amdgcn_mfma_f32_16x16x32_bf16(a, b, c, 0, 0, 0); }
DI int crow(int i, int h) { return (i & 3) + 8 * (i >> 2) + 4 * h; }
DI s16x4 trread(const bf16* p) { return __builtin_bit_cast(s16x4, __builtin_amdgcn_ds_read_tr16_b64_v4i16((LAS s16x4*)p)); }
DI int opaque_tid() { int t = threadIdx.x; asm volatile("" : "+v"(t)); return t; }
DI void lds_barrier() { asm volatile("s_waitcnt lgkmcnt(0)" ::: "memory"); __builtin_amdgcn_s_barrier(); asm volatile("" ::: "memory"); }
DI void lds_fence() { asm volatile("s_waitcnt lgkmcnt(0)" ::: "memory"); __builtin_amdgcn_wave_barrier(); }

__host__ __device__ __forceinline__ int phys_col(int n) { return (n & ~255) + 128 * ((n >> 5) & 1) + 32 * ((n >> 6) & 3) + (n & 31); }
DI int map_even(int n) { return n < 1216 ? n : (n < 1224 ? 3008 + (n - 1216) : n - 8); }
DI void transpose_tile(const float* W, int K, int N, bf16* WT, int mapmode, int tile, float* scr) {
  const int tid = opaque_tid();
  const int ntn = (N + 63) >> 6, kt = tile / ntn, nt = tile % ntn, k0 = kt * 64, n0 = nt * 64;
#pragma unroll
  for (int i = 0; i < 8; ++i) {
    const int kk = (tid >> 6) + 8 * i, nn = tid & 63, n = n0 + nn;
    scr[kk * 65 + nn] = (n < N) ? W[(size_t)(k0 + kk) * N + n] : 0.f;
  }
  __syncthreads();
  {
    const int nn = tid >> 3, kc = tid & 7, n = n0 + nn;
    if (n < N) {
      const int dst = mapmode == 1 ? phys_col(map_even(n)) : (mapmode == 2 ? phys_col(n) : n);
      const float* s = scr + (kc * 8) * 65 + nn;
      u32x4 o; o.x = cvtpk(s[0], s[65]); o.y = cvtpk(s[2 * 65], s[3 * 65]); o.z = cvtpk(s[4 * 65], s[5 * 65]); o.w = cvtpk(s[6 * 65], s[7 * 65]);
      *(u32x4*)(WT + (size_t)dst * K + k0 + kc * 8) = o;
    }
  }
  __syncthreads();
}

DI float wave_sum(float v) {
#pragma unroll
  for (int o = 1; o < 64; o <<= 1) v += __shfl_xor(v, o);
  return v;
}

DI void phase_prologue(const Params& p, char* lds) {
  const int tid = opaque_tid(), lane = tid & 63, wid = tid >> 6;
  const int nb = gridDim.x, bid = blockIdx.x;
  unsigned char* ws = p.ws;
  float* scr = (float*)lds;
  const int T0 = 16 * 48, T1 = 256, T2 = 16 * 64, T3 = 256, T4 = 256, T5 = 256, T6 = 64, T7 = 64;
  const int NT = T0 + T1 + T2 + T3 + T4 + T5 + T6 + T7;
  for (int it = bid; it < NT; it += nb) {
    int r = it;
    if (r < T0) { transpose_tile(p.in[I_W_IN_EVEN], 1024, 3016, (bf16*)(ws + WS_WINE), 1, r, scr); continue; } r -= T0;
    if (r < T1) { transpose_tile(p.in[I_W_OUT_EVEN], 1024, 1024, (bf16*)(ws + WS_WOUTE), 0, r, scr); continue; } r -= T1;
    if (r < T2) { transpose_tile(p.in[I_W_IN_ODD], 1024, 4096, (bf16*)(ws + WS_WINO), 2, r, scr); continue; } r -= T2;
    if (r < T3) { transpose_tile(p.in[I_W_OUT_ODD], 1024, 1024, (bf16*)(ws + WS_WOUTO), 0, r, scr); continue; } r -= T3;
    if (r < T4) { transpose_tile(p.in[I_W_PLE_GATE], 1024, 1024, (bf16*)(ws + WS_WG0), 0, r, scr); continue; } r -= T4;
    if (r < T5) { transpose_tile(p.in[I_W_PLE_GATE] + 1024 * 1024, 1024, 1024, (bf16*)(ws + WS_WG1), 0, r, scr); continue; } r -= T5;
    if (r < T6) { transpose_tile(p.in[I_W_PLE_PROJ], 256, 1024, (bf16*)(ws + WS_WP0), 0, r, scr); continue; } r -= T6;
    transpose_tile(p.in[I_W_PLE_PROJ] + 256 * 1024, 256, 1024, (bf16*)(ws + WS_WP1), 0, r, scr);
  }
  const int gt = bid * NTHREADS + tid, ngt = nb * NTHREADS;
  { unsigned* z = (unsigned*)(ws + WS_WINE); for (int i = gt; i < 56 * 512; i += ngt) z[(size_t)phys_col(3016 + (i >> 9)) * 512 + (i & 511)] = 0u; }
  { const f32x4* src = (const f32x4*)p.in[I_P]; u32x2* dst = (u32x2*)(ws + WS_PBF); for (int i = gt; i < 2 * NTOK * 256 / 4; i += ngt) { const f32x4 v = src[i]; u32x2 w; w.x = cvtpk(v.x, v.y); w.y = cvtpk(v.z, v.w); dst[i] = w; } }
  { float* ss = (float*)(ws + WS_SS); for (int i = gt; i < 3 * NTOK; i += ngt) ss[i] = 0.f; }
  { float2* tab = (float2*)(ws + WS_ROPE);
    for (int i = gt; i < SEQ * 32; i += ngt) {
      const int pos = i >> 5, k = i & 31;
      const float ang = (float)pos * p.inv_freq[k];
      double rev = (double)ang * 0.15915494309189535; rev -= floor(rev);
      const float rf = (float)rev;
      tab[i] = make_float2(__builtin_amdgcn_cosf(rf), __builtin_amdgcn_sinf(rf));
    } }
  if (bid == 0 && wid == 0) {
    const float a = wave_sum(p.in[I_LQ1][lane] * p.in[I_LK1][lane]);
    const float b = wave_sum(p.in[I_LQ2][lane] * p.in[I_LK2][lane]);
    const float lambda_init = 0.8f - 0.6f * expf(-0.3f);
    if (lane == 0) *(float*)(ws + WS_LAM) = expf(a) - expf(b) + lambda_init;
  }
  { const float* x = p.in[I_X]; const float* g = p.in[I_NORM_GAIN]; bf16* H = (bf16*)(ws + WS_ACT);
    const int gw = bid * 8 + wid, ngw = nb * 8;
    for (int m = gw; m < NTOK; m += ngw) {
      const f32x4* xr = (const f32x4*)(x + (size_t)m * DM) + lane;
      f32x4 v[4]; float s = 0.f;
#pragma unroll
      for (int j = 0; j < 4; ++j) { v[j] = xr[64 * j]; s += v[j].x * v[j].x + v[j].y * v[j].y + v[j].z * v[j].z + v[j].w * v[j].w; }
      const float rstd = rsqrtf(wave_sum(s) * (1.f / DM) + EPS);
      u32x2* o = (u32x2*)(H + (size_t)m * DM) + lane;
#pragma unroll
      for (int j = 0; j < 4; ++j) { const f32x4 gg = *((const f32x4*)g + lane + 64 * j); u32x2 w; w.x = cvtpk(v[j].x * rstd * gg.x, v[j].y * rstd * gg.y); w.y = cvtpk(v[j].z * rstd * gg.z, v[j].w * rstd * gg.w); o[64 * j] = w; }
    } }
}

namespace pg8 {
#define PG8_LAS __attribute__((address_space(3)))
typedef unsigned short bf16_t;
typedef short bf16x8 __attribute__((ext_vector_type(8)));
typedef float f32x4 __attribute__((ext_vector_type(4)));
typedef unsigned u32x4 __attribute__((ext_vector_type(4)));
constexpr int BM = 256, BK = 64, HALF = 128, HTB = HALF * BK * 2  , STAGE_BYTES = 8 * HTB, NXCD = 8, WGM = 8;

__host__ __device__ __forceinline__ int lds_byte(int r, int c) { const int st = (r >> 4) * 2 + (c >> 5), rr = r & 15, cc = c & 31, ob = rr * 64 + cc * 2; return st * 1024 + (ob ^ (((ob >> 9) & 1) << 5)); }
__host__ __device__ __forceinline__ void stage_rc(int b, int& R, int& C) { const int st = b / 1024, sb = b % 1024, swz = sb ^ (((sb >> 9) & 1) << 5); R = (st >> 1) * 16 + swz / 64; C = (st & 1) * 32 + (swz % 64) / 2; }
__host__ __device__ __forceinline__ int perm32(int rho) { const int n = rho >> 4, i = rho & 15; return 8 * (i >> 2) + 4 * n + (i & 3); }

struct Unit { int pm, pn; };
struct Gemm { const bf16_t* A; const bf16_t* Bt; int M, N, K; };

struct StaticOrder {
    int nM, nN, nwg, G, c;
    __host__ __device__ void init(int M, int N, int G_, int c_) { nM = M / BM; nN = N / BM; nwg = nM * nN; G = G_; c = c_; }
    __host__ __device__ bool next(int i, Unit& u) const {
        const long L = (long)i * G + c; if (L >= nwg) return false;
        int wgid = (int)L; { const int q = nwg / NXCD, r = nwg % NXCD, xcd = wgid % NXCD, off = wgid / NXCD; wgid = (xcd < r ? xcd * (q + 1) : r * (q + 1) + (xcd - r) * q) + off; }
        const int nig = WGM * nN, gid = wgid / nig, fm = gid * WGM, gsz = (nM - fm) < WGM ? (nM - fm) : WGM;
        u.pm = fm + ((wgid % nig) % gsz); u.pn = (wgid % nig) / gsz; return true;
    }
    __device__ __forceinline__ void a_ready(const Unit&) const {}
    __device__ __forceinline__ void done(const Unit&) const {}
};
__device__ __forceinline__ unsigned cvt_pk_bf16(float lo, float hi) { unsigned r; asm volatile("v_cvt_pk_bf16_f32 %0, %1, %2" : "=v"(r) : "v"(lo), "v"(hi)); return r; }
template <class Epi, class Sched, bool ALIGN_EPI = false, bool SP2 = false>
__device__ __forceinline__ void gemm_phase(PG8_LAS unsigned char* lds, const Gemm g, const Sched& S, const Epi& E) {
    int tid_ = threadIdx.x; asm volatile("" : "+v"(tid_));
    const int tid = tid_, wid = __builtin_amdgcn_readfirstlane(tid >> 6), lane = tid & 63, wr = wid >> 2, wc = wid & 3, fr = lane & 15, fq = lane >> 4;
    const int K = g.K, nt = K / BK;
    unsigned voffA[2], voffB[2];
#pragma unroll
    for (int i = 0; i < 2; ++i) { int R, C; stage_rc(tid * 16 + i * 8192, R, C); const int Rb = Epi::PERM ? ((R & ~31) + perm32(R & 31)) : R;
        voffA[i] = (unsigned)(R * K + C) * 2u; voffB[i] = (unsigned)(Rb * K + C) * 2u; }
    const size_t kstep = (size_t)(BK * 2);
    const size_t hstep = (size_t)HALF * K * 2;
    const size_t tstep = 2 * hstep;
    const unsigned ldsw = (unsigned)wid * 1024u;
    const int aoff = lds_byte(wr * 64 + fr, fq * 8), boff = lds_byte(wc * 32 + fr, fq * 8);
#define PG8_SA(b, h) (((b) * 2 + (h)) * HTB)
#define PG8_SB(b, h) ((4 + (b) * 2 + (h)) * HTB)
#define PG8_STAGE(bufoff, gbase, voff) do { _Pragma("unroll") for (int _i = 0; _i < 2; ++_i) \
        __builtin_amdgcn_global_load_lds((const unsigned*)((const char*)(gbase) + (voff)[_i]), (PG8_LAS unsigned*)(lds + (bufoff) + ldsw + _i * 8192), 16, 0, 0); } while (0)
#define PG8_LDA(dst, b, h) do { _Pragma("unroll") for (int m = 0; m < 4; ++m) _Pragma("unroll") for (int k = 0; k < 2; ++k) dst[m][k] = *(const PG8_LAS bf16x8*)(lds + PG8_SA(b, h) + aoff + m * 2048 + k * 1024); } while (0)
#define PG8_LDB(dst, b, h) do { _Pragma("unroll") for (int n = 0; n < 2; ++n) _Pragma("unroll") for (int k = 0; k < 2; ++k) dst[n][k] = *(const PG8_LAS bf16x8*)(lds + PG8_SB(b, h) + boff + n * 2048 + k * 1024); } while (0)
#define PG8_MMA(ai, bj, At, Bt) do { __builtin_amdgcn_s_setprio(1); _Pragma("unroll") for (int m = 0; m < 4; ++m) _Pragma("unroll") for (int n = 0; n < 2; ++n) _Pragma("unroll") for (int k = 0; k < 2; ++k) \
        acc[ai][bj][m][n] = __builtin_amdgcn_mfma_f32_16x16x32_bf16(Bt[n][k], At[m][k], acc[ai][bj][m][n], 0, 0, 0); __builtin_amdgcn_s_setprio(0); } while (0)
#define PG8_WAIT_V(n) asm volatile("s_waitcnt vmcnt(" #n ")" ::: "memory")
#define PG8_WAIT_L(n) asm volatile("s_waitcnt lgkmcnt(" #n ")" ::: "memory")
#define PG8_BAR __builtin_amdgcn_s_barrier()
#define PG8_SCHED __builtin_amdgcn_sched_barrier(0)
    Unit cur, nxt; int ui = 0;
    if (!S.next(0, cur)) return;
    f32x4 acc[2][2][4][2];
#pragma unroll
    for (int a = 0; a < 2; ++a)
#pragma unroll
        for (int b = 0; b < 2; ++b)
#pragma unroll
            for (int m = 0; m < 4; ++m)
#pragma unroll
                for (int n = 0; n < 2; ++n) acc[a][b][m][n] = (f32x4){0.f, 0.f, 0.f, 0.f};
    bf16x8 At[4][2], B0[2][2], B1[2][2];
    const char* cA = (const char*)g.A + (size_t)cur.pm * tstep; const char* cB = (const char*)g.Bt + (size_t)cur.pn * tstep;
    S.a_ready(cur);
    if constexpr (SP2) {
        PG8_STAGE(PG8_SB(0, 0), cB, voffB); PG8_STAGE(PG8_SB(0, 1), cB + hstep, voffB); PG8_STAGE(PG8_SA(0, 0), cA, voffA); PG8_STAGE(PG8_SA(0, 1), cA + hstep, voffA);
        if (wr == 1) PG8_BAR;
        PG8_WAIT_V(2); PG8_BAR;
        PG8_STAGE(PG8_SB(1, 0), cB + kstep, voffB); PG8_STAGE(PG8_SA(1, 0), cA + kstep, voffA); PG8_STAGE(PG8_SB(1, 1), cB + hstep + kstep, voffB);
        PG8_WAIT_V(6); PG8_BAR;
    } else {
        PG8_STAGE(PG8_SB(0, 0), cB, voffB); PG8_STAGE(PG8_SA(0, 0), cA, voffA); PG8_STAGE(PG8_SB(0, 1), cB + hstep, voffB); PG8_STAGE(PG8_SA(0, 1), cA + hstep, voffA);
        if (wr == 1) PG8_BAR;
        PG8_WAIT_V(4); PG8_BAR;
        PG8_STAGE(PG8_SB(1, 0), cB + kstep, voffB); PG8_STAGE(PG8_SA(1, 0), cA + kstep, voffA); PG8_STAGE(PG8_SB(1, 1), cB + hstep + kstep, voffB);
        PG8_WAIT_V(6); PG8_BAR;
    }
    for (;;) {
        const bool has_next = S.next(ui + 1, nxt);
        const char* nA = has_next ? (const char*)g.A + (size_t)nxt.pm * tstep : cA; const char* nB = has_next ? (const char*)g.Bt + (size_t)nxt.pn * tstep : cB;
        for (int t = 0; t < nt; t += 2) {
            const bool last = (t == nt - 2);
            const char* a1 = cA + (size_t)(t + 1) * kstep;
            const char* a2 = last ? nA : cA + (size_t)(t + 2) * kstep; const char* b2 = last ? nB : cB + (size_t)(t + 2) * kstep;
            const char* a3 = a2 + kstep; const char* b3 = b2 + kstep;
            if (last && has_next) S.a_ready(nxt);
            if constexpr (SP2) {
            PG8_LDB(B0, 0, 0); PG8_LDB(B1, 0, 1); PG8_SCHED; PG8_LDA(At, 0, 0); PG8_STAGE(PG8_SA(1, 1), a1 + hstep, voffA);
            PG8_WAIT_V(8); PG8_WAIT_L(0); PG8_BAR; PG8_MMA(0, 0, At, B0); PG8_MMA(0, 1, At, B1); PG8_BAR; PG8_SCHED;
            PG8_LDA(At, 0, 1); PG8_STAGE(PG8_SB(0, 0), b2, voffB); PG8_STAGE(PG8_SB(0, 1), b2 + hstep, voffB); PG8_STAGE(PG8_SA(0, 0), a2, voffA);
            PG8_WAIT_V(8); PG8_WAIT_L(0); PG8_BAR; PG8_MMA(1, 0, At, B0); PG8_MMA(1, 1, At, B1); PG8_BAR; PG8_SCHED;
            PG8_LDB(B0, 1, 0); PG8_LDB(B1, 1, 1); PG8_SCHED; PG8_LDA(At, 1, 0); PG8_STAGE(PG8_SA(0, 1), a2 + hstep, voffA);
            PG8_WAIT_V(8); PG8_WAIT_L(0); PG8_BAR; PG8_MMA(0, 0, At, B0); PG8_MMA(0, 1, At, B1); PG8_BAR; PG8_SCHED;
            PG8_LDA(At, 1, 1); PG8_STAGE(PG8_SB(1, 0), b3, voffB); PG8_STAGE(PG8_SB(1, 1), b3 + hstep, voffB); PG8_STAGE(PG8_SA(1, 0), a3, voffA);
            PG8_WAIT_V(8); PG8_WAIT_L(0); PG8_BAR; PG8_MMA(1, 0, At, B0); PG8_MMA(1, 1, At, B1); PG8_BAR; PG8_SCHED;
            } else {
            PG8_LDB(B0, 0, 0); PG8_SCHED; PG8_LDA(At, 0, 0); PG8_STAGE(PG8_SA(1, 1), a1 + hstep, voffA);
            PG8_WAIT_L(8); PG8_BAR; PG8_WAIT_L(0); PG8_MMA(0, 0, At, B0); PG8_BAR; PG8_SCHED;
            PG8_LDB(B1, 0, 1); PG8_STAGE(PG8_SB(0, 0), b2, voffB);
            PG8_BAR; PG8_WAIT_L(0); PG8_MMA(0, 1, At, B1); PG8_BAR;
            PG8_LDA(At, 0, 1); PG8_STAGE(PG8_SA(0, 0), a2, voffA);
            PG8_BAR; PG8_WAIT_L(0); PG8_MMA(1, 0, At, B0); PG8_BAR; PG8_SCHED;
            PG8_STAGE(PG8_SB(0, 1), b2 + hstep, voffB);
            PG8_WAIT_V(6); PG8_BAR; PG8_MMA(1, 1, At, B1); PG8_BAR;
            PG8_LDB(B0, 1, 0); PG8_SCHED; PG8_LDA(At, 1, 0); PG8_STAGE(PG8_SA(0, 1), a2 + hstep, voffA);
            PG8_WAIT_L(8); PG8_BAR; PG8_WAIT_L(0); PG8_MMA(0, 0, At, B0); PG8_BAR; PG8_SCHED;
            PG8_LDB(B1, 1, 1); PG8_STAGE(PG8_SB(1, 0), b3, voffB);
            PG8_BAR; PG8_WAIT_L(0); PG8_MMA(0, 1, At, B1); PG8_BAR;
            PG8_LDA(At, 1, 1); PG8_STAGE(PG8_SA(1, 0), a3, voffA);
            PG8_BAR; PG8_WAIT_L(0); PG8_MMA(1, 0, At, B0); PG8_BAR; PG8_SCHED;
            PG8_STAGE(PG8_SB(1, 1), b3 + hstep, voffB);
            PG8_WAIT_V(6); PG8_BAR; PG8_MMA(1, 1, At, B1); PG8_BAR;
            }
        }
        if constexpr (ALIGN_EPI) { if (wr == 0) PG8_BAR; }
        if constexpr (!Epi::AFTER_DRAIN) { E(acc, cur, wr, wc, fr, fq); S.done(cur); }
        if (!has_next) break;
#pragma unroll
        for (int a = 0; a < 2; ++a)
#pragma unroll
            for (int b = 0; b < 2; ++b)
#pragma unroll
                for (int m = 0; m < 4; ++m)
#pragma unroll
                    for (int n = 0; n < 2; ++n) acc[a][b][m][n] = (f32x4){0.f, 0.f, 0.f, 0.f};
        cur = nxt; cA = nA; cB = nB; ++ui;
        if constexpr (ALIGN_EPI) { if (wr == 1) PG8_BAR; }
    }
    PG8_WAIT_V(0);
    if constexpr (!ALIGN_EPI) { if (wr == 0) PG8_BAR; }
    PG8_BAR;
    if constexpr (Epi::AFTER_DRAIN) { E.fused(acc, cur, wr, wc, fr, fq, lds, wid, lane); S.done(cur); }
#undef PG8_SA
#undef PG8_SB
#undef PG8_STAGE
#undef PG8_LDA
#undef PG8_LDB
#undef PG8_MMA
#undef PG8_WAIT_V
#undef PG8_WAIT_L
#undef PG8_BAR
#undef PG8_SCHED
}
}

enum { T_PLAIN = 0, T_NR = 1, T_ROPE = 2, T_SILU = 3, T_IW = 4 };
DI void slot_info(const Params& p, int layer, int slot, int& type, const float*& gain) {
  gain = nullptr;
  if (layer == 0) {
    if (slot < 8) { type = T_NR; gain = p.in[I_A_Q_GAIN]; }
    else if (slot == 8) { type = T_NR; gain = p.in[I_A_K_GAIN]; }
    else if (slot == 9) type = T_PLAIN;
    else if (slot < 18) type = T_ROPE;
    else if (slot == 18) { type = T_NR; gain = p.in[I_IDX_K_GAIN]; }
    else if (slot < 27) type = T_SILU;
    else if (slot < 35) { type = T_NR; gain = p.in[I_B_Q_GAIN]; }
    else if (slot < 37) { type = T_NR; gain = p.in[I_B_K_GAIN]; }
    else if (slot < 39) type = T_PLAIN;
    else if (slot < 47) type = T_SILU;
    else type = T_IW;
  } else {
    if (slot < 8) { type = T_NR; gain = p.in[I_C_Q_GAIN]; }
    else if (slot < 16) { type = T_NR; gain = p.in[I_C_K_GAIN]; }
    else if (slot < 24) type = T_PLAIN;
    else if (slot < 32) type = T_SILU;
    else if (slot < 40) { type = T_NR; gain = p.in[I_D_Q_GAIN]; }
    else if (slot < 48) { type = T_NR; gain = p.in[I_D_K_GAIN]; }
    else if (slot < 56) type = T_PLAIN;
    else type = T_SILU;
  }
}
constexpr int E_AQ = 0, E_AK = 512, E_AV = 576, E_IQ = 640, E_IK = 1152, E_AG = 1216, E_BQ = 1728, E_BK = 2240, E_BV = 2368, E_BG = 2496;
constexpr int O_CQ = 0, O_CK = 512, O_CV = 1024, O_CG = 1536, O_DQ = 2048, O_DK = 2560, O_DV = 3072, O_DG = 3584;

typedef pg8::f32x4 (AccT)[2][2][4][2];

struct EpiInProj {
  static constexpr bool PERM = false, AFTER_DRAIN = false;
  const Params& p; int layer;
  DI void operator()(const f32x4 (&acc)[2][2][4][2], const pg8::Unit& u, int wr, int wc, int fr, int fq) const {
    unsigned char* ws = p.ws;
    const int NP = layer == 0 ? NPE : NPO;
    bf16* PE = (bf16*)(ws + WS_PE);
    const float2* rope = (const float2*)(ws + WS_ROPE);
    const float* ss1 = (const float*)(ws + WS_SS);
    float* IW = (float*)(ws + WS_IW);
    const int slot = u.pn * 4 + wc;
    int type; const float* gain; slot_info(p, layer, slot, type, gain);
#pragma unroll
    for (int ai = 0; ai < 2; ++ai)
#pragma unroll
      for (int m = 0; m < 4; ++m) {
        const int row = u.pm * 256 + ai * 128 + wr * 64 + m * 16 + fr, pos = row & (SEQ - 1);
        float sc = 1.f;
        if (layer == 1) sc = rsqrtf(ss1[row] * (1.f / DM) + EPS);
        f32x4 v1[2], v2[2];
#pragma unroll
        for (int n = 0; n < 2; ++n) { v1[n] = acc[ai][0][m][n] * sc; v2[n] = acc[ai][1][m][n] * sc; }
        if (type == T_NR) {
          float s = 0.f;
#pragma unroll
          for (int n = 0; n < 2; ++n) s += v1[n].x * v1[n].x + v1[n].y * v1[n].y + v1[n].z * v1[n].z + v1[n].w * v1[n].w + v2[n].x * v2[n].x + v2[n].y * v2[n].y + v2[n].z * v2[n].z + v2[n].w * v2[n].w;
          s += __shfl_xor(s, 16); s += __shfl_xor(s, 32);
          const float rn = rsqrtf(s * (1.f / 64.f) + EPS);
#pragma unroll
          for (int n = 0; n < 2; ++n) { const f32x4 g1 = *(const f32x4*)(gain + n * 16 + fq * 4), g2 = *(const f32x4*)(gain + 32 + n * 16 + fq * 4); v1[n] = v1[n] * rn * g1; v2[n] = v2[n] * rn * g2; }
        }
        if (type == T_NR || type == T_ROPE) {
#pragma unroll
          for (int n = 0; n < 2; ++n) {
            const f32x4* cs = (const f32x4*)(rope + (size_t)pos * 32 + n * 16 + fq * 4);
            const f32x4 c01 = cs[0], c23 = cs[1];
            const f32x4 x1 = v1[n], x2 = v2[n];
            f32x4 o1, o2;
            o1.x = x1.x * c01.x - x2.x * c01.y; o2.x = x2.x * c01.x + x1.x * c01.y;
            o1.y = x1.y * c01.z - x2.y * c01.w; o2.y = x2.y * c01.z + x1.y * c01.w;
            o1.z = x1.z * c23.x - x2.z * c23.y; o2.z = x2.z * c23.x + x1.z * c23.y;
            o1.w = x1.w * c23.z - x2.w * c23.w; o2.w = x2.w * c23.z + x1.w * c23.w;
            v1[n] = o1; v2[n] = o2;
          }
        }
        if (type == T_SILU) {
#pragma unroll
          for (int n = 0; n < 2; ++n)
#pragma unroll
            for (int j = 0; j < 4; ++j) { const float a = v1[n][j]; v1[n][j] = a / (1.f + __expf(-a)); const float b = v2[n][j]; v2[n][j] = b / (1.f + __expf(-b)); }
        }
        if (type == T_IW) {
          if (fq < 2) *(f32x4*)(IW + (size_t)row * 8 + fq * 4) = v1[0];
        } else {
          bf16* dst = PE + (size_t)row * NP + slot * 64 + fq * 4;
#pragma unroll
          for (int n = 0; n < 2; ++n) {
            u32x2 w1, w2; w1.x = cvtpk(v1[n].x, v1[n].y); w1.y = cvtpk(v1[n].z, v1[n].w); w2.x = cvtpk(v2[n].x, v2[n].y); w2.y = cvtpk(v2[n].z, v2[n].w);
            *(u32x2*)(dst + n * 16) = w1; *(u32x2*)(dst + 32 + n * 16) = w2;
            if (layer == 0 && slot == 18) { bf16* IKS = (bf16*)(ws + WS_IKS); const int key = row & (SEQ - 1);
              bf16* base = IKS + (((size_t)(row >> 13) * 256 + (key >> 5)) * 4) * 512 + ((fq >> 1) * 32 + (key & 31)) * 8 + (fq & 1) * 4;
              *(u32x2*)(base + (size_t)n * 512) = w1; *(u32x2*)(base + (size_t)(n + 2) * 512) = w2; }
          }
        }
        asm volatile("" ::: "memory");
      }
  }
};

DI void phase_inproj(const Params& p, int layer, char* lds) {
  unsigned char* ws = p.ws;
  const int NP = layer == 0 ? NPE : NPO;
  pg8::Gemm g{(const bf16*)(ws + (layer == 0 ? WS_ACT : WS_Y)), (const bf16*)(ws + (layer == 0 ? WS_WINE : WS_WINO)), NTOK, NP, DM};
  pg8::StaticOrder S; S.init(NTOK, NP, (int)gridDim.x, (int)blockIdx.x);
  EpiInProj E{p, layer};
  pg8::gemm_phase<EpiInProj, pg8::StaticOrder, true, true>((PG8_LAS unsigned char*)lds, g, S, E);
}

struct EpiOutProj {
  static constexpr bool PERM = false, AFTER_DRAIN = false;
  const float* xin; float* out; bf16* XG; const float* pg; float* ss;
  DI void operator()(const f32x4 (&acc)[2][2][4][2], const pg8::Unit& u, int wr, int wc, int fr, int fq) const {
#pragma unroll
    for (int ai = 0; ai < 2; ++ai)
#pragma unroll
      for (int m = 0; m < 4; ++m) {
        const int row = u.pm * 256 + ai * 128 + wr * 64 + m * 16 + fr; float rs = 0.f;
#pragma unroll
        for (int bj = 0; bj < 2; ++bj)
#pragma unroll
          for (int n = 0; n < 2; ++n) {
            const int col = u.pn * 256 + bj * 128 + wc * 32 + n * 16 + fq * 4; const size_t off = (size_t)row * DM + col;
            const f32x4 xn = *(const f32x4*)(xin + off) + acc[ai][bj][m][n];
            *(f32x4*)(out + off) = xn;
            rs += xn.x * xn.x + xn.y * xn.y + xn.z * xn.z + xn.w * xn.w;
            const f32x4 gg = *(const f32x4*)(pg + col);
            u32x2 w; w.x = cvtpk(xn.x * gg.x, xn.y * gg.y); w.y = cvtpk(xn.z * gg.z, xn.w * gg.w); *(u32x2*)(XG + off) = w;
          }
        rs += __shfl_xor(rs, 16); rs += __shfl_xor(rs, 32);
        if (fq == 0) atomicAdd(ss + row, rs);
        asm volatile("" ::: "memory");
      }
  }
};
DI void phase_outproj(const Params& p, int layer, char* lds) {
  unsigned char* ws = p.ws;
  pg8::Gemm g{(const bf16*)(ws + WS_Y), (const bf16*)(ws + (layer == 0 ? WS_WOUTE : WS_WOUTO)), NTOK, DM, DM};
  pg8::StaticOrder S; S.init(NTOK, DM, (int)gridDim.x, (int)blockIdx.x);
  EpiOutProj E{layer == 0 ? p.in[I_X] : p.out, p.out, (bf16*)(ws + WS_ACT), p.in[I_PLE_NORM_GAIN] + layer * DM, (float*)(ws + WS_SS) + (layer == 0 ? 1 : 2) * NTOK};
  pg8::gemm_phase<EpiOutProj, pg8::StaticOrder, true, true>((PG8_LAS unsigned char*)lds, g, S, E);
}

struct EpiPleProj {
  static constexpr bool PERM = false, AFTER_DRAIN = false;
  bf16* PT;
  DI void operator()(const f32x4 (&acc)[2][2][4][2], const pg8::Unit& u, int wr, int wc, int fr, int fq) const {
#pragma unroll
    for (int ai = 0; ai < 2; ++ai)
#pragma unroll
      for (int m = 0; m < 4; ++m) {
        const int row = u.pm * 256 + ai * 128 + wr * 64 + m * 16 + fr;
#pragma unroll
        for (int bj = 0; bj < 2; ++bj)
#pragma unroll
          for (int n = 0; n < 2; ++n) { const f32x4 a = acc[ai][bj][m][n]; u32x2 w; w.x = cvtpk(a.x, a.y); w.y = cvtpk(a.z, a.w); *(u32x2*)(PT + (size_t)row * DM + u.pn * 256 + bj * 128 + wc * 32 + n * 16 + fq * 4) = w; }
      }
  }
};
struct EpiPleGate {
  static constexpr bool PERM = false, AFTER_DRAIN = false;
  const bf16* PT; float* out; const float* ssx; float* ss1; bf16* H; const float* ng1; int layer;
  DI void operator()(const f32x4 (&acc)[2][2][4][2], const pg8::Unit& u, int wr, int wc, int fr, int fq) const {
#pragma unroll
    for (int ai = 0; ai < 2; ++ai)
#pragma unroll
      for (int m = 0; m < 4; ++m) {
        const int row = u.pm * 256 + ai * 128 + wr * 64 + m * 16 + fr; float rs = 0.f;
        const float rstd = rsqrtf(ssx[row] * (1.f / DM) + EPS);
#pragma unroll
        for (int bj = 0; bj < 2; ++bj)
#pragma unroll
          for (int n = 0; n < 2; ++n) {
            const int col = u.pn * 256 + bj * 128 + wc * 32 + n * 16 + fq * 4; const size_t off = (size_t)row * DM + col;
            f32x4 g;
#pragma unroll
            for (int j = 0; j < 4; ++j) g[j] = 1.f / (1.f + __expf(-rstd * acc[ai][bj][m][n][j]));
            const u32x2 pw = *(const u32x2*)(PT + off); f32x4 pp; pp.x = __uint_as_float(pw.x << 16); pp.y = __uint_as_float(pw.x & 0xffff0000u); pp.z = __uint_as_float(pw.y << 16); pp.w = __uint_as_float(pw.y & 0xffff0000u);
            const f32x4 xn = *(const f32x4*)(out + off) + pp * g;
            *(f32x4*)(out + off) = xn;
            if (layer == 0) {
              rs += xn.x * xn.x + xn.y * xn.y + xn.z * xn.z + xn.w * xn.w;
              const f32x4 gg = *(const f32x4*)(ng1 + col);
              u32x2 w; w.x = cvtpk(xn.x * gg.x, xn.y * gg.y); w.y = cvtpk(xn.z * gg.z, xn.w * gg.w); *(u32x2*)(H + off) = w;
            }
          }
        if (layer == 0) { rs += __shfl_xor(rs, 16); rs += __shfl_xor(rs, 32); if (fq == 0) atomicAdd(ss1 + row, rs); }
        asm volatile("" ::: "memory");
      }
  }
};
DI void phase_ple(const Params& p, int layer, char* lds) {
  unsigned char* ws = p.ws;
  bf16* PT = (bf16*)(ws + WS_PE);
  pg8::StaticOrder S; S.init(NTOK, DM, (int)gridDim.x, (int)blockIdx.x);
  { pg8::Gemm g{(const bf16*)(ws + WS_PBF) + (size_t)layer * NTOK * 256, (const bf16*)(ws + (layer == 0 ? WS_WP0 : WS_WP1)), NTOK, DM, 256};
    EpiPleProj E{PT};
    pg8::gemm_phase<EpiPleProj, pg8::StaticOrder, true, true>((PG8_LAS unsigned char*)lds, g, S, E); }
  { pg8::Gemm g{(const bf16*)(ws + WS_ACT), (const bf16*)(ws + (layer == 0 ? WS_WG0 : WS_WG1)), NTOK, DM, DM};
    EpiPleGate E{PT, p.out, (const float*)(ws + WS_SS) + (layer == 0 ? 1 : 2) * NTOK, (float*)(ws + WS_SS), (bf16*)(ws + WS_Y), p.in[I_NORM_GAIN] + DM, layer};
    pg8::gemm_phase<EpiPleGate, pg8::StaticOrder, true, true>((PG8_LAS unsigned char*)lds, g, S, E); }
}

DI float half_max(float v) { auto rr = __builtin_amdgcn_permlane32_swap(__float_as_uint(v), __float_as_uint(v), false, false); return fmaxf(__uint_as_float(rr[0]), __uint_as_float(rr[1])); }
template <int DVB, bool MASKED = true>
DI void attn_step32(const bf16* Kt, int KP, const bf16* Vt, int VP, const bf16x8 (&qf)[4], f32x16 (&o)[DVB], float& m, float& l, unsigned vmask, float c2, int lane) {
  const int r32 = lane & 31, h = lane >> 5;
  f32x16 s;
#pragma unroll
  for (int i = 0; i < 16; ++i) s[i] = 0.f;
#pragma unroll
  for (int t = 0; t < 4; ++t) { const bf16x8 kf = *(const bf16x8*)(Kt + r32 * KP + t * 16 + h * 8); s = mfma32(kf, qf[t], s); }
  float mx = -INFINITY;
#pragma unroll
  for (int i = 0; i < 16; ++i) { if (MASKED) { s[i] = ((vmask >> i) & 1u) ? s[i] : -INFINITY; } mx = fmaxf(mx, s[i]); }
  mx = half_max(mx);
  const float mn = fmaxf(m, mx * c2);
  if (__any(mn > m)) {
    const float alpha = fexp2(m - mn); l *= alpha;
#pragma unroll
    for (int d = 0; d < DVB; ++d)
#pragma unroll
      for (int i = 0; i < 16; ++i) o[d][i] *= alpha;
    m = mn;
  }
  float ps = 0.f; const float negm = -m;
#pragma unroll
  for (int i = 0; i < 16; ++i) { const float pv = fexp2(__builtin_fmaf(s[i], c2, negm)); s[i] = pv; ps += pv; }
  l += ps;
  bf16x8 pf[2];
  { u32x4 a, b; a.x = cvtpk(s[0], s[1]); a.y = cvtpk(s[2], s[3]); a.z = cvtpk(s[4], s[5]); a.w = cvtpk(s[6], s[7]);
    b.x = cvtpk(s[8], s[9]); b.y = cvtpk(s[10], s[11]); b.z = cvtpk(s[12], s[13]); b.w = cvtpk(s[14], s[15]);
    pf[0] = __builtin_bit_cast(bf16x8, a); pf[1] = __builtin_bit_cast(bf16x8, b); }
  const int i16 = lane & 15, q = i16 >> 2, pp = i16 & 3, blk = (lane >> 4) & 1;
#pragma unroll
  for (int d = 0; d < DVB; ++d)
#pragma unroll
    for (int sk = 0; sk < 2; ++sk) {
      const s16x4 lo = trread(Vt + (16 * sk + 4 * h + q) * VP + 32 * d + 16 * blk + 4 * pp);
      const s16x4 hi = trread(Vt + (16 * sk + 8 + 4 * h + q) * VP + 32 * d + 16 * blk + 4 * pp);
      const bf16x8 vf = __builtin_shufflevector(lo, hi, 0, 1, 2, 3, 4, 5, 6, 7);
      o[d] = mfma32(vf, pf[sk], o[d]);
    }
}

DI unsigned row_range_mask(int lo, int hi) {
  lo = lo < 0 ? 0 : lo; hi = hi > 31 ? 31 : hi;
  if (hi < lo) return 0u;
  const unsigned upto_hi = (hi >= 31) ? 0xffffffffu : ((1u << (hi + 1)) - 1u);
  return upto_hi & ~((1u << lo) - 1u);
}
DI unsigned lane_rows(unsigned m32, int h) {
  const unsigned t = m32 >> (4 * h);
  return (t & 0xFu) | ((t >> 4) & 0xF0u) | ((t >> 8) & 0xF00u) | ((t >> 12) & 0xF000u);
}
constexpr int WP = 72;
constexpr int WAVE_LDS = 2 * 32 * WP * 2 + 512;

struct KVRegs { u32x4 k[4], v[4]; };
DI void kv_store(const KVRegs& R, bf16* Ks, bf16* Vs, int lane) {
#pragma unroll
  for (int i = 0; i < 4; ++i) { const int row = (lane >> 3) + 8 * i, ch = lane & 7; *(u32x4*)(Ks + row * WP + ch * 8) = R.k[i]; *(u32x4*)(Vs + row * WP + ch * 8) = R.v[i]; }
}

DI void band_load(KVRegs& R, const bf16* Kg, const bf16* Vg, int NP, int kstart, int dil, int roff, int lane) {
#pragma unroll
  for (int i = 0; i < 4; ++i) {
    const int row = (lane >> 3) + 8 * i, ch = lane & 7; int k = kstart + row; if (k < 0) k = 0;
    const size_t off = (size_t)(dil * k + roff) * NP + ch * 8;
    R.k[i] = *(const u32x4*)(Kg + off); R.v[i] = *(const u32x4*)(Vg + off);
  }
}
template <int DVB>
DI void band_run(const bf16* Kg, const bf16* Vg, int NP, int kbase, int nsteps, int dil, int roff, int qidx, int win,
                 const bf16x8 (&qf)[4], f32x16 (&o)[DVB], float& m, float& l, float c2, bf16* Ks, bf16* Vs, int lane) {
  const int h = lane >> 5;
  KVRegs R; band_load(R, Kg, Vg, NP, kbase, dil, roff, lane);
  for (int j = 0; j < nsteps; ++j) {
    lds_fence();
    kv_store(R, Ks, Vs, lane);
    lds_fence();
    if (j + 1 < nsteps) band_load(R, Kg, Vg, NP, kbase + 32 * (j + 1), dil, roff, lane);
    const int kb = kbase + 32 * j, lo_r = (qidx - win > 0 ? qidx - win : 0) - kb;
    const unsigned vm = lane_rows(row_range_mask(lo_r, qidx - kb), h);
    attn_step32<DVB>(Ks, WP, Vs, WP, qf, o, m, l, vm, c2, lane);
  }
}

DI void write_o64(const f32x16 (&o)[2], float linv, const bf16* gate_row, bf16* y_row, int h) {
#pragma unroll
  for (int d = 0; d < 2; ++d)
#pragma unroll
    for (int g = 0; g < 4; ++g) {
      const int dd = 32 * d + 8 * g + 4 * h;
      const u32x2 gv = *(const u32x2*)(gate_row + dd);
      const float g0 = __uint_as_float(gv.x << 16), g1 = __uint_as_float(gv.x & 0xffff0000u), g2 = __uint_as_float(gv.y << 16), g3 = __uint_as_float(gv.y & 0xffff0000u);
      u32x2 w; w.x = cvtpk(o[d][4 * g] * linv * g0, o[d][4 * g + 1] * linv * g1); w.y = cvtpk(o[d][4 * g + 2] * linv * g2, o[d][4 * g + 3] * linv * g3);
      *(u32x2*)(y_row + dd) = w;
    }
}

DI void load_q(bf16x8 (&qf)[4], const bf16* qrow, int h) {
#pragma unroll
  for (int t = 0; t < 4; ++t) qf[t] = *(const bf16x8*)(qrow + t * 16 + h * 8);
}
template <int DVB> DI void zero_o(f32x16 (&o)[DVB]) {
#pragma unroll
  for (int d = 0; d < DVB; ++d)
#pragma unroll
    for (int i = 0; i < 16; ++i) o[d][i] = 0.f;
}

DI void mixerB_tile(const Params& p, int item, bf16* Ks, bf16* Vs, int lane) {
  const bf16* PE = (const bf16*)(p.ws + WS_PE); bf16* Y = (bf16*)(p.ws + WS_Y);
  const int qblk = item & 255, head = (item >> 8) & 7, b = item >> 11;
  const int r32 = lane & 31, h = lane >> 5, q0 = qblk * 32, kvh = head >> 2;
  const size_t rowb = (size_t)b * SEQ;
  bf16x8 qf[4]; load_q(qf, PE + (rowb + q0 + r32) * NPE + E_BQ + head * 64, h);
  f32x16 o[2]; zero_o<2>(o);
  const float sink2 = p.in[I_B_SINKS][head] * LOG2E;
  float m = sink2, l = (h == 0) ? 1.f : 0.f;
  band_run<2>(PE + rowb * NPE + E_BK + kvh * 64, PE + rowb * NPE + E_BV + kvh * 64, NPE, q0 - 128, 5, 1, 0, q0 + r32, 127, qf, o, m, l, 0.125f * LOG2E, Ks, Vs, lane);
  l += __shfl_xor(l, 32);
  const size_t tok = rowb + q0 + r32;
  write_o64(o, 1.f / l, PE + tok * NPE + E_BG + head * 64, Y + tok * DM + 512 + head * 64, h);
}

DI void mixerC_tile(const Params& p, int item, bf16* Ks, bf16* Vs, int lane) {
  const bf16* PO = (const bf16*)(p.ws + WS_PE); bf16* Y = (bf16*)(p.ws + WS_Y);
  const int qt = item & 15, r16 = (item >> 4) & 15, head = (item >> 8) & 7, b = item >> 11;
  const int r32 = lane & 31, h = lane >> 5, qi0 = qt * 32;
  const size_t rowb = (size_t)b * SEQ;
  const int t = 16 * (qi0 + r32) + r16;
  bf16x8 qf[4]; load_q(qf, PO + (rowb + t) * NPO + O_CQ + head * 64, h);
  f32x16 o[2]; zero_o<2>(o);
  float m = -1e30f, l = 0.f;
  const bf16* Kg = PO + rowb * NPO + O_CK + head * 64; const bf16* Vg = PO + rowb * NPO + O_CV + head * 64;
  const float c2 = 0.125f * LOG2E;
  band_run<2>(Kg, Vg, NPO, qi0 - 128, 5, 16, r16, qi0 + r32, 128, qf, o, m, l, c2, Ks, Vs, lane);
  band_run<2>(Kg, Vg, NPO, 4 * qi0 + (r16 >> 2) - 128, 8, 4, r16 & 3, 4 * (qi0 + r32) + (r16 >> 2), 128, qf, o, m, l, c2, Ks, Vs, lane);
  band_run<2>(Kg, Vg, NPO, 16 * qi0 + r16 - 128, 20, 1, 0, t, 128, qf, o, m, l, c2, Ks, Vs, lane);
  l += __shfl_xor(l, 32);
  const size_t tok = rowb + t;
  write_o64(o, 1.f / l, PO + tok * NPO + O_CG + head * 64, Y + tok * DM + head * 64, h);
}

DI void mixerA_item(const Params& p, int item, bf16* Ks, bf16* Vs, int lane) {
  const bf16* PE = (const bf16*)(p.ws + WS_PE); bf16* Y = (bf16*)(p.ws + WS_Y);
  const unsigned short* SEL = (const unsigned short*)(p.ws + WS_SEL) + (size_t)item * 256;
  const int t = item & (SEQ - 1), b = item >> 13;
  const int r32 = lane & 31, h = lane >> 5, head = r32 & 7;
  const size_t rowb = (size_t)b * SEQ;
  const int count = (t + 1 < 256) ? t + 1 : 256, nsteps = (count + 31) >> 5;
  bf16x8 qf[4]; load_q(qf, PE + (size_t)item * NPE + E_AQ + head * 64, h);
  f32x16 o[2]; zero_o<2>(o);
  float m = -1e30f, l = 0.f;
  const bf16* Kg = PE + rowb * NPE + E_AK; const bf16* Vg = PE + rowb * NPE + E_AV;
  KVRegs R;
  unsigned short* sel_l = (unsigned short*)(Vs + 32 * WP);
  lds_fence();
  *(u32x2*)(sel_l + 4 * lane) = *(const u32x2*)(SEL + 4 * lane);
  lds_fence();
#define A_LOAD(j) do { _Pragma("unroll") for (int i = 0; i < 4; ++i) { const int row = (lane >> 3) + 8 * i, ch = lane & 7, e = 32 * (j) + row; \
      const int tokk = (e < count) ? (int)sel_l[e] : 0; const size_t off = (size_t)tokk * NPE + ch * 8; R.k[i] = *(const u32x4*)(Kg + off); R.v[i] = *(const u32x4*)(Vg + off); } } while (0)
  A_LOAD(0);
  for (int j = 0; j < nsteps; ++j) {
    lds_fence();
    kv_store(R, Ks, Vs, lane);
    lds_fence();
    if (j + 1 < nsteps) A_LOAD(j + 1);
    const unsigned vm = lane_rows(row_range_mask(0, count - 1 - 32 * j), h);
    attn_step32<2>(Ks, WP, Vs, WP, qf, o, m, l, vm, 0.125f * LOG2E, lane);
  }
#undef A_LOAD
  l += __shfl_xor(l, 32);
  if (r32 < 8) write_o64(o, 1.f / l, PE + (size_t)item * NPE + E_AG + head * 64, Y + (size_t)item * DM + head * 64, h);
}

DI unsigned f2ord(float f) { f += 0.f; const unsigned u = __float_as_uint(f); return (u & 0x80000000u) ? ~u : (u | 0x80000000u); }
DI int block_excl_scan(int v, int* tmp, int* tot) {
  const int lane = threadIdx.x & 63, wid = threadIdx.x >> 6;
  int inc = v;
#pragma unroll
  for (int o = 1; o < 64; o <<= 1) { const int u = __shfl_up(inc, o); if (lane >= o) inc += u; }
  if (lane == 63) tmp[wid] = inc;
  __syncthreads();
  int base = 0, total = 0;
#pragma unroll
  for (int w = 0; w < 8; ++w) { const int x = tmp[w]; if (w < wid) base += x; total += x; }
  *tot = total;
  return base + inc - v;
}

DI float dpp_sum8(float v) {
  v += __builtin_bit_cast(float, __builtin_amdgcn_mov_dpp(__builtin_bit_cast(int, v), 0xB1, 0xF, 0xF, true));
  v += __builtin_bit_cast(float, __builtin_amdgcn_mov_dpp(__builtin_bit_cast(int, v), 0x4E, 0xF, 0xF, true));
  v += __builtin_bit_cast(float, __builtin_amdgcn_mov_dpp(__builtin_bit_cast(int, v), 0x141, 0xF, 0xF, true));
  return v;
}
DI void hist_find(const int* hist, int* misc, int need, int& digit, int& nneed, int& cnt) {
  const int tid = threadIdx.x;
  typedef int i32x4 __attribute__((ext_vector_type(4)));
  const i32x4 h0 = *(const i32x4*)(hist + tid * 8), h1 = *(const i32x4*)(hist + tid * 8 + 4);
  int hh[8] = {h0.x, h0.y, h0.z, h0.w, h1.x, h1.y, h1.z, h1.w}; int tot = 0;
#pragma unroll
  for (int k = 0; k < 8; ++k) tot += hh[k];
  int total; const int ex = block_excl_scan(tot, misc, &total);
  int above = total - ex - tot;
#pragma unroll
  for (int k = 7; k >= 0; --k) { const int c = hh[k]; if (above < need && above + c >= need) { misc[16] = tid * 8 + k; misc[17] = need - above; misc[18] = c; } above += c; }
  __syncthreads();
  digit = misc[16]; nneed = misc[17]; cnt = misc[18];
  __syncthreads();
}
DI unsigned long long mkcmp(float v, int idx) { return ((unsigned long long)f2ord(v) << 16) | ((unsigned long long)(8191 - idx) << 3); }
DI float ord2f(unsigned k) { return __uint_as_float((k & 0x80000000u) ? (k ^ 0x80000000u) : ~k); }
DI float half_sum(float v) { auto rr = __builtin_amdgcn_permlane32_swap(__float_as_uint(v), __float_as_uint(v), false, false); return __uint_as_float(rr[0]) + __uint_as_float(rr[1]); }

constexpr int CL_CAP = 512;
DI void select_slow(const float* scq, int n, unsigned short* out, float lo, float hi, int* hist, int* misc, unsigned long long* clist) {
  const int tid = opaque_tid();
    const float scale = (hi > lo) ? 4095.f / (hi - lo) : 0.f;
    for (int i = tid; i < 4096; i += 512) hist[i] = 0;
    if (tid == 0) misc[20] = 0;
    __syncthreads();
    float val[16]; int bin[16];
#pragma unroll
    for (int i = 0; i < 16; ++i) { const int idx = tid + 512 * i; const float v = (idx < n) ? scq[idx] : lo; val[i] = v;
      int bb = (int)((v - lo) * scale); bb = bb < 0 ? 0 : (bb > 4095 ? 4095 : bb); bin[i] = bb; if (idx < n) atomicAdd(&hist[bb], 1); }
    __syncthreads();
    int bstar, need, cnt;
    hist_find(hist, misc, 256, bstar, need, cnt);
    unsigned long long T = 0ull;
    if (cnt != need) {
      if (cnt <= CL_CAP) {
#pragma unroll
        for (int i = 0; i < 16; ++i) { const int idx = tid + 512 * i; if (idx < n && bin[i] == bstar) { const int slot = atomicAdd(&misc[20], 1); clist[slot] = mkcmp(val[i], idx); } }
        __syncthreads();
        if (tid < cnt) { const unsigned long long c = clist[tid]; int rank = 0; for (int jx = 0; jx < cnt; ++jx) rank += (clist[jx] > c) ? 1 : 0;
          if (rank == need - 1) { misc[21] = (int)(unsigned)(c & 0xffffffffull); misc[22] = (int)(unsigned)(c >> 32); } }
        __syncthreads();
        T = ((unsigned long long)(unsigned)misc[22] << 32) | (unsigned long long)(unsigned)misc[21];
      } else {
        unsigned long long prefix = 0ull; int shift = 36;
        for (int pass = 0; pass < 4; ++pass) {
          for (int i = tid; i < 4096; i += 512) hist[i] = 0;
          __syncthreads();
#pragma unroll
          for (int i = 0; i < 16; ++i) { const int idx = tid + 512 * i; if (idx < n && bin[i] == bstar) { const unsigned long long c = mkcmp(val[i], idx); if (pass == 0 || (c >> (shift + 12)) == prefix) atomicAdd(&hist[(int)((c >> shift) & 4095ull)], 1); } }
          __syncthreads();
          int digit, nneed, c2;
          hist_find(hist, misc, need, digit, nneed, c2);
          prefix = (prefix << 12) | (unsigned long long)digit; need = nneed;
          if (c2 == need) break;
          shift -= 12;
        }
        T = prefix << shift;
      }
    }
    int mycnt = 0; unsigned selm = 0;
#pragma unroll
    for (int i = 0; i < 16; ++i) { const int idx = tid + 512 * i;
      bool sel = false;
      if (idx < n) { if (bin[i] > bstar) sel = true; else if (bin[i] == bstar) sel = (mkcmp(val[i], idx) >= T); }
      if (sel) { ++mycnt; selm |= (1u << i); } }
    int total; int pos = block_excl_scan(mycnt, misc + 8, &total);
#pragma unroll
    for (int i = 0; i < 16; ++i) { if ((selm >> i) & 1u) { if (pos < 256) out[pos] = (unsigned short)(tid + 512 * i); ++pos; } }
    __syncthreads();
}

DI void selectA_item(const Params& p, int item, char* lds) {
  const bf16* PE = (const bf16*)(p.ws + WS_PE);
  const float* IW = (const float*)(p.ws + WS_IW);
  unsigned short* SEL = (unsigned short*)(p.ws + WS_SEL);
  float* sc = (float*)lds;
  int* hist = (int*)(lds + 4 * 8192 * 4);
  int* misc = hist + 4096;
  unsigned* mm = (unsigned*)(misc + 24);
  unsigned long long* clist = (unsigned long long*)(misc + 96);
  const int tid = opaque_tid(), lane = tid & 63, wid = tid >> 6, r32 = lane & 31, h = lane >> 5;
  const int b = item >> 11, t0 = (item & 2047) * 4;
  const size_t rowb = (size_t)b * SEQ;
  const int nk = t0 + 4, ntile = (nk + 31) >> 5;
  if (tid < 4) { mm[tid * 2] = 0xFFFFFFFFu; mm[tid * 2 + 1] = 0u; }
  lds_barrier();
  bf16x8 qf[4]; load_q(qf, PE + (rowb + t0 + (r32 >> 3)) * NPE + E_IQ + (r32 & 7) * 64, h);
  float wq[16];
#pragma unroll
  for (int i = 0; i < 16; ++i) wq[i] = IW[(rowb + t0 + (i >> 2)) * 8 + (i & 3) + 4 * h] * 0.04419417382415922f;
  const bf16* Kt = (const bf16*)(p.ws + WS_IKS) + (size_t)b * 256 * 2048 + lane * 8;
  {
    bf16x8 kf[4], kn[4];
#pragma unroll
    for (int t = 0; t < 4; ++t) { kf[t] = (bf16x8){0, 0, 0, 0, 0, 0, 0, 0}; kn[t] = kf[t]; }
    if (wid < ntile) {
#pragma unroll
      for (int t = 0; t < 4; ++t) kf[t] = *(const bf16x8*)(Kt + (size_t)wid * 2048 + t * 512);
    }
    float lo0 = INFINITY, hi0 = -INFINITY, lo1 = INFINITY, hi1 = -INFINITY;
    for (int kt = wid; kt < ntile; kt += 8) {
      if (kt + 8 < ntile) {
#pragma unroll
        for (int t = 0; t < 4; ++t) kn[t] = *(const bf16x8*)(Kt + (size_t)(kt + 8) * 2048 + t * 512);
      }
      f32x16 s;
#pragma unroll
      for (int i = 0; i < 16; ++i) s[i] = 0.f;
#pragma unroll
      for (int t = 0; t < 4; ++t) s = mfma32(qf[t], kf[t], s);
      float v[4];
#pragma unroll
      for (int q = 0; q < 4; ++q) {
        float a = wq[4 * q] * fmaxf(s[4 * q], 0.f);
#pragma unroll
        for (int jj = 1; jj < 4; ++jj) a += wq[4 * q + jj] * fmaxf(s[4 * q + jj], 0.f);
        v[q] = half_sum(a) + 0.f;
      }
      const float va = h ? v[2] : v[0], vb = h ? v[3] : v[1];
      const int key = kt * 32 + r32;
      sc[(2 * h) * 8192 + key] = va; sc[(2 * h + 1) * 8192 + key] = vb;
      lo0 = fminf(lo0, va); hi0 = fmaxf(hi0, va); lo1 = fminf(lo1, vb); hi1 = fmaxf(hi1, vb);
#pragma unroll
      for (int t = 0; t < 4; ++t) kf[t] = kn[t];
    }
    if (wid < ntile) {
#pragma unroll
      for (int o = 1; o < 32; o <<= 1) { lo0 = fminf(lo0, __shfl_xor(lo0, o)); hi0 = fmaxf(hi0, __shfl_xor(hi0, o)); lo1 = fminf(lo1, __shfl_xor(lo1, o)); hi1 = fmaxf(hi1, __shfl_xor(hi1, o)); }
      if (r32 == 0) { atomicMin(&mm[(2 * h) * 2], f2ord(lo0)); atomicMax(&mm[(2 * h) * 2 + 1], f2ord(hi0)); atomicMin(&mm[(2 * h + 1) * 2], f2ord(lo1)); atomicMax(&mm[(2 * h + 1) * 2 + 1], f2ord(hi1)); }
    }
  }
  lds_barrier();
  {
    const int g = wid >> 1, gt = tid & 127, upper = wid & 1;
    const int t = t0 + g, n = t + 1;
    const bool big = n > 256;
    const float* scq = sc + g * 8192;
    unsigned short* out = SEL + (rowb + t) * 256;
    int* histq = hist + g * 1024;
    unsigned long long* clq = clist + g * 128;
    int* mq = misc + 32 + g * 8;
    const float lo = ord2f(mm[g * 2]), hi = ord2f(mm[g * 2 + 1]);
    const float scale = (hi > lo) ? 1023.f / (hi - lo) : 0.f;
    for (int i = gt; i < 1024; i += 128) histq[i] = 0;
    if (gt == 0) { mq[0] = 0; mq[6] = 0; }
    lds_barrier();
    float uu[64];
#pragma unroll
    for (int i = 0; i < 64; ++i) { const int idx = gt + 128 * i; const float v = (idx < n) ? scq[idx] : lo; const float u = (v - lo) * scale; uu[i] = u;
      if (big && idx < n) { int bb = (int)u; bb = bb > 1023 ? 1023 : bb; atomicAdd(&histq[bb], 1); } }
    lds_barrier();
    typedef int i32x4 __attribute__((ext_vector_type(4)));
    const i32x4 h0 = *(const i32x4*)(histq + gt * 8), h1 = *(const i32x4*)(histq + gt * 8 + 4);
    const int hh[8] = {h0.x, h0.y, h0.z, h0.w, h1.x, h1.y, h1.z, h1.w};
    int tot = 0;
#pragma unroll
    for (int k = 0; k < 8; ++k) tot += hh[k];
    int inc = tot;
#pragma unroll
    for (int o = 1; o < 64; o <<= 1) { const int ux = __shfl_down(inc, o); if (lane + o < 64) inc += ux; }
    if (lane == 0) misc[wid] = inc;
    lds_barrier();
    {
      int above = inc - tot + (upper ? 0 : misc[wid + 1]);
      if (big) {
#pragma unroll
        for (int k = 7; k >= 0; --k) { const int c = hh[k]; if (above < 256 && above + c >= 256) { mq[1] = gt * 8 + k; mq[2] = 256 - above; mq[3] = c; } above += c; }
      }
    }
    lds_barrier();
    const int bstar = mq[1], need = mq[2], cnt = mq[3];
    const float flo = (float)bstar, fhi = (bstar >= 1023) ? INFINITY : (float)(bstar + 1);
    const bool tie = big && cnt != need;
    if (tie) {
      if (cnt <= 128) {
#pragma unroll
        for (int i = 0; i < 64; ++i) { const int idx = gt + 128 * i; if (idx < n && uu[i] >= flo && uu[i] < fhi) { const int slot = atomicAdd(&mq[0], 1); clq[slot] = mkcmp(scq[idx], idx); } }
      } else if (gt == 0) mq[6] = 1;
    }
    lds_barrier();
    if (tie && cnt <= 128 && gt < cnt) { const unsigned long long c = clq[gt]; int rank = 0; for (int jx = 0; jx < cnt; ++jx) rank += (clq[jx] > c) ? 1 : 0;
      if (rank == need - 1) { mq[4] = (int)(unsigned)(c & 0xffffffffull); mq[5] = (int)(unsigned)(c >> 32); } }
    lds_barrier();
    const unsigned long long T = tie ? (((unsigned long long)(unsigned)mq[5] << 32) | (unsigned long long)(unsigned)mq[4]) : 0ull;
    const bool fast = big && !(tie && cnt > 128);
    unsigned long long selm = 0ull;
    if (fast) {
#pragma unroll
      for (int i = 0; i < 64; ++i) { const int idx = gt + 128 * i;
        if (idx < n) { const float u = uu[i]; bool sel = u >= fhi; if (!sel && u >= flo) sel = !tie || (mkcmp(scq[idx], idx) >= T); if (sel) selm |= (1ull << i); } }
    }
    const int mycnt = __popcll(selm);
    int pinc = mycnt;
#pragma unroll
    for (int o = 1; o < 64; o <<= 1) { const int ux = __shfl_up(pinc, o); if (lane >= o) pinc += ux; }
    if (lane == 63) misc[8 + wid] = pinc;
    lds_barrier();
    if (fast) {
      int pos = pinc - mycnt + (upper ? misc[8 + wid - 1] : 0);
      while (selm) { const int i = __ffsll((long long)selm) - 1; selm &= selm - 1ull; if (pos < 256) out[pos] = (unsigned short)(gt + 128 * i); ++pos; }
    } else if (!big) {
      for (int i = gt; i < n; i += 128) out[i] = (unsigned short)i;
    }
    lds_barrier();
  }
  for (int q = 0; q < 4; ++q) {
    if (misc[32 + q * 8 + 6]) { const int t = t0 + q; select_slow(sc + q * 8192, t + 1, SEL + (rowb + t) * 256, ord2f(mm[q * 2]), ord2f(mm[q * 2 + 1]), hist, misc, clist); }
  }
  lds_barrier();
}

constexpr int DKP = 72, DVP = 136;
constexpr int D_STAGE = (64 * DKP * 2 + 64 * DVP) * 2;
DI void mixerD_unit(const Params& p, int b, int head, int qb, char* lds) {
  const bf16* PO = (const bf16*)(p.ws + WS_PE); bf16* Y = (bf16*)(p.ws + WS_Y);
  const int tid = opaque_tid(), lane = tid & 63, wid = tid >> 6, r32 = lane & 31, h = lane >> 5;
  const int map = wid & 1, qsub = wid >> 1;
  const size_t rowb = (size_t)b * SEQ;
  const int qpos = 128 * qb + 32 * qsub + r32;
  bf16x8 qf[4]; load_q(qf, PO + (rowb + qpos) * NPO + O_DQ + (2 * head + map) * 64, h);
  f32x16 o[4]; zero_o<4>(o);
  float m = -1e30f, l = 0.f;
  const int nsteps = 2 * qb + 2;
  const bf16* K1g = PO + rowb * NPO + O_DK + (2 * head) * 64;
  const bf16* K2g = K1g + 64;
  const bf16* Vg = PO + rowb * NPO + O_DV + head * 128;
  u32x4 rk1, rk2, rv[2];
#define D_LOAD(j) do { const int row = tid >> 3, ch = tid & 7; const size_t off = (size_t)((j) * 64 + row) * NPO + ch * 8; rk1 = *(const u32x4*)(K1g + off); rk2 = *(const u32x4*)(K2g + off); \
    _Pragma("unroll") for (int i = 0; i < 2; ++i) { const int c = tid + 512 * i, vr = c >> 4, vc = c & 15; rv[i] = *(const u32x4*)(Vg + (size_t)((j) * 64 + vr) * NPO + vc * 8); } } while (0)
  __syncthreads();
  D_LOAD(0);
  for (int j = 0; j < nsteps; ++j) {
    char* st = lds + (j & 1) * D_STAGE;
    bf16* K1s = (bf16*)st; bf16* K2s = K1s + 64 * DKP; bf16* Vs = K2s + 64 * DKP;
    { const int row = tid >> 3, ch = tid & 7; *(u32x4*)(K1s + row * DKP + ch * 8) = rk1; *(u32x4*)(K2s + row * DKP + ch * 8) = rk2;
#pragma unroll
      for (int i = 0; i < 2; ++i) { const int c = tid + 512 * i, vr = c >> 4, vc = c & 15; *(u32x4*)(Vs + vr * DVP + vc * 8) = rv[i]; } }
    __syncthreads();
    if (j + 1 < nsteps) D_LOAD(j + 1);
    const bf16* Ks = map ? K2s : K1s;
#pragma unroll
    for (int sub = 0; sub < 2; ++sub) {
      const int k0 = j * 64 + sub * 32;
      if (k0 <= 128 * qb + 32 * qsub + 31) {
        if (k0 + 31 <= 128 * qb + 32 * qsub) {
          attn_step32<4, false>(Ks + sub * 32 * DKP, DKP, Vs + sub * 32 * DVP, DVP, qf, o, m, l, 0xffffu, 0.125f * LOG2E, lane);
        } else {
          unsigned vm = 0;
#pragma unroll
          for (int i = 0; i < 16; ++i) if (k0 + crow(i, h) <= qpos) vm |= (1u << i);
          attn_step32<4, true>(Ks + sub * 32 * DKP, DKP, Vs + sub * 32 * DVP, DVP, qf, o, m, l, vm, 0.125f * LOG2E, lane);
        }
      }
    }
  }
#undef D_LOAD
  l += __shfl_xor(l, 32);
  const float linv = 1.f / l;
  __syncthreads();
  float* xch = (float*)lds + qsub * 4096;
  if (map == 1) {
#pragma unroll
    for (int d = 0; d < 4; ++d)
#pragma unroll
      for (int i = 0; i < 16; ++i) xch[(d * 16 + i) * 64 + lane] = o[d][i] * linv;
  }
  __syncthreads();
  if (map == 0) {
    const float lam = *(const float*)(p.ws + WS_LAM);
    float ssq = 0.f;
#pragma unroll
    for (int d = 0; d < 4; ++d)
#pragma unroll
      for (int i = 0; i < 16; ++i) { const float a = o[d][i] * linv - lam * xch[(d * 16 + i) * 64 + lane]; o[d][i] = a; ssq += a * a; }
    ssq += __shfl_xor(ssq, 32);
    const float lambda_init = 0.8f - 0.6f * expf(-0.3f);
    const float rn = rsqrtf(ssq * (1.f / 128.f) + EPS) * (1.f - lambda_init);
    const size_t tok = rowb + qpos;
    const bf16* gate = PO + tok * NPO + O_DG + head * 128;
    bf16* y = Y + tok * DM + 512 + head * 128;
    const float* sg = p.in[I_SUB_GAIN];
#pragma unroll
    for (int d = 0; d < 4; ++d)
#pragma unroll
      for (int g = 0; g < 4; ++g) {
        const int dd = 32 * d + 8 * g + 4 * h;
        const u32x2 gv = *(const u32x2*)(gate + dd); const f32x4 s4 = *(const f32x4*)(sg + dd);
        const float g0 = __uint_as_float(gv.x << 16), g1 = __uint_as_float(gv.x & 0xffff0000u), g2 = __uint_as_float(gv.y << 16), g3 = __uint_as_float(gv.y & 0xffff0000u);
        u32x2 w; w.x = cvtpk(o[d][4 * g] * rn * s4.x * g0, o[d][4 * g + 1] * rn * s4.y * g1); w.y = cvtpk(o[d][4 * g + 2] * rn * s4.z * g2, o[d][4 * g + 3] * rn * s4.w * g3);
        *(u32x2*)(y + dd) = w;
      }
  }
  __syncthreads();
}

#define XB_TMO      128
#define XB_XCNT(j)  (256  + 64 * (j))
#define XB_XSUB(j)  (1280 + 64 * (j))
#define XB_XGEN(j)  (2304 + 64 * (j))
#define XB_TOP      3328
#define XB_TOPGEN   3392
#define XCD_BAR_WORDS 3456
#define XB_SPIN_CAP (1u << 18)

__device__ __forceinline__ unsigned xb_ld(unsigned* p)              { return __hip_atomic_load(p, __ATOMIC_RELAXED, __HIP_MEMORY_SCOPE_AGENT); }
__device__ __forceinline__ unsigned xb_add(unsigned* p, unsigned v) { return __hip_atomic_fetch_add(p, v, __ATOMIC_RELAXED, __HIP_MEMORY_SCOPE_AGENT); }
__device__ __forceinline__ unsigned xb_xcc_id() { return (unsigned)__builtin_amdgcn_s_getreg((3 << 11) | 20) & 0xFu; }
#define XB_SPIN(cond, bar) do { unsigned _sp = 0; while (cond) { __builtin_amdgcn_s_sleep(1); \
    if ((++_sp & 255u) == 0u) { if (xb_ld(&(bar)[XB_TMO])) break; if (_sp > XB_SPIN_CAP) { atomicAdd(&(bar)[XB_TMO], 1u); break; } } } } while (0)

struct XcdBarrier {
    unsigned* bar; unsigned x;
    volatile LAS unsigned* st;
};

__device__ __forceinline__ XcdBarrier xcd_barrier_post(unsigned* bar, volatile LAS unsigned* st) {
    XcdBarrier b; b.bar = bar; b.x = xb_xcc_id(); b.st = st;
    if (threadIdx.x == 0) (void)xb_add(&bar[XB_XCNT(b.x)], 1u);
    return b;
}
__device__ __forceinline__ void xcd_barrier_complete(unsigned* bar, unsigned x, unsigned& nloc, unsigned& nx) {
    const unsigned G = gridDim.x * gridDim.y * gridDim.z;
    unsigned sum, cnt, mine, sp = 0u;
    for (;;) {
        sum = 0u; cnt = 0u; mine = 0u;
#pragma unroll
        for (unsigned j = 0; j < 16; ++j) { const unsigned c = xb_ld(&bar[XB_XCNT(j)]); sum += c; cnt += (c > 0u) ? 1u : 0u; mine = (j == x) ? c : mine; }
        if (sum == G) break;
        __builtin_amdgcn_s_sleep(1);
        if ((++sp & 255u) == 0u) { if (xb_ld(&bar[XB_TMO])) break; if (sp > XB_SPIN_CAP) { atomicAdd(&bar[XB_TMO], 1u); break; } }
    }
    nloc = mine > 0u ? mine : 1u; nx = cnt > 0u ? cnt : 1u;
}

__device__ __forceinline__ void xcd_barrier(const XcdBarrier& b) {
    asm volatile("s_waitcnt vmcnt(0)" ::: "memory");
    __syncthreads();
    if (threadIdx.x == 0) {
        unsigned* bar = b.bar;
        __builtin_amdgcn_s_waitcnt(0);
        unsigned nloc = b.st[0], nx = b.st[1];
        if (nloc == 0u) { xcd_barrier_complete(bar, b.x, nloc, nx); b.st[0] = nloc; b.st[1] = nx; }
        const unsigned old = xb_add(&bar[XB_XSUB(b.x)], 1u);
        const unsigned gen = old / nloc;
        if (old + 1u == (gen + 1u) * nloc) {
            __builtin_amdgcn_fence(__ATOMIC_RELEASE, "agent");
            asm volatile("s_waitcnt vmcnt(0)" ::: "memory");
            const unsigned og = xb_add(&bar[XB_TOP], 1u);
            const unsigned tg = og / nx;
            if (og + 1u == (tg + 1u) * nx) xb_add(&bar[XB_TOPGEN], 1u);
            else XB_SPIN(xb_ld(&bar[XB_TOPGEN]) == tg, bar);
            __builtin_amdgcn_fence(__ATOMIC_ACQUIRE, "agent");
            xb_add(&bar[XB_XGEN(b.x)], 1u);
            asm volatile("s_waitcnt vmcnt(0)" ::: "memory");
        } else {
            XB_SPIN(xb_ld(&bar[XB_XGEN(b.x)]) == gen, bar);
            __builtin_amdgcn_fence(__ATOMIC_ACQUIRE, "agent");
            asm volatile("s_waitcnt vmcnt(0)" ::: "memory");
        }
    }
    __syncthreads();
}


__global__ void __launch_bounds__(NTHREADS) fwd_kernel(Params p) {
  extern __shared__ __attribute__((aligned(16))) char smem[];
  cg::grid_group grid = cg::this_grid();
  char* lds = smem;
  volatile LAS unsigned* xb_st = (volatile LAS unsigned*)((LAS char*)smem + (LDS_BYTES - 16));
  if (threadIdx.x < 2) xb_st[threadIdx.x] = 0u;
  __syncthreads();
  const XcdBarrier xbar = xcd_barrier_post((unsigned*)(p.ws + WS_BAR), xb_st);
#define FRESH_IDS const int tid = opaque_tid(), lane = tid & 63, wid = tid >> 6; const int gw = blockIdx.x * 8 + wid, ngw = gridDim.x * 8; bf16* Ks = (bf16*)(lds + wid * WAVE_LDS); bf16* Vs = Ks + 32 * WP; (void)gw; (void)ngw; (void)Ks; (void)Vs; (void)lane;

  phase_prologue(p, lds);
  if (p.ws == nullptr) grid.sync();
  xcd_barrier(xbar);
  for (int rep = 0; rep < REP_GEMM; ++rep) phase_inproj(p, 0, lds);
  xcd_barrier(xbar);
#if EN_A
  for (int rep = 0; rep < REP_SELA; ++rep) for (int k = 0; k * (int)gridDim.x < 2 * 2048; ++k) { const int it = k * (int)gridDim.x + ((k & 1) ? (int)gridDim.x - 1 - (int)blockIdx.x : (int)blockIdx.x); if (it < 2 * 2048) selectA_item(p, it, lds); }
  xcd_barrier(xbar);
  { FRESH_IDS for (int rep = 0; rep < REP_AATT; ++rep) for (int it = gw; it < NTOK; it += ngw) mixerA_item(p, it, Ks, Vs, lane); }
#else
  { unsigned* y = (unsigned*)(p.ws + WS_Y); for (int i = blockIdx.x * NTHREADS + (int)threadIdx.x; i < NTOK * 256; i += gridDim.x * NTHREADS) { const int row = i >> 8, c = i & 255; y[row * 512 + c] = 0u; } }
#endif
#if EN_B
  { FRESH_IDS for (int it = gw; it < 4096; it += ngw) mixerB_tile(p, it, Ks, Vs, lane); }
#else
  { unsigned* y = (unsigned*)(p.ws + WS_Y); for (int i = blockIdx.x * NTHREADS + (int)threadIdx.x; i < NTOK * 256; i += gridDim.x * NTHREADS) { const int row = i >> 8, c = i & 255; y[row * 512 + 256 + c] = 0u; } }
#endif
  xcd_barrier(xbar);
  phase_outproj(p, 0, lds);
  xcd_barrier(xbar);
  phase_ple(p, 0, lds);
  xcd_barrier(xbar);
  phase_inproj(p, 1, lds);
  xcd_barrier(xbar);
#if EN_D
  for (int rep = 0; rep < REP_D; ++rep) {
#pragma unroll 1
    for (int u2 = blockIdx.x * 2; u2 < 512; u2 += gridDim.x * 2) {
#pragma unroll 1
      for (int k = 0; k < 2; ++k) { const int u = u2 >> 1, bh = u >> 5, pr = u & 31; mixerD_unit(p, bh >> 2, bh & 3, k ? 63 - pr : pr, lds); }
    }
  }
#else
  { unsigned* y = (unsigned*)(p.ws + WS_Y); for (int i = blockIdx.x * NTHREADS + (int)threadIdx.x; i < NTOK * 256; i += gridDim.x * NTHREADS) { const int row = i >> 8, c = i & 255; y[row * 512 + 256 + c] = 0u; } }
#endif
#if EN_C
  __syncthreads();
  { FRESH_IDS for (int rep = 0; rep < REP_C; ++rep) for (int it = gw; it < 4096; it += ngw) mixerC_tile(p, it, Ks, Vs, lane); }
#else
  { unsigned* y = (unsigned*)(p.ws + WS_Y); for (int i = blockIdx.x * NTHREADS + (int)threadIdx.x; i < NTOK * 256; i += gridDim.x * NTHREADS) { const int row = i >> 8, c = i & 255; y[row * 512 + c] = 0u; } }
#endif
  xcd_barrier(xbar);
  phase_outproj(p, 1, lds);
  xcd_barrier(xbar);
  phase_ple(p, 1, lds);
}

extern "C" void kernel_launch(void* const* d_in, const int* in_sizes, int n_in, void* d_out, int out_size, void* d_ws, size_t ws_size, hipStream_t stream) {
  static int grid_blocks = 0;
  if (!grid_blocks) {
    int dev = 0, cus = 0, per_cu = 0;
    hipGetDevice(&dev);
    hipDeviceGetAttribute(&cus, hipDeviceAttributeMultiprocessorCount, dev);
    hipFuncSetAttribute((const void*)fwd_kernel, hipFuncAttributeMaxDynamicSharedMemorySize, LDS_BYTES);
    hipOccupancyMaxActiveBlocksPerMultiprocessor(&per_cu, (const void*)fwd_kernel, NTHREADS, LDS_BYTES);
    if (per_cu < 1) per_cu = 1;
    grid_blocks = cus * per_cu;
    if (grid_blocks > 256) grid_blocks = 256;
  }
  Params p{};
  for (int i = 0; i < 25; ++i) p.in[i] = (const float*)d_in[i];
  p.out = (float*)d_out; p.ws = (unsigned char*)d_ws;
  for (int i = 0; i < 32; ++i) p.inv_freq[i] = (float)pow(10000.0, -(double)i / 32.0);
  (void)hipMemsetAsync((char*)d_ws + WS_BAR, 0, 16384, stream);
  void* args[] = {&p};
  hipError_t e = hipLaunchCooperativeKernel((const void*)fwd_kernel, dim3(grid_blocks), dim3(NTHREADS), args, LDS_BYTES, stream);
  if (e != hipSuccess) fprintf(stderr, "cooperative launch failed: %s (grid %d)\n", hipGetErrorString(e), grid_blocks);
}
```

```cpp
#include <hip/hip_runtime.h>
#include <hip/hip_cooperative_groups.h>
#include <cstdio>
#include <cmath>
namespace cg = cooperative_groups;

#ifndef REP_GEMM
#define REP_GEMM 1
#endif
#ifndef REP_SELA
#define REP_SELA 1
#endif
#ifndef REP_D
#define REP_D 1
#endif
#ifndef REP_C
#define REP_C 1
#endif
#ifndef REP_AATT
#define REP_AATT 1
#endif
#ifndef EN_A
#define EN_A 1
#endif
#ifndef EN_B
#define EN_B 1
#endif
#ifndef EN_C
#define EN_C 1
#endif
#ifndef EN_D
#define EN_D 1
#endif

typedef unsigned short bf16;
typedef short bf16x8 __attribute__((ext_vector_type(8)));
typedef short s16x4 __attribute__((ext_vector_type(4)));
typedef float f32x4 __attribute__((ext_vector_type(4)));
typedef float f32x16 __attribute__((ext_vector_type(16)));
typedef unsigned u32x4 __attribute__((ext_vector_type(4)));
typedef unsigned u32x2 __attribute__((ext_vector_type(2)));
typedef float f32x2_t __attribute__((ext_vector_type(2)));
typedef __bf16 bf16x2_t __attribute__((ext_vector_type(2)));
#define LAS __attribute__((address_space(3)))
#define DI __device__ __forceinline__

constexpr int SEQ = 8192, NTOK = 16384, DM = 1024;
constexpr int NPE = 3072, NPO = 4096;
constexpr float EPS = 1e-6f;
constexpr float LOG2E = 1.4426950408889634f;
constexpr int NTHREADS = 512;
constexpr int LDS_BYTES = 150 * 1024;

constexpr size_t MiB = 1u << 20;
constexpr size_t WS_PE = 0;
constexpr size_t WS_ACT = 128 * MiB;
constexpr size_t WS_Y = 160 * MiB;
constexpr size_t WS_WINE = 192 * MiB;
constexpr size_t WS_WOUTE = 198 * MiB;
constexpr size_t WS_WINO = 200 * MiB;
constexpr size_t WS_WOUTO = 208 * MiB;
constexpr size_t WS_WG0 = 210 * MiB;
constexpr size_t WS_WG1 = 212 * MiB;
constexpr size_t WS_WP0 = 214 * MiB;
constexpr size_t WS_WP1 = 215 * MiB;
constexpr size_t WS_ROPE = 216 * MiB;
constexpr size_t WS_SEL = 218 * MiB;
constexpr size_t WS_IW = 226 * MiB;
constexpr size_t WS_SS = 227 * MiB;
constexpr size_t WS_LAM = 228 * MiB;
constexpr size_t WS_BAR = 250 * MiB;
constexpr size_t WS_PBF = 232 * MiB;
constexpr size_t WS_IKS = 229 * MiB;

struct Params {
  const float* in[25];
  float* out;
  unsigned char* ws;
  float inv_freq[32];
};
enum { I_X = 0, I_P, I_NORM_GAIN, I_W_IN_EVEN, I_W_OUT_EVEN, I_A_Q_GAIN, I_A_K_GAIN, I_IDX_K_GAIN, I_B_Q_GAIN, I_B_K_GAIN, I_B_SINKS,
       I_W_IN_ODD, I_W_OUT_ODD, I_C_Q_GAIN, I_C_K_GAIN, I_D_Q_GAIN, I_D_K_GAIN, I_LQ1, I_LK1, I_LQ2, I_LK2, I_SUB_GAIN, I_PLE_NORM_GAIN,
       I_W_PLE_GATE, I_W_PLE_PROJ };

DI unsigned cvtpk(float lo, float hi) { f32x2_t v = {lo, hi}; bf16x2_t b = __builtin_convertvector(v, bf16x2_t); return __builtin_bit_cast(unsigned, b); }
DI float bf2f(bf16 b) { return __uint_as_float(((unsigned)b) << 16); }
DI float fexp2(float x) { return __builtin_amdgcn_exp2f(x); }
DI f32x16 mfma32(bf16x8 a, bf16x8 b, f32x16 c) { return __builtin_amdgcn_mfma_f32_32x32x16_bf16(a, b, c, 0, 0, 0); }
DI f32x4 mfma16(bf16x8 a, bf16x8 b, f32x4 c) { return __builtin_amdgcn_mfma_f32_16x16x32_bf16(a, b, c, 0, 0, 0); }
DI int crow(int i, int h) { return (i & 3) + 8 * (i >> 2) + 4 * h; }
DI s16x4 trread(const bf16* p) { return __builtin_bit_cast(s16x4, __builtin_amdgcn_ds_read_tr16_b64_v4i16((LAS s16x4*)p)); }
DI int opaque_tid() { int t = threadIdx.x; asm volatile("" : "+v"(t)); return t; }
DI void lds_barrier() { asm volatile("s_waitcnt lgkmcnt(0)" ::: "memory"); __builtin_amdgcn_s_barrier(); asm volatile("" ::: "memory"); }
DI void lds_fence() { asm volatile("s_waitcnt lgkmcnt(0)" ::: "memory"); __builtin_amdgcn_wave_barrier(); }

__host__ __device__ __forceinline__ int phys_col(int n) { return (n & ~255) + 128 * ((n >> 5) & 1) + 32 * ((n >> 6) & 3) + (n & 31); }
DI int map_even(int n) { return n < 1216 ? n : (n < 1224 ? 3008 + (n - 1216) : n - 8); }
DI void transpose_tile(const float* W, int K, int N, bf16* WT, int mapmode, int tile, float* scr) {
  const int tid = opaque_tid();
  const int ntn = (N + 63) >> 6, kt = tile / ntn, nt = tile % ntn, k0 = kt * 64, n0 = nt * 64;
#pragma unroll
  for (int i = 0; i < 8; ++i) {
    const int kk = (tid >> 6) + 8 * i, nn = tid & 63, n = n0 + nn;
    scr[kk * 65 + nn] = (n < N) ? W[(size_t)(k0 + kk) * N + n] : 0.f;
  }
  __syncthreads();
  {
    const int nn = tid >> 3, kc = tid & 7, n = n0 + nn;
    if (n < N) {
      const int dst = mapmode == 1 ? phys_col(map_even(n)) : (mapmode == 2 ? phys_col(n) : n);
      const float* s = scr + (kc * 8) * 65 + nn;
      u32x4 o; o.x = cvtpk(s[0], s[65]); o.y = cvtpk(s[2 * 65], s[3 * 65]); o.z = cvtpk(s[4 * 65], s[5 * 65]); o.w = cvtpk(s[6 * 65], s[7 * 65]);
      *(u32x4*)(WT + (size_t)dst * K + k0 + kc * 8) = o;
    }
  }
  __syncthreads();
}

DI float wave_sum(float v) {
#pragma unroll
  for (int o = 1; o < 64; o <<= 1) v += __shfl_xor(v, o);
  return v;
}

DI void phase_prologue(const Params& p, char* lds) {
  const int tid = opaque_tid(), lane = tid & 63, wid = tid >> 6;
  const int nb = gridDim.x, bid = blockIdx.x;
  unsigned char* ws = p.ws;
  float* scr = (float*)lds;
  const int T0 = 16 * 48, T1 = 256, T2 = 16 * 64, T3 = 256, T4 = 256, T5 = 256, T6 = 64, T7 = 64;
  const int NT = T0 + T1 + T2 + T3 + T4 + T5 + T6 + T7;
  for (int it = bid; it < NT; it += nb) {
    int r = it;
    if (r < T0) { transpose_tile(p.in[I_W_IN_EVEN], 1024, 3016, (bf16*)(ws + WS_WINE), 1, r, scr); continue; } r -= T0;
    if (r < T1) { transpose_tile(p.in[I_W_OUT_EVEN], 1024, 1024, (bf16*)(ws + WS_WOUTE), 0, r, scr); continue; } r -= T1;
    if (r < T2) { transpose_tile(p.in[I_W_IN_ODD], 1024, 4096, (bf16*)(ws + WS_WINO), 2, r, scr); continue; } r -= T2;
    if (r < T3) { transpose_tile(p.in[I_W_OUT_ODD], 1024, 1024, (bf16*)(ws + WS_WOUTO), 0, r, scr); continue; } r -= T3;
    if (r < T4) { transpose_tile(p.in[I_W_PLE_GATE], 1024, 1024, (bf16*)(ws + WS_WG0), 0, r, scr); continue; } r -= T4;
    if (r < T5) { transpose_tile(p.in[I_W_PLE_GATE] + 1024 * 1024, 1024, 1024, (bf16*)(ws + WS_WG1), 0, r, scr); continue; } r -= T5;
    if (r < T6) { transpose_tile(p.in[I_W_PLE_PROJ], 256, 1024, (bf16*)(ws + WS_WP0), 0, r, scr); continue; } r -= T6;
    transpose_tile(p.in[I_W_PLE_PROJ] + 256 * 1024, 256, 1024, (bf16*)(ws + WS_WP1), 0, r, scr);
  }
  const int gt = bid * NTHREADS + tid, ngt = nb * NTHREADS;
  { unsigned* z = (unsigned*)(ws + WS_WINE); for (int i = gt; i < 56 * 512; i += ngt) z[(size_t)phys_col(3016 + (i >> 9)) * 512 + (i & 511)] = 0u; }
  { const f32x4* src = (const f32x4*)p.in[I_P]; u32x2* dst = (u32x2*)(ws + WS_PBF); for (int i = gt; i < 2 * NTOK * 256 / 4; i += ngt) { const f32x4 v = src[i]; u32x2 w; w.x = cvtpk(v.x, v.y); w.y = cvtpk(v.z, v.w); dst[i] = w; } }
  { float* ss = (float*)(ws + WS_SS); for (int i = gt; i < 3 * NTOK; i += ngt) ss[i] = 0.f; }
  { float2* tab = (float2*)(ws + WS_ROPE);
    for (int i = gt; i < SEQ * 32; i += ngt) {
      const int pos = i >> 5, k = i & 31;
      const float ang = (float)pos * p.inv_freq[k];
      double rev = (double)ang * 0.15915494309189535; rev -= floor(rev);
      const float rf = (float)rev;
      tab[i] = make_float2(__builtin_amdgcn_cosf(rf), __builtin_amdgcn_sinf(rf));
    } }
  if (bid == 0 && wid == 0) {
    const float a = wave_sum(p.in[I_LQ1][lane] * p.in[I_LK1][lane]);
    const float b = wave_sum(p.in[I_LQ2][lane] * p.in[I_LK2][lane]);
    const float lambda_init = 0.8f - 0.6f * expf(-0.3f);
    if (lane == 0) *(float*)(ws + WS_LAM) = expf(a) - expf(b) + lambda_init;
  }
  { const float* x = p.in[I_X]; const float* g = p.in[I_NORM_GAIN]; bf16* H = (bf16*)(ws + WS_ACT);
    const int gw = bid * 8 + wid, ngw = nb * 8;
    for (int m = gw; m < NTOK; m += ngw) {
      const f32x4* xr = (const f32x4*)(x + (size_t)m * DM) + lane;
      f32x4 v[4]; float s = 0.f;
#pragma unroll
      for (int j = 0; j < 4; ++j) { v[j] = xr[64 * j]; s += v[j].x * v[j].x + v[j].y * v[j].y + v[j].z * v[j].z + v[j].w * v[j].w; }
      const float rstd = rsqrtf(wave_sum(s) * (1.f / DM) + EPS);
      u32x2* o = (u32x2*)(H + (size_t)m * DM) + lane;
#pragma unroll
      for (int j = 0; j < 4; ++j) { const f32x4 gg = *((const f32x4*)g + lane + 64 * j); u32x2 w; w.x = cvtpk(v[j].x * rstd * gg.x, v[j].y * rstd * gg.y); w.y = cvtpk(v[j].z * rstd * gg.z, v[j].w * rstd * gg.w); o[64 * j] = w; }
    } }
}

namespace pg8 {
#define PG8_LAS __attribute__((address_space(3)))
typedef unsigned short bf16_t;
typedef short bf16x8 __attribute__((ext_vector_type(8)));
typedef float f32x4 __attribute__((ext_vector_type(4)));
typedef unsigned u32x4 __attribute__((ext_vector_type(4)));
constexpr int BM = 256, BK = 64, HALF = 128, HTB = HALF * BK * 2  , STAGE_BYTES = 8 * HTB, NXCD = 8, WGM = 8;

__host__ __device__ __forceinline__ int lds_byte(int r, int c) { const int st = (r >> 4) * 2 + (c >> 5), rr = r & 15, cc = c & 31, ob = rr * 64 + cc * 2; return st * 1024 + (ob ^ (((ob >> 9) & 1) << 5)); }
__host__ __device__ __forceinline__ void stage_rc(int b, int& R, int& C) { const int st = b / 1024, sb = b % 1024, swz = sb ^ (((sb >> 9) & 1) << 5); R = (st >> 1) * 16 + swz / 64; C = (st & 1) * 32 + (swz % 64) / 2; }
__host__ __device__ __forceinline__ int perm32(int rho) { const int n = rho >> 4, i = rho & 15; return 8 * (i >> 2) + 4 * n + (i & 3); }

struct Unit { int pm, pn; };
struct Gemm { const bf16_t* A; const bf16_t* Bt; int M, N, K; };

struct StaticOrder {
    int nM, nN, nwg, G, c;
    __host__ __device__ void init(int M, int N, int G_, int c_) { nM = M / BM; nN = N / BM; nwg = nM * nN; G = G_; c = c_; }
    __host__ __device__ bool next(int i, Unit& u) const {
        const long L = (long)i * G + c; if (L >= nwg) return false;
        int wgid = (int)L; { const int q = nwg / NXCD, r = nwg % NXCD, xcd = wgid % NXCD, off = wgid / NXCD; wgid = (xcd < r ? xcd * (q + 1) : r * (q + 1) + (xcd - r) * q) + off; }
        const int nig = WGM * nN, gid = wgid / nig, fm = gid * WGM, gsz = (nM - fm) < WGM ? (nM - fm) : WGM;
        u.pm = fm + ((wgid % nig) % gsz); u.pn = (wgid % nig) / gsz; return true;
    }
    __device__ __forceinline__ void a_ready(const Unit&) const {}
    __device__ __forceinline__ void done(const Unit&) const {}
};
__device__ __forceinline__ unsigned cvt_pk_bf16(float lo, float hi) { unsigned r; asm volatile("v_cvt_pk_bf16_f32 %0, %1, %2" : "=v"(r) : "v"(lo), "v"(hi)); return r; }
template <class Epi, class Sched, bool ALIGN_EPI = false, bool SP2 = false>
__device__ __forceinline__ void gemm_phase(PG8_LAS unsigned char* lds, const Gemm g, const Sched& S, const Epi& E) {
    int tid_ = threadIdx.x; asm volatile("" : "+v"(tid_));
    const int tid = tid_, wid = __builtin_amdgcn_readfirstlane(tid >> 6), lane = tid & 63, wr = wid >> 2, wc = wid & 3, fr = lane & 15, fq = lane >> 4;
    const int K = g.K, nt = K / BK;
    unsigned voffA[2], voffB[2];
#pragma unroll
    for (int i = 0; i < 2; ++i) { int R, C; stage_rc(tid * 16 + i * 8192, R, C); const int Rb = Epi::PERM ? ((R & ~31) + perm32(R & 31)) : R;
        voffA[i] = (unsigned)(R * K + C) * 2u; voffB[i] = (unsigned)(Rb * K + C) * 2u; }
    const size_t kstep = (size_t)(BK * 2);
    const size_t hstep = (size_t)HALF * K * 2;
    const size_t tstep = 2 * hstep;
    const unsigned ldsw = (unsigned)wid * 1024u;
    const int aoff = lds_byte(wr * 64 + fr, fq * 8), boff = lds_byte(wc * 32 + fr, fq * 8);
#define PG8_SA(b, h) (((b) * 2 + (h)) * HTB)
#define PG8_SB(b, h) ((4 + (b) * 2 + (h)) * HTB)
#define PG8_STAGE(bufoff, gbase, voff) do { _Pragma("unroll") for (int _i = 0; _i < 2; ++_i) \
        __builtin_amdgcn_global_load_lds((const unsigned*)((const char*)(gbase) + (voff)[_i]), (PG8_LAS unsigned*)(lds + (bufoff) + ldsw + _i * 8192), 16, 0, 0); } while (0)
#define PG8_LDA(dst, b, h) do { _Pragma("unroll") for (int m = 0; m < 4; ++m) _Pragma("unroll") for (int k = 0; k < 2; ++k) dst[m][k] = *(const PG8_LAS bf16x8*)(lds + PG8_SA(b, h) + aoff + m * 2048 + k * 1024); } while (0)
#define PG8_LDB(dst, b, h) do { _Pragma("unroll") for (int n = 0; n < 2; ++n) _Pragma("unroll") for (int k = 0; k < 2; ++k) dst[n][k] = *(const PG8_LAS bf16x8*)(lds + PG8_SB(b, h) + boff + n * 2048 + k * 1024); } while (0)
#define PG8_MMA(ai, bj, At, Bt) do { __builtin_amdgcn_s_setprio(1); _Pragma("unroll") for (int m = 0; m < 4; ++m) _Pragma("unroll") for (int n = 0; n < 2; ++n) _Pragma("unroll") for (int k = 0; k < 2; ++k) \
        acc[ai][bj][m][n] = __builtin_amdgcn_mfma_f32_16x16x32_bf16(Bt[n][k], At[m][k], acc[ai][bj][m][n], 0, 0, 0); __builtin_amdgcn_s_setprio(0); } while (0)
#define PG8_WAIT_V(n) asm volatile("s_waitcnt vmcnt(" #n ")" ::: "memory")
#define PG8_WAIT_L(n) asm volatile("s_waitcnt lgkmcnt(" #n ")" ::: "memory")
#define PG8_BAR __builtin_amdgcn_s_barrier()
#define PG8_SCHED __builtin_amdgcn_sched_barrier(0)
    Unit cur, nxt; int ui = 0;
    if (!S.next(0, cur)) return;
    f32x4 acc[2][2][4][2];
#pragma unroll
    for (int a = 0; a < 2; ++a)
#pragma unroll
        for (int b = 0; b < 2; ++b)
#pragma unroll
            for (int m = 0; m < 4; ++m)
#pragma unroll
                for (int n = 0; n < 2; ++n) acc[a][b][m][n] = (f32x4){0.f, 0.f, 0.f, 0.f};
    bf16x8 At[4][2], B0[2][2], B1[2][2];
    const char* cA = (const char*)g.A + (size_t)cur.pm * tstep; const char* cB = (const char*)g.Bt + (size_t)cur.pn * tstep;
    S.a_ready(cur);
    if constexpr (SP2) {
        PG8_STAGE(PG8_SB(0, 0), cB, voffB); PG8_STAGE(PG8_SB(0, 1), cB + hstep, voffB); PG8_STAGE(PG8_SA(0, 0), cA, voffA); PG8_STAGE(PG8_SA(0, 1), cA + hstep, voffA);
        if (wr == 1) PG8_BAR;
        PG8_WAIT_V(2); PG8_BAR;
        PG8_STAGE(PG8_SB(1, 0), cB + kstep, voffB); PG8_STAGE(PG8_SA(1, 0), cA + kstep, voffA); PG8_STAGE(PG8_SB(1, 1), cB + hstep + kstep, voffB);
        PG8_WAIT_V(6); PG8_BAR;
    } else {
        PG8_STAGE(PG8_SB(0, 0), cB, voffB); PG8_STAGE(PG8_SA(0, 0), cA, voffA); PG8_STAGE(PG8_SB(0, 1), cB + hstep, voffB); PG8_STAGE(PG8_SA(0, 1), cA + hstep, voffA);
        if (wr == 1) PG8_BAR;
        PG8_WAIT_V(4); PG8_BAR;
        PG8_STAGE(PG8_SB(1, 0), cB + kstep, voffB); PG8_STAGE(PG8_SA(1, 0), cA + kstep, voffA); PG8_STAGE(PG8_SB(1, 1), cB + hstep + kstep, voffB);
        PG8_WAIT_V(6); PG8_BAR;
    }
    for (;;) {
        const bool has_next = S.next(ui + 1, nxt);
        const char* nA = has_next ? (const char*)g.A + (size_t)nxt.pm * tstep : cA; const char* nB = has_next ? (const char*)g.Bt + (size_t)nxt.pn * tstep : cB;
        for (int t = 0; t < nt; t += 2) {
            const bool last = (t == nt - 2);
            const char* a1 = cA + (size_t)(t + 1) * kstep;
            const char* a2 = last ? nA : cA + (size_t)(t + 2) * kstep; const char* b2 = last ? nB : cB + (size_t)(t + 2) * kstep;
            const char* a3 = a2 + kstep; const char* b3 = b2 + kstep;
            if (last && has_next) S.a_ready(nxt);
            if constexpr (SP2) {
            PG8_LDB(B0, 0, 0); PG8_LDB(B1, 0, 1); PG8_SCHED; PG8_LDA(At, 0, 0); PG8_STAGE(PG8_SA(1, 1), a1 + hstep, voffA);
            PG8_WAIT_V(8); PG8_WAIT_L(0); PG8_BAR; PG8_MMA(0, 0, At, B0); PG8_MMA(0, 1, At, B1); PG8_BAR; PG8_SCHED;
            PG8_LDA(At, 0, 1); PG8_STAGE(PG8_SB(0, 0), b2, voffB); PG8_STAGE(PG8_SB(0, 1), b2 + hstep, voffB); PG8_STAGE(PG8_SA(0, 0), a2, voffA);
            PG8_WAIT_V(8); PG8_WAIT_L(0); PG8_BAR; PG8_MMA(1, 0, At, B0); PG8_MMA(1, 1, At, B1); PG8_BAR; PG8_SCHED;
            PG8_LDB(B0, 1, 0); PG8_LDB(B1, 1, 1); PG8_SCHED; PG8_LDA(At, 1, 0); PG8_STAGE(PG8_SA(0, 1), a2 + hstep, voffA);
            PG8_WAIT_V(8); PG8_WAIT_L(0); PG8_BAR; PG8_MMA(0, 0, At, B0); PG8_MMA(0, 1, At, B1); PG8_BAR; PG8_SCHED;
            PG8_LDA(At, 1, 1); PG8_STAGE(PG8_SB(1, 0), b3, voffB); PG8_STAGE(PG8_SB(1, 1), b3 + hstep, voffB); PG8_STAGE(PG8_SA(1, 0), a3, voffA);
            PG8_WAIT_V(8); PG8_WAIT_L(0); PG8_BAR; PG8_MMA(1, 0, At, B0); PG8_MMA(1, 1, At, B1); PG8_BAR; PG8_SCHED;
            } else {
            PG8_LDB(B0, 0, 0); PG8_SCHED; PG8_LDA(At, 0, 0); PG8_STAGE(PG8_SA(1, 1), a1 + hstep, voffA);
            PG8_WAIT_L(8); PG8_BAR; PG8_WAIT_L(0); PG8_MMA(0, 0, At, B0); PG8_BAR; PG8_SCHED;
            PG8_LDB(B1, 0, 1); PG8_STAGE(PG8_SB(0, 0), b2, voffB);
            PG8_BAR; PG8_WAIT_L(0); PG8_MMA(0, 1, At, B1); PG8_BAR;
            PG8_LDA(At, 0, 1); PG8_STAGE(PG8_SA(0, 0), a2, voffA);
            PG8_BAR; PG8_WAIT_L(0); PG8_MMA(1, 0, At, B0); PG8_BAR; PG8_SCHED;
            PG8_STAGE(PG8_SB(0, 1), b2 + hstep, voffB);
            PG8_WAIT_V(6); PG8_BAR; PG8_MMA(1, 1, At, B1); PG8_BAR;
            PG8_LDB(B0, 1, 0); PG8_SCHED; PG8_LDA(At, 1, 0); PG8_STAGE(PG8_SA(0, 1), a2 + hstep, voffA);
            PG8_WAIT_L(8); PG8_BAR; PG8_WAIT_L(0); PG8_MMA(0, 0, At, B0); PG8_BAR; PG8_SCHED;
            PG8_LDB(B1, 1, 1); PG8_STAGE(PG8_SB(1, 0), b3, voffB);
            PG8_BAR; PG8_WAIT_L(0); PG8_MMA(0, 1, At, B1); PG8_BAR;
            PG8_LDA(At, 1, 1); PG8_STAGE(PG8_SA(1, 0), a3, voffA);
            PG8_BAR; PG8_WAIT_L(0); PG8_MMA(1, 0, At, B0); PG8_BAR; PG8_SCHED;
            PG8_STAGE(PG8_SB(1, 1), b3 + hstep, voffB);
            PG8_WAIT_V(6); PG8_BAR; PG8_MMA(1, 1, At, B1); PG8_BAR;
            }
        }
        if constexpr (ALIGN_EPI) { if (wr == 0) PG8_BAR; }
        if constexpr (!Epi::AFTER_DRAIN) { E(acc, cur, wr, wc, fr, fq); S.done(cur); }
        if (!has_next) break;
#pragma unroll
        for (int a = 0; a < 2; ++a)
#pragma unroll
            for (int b = 0; b < 2; ++b)
#pragma unroll
                for (int m = 0; m < 4; ++m)
#pragma unroll
                    for (int n = 0; n < 2; ++n) acc[a][b][m][n] = (f32x4){0.f, 0.f, 0.f, 0.f};
        cur = nxt; cA = nA; cB = nB; ++ui;
        if constexpr (ALIGN_EPI) { if (wr == 1) PG8_BAR; }
    }
    PG8_WAIT_V(0);
    if constexpr (!ALIGN_EPI) { if (wr == 0) PG8_BAR; }
    PG8_BAR;
    if constexpr (Epi::AFTER_DRAIN) { E.fused(acc, cur, wr, wc, fr, fq, lds, wid, lane); S.done(cur); }
#undef PG8_SA
#undef PG8_SB
#undef PG8_STAGE
#undef PG8_LDA
#undef PG8_LDB
#undef PG8_MMA
#undef PG8_WAIT_V
#undef PG8_WAIT_L
#undef PG8_BAR
#undef PG8_SCHED
}
}

enum { T_PLAIN = 0, T_NR = 1, T_ROPE = 2, T_SILU = 3, T_IW = 4 };
DI void slot_info(const Params& p, int layer, int slot, int& type, const float*& gain) {
  gain = nullptr;
  if (layer == 0) {
    if (slot < 8) { type = T_NR; gain = p.in[I_A_Q_GAIN]; }
    else if (slot == 8) { type = T_NR; gain = p.in[I_A_K_GAIN]; }
    else if (slot == 9) type = T_PLAIN;
    else if (slot < 18) type = T_ROPE;
    else if (slot == 18) { type = T_NR; gain = p.in[I_IDX_K_GAIN]; }
    else if (slot < 27) type = T_SILU;
    else if (slot < 35) { type = T_NR; gain = p.in[I_B_Q_GAIN]; }
    else if (slot < 37) { type = T_NR; gain = p.in[I_B_K_GAIN]; }
    else if (slot < 39) type = T_PLAIN;
    else if (slot < 47) type = T_SILU;
    else type = T_IW;
  } else {
    if (slot < 8) { type = T_NR; gain = p.in[I_C_Q_GAIN]; }
    else if (slot < 16) { type = T_NR; gain = p.in[I_C_K_GAIN]; }
    else if (slot < 24) type = T_PLAIN;
    else if (slot < 32) type = T_SILU;
    else if (slot < 40) { type = T_NR; gain = p.in[I_D_Q_GAIN]; }
    else if (slot < 48) { type = T_NR; gain = p.in[I_D_K_GAIN]; }
    else if (slot < 56) type = T_PLAIN;
    else type = T_SILU;
  }
}
constexpr int E_AQ = 0, E_AK = 512, E_AV = 576, E_IQ = 640, E_IK = 1152, E_AG = 1216, E_BQ = 1728, E_BK = 2240, E_BV = 2368, E_BG = 2496;
constexpr int O_CQ = 0, O_CK = 512, O_CV = 1024, O_CG = 1536, O_DQ = 2048, O_DK = 2560, O_DV = 3072, O_DG = 3584;

typedef pg8::f32x4 (AccT)[2][2][4][2];

struct EpiInProj {
  static constexpr bool PERM = false, AFTER_DRAIN = false;
  const Params& p; int layer;
  DI void operator()(const f32x4 (&acc)[2][2][4][2], const pg8::Unit& u, int wr, int wc, int fr, int fq) const {
    unsigned char* ws = p.ws;
    const int NP = layer == 0 ? NPE : NPO;
    bf16* PE = (bf16*)(ws + WS_PE);
    const float2* rope = (const float2*)(ws + WS_ROPE);
    const float* ss1 = (const float*)(ws + WS_SS);
    float* IW = (float*)(ws + WS_IW);
    const int slot = u.pn * 4 + wc;
    int type; const float* gain; slot_info(p, layer, slot, type, gain);
#pragma unroll
    for (int ai = 0; ai < 2; ++ai)
#pragma unroll
      for (int m = 0; m < 4; ++m) {
        const int row = u.pm * 256 + ai * 128 + wr * 64 + m * 16 + fr, pos = row & (SEQ - 1);
        float sc = 1.f;
        if (layer == 1) sc = rsqrtf(ss1[row] * (1.f / DM) + EPS);
        f32x4 v1[2], v2[2];
#pragma unroll
        for (int n = 0; n < 2; ++n) { v1[n] = acc[ai][0][m][n] * sc; v2[n] = acc[ai][1][m][n] * sc; }
        if (type == T_NR) {
          float s = 0.f;
#pragma unroll
          for (int n = 0; n < 2; ++n) s += v1[n].x * v1[n].x + v1[n].y * v1[n].y + v1[n].z * v1[n].z + v1[n].w * v1[n].w + v2[n].x * v2[n].x + v2[n].y * v2[n].y + v2[n].z * v2[n].z + v2[n].w * v2[n].w;
          s += __shfl_xor(s, 16); s += __shfl_xor(s, 32);
          const float rn = rsqrtf(s * (1.f / 64.f) + EPS);
#pragma unroll
          for (int n = 0; n < 2; ++n) { const f32x4 g1 = *(const f32x4*)(gain + n * 16 + fq * 4), g2 = *(const f32x4*)(gain + 32 + n * 16 + fq * 4); v1[n] = v1[n] * rn * g1; v2[n] = v2[n] * rn * g2; }
        }
        if (type == T_NR || type == T_ROPE) {
#pragma unroll
          for (int n = 0; n < 2; ++n) {
            const f32x4* cs = (const f32x4*)(rope + (size_t)pos * 32 + n * 16 + fq * 4);
            const f32x4 c01 = cs[0], c23 = cs[1];
            const f32x4 x1 = v1[n], x2 = v2[n];
            f32x4 o1, o2;
            o1.x = x1.x * c01.x - x2.x * c01.y; o2.x = x2.x * c01.x + x1.x * c01.y;
            o1.y = x1.y * c01.z - x2.y * c01.w; o2.y = x2.y * c01.z + x1.y * c01.w;
            o1.z = x1.z * c23.x - x2.z * c23.y; o2.z = x2.z * c23.x + x1.z * c23.y;
            o1.w = x1.w * c23.z - x2.w * c23.w; o2.w = x2.w * c23.z + x1.w * c23.w;
            v1[n] = o1; v2[n] = o2;
          }
        }
        if (type == T_SILU) {
#pragma unroll
          for (int n = 0; n < 2; ++n)
#pragma unroll
            for (int j = 0; j < 4; ++j) { const float a = v1[n][j]; v1[n][j] = a / (1.f + __expf(-a)); const float b = v2[n][j]; v2[n][j] = b / (1.f + __expf(-b)); }
        }
        if (type == T_IW) {
          if (fq < 2) *(f32x4*)(IW + (size_t)row * 8 + fq * 4) = v1[0];
        } else {
          bf16* dst = PE + (size_t)row * NP + slot * 64 + fq * 4;
#pragma unroll
          for (int n = 0; n < 2; ++n) {
            u32x2 w1, w2; w1.x = cvtpk(v1[n].x, v1[n].y); w1.y = cvtpk(v1[n].z, v1[n].w); w2.x = cvtpk(v2[n].x, v2[n].y); w2.y = cvtpk(v2[n].z, v2[n].w);
            *(u32x2*)(dst + n * 16) = w1; *(u32x2*)(dst + 32 + n * 16) = w2;
            if (layer == 0 && slot == 18) { bf16* IKS = (bf16*)(ws + WS_IKS); const int key = row & (SEQ - 1);
              bf16* base = IKS + (((size_t)(row >> 13) * 256 + (key >> 5)) * 4) * 512 + ((fq >> 1) * 32 + (key & 31)) * 8 + (fq & 1) * 4;
              *(u32x2*)(base + (size_t)n * 512) = w1; *(u32x2*)(base + (size_t)(n + 2) * 512) = w2; }
          }
        }
        asm volatile("" ::: "memory");
      }
  }
};

DI void phase_inproj(const Params& p, int layer, char* lds) {
  unsigned char* ws = p.ws;
  const int NP = layer == 0 ? NPE : NPO;
  pg8::Gemm g{(const bf16*)(ws + (layer == 0 ? WS_ACT : WS_Y)), (const bf16*)(ws + (layer == 0 ? WS_WINE : WS_WINO)), NTOK, NP, DM};
  pg8::StaticOrder S; S.init(NTOK, NP, (int)gridDim.x, (int)blockIdx.x);
  EpiInProj E{p, layer};
  pg8::gemm_phase<EpiInProj, pg8::StaticOrder, true, true>((PG8_LAS unsigned char*)lds, g, S, E);
}

struct EpiOutProj {
  static constexpr bool PERM = false, AFTER_DRAIN = false;
  const float* xin; float* out; bf16* XG; const float* pg; float* ss;
  DI void operator()(const f32x4 (&acc)[2][2][4][2], const pg8::Unit& u, int wr, int wc, int fr, int fq) const {
#pragma unroll
    for (int ai = 0; ai < 2; ++ai)
#pragma unroll
      for (int m = 0; m < 4; ++m) {
        const int row = u.pm * 256 + ai * 128 + wr * 64 + m * 16 + fr; float rs = 0.f;
#pragma unroll
        for (int bj = 0; bj < 2; ++bj)
#pragma unroll
          for (int n = 0; n < 2; ++n) {
            const int col = u.pn * 256 + bj * 128 + wc * 32 + n * 16 + fq * 4; const size_t off = (size_t)row * DM + col;
            const f32x4 xn = *(const f32x4*)(xin + off) + acc[ai][bj][m][n];
            *(f32x4*)(out + off) = xn;
            rs += xn.x * xn.x + xn.y * xn.y + xn.z * xn.z + xn.w * xn.w;
            const f32x4 gg = *(const f32x4*)(pg + col);
            u32x2 w; w.x = cvtpk(xn.x * gg.x, xn.y * gg.y); w.y = cvtpk(xn.z * gg.z, xn.w * gg.w); *(u32x2*)(XG + off) = w;
          }
        rs += __shfl_xor(rs, 16); rs += __shfl_xor(rs, 32);
        if (fq == 0) atomicAdd(ss + row, rs);
        asm volatile("" ::: "memory");
      }
  }
};
DI void phase_outproj(const Params& p, int layer, char* lds) {
  unsigned char* ws = p.ws;
  pg8::Gemm g{(const bf16*)(ws + WS_Y), (const bf16*)(ws + (layer == 0 ? WS_WOUTE : WS_WOUTO)), NTOK, DM, DM};
  pg8::StaticOrder S; S.init(NTOK, DM, (int)gridDim.x, (int)blockIdx.x);
  EpiOutProj E{layer == 0 ? p.in[I_X] : p.out, p.out, (bf16*)(ws + WS_ACT), p.in[I_PLE_NORM_GAIN] + layer * DM, (float*)(ws + WS_SS) + (layer == 0 ? 1 : 2) * NTOK};
  pg8::gemm_phase<EpiOutProj, pg8::StaticOrder, true, true>((PG8_LAS unsigned char*)lds, g, S, E);
}

struct EpiPleProj {
  static constexpr bool PERM = false, AFTER_DRAIN = false;
  bf16* PT;
  DI void operator()(const f32x4 (&acc)[2][2][4][2], const pg8::Unit& u, int wr, int wc, int fr, int fq) const {
#pragma unroll
    for (int ai = 0; ai < 2; ++ai)
#pragma unroll
      for (int m = 0; m < 4; ++m) {
        const int row = u.pm * 256 + ai * 128 + wr * 64 + m * 16 + fr;
#pragma unroll
        for (int bj = 0; bj < 2; ++bj)
#pragma unroll
          for (int n = 0; n < 2; ++n) { const f32x4 a = acc[ai][bj][m][n]; u32x2 w; w.x = cvtpk(a.x, a.y); w.y = cvtpk(a.z, a.w); *(u32x2*)(PT + (size_t)row * DM + u.pn * 256 + bj * 128 + wc * 32 + n * 16 + fq * 4) = w; }
      }
  }
};
struct EpiPleGate {
  static constexpr bool PERM = false, AFTER_DRAIN = false;
  const bf16* PT; float* out; const float* ssx; float* ss1; bf16* H; const float* ng1; int layer;
  DI void operator()(const f32x4 (&acc)[2][2][4][2], const pg8::Unit& u, int wr, int wc, int fr, int fq) const {
#pragma unroll
    for (int ai = 0; ai < 2; ++ai)
#pragma unroll
      for (int m = 0; m < 4; ++m) {
        const int row = u.pm * 256 + ai * 128 + wr * 64 + m * 16 + fr; float rs = 0.f;
        const float rstd = rsqrtf(ssx[row] * (1.f / DM) + EPS);
#pragma unroll
        for (int bj = 0; bj < 2; ++bj)
#pragma unroll
          for (int n = 0; n < 2; ++n) {
            const int col = u.pn * 256 + bj * 128 + wc * 32 + n * 16 + fq * 4; const size_t off = (size_t)row * DM + col;
            f32x4 g;
#pragma unroll
            for (int j = 0; j < 4; ++j) g[j] = 1.f / (1.f + __expf(-rstd * acc[ai][bj][m][n][j]));
            const u32x2 pw = *(const u32x2*)(PT + off); f32x4 pp; pp.x = __uint_as_float(pw.x << 16); pp.y = __uint_as_float(pw.x & 0xffff0000u); pp.z = __uint_as_float(pw.y << 16); pp.w = __uint_as_float(pw.y & 0xffff0000u);
            const f32x4 xn = *(const f32x4*)(out + off) + pp * g;
            *(f32x4*)(out + off) = xn;
            if (layer == 0) {
              rs += xn.x * xn.x + xn.y * xn.y + xn.z * xn.z + xn.w * xn.w;
              const f32x4 gg = *(const f32x4*)(ng1 + col);
              u32x2 w; w.x = cvtpk(xn.x * gg.x, xn.y * gg.y); w.y = cvtpk(xn.z * gg.z, xn.w * gg.w); *(u32x2*)(H + off) = w;
            }
          }
        if (layer == 0) { rs += __shfl_xor(rs, 16); rs += __shfl_xor(rs, 32); if (fq == 0) atomicAdd(ss1 + row, rs); }
        asm volatile("" ::: "memory");
      }
  }
};
DI void phase_ple(const Params& p, int layer, char* lds) {
  unsigned char* ws = p.ws;
  bf16* PT = (bf16*)(ws + WS_PE);
  pg8::StaticOrder S; S.init(NTOK, DM, (int)gridDim.x, (int)blockIdx.x);
  { pg8::Gemm g{(const bf16*)(ws + WS_PBF) + (size_t)layer * NTOK * 256, (const bf16*)(ws + (layer == 0 ? WS_WP0 : WS_WP1)), NTOK, DM, 256};
    EpiPleProj E{PT};
    pg8::gemm_phase<EpiPleProj, pg8::StaticOrder, true, true>((PG8_LAS unsigned char*)lds, g, S, E); }
  { pg8::Gemm g{(const bf16*)(ws + WS_ACT), (const bf16*)(ws + (layer == 0 ? WS_WG0 : WS_WG1)), NTOK, DM, DM};
    EpiPleGate E{PT, p.out, (const float*)(ws + WS_SS) + (layer == 0 ? 1 : 2) * NTOK, (float*)(ws + WS_SS), (bf16*)(ws + WS_Y), p.in[I_NORM_GAIN] + DM, layer};
    pg8::gemm_phase<EpiPleGate, pg8::StaticOrder, true, true>((PG8_LAS unsigned char*)lds, g, S, E); }
}

DI float half_max(float v) { auto rr = __builtin_amdgcn_permlane32_swap(__float_as_uint(v), __float_as_uint(v), false, false); return fmaxf(__uint_as_float(rr[0]), __uint_as_float(rr[1])); }
template <int DVB, bool MASKED = true>
DI void attn_step32(const bf16* Kt, int KP, const bf16* Vt, int VP, const bf16x8 (&qf)[4], f32x16 (&o)[DVB], float& m, float& l, unsigned vmask, float c2, int lane) {
  const int r32 = lane & 31, h = lane >> 5;
  f32x16 s;
#pragma unroll
  for (int i = 0; i < 16; ++i) s[i] = 0.f;
#pragma unroll
  for (int t = 0; t < 4; ++t) { const bf16x8 kf = *(const bf16x8*)(Kt + r32 * KP + t * 16 + h * 8); s = mfma32(kf, qf[t], s); }
  float mx = -INFINITY;
#pragma unroll
  for (int i = 0; i < 16; ++i) { if (MASKED) { s[i] = ((vmask >> i) & 1u) ? s[i] : -INFINITY; } mx = fmaxf(mx, s[i]); }
  mx = half_max(mx);
  const float mn = fmaxf(m, mx * c2);
  if (__any(mn > m)) {
    const float alpha = fexp2(m - mn); l *= alpha;
#pragma unroll
    for (int d = 0; d < DVB; ++d)
#pragma unroll
      for (int i = 0; i < 16; ++i) o[d][i] *= alpha;
    m = mn;
  }
  float ps = 0.f; const float negm = -m;
#pragma unroll
  for (int i = 0; i < 16; ++i) { const float pv = fexp2(__builtin_fmaf(s[i], c2, negm)); s[i] = pv; ps += pv; }
  l += ps;
  bf16x8 pf[2];
  { u32x4 a, b; a.x = cvtpk(s[0], s[1]); a.y = cvtpk(s[2], s[3]); a.z = cvtpk(s[4], s[5]); a.w = cvtpk(s[6], s[7]);
    b.x = cvtpk(s[8], s[9]); b.y = cvtpk(s[10], s[11]); b.z = cvtpk(s[12], s[13]); b.w = cvtpk(s[14], s[15]);
    pf[0] = __builtin_bit_cast(bf16x8, a); pf[1] = __builtin_bit_cast(bf16x8, b); }
  const int i16 = lane & 15, q = i16 >> 2, pp = i16 & 3, blk = (lane >> 4) & 1;
#pragma unroll
  for (int d = 0; d < DVB; ++d)
#pragma unroll
    for (int sk = 0; sk < 2; ++sk) {
      const s16x4 lo = trread(Vt + (16 * sk + 4 * h + q) * VP + 32 * d + 16 * blk + 4 * pp);
      const s16x4 hi = trread(Vt + (16 * sk + 8 + 4 * h + q) * VP + 32 * d + 16 * blk + 4 * pp);
      const bf16x8 vf = __builtin_shufflevector(lo, hi, 0, 1, 2, 3, 4, 5, 6, 7);
      o[d] = mfma32(vf, pf[sk], o[d]);
    }
}

DI unsigned row_range_mask(int lo, int hi) {
  lo = lo < 0 ? 0 : lo; hi = hi > 31 ? 31 : hi;
  if (hi < lo) return 0u;
  const unsigned upto_hi = (hi >= 31) ? 0xffffffffu : ((1u << (hi + 1)) - 1u);
  return upto_hi & ~((1u << lo) - 1u);
}
DI unsigned lane_rows(unsigned m32, int h) {
  const unsigned t = m32 >> (4 * h);
  return (t & 0xFu) | ((t >> 4) & 0xF0u) | ((t >> 8) & 0xF00u) | ((t >> 12) & 0xF000u);
}
constexpr int WP = 72;
constexpr int WAVE_LDS = 2 * 32 * WP * 2 + 512;

struct KVRegs { u32x4 k[4], v[4]; };
DI void kv_store(const KVRegs& R, bf16* Ks, bf16* Vs, int lane) {
#pragma unroll
  for (int i = 0; i < 4; ++i) { const int row = (lane >> 3) + 8 * i, ch = lane & 7; *(u32x4*)(Ks + row * WP + ch * 8) = R.k[i]; *(u32x4*)(Vs + row * WP + ch * 8) = R.v[i]; }
}

DI void band_load(KVRegs& R, const bf16* Kg, const bf16* Vg, int NP, int kstart, int dil, int roff, int lane) {
#pragma unroll
  for (int i = 0; i < 4; ++i) {
    const int row = (lane >> 3) + 8 * i, ch = lane & 7; int k = kstart + row; if (k < 0) k = 0;
    const size_t off = (size_t)(dil * k + roff) * NP + ch * 8;
    R.k[i] = *(const u32x4*)(Kg + off); R.v[i] = *(const u32x4*)(Vg + off);
  }
}
template <int DVB>
DI void band_run(const bf16* Kg, const bf16* Vg, int NP, int kbase, int nsteps, int dil, int roff, int qidx, int win,
                 const bf16x8 (&qf)[4], f32x16 (&o)[DVB], float& m, float& l, float c2, bf16* Ks, bf16* Vs, int lane) {
  const int h = lane >> 5;
  KVRegs R; band_load(R, Kg, Vg, NP, kbase, dil, roff, lane);
  for (int j = 0; j < nsteps; ++j) {
    lds_fence();
    kv_store(R, Ks, Vs, lane);
    lds_fence();
    if (j + 1 < nsteps) band_load(R, Kg, Vg, NP, kbase + 32 * (j + 1), dil, roff, lane);
    const int kb = kbase + 32 * j, lo_r = (qidx - win > 0 ? qidx - win : 0) - kb;
    const unsigned vm = lane_rows(row_range_mask(lo_r, qidx - kb), h);
    attn_step32<DVB>(Ks, WP, Vs, WP, qf, o, m, l, vm, c2, lane);
  }
}

DI void write_o64(const f32x16 (&o)[2], float linv, const bf16* gate_row, bf16* y_row, int h) {
#pragma unroll
  for (int d = 0; d < 2; ++d)
#pragma unroll
    for (int g = 0; g < 4; ++g) {
      const int dd = 32 * d + 8 * g + 4 * h;
      const u32x2 gv = *(const u32x2*)(gate_row + dd);
      const float g0 = __uint_as_float(gv.x << 16), g1 = __uint_as_float(gv.x & 0xffff0000u), g2 = __uint_as_float(gv.y << 16), g3 = __uint_as_float(gv.y & 0xffff0000u);
      u32x2 w; w.x = cvtpk(o[d][4 * g] * linv * g0, o[d][4 * g + 1] * linv * g1); w.y = cvtpk(o[d][4 * g + 2] * linv * g2, o[d][4 * g + 3] * linv * g3);
      *(u32x2*)(y_row + dd) = w;
    }
}

DI void load_q(bf16x8 (&qf)[4], const bf16* qrow, int h) {
#pragma unroll
  for (int t = 0; t < 4; ++t) qf[t] = *(const bf16x8*)(qrow + t * 16 + h * 8);
}
template <int DVB> DI void zero_o(f32x16 (&o)[DVB]) {
#pragma unroll
  for (int d = 0; d < DVB; ++d)
#pragma unroll
    for (int i = 0; i < 16; ++i) o[d][i] = 0.f;
}

DI void mixerB_tile(const Params& p, int item, bf16* Ks, bf16* Vs, int lane) {
  const bf16* PE = (const bf16*)(p.ws + WS_PE); bf16* Y = (bf16*)(p.ws + WS_Y);
  const int qblk = item & 255, head = (item >> 8) & 7, b = item >> 11;
  const int r32 = lane & 31, h = lane >> 5, q0 = qblk * 32, kvh = head >> 2;
  const size_t rowb = (size_t)b * SEQ;
  bf16x8 qf[4]; load_q(qf, PE + (rowb + q0 + r32) * NPE + E_BQ + head * 64, h);
  f32x16 o[2]; zero_o<2>(o);
  const float sink2 = p.in[I_B_SINKS][head] * LOG2E;
  float m = sink2, l = (h == 0) ? 1.f : 0.f;
  band_run<2>(PE + rowb * NPE + E_BK + kvh * 64, PE + rowb * NPE + E_BV + kvh * 64, NPE, q0 - 128, 5, 1, 0, q0 + r32, 127, qf, o, m, l, 0.125f * LOG2E, Ks, Vs, lane);
  l += __shfl_xor(l, 32);
  const size_t tok = rowb + q0 + r32;
  write_o64(o, 1.f / l, PE + tok * NPE + E_BG + head * 64, Y + tok * DM + 512 + head * 64, h);
}

DI void mixerC_tile(const Params& p, int item, bf16* Ks, bf16* Vs, int lane) {
  const bf16* PO = (const bf16*)(p.ws + WS_PE); bf16* Y = (bf16*)(p.ws + WS_Y);
  const int qt = item & 15, r16 = (item >> 4) & 15, head = (item >> 8) & 7, b = item >> 11;
  const int r32 = lane & 31, h = lane >> 5, qi0 = qt * 32;
  const size_t rowb = (size_t)b * SEQ;
  const int t = 16 * (qi0 + r32) + r16;
  bf16x8 qf[4]; load_q(qf, PO + (rowb + t) * NPO + O_CQ + head * 64, h);
  f32x16 o[2]; zero_o<2>(o);
  float m = -1e30f, l = 0.f;
  const bf16* Kg = PO + rowb * NPO + O_CK + head * 64; const bf16* Vg = PO + rowb * NPO + O_CV + head * 64;
  const float c2 = 0.125f * LOG2E;
  band_run<2>(Kg, Vg, NPO, qi0 - 128, 5, 16, r16, qi0 + r32, 128, qf, o, m, l, c2, Ks, Vs, lane);
  band_run<2>(Kg, Vg, NPO, 4 * qi0 + (r16 >> 2) - 128, 8, 4, r16 & 3, 4 * (qi0 + r32) + (r16 >> 2), 128, qf, o, m, l, c2, Ks, Vs, lane);
  band_run<2>(Kg, Vg, NPO, 16 * qi0 + r16 - 128, 20, 1, 0, t, 128, qf, o, m, l, c2, Ks, Vs, lane);
  l += __shfl_xor(l, 32);
  const size_t tok = rowb + t;
  write_o64(o, 1.f / l, PO + tok * NPO + O_CG + head * 64, Y + tok * DM + head * 64, h);
}

DI void mixerA_item(const Params& p, int item, bf16* Ks, bf16* Vs, int lane) {
  const bf16* PE = (const bf16*)(p.ws + WS_PE); bf16* Y = (bf16*)(p.ws + WS_Y);
  const unsigned short* SEL = (const unsigned short*)(p.ws + WS_SEL) + (size_t)item * 256;
  const int t = item & (SEQ - 1), b = item >> 13;
  const int r32 = lane & 31, h = lane >> 5, head = r32 & 7;
  const size_t rowb = (size_t)b * SEQ;
  const int count = (t + 1 < 256) ? t + 1 : 256, nsteps = (count + 31) >> 5;
  bf16x8 qf[4]; load_q(qf, PE + (size_t)item * NPE + E_AQ + head * 64, h);
  f32x16 o[2]; zero_o<2>(o);
  float m = -1e30f, l = 0.f;
  const bf16* Kg = PE + rowb * NPE + E_AK; const bf16* Vg = PE + rowb * NPE + E_AV;
  KVRegs R;
  unsigned short* sel_l = (unsigned short*)(Vs + 32 * WP);
  lds_fence();
  *(u32x2*)(sel_l + 4 * lane) = *(const u32x2*)(SEL + 4 * lane);
  lds_fence();
#define A_LOAD(j) do { _Pragma("unroll") for (int i = 0; i < 4; ++i) { const int row = (lane >> 3) + 8 * i, ch = lane & 7, e = 32 * (j) + row; \
      const int tokk = (e < count) ? (int)sel_l[e] : 0; const size_t off = (size_t)tokk * NPE + ch * 8; R.k[i] = *(const u32x4*)(Kg + off); R.v[i] = *(const u32x4*)(Vg + off); } } while (0)
  A_LOAD(0);
  for (int j = 0; j < nsteps; ++j) {
    lds_fence();
    kv_store(R, Ks, Vs, lane);
    lds_fence();
    if (j + 1 < nsteps) A_LOAD(j + 1);
    const unsigned vm = lane_rows(row_range_mask(0, count - 1 - 32 * j), h);
    attn_step32<2>(Ks, WP, Vs, WP, qf, o, m, l, vm, 0.125f * LOG2E, lane);
  }
#undef A_LOAD
  l += __shfl_xor(l, 32);
  if (r32 < 8) write_o64(o, 1.f / l, PE + (size_t)item * NPE + E_AG + head * 64, Y + (size_t)item * DM + head * 64, h);
}

DI unsigned f2ord(float f) { f += 0.f; const unsigned u = __float_as_uint(f); return (u & 0x80000000u) ? ~u : (u | 0x80000000u); }
DI int block_excl_scan(int v, int* tmp, int* tot) {
  const int lane = threadIdx.x & 63, wid = threadIdx.x >> 6;
  int inc = v;
#pragma unroll
  for (int o = 1; o < 64; o <<= 1) { const int u = __shfl_up(inc, o); if (lane >= o) inc += u; }
  if (lane == 63) tmp[wid] = inc;
  __syncthreads();
  int base = 0, total = 0;
#pragma unroll
  for (int w = 0; w < 8; ++w) { const int x = tmp[w]; if (w < wid) base += x; total += x; }
  *tot = total;
  return base + inc - v;
}

DI float dpp_sum8(float v) {
  v += __builtin_bit_cast(float, __builtin_amdgcn_mov_dpp(__builtin_bit_cast(int, v), 0xB1, 0xF, 0xF, true));
  v += __builtin_bit_cast(float, __builtin_amdgcn_mov_dpp(__builtin_bit_cast(int, v), 0x4E, 0xF, 0xF, true));
  v += __builtin_bit_cast(float, __builtin_amdgcn_mov_dpp(__builtin_bit_cast(int, v), 0x141, 0xF, 0xF, true));
  return v;
}
DI void hist_find(const int* hist, int* misc, int need, int& digit, int& nneed, int& cnt) {
  const int tid = threadIdx.x;
  typedef int i32x4 __attribute__((ext_vector_type(4)));
  const i32x4 h0 = *(const i32x4*)(hist + tid * 8), h1 = *(const i32x4*)(hist + tid * 8 + 4);
  int hh[8] = {h0.x, h0.y, h0.z, h0.w, h1.x, h1.y, h1.z, h1.w}; int tot = 0;
#pragma unroll
  for (int k = 0; k < 8; ++k) tot += hh[k];
  int total; const int ex = block_excl_scan(tot, misc, &total);
  int above = total - ex - tot;
#pragma unroll
  for (int k = 7; k >= 0; --k) { const int c = hh[k]; if (above < need && above + c >= need) { misc[16] = tid * 8 + k; misc[17] = need - above; misc[18] = c; } above += c; }
  __syncthreads();
  digit = misc[16]; nneed = misc[17]; cnt = misc[18];
  __syncthreads();
}
DI unsigned long long mkcmp(float v, int idx) { return ((unsigned long long)f2ord(v) << 16) | ((unsigned long long)(8191 - idx) << 3); }
DI float ord2f(unsigned k) { return __uint_as_float((k & 0x80000000u) ? (k ^ 0x80000000u) : ~k); }
DI float half_sum(float v) { auto rr = __builtin_amdgcn_permlane32_swap(__float_as_uint(v), __float_as_uint(v), false, false); return __uint_as_float(rr[0]) + __uint_as_float(rr[1]); }

constexpr int CL_CAP = 512;
DI void select_slow(const float* scq, int n, unsigned short* out, float lo, float hi, int* hist, int* misc, unsigned long long* clist) {
  const int tid = opaque_tid();
    const float scale = (hi > lo) ? 4095.f / (hi - lo) : 0.f;
    for (int i = tid; i < 4096; i += 512) hist[i] = 0;
    if (tid == 0) misc[20] = 0;
    __syncthreads();
    float val[16]; int bin[16];
#pragma unroll
    for (int i = 0; i < 16; ++i) { const int idx = tid + 512 * i; const float v = (idx < n) ? scq[idx] : lo; val[i] = v;
      int bb = (int)((v - lo) * scale); bb = bb < 0 ? 0 : (bb > 4095 ? 4095 : bb); bin[i] = bb; if (idx < n) atomicAdd(&hist[bb], 1); }
    __syncthreads();
    int bstar, need, cnt;
    hist_find(hist, misc, 256, bstar, need, cnt);
    unsigned long long T = 0ull;
    if (cnt != need) {
      if (cnt <= CL_CAP) {
#pragma unroll
        for (int i = 0; i < 16; ++i) { const int idx = tid + 512 * i; if (idx < n && bin[i] == bstar) { const int slot = atomicAdd(&misc[20], 1); clist[slot] = mkcmp(val[i], idx); } }
        __syncthreads();
        if (tid < cnt) { const unsigned long long c = clist[tid]; int rank = 0; for (int jx = 0; jx < cnt; ++jx) rank += (clist[jx] > c) ? 1 : 0;
          if (rank == need - 1) { misc[21] = (int)(unsigned)(c & 0xffffffffull); misc[22] = (int)(unsigned)(c >> 32); } }
        __syncthreads();
        T = ((unsigned long long)(unsigned)misc[22] << 32) | (unsigned long long)(unsigned)misc[21];
      } else {
        unsigned long long prefix = 0ull; int shift = 36;
        for (int pass = 0; pass < 4; ++pass) {
          for (int i = tid; i < 4096; i += 512) hist[i] = 0;
          __syncthreads();
#pragma unroll
          for (int i = 0; i < 16; ++i) { const int idx = tid + 512 * i; if (idx < n && bin[i] == bstar) { const unsigned long long c = mkcmp(val[i], idx); if (pass == 0 || (c >> (shift + 12)) == prefix) atomicAdd(&hist[(int)((c >> shift) & 4095ull)], 1); } }
          __syncthreads();
          int digit, nneed, c2;
          hist_find(hist, misc, need, digit, nneed, c2);
          prefix = (prefix << 12) | (unsigned long long)digit; need = nneed;
          if (c2 == need) break;
          shift -= 12;
        }
        T = prefix << shift;
      }
    }
    int mycnt = 0; unsigned selm = 0;
#pragma unroll
    for (int i = 0; i < 16; ++i) { const int idx = tid + 512 * i;
      bool sel = false;
      if (idx < n) { if (bin[i] > bstar) sel = true; else if (bin[i] == bstar) sel = (mkcmp(val[i], idx) >= T); }
      if (sel) { ++mycnt; selm |= (1u << i); } }
    int total; int pos = block_excl_scan(mycnt, misc + 8, &total);
#pragma unroll
    for (int i = 0; i < 16; ++i) { if ((selm >> i) & 1u) { if (pos < 256) out[pos] = (unsigned short)(tid + 512 * i); ++pos; } }
    __syncthreads();
}

DI void sel_load_qw(const Params& p, int item, bf16x8 (&qf)[4], float (&wq)[16], int lane) {
  const bf16* PE = (const bf16*)(p.ws + WS_PE); const float* IW = (const float*)(p.ws + WS_IW);
  const int r32 = lane & 31, h = lane >> 5, b = item >> 11, t0 = (item & 2047) * 4; const size_t rowb = (size_t)b * SEQ;
  load_q(qf, PE + (rowb + t0 + (r32 >> 3)) * NPE + E_IQ + (r32 & 7) * 64, h);
#pragma unroll
  for (int q = 0; q < 4; ++q) { const f32x4 w4 = *(const f32x4*)(IW + (rowb + t0 + q) * 8 + 4 * h);
    wq[4 * q] = w4.x * 0.04419417382415922f; wq[4 * q + 1] = w4.y * 0.04419417382415922f; wq[4 * q + 2] = w4.z * 0.04419417382415922f; wq[4 * q + 3] = w4.w * 0.04419417382415922f; }
}
DI void selectA_item(const Params& p, int item, int next_item, char* lds, bf16x8 (&qf)[4], float (&wq)[16]) {
  const bf16* PE = (const bf16*)(p.ws + WS_PE);
  const float* IW = (const float*)(p.ws + WS_IW);
  unsigned short* SEL = (unsigned short*)(p.ws + WS_SEL);
  float* sc = (float*)lds;
  int* hist = (int*)(lds + 4 * 8192 * 4);
  int* misc = hist + 4096;
  unsigned* mm = (unsigned*)(misc + 24);
  unsigned long long* clist = (unsigned long long*)(misc + 96);
  const int tid = opaque_tid(), lane = tid & 63, wid = tid >> 6, r32 = lane & 31, h = lane >> 5;
  const int b = item >> 11, t0 = (item & 2047) * 4;
  const size_t rowb = (size_t)b * SEQ;
  const int nk = t0 + 4, ntile = (nk + 31) >> 5;
  if (tid < 4) { mm[tid * 2] = 0xFFFFFFFFu; mm[tid * 2 + 1] = 0u; }
  lds_barrier();
  const bf16* Kt = (const bf16*)(p.ws + WS_IKS) + (size_t)b * 256 * 2048 + lane * 8;
  {
    bf16x8 kf[4], kn[4];
#pragma unroll
    for (int t = 0; t < 4; ++t) { kf[t] = (bf16x8){0, 0, 0, 0, 0, 0, 0, 0}; kn[t] = kf[t]; }
    if (wid < ntile) {
#pragma unroll
      for (int t = 0; t < 4; ++t) kf[t] = *(const bf16x8*)(Kt + (size_t)wid * 2048 + t * 512);
    }
    float lo0 = INFINITY, hi0 = -INFINITY, lo1 = INFINITY, hi1 = -INFINITY;
    for (int kt = wid; kt < ntile; kt += 8) {
      if (kt + 8 < ntile) {
#pragma unroll
        for (int t = 0; t < 4; ++t) kn[t] = *(const bf16x8*)(Kt + (size_t)(kt + 8) * 2048 + t * 512);
      }
      f32x16 s;
#pragma unroll
      for (int i = 0; i < 16; ++i) s[i] = 0.f;
#pragma unroll
      for (int t = 0; t < 4; ++t) s = mfma32(qf[t], kf[t], s);
      float v[4];
#pragma unroll
      for (int q = 0; q < 4; ++q) {
        float a = wq[4 * q] * fmaxf(s[4 * q], 0.f);
#pragma unroll
        for (int jj = 1; jj < 4; ++jj) a += wq[4 * q + jj] * fmaxf(s[4 * q + jj], 0.f);
        v[q] = half_sum(a) + 0.f;
      }
      const float va = h ? v[2] : v[0], vb = h ? v[3] : v[1];
      const int key = kt * 32 + r32;
      sc[(2 * h) * 8192 + key] = va; sc[(2 * h + 1) * 8192 + key] = vb;
      lo0 = fminf(lo0, va); hi0 = fmaxf(hi0, va); lo1 = fminf(lo1, vb); hi1 = fmaxf(hi1, vb);
#pragma unroll
      for (int t = 0; t < 4; ++t) kf[t] = kn[t];
    }
    if (wid < ntile) {
#pragma unroll
      for (int o = 1; o < 32; o <<= 1) { lo0 = fminf(lo0, __shfl_xor(lo0, o)); hi0 = fmaxf(hi0, __shfl_xor(hi0, o)); lo1 = fminf(lo1, __shfl_xor(lo1, o)); hi1 = fmaxf(hi1, __shfl_xor(hi1, o)); }
      if (r32 == 0) { atomicMin(&mm[(2 * h) * 2], f2ord(lo0)); atomicMax(&mm[(2 * h) * 2 + 1], f2ord(hi0)); atomicMin(&mm[(2 * h + 1) * 2], f2ord(lo1)); atomicMax(&mm[(2 * h + 1) * 2 + 1], f2ord(hi1)); }
    }
  }
  if (next_item >= 0) sel_load_qw(p, next_item, qf, wq, lane);
  lds_barrier();
  {
    const int g = wid >> 1, gt = tid & 127, upper = wid & 1;
    const int t = t0 + g, n = t + 1;
    const bool big = n > 256;
    const float* scq = sc + g * 8192;
    unsigned short* out = SEL + (rowb + t) * 256;
    int* histq = hist + g * 1024;
    unsigned long long* clq = clist + g * 128;
    int* mq = misc + 32 + g * 8;
    const float lo = ord2f(mm[g * 2]), hi = ord2f(mm[g * 2 + 1]);
    const float scale = (hi > lo) ? 1023.f / (hi - lo) : 0.f;
    for (int i = gt; i < 1024; i += 128) histq[i] = 0;
    if (gt == 0) { mq[0] = 0; mq[6] = 0; }
    lds_barrier();
    float uu[64];
#pragma unroll
    for (int i = 0; i < 64; ++i) { const int idx = gt + 128 * i; const float v = (idx < n) ? scq[idx] : lo; const float u = (v - lo) * scale; uu[i] = u;
      if (big && idx < n) { int bb = (int)u; bb = bb > 1023 ? 1023 : bb; atomicAdd(&histq[bb], 1); } }
    lds_barrier();
    typedef int i32x4 __attribute__((ext_vector_type(4)));
    const i32x4 h0 = *(const i32x4*)(histq + gt * 8), h1 = *(const i32x4*)(histq + gt * 8 + 4);
    const int hh[8] = {h0.x, h0.y, h0.z, h0.w, h1.x, h1.y, h1.z, h1.w};
    int tot = 0;
#pragma unroll
    for (int k = 0; k < 8; ++k) tot += hh[k];
    int inc = tot;
#pragma unroll
    for (int o = 1; o < 64; o <<= 1) { const int ux = __shfl_down(inc, o); if (lane + o < 64) inc += ux; }
    if (lane == 0) misc[wid] = inc;
    lds_barrier();
    {
      int above = inc - tot + (upper ? 0 : misc[wid + 1]);
      if (big) {
#pragma unroll
        for (int k = 7; k >= 0; --k) { const int c = hh[k]; if (above < 256 && above + c >= 256) { mq[1] = gt * 8 + k; mq[2] = 256 - above; mq[3] = c; } above += c; }
      }
    }
    lds_barrier();
    const int bstar = mq[1], need = mq[2], cnt = mq[3];
    const float flo = (float)bstar, fhi = (bstar >= 1023) ? INFINITY : (float)(bstar + 1);
    const bool tie = big && cnt != need;
    if (tie) {
      if (cnt <= 128) {
#pragma unroll
        for (int i = 0; i < 64; ++i) { const int idx = gt + 128 * i; if (idx < n && uu[i] >= flo && uu[i] < fhi) { const int slot = atomicAdd(&mq[0], 1); clq[slot] = mkcmp(scq[idx], idx); } }
      } else if (gt == 0) mq[6] = 1;
    }
    lds_barrier();
    if (tie && cnt <= 128 && gt < cnt) { const unsigned long long c = clq[gt]; int rank = 0; for (int jx = 0; jx < cnt; ++jx) rank += (clq[jx] > c) ? 1 : 0;
      if (rank == need - 1) { mq[4] = (int)(unsigned)(c & 0xffffffffull); mq[5] = (int)(unsigned)(c >> 32); } }
    lds_barrier();
    const unsigned long long T = tie ? (((unsigned long long)(unsigned)mq[5] << 32) | (unsigned long long)(unsigned)mq[4]) : 0ull;
    const bool fast = big && !(tie && cnt > 128);
    unsigned long long selm = 0ull;
    if (fast) {
#pragma unroll
      for (int i = 0; i < 64; ++i) { const int idx = gt + 128 * i;
        if (idx < n) { const float u = uu[i]; bool sel = u >= fhi; if (!sel && u >= flo) sel = !tie || (mkcmp(scq[idx], idx) >= T); if (sel) selm |= (1ull << i); } }
    }
    const int mycnt = __popcll(selm);
    int pinc = mycnt;
#pragma unroll
    for (int o = 1; o < 64; o <<= 1) { const int ux = __shfl_up(pinc, o); if (lane >= o) pinc += ux; }
    if (lane == 63) misc[8 + wid] = pinc;
    lds_barrier();
    if (fast) {
      int pos = pinc - mycnt + (upper ? misc[8 + wid - 1] : 0);
      while (selm) { const int i = __ffsll((long long)selm) - 1; selm &= selm - 1ull; if (pos < 256) out[pos] = (unsigned short)(gt + 128 * i); ++pos; }
    } else if (!big) {
      for (int i = gt; i < n; i += 128) out[i] = (unsigned short)i;
    }
    lds_barrier();
  }
  for (int q = 0; q < 4; ++q) {
    if (misc[32 + q * 8 + 6]) { const int t = t0 + q; select_slow(sc + q * 8192, t + 1, SEL + (rowb + t) * 256, ord2f(mm[q * 2]), ord2f(mm[q * 2 + 1]), hist, misc, clist); }
  }
  lds_barrier();
}

constexpr int DKP = 72, DVP = 136;
constexpr int D_STAGE = (64 * DKP * 2 + 64 * DVP) * 2;
DI void mixerD_unit(const Params& p, int b, int head, int qb, char* lds) {
  const bf16* PO = (const bf16*)(p.ws + WS_PE); bf16* Y = (bf16*)(p.ws + WS_Y);
  const int tid = opaque_tid(), lane = tid & 63, wid = tid >> 6, r32 = lane & 31, h = lane >> 5;
  const int map = wid & 1, qsub = wid >> 1;
  const size_t rowb = (size_t)b * SEQ;
  const int qpos = 128 * qb + 32 * qsub + r32;
  bf16x8 qf[4]; load_q(qf, PO + (rowb + qpos) * NPO + O_DQ + (2 * head + map) * 64, h);
  f32x16 o[4]; zero_o<4>(o);
  float m = -1e30f, l = 0.f;
  const int nsteps = 2 * qb + 2;
  const bf16* K1g = PO + rowb * NPO + O_DK + (2 * head) * 64;
  const bf16* K2g = K1g + 64;
  const bf16* Vg = PO + rowb * NPO + O_DV + head * 128;
  u32x4 rk1, rk2, rv[2];
#define D_LOAD(j) do { const int row = tid >> 3, ch = tid & 7; const size_t off = (size_t)((j) * 64 + row) * NPO + ch * 8; rk1 = *(const u32x4*)(K1g + off); rk2 = *(const u32x4*)(K2g + off); \
    _Pragma("unroll") for (int i = 0; i < 2; ++i) { const int c = tid + 512 * i, vr = c >> 4, vc = c & 15; rv[i] = *(const u32x4*)(Vg + (size_t)((j) * 64 + vr) * NPO + vc * 8); } } while (0)
  __syncthreads();
  D_LOAD(0);
  for (int j = 0; j < nsteps; ++j) {
    char* st = lds + (j & 1) * D_STAGE;
    bf16* K1s = (bf16*)st; bf16* K2s = K1s + 64 * DKP; bf16* Vs = K2s + 64 * DKP;
    { const int row = tid >> 3, ch = tid & 7; *(u32x4*)(K1s + row * DKP + ch * 8) = rk1; *(u32x4*)(K2s + row * DKP + ch * 8) = rk2;
#pragma unroll
      for (int i = 0; i < 2; ++i) { const int c = tid + 512 * i, vr = c >> 4, vc = c & 15; *(u32x4*)(Vs + vr * DVP + vc * 8) = rv[i]; } }
    __syncthreads();
    if (j + 1 < nsteps) D_LOAD(j + 1);
    const bf16* Ks = map ? K2s : K1s;
#pragma unroll
    for (int sub = 0; sub < 2; ++sub) {
      const int k0 = j * 64 + sub * 32;
      if (k0 <= 128 * qb + 32 * qsub + 31) {
        if (k0 + 31 <= 128 * qb + 32 * qsub) {
          attn_step32<4, false>(Ks + sub * 32 * DKP, DKP, Vs + sub * 32 * DVP, DVP, qf, o, m, l, 0xffffu, 0.125f * LOG2E, lane);
        } else {
          unsigned vm = 0;
#pragma unroll
          for (int i = 0; i < 16; ++i) if (k0 + crow(i, h) <= qpos) vm |= (1u << i);
          attn_step32<4, true>(Ks + sub * 32 * DKP, DKP, Vs + sub * 32 * DVP, DVP, qf, o, m, l, vm, 0.125f * LOG2E, lane);
        }
      }
    }
  }
#undef D_LOAD
  l += __shfl_xor(l, 32);
  const float linv = 1.f / l;
  __syncthreads();
  float* xch = (float*)lds + qsub * 4096;
  if (map == 1) {
#pragma unroll
    for (int d = 0; d < 4; ++d)
#pragma unroll
      for (int i = 0; i < 16; ++i) xch[(d * 16 + i) * 64 + lane] = o[d][i] * linv;
  }
  __syncthreads();
  if (map == 0) {
    const float lam = *(const float*)(p.ws + WS_LAM);
    float ssq = 0.f;
#pragma unroll
    for (int d = 0; d < 4; ++d)
#pragma unroll
      for (int i = 0; i < 16; ++i) { const float a = o[d][i] * linv - lam * xch[(d * 16 + i) * 64 + lane]; o[d][i] = a; ssq += a * a; }
    ssq += __shfl_xor(ssq, 32);
    const float lambda_init = 0.8f - 0.6f * expf(-0.3f);
    const float rn = rsqrtf(ssq * (1.f / 128.f) + EPS) * (1.f - lambda_init);
    const size_t tok = rowb + qpos;
    const bf16* gate = PO + tok * NPO + O_DG + head * 128;
    bf16* y = Y + tok * DM + 512 + head * 128;
    const float* sg = p.in[I_SUB_GAIN];
#pragma unroll
    for (int d = 0; d < 4; ++d)
#pragma unroll
      for (int g = 0; g < 4; ++g) {
        const int dd = 32 * d + 8 * g + 4 * h;
        const u32x2 gv = *(const u32x2*)(gate + dd); const f32x4 s4 = *(const f32x4*)(sg + dd);
        const float g0 = __uint_as_float(gv.x << 16), g1 = __uint_as_float(gv.x & 0xffff0000u), g2 = __uint_as_float(gv.y << 16), g3 = __uint_as_float(gv.y & 0xffff0000u);
        u32x2 w; w.x = cvtpk(o[d][4 * g] * rn * s4.x * g0, o[d][4 * g + 1] * rn * s4.y * g1); w.y = cvtpk(o[d][4 * g + 2] * rn * s4.z * g2, o[d][4 * g + 3] * rn * s4.w * g3);
        *(u32x2*)(y + dd) = w;
      }
  }
  __syncthreads();
}

#define XB_TMO      128
#define XB_XCNT(j)  (256  + 64 * (j))
#define XB_XSUB(j)  (1280 + 64 * (j))
#define XB_XGEN(j)  (2304 + 64 * (j))
#define XB_TOP      3328
#define XB_TOPGEN   3392
#define XCD_BAR_WORDS 3456
#define XB_SPIN_CAP (1u << 18)

__device__ __forceinline__ unsigned xb_ld(unsigned* p)              { return __hip_atomic_load(p, __ATOMIC_RELAXED, __HIP_MEMORY_SCOPE_AGENT); }
__device__ __forceinline__ unsigned xb_add(unsigned* p, unsigned v) { return __hip_atomic_fetch_add(p, v, __ATOMIC_RELAXED, __HIP_MEMORY_SCOPE_AGENT); }
__device__ __forceinline__ unsigned xb_xcc_id() { return (unsigned)__builtin_amdgcn_s_getreg((3 << 11) | 20) & 0xFu; }
#define XB_SPIN(cond, bar) do { unsigned _sp = 0; while (cond) { __builtin_amdgcn_s_sleep(1); \
    if ((++_sp & 255u) == 0u) { if (xb_ld(&(bar)[XB_TMO])) break; if (_sp > XB_SPIN_CAP) { atomicAdd(&(bar)[XB_TMO], 1u); break; } } } } while (0)

struct XcdBarrier {
    unsigned* bar; unsigned x;
    volatile LAS unsigned* st;
};

__device__ __forceinline__ XcdBarrier xcd_barrier_post(unsigned* bar, volatile LAS unsigned* st) {
    XcdBarrier b; b.bar = bar; b.x = xb_xcc_id(); b.st = st;
    if (threadIdx.x == 0) (void)xb_add(&bar[XB_XCNT(b.x)], 1u);
    return b;
}
__device__ __forceinline__ void xcd_barrier_complete(unsigned* bar, unsigned x, unsigned& nloc, unsigned& nx) {
    const unsigned G = gridDim.x * gridDim.y * gridDim.z;
    unsigned sum, cnt, mine, sp = 0u;
    for (;;) {
        sum = 0u; cnt = 0u; mine = 0u;
#pragma unroll
        for (unsigned j = 0; j < 16; ++j) { const unsigned c = xb_ld(&bar[XB_XCNT(j)]); sum += c; cnt += (c > 0u) ? 1u : 0u; mine = (j == x) ? c : mine; }
        if (sum == G) break;
        __builtin_amdgcn_s_sleep(1);
        if ((++sp & 255u) == 0u) { if (xb_ld(&bar[XB_TMO])) break; if (sp > XB_SPIN_CAP) { atomicAdd(&bar[XB_TMO], 1u); break; } }
    }
    nloc = mine > 0u ? mine : 1u; nx = cnt > 0u ? cnt : 1u;
}

__device__ __forceinline__ void xcd_barrier(const XcdBarrier& b) {
    asm volatile("s_waitcnt vmcnt(0)" ::: "memory");
    __syncthreads();
    if (threadIdx.x == 0) {
        unsigned* bar = b.bar;
        __builtin_amdgcn_s_waitcnt(0);
        unsigned nloc = b.st[0], nx = b.st[1];
        if (nloc == 0u) { xcd_barrier_complete(bar, b.x, nloc, nx); b.st[0] = nloc; b.st[1] = nx; }
        const unsigned old = xb_add(&bar[XB_XSUB(b.x)], 1u);
        const unsigned gen = old / nloc;
        if (old + 1u == (gen + 1u) * nloc) {
            __builtin_amdgcn_fence(__ATOMIC_RELEASE, "agent");
            asm volatile("s_waitcnt vmcnt(0)" ::: "memory");
            const unsigned og = xb_add(&bar[XB_TOP], 1u);
            const unsigned tg = og / nx;
            if (og + 1u == (tg + 1u) * nx) xb_add(&bar[XB_TOPGEN], 1u);
            else XB_SPIN(xb_ld(&bar[XB_TOPGEN]) == tg, bar);
            __builtin_amdgcn_fence(__ATOMIC_ACQUIRE, "agent");
            xb_add(&bar[XB_XGEN(b.x)], 1u);
            asm volatile("s_waitcnt vmcnt(0)" ::: "memory");
        } else {
            XB_SPIN(xb_ld(&bar[XB_XGEN(b.x)]) == gen, bar);
            __builtin_amdgcn_fence(__ATOMIC_ACQUIRE, "agent");
            asm volatile("s_waitcnt vmcnt(0)" ::: "memory");
        }
    }
    __syncthreads();
}


__global__ void __launch_bounds__(NTHREADS) fwd_kernel(Params p) {
  extern __shared__ __attribute__((aligned(16))) char smem[];
  cg::grid_group grid = cg::this_grid();
  char* lds = smem;
  volatile LAS unsigned* xb_st = (volatile LAS unsigned*)((LAS char*)smem + (LDS_BYTES - 16));
  if (threadIdx.x < 2) xb_st[threadIdx.x] = 0u;
  __syncthreads();
  const XcdBarrier xbar = xcd_barrier_post((unsigned*)(p.ws + WS_BAR), xb_st);
#define FRESH_IDS const int tid = opaque_tid(), lane = tid & 63, wid = tid >> 6; const int gw = blockIdx.x * 8 + wid, ngw = gridDim.x * 8; bf16* Ks = (bf16*)(lds + wid * WAVE_LDS); bf16* Vs = Ks + 32 * WP; (void)gw; (void)ngw; (void)Ks; (void)Vs; (void)lane;

  phase_prologue(p, lds);
  if (p.ws == nullptr) grid.sync();
  xcd_barrier(xbar);
  for (int rep = 0; rep < REP_GEMM; ++rep) phase_inproj(p, 0, lds);
  xcd_barrier(xbar);
#if EN_A
  for (int rep = 0; rep < REP_SELA; ++rep) { FRESH_IDS
#define SEL_ITEM(k) ((k) * (int)gridDim.x + (((k) & 1) ? (int)gridDim.x - 1 - (int)blockIdx.x : (int)blockIdx.x))
    bf16x8 sqf[4]; float swq[16];
    if (SEL_ITEM(0) < 2 * 2048) sel_load_qw(p, SEL_ITEM(0), sqf, swq, lane);
    for (int k = 0; k * (int)gridDim.x < 2 * 2048; ++k) { const int it = SEL_ITEM(k); int nx = SEL_ITEM(k + 1); if (nx >= 2 * 2048) nx = -1; if (it < 2 * 2048) selectA_item(p, it, nx, lds, sqf, swq); }
#undef SEL_ITEM
  }
  xcd_barrier(xbar);
  { FRESH_IDS for (int rep = 0; rep < REP_AATT; ++rep) for (int it = gw; it < NTOK; it += ngw) mixerA_item(p, it, Ks, Vs, lane); }
#else
  { unsigned* y = (unsigned*)(p.ws + WS_Y); for (int i = blockIdx.x * NTHREADS + (int)threadIdx.x; i < NTOK * 256; i += gridDim.x * NTHREADS) { const int row = i >> 8, c = i & 255; y[row * 512 + c] = 0u; } }
#endif
#if EN_B
  { FRESH_IDS for (int it = gw; it < 4096; it += ngw) mixerB_tile(p, it, Ks, Vs, lane); }
#else
  { unsigned* y = (unsigned*)(p.ws + WS_Y); for (int i = blockIdx.x * NTHREADS + (int)threadIdx.x; i < NTOK * 256; i += gridDim.x * NTHREADS) { const int row = i >> 8, c = i & 255; y[row * 512 + 256 + c] = 0u; } }
#endif
  xcd_barrier(xbar);
  phase_outproj(p, 0, lds);
  xcd_barrier(xbar);
  phase_ple(p, 0, lds);
  xcd_barrier(xbar);
  phase_inproj(p, 1, lds);
  xcd_barrier(xbar);
#if EN_D
  for (int rep = 0; rep < REP_D; ++rep) {
#pragma unroll 1
    for (int u2 = blockIdx.x * 2; u2 < 512; u2 += gridDim.x * 2) {
#pragma unroll 1
      for (int k = 0; k < 2; ++k) { const int u = u2 >> 1, bh = u >> 5, pr = u & 31; mixerD_unit(p, bh >> 2, bh & 3, k ? 63 - pr : pr, lds); }
    }
  }
#else
  { unsigned* y = (unsigned*)(p.ws + WS_Y); for (int i = blockIdx.x * NTHREADS + (int)threadIdx.x; i < NTOK * 256; i += gridDim.x * NTHREADS) { const int row = i >> 8, c = i & 255; y[row * 512 + 256 + c] = 0u; } }
#endif
#if EN_C
  __syncthreads();
  { FRESH_IDS for (int rep = 0; rep < REP_C; ++rep) for (int it = gw; it < 4096; it += ngw) mixerC_tile(p, it, Ks, Vs, lane); }
#else
  { unsigned* y = (unsigned*)(p.ws + WS_Y); for (int i = blockIdx.x * NTHREADS + (int)threadIdx.x; i < NTOK * 256; i += gridDim.x * NTHREADS) { const int row = i >> 8, c = i & 255; y[row * 512 + c] = 0u; } }
#endif
  xcd_barrier(xbar);
  phase_outproj(p, 1, lds);
  xcd_barrier(xbar);
  phase_ple(p, 1, lds);
}

extern "C" void kernel_launch(void* const* d_in, const int* in_sizes, int n_in, void* d_out, int out_size, void* d_ws, size_t ws_size, hipStream_t stream) {
  static int grid_blocks = 0;
  if (!grid_blocks) {
    int dev = 0, cus = 0, per_cu = 0;
    hipGetDevice(&dev);
    hipDeviceGetAttribute(&cus, hipDeviceAttributeMultiprocessorCount, dev);
    hipFuncSetAttribute((const void*)fwd_kernel, hipFuncAttributeMaxDynamicSharedMemorySize, LDS_BYTES);
    hipOccupancyMaxActiveBlocksPerMultiprocessor(&per_cu, (const void*)fwd_kernel, NTHREADS, LDS_BYTES);
    if (per_cu < 1) per_cu = 1;
    grid_blocks = cus * per_cu;
    if (grid_blocks > 256) grid_blocks = 256;
  }
  Params p{};
  for (int i = 0; i < 25; ++i) p.in[i] = (const float*)d_in[i];
  p.out = (float*)d_out; p.ws = (unsigned char*)d_ws;
  for (int i = 0; i < 32; ++i) p.inv_freq[i] = (float)pow(10000.0, -(double)i / 32.0);
  (void)hipMemsetAsync((char*)d_ws + WS_BAR, 0, 16384, stream);
  void* args[] = {&p};
  hipError_t e = hipLaunchCooperativeKernel((const void*)fwd_kernel, dim3(grid_blocks), dim3(NTHREADS), args, LDS_BYTES, stream);
  if (e != hipSuccess) fprintf(stderr, "cooperative launch failed: %s (grid %d)\n", hipGetErrorString(e), grid_blocks);
}
```

```cpp
#include <hip/hip_runtime.h>
#include <hip/hip_cooperative_groups.h>
#include <cstdio>
#include <cmath>
namespace cg = cooperative_groups;

#ifndef REP_GEMM
#define REP_GEMM 1
#endif
#ifndef REP_SELA
#define REP_SELA 1
#endif
#ifndef REP_D
#define REP_D 1
#endif
#ifndef REP_C
#define REP_C 1
#endif
#ifndef REP_AATT
#define REP_AATT 1
#endif
#ifndef EN_A
#define EN_A 1
#endif
#ifndef EN_B
#define EN_B 1
#endif
#ifndef EN_C
#define EN_C 1
#endif
#ifndef EN_D
#define EN_D 1
#endif

typedef unsigned short bf16;
typedef short bf16x8 __attribute__((ext_vector_type(8)));
typedef short s16x4 __attribute__((ext_vector_type(4)));
typedef float f32x4 __attribute__((ext_vector_type(4)));
typedef float f32x16 __attribute__((ext_vector_type(16)));
typedef unsigned u32x4 __attribute__((ext_vector_type(4)));
typedef unsigned u32x2 __attribute__((ext_vector_type(2)));
typedef float f32x2_t __attribute__((ext_vector_type(2)));
typedef __bf16 bf16x2_t __attribute__((ext_vector_type(2)));
#define LAS __attribute__((address_space(3)))
#define DI __device__ __forceinline__

constexpr int SEQ = 8192, NTOK = 16384, DM = 1024;
constexpr int NPE = 3072, NPO = 4096;
constexpr float EPS = 1e-6f;
constexpr float LOG2E = 1.4426950408889634f;
constexpr int NTHREADS = 512;
constexpr int LDS_BYTES = 150 * 1024;

constexpr size_t MiB = 1u << 20;
constexpr size_t WS_PE = 0;
constexpr size_t WS_ACT = 128 * MiB;
constexpr size_t WS_Y = 160 * MiB;
constexpr size_t WS_WINE = 192 * MiB;
constexpr size_t WS_WOUTE = 198 * MiB;
constexpr size_t WS_WINO = 200 * MiB;
constexpr size_t WS_WOUTO = 208 * MiB;
constexpr size_t WS_WG0 = 210 * MiB;
constexpr size_t WS_WG1 = 212 * MiB;
constexpr size_t WS_WP0 = 214 * MiB;
constexpr size_t WS_WP1 = 215 * MiB;
constexpr size_t WS_ROPE = 216 * MiB;
constexpr size_t WS_SEL = 218 * MiB;
constexpr size_t WS_IW = 226 * MiB;
constexpr size_t WS_SS = 227 * MiB;
constexpr size_t WS_LAM = 228 * MiB;
constexpr size_t WS_BAR = 250 * MiB;
constexpr size_t WS_PBF = 232 * MiB;
constexpr size_t WS_IKS = 229 * MiB;

struct Params {
  const float* in[25];
  float* out;
  unsigned char* ws;
  float inv_freq[32];
};
enum { I_X = 0, I_P, I_NORM_GAIN, I_W_IN_EVEN, I_W_OUT_EVEN, I_A_Q_GAIN, I_A_K_GAIN, I_IDX_K_GAIN, I_B_Q_GAIN, I_B_K_GAIN, I_B_SINKS,
       I_W_IN_ODD, I_W_OUT_ODD, I_C_Q_GAIN, I_C_K_GAIN, I_D_Q_GAIN, I_D_K_GAIN, I_LQ1, I_LK1, I_LQ2, I_LK2, I_SUB_GAIN, I_PLE_NORM_GAIN,
       I_W_PLE_GATE, I_W_PLE_PROJ };

DI unsigned cvtpk(float lo, float hi) { f32x2_t v = {lo, hi}; bf16x2_t b = __builtin_convertvector(v, bf16x2_t); return __builtin_bit_cast(unsigned, b); }
DI float bf2f(bf16 b) { return __uint_as_float(((unsigned)b) << 16); }
DI float fexp2(float x) { return __builtin_amdgcn_exp2f(x); }
DI f32x16 mfma32(bf16x8 a, bf16x8 b, f32x16 c) { return __builtin_amdgcn_mfma_f32_32x32x16_bf16(a, b, c, 0, 0, 0); }
DI f32x4 mfma16(bf16x8 a, bf16x8 b, f32x4 c) { return __builtin_amdgcn_mfma_f32_16x16x32_bf16(a, b, c, 0, 0, 0); }
DI int crow(int i, int h) { return (i & 3) + 8 * (i >> 2) + 4 * h; }
DI s16x4 trread(const bf16* p) { return __builtin_bit_cast(s16x4, __builtin_amdgcn_ds_read_tr16_b64_v4i16((LAS s16x4*)p)); }
DI int opaque_tid() { int t = threadIdx.x; asm volatile("" : "+v"(t)); return t; }
DI void lds_barrier() { asm volatile("s_waitcnt lgkmcnt(0)" ::: "memory"); __builtin_amdgcn_s_barrier(); asm volatile("" ::: "memory"); }
DI void lds_fence() { asm volatile("s_waitcnt lgkmcnt(0)" ::: "memory"); __builtin_amdgcn_wave_barrier(); }

__host__ __device__ __forceinline__ int phys_col(int n) { return (n & ~255) + 128 * ((n >> 5) & 1) + 32 * ((n >> 6) & 3) + (n & 31); }
DI int map_even(int n) { return n < 1216 ? n : (n < 1224 ? 3008 + (n - 1216) : n - 8); }
DI void transpose_tile(const float* W, int K, int N, bf16* WT, int mapmode, int tile, float* scr) {
  const int tid = opaque_tid();
  const int ntn = (N + 63) >> 6, kt = tile / ntn, nt = tile % ntn, k0 = kt * 64, n0 = nt * 64;
#pragma unroll
  for (int i = 0; i < 8; ++i) {
    const int kk = (tid >> 6) + 8 * i, nn = tid & 63, n = n0 + nn;
    scr[kk * 65 + nn] = (n < N) ? W[(size_t)(k0 + kk) * N + n] : 0.f;
  }
  __syncthreads();
  {
    const int nn = tid >> 3, kc = tid & 7, n = n0 + nn;
    if (n < N) {
      const int dst = mapmode == 1 ? phys_col(map_even(n)) : (mapmode == 2 ? phys_col(n) : n);
      const float* s = scr + (kc * 8) * 65 + nn;
      u32x4 o; o.x = cvtpk(s[0], s[65]); o.y = cvtpk(s[2 * 65], s[3 * 65]); o.z = cvtpk(s[4 * 65], s[5 * 65]); o.w = cvtpk(s[6 * 65], s[7 * 65]);
      *(u32x4*)(WT + (size_t)dst * K + k0 + kc * 8) = o;
    }
  }
  __syncthreads();
}

DI float wave_sum(float v) {
#pragma unroll
  for (int o = 1; o < 64; o <<= 1) v += __shfl_xor(v, o);
  return v;
}

DI void phase_prologue(const Params& p, char* lds) {
  const int tid = opaque_tid(), lane = tid & 63, wid = tid >> 6;
  const int nb = gridDim.x, bid = blockIdx.x;
  unsigned char* ws = p.ws;
  float* scr = (float*)lds;
  const int T0 = 16 * 48, T1 = 256, T2 = 16 * 64, T3 = 256, T4 = 256, T5 = 256, T6 = 64, T7 = 64;
  const int NT = T0 + T1 + T2 + T3 + T4 + T5 + T6 + T7;
  for (int it = bid; it < NT; it += nb) {
    int r = it;
    if (r < T0) { transpose_tile(p.in[I_W_IN_EVEN], 1024, 3016, (bf16*)(ws + WS_WINE), 1, r, scr); continue; } r -= T0;
    if (r < T1) { transpose_tile(p.in[I_W_OUT_EVEN], 1024, 1024, (bf16*)(ws + WS_WOUTE), 0, r, scr); continue; } r -= T1;
    if (r < T2) { transpose_tile(p.in[I_W_IN_ODD], 1024, 4096, (bf16*)(ws + WS_WINO), 2, r, scr); continue; } r -= T2;
    if (r < T3) { transpose_tile(p.in[I_W_OUT_ODD], 1024, 1024, (bf16*)(ws + WS_WOUTO), 0, r, scr); continue; } r -= T3;
    if (r < T4) { transpose_tile(p.in[I_W_PLE_GATE], 1024, 1024, (bf16*)(ws + WS_WG0), 0, r, scr); continue; } r -= T4;
    if (r < T5) { transpose_tile(p.in[I_W_PLE_GATE] + 1024 * 1024, 1024, 1024, (bf16*)(ws + WS_WG1), 0, r, scr); continue; } r -= T5;
    if (r < T6) { transpose_tile(p.in[I_W_PLE_PROJ], 256, 1024, (bf16*)(ws + WS_WP0), 0, r, scr); continue; } r -= T6;
    transpose_tile(p.in[I_W_PLE_PROJ] + 256 * 1024, 256, 1024, (bf16*)(ws + WS_WP1), 0, r, scr);
  }
  const int gt = bid * NTHREADS + tid, ngt = nb * NTHREADS;
  { unsigned* z = (unsigned*)(ws + WS_WINE); for (int i = gt; i < 56 * 512; i += ngt) z[(size_t)phys_col(3016 + (i >> 9)) * 512 + (i & 511)] = 0u; }
  { const f32x4* src = (const f32x4*)p.in[I_P]; u32x2* dst = (u32x2*)(ws + WS_PBF); for (int i = gt; i < 2 * NTOK * 256 / 4; i += ngt) { const f32x4 v = src[i]; u32x2 w; w.x = cvtpk(v.x, v.y); w.y = cvtpk(v.z, v.w); dst[i] = w; } }
  { float* ss = (float*)(ws + WS_SS); for (int i = gt; i < 3 * NTOK; i += ngt) ss[i] = 0.f; }
  { float2* tab = (float2*)(ws + WS_ROPE);
    for (int i = gt; i < SEQ * 32; i += ngt) {
      const int pos = i >> 5, k = i & 31;
      const float ang = (float)pos * p.inv_freq[k];
      double rev = (double)ang * 0.15915494309189535; rev -= floor(rev);
      const float rf = (float)rev;
      tab[i] = make_float2(__builtin_amdgcn_cosf(rf), __builtin_amdgcn_sinf(rf));
    } }
  if (bid == 0 && wid == 0) {
    const float a = wave_sum(p.in[I_LQ1][lane] * p.in[I_LK1][lane]);
    const float b = wave_sum(p.in[I_LQ2][lane] * p.in[I_LK2][lane]);
    const float lambda_init = 0.8f - 0.6f * expf(-0.3f);
    if (lane == 0) *(float*)(ws + WS_LAM) = expf(a) - expf(b) + lambda_init;
  }
  { const float* x = p.in[I_X]; const float* g = p.in[I_NORM_GAIN]; bf16* H = (bf16*)(ws + WS_ACT);
    const int gw = bid * 8 + wid, ngw = nb * 8;
    for (int m = gw; m < NTOK; m += ngw) {
      const f32x4* xr = (const f32x4*)(x + (size_t)m * DM) + lane;
      f32x4 v[4]; float s = 0.f;
#pragma unroll
      for (int j = 0; j < 4; ++j) { v[j] = xr[64 * j]; s += v[j].x * v[j].x + v[j].y * v[j].y + v[j].z * v[j].z + v[j].w * v[j].w; }
      const float rstd = rsqrtf(wave_sum(s) * (1.f / DM) + EPS);
      u32x2* o = (u32x2*)(H + (size_t)m * DM) + lane;
#pragma unroll
      for (int j = 0; j < 4; ++j) { const f32x4 gg = *((const f32x4*)g + lane + 64 * j); u32x2 w; w.x = cvtpk(v[j].x * rstd * gg.x, v[j].y * rstd * gg.y); w.y = cvtpk(v[j].z * rstd * gg.z, v[j].w * rstd * gg.w); o[64 * j] = w; }
    } }
}

namespace pg8 {
#define PG8_LAS __attribute__((address_space(3)))
typedef unsigned short bf16_t;
typedef short bf16x8 __attribute__((ext_vector_type(8)));
typedef float f32x4 __attribute__((ext_vector_type(4)));
typedef unsigned u32x4 __attribute__((ext_vector_type(4)));
constexpr int BM = 256, BK = 64, HALF = 128, HTB = HALF * BK * 2  , STAGE_BYTES = 8 * HTB, NXCD = 8, WGM = 8;

__host__ __device__ __forceinline__ int lds_byte(int r, int c) { const int st = (r >> 4) * 2 + (c >> 5), rr = r & 15, cc = c & 31, ob = rr * 64 + cc * 2; return st * 1024 + (ob ^ (((ob >> 9) & 1) << 5)); }
__host__ __device__ __forceinline__ void stage_rc(int b, int& R, int& C) { const int st = b / 1024, sb = b % 1024, swz = sb ^ (((sb >> 9) & 1) << 5); R = (st >> 1) * 16 + swz / 64; C = (st & 1) * 32 + (swz % 64) / 2; }
__host__ __device__ __forceinline__ int perm32(int rho) { const int n = rho >> 4, i = rho & 15; return 8 * (i >> 2) + 4 * n + (i & 3); }

struct Unit { int pm, pn; };
struct Gemm { const bf16_t* A; const bf16_t* Bt; int M, N, K; };

struct StaticOrder {
    int nM, nN, nwg, G, c;
    __host__ __device__ void init(int M, int N, int G_, int c_) { nM = M / BM; nN = N / BM; nwg = nM * nN; G = G_; c = c_; }
    __host__ __device__ bool next(int i, Unit& u) const {
        const long L = (long)i * G + c; if (L >= nwg) return false;
        int wgid = (int)L; { const int q = nwg / NXCD, r = nwg % NXCD, xcd = wgid % NXCD, off = wgid / NXCD; wgid = (xcd < r ? xcd * (q + 1) : r * (q + 1) + (xcd - r) * q) + off; }
        const int nig = WGM * nN, gid = wgid / nig, fm = gid * WGM, gsz = (nM - fm) < WGM ? (nM - fm) : WGM;
        u.pm = fm + ((wgid % nig) % gsz); u.pn = (wgid % nig) / gsz; return true;
    }
    __device__ __forceinline__ void a_ready(const Unit&) const {}
    __device__ __forceinline__ void done(const Unit&) const {}
};
__device__ __forceinline__ unsigned cvt_pk_bf16(float lo, float hi) { unsigned r; asm volatile("v_cvt_pk_bf16_f32 %0, %1, %2" : "=v"(r) : "v"(lo), "v"(hi)); return r; }
template <class Epi, class Sched, bool ALIGN_EPI = false, bool SP2 = false>
__device__ __forceinline__ void gemm_phase(PG8_LAS unsigned char* lds, const Gemm g, const Sched& S, const Epi& E) {
    int tid_ = threadIdx.x; asm volatile("" : "+v"(tid_));
    const int tid = tid_, wid = __builtin_amdgcn_readfirstlane(tid >> 6), lane = tid & 63, wr = wid >> 2, wc = wid & 3, fr = lane & 15, fq = lane >> 4;
    const int K = g.K, nt = K / BK;
    unsigned voffA[2], voffB[2];
#pragma unroll
    for (int i = 0; i < 2; ++i) { int R, C; stage_rc(tid * 16 + i * 8192, R, C); const int Rb = Epi::PERM ? ((R & ~31) + perm32(R & 31)) : R;
        voffA[i] = (unsigned)(R * K + C) * 2u; voffB[i] = (unsigned)(Rb * K + C) * 2u; }
    const size_t kstep = (size_t)(BK * 2);
    const size_t hstep = (size_t)HALF * K * 2;
    const size_t tstep = 2 * hstep;
    const unsigned ldsw = (unsigned)wid * 1024u;
    const int aoff = lds_byte(wr * 64 + fr, fq * 8), boff = lds_byte(wc * 32 + fr, fq * 8);
#define PG8_SA(b, h) (((b) * 2 + (h)) * HTB)
#define PG8_SB(b, h) ((4 + (b) * 2 + (h)) * HTB)
#define PG8_STAGE(bufoff, gbase, voff) do { _Pragma("unroll") for (int _i = 0; _i < 2; ++_i) \
        __builtin_amdgcn_global_load_lds((const unsigned*)((const char*)(gbase) + (voff)[_i]), (PG8_LAS unsigned*)(lds + (bufoff) + ldsw + _i * 8192), 16, 0, 0); } while (0)
#define PG8_LDA(dst, b, h) do { _Pragma("unroll") for (int m = 0; m < 4; ++m) _Pragma("unroll") for (int k = 0; k < 2; ++k) dst[m][k] = *(const PG8_LAS bf16x8*)(lds + PG8_SA(b, h) + aoff + m * 2048 + k * 1024); } while (0)
#define PG8_LDB(dst, b, h) do { _Pragma("unroll") for (int n = 0; n < 2; ++n) _Pragma("unroll") for (int k = 0; k < 2; ++k) dst[n][k] = *(const PG8_LAS bf16x8*)(lds + PG8_SB(b, h) + boff + n * 2048 + k * 1024); } while (0)
#define PG8_MMA(ai, bj, At, Bt) do { __builtin_amdgcn_s_setprio(1); _Pragma("unroll") for (int m = 0; m < 4; ++m) _Pragma("unroll") for (int n = 0; n < 2; ++n) _Pragma("unroll") for (int k = 0; k < 2; ++k) \
        acc[ai][bj][m][n] = __builtin_amdgcn_mfma_f32_16x16x32_bf16(Bt[n][k], At[m][k], acc[ai][bj][m][n], 0, 0, 0); __builtin_amdgcn_s_setprio(0); } while (0)
#define PG8_WAIT_V(n) asm volatile("s_waitcnt vmcnt(" #n ")" ::: "memory")
#define PG8_WAIT_L(n) asm volatile("s_waitcnt lgkmcnt(" #n ")" ::: "memory")
#define PG8_BAR __builtin_amdgcn_s_barrier()
#define PG8_SCHED __builtin_amdgcn_sched_barrier(0)
    Unit cur, nxt; int ui = 0;
    if (!S.next(0, cur)) return;
    f32x4 acc[2][2][4][2];
#pragma unroll
    for (int a = 0; a < 2; ++a)
#pragma unroll
        for (int b = 0; b < 2; ++b)
#pragma unroll
            for (int m = 0; m < 4; ++m)
#pragma unroll
                for (int n = 0; n < 2; ++n) acc[a][b][m][n] = (f32x4){0.f, 0.f, 0.f, 0.f};
    bf16x8 At[4][2], B0[2][2], B1[2][2];
    const char* cA = (const char*)g.A + (size_t)cur.pm * tstep; const char* cB = (const char*)g.Bt + (size_t)cur.pn * tstep;
    S.a_ready(cur);
    if constexpr (SP2) {
        PG8_STAGE(PG8_SB(0, 0), cB, voffB); PG8_STAGE(PG8_SB(0, 1), cB + hstep, voffB); PG8_STAGE(PG8_SA(0, 0), cA, voffA); PG8_STAGE(PG8_SA(0, 1), cA + hstep, voffA);
        if (wr == 1) PG8_BAR;
        PG8_WAIT_V(2); PG8_BAR;
        PG8_STAGE(PG8_SB(1, 0), cB + kstep, voffB); PG8_STAGE(PG8_SA(1, 0), cA + kstep, voffA); PG8_STAGE(PG8_SB(1, 1), cB + hstep + kstep, voffB);
        PG8_WAIT_V(6); PG8_BAR;
    } else {
        PG8_STAGE(PG8_SB(0, 0), cB, voffB); PG8_STAGE(PG8_SA(0, 0), cA, voffA); PG8_STAGE(PG8_SB(0, 1), cB + hstep, voffB); PG8_STAGE(PG8_SA(0, 1), cA + hstep, voffA);
        if (wr == 1) PG8_BAR;
        PG8_WAIT_V(4); PG8_BAR;
        PG8_STAGE(PG8_SB(1, 0), cB + kstep, voffB); PG8_STAGE(PG8_SA(1, 0), cA + kstep, voffA); PG8_STAGE(PG8_SB(1, 1), cB + hstep + kstep, voffB);
        PG8_WAIT_V(6); PG8_BAR;
    }
    for (;;) {
        const bool has_next = S.next(ui + 1, nxt);
        const char* nA = has_next ? (const char*)g.A + (size_t)nxt.pm * tstep : cA; const char* nB = has_next ? (const char*)g.Bt + (size_t)nxt.pn * tstep : cB;
        for (int t = 0; t < nt; t += 2) {
            const bool last = (t == nt - 2);
            const char* a1 = cA + (size_t)(t + 1) * kstep;
            const char* a2 = last ? nA : cA + (size_t)(t + 2) * kstep; const char* b2 = last ? nB : cB + (size_t)(t + 2) * kstep;
            const char* a3 = a2 + kstep; const char* b3 = b2 + kstep;
            if (last && has_next) S.a_ready(nxt);
            if constexpr (SP2) {
            PG8_LDB(B0, 0, 0); PG8_LDB(B1, 0, 1); PG8_SCHED; PG8_LDA(At, 0, 0); PG8_STAGE(PG8_SA(1, 1), a1 + hstep, voffA);
            PG8_WAIT_V(8); PG8_WAIT_L(0); PG8_BAR; PG8_MMA(0, 0, At, B0); PG8_MMA(0, 1, At, B1); PG8_BAR; PG8_SCHED;
            PG8_LDA(At, 0, 1); PG8_STAGE(PG8_SB(0, 0), b2, voffB); PG8_STAGE(PG8_SB(0, 1), b2 + hstep, voffB); PG8_STAGE(PG8_SA(0, 0), a2, voffA);
            PG8_WAIT_V(8); PG8_WAIT_L(0); PG8_BAR; PG8_MMA(1, 0, At, B0); PG8_MMA(1, 1, At, B1); PG8_BAR; PG8_SCHED;
            PG8_LDB(B0, 1, 0); PG8_LDB(B1, 1, 1); PG8_SCHED; PG8_LDA(At, 1, 0); PG8_STAGE(PG8_SA(0, 1), a2 + hstep, voffA);
            PG8_WAIT_V(8); PG8_WAIT_L(0); PG8_BAR; PG8_MMA(0, 0, At, B0); PG8_MMA(0, 1, At, B1); PG8_BAR; PG8_SCHED;
            PG8_LDA(At, 1, 1); PG8_STAGE(PG8_SB(1, 0), b3, voffB); PG8_STAGE(PG8_SB(1, 1), b3 + hstep, voffB); PG8_STAGE(PG8_SA(1, 0), a3, voffA);
            PG8_WAIT_V(8); PG8_WAIT_L(0); PG8_BAR; PG8_MMA(1, 0, At, B0); PG8_MMA(1, 1, At, B1); PG8_BAR; PG8_SCHED;
            } else {
            PG8_LDB(B0, 0, 0); PG8_SCHED; PG8_LDA(At, 0, 0); PG8_STAGE(PG8_SA(1, 1), a1 + hstep, voffA);
            PG8_WAIT_L(8); PG8_BAR; PG8_WAIT_L(0); PG8_MMA(0, 0, At, B0); PG8_BAR; PG8_SCHED;
            PG8_LDB(B1, 0, 1); PG8_STAGE(PG8_SB(0, 0), b2, voffB);
            PG8_BAR; PG8_WAIT_L(0); PG8_MMA(0, 1, At, B1); PG8_BAR;
            PG8_LDA(At, 0, 1); PG8_STAGE(PG8_SA(0, 0), a2, voffA);
            PG8_BAR; PG8_WAIT_L(0); PG8_MMA(1, 0, At, B0); PG8_BAR; PG8_SCHED;
            PG8_STAGE(PG8_SB(0, 1), b2 + hstep, voffB);
            PG8_WAIT_V(6); PG8_BAR; PG8_MMA(1, 1, At, B1); PG8_BAR;
            PG8_LDB(B0, 1, 0); PG8_SCHED; PG8_LDA(At, 1, 0); PG8_STAGE(PG8_SA(0, 1), a2 + hstep, voffA);
            PG8_WAIT_L(8); PG8_BAR; PG8_WAIT_L(0); PG8_MMA(0, 0, At, B0); PG8_BAR; PG8_SCHED;
            PG8_LDB(B1, 1, 1); PG8_STAGE(PG8_SB(1, 0), b3, voffB);
            PG8_BAR; PG8_WAIT_L(0); PG8_MMA(0, 1, At, B1); PG8_BAR;
            PG8_LDA(At, 1, 1); PG8_STAGE(PG8_SA(1, 0), a3, voffA);
            PG8_BAR; PG8_WAIT_L(0); PG8_MMA(1, 0, At, B0); PG8_BAR; PG8_SCHED;
            PG8_STAGE(PG8_SB(1, 1), b3 + hstep, voffB);
            PG8_WAIT_V(6); PG8_BAR; PG8_MMA(1, 1, At, B1); PG8_BAR;
            }
        }
        if constexpr (ALIGN_EPI) { if (wr == 0) PG8_BAR; }
        if constexpr (!Epi::AFTER_DRAIN) { E(acc, cur, wr, wc, fr, fq); S.done(cur); }
        if (!has_next) break;
#pragma unroll
        for (int a = 0; a < 2; ++a)
#pragma unroll
            for (int b = 0; b < 2; ++b)
#pragma unroll
                for (int m = 0; m < 4; ++m)
#pragma unroll
                    for (int n = 0; n < 2; ++n) acc[a][b][m][n] = (f32x4){0.f, 0.f, 0.f, 0.f};
        cur = nxt; cA = nA; cB = nB; ++ui;
        if constexpr (ALIGN_EPI) { if (wr == 1) PG8_BAR; }
    }
    PG8_WAIT_V(0);
    if constexpr (!ALIGN_EPI) { if (wr == 0) PG8_BAR; }
    PG8_BAR;
    if constexpr (Epi::AFTER_DRAIN) { E.fused(acc, cur, wr, wc, fr, fq, lds, wid, lane); S.done(cur); }
#undef PG8_SA
#undef PG8_SB
#undef PG8_STAGE
#undef PG8_LDA
#undef PG8_LDB
#undef PG8_MMA
#undef PG8_WAIT_V
#undef PG8_WAIT_L
#undef PG8_BAR
#undef PG8_SCHED
}
}

enum { T_PLAIN = 0, T_NR = 1, T_ROPE = 2, T_SILU = 3, T_IW = 4 };
DI void slot_info(const Params& p, int layer, int slot, int& type, const float*& gain) {
  gain = nullptr;
  if (layer == 0) {
    if (slot < 8) { type = T_NR; gain = p.in[I_A_Q_GAIN]; }
    else if (slot == 8) { type = T_NR; gain = p.in[I_A_K_GAIN]; }
    else if (slot == 9) type = T_PLAIN;
    else if (slot < 18) type = T_ROPE;
    else if (slot == 18) { type = T_NR; gain = p.in[I_IDX_K_GAIN]; }
    else if (slot < 27) type = T_SILU;
    else if (slot < 35) { type = T_NR; gain = p.in[I_B_Q_GAIN]; }
    else if (slot < 37) { type = T_NR; gain = p.in[I_B_K_GAIN]; }
    else if (slot < 39) type = T_PLAIN;
    else if (slot < 47) type = T_SILU;
    else type = T_IW;
  } else {
    if (slot < 8) { type = T_NR; gain = p.in[I_C_Q_GAIN]; }
    else if (slot < 16) { type = T_NR; gain = p.in[I_C_K_GAIN]; }
    else if (slot < 24) type = T_PLAIN;
    else if (slot < 32) type = T_SILU;
    else if (slot < 40) { type = T_NR; gain = p.in[I_D_Q_GAIN]; }
    else if (slot < 48) { type = T_NR; gain = p.in[I_D_K_GAIN]; }
    else if (slot < 56) type = T_PLAIN;
    else type = T_SILU;
  }
}
constexpr int E_AQ = 0, E_AK = 512, E_AV = 576, E_IQ = 640, E_IK = 1152, E_AG = 1216, E_BQ = 1728, E_BK = 2240, E_BV = 2368, E_BG = 2496;
constexpr int O_CQ = 0, O_CK = 512, O_CV = 1024, O_CG = 1536, O_DQ = 2048, O_DK = 2560, O_DV = 3072, O_DG = 3584;

typedef pg8::f32x4 (AccT)[2][2][4][2];

struct EpiInProj {
  static constexpr bool PERM = false, AFTER_DRAIN = false;
  const Params& p; int layer;
  DI void operator()(const f32x4 (&acc)[2][2][4][2], const pg8::Unit& u, int wr, int wc, int fr, int fq) const {
    unsigned char* ws = p.ws;
    const int NP = layer == 0 ? NPE : NPO;
    bf16* PE = (bf16*)(ws + WS_PE);
    const float2* rope = (const float2*)(ws + WS_ROPE);
    const float* ss1 = (const float*)(ws + WS_SS);
    float* IW = (float*)(ws + WS_IW);
    const int slot = u.pn * 4 + wc;
    int type; const float* gain; slot_info(p, layer, slot, type, gain);
#pragma unroll
    for (int ai = 0; ai < 2; ++ai)
#pragma unroll
      for (int m = 0; m < 4; ++m) {
        const int row = u.pm * 256 + ai * 128 + wr * 64 + m * 16 + fr, pos = row & (SEQ - 1);
        float sc = 1.f;
        if (layer == 1) sc = rsqrtf(ss1[row] * (1.f / DM) + EPS);
        f32x4 v1[2], v2[2];
#pragma unroll
        for (int n = 0; n < 2; ++n) { v1[n] = acc[ai][0][m][n] * sc; v2[n] = acc[ai][1][m][n] * sc; }
        if (type == T_NR) {
          float s = 0.f;
#pragma unroll
          for (int n = 0; n < 2; ++n) s += v1[n].x * v1[n].x + v1[n].y * v1[n].y + v1[n].z * v1[n].z + v1[n].w * v1[n].w + v2[n].x * v2[n].x + v2[n].y * v2[n].y + v2[n].z * v2[n].z + v2[n].w * v2[n].w;
          s += __shfl_xor(s, 16); s += __shfl_xor(s, 32);
          const float rn = rsqrtf(s * (1.f / 64.f) + EPS);
#pragma unroll
          for (int n = 0; n < 2; ++n) { const f32x4 g1 = *(const f32x4*)(gain + n * 16 + fq * 4), g2 = *(const f32x4*)(gain + 32 + n * 16 + fq * 4); v1[n] = v1[n] * rn * g1; v2[n] = v2[n] * rn * g2; }
        }
        if (type == T_NR || type == T_ROPE) {
#pragma unroll
          for (int n = 0; n < 2; ++n) {
            const f32x4* cs = (const f32x4*)(rope + (size_t)pos * 32 + n * 16 + fq * 4);
            const f32x4 c01 = cs[0], c23 = cs[1];
            const f32x4 x1 = v1[n], x2 = v2[n];
            f32x4 o1, o2;
            o1.x = x1.x * c01.x - x2.x * c01.y; o2.x = x2.x * c01.x + x1.x * c01.y;
            o1.y = x1.y * c01.z - x2.y * c01.w; o2.y = x2.y * c01.z + x1.y * c01.w;
            o1.z = x1.z * c23.x - x2.z * c23.y; o2.z = x2.z * c23.x + x1.z * c23.y;
            o1.w = x1.w * c23.z - x2.w * c23.w; o2.w = x2.w * c23.z + x1.w * c23.w;
            v1[n] = o1; v2[n] = o2;
          }
        }
        if (type == T_SILU) {
#pragma unroll
          for (int n = 0; n < 2; ++n)
#pragma unroll
            for (int j = 0; j < 4; ++j) { const float a = v1[n][j]; v1[n][j] = a / (1.f + __expf(-a)); const float b = v2[n][j]; v2[n][j] = b / (1.f + __expf(-b)); }
        }
        if (type == T_IW) {
          if (fq < 2) *(f32x4*)(IW + (size_t)row * 8 + fq * 4) = v1[0];
        } else {
          bf16* dst = PE + (size_t)row * NP + slot * 64 + fq * 4;
#pragma unroll
          for (int n = 0; n < 2; ++n) {
            u32x2 w1, w2; w1.x = cvtpk(v1[n].x, v1[n].y); w1.y = cvtpk(v1[n].z, v1[n].w); w2.x = cvtpk(v2[n].x, v2[n].y); w2.y = cvtpk(v2[n].z, v2[n].w);
            *(u32x2*)(dst + n * 16) = w1; *(u32x2*)(dst + 32 + n * 16) = w2;
            if (layer == 0 && slot == 18) { bf16* IKS = (bf16*)(ws + WS_IKS); const int key = row & (SEQ - 1);
              bf16* base = IKS + (((size_t)(row >> 13) * 256 + (key >> 5)) * 4) * 512 + ((fq >> 1) * 32 + (key & 31)) * 8 + (fq & 1) * 4;
              *(u32x2*)(base + (size_t)n * 512) = w1; *(u32x2*)(base + (size_t)(n + 2) * 512) = w2; }
          }
        }
        asm volatile("" ::: "memory");
      }
  }
};

DI void phase_inproj(const Params& p, int layer, char* lds) {
  unsigned char* ws = p.ws;
  const int NP = layer == 0 ? NPE : NPO;
  pg8::Gemm g{(const bf16*)(ws + (layer == 0 ? WS_ACT : WS_Y)), (const bf16*)(ws + (layer == 0 ? WS_WINE : WS_WINO)), NTOK, NP, DM};
  pg8::StaticOrder S; S.init(NTOK, NP, (int)gridDim.x, (int)blockIdx.x);
  EpiInProj E{p, layer};
  pg8::gemm_phase<EpiInProj, pg8::StaticOrder, true, true>((PG8_LAS unsigned char*)lds, g, S, E);
}

struct EpiOutProj {
  static constexpr bool PERM = false, AFTER_DRAIN = false;
  const float* xin; float* out; bf16* XG; const float* pg; float* ss;
  DI void operator()(const f32x4 (&acc)[2][2][4][2], const pg8::Unit& u, int wr, int wc, int fr, int fq) const {
#pragma unroll
    for (int ai = 0; ai < 2; ++ai)
#pragma unroll
      for (int m = 0; m < 4; ++m) {
        const int row = u.pm * 256 + ai * 128 + wr * 64 + m * 16 + fr; float rs = 0.f;
#pragma unroll
        for (int bj = 0; bj < 2; ++bj)
#pragma unroll
          for (int n = 0; n < 2; ++n) {
            const int col = u.pn * 256 + bj * 128 + wc * 32 + n * 16 + fq * 4; const size_t off = (size_t)row * DM + col;
            const f32x4 xn = *(const f32x4*)(xin + off) + acc[ai][bj][m][n];
            *(f32x4*)(out + off) = xn;
            rs += xn.x * xn.x + xn.y * xn.y + xn.z * xn.z + xn.w * xn.w;
            const f32x4 gg = *(const f32x4*)(pg + col);
            u32x2 w; w.x = cvtpk(xn.x * gg.x, xn.y * gg.y); w.y = cvtpk(xn.z * gg.z, xn.w * gg.w); *(u32x2*)(XG + off) = w;
          }
        rs += __shfl_xor(rs, 16); rs += __shfl_xor(rs, 32);
        if (fq == 0) atomicAdd(ss + row, rs);
        asm volatile("" ::: "memory");
      }
  }
};
DI void phase_outproj(const Params& p, int layer, char* lds) {
  unsigned char* ws = p.ws;
  pg8::Gemm g{(const bf16*)(ws + WS_Y), (const bf16*)(ws + (layer == 0 ? WS_WOUTE : WS_WOUTO)), NTOK, DM, DM};
  pg8::StaticOrder S; S.init(NTOK, DM, (int)gridDim.x, (int)blockIdx.x);
  EpiOutProj E{layer == 0 ? p.in[I_X] : p.out, p.out, (bf16*)(ws + WS_ACT), p.in[I_PLE_NORM_GAIN] + layer * DM, (float*)(ws + WS_SS) + (layer == 0 ? 1 : 2) * NTOK};
  pg8::gemm_phase<EpiOutProj, pg8::StaticOrder, true, true>((PG8_LAS unsigned char*)lds, g, S, E);
}

struct EpiPleProj {
  static constexpr bool PERM = false, AFTER_DRAIN = false;
  bf16* PT;
  DI void operator()(const f32x4 (&acc)[2][2][4][2], const pg8::Unit& u, int wr, int wc, int fr, int fq) const {
#pragma unroll
    for (int ai = 0; ai < 2; ++ai)
#pragma unroll
      for (int m = 0; m < 4; ++m) {
        const int row = u.pm * 256 + ai * 128 + wr * 64 + m * 16 + fr;
#pragma unroll
        for (int bj = 0; bj < 2; ++bj)
#pragma unroll
          for (int n = 0; n < 2; ++n) { const f32x4 a = acc[ai][bj][m][n]; u32x2 w; w.x = cvtpk(a.x, a.y); w.y = cvtpk(a.z, a.w); *(u32x2*)(PT + (size_t)row * DM + u.pn * 256 + bj * 128 + wc * 32 + n * 16 + fq * 4) = w; }
      }
  }
};
struct EpiPleGate {
  static constexpr bool PERM = false, AFTER_DRAIN = false;
  const bf16* PT; float* out; const float* ssx; float* ss1; bf16* H; const float* ng1; int layer;
  DI void operator()(const f32x4 (&acc)[2][2][4][2], const pg8::Unit& u, int wr, int wc, int fr, int fq) const {
#pragma unroll
    for (int ai = 0; ai < 2; ++ai)
#pragma unroll
      for (int m = 0; m < 4; ++m) {
        const int row = u.pm * 256 + ai * 128 + wr * 64 + m * 16 + fr; float rs = 0.f;
        const float rstd = rsqrtf(ssx[row] * (1.f / DM) + EPS);
#pragma unroll
        for (int bj = 0; bj < 2; ++bj)
#pragma unroll
          for (int n = 0; n < 2; ++n) {
            const int col = u.pn * 256 + bj * 128 + wc * 32 + n * 16 + fq * 4; const size_t off = (size_t)row * DM + col;
            f32x4 g;
#pragma unroll
            for (int j = 0; j < 4; ++j) g[j] = 1.f / (1.f + __expf(-rstd * acc[ai][bj][m][n][j]));
            const u32x2 pw = *(const u32x2*)(PT + off); f32x4 pp; pp.x = __uint_as_float(pw.x << 16); pp.y = __uint_as_float(pw.x & 0xffff0000u); pp.z = __uint_as_float(pw.y << 16); pp.w = __uint_as_float(pw.y & 0xffff0000u);
            const f32x4 xn = *(const f32x4*)(out + off) + pp * g;
            *(f32x4*)(out + off) = xn;
            if (layer == 0) {
              rs += xn.x * xn.x + xn.y * xn.y + xn.z * xn.z + xn.w * xn.w;
              const f32x4 gg = *(const f32x4*)(ng1 + col);
              u32x2 w; w.x = cvtpk(xn.x * gg.x, xn.y * gg.y); w.y = cvtpk(xn.z * gg.z, xn.w * gg.w); *(u32x2*)(H + off) = w;
            }
          }
        if (layer == 0) { rs += __shfl_xor(rs, 16); rs += __shfl_xor(rs, 32); if (fq == 0) atomicAdd(ss1 + row, rs); }
        asm volatile("" ::: "memory");
      }
  }
};
DI void phase_ple(const Params& p, int layer, char* lds) {
  unsigned char* ws = p.ws;
  bf16* PT = (bf16*)(ws + WS_PE);
  pg8::StaticOrder S; S.init(NTOK, DM, (int)gridDim.x, (int)blockIdx.x);
  { pg8::Gemm g{(const bf16*)(ws + WS_PBF) + (size_t)layer * NTOK * 256, (const bf16*)(ws + (layer == 0 ? WS_WP0 : WS_WP1)), NTOK, DM, 256};
    EpiPleProj E{PT};
    pg8::gemm_phase<EpiPleProj, pg8::StaticOrder, true, true>((PG8_LAS unsigned char*)lds, g, S, E); }
  { pg8::Gemm g{(const bf16*)(ws + WS_ACT), (const bf16*)(ws + (layer == 0 ? WS_WG0 : WS_WG1)), NTOK, DM, DM};
    EpiPleGate E{PT, p.out, (const float*)(ws + WS_SS) + (layer == 0 ? 1 : 2) * NTOK, (float*)(ws + WS_SS), (bf16*)(ws + WS_Y), p.in[I_NORM_GAIN] + DM, layer};
    pg8::gemm_phase<EpiPleGate, pg8::StaticOrder, true, true>((PG8_LAS unsigned char*)lds, g, S, E); }
}

DI float half_max(float v) { auto rr = __builtin_amdgcn_permlane32_swap(__float_as_uint(v), __float_as_uint(v), false, false); return fmaxf(__uint_as_float(rr[0]), __uint_as_float(rr[1])); }
template <int DVB, bool MASKED = true>
DI void attn_step32(const bf16* Kt, int KP, const bf16* Vt, int VP, const bf16x8 (&qf)[4], f32x16 (&o)[DVB], float& m, float& l, unsigned vmask, float c2, int lane) {
  const int r32 = lane & 31, h = lane >> 5;
  f32x16 s;
#pragma unroll
  for (int i = 0; i < 16; ++i) s[i] = 0.f;
#pragma unroll
  for (int t = 0; t < 4; ++t) { const bf16x8 kf = *(const bf16x8*)(Kt + r32 * KP + t * 16 + h * 8); s = mfma32(kf, qf[t], s); }
  float mx = -INFINITY;
#pragma unroll
  for (int i = 0; i < 16; ++i) { if (MASKED) { s[i] = ((vmask >> i) & 1u) ? s[i] : -INFINITY; } mx = fmaxf(mx, s[i]); }
  mx = half_max(mx);
  const float mxs = mx * c2;
  if (__any(mxs > m + 6.f)) {
    const float mn = fmaxf(m, mxs);
    const float alpha = fexp2(m - mn); l *= alpha;
#pragma unroll
    for (int d = 0; d < DVB; ++d)
#pragma unroll
      for (int i = 0; i < 16; ++i) o[d][i] *= alpha;
    m = mn;
  }
  float ps = 0.f; const float negm = -m;
#pragma unroll
  for (int i = 0; i < 16; ++i) { const float pv = fexp2(__builtin_fmaf(s[i], c2, negm)); s[i] = pv; ps += pv; }
  l += ps;
  bf16x8 pf[2];
  { u32x4 a, b; a.x = cvtpk(s[0], s[1]); a.y = cvtpk(s[2], s[3]); a.z = cvtpk(s[4], s[5]); a.w = cvtpk(s[6], s[7]);
    b.x = cvtpk(s[8], s[9]); b.y = cvtpk(s[10], s[11]); b.z = cvtpk(s[12], s[13]); b.w = cvtpk(s[14], s[15]);
    pf[0] = __builtin_bit_cast(bf16x8, a); pf[1] = __builtin_bit_cast(bf16x8, b); }
  const int i16 = lane & 15, q = i16 >> 2, pp = i16 & 3, blk = (lane >> 4) & 1;
#pragma unroll
  for (int d = 0; d < DVB; ++d)
#pragma unroll
    for (int sk = 0; sk < 2; ++sk) {
      const s16x4 lo = trread(Vt + (16 * sk + 4 * h + q) * VP + 32 * d + 16 * blk + 4 * pp);
      const s16x4 hi = trread(Vt + (16 * sk + 8 + 4 * h + q) * VP + 32 * d + 16 * blk + 4 * pp);
      const bf16x8 vf = __builtin_shufflevector(lo, hi, 0, 1, 2, 3, 4, 5, 6, 7);
      o[d] = mfma32(vf, pf[sk], o[d]);
    }
}

DI unsigned row_range_mask(int lo, int hi) {
  lo = lo < 0 ? 0 : lo; hi = hi > 31 ? 31 : hi;
  if (hi < lo) return 0u;
  const unsigned upto_hi = (hi >= 31) ? 0xffffffffu : ((1u << (hi + 1)) - 1u);
  return upto_hi & ~((1u << lo) - 1u);
}
DI unsigned lane_rows(unsigned m32, int h) {
  const unsigned t = m32 >> (4 * h);
  return (t & 0xFu) | ((t >> 4) & 0xF0u) | ((t >> 8) & 0xF00u) | ((t >> 12) & 0xF000u);
}
constexpr int WP = 72;
constexpr int WAVE_LDS = 2 * 32 * WP * 2 + 512;

struct KVRegs { u32x4 k[4], v[4]; };
DI void kv_store(const KVRegs& R, bf16* Ks, bf16* Vs, int lane) {
#pragma unroll
  for (int i = 0; i < 4; ++i) { const int row = (lane >> 3) + 8 * i, ch = lane & 7; *(u32x4*)(Ks + row * WP + ch * 8) = R.k[i]; *(u32x4*)(Vs + row * WP + ch * 8) = R.v[i]; }
}

DI void band_load(KVRegs& R, const bf16* Kg, const bf16* Vg, int NP, int kstart, int dil, int roff, int lane) {
#pragma unroll
  for (int i = 0; i < 4; ++i) {
    const int row = (lane >> 3) + 8 * i, ch = lane & 7; int k = kstart + row; if (k < 0) k = 0;
    const size_t off = (size_t)(dil * k + roff) * NP + ch * 8;
    R.k[i] = *(const u32x4*)(Kg + off); R.v[i] = *(const u32x4*)(Vg + off);
  }
}
template <int DVB>
DI void band_run(const bf16* Kg, const bf16* Vg, int NP, int kbase, int nsteps, int dil, int roff, int qidx, int win,
                 const bf16x8 (&qf)[4], f32x16 (&o)[DVB], float& m, float& l, float c2, bf16* Ks, bf16* Vs, int lane) {
  const int h = lane >> 5;
  KVRegs R; band_load(R, Kg, Vg, NP, kbase, dil, roff, lane);
  for (int j = 0; j < nsteps; ++j) {
    lds_fence();
    kv_store(R, Ks, Vs, lane);
    lds_fence();
    if (j + 1 < nsteps) band_load(R, Kg, Vg, NP, kbase + 32 * (j + 1), dil, roff, lane);
    const int kb = kbase + 32 * j, lo_r = (qidx - win > 0 ? qidx - win : 0) - kb;
    const unsigned vm = lane_rows(row_range_mask(lo_r, qidx - kb), h);
    attn_step32<DVB>(Ks, WP, Vs, WP, qf, o, m, l, vm, c2, lane);
  }
}

DI void write_o64(const f32x16 (&o)[2], float linv, const bf16* gate_row, bf16* y_row, int h) {
#pragma unroll
  for (int d = 0; d < 2; ++d)
#pragma unroll
    for (int g = 0; g < 4; ++g) {
      const int dd = 32 * d + 8 * g + 4 * h;
      const u32x2 gv = *(const u32x2*)(gate_row + dd);
      const float g0 = __uint_as_float(gv.x << 16), g1 = __uint_as_float(gv.x & 0xffff0000u), g2 = __uint_as_float(gv.y << 16), g3 = __uint_as_float(gv.y & 0xffff0000u);
      u32x2 w; w.x = cvtpk(o[d][4 * g] * linv * g0, o[d][4 * g + 1] * linv * g1); w.y = cvtpk(o[d][4 * g + 2] * linv * g2, o[d][4 * g + 3] * linv * g3);
      *(u32x2*)(y_row + dd) = w;
    }
}

DI void load_q(bf16x8 (&qf)[4], const bf16* qrow, int h) {
#pragma unroll
  for (int t = 0; t < 4; ++t) qf[t] = *(const bf16x8*)(qrow + t * 16 + h * 8);
}
template <int DVB> DI void zero_o(f32x16 (&o)[DVB]) {
#pragma unroll
  for (int d = 0; d < DVB; ++d)
#pragma unroll
    for (int i = 0; i < 16; ++i) o[d][i] = 0.f;
}

DI void mixerB_tile(const Params& p, int item, bf16* Ks, bf16* Vs, int lane) {
  const bf16* PE = (const bf16*)(p.ws + WS_PE); bf16* Y = (bf16*)(p.ws + WS_Y);
  const int qblk = item & 255, head = (item >> 8) & 7, b = item >> 11;
  const int r32 = lane & 31, h = lane >> 5, q0 = qblk * 32, kvh = head >> 2;
  const size_t rowb = (size_t)b * SEQ;
  bf16x8 qf[4]; load_q(qf, PE + (rowb + q0 + r32) * NPE + E_BQ + head * 64, h);
  f32x16 o[2]; zero_o<2>(o);
  const float sink2 = p.in[I_B_SINKS][head] * LOG2E;
  float m = sink2, l = (h == 0) ? 1.f : 0.f;
  band_run<2>(PE + rowb * NPE + E_BK + kvh * 64, PE + rowb * NPE + E_BV + kvh * 64, NPE, q0 - 128, 5, 1, 0, q0 + r32, 127, qf, o, m, l, 0.125f * LOG2E, Ks, Vs, lane);
  l += __shfl_xor(l, 32);
  const size_t tok = rowb + q0 + r32;
  write_o64(o, 1.f / l, PE + tok * NPE + E_BG + head * 64, Y + tok * DM + 512 + head * 64, h);
}

DI void mixerC_tile(const Params& p, int item, bf16* Ks, bf16* Vs, int lane) {
  const bf16* PO = (const bf16*)(p.ws + WS_PE); bf16* Y = (bf16*)(p.ws + WS_Y);
  const int qt = item & 15, r16 = (item >> 4) & 15, head = (item >> 8) & 7, b = item >> 11;
  const int r32 = lane & 31, h = lane >> 5, qi0 = qt * 32;
  const size_t rowb = (size_t)b * SEQ;
  const int t = 16 * (qi0 + r32) + r16;
  bf16x8 qf[4]; load_q(qf, PO + (rowb + t) * NPO + O_CQ + head * 64, h);
  f32x16 o[2]; zero_o<2>(o);
  float m = -1e30f, l = 0.f;
  const bf16* Kg = PO + rowb * NPO + O_CK + head * 64; const bf16* Vg = PO + rowb * NPO + O_CV + head * 64;
  const float c2 = 0.125f * LOG2E;
  band_run<2>(Kg, Vg, NPO, qi0 - 128, 5, 16, r16, qi0 + r32, 128, qf, o, m, l, c2, Ks, Vs, lane);
  band_run<2>(Kg, Vg, NPO, 4 * qi0 + (r16 >> 2) - 128, 8, 4, r16 & 3, 4 * (qi0 + r32) + (r16 >> 2), 128, qf, o, m, l, c2, Ks, Vs, lane);
  band_run<2>(Kg, Vg, NPO, 16 * qi0 + r16 - 128, 20, 1, 0, t, 128, qf, o, m, l, c2, Ks, Vs, lane);
  l += __shfl_xor(l, 32);
  const size_t tok = rowb + t;
  write_o64(o, 1.f / l, PO + tok * NPO + O_CG + head * 64, Y + tok * DM + head * 64, h);
}

DI void mixerA_item(const Params& p, int item, bf16* Ks, bf16* Vs, int lane) {
  const bf16* PE = (const bf16*)(p.ws + WS_PE); bf16* Y = (bf16*)(p.ws + WS_Y);
  const unsigned short* SEL = (const unsigned short*)(p.ws + WS_SEL) + (size_t)item * 256;
  const int t = item & (SEQ - 1), b = item >> 13;
  const int r32 = lane & 31, h = lane >> 5, head = r32 & 7;
  const size_t rowb = (size_t)b * SEQ;
  const int count = (t + 1 < 256) ? t + 1 : 256, nsteps = (count + 31) >> 5;
  bf16x8 qf[4]; load_q(qf, PE + (size_t)item * NPE + E_AQ + head * 64, h);
  f32x16 o[2]; zero_o<2>(o);
  float m = -1e30f, l = 0.f;
  const bf16* Kg = PE + rowb * NPE + E_AK; const bf16* Vg = PE + rowb * NPE + E_AV;
  KVRegs R;
  unsigned short* sel_l = (unsigned short*)(Vs + 32 * WP);
  lds_fence();
  *(u32x2*)(sel_l + 4 * lane) = *(const u32x2*)(SEL + 4 * lane);
  lds_fence();
#define A_LOAD(j) do { _Pragma("unroll") for (int i = 0; i < 4; ++i) { const int row = (lane >> 3) + 8 * i, ch = lane & 7, e = 32 * (j) + row; \
      const int tokk = (e < count) ? (int)sel_l[e] : 0; const size_t off = (size_t)tokk * NPE + ch * 8; R.k[i] = *(const u32x4*)(Kg + off); R.v[i] = *(const u32x4*)(Vg + off); } } while (0)
  A_LOAD(0);
  for (int j = 0; j < nsteps; ++j) {
    lds_fence();
    kv_store(R, Ks, Vs, lane);
    lds_fence();
    if (j + 1 < nsteps) A_LOAD(j + 1);
    const unsigned vm = lane_rows(row_range_mask(0, count - 1 - 32 * j), h);
    attn_step32<2>(Ks, WP, Vs, WP, qf, o, m, l, vm, 0.125f * LOG2E, lane);
  }
#undef A_LOAD
  l += __shfl_xor(l, 32);
  if (r32 < 8) write_o64(o, 1.f / l, PE + (size_t)item * NPE + E_AG + head * 64, Y + (size_t)item * DM + head * 64, h);
}

DI unsigned f2ord(float f) { f += 0.f; const unsigned u = __float_as_uint(f); return (u & 0x80000000u) ? ~u : (u | 0x80000000u); }
DI int block_excl_scan(int v, int* tmp, int* tot) {
  const int lane = threadIdx.x & 63, wid = threadIdx.x >> 6;
  int inc = v;
#pragma unroll
  for (int o = 1; o < 64; o <<= 1) { const int u = __shfl_up(inc, o); if (lane >= o) inc += u; }
  if (lane == 63) tmp[wid] = inc;
  __syncthreads();
  int base = 0, total = 0;
#pragma unroll
  for (int w = 0; w < 8; ++w) { const int x = tmp[w]; if (w < wid) base += x; total += x; }
  *tot = total;
  return base + inc - v;
}

DI float dpp_sum8(float v) {
  v += __builtin_bit_cast(float, __builtin_amdgcn_mov_dpp(__builtin_bit_cast(int, v), 0xB1, 0xF, 0xF, true));
  v += __builtin_bit_cast(float, __builtin_amdgcn_mov_dpp(__builtin_bit_cast(int, v), 0x4E, 0xF, 0xF, true));
  v += __builtin_bit_cast(float, __builtin_amdgcn_mov_dpp(__builtin_bit_cast(int, v), 0x141, 0xF, 0xF, true));
  return v;
}
DI void hist_find(const int* hist, int* misc, int need, int& digit, int& nneed, int& cnt) {
  const int tid = threadIdx.x;
  typedef int i32x4 __attribute__((ext_vector_type(4)));
  const i32x4 h0 = *(const i32x4*)(hist + tid * 8), h1 = *(const i32x4*)(hist + tid * 8 + 4);
  int hh[8] = {h0.x, h0.y, h0.z, h0.w, h1.x, h1.y, h1.z, h1.w}; int tot = 0;
#pragma unroll
  for (int k = 0; k < 8; ++k) tot += hh[k];
  int total; const int ex = block_excl_scan(tot, misc, &total);
  int above = total - ex - tot;
#pragma unroll
  for (int k = 7; k >= 0; --k) { const int c = hh[k]; if (above < need && above + c >= need) { misc[16] = tid * 8 + k; misc[17] = need - above; misc[18] = c; } above += c; }
  __syncthreads();
  digit = misc[16]; nneed = misc[17]; cnt = misc[18];
  __syncthreads();
}
DI unsigned long long mkcmp(float v, int idx) { return ((unsigned long long)f2ord(v) << 16) | ((unsigned long long)(8191 - idx) << 3); }
DI float ord2f(unsigned k) { return __uint_as_float((k & 0x80000000u) ? (k ^ 0x80000000u) : ~k); }
DI float half_sum(float v) { auto rr = __builtin_amdgcn_permlane32_swap(__float_as_uint(v), __float_as_uint(v), false, false); return __uint_as_float(rr[0]) + __uint_as_float(rr[1]); }

constexpr int CL_CAP = 512;
DI void select_slow(const float* scq, int n, unsigned short* out, float lo, float hi, int* hist, int* misc, unsigned long long* clist) {
  const int tid = opaque_tid();
    const float scale = (hi > lo) ? 4095.f / (hi - lo) : 0.f;
    for (int i = tid; i < 4096; i += 512) hist[i] = 0;
    if (tid == 0) misc[20] = 0;
    __syncthreads();
    float val[16]; int bin[16];
#pragma unroll
    for (int i = 0; i < 16; ++i) { const int idx = tid + 512 * i; const float v = (idx < n) ? scq[idx] : lo; val[i] = v;
      int bb = (int)((v - lo) * scale); bb = bb < 0 ? 0 : (bb > 4095 ? 4095 : bb); bin[i] = bb; if (idx < n) atomicAdd(&hist[bb], 1); }
    __syncthreads();
    int bstar, need, cnt;
    hist_find(hist, misc, 256, bstar, need, cnt);
    unsigned long long T = 0ull;
    if (cnt != need) {
      if (cnt <= CL_CAP) {
#pragma unroll
        for (int i = 0; i < 16; ++i) { const int idx = tid + 512 * i; if (idx < n && bin[i] == bstar) { const int slot = atomicAdd(&misc[20], 1); clist[slot] = mkcmp(val[i], idx); } }
        __syncthreads();
        if (tid < cnt) { const unsigned long long c = clist[tid]; int rank = 0; for (int jx = 0; jx < cnt; ++jx) rank += (clist[jx] > c) ? 1 : 0;
          if (rank == need - 1) { misc[21] = (int)(unsigned)(c & 0xffffffffull); misc[22] = (int)(unsigned)(c >> 32); } }
        __syncthreads();
        T = ((unsigned long long)(unsigned)misc[22] << 32) | (unsigned long long)(unsigned)misc[21];
      } else {
        unsigned long long prefix = 0ull; int shift = 36;
        for (int pass = 0; pass < 4; ++pass) {
          for (int i = tid; i < 4096; i += 512) hist[i] = 0;
          __syncthreads();
#pragma unroll
          for (int i = 0; i < 16; ++i) { const int idx = tid + 512 * i; if (idx < n && bin[i] == bstar) { const unsigned long long c = mkcmp(val[i], idx); if (pass == 0 || (c >> (shift + 12)) == prefix) atomicAdd(&hist[(int)((c >> shift) & 4095ull)], 1); } }
          __syncthreads();
          int digit, nneed, c2;
          hist_find(hist, misc, need, digit, nneed, c2);
          prefix = (prefix << 12) | (unsigned long long)digit; need = nneed;
          if (c2 == need) break;
          shift -= 12;
        }
        T = prefix << shift;
      }
    }
    int mycnt = 0; unsigned selm = 0;
#pragma unroll
    for (int i = 0; i < 16; ++i) { const int idx = tid + 512 * i;
      bool sel = false;
      if (idx < n) { if (bin[i] > bstar) sel = true; else if (bin[i] == bstar) sel = (mkcmp(val[i], idx) >= T); }
      if (sel) { ++mycnt; selm |= (1u << i); } }
    int total; int pos = block_excl_scan(mycnt, misc + 8, &total);
#pragma unroll
    for (int i = 0; i < 16; ++i) { if ((selm >> i) & 1u) { if (pos < 256) out[pos] = (unsigned short)(tid + 512 * i); ++pos; } }
    __syncthreads();
}

DI void sel_load_qw(const Params& p, int item, bf16x8 (&qf)[4], float (&wq)[16], int lane) {
  const bf16* PE = (const bf16*)(p.ws + WS_PE); const float* IW = (const float*)(p.ws + WS_IW);
  const int r32 = lane & 31, h = lane >> 5, b = item >> 11, t0 = (item & 2047) * 4; const size_t rowb = (size_t)b * SEQ;
  load_q(qf, PE + (rowb + t0 + (r32 >> 3)) * NPE + E_IQ + (r32 & 7) * 64, h);
#pragma unroll
  for (int q = 0; q < 4; ++q) { const f32x4 w4 = *(const f32x4*)(IW + (rowb + t0 + q) * 8 + 4 * h);
    wq[4 * q] = w4.x * 0.04419417382415922f; wq[4 * q + 1] = w4.y * 0.04419417382415922f; wq[4 * q + 2] = w4.z * 0.04419417382415922f; wq[4 * q + 3] = w4.w * 0.04419417382415922f; }
}
DI void selectA_item(const Params& p, int item, int next_item, char* lds, bf16x8 (&qf)[4], float (&wq)[16]) {
  const bf16* PE = (const bf16*)(p.ws + WS_PE);
  const float* IW = (const float*)(p.ws + WS_IW);
  unsigned short* SEL = (unsigned short*)(p.ws + WS_SEL);
  float* sc = (float*)lds;
  int* hist = (int*)(lds + 4 * 8192 * 4);
  int* misc = hist + 4096;
  unsigned* mm = (unsigned*)(misc + 24);
  unsigned long long* clist = (unsigned long long*)(misc + 96);
  const int tid = opaque_tid(), lane = tid & 63, wid = tid >> 6, r32 = lane & 31, h = lane >> 5;
  const int b = item >> 11, t0 = (item & 2047) * 4;
  const size_t rowb = (size_t)b * SEQ;
  const int nk = t0 + 4, ntile = (nk + 31) >> 5;
  if (tid < 4) { mm[tid * 2] = 0xFFFFFFFFu; mm[tid * 2 + 1] = 0u; }
  lds_barrier();
  const bf16* Kt = (const bf16*)(p.ws + WS_IKS) + (size_t)b * 256 * 2048 + lane * 8;
  {
    bf16x8 kf[4], kn[4];
#pragma unroll
    for (int t = 0; t < 4; ++t) { kf[t] = (bf16x8){0, 0, 0, 0, 0, 0, 0, 0}; kn[t] = kf[t]; }
    if (wid < ntile) {
#pragma unroll
      for (int t = 0; t < 4; ++t) kf[t] = *(const bf16x8*)(Kt + (size_t)wid * 2048 + t * 512);
    }
    float lo0 = INFINITY, hi0 = -INFINITY, lo1 = INFINITY, hi1 = -INFINITY;
    for (int kt = wid; kt < ntile; kt += 8) {
      if (kt + 8 < ntile) {
#pragma unroll
        for (int t = 0; t < 4; ++t) kn[t] = *(const bf16x8*)(Kt + (size_t)(kt + 8) * 2048 + t * 512);
      }
      f32x16 s;
#pragma unroll
      for (int i = 0; i < 16; ++i) s[i] = 0.f;
#pragma unroll
      for (int t = 0; t < 4; ++t) s = mfma32(qf[t], kf[t], s);
      float v[4];
#pragma unroll
      for (int q = 0; q < 4; ++q) {
        float a = wq[4 * q] * fmaxf(s[4 * q], 0.f);
#pragma unroll
        for (int jj = 1; jj < 4; ++jj) a += wq[4 * q + jj] * fmaxf(s[4 * q + jj], 0.f);
        v[q] = half_sum(a) + 0.f;
      }
      const float va = h ? v[2] : v[0], vb = h ? v[3] : v[1];
      const int key = kt * 32 + r32;
      sc[(2 * h) * 8192 + key] = va; sc[(2 * h + 1) * 8192 + key] = vb;
      lo0 = fminf(lo0, va); hi0 = fmaxf(hi0, va); lo1 = fminf(lo1, vb); hi1 = fmaxf(hi1, vb);
#pragma unroll
      for (int t = 0; t < 4; ++t) kf[t] = kn[t];
    }
    if (wid < ntile) {
#pragma unroll
      for (int o = 1; o < 32; o <<= 1) { lo0 = fminf(lo0, __shfl_xor(lo0, o)); hi0 = fmaxf(hi0, __shfl_xor(hi0, o)); lo1 = fminf(lo1, __shfl_xor(lo1, o)); hi1 = fmaxf(hi1, __shfl_xor(hi1, o)); }
      if (r32 == 0) { atomicMin(&mm[(2 * h) * 2], f2ord(lo0)); atomicMax(&mm[(2 * h) * 2 + 1], f2ord(hi0)); atomicMin(&mm[(2 * h + 1) * 2], f2ord(lo1)); atomicMax(&mm[(2 * h + 1) * 2 + 1], f2ord(hi1)); }
    }
  }
  if (next_item >= 0) sel_load_qw(p, next_item, qf, wq, lane);
  lds_barrier();
  {
    const int g = wid >> 1, gt = tid & 127, upper = wid & 1;
    const int t = t0 + g, n = t + 1;
    const bool big = n > 256;
    const float* scq = sc + g * 8192;
    unsigned short* out = SEL + (rowb + t) * 256;
    int* histq = hist + g * 1024;
    unsigned long long* clq = clist + g * 128;
    int* mq = misc + 32 + g * 8;
    const float lo = ord2f(mm[g * 2]), hi = ord2f(mm[g * 2 + 1]);
    const float scale = (hi > lo) ? 1023.f / (hi - lo) : 0.f;
    for (int i = gt; i < 1024; i += 128) histq[i] = 0;
    if (gt == 0) { mq[0] = 0; mq[6] = 0; }
    lds_barrier();
    float uu[64];
#pragma unroll
    for (int i = 0; i < 64; ++i) { const int idx = gt + 128 * i; const float v = (idx < n) ? scq[idx] : lo; const float u = (v - lo) * scale; uu[i] = u;
      if (big && idx < n) { int bb = (int)u; bb = bb > 1023 ? 1023 : bb; atomicAdd(&histq[bb], 1); } }
    lds_barrier();
    typedef int i32x4 __attribute__((ext_vector_type(4)));
    const i32x4 h0 = *(const i32x4*)(histq + gt * 8), h1 = *(const i32x4*)(histq + gt * 8 + 4);
    const int hh[8] = {h0.x, h0.y, h0.z, h0.w, h1.x, h1.y, h1.z, h1.w};
    int tot = 0;
#pragma unroll
    for (int k = 0; k < 8; ++k) tot += hh[k];
    int inc = tot;
#pragma unroll
    for (int o = 1; o < 64; o <<= 1) { const int ux = __shfl_down(inc, o); if (lane + o < 64) inc += ux; }
    if (lane == 0) misc[wid] = inc;
    lds_barrier();
    {
      int above = inc - tot + (upper ? 0 : misc[wid + 1]);
      if (big) {
#pragma unroll
        for (int k = 7; k >= 0; --k) { const int c = hh[k]; if (above < 256 && above + c >= 256) { mq[1] = gt * 8 + k; mq[2] = 256 - above; mq[3] = c; } above += c; }
      }
    }
    lds_barrier();
    const int bstar = mq[1], need = mq[2], cnt = mq[3];
    const float flo = (float)bstar, fhi = (bstar >= 1023) ? INFINITY : (float)(bstar + 1);
    const bool tie = big && cnt != need;
    if (tie) {
      if (cnt <= 128) {
#pragma unroll
        for (int i = 0; i < 64; ++i) { const int idx = gt + 128 * i; if (idx < n && uu[i] >= flo && uu[i] < fhi) { const int slot = atomicAdd(&mq[0], 1); clq[slot] = mkcmp(scq[idx], idx); } }
      } else if (gt == 0) mq[6] = 1;
    }
    lds_barrier();
    if (tie && cnt <= 128 && gt < cnt) { const unsigned long long c = clq[gt]; int rank = 0; for (int jx = 0; jx < cnt; ++jx) rank += (clq[jx] > c) ? 1 : 0;
      if (rank == need - 1) { mq[4] = (int)(unsigned)(c & 0xffffffffull); mq[5] = (int)(unsigned)(c >> 32); } }
    lds_barrier();
    const unsigned long long T = tie ? (((unsigned long long)(unsigned)mq[5] << 32) | (unsigned long long)(unsigned)mq[4]) : 0ull;
    const bool fast = big && !(tie && cnt > 128);
    unsigned long long selm = 0ull;
    if (fast) {
#pragma unroll
      for (int i = 0; i < 64; ++i) { const int idx = gt + 128 * i;
        if (idx < n) { const float u = uu[i]; bool sel = u >= fhi; if (!sel && u >= flo) sel = !tie || (mkcmp(scq[idx], idx) >= T); if (sel) selm |= (1ull << i); } }
    }
    const int mycnt = __popcll(selm);
    int pinc = mycnt;
#pragma unroll
    for (int o = 1; o < 64; o <<= 1) { const int ux = __shfl_up(pinc, o); if (lane >= o) pinc += ux; }
    if (lane == 63) misc[8 + wid] = pinc;
    lds_barrier();
    if (fast) {
      int pos = pinc - mycnt + (upper ? misc[8 + wid - 1] : 0);
      while (selm) { const int i = __ffsll((long long)selm) - 1; selm &= selm - 1ull; if (pos < 256) out[pos] = (unsigned short)(gt + 128 * i); ++pos; }
    } else if (!big) {
      for (int i = gt; i < n; i += 128) out[i] = (unsigned short)i;
    }
    lds_barrier();
  }
  for (int q = 0; q < 4; ++q) {
    if (misc[32 + q * 8 + 6]) { const int t = t0 + q; select_slow(sc + q * 8192, t + 1, SEL + (rowb + t) * 256, ord2f(mm[q * 2]), ord2f(mm[q * 2 + 1]), hist, misc, clist); }
  }
  lds_barrier();
}

constexpr int DKP = 72, DVP = 136;
constexpr int D_STAGE = (64 * DKP * 2 + 64 * DVP) * 2;
DI void mixerD_unit(const Params& p, int b, int head, int qb, char* lds) {
  const bf16* PO = (const bf16*)(p.ws + WS_PE); bf16* Y = (bf16*)(p.ws + WS_Y);
  const int tid = opaque_tid(), lane = tid & 63, wid = tid >> 6, r32 = lane & 31, h = lane >> 5;
  const int map = wid & 1, qsub = wid >> 1;
  const size_t rowb = (size_t)b * SEQ;
  const int qpos = 128 * qb + 32 * qsub + r32;
  bf16x8 qf[4]; load_q(qf, PO + (rowb + qpos) * NPO + O_DQ + (2 * head + map) * 64, h);
  f32x16 o[4]; zero_o<4>(o);
  float m = -1e30f, l = 0.f;
  const int nsteps = 2 * qb + 2;
  const bf16* K1g = PO + rowb * NPO + O_DK + (2 * head) * 64;
  const bf16* K2g = K1g + 64;
  const bf16* Vg = PO + rowb * NPO + O_DV + head * 128;
  u32x4 rk1, rk2, rv[2];
#define D_LOAD(j) do { const int row = tid >> 3, ch = tid & 7; const size_t off = (size_t)((j) * 64 + row) * NPO + ch * 8; rk1 = *(const u32x4*)(K1g + off); rk2 = *(const u32x4*)(K2g + off); \
    _Pragma("unroll") for (int i = 0; i < 2; ++i) { const int c = tid + 512 * i, vr = c >> 4, vc = c & 15; rv[i] = *(const u32x4*)(Vg + (size_t)((j) * 64 + vr) * NPO + vc * 8); } } while (0)
  __syncthreads();
  D_LOAD(0);
  for (int j = 0; j < nsteps; ++j) {
    char* st = lds + (j & 1) * D_STAGE;
    bf16* K1s = (bf16*)st; bf16* K2s = K1s + 64 * DKP; bf16* Vs = K2s + 64 * DKP;
    { const int row = tid >> 3, ch = tid & 7; *(u32x4*)(K1s + row * DKP + ch * 8) = rk1; *(u32x4*)(K2s + row * DKP + ch * 8) = rk2;
#pragma unroll
      for (int i = 0; i < 2; ++i) { const int c = tid + 512 * i, vr = c >> 4, vc = c & 15; *(u32x4*)(Vs + vr * DVP + vc * 8) = rv[i]; } }
    __syncthreads();
    if (j + 1 < nsteps) D_LOAD(j + 1);
    const bf16* Ks = map ? K2s : K1s;
#pragma unroll
    for (int sub = 0; sub < 2; ++sub) {
      const int k0 = j * 64 + sub * 32;
      if (k0 <= 128 * qb + 32 * qsub + 31) {
        if (k0 + 31 <= 128 * qb + 32 * qsub) {
          attn_step32<4, false>(Ks + sub * 32 * DKP, DKP, Vs + sub * 32 * DVP, DVP, qf, o, m, l, 0xffffu, 0.125f * LOG2E, lane);
        } else {
          unsigned vm = 0;
#pragma unroll
          for (int i = 0; i < 16; ++i) if (k0 + crow(i, h) <= qpos) vm |= (1u << i);
          attn_step32<4, true>(Ks + sub * 32 * DKP, DKP, Vs + sub * 32 * DVP, DVP, qf, o, m, l, vm, 0.125f * LOG2E, lane);
        }
      }
    }
  }
#undef D_LOAD
  l += __shfl_xor(l, 32);
  const float linv = 1.f / l;
  __syncthreads();
  float* xch = (float*)lds + qsub * 4096;
  if (map == 1) {
#pragma unroll
    for (int d = 0; d < 4; ++d)
#pragma unroll
      for (int i = 0; i < 16; ++i) xch[(d * 16 + i) * 64 + lane] = o[d][i] * linv;
  }
  __syncthreads();
  if (map == 0) {
    const float lam = *(const float*)(p.ws + WS_LAM);
    float ssq = 0.f;
#pragma unroll
    for (int d = 0; d < 4; ++d)
#pragma unroll
      for (int i = 0; i < 16; ++i) { const float a = o[d][i] * linv - lam * xch[(d * 16 + i) * 64 + lane]; o[d][i] = a; ssq += a * a; }
    ssq += __shfl_xor(ssq, 32);
    const float lambda_init = 0.8f - 0.6f * expf(-0.3f);
    const float rn = rsqrtf(ssq * (1.f / 128.f) + EPS) * (1.f - lambda_init);
    const size_t tok = rowb + qpos;
    const bf16* gate = PO + tok * NPO + O_DG + head * 128;
    bf16* y = Y + tok * DM + 512 + head * 128;
    const float* sg = p.in[I_SUB_GAIN];
#pragma unroll
    for (int d = 0; d < 4; ++d)
#pragma unroll
      for (int g = 0; g < 4; ++g) {
        const int dd = 32 * d + 8 * g + 4 * h;
        const u32x2 gv = *(const u32x2*)(gate + dd); const f32x4 s4 = *(const f32x4*)(sg + dd);
        const float g0 = __uint_as_float(gv.x << 16), g1 = __uint_as_float(gv.x & 0xffff0000u), g2 = __uint_as_float(gv.y << 16), g3 = __uint_as_float(gv.y & 0xffff0000u);
        u32x2 w; w.x = cvtpk(o[d][4 * g] * rn * s4.x * g0, o[d][4 * g + 1] * rn * s4.y * g1); w.y = cvtpk(o[d][4 * g + 2] * rn * s4.z * g2, o[d][4 * g + 3] * rn * s4.w * g3);
        *(u32x2*)(y + dd) = w;
      }
  }
  __syncthreads();
}

#define XB_TMO      128
#define XB_XCNT(j)  (256  + 64 * (j))
#define XB_XSUB(j)  (1280 + 64 * (j))
#define XB_XGEN(j)  (2304 + 64 * (j))
#define XB_TOP      3328
#define XB_TOPGEN   3392
#define XCD_BAR_WORDS 3456
#define XB_SPIN_CAP (1u << 18)

__device__ __forceinline__ unsigned xb_ld(unsigned* p)              { return __hip_atomic_load(p, __ATOMIC_RELAXED, __HIP_MEMORY_SCOPE_AGENT); }
__device__ __forceinline__ unsigned xb_add(unsigned* p, unsigned v) { return __hip_atomic_fetch_add(p, v, __ATOMIC_RELAXED, __HIP_MEMORY_SCOPE_AGENT); }
__device__ __forceinline__ unsigned xb_xcc_id() { return (unsigned)__builtin_amdgcn_s_getreg((3 << 11) | 20) & 0xFu; }
#define XB_SPIN(cond, bar) do { unsigned _sp = 0; while (cond) { __builtin_amdgcn_s_sleep(1); \
    if ((++_sp & 255u) == 0u) { if (xb_ld(&(bar)[XB_TMO])) break; if (_sp > XB_SPIN_CAP) { atomicAdd(&(bar)[XB_TMO], 1u); break; } } } } while (0)

struct XcdBarrier {
    unsigned* bar; unsigned x;
    volatile LAS unsigned* st;
};

__device__ __forceinline__ XcdBarrier xcd_barrier_post(unsigned* bar, volatile LAS unsigned* st) {
    XcdBarrier b; b.bar = bar; b.x = xb_xcc_id(); b.st = st;
    if (threadIdx.x == 0) (void)xb_add(&bar[XB_XCNT(b.x)], 1u);
    return b;
}
__device__ __forceinline__ void xcd_barrier_complete(unsigned* bar, unsigned x, unsigned& nloc, unsigned& nx) {
    const unsigned G = gridDim.x * gridDim.y * gridDim.z;
    unsigned sum, cnt, mine, sp = 0u;
    for (;;) {
        sum = 0u; cnt = 0u; mine = 0u;
#pragma unroll
        for (unsigned j = 0; j < 16; ++j) { const unsigned c = xb_ld(&bar[XB_XCNT(j)]); sum += c; cnt += (c > 0u) ? 1u : 0u; mine = (j == x) ? c : mine; }
        if (sum == G) break;
        __builtin_amdgcn_s_sleep(1);
        if ((++sp & 255u) == 0u) { if (xb_ld(&bar[XB_TMO])) break; if (sp > XB_SPIN_CAP) { atomicAdd(&bar[XB_TMO], 1u); break; } }
    }
    nloc = mine > 0u ? mine : 1u; nx = cnt > 0u ? cnt : 1u;
}

__device__ __forceinline__ void xcd_barrier(const XcdBarrier& b) {
    asm volatile("s_waitcnt vmcnt(0)" ::: "memory");
    __syncthreads();
    if (threadIdx.x == 0) {
        unsigned* bar = b.bar;
        __builtin_amdgcn_s_waitcnt(0);
        unsigned nloc = b.st[0], nx = b.st[1];
        if (nloc == 0u) { xcd_barrier_complete(bar, b.x, nloc, nx); b.st[0] = nloc; b.st[1] = nx; }
        const unsigned old = xb_add(&bar[XB_XSUB(b.x)], 1u);
        const unsigned gen = old / nloc;
        if (old + 1u == (gen + 1u) * nloc) {
            __builtin_amdgcn_fence(__ATOMIC_RELEASE, "agent");
            asm volatile("s_waitcnt vmcnt(0)" ::: "memory");
            const unsigned og = xb_add(&bar[XB_TOP], 1u);
            const unsigned tg = og / nx;
            if (og + 1u == (tg + 1u) * nx) xb_add(&bar[XB_TOPGEN], 1u);
            else XB_SPIN(xb_ld(&bar[XB_TOPGEN]) == tg, bar);
            __builtin_amdgcn_fence(__ATOMIC_ACQUIRE, "agent");
            xb_add(&bar[XB_XGEN(b.x)], 1u);
            asm volatile("s_waitcnt vmcnt(0)" ::: "memory");
        } else {
            XB_SPIN(xb_ld(&bar[XB_XGEN(b.x)]) == gen, bar);
            __builtin_amdgcn_fence(__ATOMIC_ACQUIRE, "agent");
            asm volatile("s_waitcnt vmcnt(0)" ::: "memory");
        }
    }
    __syncthreads();
}


__global__ void __launch_bounds__(NTHREADS) fwd_kernel(Params p) {
  extern __shared__ __attribute__((aligned(16))) char smem[];
  cg::grid_group grid = cg::this_grid();
  char* lds = smem;
  volatile LAS unsigned* xb_st = (volatile LAS unsigned*)((LAS char*)smem + (LDS_BYTES - 16));
  if (threadIdx.x < 2) xb_st[threadIdx.x] = 0u;
  __syncthreads();
  const XcdBarrier xbar = xcd_barrier_post((unsigned*)(p.ws + WS_BAR), xb_st);
#define FRESH_IDS const int tid = opaque_tid(), lane = tid & 63, wid = tid >> 6; const int gw = blockIdx.x * 8 + wid, ngw = gridDim.x * 8; bf16* Ks = (bf16*)(lds + wid * WAVE_LDS); bf16* Vs = Ks + 32 * WP; (void)gw; (void)ngw; (void)Ks; (void)Vs; (void)lane;

  phase_prologue(p, lds);
  if (p.ws == nullptr) grid.sync();
  xcd_barrier(xbar);
  for (int rep = 0; rep < REP_GEMM; ++rep) phase_inproj(p, 0, lds);
  xcd_barrier(xbar);
#if EN_A
  for (int rep = 0; rep < REP_SELA; ++rep) { FRESH_IDS
#define SEL_ITEM(k) ((k) * (int)gridDim.x + (((k) & 1) ? (int)gridDim.x - 1 - (int)blockIdx.x : (int)blockIdx.x))
    bf16x8 sqf[4]; float swq[16];
    if (SEL_ITEM(0) < 2 * 2048) sel_load_qw(p, SEL_ITEM(0), sqf, swq, lane);
    for (int k = 0; k * (int)gridDim.x < 2 * 2048; ++k) { const int it = SEL_ITEM(k); int nx = SEL_ITEM(k + 1); if (nx >= 2 * 2048) nx = -1; if (it < 2 * 2048) selectA_item(p, it, nx, lds, sqf, swq); }
#undef SEL_ITEM
  }
  xcd_barrier(xbar);
  { FRESH_IDS for (int rep = 0; rep < REP_AATT; ++rep) for (int it = gw; it < NTOK; it += ngw) mixerA_item(p, it, Ks, Vs, lane); }
#else
  { unsigned* y = (unsigned*)(p.ws + WS_Y); for (int i = blockIdx.x * NTHREADS + (int)threadIdx.x; i < NTOK * 256; i += gridDim.x * NTHREADS) { const int row = i >> 8, c = i & 255; y[row * 512 + c] = 0u; } }
#endif
#if EN_B
  { FRESH_IDS for (int it = gw; it < 4096; it += ngw) mixerB_tile(p, it, Ks, Vs, lane); }
#else
  { unsigned* y = (unsigned*)(p.ws + WS_Y); for (int i = blockIdx.x * NTHREADS + (int)threadIdx.x; i < NTOK * 256; i += gridDim.x * NTHREADS) { const int row = i >> 8, c = i & 255; y[row * 512 + 256 + c] = 0u; } }
#endif
  xcd_barrier(xbar);
  phase_outproj(p, 0, lds);
  xcd_barrier(xbar);
  phase_ple(p, 0, lds);
  xcd_barrier(xbar);
  phase_inproj(p, 1, lds);
  xcd_barrier(xbar);
#if EN_D
  for (int rep = 0; rep < REP_D; ++rep) {
#pragma unroll 1
    for (int u2 = blockIdx.x * 2; u2 < 512; u2 += gridDim.x * 2) {
#pragma unroll 1
      for (int k = 0; k < 2; ++k) { const int u = u2 >> 1, bh = u >> 5, pr = u & 31; mixerD_unit(p, bh >> 2, bh & 3, k ? 63 - pr : pr, lds); }
    }
  }
#else
  { unsigned* y = (unsigned*)(p.ws + WS_Y); for (int i = blockIdx.x * NTHREADS + (int)threadIdx.x; i < NTOK * 256; i += gridDim.x * NTHREADS) { const int row = i >> 8, c = i & 255; y[row * 512 + 256 + c] = 0u; } }
#endif
#if EN_C
  __syncthreads();
  { FRESH_IDS for (int rep = 0; rep < REP_C; ++rep) for (int it = gw; it < 4096; it += ngw) mixerC_tile(p, it, Ks, Vs, lane); }
#else
  { unsigned* y = (unsigned*)(p.ws + WS_Y); for (int i = blockIdx.x * NTHREADS + (int)threadIdx.x; i < NTOK * 256; i += gridDim.x * NTHREADS) { const int row = i >> 8, c = i & 255; y[row * 512 + c] = 0u; } }
#endif
  xcd_barrier(xbar);
  phase_outproj(p, 1, lds);
  xcd_barrier(xbar);
  phase_ple(p, 1, lds);
}

extern "C" void kernel_launch(void* const* d_in, const int* in_sizes, int n_in, void* d_out, int out_size, void* d_ws, size_t ws_size, hipStream_t stream) {
  static int grid_blocks = 0;
  if (!grid_blocks) {
    int dev = 0, cus = 0, per_cu = 0;
    hipGetDevice(&dev);
    hipDeviceGetAttribute(&cus, hipDeviceAttributeMultiprocessorCount, dev);
    hipFuncSetAttribute((const void*)fwd_kernel, hipFuncAttributeMaxDynamicSharedMemorySize, LDS_BYTES);
    hipOccupancyMaxActiveBlocksPerMultiprocessor(&per_cu, (const void*)fwd_kernel, NTHREADS, LDS_BYTES);
    if (per_cu < 1) per_cu = 1;
    grid_blocks = cus * per_cu;
    if (grid_blocks > 256) grid_blocks = 256;
  }
  Params p{};
  for (int i = 0; i < 25; ++i) p.in[i] = (const float*)d_in[i];
  p.out = (float*)d_out; p.ws = (unsigned char*)d_ws;
  for (int i = 0; i < 32; ++i) p.inv_freq[i] = (float)pow(10000.0, -(double)i / 32.0);
  (void)hipMemsetAsync((char*)d_ws + WS_BAR, 0, 16384, stream);
  void* args[] = {&p};
  hipError_t e = hipLaunchCooperativeKernel((const void*)fwd_kernel, dim3(grid_blocks), dim3(NTHREADS), args, LDS_BYTES, stream);
  if (e != hipSuccess) fprintf(stderr, "cooperative launch failed: %s (grid %d)\n", hipGetErrorString(e), grid_blocks);
}
```

```cpp
#include <hip/hip_runtime.h>
#include <hip/hip_cooperative_groups.h>
#include <cstdio>
#include <cmath>
namespace cg = cooperative_groups;

#ifndef REP_GEMM
#define REP_GEMM 1
#endif
#ifndef REP_SELA
#define REP_SELA 1
#endif
#ifndef REP_D
#define REP_D 1
#endif
#ifndef REP_C
#define REP_C 1
#endif
#ifndef REP_AATT
#define REP_AATT 1
#endif
#ifndef EN_A
#define EN_A 1
#endif
#ifndef EN_B
#define EN_B 1
#endif
#ifndef EN_C
#define EN_C 1
#endif
#ifndef EN_D
#define EN_D 1
#endif

typedef unsigned short bf16;
typedef short bf16x8 __attribute__((ext_vector_type(8)));
typedef short s16x4 __attribute__((ext_vector_type(4)));
typedef float f32x4 __attribute__((ext_vector_type(4)));
typedef float f32x16 __attribute__((ext_vector_type(16)));
typedef unsigned u32x4 __attribute__((ext_vector_type(4)));
typedef unsigned u32x2 __attribute__((ext_vector_type(2)));
typedef float f32x2_t __attribute__((ext_vector_type(2)));
typedef __bf16 bf16x2_t __attribute__((ext_vector_type(2)));
#define LAS __attribute__((address_space(3)))
#define DI __device__ __forceinline__

constexpr int SEQ = 8192, NTOK = 16384, DM = 1024;
constexpr int NPE = 3072, NPO = 4096;
constexpr float EPS = 1e-6f;
constexpr float LOG2E = 1.4426950408889634f;
constexpr int NTHREADS = 512;
constexpr int LDS_BYTES = 150 * 1024;

constexpr size_t MiB = 1u << 20;
constexpr size_t WS_PE = 0;
constexpr size_t WS_ACT = 128 * MiB;
constexpr size_t WS_Y = 160 * MiB;
constexpr size_t WS_WINE = 192 * MiB;
constexpr size_t WS_WOUTE = 198 * MiB;
constexpr size_t WS_WINO = 200 * MiB;
constexpr size_t WS_WOUTO = 208 * MiB;
constexpr size_t WS_WG0 = 210 * MiB;
constexpr size_t WS_WG1 = 212 * MiB;
constexpr size_t WS_WP0 = 214 * MiB;
constexpr size_t WS_WP1 = 215 * MiB;
constexpr size_t WS_ROPE = 216 * MiB;
constexpr size_t WS_SEL = 218 * MiB;
constexpr size_t WS_IW = 226 * MiB;
constexpr size_t WS_SS = 227 * MiB;
constexpr size_t WS_LAM = 228 * MiB;
constexpr size_t WS_BAR = 250 * MiB;
constexpr size_t WS_PBF = 232 * MiB;
constexpr size_t WS_IKS = 229 * MiB;

struct Params {
  const float* in[25];
  float* out;
  unsigned char* ws;
  float inv_freq[32];
};
enum { I_X = 0, I_P, I_NORM_GAIN, I_W_IN_EVEN, I_W_OUT_EVEN, I_A_Q_GAIN, I_A_K_GAIN, I_IDX_K_GAIN, I_B_Q_GAIN, I_B_K_GAIN, I_B_SINKS,
       I_W_IN_ODD, I_W_OUT_ODD, I_C_Q_GAIN, I_C_K_GAIN, I_D_Q_GAIN, I_D_K_GAIN, I_LQ1, I_LK1, I_LQ2, I_LK2, I_SUB_GAIN, I_PLE_NORM_GAIN,
       I_W_PLE_GATE, I_W_PLE_PROJ };

DI unsigned cvtpk(float lo, float hi) { f32x2_t v = {lo, hi}; bf16x2_t b = __builtin_convertvector(v, bf16x2_t); return __builtin_bit_cast(unsigned, b); }
DI float bf2f(bf16 b) { return __uint_as_float(((unsigned)b) << 16); }
DI float fexp2(float x) { return __builtin_amdgcn_exp2f(x); }
DI f32x16 mfma32(bf16x8 a, bf16x8 b, f32x16 c) { return __builtin_amdgcn_mfma_f32_32x32x16_bf16(a, b, c, 0, 0, 0); }
DI f32x4 mfma16(bf16x8 a, bf16x8 b, f32x4 c) { return __builtin_amdgcn_mfma_f32_16x16x32_bf16(a, b, c, 0, 0, 0); }
DI int crow(int i, int h) { return (i & 3) + 8 * (i >> 2) + 4 * h; }
DI s16x4 trread(const bf16* p) { return __builtin_bit_cast(s16x4, __builtin_amdgcn_ds_read_tr16_b64_v4i16((LAS s16x4*)p)); }
DI int opaque_tid() { int t = threadIdx.x; asm volatile("" : "+v"(t)); return t; }
DI void lds_barrier() { asm volatile("s_waitcnt lgkmcnt(0)" ::: "memory"); __builtin_amdgcn_s_barrier(); asm volatile("" ::: "memory"); }
DI void lds_fence() { asm volatile("s_waitcnt lgkmcnt(0)" ::: "memory"); __builtin_amdgcn_wave_barrier(); }

__host__ __device__ __forceinline__ int phys_col(int n) { return (n & ~255) + 128 * ((n >> 5) & 1) + 32 * ((n >> 6) & 3) + (n & 31); }
DI int map_even(int n) { return n < 1216 ? n : (n < 1224 ? 3008 + (n - 1216) : n - 8); }
DI void transpose_tile(const float* W, int K, int N, bf16* WT, int mapmode, int tile, float* scr) {
  const int tid = opaque_tid();
  const int ntn = (N + 63) >> 6, kt = tile / ntn, nt = tile % ntn, k0 = kt * 64, n0 = nt * 64;
#pragma unroll
  for (int i = 0; i < 8; ++i) {
    const int kk = (tid >> 6) + 8 * i, nn = tid & 63, n = n0 + nn;
    scr[kk * 65 + nn] = (n < N) ? W[(size_t)(k0 + kk) * N + n] : 0.f;
  }
  __syncthreads();
  {
    const int nn = tid >> 3, kc = tid & 7, n = n0 + nn;
    if (n < N) {
      const int dst = mapmode == 1 ? phys_col(map_even(n)) : (mapmode == 2 ? phys_col(n) : n);
      const float* s = scr + (kc * 8) * 65 + nn;
      u32x4 o; o.x = cvtpk(s[0], s[65]); o.y = cvtpk(s[2 * 65], s[3 * 65]); o.z = cvtpk(s[4 * 65], s[5 * 65]); o.w = cvtpk(s[6 * 65], s[7 * 65]);
      *(u32x4*)(WT + (size_t)dst * K + k0 + kc * 8) = o;
    }
  }
  __syncthreads();
}

DI float wave_sum(float v) {
#pragma unroll
  for (int o = 1; o < 64; o <<= 1) v += __shfl_xor(v, o);
  return v;
}

DI void phase_prologue(const Params& p, char* lds) {
  const int tid = opaque_tid(), lane = tid & 63, wid = tid >> 6;
  const int nb = gridDim.x, bid = blockIdx.x;
  unsigned char* ws = p.ws;
  float* scr = (float*)lds;
  const int T0 = 16 * 48, T1 = 256, T2 = 16 * 64, T3 = 256, T4 = 256, T5 = 256, T6 = 64, T7 = 64;
  const int NT = T0 + T1 + T2 + T3 + T4 + T5 + T6 + T7;
  for (int it = bid; it < NT; it += nb) {
    int r = it;
    if (r < T0) { transpose_tile(p.in[I_W_IN_EVEN], 1024, 3016, (bf16*)(ws + WS_WINE), 1, r, scr); continue; } r -= T0;
    if (r < T1) { transpose_tile(p.in[I_W_OUT_EVEN], 1024, 1024, (bf16*)(ws + WS_WOUTE), 0, r, scr); continue; } r -= T1;
    if (r < T2) { transpose_tile(p.in[I_W_IN_ODD], 1024, 4096, (bf16*)(ws + WS_WINO), 2, r, scr); continue; } r -= T2;
    if (r < T3) { transpose_tile(p.in[I_W_OUT_ODD], 1024, 1024, (bf16*)(ws + WS_WOUTO), 0, r, scr); continue; } r -= T3;
    if (r < T4) { transpose_tile(p.in[I_W_PLE_GATE], 1024, 1024, (bf16*)(ws + WS_WG0), 0, r, scr); continue; } r -= T4;
    if (r < T5) { transpose_tile(p.in[I_W_PLE_GATE] + 1024 * 1024, 1024, 1024, (bf16*)(ws + WS_WG1), 0, r, scr); continue; } r -= T5;
    if (r < T6) { transpose_tile(p.in[I_W_PLE_PROJ], 256, 1024, (bf16*)(ws + WS_WP0), 0, r, scr); continue; } r -= T6;
    transpose_tile(p.in[I_W_PLE_PROJ] + 256 * 1024, 256, 1024, (bf16*)(ws + WS_WP1), 0, r, scr);
  }
  const int gt = bid * NTHREADS + tid, ngt = nb * NTHREADS;
  { unsigned* z = (unsigned*)(ws + WS_WINE); for (int i = gt; i < 56 * 512; i += ngt) z[(size_t)phys_col(3016 + (i >> 9)) * 512 + (i & 511)] = 0u; }
  { const f32x4* src = (const f32x4*)p.in[I_P]; u32x2* dst = (u32x2*)(ws + WS_PBF); for (int i = gt; i < 2 * NTOK * 256 / 4; i += ngt) { const f32x4 v = src[i]; u32x2 w; w.x = cvtpk(v.x, v.y); w.y = cvtpk(v.z, v.w); dst[i] = w; } }
  { float* ss = (float*)(ws + WS_SS); for (int i = gt; i < 3 * NTOK; i += ngt) ss[i] = 0.f; }
  { float2* tab = (float2*)(ws + WS_ROPE);
    for (int i = gt; i < SEQ * 32; i += ngt) {
      const int pos = i >> 5, k = i & 31;
      const float ang = (float)pos * p.inv_freq[k];
      double rev = (double)ang * 0.15915494309189535; rev -= floor(rev);
      const float rf = (float)rev;
      tab[i] = make_float2(__builtin_amdgcn_cosf(rf), __builtin_amdgcn_sinf(rf));
    } }
  if (bid == 0 && wid == 0) {
    const float a = wave_sum(p.in[I_LQ1][lane] * p.in[I_LK1][lane]);
    const float b = wave_sum(p.in[I_LQ2][lane] * p.in[I_LK2][lane]);
    const float lambda_init = 0.8f - 0.6f * expf(-0.3f);
    if (lane == 0) *(float*)(ws + WS_LAM) = expf(a) - expf(b) + lambda_init;
  }
  { const float* x = p.in[I_X]; const float* g = p.in[I_NORM_GAIN]; bf16* H = (bf16*)(ws + WS_ACT);
    const int gw = bid * 8 + wid, ngw = nb * 8;
    for (int m = gw; m < NTOK; m += ngw) {
      const f32x4* xr = (const f32x4*)(x + (size_t)m * DM) + lane;
      f32x4 v[4]; float s = 0.f;
#pragma unroll
      for (int j = 0; j < 4; ++j) { v[j] = xr[64 * j]; s += v[j].x * v[j].x + v[j].y * v[j].y + v[j].z * v[j].z + v[j].w * v[j].w; }
      const float rstd = rsqrtf(wave_sum(s) * (1.f / DM) + EPS);
      u32x2* o = (u32x2*)(H + (size_t)m * DM) + lane;
#pragma unroll
      for (int j = 0; j < 4; ++j) { const f32x4 gg = *((const f32x4*)g + lane + 64 * j); u32x2 w; w.x = cvtpk(v[j].x * rstd * gg.x, v[j].y * rstd * gg.y); w.y = cvtpk(v[j].z * rstd * gg.z, v[j].w * rstd * gg.w); o[64 * j] = w; }
    } }
}

namespace pg8 {
#define PG8_LAS __attribute__((address_space(3)))
typedef unsigned short bf16_t;
typedef short bf16x8 __attribute__((ext_vector_type(8)));
typedef float f32x4 __attribute__((ext_vector_type(4)));
typedef unsigned u32x4 __attribute__((ext_vector_type(4)));
constexpr int BM = 256, BK = 64, HALF = 128, HTB = HALF * BK * 2  , STAGE_BYTES = 8 * HTB, NXCD = 8, WGM = 8;

__host__ __device__ __forceinline__ int lds_byte(int r, int c) { const int st = (r >> 4) * 2 + (c >> 5), rr = r & 15, cc = c & 31, ob = rr * 64 + cc * 2; return st * 1024 + (ob ^ (((ob >> 9) & 1) << 5)); }
__host__ __device__ __forceinline__ void stage_rc(int b, int& R, int& C) { const int st = b / 1024, sb = b % 1024, swz = sb ^ (((sb >> 9) & 1) << 5); R = (st >> 1) * 16 + swz / 64; C = (st & 1) * 32 + (swz % 64) / 2; }
__host__ __device__ __forceinline__ int perm32(int rho) { const int n = rho >> 4, i = rho & 15; return 8 * (i >> 2) + 4 * n + (i & 3); }

struct Unit { int pm, pn; };
struct Gemm { const bf16_t* A; const bf16_t* Bt; int M, N, K; };

struct StaticOrder {
    int nM, nN, nwg, G, c;
    __host__ __device__ void init(int M, int N, int G_, int c_) { nM = M / BM; nN = N / BM; nwg = nM * nN; G = G_; c = c_; }
    __host__ __device__ bool next(int i, Unit& u) const {
        const long L = (long)i * G + c; if (L >= nwg) return false;
        int wgid = (int)L; { const int q = nwg / NXCD, r = nwg % NXCD, xcd = wgid % NXCD, off = wgid / NXCD; wgid = (xcd < r ? xcd * (q + 1) : r * (q + 1) + (xcd - r) * q) + off; }
        const int nig = WGM * nN, gid = wgid / nig, fm = gid * WGM, gsz = (nM - fm) < WGM ? (nM - fm) : WGM;
        u.pm = fm + ((wgid % nig) % gsz); u.pn = (wgid % nig) / gsz; return true;
    }
    __device__ __forceinline__ void a_ready(const Unit&) const {}
    __device__ __forceinline__ void done(const Unit&) const {}
};
__device__ __forceinline__ unsigned cvt_pk_bf16(float lo, float hi) { unsigned r; asm volatile("v_cvt_pk_bf16_f32 %0, %1, %2" : "=v"(r) : "v"(lo), "v"(hi)); return r; }
template <class Epi, class Sched, bool ALIGN_EPI = false, bool SP2 = false>
__device__ __forceinline__ void gemm_phase(PG8_LAS unsigned char* lds, const Gemm g, const Sched& S, const Epi& E) {
    int tid_ = threadIdx.x; asm volatile("" : "+v"(tid_));
    const int tid = tid_, wid = __builtin_amdgcn_readfirstlane(tid >> 6), lane = tid & 63, wr = wid >> 2, wc = wid & 3, fr = lane & 15, fq = lane >> 4;
    const int K = g.K, nt = K / BK;
    unsigned voffA[2], voffB[2];
#pragma unroll
    for (int i = 0; i < 2; ++i) { int R, C; stage_rc(tid * 16 + i * 8192, R, C); const int Rb = Epi::PERM ? ((R & ~31) + perm32(R & 31)) : R;
        voffA[i] = (unsigned)(R * K + C) * 2u; voffB[i] = (unsigned)(Rb * K + C) * 2u; }
    const size_t kstep = (size_t)(BK * 2);
    const size_t hstep = (size_t)HALF * K * 2;
    const size_t tstep = 2 * hstep;
    const unsigned ldsw = (unsigned)wid * 1024u;
    const int aoff = lds_byte(wr * 64 + fr, fq * 8), boff = lds_byte(wc * 32 + fr, fq * 8);
#define PG8_SA(b, h) (((b) * 2 + (h)) * HTB)
#define PG8_SB(b, h) ((4 + (b) * 2 + (h)) * HTB)
#define PG8_STAGE(bufoff, gbase, voff) do { _Pragma("unroll") for (int _i = 0; _i < 2; ++_i) \
        __builtin_amdgcn_global_load_lds((const unsigned*)((const char*)(gbase) + (voff)[_i]), (PG8_LAS unsigned*)(lds + (bufoff) + ldsw + _i * 8192), 16, 0, 0); } while (0)
#define PG8_LDA(dst, b, h) do { _Pragma("unroll") for (int m = 0; m < 4; ++m) _Pragma("unroll") for (int k = 0; k < 2; ++k) dst[m][k] = *(const PG8_LAS bf16x8*)(lds + PG8_SA(b, h) + aoff + m * 2048 + k * 1024); } while (0)
#define PG8_LDB(dst, b, h) do { _Pragma("unroll") for (int n = 0; n < 2; ++n) _Pragma("unroll") for (int k = 0; k < 2; ++k) dst[n][k] = *(const PG8_LAS bf16x8*)(lds + PG8_SB(b, h) + boff + n * 2048 + k * 1024); } while (0)
#define PG8_MMA(ai, bj, At, Bt) do { __builtin_amdgcn_s_setprio(1); _Pragma("unroll") for (int m = 0; m < 4; ++m) _Pragma("unroll") for (int n = 0; n < 2; ++n) _Pragma("unroll") for (int k = 0; k < 2; ++k) \
        acc[ai][bj][m][n] = __builtin_amdgcn_mfma_f32_16x16x32_bf16(Bt[n][k], At[m][k], acc[ai][bj][m][n], 0, 0, 0); __builtin_amdgcn_s_setprio(0); } while (0)
#define PG8_WAIT_V(n) asm volatile("s_waitcnt vmcnt(" #n ")" ::: "memory")
#define PG8_WAIT_L(n) asm volatile("s_waitcnt lgkmcnt(" #n ")" ::: "memory")
#define PG8_BAR __builtin_amdgcn_s_barrier()
#define PG8_SCHED __builtin_amdgcn_sched_barrier(0)
    Unit cur, nxt; int ui = 0;
    if (!S.next(0, cur)) return;
    f32x4 acc[2][2][4][2];
#pragma unroll
    for (int a = 0; a < 2; ++a)
#pragma unroll
        for (int b = 0; b < 2; ++b)
#pragma unroll
            for (int m = 0; m < 4; ++m)
#pragma unroll
                for (int n = 0; n < 2; ++n) acc[a][b][m][n] = (f32x4){0.f, 0.f, 0.f, 0.f};
    bf16x8 At[4][2], B0[2][2], B1[2][2];
    const char* cA = (const char*)g.A + (size_t)cur.pm * tstep; const char* cB = (const char*)g.Bt + (size_t)cur.pn * tstep;
    S.a_ready(cur);
    if constexpr (SP2) {
        PG8_STAGE(PG8_SB(0, 0), cB, voffB); PG8_STAGE(PG8_SB(0, 1), cB + hstep, voffB); PG8_STAGE(PG8_SA(0, 0), cA, voffA); PG8_STAGE(PG8_SA(0, 1), cA + hstep, voffA);
        if (wr == 1) PG8_BAR;
        PG8_WAIT_V(2); PG8_BAR;
        PG8_STAGE(PG8_SB(1, 0), cB + kstep, voffB); PG8_STAGE(PG8_SA(1, 0), cA + kstep, voffA); PG8_STAGE(PG8_SB(1, 1), cB + hstep + kstep, voffB);
        PG8_WAIT_V(6); PG8_BAR;
    } else {
        PG8_STAGE(PG8_SB(0, 0), cB, voffB); PG8_STAGE(PG8_SA(0, 0), cA, voffA); PG8_STAGE(PG8_SB(0, 1), cB + hstep, voffB); PG8_STAGE(PG8_SA(0, 1), cA + hstep, voffA);
        if (wr == 1) PG8_BAR;
        PG8_WAIT_V(4); PG8_BAR;
        PG8_STAGE(PG8_SB(1, 0), cB + kstep, voffB); PG8_STAGE(PG8_SA(1, 0), cA + kstep, voffA); PG8_STAGE(PG8_SB(1, 1), cB + hstep + kstep, voffB);
        PG8_WAIT_V(6); PG8_BAR;
    }
    for (;;) {
        const bool has_next = S.next(ui + 1, nxt);
        const char* nA = has_next ? (const char*)g.A + (size_t)nxt.pm * tstep : cA; const char* nB = has_next ? (const char*)g.Bt + (size_t)nxt.pn * tstep : cB;
        for (int t = 0; t < nt; t += 2) {
            const bool last = (t == nt - 2);
            const char* a1 = cA + (size_t)(t + 1) * kstep;
            const char* a2 = last ? nA : cA + (size_t)(t + 2) * kstep; const char* b2 = last ? nB : cB + (size_t)(t + 2) * kstep;
            const char* a3 = a2 + kstep; const char* b3 = b2 + kstep;
            if (last && has_next) S.a_ready(nxt);
            if constexpr (SP2) {
            PG8_LDB(B0, 0, 0); PG8_LDB(B1, 0, 1); PG8_SCHED; PG8_LDA(At, 0, 0); PG8_STAGE(PG8_SA(1, 1), a1 + hstep, voffA);
            PG8_WAIT_V(8); PG8_WAIT_L(0); PG8_BAR; PG8_MMA(0, 0, At, B0); PG8_MMA(0, 1, At, B1); PG8_BAR; PG8_SCHED;
            PG8_LDA(At, 0, 1); PG8_STAGE(PG8_SB(0, 0), b2, voffB); PG8_STAGE(PG8_SB(0, 1), b2 + hstep, voffB); PG8_STAGE(PG8_SA(0, 0), a2, voffA);
            PG8_WAIT_V(8); PG8_WAIT_L(0); PG8_BAR; PG8_MMA(1, 0, At, B0); PG8_MMA(1, 1, At, B1); PG8_BAR; PG8_SCHED;
            PG8_LDB(B0, 1, 0); PG8_LDB(B1, 1, 1); PG8_SCHED; PG8_LDA(At, 1, 0); PG8_STAGE(PG8_SA(0, 1), a2 + hstep, voffA);
            PG8_WAIT_V(8); PG8_WAIT_L(0); PG8_BAR; PG8_MMA(0, 0, At, B0); PG8_MMA(0, 1, At, B1); PG8_BAR; PG8_SCHED;
            PG8_LDA(At, 1, 1); PG8_STAGE(PG8_SB(1, 0), b3, voffB); PG8_STAGE(PG8_SB(1, 1), b3 + hstep, voffB); PG8_STAGE(PG8_SA(1, 0), a3, voffA);
            PG8_WAIT_V(8); PG8_WAIT_L(0); PG8_BAR; PG8_MMA(1, 0, At, B0); PG8_MMA(1, 1, At, B1); PG8_BAR; PG8_SCHED;
            } else {
            PG8_LDB(B0, 0, 0); PG8_SCHED; PG8_LDA(At, 0, 0); PG8_STAGE(PG8_SA(1, 1), a1 + hstep, voffA);
            PG8_WAIT_L(8); PG8_BAR; PG8_WAIT_L(0); PG8_MMA(0, 0, At, B0); PG8_BAR; PG8_SCHED;
            PG8_LDB(B1, 0, 1); PG8_STAGE(PG8_SB(0, 0), b2, voffB);
            PG8_BAR; PG8_WAIT_L(0); PG8_MMA(0, 1, At, B1); PG8_BAR;
            PG8_LDA(At, 0, 1); PG8_STAGE(PG8_SA(0, 0), a2, voffA);
            PG8_BAR; PG8_WAIT_L(0); PG8_MMA(1, 0, At, B0); PG8_BAR; PG8_SCHED;
            PG8_STAGE(PG8_SB(0, 1), b2 + hstep, voffB);
            PG8_WAIT_V(6); PG8_BAR; PG8_MMA(1, 1, At, B1); PG8_BAR;
            PG8_LDB(B0, 1, 0); PG8_SCHED; PG8_LDA(At, 1, 0); PG8_STAGE(PG8_SA(0, 1), a2 + hstep, voffA);
            PG8_WAIT_L(8); PG8_BAR; PG8_WAIT_L(0); PG8_MMA(0, 0, At, B0); PG8_BAR; PG8_SCHED;
            PG8_LDB(B1, 1, 1); PG8_STAGE(PG8_SB(1, 0), b3, voffB);
            PG8_BAR; PG8_WAIT_L(0); PG8_MMA(0, 1, At, B1); PG8_BAR;
            PG8_LDA(At, 1, 1); PG8_STAGE(PG8_SA(1, 0), a3, voffA);
            PG8_BAR; PG8_WAIT_L(0); PG8_MMA(1, 0, At, B0); PG8_BAR; PG8_SCHED;
            PG8_STAGE(PG8_SB(1, 1), b3 + hstep, voffB);
            PG8_WAIT_V(6); PG8_BAR; PG8_MMA(1, 1, At, B1); PG8_BAR;
            }
        }
        if constexpr (ALIGN_EPI) { if (wr == 0) PG8_BAR; }
        if constexpr (!Epi::AFTER_DRAIN) { E(acc, cur, wr, wc, fr, fq); S.done(cur); }
        if (!has_next) break;
#pragma unroll
        for (int a = 0; a < 2; ++a)
#pragma unroll
            for (int b = 0; b < 2; ++b)
#pragma unroll
                for (int m = 0; m < 4; ++m)
#pragma unroll
                    for (int n = 0; n < 2; ++n) acc[a][b][m][n] = (f32x4){0.f, 0.f, 0.f, 0.f};
        cur = nxt; cA = nA; cB = nB; ++ui;
        if constexpr (ALIGN_EPI) { if (wr == 1) PG8_BAR; }
    }
    PG8_WAIT_V(0);
    if constexpr (!ALIGN_EPI) { if (wr == 0) PG8_BAR; }
    PG8_BAR;
    if constexpr (Epi::AFTER_DRAIN) { E.fused(acc, cur, wr, wc, fr, fq, lds, wid, lane); S.done(cur); }
#undef PG8_SA
#undef PG8_SB
#undef PG8_STAGE
#undef PG8_LDA
#undef PG8_LDB
#undef PG8_MMA
#undef PG8_WAIT_V
#undef PG8_WAIT_L
#undef PG8_BAR
#undef PG8_SCHED
}
}

enum { T_PLAIN = 0, T_NR = 1, T_ROPE = 2, T_SILU = 3, T_IW = 4 };
DI void slot_info(const Params& p, int layer, int slot, int& type, const float*& gain) {
  gain = nullptr;
  if (layer == 0) {
    if (slot < 8) { type = T_NR; gain = p.in[I_A_Q_GAIN]; }
    else if (slot == 8) { type = T_NR; gain = p.in[I_A_K_GAIN]; }
    else if (slot == 9) type = T_PLAIN;
    else if (slot < 18) type = T_ROPE;
    else if (slot == 18) { type = T_NR; gain = p.in[I_IDX_K_GAIN]; }
    else if (slot < 27) type = T_SILU;
    else if (slot < 35) { type = T_NR; gain = p.in[I_B_Q_GAIN]; }
    else if (slot < 37) { type = T_NR; gain = p.in[I_B_K_GAIN]; }
    else if (slot < 39) type = T_PLAIN;
    else if (slot < 47) type = T_SILU;
    else type = T_IW;
  } else {
    if (slot < 8) { type = T_NR; gain = p.in[I_C_Q_GAIN]; }
    else if (slot < 16) { type = T_NR; gain = p.in[I_C_K_GAIN]; }
    else if (slot < 24) type = T_PLAIN;
    else if (slot < 32) type = T_SILU;
    else if (slot < 40) { type = T_NR; gain = p.in[I_D_Q_GAIN]; }
    else if (slot < 48) { type = T_NR; gain = p.in[I_D_K_GAIN]; }
    else if (slot < 56) type = T_PLAIN;
    else type = T_SILU;
  }
}
constexpr int E_AQ = 0, E_AK = 512, E_AV = 576, E_IQ = 640, E_IK = 1152, E_AG = 1216, E_BQ = 1728, E_BK = 2240, E_BV = 2368, E_BG = 2496;
constexpr int O_CQ = 0, O_CK = 512, O_CV = 1024, O_CG = 1536, O_DQ = 2048, O_DK = 2560, O_DV = 3072, O_DG = 3584;

typedef pg8::f32x4 (AccT)[2][2][4][2];

struct EpiInProj {
  static constexpr bool PERM = false, AFTER_DRAIN = false;
  const Params& p; int layer;
  DI void operator()(const f32x4 (&acc)[2][2][4][2], const pg8::Unit& u, int wr, int wc, int fr, int fq) const {
    unsigned char* ws = p.ws;
    const int NP = layer == 0 ? NPE : NPO;
    bf16* PE = (bf16*)(ws + WS_PE);
    const float2* rope = (const float2*)(ws + WS_ROPE);
    const float* ss1 = (const float*)(ws + WS_SS);
    float* IW = (float*)(ws + WS_IW);
    const int slot = u.pn * 4 + wc;
    int type; const float* gain; slot_info(p, layer, slot, type, gain);
#pragma unroll
    for (int ai = 0; ai < 2; ++ai)
#pragma unroll
      for (int m = 0; m < 4; ++m) {
        const int row = u.pm * 256 + ai * 128 + wr * 64 + m * 16 + fr, pos = row & (SEQ - 1);
        float sc = 1.f;
        if (layer == 1) sc = rsqrtf(ss1[row] * (1.f / DM) + EPS);
        f32x4 v1[2], v2[2];
#pragma unroll
        for (int n = 0; n < 2; ++n) { v1[n] = acc[ai][0][m][n] * sc; v2[n] = acc[ai][1][m][n] * sc; }
        if (type == T_NR) {
          float s = 0.f;
#pragma unroll
          for (int n = 0; n < 2; ++n) s += v1[n].x * v1[n].x + v1[n].y * v1[n].y + v1[n].z * v1[n].z + v1[n].w * v1[n].w + v2[n].x * v2[n].x + v2[n].y * v2[n].y + v2[n].z * v2[n].z + v2[n].w * v2[n].w;
          s += __shfl_xor(s, 16); s += __shfl_xor(s, 32);
          const float rn = rsqrtf(s * (1.f / 64.f) + EPS);
#pragma unroll
          for (int n = 0; n < 2; ++n) { const f32x4 g1 = *(const f32x4*)(gain + n * 16 + fq * 4), g2 = *(const f32x4*)(gain + 32 + n * 16 + fq * 4); v1[n] = v1[n] * rn * g1; v2[n] = v2[n] * rn * g2; }
        }
        if (type == T_NR || type == T_ROPE) {
#pragma unroll
          for (int n = 0; n < 2; ++n) {
            const f32x4* cs = (const f32x4*)(rope + (size_t)pos * 32 + n * 16 + fq * 4);
            const f32x4 c01 = cs[0], c23 = cs[1];
            const f32x4 x1 = v1[n], x2 = v2[n];
            f32x4 o1, o2;
            o1.x = x1.x * c01.x - x2.x * c01.y; o2.x = x2.x * c01.x + x1.x * c01.y;
            o1.y = x1.y * c01.z - x2.y * c01.w; o2.y = x2.y * c01.z + x1.y * c01.w;
            o1.z = x1.z * c23.x - x2.z * c23.y; o2.z = x2.z * c23.x + x1.z * c23.y;
            o1.w = x1.w * c23.z - x2.w * c23.w; o2.w = x2.w * c23.z + x1.w * c23.w;
            v1[n] = o1; v2[n] = o2;
          }
        }
        if (type == T_SILU) {
#pragma unroll
          for (int n = 0; n < 2; ++n)
#pragma unroll
            for (int j = 0; j < 4; ++j) { const float a = v1[n][j]; v1[n][j] = a / (1.f + __expf(-a)); const float b = v2[n][j]; v2[n][j] = b / (1.f + __expf(-b)); }
        }
        if (type == T_IW) {
          if (fq < 2) *(f32x4*)(IW + (size_t)row * 8 + fq * 4) = v1[0];
        } else {
          bf16* dst = PE + (size_t)row * NP + slot * 64 + fq * 4;
#pragma unroll
          for (int n = 0; n < 2; ++n) {
            u32x2 w1, w2; w1.x = cvtpk(v1[n].x, v1[n].y); w1.y = cvtpk(v1[n].z, v1[n].w); w2.x = cvtpk(v2[n].x, v2[n].y); w2.y = cvtpk(v2[n].z, v2[n].w);
            *(u32x2*)(dst + n * 16) = w1; *(u32x2*)(dst + 32 + n * 16) = w2;
            if (layer == 0 && slot == 18) { bf16* IKS = (bf16*)(ws + WS_IKS); const int key = row & (SEQ - 1);
              bf16* base = IKS + (((size_t)(row >> 13) * 256 + (key >> 5)) * 4) * 512 + ((fq >> 1) * 32 + (key & 31)) * 8 + (fq & 1) * 4;
              *(u32x2*)(base + (size_t)n * 512) = w1; *(u32x2*)(base + (size_t)(n + 2) * 512) = w2; }
          }
        }
        asm volatile("" ::: "memory");
      }
  }
};

DI void phase_inproj(const Params& p, int layer, char* lds) {
  unsigned char* ws = p.ws;
  const int NP = layer == 0 ? NPE : NPO;
  pg8::Gemm g{(const bf16*)(ws + (layer == 0 ? WS_ACT : WS_Y)), (const bf16*)(ws + (layer == 0 ? WS_WINE : WS_WINO)), NTOK, NP, DM};
  pg8::StaticOrder S; S.init(NTOK, NP, (int)gridDim.x, (int)blockIdx.x);
  EpiInProj E{p, layer};
  pg8::gemm_phase<EpiInProj, pg8::StaticOrder, true, true>((PG8_LAS unsigned char*)lds, g, S, E);
}

struct EpiOutProj {
  static constexpr bool PERM = false, AFTER_DRAIN = false;
  const float* xin; bf16* X1B; bf16* XG; const float* pg; float* ss;
  DI void operator()(const f32x4 (&acc)[2][2][4][2], const pg8::Unit& u, int wr, int wc, int fr, int fq) const {
#pragma unroll
    for (int ai = 0; ai < 2; ++ai)
#pragma unroll
      for (int m = 0; m < 4; ++m) {
        const int row = u.pm * 256 + ai * 128 + wr * 64 + m * 16 + fr; float rs = 0.f;
#pragma unroll
        for (int bj = 0; bj < 2; ++bj)
#pragma unroll
          for (int n = 0; n < 2; ++n) {
            const int col = u.pn * 256 + bj * 128 + wc * 32 + n * 16 + fq * 4; const size_t off = (size_t)row * DM + col;
            const f32x4 xn = *(const f32x4*)(xin + off) + acc[ai][bj][m][n];
            { u32x2 wx; wx.x = cvtpk(xn.x, xn.y); wx.y = cvtpk(xn.z, xn.w); *(u32x2*)(X1B + off) = wx; }
            rs += xn.x * xn.x + xn.y * xn.y + xn.z * xn.z + xn.w * xn.w;
            const f32x4 gg = *(const f32x4*)(pg + col);
            u32x2 w; w.x = cvtpk(xn.x * gg.x, xn.y * gg.y); w.y = cvtpk(xn.z * gg.z, xn.w * gg.w); *(u32x2*)(XG + off) = w;
          }
        rs += __shfl_xor(rs, 16); rs += __shfl_xor(rs, 32);
        if (fq == 0) atomicAdd(ss + row, rs);
        asm volatile("" ::: "memory");
      }
  }
};
DI void phase_outproj(const Params& p, int layer, char* lds) {
  unsigned char* ws = p.ws;
  pg8::Gemm g{(const bf16*)(ws + WS_Y), (const bf16*)(ws + (layer == 0 ? WS_WOUTE : WS_WOUTO)), NTOK, DM, DM};
  pg8::StaticOrder S; S.init(NTOK, DM, (int)gridDim.x, (int)blockIdx.x);
  EpiOutProj E{layer == 0 ? p.in[I_X] : p.out, (bf16*)(ws + WS_PE + 64 * MiB), (bf16*)(ws + WS_ACT), p.in[I_PLE_NORM_GAIN] + layer * DM, (float*)(ws + WS_SS) + (layer == 0 ? 1 : 2) * NTOK};
  pg8::gemm_phase<EpiOutProj, pg8::StaticOrder, true, true>((PG8_LAS unsigned char*)lds, g, S, E);
}

struct EpiPleProj {
  static constexpr bool PERM = false, AFTER_DRAIN = false;
  bf16* PT;
  DI void operator()(const f32x4 (&acc)[2][2][4][2], const pg8::Unit& u, int wr, int wc, int fr, int fq) const {
#pragma unroll
    for (int ai = 0; ai < 2; ++ai)
#pragma unroll
      for (int m = 0; m < 4; ++m) {
        const int row = u.pm * 256 + ai * 128 + wr * 64 + m * 16 + fr;
#pragma unroll
        for (int bj = 0; bj < 2; ++bj)
#pragma unroll
          for (int n = 0; n < 2; ++n) { const f32x4 a = acc[ai][bj][m][n]; u32x2 w; w.x = cvtpk(a.x, a.y); w.y = cvtpk(a.z, a.w); *(u32x2*)(PT + (size_t)row * DM + u.pn * 256 + bj * 128 + wc * 32 + n * 16 + fq * 4) = w; }
      }
  }
};
struct EpiPleGate {
  static constexpr bool PERM = false, AFTER_DRAIN = false;
  const bf16* PT; const bf16* X1B; float* out; const float* ssx; float* ss1; bf16* H; const float* ng1; int layer;
  DI void operator()(const f32x4 (&acc)[2][2][4][2], const pg8::Unit& u, int wr, int wc, int fr, int fq) const {
#pragma unroll
    for (int ai = 0; ai < 2; ++ai)
#pragma unroll
      for (int m = 0; m < 4; ++m) {
        const int row = u.pm * 256 + ai * 128 + wr * 64 + m * 16 + fr; float rs = 0.f;
        const float rstd = rsqrtf(ssx[row] * (1.f / DM) + EPS);
#pragma unroll
        for (int bj = 0; bj < 2; ++bj)
#pragma unroll
          for (int n = 0; n < 2; ++n) {
            const int col = u.pn * 256 + bj * 128 + wc * 32 + n * 16 + fq * 4; const size_t off = (size_t)row * DM + col;
            f32x4 g;
#pragma unroll
            for (int j = 0; j < 4; ++j) g[j] = 1.f / (1.f + __expf(-rstd * acc[ai][bj][m][n][j]));
            const u32x2 pw = *(const u32x2*)(PT + off); f32x4 pp; pp.x = __uint_as_float(pw.x << 16); pp.y = __uint_as_float(pw.x & 0xffff0000u); pp.z = __uint_as_float(pw.y << 16); pp.w = __uint_as_float(pw.y & 0xffff0000u);
            const u32x2 xw = *(const u32x2*)(X1B + off); f32x4 x1; x1.x = __uint_as_float(xw.x << 16); x1.y = __uint_as_float(xw.x & 0xffff0000u); x1.z = __uint_as_float(xw.y << 16); x1.w = __uint_as_float(xw.y & 0xffff0000u);
            const f32x4 xn = x1 + pp * g;
            *(f32x4*)(out + off) = xn;
            if (layer == 0) {
              rs += xn.x * xn.x + xn.y * xn.y + xn.z * xn.z + xn.w * xn.w;
              const f32x4 gg = *(const f32x4*)(ng1 + col);
              u32x2 w; w.x = cvtpk(xn.x * gg.x, xn.y * gg.y); w.y = cvtpk(xn.z * gg.z, xn.w * gg.w); *(u32x2*)(H + off) = w;
            }
          }
        if (layer == 0) { rs += __shfl_xor(rs, 16); rs += __shfl_xor(rs, 32); if (fq == 0) atomicAdd(ss1 + row, rs); }
        asm volatile("" ::: "memory");
      }
  }
};
DI void phase_ple(const Params& p, int layer, char* lds) {
  unsigned char* ws = p.ws;
  bf16* PT = (bf16*)(ws + WS_PE);
  pg8::StaticOrder S; S.init(NTOK, DM, (int)gridDim.x, (int)blockIdx.x);
  { pg8::Gemm g{(const bf16*)(ws + WS_PBF) + (size_t)layer * NTOK * 256, (const bf16*)(ws + (layer == 0 ? WS_WP0 : WS_WP1)), NTOK, DM, 256};
    EpiPleProj E{PT};
    pg8::gemm_phase<EpiPleProj, pg8::StaticOrder, true, true>((PG8_LAS unsigned char*)lds, g, S, E); }
  { pg8::Gemm g{(const bf16*)(ws + WS_ACT), (const bf16*)(ws + (layer == 0 ? WS_WG0 : WS_WG1)), NTOK, DM, DM};
    EpiPleGate E{PT, (const bf16*)(ws + WS_PE + 64 * MiB), p.out, (const float*)(ws + WS_SS) + (layer == 0 ? 1 : 2) * NTOK, (float*)(ws + WS_SS), (bf16*)(ws + WS_Y), p.in[I_NORM_GAIN] + DM, layer};
    pg8::gemm_phase<EpiPleGate, pg8::StaticOrder, true, true>((PG8_LAS unsigned char*)lds, g, S, E); }
}

DI float half_max(float v) { auto rr = __builtin_amdgcn_permlane32_swap(__float_as_uint(v), __float_as_uint(v), false, false); return fmaxf(__uint_as_float(rr[0]), __uint_as_float(rr[1])); }
template <int DVB, bool MASKED = true>
DI void attn_step32(const bf16* Kt, int KP, const bf16* Vt, int VP, const bf16x8 (&qf)[4], f32x16 (&o)[DVB], float& m, float& l, unsigned vmask, float c2, int lane) {
  const int r32 = lane & 31, h = lane >> 5;
  f32x16 s;
#pragma unroll
  for (int i = 0; i < 16; ++i) s[i] = 0.f;
#pragma unroll
  for (int t = 0; t < 4; ++t) { const bf16x8 kf = *(const bf16x8*)(Kt + r32 * KP + t * 16 + h * 8); s = mfma32(kf, qf[t], s); }
  float mx = -INFINITY;
#pragma unroll
  for (int i = 0; i < 16; ++i) { if (MASKED) { s[i] = ((vmask >> i) & 1u) ? s[i] : -INFINITY; } mx = fmaxf(mx, s[i]); }
  mx = half_max(mx);
  const float mxs = mx * c2;
  if (__any(mxs > m + 6.f)) {
    const float mn = fmaxf(m, mxs);
    const float alpha = fexp2(m - mn); l *= alpha;
#pragma unroll
    for (int d = 0; d < DVB; ++d)
#pragma unroll
      for (int i = 0; i < 16; ++i) o[d][i] *= alpha;
    m = mn;
  }
  float ps = 0.f; const float negm = -m;
#pragma unroll
  for (int i = 0; i < 16; ++i) { const float pv = fexp2(__builtin_fmaf(s[i], c2, negm)); s[i] = pv; ps += pv; }
  l += ps;
  bf16x8 pf[2];
  { u32x4 a, b; a.x = cvtpk(s[0], s[1]); a.y = cvtpk(s[2], s[3]); a.z = cvtpk(s[4], s[5]); a.w = cvtpk(s[6], s[7]);
    b.x = cvtpk(s[8], s[9]); b.y = cvtpk(s[10], s[11]); b.z = cvtpk(s[12], s[13]); b.w = cvtpk(s[14], s[15]);
    pf[0] = __builtin_bit_cast(bf16x8, a); pf[1] = __builtin_bit_cast(bf16x8, b); }
  const int i16 = lane & 15, q = i16 >> 2, pp = i16 & 3, blk = (lane >> 4) & 1;
#pragma unroll
  for (int d = 0; d < DVB; ++d)
#pragma unroll
    for (int sk = 0; sk < 2; ++sk) {
      const s16x4 lo = trread(Vt + (16 * sk + 4 * h + q) * VP + 32 * d + 16 * blk + 4 * pp);
      const s16x4 hi = trread(Vt + (16 * sk + 8 + 4 * h + q) * VP + 32 * d + 16 * blk + 4 * pp);
      const bf16x8 vf = __builtin_shufflevector(lo, hi, 0, 1, 2, 3, 4, 5, 6, 7);
      o[d] = mfma32(vf, pf[sk], o[d]);
    }
}

DI unsigned row_range_mask(int lo, int hi) {
  lo = lo < 0 ? 0 : lo; hi = hi > 31 ? 31 : hi;
  if (hi < lo) return 0u;
  const unsigned upto_hi = (hi >= 31) ? 0xffffffffu : ((1u << (hi + 1)) - 1u);
  return upto_hi & ~((1u << lo) - 1u);
}
DI unsigned lane_rows(unsigned m32, int h) {
  const unsigned t = m32 >> (4 * h);
  return (t & 0xFu) | ((t >> 4) & 0xF0u) | ((t >> 8) & 0xF00u) | ((t >> 12) & 0xF000u);
}
constexpr int WP = 72;
constexpr int WAVE_LDS = 2 * 32 * WP * 2 + 512;

struct KVRegs { u32x4 k[4], v[4]; };
DI void kv_store(const KVRegs& R, bf16* Ks, bf16* Vs, int lane) {
#pragma unroll
  for (int i = 0; i < 4; ++i) { const int row = (lane >> 3) + 8 * i, ch = lane & 7; *(u32x4*)(Ks + row * WP + ch * 8) = R.k[i]; *(u32x4*)(Vs + row * WP + ch * 8) = R.v[i]; }
}

DI void band_load(KVRegs& R, const bf16* Kg, const bf16* Vg, int NP, int kstart, int dil, int roff, int lane) {
#pragma unroll
  for (int i = 0; i < 4; ++i) {
    const int row = (lane >> 3) + 8 * i, ch = lane & 7; int k = kstart + row; if (k < 0) k = 0;
    const size_t off = (size_t)(dil * k + roff) * NP + ch * 8;
    R.k[i] = *(const u32x4*)(Kg + off); R.v[i] = *(const u32x4*)(Vg + off);
  }
}
template <int DVB>
DI void band_run(const bf16* Kg, const bf16* Vg, int NP, int kbase, int nsteps, int dil, int roff, int qidx, int win,
                 const bf16x8 (&qf)[4], f32x16 (&o)[DVB], float& m, float& l, float c2, bf16* Ks, bf16* Vs, int lane) {
  const int h = lane >> 5;
  KVRegs R; band_load(R, Kg, Vg, NP, kbase, dil, roff, lane);
  for (int j = 0; j < nsteps; ++j) {
    lds_fence();
    kv_store(R, Ks, Vs, lane);
    lds_fence();
    if (j + 1 < nsteps) band_load(R, Kg, Vg, NP, kbase + 32 * (j + 1), dil, roff, lane);
    const int kb = kbase + 32 * j, lo_r = (qidx - win > 0 ? qidx - win : 0) - kb;
    const unsigned vm = lane_rows(row_range_mask(lo_r, qidx - kb), h);
    attn_step32<DVB>(Ks, WP, Vs, WP, qf, o, m, l, vm, c2, lane);
  }
}

DI void write_o64(const f32x16 (&o)[2], float linv, const bf16* gate_row, bf16* y_row, int h) {
#pragma unroll
  for (int d = 0; d < 2; ++d)
#pragma unroll
    for (int g = 0; g < 4; ++g) {
      const int dd = 32 * d + 8 * g + 4 * h;
      const u32x2 gv = *(const u32x2*)(gate_row + dd);
      const float g0 = __uint_as_float(gv.x << 16), g1 = __uint_as_float(gv.x & 0xffff0000u), g2 = __uint_as_float(gv.y << 16), g3 = __uint_as_float(gv.y & 0xffff0000u);
      u32x2 w; w.x = cvtpk(o[d][4 * g] * linv * g0, o[d][4 * g + 1] * linv * g1); w.y = cvtpk(o[d][4 * g + 2] * linv * g2, o[d][4 * g + 3] * linv * g3);
      *(u32x2*)(y_row + dd) = w;
    }
}

DI void load_q(bf16x8 (&qf)[4], const bf16* qrow, int h) {
#pragma unroll
  for (int t = 0; t < 4; ++t) qf[t] = *(const bf16x8*)(qrow + t * 16 + h * 8);
}
template <int DVB> DI void zero_o(f32x16 (&o)[DVB]) {
#pragma unroll
  for (int d = 0; d < DVB; ++d)
#pragma unroll
    for (int i = 0; i < 16; ++i) o[d][i] = 0.f;
}

DI void mixerB_tile(const Params& p, int item, bf16* Ks, bf16* Vs, int lane) {
  const bf16* PE = (const bf16*)(p.ws + WS_PE); bf16* Y = (bf16*)(p.ws + WS_Y);
  const int qblk = item & 255, head = (item >> 8) & 7, b = item >> 11;
  const int r32 = lane & 31, h = lane >> 5, q0 = qblk * 32, kvh = head >> 2;
  const size_t rowb = (size_t)b * SEQ;
  bf16x8 qf[4]; load_q(qf, PE + (rowb + q0 + r32) * NPE + E_BQ + head * 64, h);
  f32x16 o[2]; zero_o<2>(o);
  const float sink2 = p.in[I_B_SINKS][head] * LOG2E;
  float m = sink2, l = (h == 0) ? 1.f : 0.f;
  band_run<2>(PE + rowb * NPE + E_BK + kvh * 64, PE + rowb * NPE + E_BV + kvh * 64, NPE, q0 - 128, 5, 1, 0, q0 + r32, 127, qf, o, m, l, 0.125f * LOG2E, Ks, Vs, lane);
  l += __shfl_xor(l, 32);
  const size_t tok = rowb + q0 + r32;
  write_o64(o, 1.f / l, PE + tok * NPE + E_BG + head * 64, Y + tok * DM + 512 + head * 64, h);
}

DI void mixerC_tile(const Params& p, int item, bf16* Ks, bf16* Vs, int lane) {
  const bf16* PO = (const bf16*)(p.ws + WS_PE); bf16* Y = (bf16*)(p.ws + WS_Y);
  const int qt = item & 15, r16 = (item >> 4) & 15, head = (item >> 8) & 7, b = item >> 11;
  const int r32 = lane & 31, h = lane >> 5, qi0 = qt * 32;
  const size_t rowb = (size_t)b * SEQ;
  const int t = 16 * (qi0 + r32) + r16;
  bf16x8 qf[4]; load_q(qf, PO + (rowb + t) * NPO + O_CQ + head * 64, h);
  f32x16 o[2]; zero_o<2>(o);
  float m = -1e30f, l = 0.f;
  const bf16* Kg = PO + rowb * NPO + O_CK + head * 64; const bf16* Vg = PO + rowb * NPO + O_CV + head * 64;
  const float c2 = 0.125f * LOG2E;
  band_run<2>(Kg, Vg, NPO, qi0 - 128, 5, 16, r16, qi0 + r32, 128, qf, o, m, l, c2, Ks, Vs, lane);
  band_run<2>(Kg, Vg, NPO, 4 * qi0 + (r16 >> 2) - 128, 8, 4, r16 & 3, 4 * (qi0 + r32) + (r16 >> 2), 128, qf, o, m, l, c2, Ks, Vs, lane);
  band_run<2>(Kg, Vg, NPO, 16 * qi0 + r16 - 128, 20, 1, 0, t, 128, qf, o, m, l, c2, Ks, Vs, lane);
  l += __shfl_xor(l, 32);
  const size_t tok = rowb + t;
  write_o64(o, 1.f / l, PO + tok * NPO + O_CG + head * 64, Y + tok * DM + head * 64, h);
}

DI void mixerA_item(const Params& p, int item, bf16* Ks, bf16* Vs, int lane) {
  const bf16* PE = (const bf16*)(p.ws + WS_PE); bf16* Y = (bf16*)(p.ws + WS_Y);
  const unsigned short* SEL = (const unsigned short*)(p.ws + WS_SEL) + (size_t)item * 256;
  const int t = item & (SEQ - 1), b = item >> 13;
  const int r32 = lane & 31, h = lane >> 5, head = r32 & 7;
  const size_t rowb = (size_t)b * SEQ;
  const int count = (t + 1 < 256) ? t + 1 : 256, nsteps = (count + 31) >> 5;
  bf16x8 qf[4]; load_q(qf, PE + (size_t)item * NPE + E_AQ + head * 64, h);
  f32x16 o[2]; zero_o<2>(o);
  float m = -1e30f, l = 0.f;
  const bf16* Kg = PE + rowb * NPE + E_AK; const bf16* Vg = PE + rowb * NPE + E_AV;
  KVRegs R;
  unsigned short* sel_l = (unsigned short*)(Vs + 32 * WP);
  lds_fence();
  *(u32x2*)(sel_l + 4 * lane) = *(const u32x2*)(SEL + 4 * lane);
  lds_fence();
#define A_LOAD(j) do { _Pragma("unroll") for (int i = 0; i < 4; ++i) { const int row = (lane >> 3) + 8 * i, ch = lane & 7, e = 32 * (j) + row; \
      const int tokk = (e < count) ? (int)sel_l[e] : 0; const size_t off = (size_t)tokk * NPE + ch * 8; R.k[i] = *(const u32x4*)(Kg + off); R.v[i] = *(const u32x4*)(Vg + off); } } while (0)
  A_LOAD(0);
  for (int j = 0; j < nsteps; ++j) {
    lds_fence();
    kv_store(R, Ks, Vs, lane);
    lds_fence();
    if (j + 1 < nsteps) A_LOAD(j + 1);
    const unsigned vm = lane_rows(row_range_mask(0, count - 1 - 32 * j), h);
    attn_step32<2>(Ks, WP, Vs, WP, qf, o, m, l, vm, 0.125f * LOG2E, lane);
  }
#undef A_LOAD
  l += __shfl_xor(l, 32);
  if (r32 < 8) write_o64(o, 1.f / l, PE + (size_t)item * NPE + E_AG + head * 64, Y + (size_t)item * DM + head * 64, h);
}

DI unsigned f2ord(float f) { f += 0.f; const unsigned u = __float_as_uint(f); return (u & 0x80000000u) ? ~u : (u | 0x80000000u); }
DI int block_excl_scan(int v, int* tmp, int* tot) {
  const int lane = threadIdx.x & 63, wid = threadIdx.x >> 6;
  int inc = v;
#pragma unroll
  for (int o = 1; o < 64; o <<= 1) { const int u = __shfl_up(inc, o); if (lane >= o) inc += u; }
  if (lane == 63) tmp[wid] = inc;
  __syncthreads();
  int base = 0, total = 0;
#pragma unroll
  for (int w = 0; w < 8; ++w) { const int x = tmp[w]; if (w < wid) base += x; total += x; }
  *tot = total;
  return base + inc - v;
}

DI float dpp_sum8(float v) {
  v += __builtin_bit_cast(float, __builtin_amdgcn_mov_dpp(__builtin_bit_cast(int, v), 0xB1, 0xF, 0xF, true));
  v += __builtin_bit_cast(float, __builtin_amdgcn_mov_dpp(__builtin_bit_cast(int, v), 0x4E, 0xF, 0xF, true));
  v += __builtin_bit_cast(float, __builtin_amdgcn_mov_dpp(__builtin_bit_cast(int, v), 0x141, 0xF, 0xF, true));
  return v;
}
DI void hist_find(const int* hist, int* misc, int need, int& digit, int& nneed, int& cnt) {
  const int tid = threadIdx.x;
  typedef int i32x4 __attribute__((ext_vector_type(4)));
  const i32x4 h0 = *(const i32x4*)(hist + tid * 8), h1 = *(const i32x4*)(hist + tid * 8 + 4);
  int hh[8] = {h0.x, h0.y, h0.z, h0.w, h1.x, h1.y, h1.z, h1.w}; int tot = 0;
#pragma unroll
  for (int k = 0; k < 8; ++k) tot += hh[k];
  int total; const int ex = block_excl_scan(tot, misc, &total);
  int above = total - ex - tot;
#pragma unroll
  for (int k = 7; k >= 0; --k) { const int c = hh[k]; if (above < need && above + c >= need) { misc[16] = tid * 8 + k; misc[17] = need - above; misc[18] = c; } above += c; }
  __syncthreads();
  digit = misc[16]; nneed = misc[17]; cnt = misc[18];
  __syncthreads();
}
DI unsigned long long mkcmp(float v, int idx) { return ((unsigned long long)f2ord(v) << 16) | ((unsigned long long)(8191 - idx) << 3); }
DI float ord2f(unsigned k) { return __uint_as_float((k & 0x80000000u) ? (k ^ 0x80000000u) : ~k); }
DI float half_sum(float v) { auto rr = __builtin_amdgcn_permlane32_swap(__float_as_uint(v), __float_as_uint(v), false, false); return __uint_as_float(rr[0]) + __uint_as_float(rr[1]); }

constexpr int CL_CAP = 512;
DI void select_slow(const float* scq, int n, unsigned short* out, float lo, float hi, int* hist, int* misc, unsigned long long* clist) {
  const int tid = opaque_tid();
    const float scale = (hi > lo) ? 4095.f / (hi - lo) : 0.f;
    for (int i = tid; i < 4096; i += 512) hist[i] = 0;
    if (tid == 0) misc[20] = 0;
    __syncthreads();
    float val[16]; int bin[16];
#pragma unroll
    for (int i = 0; i < 16; ++i) { const int idx = tid + 512 * i; const float v = (idx < n) ? scq[idx] : lo; val[i] = v;
      int bb = (int)((v - lo) * scale); bb = bb < 0 ? 0 : (bb > 4095 ? 4095 : bb); bin[i] = bb; if (idx < n) atomicAdd(&hist[bb], 1); }
    __syncthreads();
    int bstar, need, cnt;
    hist_find(hist, misc, 256, bstar, need, cnt);
    unsigned long long T = 0ull;
    if (cnt != need) {
      if (cnt <= CL_CAP) {
#pragma unroll
        for (int i = 0; i < 16; ++i) { const int idx = tid + 512 * i; if (idx < n && bin[i] == bstar) { const int slot = atomicAdd(&misc[20], 1); clist[slot] = mkcmp(val[i], idx); } }
        __syncthreads();
        if (tid < cnt) { const unsigned long long c = clist[tid]; int rank = 0; for (int jx = 0; jx < cnt; ++jx) rank += (clist[jx] > c) ? 1 : 0;
          if (rank == need - 1) { misc[21] = (int)(unsigned)(c & 0xffffffffull); misc[22] = (int)(unsigned)(c >> 32); } }
        __syncthreads();
        T = ((unsigned long long)(unsigned)misc[22] << 32) | (unsigned long long)(unsigned)misc[21];
      } else {
        unsigned long long prefix = 0ull; int shift = 36;
        for (int pass = 0; pass < 4; ++pass) {
          for (int i = tid; i < 4096; i += 512) hist[i] = 0;
          __syncthreads();
#pragma unroll
          for (int i = 0; i < 16; ++i) { const int idx = tid + 512 * i; if (idx < n && bin[i] == bstar) { const unsigned long long c = mkcmp(val[i], idx); if (pass == 0 || (c >> (shift + 12)) == prefix) atomicAdd(&hist[(int)((c >> shift) & 4095ull)], 1); } }
          __syncthreads();
          int digit, nneed, c2;
          hist_find(hist, misc, need, digit, nneed, c2);
          prefix = (prefix << 12) | (unsigned long long)digit; need = nneed;
          if (c2 == need) break;
          shift -= 12;
        }
        T = prefix << shift;
      }
    }
    int mycnt = 0; unsigned selm = 0;
#pragma unroll
    for (int i = 0; i < 16; ++i) { const int idx = tid + 512 * i;
      bool sel = false;
      if (idx < n) { if (bin[i] > bstar) sel = true; else if (bin[i] == bstar) sel = (mkcmp(val[i], idx) >= T); }
      if (sel) { ++mycnt; selm |= (1u << i); } }
    int total; int pos = block_excl_scan(mycnt, misc + 8, &total);
#pragma unroll
    for (int i = 0; i < 16; ++i) { if ((selm >> i) & 1u) { if (pos < 256) out[pos] = (unsigned short)(tid + 512 * i); ++pos; } }
    __syncthreads();
}

DI void sel_load_qw(const Params& p, int item, bf16x8 (&qf)[4], float (&wq)[16], int lane) {
  const bf16* PE = (const bf16*)(p.ws + WS_PE); const float* IW = (const float*)(p.ws + WS_IW);
  const int r32 = lane & 31, h = lane >> 5, b = item >> 11, t0 = (item & 2047) * 4; const size_t rowb = (size_t)b * SEQ;
  load_q(qf, PE + (rowb + t0 + (r32 >> 3)) * NPE + E_IQ + (r32 & 7) * 64, h);
#pragma unroll
  for (int q = 0; q < 4; ++q) { const f32x4 w4 = *(const f32x4*)(IW + (rowb + t0 + q) * 8 + 4 * h);
    wq[4 * q] = w4.x * 0.04419417382415922f; wq[4 * q + 1] = w4.y * 0.04419417382415922f; wq[4 * q + 2] = w4.z * 0.04419417382415922f; wq[4 * q + 3] = w4.w * 0.04419417382415922f; }
}
DI void selectA_item(const Params& p, int item, int next_item, char* lds, bf16x8 (&qf)[4], float (&wq)[16]) {
  const bf16* PE = (const bf16*)(p.ws + WS_PE);
  const float* IW = (const float*)(p.ws + WS_IW);
  unsigned short* SEL = (unsigned short*)(p.ws + WS_SEL);
  float* sc = (float*)lds;
  int* hist = (int*)(lds + 4 * 8192 * 4);
  int* misc = hist + 4096;
  unsigned* mm = (unsigned*)(misc + 24);
  unsigned long long* clist = (unsigned long long*)(misc + 96);
  const int tid = opaque_tid(), lane = tid & 63, wid = tid >> 6, r32 = lane & 31, h = lane >> 5;
  const int b = item >> 11, t0 = (item & 2047) * 4;
  const size_t rowb = (size_t)b * SEQ;
  const int nk = t0 + 4, ntile = (nk + 31) >> 5;
  if (tid < 4) { mm[tid * 2] = 0xFFFFFFFFu; mm[tid * 2 + 1] = 0u; }
  lds_barrier();
  const bf16* Kt = (const bf16*)(p.ws + WS_IKS) + (size_t)b * 256 * 2048 + lane * 8;
  {
    bf16x8 kf[4], kn[4];
#pragma unroll
    for (int t = 0; t < 4; ++t) { kf[t] = (bf16x8){0, 0, 0, 0, 0, 0, 0, 0}; kn[t] = kf[t]; }
    if (wid < ntile) {
#pragma unroll
      for (int t = 0; t < 4; ++t) kf[t] = *(const bf16x8*)(Kt + (size_t)wid * 2048 + t * 512);
    }
    float lo0 = INFINITY, hi0 = -INFINITY, lo1 = INFINITY, hi1 = -INFINITY;
    for (int kt = wid; kt < ntile; kt += 8) {
      if (kt + 8 < ntile) {
#pragma unroll
        for (int t = 0; t < 4; ++t) kn[t] = *(const bf16x8*)(Kt + (size_t)(kt + 8) * 2048 + t * 512);
      }
      f32x16 s;
#pragma unroll
      for (int i = 0; i < 16; ++i) s[i] = 0.f;
#pragma unroll
      for (int t = 0; t < 4; ++t) s = mfma32(qf[t], kf[t], s);
      float v[4];
#pragma unroll
      for (int q = 0; q < 4; ++q) {
        float a = wq[4 * q] * fmaxf(s[4 * q], 0.f);
#pragma unroll
        for (int jj = 1; jj < 4; ++jj) a += wq[4 * q + jj] * fmaxf(s[4 * q + jj], 0.f);
        v[q] = half_sum(a) + 0.f;
      }
      const float va = h ? v[2] : v[0], vb = h ? v[3] : v[1];
      const int key = kt * 32 + r32;
      sc[(2 * h) * 8192 + key] = va; sc[(2 * h + 1) * 8192 + key] = vb;
      lo0 = fminf(lo0, va); hi0 = fmaxf(hi0, va); lo1 = fminf(lo1, vb); hi1 = fmaxf(hi1, vb);
#pragma unroll
      for (int t = 0; t < 4; ++t) kf[t] = kn[t];
    }
    if (wid < ntile) {
#pragma unroll
      for (int o = 1; o < 32; o <<= 1) { lo0 = fminf(lo0, __shfl_xor(lo0, o)); hi0 = fmaxf(hi0, __shfl_xor(hi0, o)); lo1 = fminf(lo1, __shfl_xor(lo1, o)); hi1 = fmaxf(hi1, __shfl_xor(hi1, o)); }
      if (r32 == 0) { atomicMin(&mm[(2 * h) * 2], f2ord(lo0)); atomicMax(&mm[(2 * h) * 2 + 1], f2ord(hi0)); atomicMin(&mm[(2 * h + 1) * 2], f2ord(lo1)); atomicMax(&mm[(2 * h + 1) * 2 + 1], f2ord(hi1)); }
    }
  }
  if (next_item >= 0) sel_load_qw(p, next_item, qf, wq, lane);
  lds_barrier();
  {
    const int g = wid >> 1, gt = tid & 127, upper = wid & 1;
    const int t = t0 + g, n = t + 1;
    const bool big = n > 256;
    const float* scq = sc + g * 8192;
    unsigned short* out = SEL + (rowb + t) * 256;
    int* histq = hist + g * 1024;
    unsigned long long* clq = clist + g * 128;
    int* mq = misc + 32 + g * 8;
    const float lo = ord2f(mm[g * 2]), hi = ord2f(mm[g * 2 + 1]);
    const float scale = (hi > lo) ? 1023.f / (hi - lo) : 0.f;
    for (int i = gt; i < 1024; i += 128) histq[i] = 0;
    if (gt == 0) { mq[0] = 0; mq[6] = 0; }
    lds_barrier();
    float uu[64];
#pragma unroll
    for (int i = 0; i < 64; ++i) { const int idx = gt + 128 * i; const float v = (idx < n) ? scq[idx] : lo; const float u = (v - lo) * scale; uu[i] = u;
      if (big && idx < n) { int bb = (int)u; bb = bb > 1023 ? 1023 : bb; atomicAdd(&histq[bb], 1); } }
    lds_barrier();
    typedef int i32x4 __attribute__((ext_vector_type(4)));
    const i32x4 h0 = *(const i32x4*)(histq + gt * 8), h1 = *(const i32x4*)(histq + gt * 8 + 4);
    const int hh[8] = {h0.x, h0.y, h0.z, h0.w, h1.x, h1.y, h1.z, h1.w};
    int tot = 0;
#pragma unroll
    for (int k = 0; k < 8; ++k) tot += hh[k];
    int inc = tot;
#pragma unroll
    for (int o = 1; o < 64; o <<= 1) { const int ux = __shfl_down(inc, o); if (lane + o < 64) inc += ux; }
    if (lane == 0) misc[wid] = inc;
    lds_barrier();
    {
      int above = inc - tot + (upper ? 0 : misc[wid + 1]);
      if (big) {
#pragma unroll
        for (int k = 7; k >= 0; --k) { const int c = hh[k]; if (above < 256 && above + c >= 256) { mq[1] = gt * 8 + k; mq[2] = 256 - above; mq[3] = c; } above += c; }
      }
    }
    lds_barrier();
    const int bstar = mq[1], need = mq[2], cnt = mq[3];
    const float flo = (float)bstar, fhi = (bstar >= 1023) ? INFINITY : (float)(bstar + 1);
    const bool tie = big && cnt != need;
    if (tie) {
      if (cnt <= 128) {
#pragma unroll
        for (int i = 0; i < 64; ++i) { const int idx = gt + 128 * i; if (idx < n && uu[i] >= flo && uu[i] < fhi) { const int slot = atomicAdd(&mq[0], 1); clq[slot] = mkcmp(scq[idx], idx); } }
      } else if (gt == 0) mq[6] = 1;
    }
    lds_barrier();
    if (tie && cnt <= 128 && gt < cnt) { const unsigned long long c = clq[gt]; int rank = 0; for (int jx = 0; jx < cnt; ++jx) rank += (clq[jx] > c) ? 1 : 0;
      if (rank == need - 1) { mq[4] = (int)(unsigned)(c & 0xffffffffull); mq[5] = (int)(unsigned)(c >> 32); } }
    lds_barrier();
    const unsigned long long T = tie ? (((unsigned long long)(unsigned)mq[5] << 32) | (unsigned long long)(unsigned)mq[4]) : 0ull;
    const bool fast = big && !(tie && cnt > 128);
    unsigned long long selm = 0ull;
    if (fast) {
#pragma unroll
      for (int i = 0; i < 64; ++i) { const int idx = gt + 128 * i;
        if (idx < n) { const float u = uu[i]; bool sel = u >= fhi; if (!sel && u >= flo) sel = !tie || (mkcmp(scq[idx], idx) >= T); if (sel) selm |= (1ull << i); } }
    }
    const int mycnt = __popcll(selm);
    int pinc = mycnt;
#pragma unroll
    for (int o = 1; o < 64; o <<= 1) { const int ux = __shfl_up(pinc, o); if (lane >= o) pinc += ux; }
    if (lane == 63) misc[8 + wid] = pinc;
    lds_barrier();
    if (fast) {
      int pos = pinc - mycnt + (upper ? misc[8 + wid - 1] : 0);
      while (selm) { const int i = __ffsll((long long)selm) - 1; selm &= selm - 1ull; if (pos < 256) out[pos] = (unsigned short)(gt + 128 * i); ++pos; }
    } else if (!big) {
      for (int i = gt; i < n; i += 128) out[i] = (unsigned short)i;
    }
    lds_barrier();
  }
  for (int q = 0; q < 4; ++q) {
    if (misc[32 + q * 8 + 6]) { const int t = t0 + q; select_slow(sc + q * 8192, t + 1, SEL + (rowb + t) * 256, ord2f(mm[q * 2]), ord2f(mm[q * 2 + 1]), hist, misc, clist); }
  }
  lds_barrier();
}

constexpr int DKP = 72, DVP = 136;
constexpr int D_STAGE = (64 * DKP * 2 + 64 * DVP) * 2;
DI void mixerD_unit(const Params& p, int b, int head, int qb, char* lds) {
  const bf16* PO = (const bf16*)(p.ws + WS_PE); bf16* Y = (bf16*)(p.ws + WS_Y);
  const int tid = opaque_tid(), lane = tid & 63, wid = tid >> 6, r32 = lane & 31, h = lane >> 5;
  const int map = wid & 1, qsub = wid >> 1;
  const size_t rowb = (size_t)b * SEQ;
  const int qpos = 128 * qb + 32 * qsub + r32;
  bf16x8 qf[4]; load_q(qf, PO + (rowb + qpos) * NPO + O_DQ + (2 * head + map) * 64, h);
  f32x16 o[4]; zero_o<4>(o);
  float m = -1e30f, l = 0.f;
  const int nsteps = 2 * qb + 2;
  const bf16* K1g = PO + rowb * NPO + O_DK + (2 * head) * 64;
  const bf16* K2g = K1g + 64;
  const bf16* Vg = PO + rowb * NPO + O_DV + head * 128;
  u32x4 rk1, rk2, rv[2];
#define D_LOAD(j) do { const int row = tid >> 3, ch = tid & 7; const size_t off = (size_t)((j) * 64 + row) * NPO + ch * 8; rk1 = *(const u32x4*)(K1g + off); rk2 = *(const u32x4*)(K2g + off); \
    _Pragma("unroll") for (int i = 0; i < 2; ++i) { const int c = tid + 512 * i, vr = c >> 4, vc = c & 15; rv[i] = *(const u32x4*)(Vg + (size_t)((j) * 64 + vr) * NPO + vc * 8); } } while (0)
  __syncthreads();
  D_LOAD(0);
  for (int j = 0; j < nsteps; ++j) {
    char* st = lds + (j & 1) * D_STAGE;
    bf16* K1s = (bf16*)st; bf16* K2s = K1s + 64 * DKP; bf16* Vs = K2s + 64 * DKP;
    { const int row = tid >> 3, ch = tid & 7; *(u32x4*)(K1s + row * DKP + ch * 8) = rk1; *(u32x4*)(K2s + row * DKP + ch * 8) = rk2;
#pragma unroll
      for (int i = 0; i < 2; ++i) { const int c = tid + 512 * i, vr = c >> 4, vc = c & 15; *(u32x4*)(Vs + vr * DVP + vc * 8) = rv[i]; } }
    __syncthreads();
    if (j + 1 < nsteps) D_LOAD(j + 1);
    const bf16* Ks = map ? K2s : K1s;
#pragma unroll
    for (int sub = 0; sub < 2; ++sub) {
      const int k0 = j * 64 + sub * 32;
      if (k0 <= 128 * qb + 32 * qsub + 31) {
        if (k0 + 31 <= 128 * qb + 32 * qsub) {
          attn_step32<4, false>(Ks + sub * 32 * DKP, DKP, Vs + sub * 32 * DVP, DVP, qf, o, m, l, 0xffffu, 0.125f * LOG2E, lane);
        } else {
          unsigned vm = 0;
#pragma unroll
          for (int i = 0; i < 16; ++i) if (k0 + crow(i, h) <= qpos) vm |= (1u << i);
          attn_step32<4, true>(Ks + sub * 32 * DKP, DKP, Vs + sub * 32 * DVP, DVP, qf, o, m, l, vm, 0.125f * LOG2E, lane);
        }
      }
    }
  }
#undef D_LOAD
  l += __shfl_xor(l, 32);
  const float linv = 1.f / l;
  __syncthreads();
  float* xch = (float*)lds + qsub * 4096;
  if (map == 1) {
#pragma unroll
    for (int d = 0; d < 4; ++d)
#pragma unroll
      for (int i = 0; i < 16; ++i) xch[(d * 16 + i) * 64 + lane] = o[d][i] * linv;
  }
  __syncthreads();
  if (map == 0) {
    const float lam = *(const float*)(p.ws + WS_LAM);
    float ssq = 0.f;
#pragma unroll
    for (int d = 0; d < 4; ++d)
#pragma unroll
      for (int i = 0; i < 16; ++i) { const float a = o[d][i] * linv - lam * xch[(d * 16 + i) * 64 + lane]; o[d][i] = a; ssq += a * a; }
    ssq += __shfl_xor(ssq, 32);
    const float lambda_init = 0.8f - 0.6f * expf(-0.3f);
    const float rn = rsqrtf(ssq * (1.f / 128.f) + EPS) * (1.f - lambda_init);
    const size_t tok = rowb + qpos;
    const bf16* gate = PO + tok * NPO + O_DG + head * 128;
    bf16* y = Y + tok * DM + 512 + head * 128;
    const float* sg = p.in[I_SUB_GAIN];
#pragma unroll
    for (int d = 0; d < 4; ++d)
#pragma unroll
      for (int g = 0; g < 4; ++g) {
        const int dd = 32 * d + 8 * g + 4 * h;
        const u32x2 gv = *(const u32x2*)(gate + dd); const f32x4 s4 = *(const f32x4*)(sg + dd);
        const float g0 = __uint_as_float(gv.x << 16), g1 = __uint_as_float(gv.x & 0xffff0000u), g2 = __uint_as_float(gv.y << 16), g3 = __uint_as_float(gv.y & 0xffff0000u);
        u32x2 w; w.x = cvtpk(o[d][4 * g] * rn * s4.x * g0, o[d][4 * g + 1] * rn * s4.y * g1); w.y = cvtpk(o[d][4 * g + 2] * rn * s4.z * g2, o[d][4 * g + 3] * rn * s4.w * g3);
        *(u32x2*)(y + dd) = w;
      }
  }
  __syncthreads();
}

#define XB_TMO      128
#define XB_XCNT(j)  (256  + 64 * (j))
#define XB_XSUB(j)  (1280 + 64 * (j))
#define XB_XGEN(j)  (2304 + 64 * (j))
#define XB_TOP      3328
#define XB_TOPGEN   3392
#define XCD_BAR_WORDS 3456
#define XB_SPIN_CAP (1u << 18)

__device__ __forceinline__ unsigned xb_ld(unsigned* p)              { return __hip_atomic_load(p, __ATOMIC_RELAXED, __HIP_MEMORY_SCOPE_AGENT); }
__device__ __forceinline__ unsigned xb_add(unsigned* p, unsigned v) { return __hip_atomic_fetch_add(p, v, __ATOMIC_RELAXED, __HIP_MEMORY_SCOPE_AGENT); }
__device__ __forceinline__ unsigned xb_xcc_id() { return (unsigned)__builtin_amdgcn_s_getreg((3 << 11) | 20) & 0xFu; }
#define XB_SPIN(cond, bar) do { unsigned _sp = 0; while (cond) { __builtin_amdgcn_s_sleep(1); \
    if ((++_sp & 255u) == 0u) { if (xb_ld(&(bar)[XB_TMO])) break; if (_sp > XB_SPIN_CAP) { atomicAdd(&(bar)[XB_TMO], 1u); break; } } } } while (0)

struct XcdBarrier {
    unsigned* bar; unsigned x;
    volatile LAS unsigned* st;
};

__device__ __forceinline__ XcdBarrier xcd_barrier_post(unsigned* bar, volatile LAS unsigned* st) {
    XcdBarrier b; b.bar = bar; b.x = xb_xcc_id(); b.st = st;
    if (threadIdx.x == 0) (void)xb_add(&bar[XB_XCNT(b.x)], 1u);
    return b;
}
__device__ __forceinline__ void xcd_barrier_complete(unsigned* bar, unsigned x, unsigned& nloc, unsigned& nx) {
    const unsigned G = gridDim.x * gridDim.y * gridDim.z;
    unsigned sum, cnt, mine, sp = 0u;
    for (;;) {
        sum = 0u; cnt = 0u; mine = 0u;
#pragma unroll
        for (unsigned j = 0; j < 16; ++j) { const unsigned c = xb_ld(&bar[XB_XCNT(j)]); sum += c; cnt += (c > 0u) ? 1u : 0u; mine = (j == x) ? c : mine; }
        if (sum == G) break;
        __builtin_amdgcn_s_sleep(1);
        if ((++sp & 255u) == 0u) { if (xb_ld(&bar[XB_TMO])) break; if (sp > XB_SPIN_CAP) { atomicAdd(&bar[XB_TMO], 1u); break; } }
    }
    nloc = mine > 0u ? mine : 1u; nx = cnt > 0u ? cnt : 1u;
}

__device__ __forceinline__ void xcd_barrier(const XcdBarrier& b) {
    asm volatile("s_waitcnt vmcnt(0)" ::: "memory");
    __syncthreads();
    if (threadIdx.x == 0) {
        unsigned* bar = b.bar;
        __builtin_amdgcn_s_waitcnt(0);
        unsigned nloc = b.st[0], nx = b.st[1];
        if (nloc == 0u) { xcd_barrier_complete(bar, b.x, nloc, nx); b.st[0] = nloc; b.st[1] = nx; }
        const unsigned old = xb_add(&bar[XB_XSUB(b.x)], 1u);
        const unsigned gen = old / nloc;
        if (old + 1u == (gen + 1u) * nloc) {
            __builtin_amdgcn_fence(__ATOMIC_RELEASE, "agent");
            asm volatile("s_waitcnt vmcnt(0)" ::: "memory");
            const unsigned og = xb_add(&bar[XB_TOP], 1u);
            const unsigned tg = og / nx;
            if (og + 1u == (tg + 1u) * nx) xb_add(&bar[XB_TOPGEN], 1u);
            else XB_SPIN(xb_ld(&bar[XB_TOPGEN]) == tg, bar);
            __builtin_amdgcn_fence(__ATOMIC_ACQUIRE, "agent");
            xb_add(&bar[XB_XGEN(b.x)], 1u);
            asm volatile("s_waitcnt vmcnt(0)" ::: "memory");
        } else {
            XB_SPIN(xb_ld(&bar[XB_XGEN(b.x)]) == gen, bar);
            __builtin_amdgcn_fence(__ATOMIC_ACQUIRE, "agent");
            asm volatile("s_waitcnt vmcnt(0)" ::: "memory");
        }
    }
    __syncthreads();
}


__global__ void __launch_bounds__(NTHREADS) fwd_kernel(Params p) {
  extern __shared__ __attribute__((aligned(16))) char smem[];
  cg::grid_group grid = cg::this_grid();
  char* lds = smem;
  volatile LAS unsigned* xb_st = (volatile LAS unsigned*)((LAS char*)smem + (LDS_BYTES - 16));
  if (threadIdx.x < 2) xb_st[threadIdx.x] = 0u;
  __syncthreads();
  const XcdBarrier xbar = xcd_barrier_post((unsigned*)(p.ws + WS_BAR), xb_st);
#define FRESH_IDS const int tid = opaque_tid(), lane = tid & 63, wid = tid >> 6; const int gw = blockIdx.x * 8 + wid, ngw = gridDim.x * 8; bf16* Ks = (bf16*)(lds + wid * WAVE_LDS); bf16* Vs = Ks + 32 * WP; (void)gw; (void)ngw; (void)Ks; (void)Vs; (void)lane;

  phase_prologue(p, lds);
  if (p.ws == nullptr) grid.sync();
  xcd_barrier(xbar);
  for (int rep = 0; rep < REP_GEMM; ++rep) phase_inproj(p, 0, lds);
  xcd_barrier(xbar);
#if EN_A
  for (int rep = 0; rep < REP_SELA; ++rep) { FRESH_IDS
#define SEL_ITEM(k) ((k) * (int)gridDim.x + (((k) & 1) ? (int)gridDim.x - 1 - (int)blockIdx.x : (int)blockIdx.x))
    bf16x8 sqf[4]; float swq[16];
    if (SEL_ITEM(0) < 2 * 2048) sel_load_qw(p, SEL_ITEM(0), sqf, swq, lane);
    for (int k = 0; k * (int)gridDim.x < 2 * 2048; ++k) { const int it = SEL_ITEM(k); int nx = SEL_ITEM(k + 1); if (nx >= 2 * 2048) nx = -1; if (it < 2 * 2048) selectA_item(p, it, nx, lds, sqf, swq); }
#undef SEL_ITEM
  }
  xcd_barrier(xbar);
  { FRESH_IDS for (int rep = 0; rep < REP_AATT; ++rep) for (int it = gw; it < NTOK; it += ngw) mixerA_item(p, it, Ks, Vs, lane); }
#else
  { unsigned* y = (unsigned*)(p.ws + WS_Y); for (int i = blockIdx.x * NTHREADS + (int)threadIdx.x; i < NTOK * 256; i += gridDim.x * NTHREADS) { const int row = i >> 8, c = i & 255; y[row * 512 + c] = 0u; } }
#endif
#if EN_B
  { FRESH_IDS for (int it = gw; it < 4096; it += ngw) mixerB_tile(p, it, Ks, Vs, lane); }
#else
  { unsigned* y = (unsigned*)(p.ws + WS_Y); for (int i = blockIdx.x * NTHREADS + (int)threadIdx.x; i < NTOK * 256; i += gridDim.x * NTHREADS) { const int row = i >> 8, c = i & 255; y[row * 512 + 256 + c] = 0u; } }
#endif
  xcd_barrier(xbar);
  phase_outproj(p, 0, lds);
  xcd_barrier(xbar);
  phase_ple(p, 0, lds);
  xcd_barrier(xbar);
  phase_inproj(p, 1, lds);
  xcd_barrier(xbar);
#if EN_D
  for (int rep = 0; rep < REP_D; ++rep) {
#pragma unroll 1
    for (int u2 = blockIdx.x * 2; u2 < 512; u2 += gridDim.x * 2) {
#pragma unroll 1
      for (int k = 0; k < 2; ++k) { const int u = u2 >> 1, bh = u >> 5, pr = u & 31; mixerD_unit(p, bh >> 2, bh & 3, k ? 63 - pr : pr, lds); }
    }
  }
#else
  { unsigned* y = (unsigned*)(p.ws + WS_Y); for (int i = blockIdx.x * NTHREADS + (int)threadIdx.x; i < NTOK * 256; i += gridDim.x * NTHREADS) { const int row = i >> 8, c = i & 255; y[row * 512 + 256 + c] = 0u; } }
#endif
#if EN_C
  __syncthreads();
  { FRESH_IDS for (int rep = 0; rep < REP_C; ++rep) for (int it = gw; it < 4096; it += ngw) mixerC_tile(p, it, Ks, Vs, lane); }
#else
  { unsigned* y = (unsigned*)(p.ws + WS_Y); for (int i = blockIdx.x * NTHREADS + (int)threadIdx.x; i < NTOK * 256; i += gridDim.x * NTHREADS) { const int row = i >> 8, c = i & 255; y[row * 512 + c] = 0u; } }
#endif
  xcd_barrier(xbar);
  phase_outproj(p, 1, lds);
  xcd_barrier(xbar);
  phase_ple(p, 1, lds);
}

extern "C" void kernel_launch(void* const* d_in, const int* in_sizes, int n_in, void* d_out, int out_size, void* d_ws, size_t ws_size, hipStream_t stream) {
  static int grid_blocks = 0;
  if (!grid_blocks) {
    int dev = 0, cus = 0, per_cu = 0;
    hipGetDevice(&dev);
    hipDeviceGetAttribute(&cus, hipDeviceAttributeMultiprocessorCount, dev);
    hipFuncSetAttribute((const void*)fwd_kernel, hipFuncAttributeMaxDynamicSharedMemorySize, LDS_BYTES);
    hipOccupancyMaxActiveBlocksPerMultiprocessor(&per_cu, (const void*)fwd_kernel, NTHREADS, LDS_BYTES);
    if (per_cu < 1) per_cu = 1;
    grid_blocks = cus * per_cu;
    if (grid_blocks > 256) grid_blocks = 256;
  }
  Params p{};
  for (int i = 0; i < 25; ++i) p.in[i] = (const float*)d_in[i];
  p.out = (float*)d_out; p.ws = (unsigned char*)d_ws;
  for (int i = 0; i < 32; ++i) p.inv_freq[i] = (float)pow(10000.0, -(double)i / 32.0);
  (void)hipMemsetAsync((char*)d_ws + WS_BAR, 0, 16384, stream);
  void* args[] = {&p};
  hipError_t e = hipLaunchCooperativeKernel((const void*)fwd_kernel, dim3(grid_blocks), dim3(NTHREADS), args, LDS_BYTES, stream);
  if (e != hipSuccess) fprintf(stderr, "cooperative launch failed: %s (grid %d)\n", hipGetErrorString(e), grid_blocks);
}
```

```cpp
#include <hip/hip_runtime.h>
#include <hip/hip_cooperative_groups.h>
#include <cstdio>
#include <cmath>
namespace cg = cooperative_groups;

#ifndef REP_GEMM
#define REP_GEMM 1
#endif
#ifndef REP_SELA
#define REP_SELA 1
#endif
#ifndef REP_D
#define REP_D 1
#endif
#ifndef REP_C
#define REP_C 1
#endif
#ifndef REP_AATT
#define REP_AATT 1
#endif
#ifndef EN_A
#define EN_A 1
#endif
#ifndef EN_B
#define EN_B 1
#endif
#ifndef EN_C
#define EN_C 1
#endif
#ifndef EN_D
#define EN_D 1
#endif

typedef unsigned short bf16;
typedef short bf16x8 __attribute__((ext_vector_type(8)));
typedef short s16x4 __attribute__((ext_vector_type(4)));
typedef float f32x4 __attribute__((ext_vector_type(4)));
typedef float f32x16 __attribute__((ext_vector_type(16)));
typedef unsigned u32x4 __attribute__((ext_vector_type(4)));
typedef unsigned u32x2 __attribute__((ext_vector_type(2)));
typedef float f32x2_t __attribute__((ext_vector_type(2)));
typedef __bf16 bf16x2_t __attribute__((ext_vector_type(2)));
#define LAS __attribute__((address_space(3)))
#define DI __device__ __forceinline__

constexpr int SEQ = 8192, NTOK = 16384, DM = 1024;
constexpr int NPE = 3072, NPO = 4096;
constexpr float EPS = 1e-6f;
constexpr float LOG2E = 1.4426950408889634f;
constexpr int NTHREADS = 512;
constexpr int LDS_BYTES = 150 * 1024;

constexpr size_t MiB = 1u << 20;
constexpr size_t WS_PE = 0;
constexpr size_t WS_ACT = 128 * MiB;
constexpr size_t WS_Y = 160 * MiB;
constexpr size_t WS_WINE = 192 * MiB;
constexpr size_t WS_WOUTE = 198 * MiB;
constexpr size_t WS_WINO = 200 * MiB;
constexpr size_t WS_WOUTO = 208 * MiB;
constexpr size_t WS_WG0 = 210 * MiB;
constexpr size_t WS_WG1 = 212 * MiB;
constexpr size_t WS_WP0 = 214 * MiB;
constexpr size_t WS_WP1 = 215 * MiB;
constexpr size_t WS_ROPE = 216 * MiB;
constexpr size_t WS_SEL = 218 * MiB;
constexpr size_t WS_IW = 226 * MiB;
constexpr size_t WS_SS = 227 * MiB;
constexpr size_t WS_LAM = 228 * MiB;
constexpr size_t WS_BAR = 250 * MiB;
constexpr size_t WS_PBF = 232 * MiB;
constexpr size_t WS_IKS = 229 * MiB;

struct Params {
  const float* in[25];
  float* out;
  unsigned char* ws;
  float inv_freq[32];
};
enum { I_X = 0, I_P, I_NORM_GAIN, I_W_IN_EVEN, I_W_OUT_EVEN, I_A_Q_GAIN, I_A_K_GAIN, I_IDX_K_GAIN, I_B_Q_GAIN, I_B_K_GAIN, I_B_SINKS,
       I_W_IN_ODD, I_W_OUT_ODD, I_C_Q_GAIN, I_C_K_GAIN, I_D_Q_GAIN, I_D_K_GAIN, I_LQ1, I_LK1, I_LQ2, I_LK2, I_SUB_GAIN, I_PLE_NORM_GAIN,
       I_W_PLE_GATE, I_W_PLE_PROJ };

DI unsigned cvtpk(float lo, float hi) { f32x2_t v = {lo, hi}; bf16x2_t b = __builtin_convertvector(v, bf16x2_t); return __builtin_bit_cast(unsigned, b); }
DI float bf2f(bf16 b) { return __uint_as_float(((unsigned)b) << 16); }
DI float fexp2(float x) { return __builtin_amdgcn_exp2f(x); }
DI f32x16 mfma32(bf16x8 a, bf16x8 b, f32x16 c) { return __builtin_amdgcn_mfma_f32_32x32x16_bf16(a, b, c, 0, 0, 0); }
DI f32x4 mfma16(bf16x8 a, bf16x8 b, f32x4 c) { return __builtin_amdgcn_mfma_f32_16x16x32_bf16(a, b, c, 0, 0, 0); }
DI int crow(int i, int h) { return (i & 3) + 8 * (i >> 2) + 4 * h; }
DI s16x4 trread(const bf16* p) { return __builtin_bit_cast(s16x4, __builtin_amdgcn_ds_read_tr16_b64_v4i16((LAS s16x4*)p)); }
DI int opaque_tid() { int t = threadIdx.x; asm volatile("" : "+v"(t)); return t; }
DI void lds_barrier() { asm volatile("s_waitcnt lgkmcnt(0)" ::: "memory"); __builtin_amdgcn_s_barrier(); asm volatile("" ::: "memory"); }
DI void lds_fence() { asm volatile("s_waitcnt lgkmcnt(0)" ::: "memory"); __builtin_amdgcn_wave_barrier(); }

__host__ __device__ __forceinline__ int phys_col(int n) { return (n & ~255) + 128 * ((n >> 5) & 1) + 32 * ((n >> 6) & 3) + (n & 31); }
DI int map_even(int n) { return n < 1216 ? n : (n < 1224 ? 3008 + (n - 1216) : n - 8); }
DI void transpose_tile(const float* W, int K, int N, bf16* WT, int mapmode, int tile, float* scr) {
  const int tid = opaque_tid();
  const int ntn = (N + 63) >> 6, kt = tile / ntn, nt = tile % ntn, k0 = kt * 64, n0 = nt * 64;
#pragma unroll
  for (int i = 0; i < 8; ++i) {
    const int kk = (tid >> 6) + 8 * i, nn = tid & 63, n = n0 + nn;
    scr[kk * 65 + nn] = (n < N) ? W[(size_t)(k0 + kk) * N + n] : 0.f;
  }
  __syncthreads();
  {
    const int nn = tid >> 3, kc = tid & 7, n = n0 + nn;
    if (n < N) {
      const int dst = mapmode == 1 ? phys_col(map_even(n)) : (mapmode == 2 ? phys_col(n) : n);
      const float* s = scr + (kc * 8) * 65 + nn;
      u32x4 o; o.x = cvtpk(s[0], s[65]); o.y = cvtpk(s[2 * 65], s[3 * 65]); o.z = cvtpk(s[4 * 65], s[5 * 65]); o.w = cvtpk(s[6 * 65], s[7 * 65]);
      *(u32x4*)(WT + (size_t)dst * K + k0 + kc * 8) = o;
    }
  }
  __syncthreads();
}

DI float wave_sum(float v) {
#pragma unroll
  for (int o = 1; o < 64; o <<= 1) v += __shfl_xor(v, o);
  return v;
}

DI void phase_prologue(const Params& p, char* lds) {
  const int tid = opaque_tid(), lane = tid & 63, wid = tid >> 6;
  const int nb = gridDim.x, bid = blockIdx.x;
  unsigned char* ws = p.ws;
  float* scr = (float*)lds;
  const int T0 = 16 * 48, T1 = 256, T2 = 16 * 64, T3 = 256, T4 = 256, T5 = 256, T6 = 64, T7 = 64;
  const int NT = T0 + T1 + T2 + T3 + T4 + T5 + T6 + T7;
  for (int it = bid; it < NT; it += nb) {
    int r = it;
    if (r < T0) { transpose_tile(p.in[I_W_IN_EVEN], 1024, 3016, (bf16*)(ws + WS_WINE), 1, r, scr); continue; } r -= T0;
    if (r < T1) { transpose_tile(p.in[I_W_OUT_EVEN], 1024, 1024, (bf16*)(ws + WS_WOUTE), 0, r, scr); continue; } r -= T1;
    if (r < T2) { transpose_tile(p.in[I_W_IN_ODD], 1024, 4096, (bf16*)(ws + WS_WINO), 2, r, scr); continue; } r -= T2;
    if (r < T3) { transpose_tile(p.in[I_W_OUT_ODD], 1024, 1024, (bf16*)(ws + WS_WOUTO), 0, r, scr); continue; } r -= T3;
    if (r < T4) { transpose_tile(p.in[I_W_PLE_GATE], 1024, 1024, (bf16*)(ws + WS_WG0), 0, r, scr); continue; } r -= T4;
    if (r < T5) { transpose_tile(p.in[I_W_PLE_GATE] + 1024 * 1024, 1024, 1024, (bf16*)(ws + WS_WG1), 0, r, scr); continue; } r -= T5;
    if (r < T6) { transpose_tile(p.in[I_W_PLE_PROJ], 256, 1024, (bf16*)(ws + WS_WP0), 0, r, scr); continue; } r -= T6;
    transpose_tile(p.in[I_W_PLE_PROJ] + 256 * 1024, 256, 1024, (bf16*)(ws + WS_WP1), 0, r, scr);
  }
  const int gt = bid * NTHREADS + tid, ngt = nb * NTHREADS;
  { unsigned* z = (unsigned*)(ws + WS_WINE); for (int i = gt; i < 56 * 512; i += ngt) z[(size_t)phys_col(3016 + (i >> 9)) * 512 + (i & 511)] = 0u; }
  { float* ss = (float*)(ws + WS_SS); for (int i = gt; i < 3 * NTOK; i += ngt) ss[i] = 0.f; }
  { float2* tab = (float2*)(ws + WS_ROPE);
    for (int i = gt; i < SEQ * 32; i += ngt) {
      const int pos = i >> 5, k = i & 31;
      const float ang = (float)pos * p.inv_freq[k];
      double rev = (double)ang * 0.15915494309189535; rev -= floor(rev);
      const float rf = (float)rev;
      tab[i] = make_float2(__builtin_amdgcn_cosf(rf), __builtin_amdgcn_sinf(rf));
    } }
  if (bid == 0 && wid == 0) {
    const float a = wave_sum(p.in[I_LQ1][lane] * p.in[I_LK1][lane]);
    const float b = wave_sum(p.in[I_LQ2][lane] * p.in[I_LK2][lane]);
    const float lambda_init = 0.8f - 0.6f * expf(-0.3f);
    if (lane == 0) *(float*)(ws + WS_LAM) = expf(a) - expf(b) + lambda_init;
  }
  { const float* x = p.in[I_X]; const float* g = p.in[I_NORM_GAIN]; bf16* H = (bf16*)(ws + WS_ACT);
    const int gw = bid * 8 + wid, ngw = nb * 8;
    for (int m = gw; m < NTOK; m += ngw) {
      const f32x4* xr = (const f32x4*)(x + (size_t)m * DM) + lane;
      f32x4 v[4]; float s = 0.f;
#pragma unroll
      for (int j = 0; j < 4; ++j) { v[j] = xr[64 * j]; s += v[j].x * v[j].x + v[j].y * v[j].y + v[j].z * v[j].z + v[j].w * v[j].w; }
      const float rstd = rsqrtf(wave_sum(s) * (1.f / DM) + EPS);
      u32x2* o = (u32x2*)(H + (size_t)m * DM) + lane;
#pragma unroll
      for (int j = 0; j < 4; ++j) { const f32x4 gg = *((const f32x4*)g + lane + 64 * j); u32x2 w; w.x = cvtpk(v[j].x * rstd * gg.x, v[j].y * rstd * gg.y); w.y = cvtpk(v[j].z * rstd * gg.z, v[j].w * rstd * gg.w); o[64 * j] = w; }
    } }
}

namespace pg8 {
#define PG8_LAS __attribute__((address_space(3)))
typedef unsigned short bf16_t;
typedef short bf16x8 __attribute__((ext_vector_type(8)));
typedef float f32x4 __attribute__((ext_vector_type(4)));
typedef unsigned u32x4 __attribute__((ext_vector_type(4)));
constexpr int BM = 256, BK = 64, HALF = 128, HTB = HALF * BK * 2  , STAGE_BYTES = 8 * HTB, NXCD = 8, WGM = 8;

__host__ __device__ __forceinline__ int lds_byte(int r, int c) { const int st = (r >> 4) * 2 + (c >> 5), rr = r & 15, cc = c & 31, ob = rr * 64 + cc * 2; return st * 1024 + (ob ^ (((ob >> 9) & 1) << 5)); }
__host__ __device__ __forceinline__ void stage_rc(int b, int& R, int& C) { const int st = b / 1024, sb = b % 1024, swz = sb ^ (((sb >> 9) & 1) << 5); R = (st >> 1) * 16 + swz / 64; C = (st & 1) * 32 + (swz % 64) / 2; }
__host__ __device__ __forceinline__ int perm32(int rho) { const int n = rho >> 4, i = rho & 15; return 8 * (i >> 2) + 4 * n + (i & 3); }

struct Unit { int pm, pn; };
struct Gemm { const bf16_t* A; const bf16_t* Bt; int M, N, K; };

struct StaticOrder {
    int nM, nN, nwg, G, c;
    __host__ __device__ void init(int M, int N, int G_, int c_) { nM = M / BM; nN = N / BM; nwg = nM * nN; G = G_; c = c_; }
    __host__ __device__ bool next(int i, Unit& u) const {
        const long L = (long)i * G + c; if (L >= nwg) return false;
        int wgid = (int)L; { const int q = nwg / NXCD, r = nwg % NXCD, xcd = wgid % NXCD, off = wgid / NXCD; wgid = (xcd < r ? xcd * (q + 1) : r * (q + 1) + (xcd - r) * q) + off; }
        const int nig = WGM * nN, gid = wgid / nig, fm = gid * WGM, gsz = (nM - fm) < WGM ? (nM - fm) : WGM;
        u.pm = fm + ((wgid % nig) % gsz); u.pn = (wgid % nig) / gsz; return true;
    }
    __device__ __forceinline__ void a_ready(const Unit&) const {}
    __device__ __forceinline__ void done(const Unit&) const {}
};
__device__ __forceinline__ unsigned cvt_pk_bf16(float lo, float hi) { unsigned r; asm volatile("v_cvt_pk_bf16_f32 %0, %1, %2" : "=v"(r) : "v"(lo), "v"(hi)); return r; }
template <class Epi, class Sched, bool ALIGN_EPI = false, bool SP2 = false>
__device__ __forceinline__ void gemm_phase(PG8_LAS unsigned char* lds, const Gemm g, const Sched& S, const Epi& E) {
    int tid_ = threadIdx.x; asm volatile("" : "+v"(tid_));
    const int tid = tid_, wid = __builtin_amdgcn_readfirstlane(tid >> 6), lane = tid & 63, wr = wid >> 2, wc = wid & 3, fr = lane & 15, fq = lane >> 4;
    const int K = g.K, nt = K / BK;
    unsigned voffA[2], voffB[2];
#pragma unroll
    for (int i = 0; i < 2; ++i) { int R, C; stage_rc(tid * 16 + i * 8192, R, C); const int Rb = Epi::PERM ? ((R & ~31) + perm32(R & 31)) : R;
        voffA[i] = (unsigned)(R * K + C) * 2u; voffB[i] = (unsigned)(Rb * K + C) * 2u; }
    const size_t kstep = (size_t)(BK * 2);
    const size_t hstep = (size_t)HALF * K * 2;
    const size_t tstep = 2 * hstep;
    const unsigned ldsw = (unsigned)wid * 1024u;
    const int aoff = lds_byte(wr * 64 + fr, fq * 8), boff = lds_byte(wc * 32 + fr, fq * 8);
#define PG8_SA(b, h) (((b) * 2 + (h)) * HTB)
#define PG8_SB(b, h) ((4 + (b) * 2 + (h)) * HTB)
#define PG8_STAGE(bufoff, gbase, voff) do { _Pragma("unroll") for (int _i = 0; _i < 2; ++_i) \
        __builtin_amdgcn_global_load_lds((const unsigned*)((const char*)(gbase) + (voff)[_i]), (PG8_LAS unsigned*)(lds + (bufoff) + ldsw + _i * 8192), 16, 0, 0); } while (0)
#define PG8_LDA(dst, b, h) do { _Pragma("unroll") for (int m = 0; m < 4; ++m) _Pragma("unroll") for (int k = 0; k < 2; ++k) dst[m][k] = *(const PG8_LAS bf16x8*)(lds + PG8_SA(b, h) + aoff + m * 2048 + k * 1024); } while (0)
#define PG8_LDB(dst, b, h) do { _Pragma("unroll") for (int n = 0; n < 2; ++n) _Pragma("unroll") for (int k = 0; k < 2; ++k) dst[n][k] = *(const PG8_LAS bf16x8*)(lds + PG8_SB(b, h) + boff + n * 2048 + k * 1024); } while (0)
#define PG8_MMA(ai, bj, At, Bt) do { __builtin_amdgcn_s_setprio(1); _Pragma("unroll") for (int m = 0; m < 4; ++m) _Pragma("unroll") for (int n = 0; n < 2; ++n) _Pragma("unroll") for (int k = 0; k < 2; ++k) \
        acc[ai][bj][m][n] = __builtin_amdgcn_mfma_f32_16x16x32_bf16(Bt[n][k], At[m][k], acc[ai][bj][m][n], 0, 0, 0); __builtin_amdgcn_s_setprio(0); } while (0)
#define PG8_WAIT_V(n) asm volatile("s_waitcnt vmcnt(" #n ")" ::: "memory")
#define PG8_WAIT_L(n) asm volatile("s_waitcnt lgkmcnt(" #n ")" ::: "memory")
#define PG8_BAR __builtin_amdgcn_s_barrier()
#define PG8_SCHED __builtin_amdgcn_sched_barrier(0)
    Unit cur, nxt; int ui = 0;
    if (!S.next(0, cur)) return;
    f32x4 acc[2][2][4][2];
#pragma unroll
    for (int a = 0; a < 2; ++a)
#pragma unroll
        for (int b = 0; b < 2; ++b)
#pragma unroll
            for (int m = 0; m < 4; ++m)
#pragma unroll
                for (int n = 0; n < 2; ++n) acc[a][b][m][n] = (f32x4){0.f, 0.f, 0.f, 0.f};
    bf16x8 At[4][2], B0[2][2], B1[2][2];
    const char* cA = (const char*)g.A + (size_t)cur.pm * tstep; const char* cB = (const char*)g.Bt + (size_t)cur.pn * tstep;
    S.a_ready(cur);
    if constexpr (SP2) {
        PG8_STAGE(PG8_SB(0, 0), cB, voffB); PG8_STAGE(PG8_SB(0, 1), cB + hstep, voffB); PG8_STAGE(PG8_SA(0, 0), cA, voffA); PG8_STAGE(PG8_SA(0, 1), cA + hstep, voffA);
        if (wr == 1) PG8_BAR;
        PG8_WAIT_V(2); PG8_BAR;
        PG8_STAGE(PG8_SB(1, 0), cB + kstep, voffB); PG8_STAGE(PG8_SA(1, 0), cA + kstep, voffA); PG8_STAGE(PG8_SB(1, 1), cB + hstep + kstep, voffB);
        PG8_WAIT_V(6); PG8_BAR;
    } else {
        PG8_STAGE(PG8_SB(0, 0), cB, voffB); PG8_STAGE(PG8_SA(0, 0), cA, voffA); PG8_STAGE(PG8_SB(0, 1), cB + hstep, voffB); PG8_STAGE(PG8_SA(0, 1), cA + hstep, voffA);
        if (wr == 1) PG8_BAR;
        PG8_WAIT_V(4); PG8_BAR;
        PG8_STAGE(PG8_SB(1, 0), cB + kstep, voffB); PG8_STAGE(PG8_SA(1, 0), cA + kstep, voffA); PG8_STAGE(PG8_SB(1, 1), cB + hstep + kstep, voffB);
        PG8_WAIT_V(6); PG8_BAR;
    }
    for (;;) {
        const bool has_next = S.next(ui + 1, nxt);
        const char* nA = has_next ? (const char*)g.A + (size_t)nxt.pm * tstep : cA; const char* nB = has_next ? (const char*)g.Bt + (size_t)nxt.pn * tstep : cB;
        for (int t = 0; t < nt; t += 2) {
            const bool last = (t == nt - 2);
            const char* a1 = cA + (size_t)(t + 1) * kstep;
            const char* a2 = last ? nA : cA + (size_t)(t + 2) * kstep; const char* b2 = last ? nB : cB + (size_t)(t + 2) * kstep;
            const char* a3 = a2 + kstep; const char* b3 = b2 + kstep;
            if (last && has_next) S.a_ready(nxt);
            if constexpr (SP2) {
            PG8_LDB(B0, 0, 0); PG8_LDB(B1, 0, 1); PG8_SCHED; PG8_LDA(At, 0, 0); PG8_STAGE(PG8_SA(1, 1), a1 + hstep, voffA);
            PG8_WAIT_V(8); PG8_WAIT_L(0); PG8_BAR; PG8_MMA(0, 0, At, B0); PG8_MMA(0, 1, At, B1); PG8_BAR; PG8_SCHED;
            PG8_LDA(At, 0, 1); PG8_STAGE(PG8_SB(0, 0), b2, voffB); PG8_STAGE(PG8_SB(0, 1), b2 + hstep, voffB); PG8_STAGE(PG8_SA(0, 0), a2, voffA);
            PG8_WAIT_V(8); PG8_WAIT_L(0); PG8_BAR; PG8_MMA(1, 0, At, B0); PG8_MMA(1, 1, At, B1); PG8_BAR; PG8_SCHED;
            PG8_LDB(B0, 1, 0); PG8_LDB(B1, 1, 1); PG8_SCHED; PG8_LDA(At, 1, 0); PG8_STAGE(PG8_SA(0, 1), a2 + hstep, voffA);
            PG8_WAIT_V(8); PG8_WAIT_L(0); PG8_BAR; PG8_MMA(0, 0, At, B0); PG8_MMA(0, 1, At, B1); PG8_BAR; PG8_SCHED;
            PG8_LDA(At, 1, 1); PG8_STAGE(PG8_SB(1, 0), b3, voffB); PG8_STAGE(PG8_SB(1, 1), b3 + hstep, voffB); PG8_STAGE(PG8_SA(1, 0), a3, voffA);
            PG8_WAIT_V(8); PG8_WAIT_L(0); PG8_BAR; PG8_MMA(1, 0, At, B0); PG8_MMA(1, 1, At, B1); PG8_BAR; PG8_SCHED;
            } else {
            PG8_LDB(B0, 0, 0); PG8_SCHED; PG8_LDA(At, 0, 0); PG8_STAGE(PG8_SA(1, 1), a1 + hstep, voffA);
            PG8_WAIT_L(8); PG8_BAR; PG8_WAIT_L(0); PG8_MMA(0, 0, At, B0); PG8_BAR; PG8_SCHED;
            PG8_LDB(B1, 0, 1); PG8_STAGE(PG8_SB(0, 0), b2, voffB);
            PG8_BAR; PG8_WAIT_L(0); PG8_MMA(0, 1, At, B1); PG8_BAR;
            PG8_LDA(At, 0, 1); PG8_STAGE(PG8_SA(0, 0), a2, voffA);
            PG8_BAR; PG8_WAIT_L(0); PG8_MMA(1, 0, At, B0); PG8_BAR; PG8_SCHED;
            PG8_STAGE(PG8_SB(0, 1), b2 + hstep, voffB);
            PG8_WAIT_V(6); PG8_BAR; PG8_MMA(1, 1, At, B1); PG8_BAR;
            PG8_LDB(B0, 1, 0); PG8_SCHED; PG8_LDA(At, 1, 0); PG8_STAGE(PG8_SA(0, 1), a2 + hstep, voffA);
            PG8_WAIT_L(8); PG8_BAR; PG8_WAIT_L(0); PG8_MMA(0, 0, At, B0); PG8_BAR; PG8_SCHED;
            PG8_LDB(B1, 1, 1); PG8_STAGE(PG8_SB(1, 0), b3, voffB);
            PG8_BAR; PG8_WAIT_L(0); PG8_MMA(0, 1, At, B1); PG8_BAR;
            PG8_LDA(At, 1, 1); PG8_STAGE(PG8_SA(1, 0), a3, voffA);
            PG8_BAR; PG8_WAIT_L(0); PG8_MMA(1, 0, At, B0); PG8_BAR; PG8_SCHED;
            PG8_STAGE(PG8_SB(1, 1), b3 + hstep, voffB);
            PG8_WAIT_V(6); PG8_BAR; PG8_MMA(1, 1, At, B1); PG8_BAR;
            }
        }
        if constexpr (ALIGN_EPI) { if (wr == 0) PG8_BAR; }
        if constexpr (!Epi::AFTER_DRAIN) { E(acc, cur, wr, wc, fr, fq); S.done(cur); }
        if (!has_next) break;
#pragma unroll
        for (int a = 0; a < 2; ++a)
#pragma unroll
            for (int b = 0; b < 2; ++b)
#pragma unroll
                for (int m = 0; m < 4; ++m)
#pragma unroll
                    for (int n = 0; n < 2; ++n) acc[a][b][m][n] = (f32x4){0.f, 0.f, 0.f, 0.f};
        cur = nxt; cA = nA; cB = nB; ++ui;
        if constexpr (ALIGN_EPI) { if (wr == 1) PG8_BAR; }
    }
    PG8_WAIT_V(0);
    if constexpr (!ALIGN_EPI) { if (wr == 0) PG8_BAR; }
    PG8_BAR;
    if constexpr (Epi::AFTER_DRAIN) { E.fused(acc, cur, wr, wc, fr, fq, lds, wid, lane); S.done(cur); }
#undef PG8_SA
#undef PG8_SB
#undef PG8_STAGE
#undef PG8_LDA
#undef PG8_LDB
#undef PG8_MMA
#undef PG8_WAIT_V
#undef PG8_WAIT_L
#undef PG8_BAR
#undef PG8_SCHED
}
}

enum { T_PLAIN = 0, T_NR = 1, T_ROPE = 2, T_SILU = 3, T_IW = 4 };
DI void slot_info(const Params& p, int layer, int slot, int& type, const float*& gain) {
  gain = nullptr;
  if (layer == 0) {
    if (slot < 8) { type = T_NR; gain = p.in[I_A_Q_GAIN]; }
    else if (slot == 8) { type = T_NR; gain = p.in[I_A_K_GAIN]; }
    else if (slot == 9) type = T_PLAIN;
    else if (slot < 18) type = T_ROPE;
    else if (slot == 18) { type = T_NR; gain = p.in[I_IDX_K_GAIN]; }
    else if (slot < 27) type = T_SILU;
    else if (slot < 35) { type = T_NR; gain = p.in[I_B_Q_GAIN]; }
    else if (slot < 37) { type = T_NR; gain = p.in[I_B_K_GAIN]; }
    else if (slot < 39) type = T_PLAIN;
    else if (slot < 47) type = T_SILU;
    else type = T_IW;
  } else {
    if (slot < 8) { type = T_NR; gain = p.in[I_C_Q_GAIN]; }
    else if (slot < 16) { type = T_NR; gain = p.in[I_C_K_GAIN]; }
    else if (slot < 24) type = T_PLAIN;
    else if (slot < 32) type = T_SILU;
    else if (slot < 40) { type = T_NR; gain = p.in[I_D_Q_GAIN]; }
    else if (slot < 48) { type = T_NR; gain = p.in[I_D_K_GAIN]; }
    else if (slot < 56) type = T_PLAIN;
    else type = T_SILU;
  }
}
constexpr int E_AQ = 0, E_AK = 512, E_AV = 576, E_IQ = 640, E_IK = 1152, E_AG = 1216, E_BQ = 1728, E_BK = 2240, E_BV = 2368, E_BG = 2496;
constexpr int O_CQ = 0, O_CK = 512, O_CV = 1024, O_CG = 1536, O_DQ = 2048, O_DK = 2560, O_DV = 3072, O_DG = 3584;

typedef pg8::f32x4 (AccT)[2][2][4][2];

struct EpiInProj {
  static constexpr bool PERM = false, AFTER_DRAIN = false;
  const Params& p; int layer;
  DI void operator()(const f32x4 (&acc)[2][2][4][2], const pg8::Unit& u, int wr, int wc, int fr, int fq) const {
    unsigned char* ws = p.ws;
    const int NP = layer == 0 ? NPE : NPO;
    bf16* PE = (bf16*)(ws + WS_PE);
    const float2* rope = (const float2*)(ws + WS_ROPE);
    const float* ss1 = (const float*)(ws + WS_SS);
    float* IW = (float*)(ws + WS_IW);
    const int slot = u.pn * 4 + wc;
    int type; const float* gain; slot_info(p, layer, slot, type, gain);
#pragma unroll
    for (int ai = 0; ai < 2; ++ai)
#pragma unroll
      for (int m = 0; m < 4; ++m) {
        const int row = u.pm * 256 + ai * 128 + wr * 64 + m * 16 + fr, pos = row & (SEQ - 1);
        float sc = 1.f;
        if (layer == 1) sc = rsqrtf(ss1[row] * (1.f / DM) + EPS);
        f32x4 v1[2], v2[2];
#pragma unroll
        for (int n = 0; n < 2; ++n) { v1[n] = acc[ai][0][m][n] * sc; v2[n] = acc[ai][1][m][n] * sc; }
        if (type == T_NR) {
          float s = 0.f;
#pragma unroll
          for (int n = 0; n < 2; ++n) s += v1[n].x * v1[n].x + v1[n].y * v1[n].y + v1[n].z * v1[n].z + v1[n].w * v1[n].w + v2[n].x * v2[n].x + v2[n].y * v2[n].y + v2[n].z * v2[n].z + v2[n].w * v2[n].w;
          s += __shfl_xor(s, 16); s += __shfl_xor(s, 32);
          const float rn = rsqrtf(s * (1.f / 64.f) + EPS);
#pragma unroll
          for (int n = 0; n < 2; ++n) { const f32x4 g1 = *(const f32x4*)(gain + n * 16 + fq * 4), g2 = *(const f32x4*)(gain + 32 + n * 16 + fq * 4); v1[n] = v1[n] * rn * g1; v2[n] = v2[n] * rn * g2; }
        }
        if (type == T_NR || type == T_ROPE) {
#pragma unroll
          for (int n = 0; n < 2; ++n) {
            const f32x4* cs = (const f32x4*)(rope + (size_t)pos * 32 + n * 16 + fq * 4);
            const f32x4 c01 = cs[0], c23 = cs[1];
            const f32x4 x1 = v1[n], x2 = v2[n];
            f32x4 o1, o2;
            o1.x = x1.x * c01.x - x2.x * c01.y; o2.x = x2.x * c01.x + x1.x * c01.y;
            o1.y = x1.y * c01.z - x2.y * c01.w; o2.y = x2.y * c01.z + x1.y * c01.w;
            o1.z = x1.z * c23.x - x2.z * c23.y; o2.z = x2.z * c23.x + x1.z * c23.y;
            o1.w = x1.w * c23.z - x2.w * c23.w; o2.w = x2.w * c23.z + x1.w * c23.w;
            v1[n] = o1; v2[n] = o2;
          }
        }
        if (type == T_SILU) {
#pragma unroll
          for (int n = 0; n < 2; ++n)
#pragma unroll
            for (int j = 0; j < 4; ++j) { const float a = v1[n][j]; v1[n][j] = a / (1.f + __expf(-a)); const float b = v2[n][j]; v2[n][j] = b / (1.f + __expf(-b)); }
        }
        if (type == T_IW) {
          if (fq < 2) *(f32x4*)(IW + (size_t)row * 8 + fq * 4) = v1[0];
        } else {
          bf16* dst = PE + (size_t)row * NP + slot * 64 + fq * 4;
#pragma unroll
          for (int n = 0; n < 2; ++n) {
            u32x2 w1, w2; w1.x = cvtpk(v1[n].x, v1[n].y); w1.y = cvtpk(v1[n].z, v1[n].w); w2.x = cvtpk(v2[n].x, v2[n].y); w2.y = cvtpk(v2[n].z, v2[n].w);
            *(u32x2*)(dst + n * 16) = w1; *(u32x2*)(dst + 32 + n * 16) = w2;
            if (layer == 0 && slot == 18) { bf16* IKS = (bf16*)(ws + WS_IKS); const int key = row & (SEQ - 1);
              bf16* base = IKS + (((size_t)(row >> 13) * 256 + (key >> 5)) * 4) * 512 + ((fq >> 1) * 32 + (key & 31)) * 8 + (fq & 1) * 4;
              *(u32x2*)(base + (size_t)n * 512) = w1; *(u32x2*)(base + (size_t)(n + 2) * 512) = w2; }
          }
        }
        asm volatile("" ::: "memory");
      }
  }
};

DI void phase_inproj(const Params& p, int layer, char* lds) {
  unsigned char* ws = p.ws;
  const int NP = layer == 0 ? NPE : NPO;
  pg8::Gemm g{(const bf16*)(ws + (layer == 0 ? WS_ACT : WS_Y)), (const bf16*)(ws + (layer == 0 ? WS_WINE : WS_WINO)), NTOK, NP, DM};
  pg8::StaticOrder S; S.init(NTOK, NP, (int)gridDim.x, (int)blockIdx.x);
  EpiInProj E{p, layer};
  pg8::gemm_phase<EpiInProj, pg8::StaticOrder, true, true>((PG8_LAS unsigned char*)lds, g, S, E);
}

struct EpiOutProj {
  static constexpr bool PERM = false, AFTER_DRAIN = false;
  const float* xin; bf16* X1B; bf16* XG; const float* pg; float* ss;
  DI void operator()(const f32x4 (&acc)[2][2][4][2], const pg8::Unit& u, int wr, int wc, int fr, int fq) const {
#pragma unroll
    for (int ai = 0; ai < 2; ++ai)
#pragma unroll
      for (int m = 0; m < 4; ++m) {
        const int row = u.pm * 256 + ai * 128 + wr * 64 + m * 16 + fr; float rs = 0.f;
#pragma unroll
        for (int bj = 0; bj < 2; ++bj)
#pragma unroll
          for (int n = 0; n < 2; ++n) {
            const int col = u.pn * 256 + bj * 128 + wc * 32 + n * 16 + fq * 4; const size_t off = (size_t)row * DM + col;
            const f32x4 xn = *(const f32x4*)(xin + off) + acc[ai][bj][m][n];
            { u32x2 wx; wx.x = cvtpk(xn.x, xn.y); wx.y = cvtpk(xn.z, xn.w); *(u32x2*)(X1B + off) = wx; }
            rs += xn.x * xn.x + xn.y * xn.y + xn.z * xn.z + xn.w * xn.w;
            const f32x4 gg = *(const f32x4*)(pg + col);
            u32x2 w; w.x = cvtpk(xn.x * gg.x, xn.y * gg.y); w.y = cvtpk(xn.z * gg.z, xn.w * gg.w); *(u32x2*)(XG + off) = w;
          }
        rs += __shfl_xor(rs, 16); rs += __shfl_xor(rs, 32);
        if (fq == 0) atomicAdd(ss + row, rs);
        asm volatile("" ::: "memory");
      }
  }
};
DI void phase_outproj(const Params& p, int layer, char* lds) {
  unsigned char* ws = p.ws;
  pg8::Gemm g{(const bf16*)(ws + WS_Y), (const bf16*)(ws + (layer == 0 ? WS_WOUTE : WS_WOUTO)), NTOK, DM, DM};
  pg8::StaticOrder S; S.init(NTOK, DM, (int)gridDim.x, (int)blockIdx.x);
  EpiOutProj E{layer == 0 ? p.in[I_X] : p.out, (bf16*)(ws + WS_PE + 64 * MiB), (bf16*)(ws + WS_ACT), p.in[I_PLE_NORM_GAIN] + layer * DM, (float*)(ws + WS_SS) + (layer == 0 ? 1 : 2) * NTOK};
  pg8::gemm_phase<EpiOutProj, pg8::StaticOrder, true, true>((PG8_LAS unsigned char*)lds, g, S, E);
}

struct EpiPleProj {
  static constexpr bool PERM = false, AFTER_DRAIN = false;
  bf16* PT;
  DI void operator()(const f32x4 (&acc)[2][2][4][2], const pg8::Unit& u, int wr, int wc, int fr, int fq) const {
#pragma unroll
    for (int ai = 0; ai < 2; ++ai)
#pragma unroll
      for (int m = 0; m < 4; ++m) {
        const int row = u.pm * 256 + ai * 128 + wr * 64 + m * 16 + fr;
#pragma unroll
        for (int bj = 0; bj < 2; ++bj)
#pragma unroll
          for (int n = 0; n < 2; ++n) { const f32x4 a = acc[ai][bj][m][n]; u32x2 w; w.x = cvtpk(a.x, a.y); w.y = cvtpk(a.z, a.w); *(u32x2*)(PT + (size_t)row * DM + u.pn * 256 + bj * 128 + wc * 32 + n * 16 + fq * 4) = w; }
      }
  }
};
struct EpiPleGate {
  static constexpr bool PERM = false, AFTER_DRAIN = false;
  const bf16* PT; const bf16* X1B; float* out; const float* ssx; float* ss1; bf16* H; const float* ng1; int layer;
  DI void operator()(const f32x4 (&acc)[2][2][4][2], const pg8::Unit& u, int wr, int wc, int fr, int fq) const {
#pragma unroll
    for (int ai = 0; ai < 2; ++ai)
#pragma unroll
      for (int m = 0; m < 4; ++m) {
        const int row = u.pm * 256 + ai * 128 + wr * 64 + m * 16 + fr; float rs = 0.f;
        const float rstd = rsqrtf(ssx[row] * (1.f / DM) + EPS);
#pragma unroll
        for (int bj = 0; bj < 2; ++bj)
#pragma unroll
          for (int n = 0; n < 2; ++n) {
            const int col = u.pn * 256 + bj * 128 + wc * 32 + n * 16 + fq * 4; const size_t off = (size_t)row * DM + col;
            f32x4 g;
#pragma unroll
            for (int j = 0; j < 4; ++j) g[j] = 1.f / (1.f + __expf(-rstd * acc[ai][bj][m][n][j]));
            const u32x2 pw = *(const u32x2*)(PT + off); f32x4 pp; pp.x = __uint_as_float(pw.x << 16); pp.y = __uint_as_float(pw.x & 0xffff0000u); pp.z = __uint_as_float(pw.y << 16); pp.w = __uint_as_float(pw.y & 0xffff0000u);
            const u32x2 xw = *(const u32x2*)(X1B + off); f32x4 x1; x1.x = __uint_as_float(xw.x << 16); x1.y = __uint_as_float(xw.x & 0xffff0000u); x1.z = __uint_as_float(xw.y << 16); x1.w = __uint_as_float(xw.y & 0xffff0000u);
            const f32x4 xn = x1 + pp * g;
            *(f32x4*)(out + off) = xn;
            if (layer == 0) {
              rs += xn.x * xn.x + xn.y * xn.y + xn.z * xn.z + xn.w * xn.w;
              const f32x4 gg = *(const f32x4*)(ng1 + col);
              u32x2 w; w.x = cvtpk(xn.x * gg.x, xn.y * gg.y); w.y = cvtpk(xn.z * gg.z, xn.w * gg.w); *(u32x2*)(H + off) = w;
            }
          }
        if (layer == 0) { rs += __shfl_xor(rs, 16); rs += __shfl_xor(rs, 32); if (fq == 0) atomicAdd(ss1 + row, rs); }
        asm volatile("" ::: "memory");
      }
  }
};
DI void phase_ple(const Params& p, int layer, char* lds) {
  unsigned char* ws = p.ws;
  bf16* PT = (bf16*)(ws + WS_PE);
  pg8::StaticOrder S; S.init(NTOK, DM, (int)gridDim.x, (int)blockIdx.x);
  { pg8::Gemm g{(const bf16*)(ws + WS_PBF) + (size_t)layer * NTOK * 256, (const bf16*)(ws + (layer == 0 ? WS_WP0 : WS_WP1)), NTOK, DM, 256};
    EpiPleProj E{PT};
    pg8::gemm_phase<EpiPleProj, pg8::StaticOrder, true, true>((PG8_LAS unsigned char*)lds, g, S, E); }
  { pg8::Gemm g{(const bf16*)(ws + WS_ACT), (const bf16*)(ws + (layer == 0 ? WS_WG0 : WS_WG1)), NTOK, DM, DM};
    EpiPleGate E{PT, (const bf16*)(ws + WS_PE + 64 * MiB), p.out, (const float*)(ws + WS_SS) + (layer == 0 ? 1 : 2) * NTOK, (float*)(ws + WS_SS), (bf16*)(ws + WS_Y), p.in[I_NORM_GAIN] + DM, layer};
    pg8::gemm_phase<EpiPleGate, pg8::StaticOrder, true, true>((PG8_LAS unsigned char*)lds, g, S, E); }
}

DI float half_max(float v) { auto rr = __builtin_amdgcn_permlane32_swap(__float_as_uint(v), __float_as_uint(v), false, false); return fmaxf(__uint_as_float(rr[0]), __uint_as_float(rr[1])); }
template <int DVB, bool MASKED = true>
DI void attn_step32(const bf16* Kt, int KP, const bf16* Vt, int VP, const bf16x8 (&qf)[4], f32x16 (&o)[DVB], float& m, float& l, unsigned vmask, float c2, int lane) {
  const int r32 = lane & 31, h = lane >> 5;
  f32x16 s;
#pragma unroll
  for (int i = 0; i < 16; ++i) s[i] = 0.f;
#pragma unroll
  for (int t = 0; t < 4; ++t) { const bf16x8 kf = *(const bf16x8*)(Kt + r32 * KP + t * 16 + h * 8); s = mfma32(kf, qf[t], s); }
  float mx = -INFINITY;
#pragma unroll
  for (int i = 0; i < 16; ++i) { if (MASKED) { s[i] = ((vmask >> i) & 1u) ? s[i] : -INFINITY; } mx = fmaxf(mx, s[i]); }
  mx = half_max(mx);
  const float mxs = mx * c2;
  if (__any(mxs > m + 6.f)) {
    const float mn = fmaxf(m, mxs);
    const float alpha = fexp2(m - mn); l *= alpha;
#pragma unroll
    for (int d = 0; d < DVB; ++d)
#pragma unroll
      for (int i = 0; i < 16; ++i) o[d][i] *= alpha;
    m = mn;
  }
  float ps = 0.f; const float negm = -m;
#pragma unroll
  for (int i = 0; i < 16; ++i) { const float pv = fexp2(__builtin_fmaf(s[i], c2, negm)); s[i] = pv; ps += pv; }
  l += ps;
  bf16x8 pf[2];
  { u32x4 a, b; a.x = cvtpk(s[0], s[1]); a.y = cvtpk(s[2], s[3]); a.z = cvtpk(s[4], s[5]); a.w = cvtpk(s[6], s[7]);
    b.x = cvtpk(s[8], s[9]); b.y = cvtpk(s[10], s[11]); b.z = cvtpk(s[12], s[13]); b.w = cvtpk(s[14], s[15]);
    pf[0] = __builtin_bit_cast(bf16x8, a); pf[1] = __builtin_bit_cast(bf16x8, b); }
  const int i16 = lane & 15, q = i16 >> 2, pp = i16 & 3, blk = (lane >> 4) & 1;
#pragma unroll
  for (int d = 0; d < DVB; ++d)
#pragma unroll
    for (int sk = 0; sk < 2; ++sk) {
      const s16x4 lo = trread(Vt + (16 * sk + 4 * h + q) * VP + 32 * d + 16 * blk + 4 * pp);
      const s16x4 hi = trread(Vt + (16 * sk + 8 + 4 * h + q) * VP + 32 * d + 16 * blk + 4 * pp);
      const bf16x8 vf = __builtin_shufflevector(lo, hi, 0, 1, 2, 3, 4, 5, 6, 7);
      o[d] = mfma32(vf, pf[sk], o[d]);
    }
}

DI unsigned row_range_mask(int lo, int hi) {
  lo = lo < 0 ? 0 : lo; hi = hi > 31 ? 31 : hi;
  if (hi < lo) return 0u;
  const unsigned upto_hi = (hi >= 31) ? 0xffffffffu : ((1u << (hi + 1)) - 1u);
  return upto_hi & ~((1u << lo) - 1u);
}
DI unsigned lane_rows(unsigned m32, int h) {
  const unsigned t = m32 >> (4 * h);
  return (t & 0xFu) | ((t >> 4) & 0xF0u) | ((t >> 8) & 0xF00u) | ((t >> 12) & 0xF000u);
}
constexpr int WP = 72;
constexpr int WAVE_LDS = 2 * 32 * WP * 2 + 512;

struct KVRegs { u32x4 k[4], v[4]; };
DI void kv_store(const KVRegs& R, bf16* Ks, bf16* Vs, int lane) {
#pragma unroll
  for (int i = 0; i < 4; ++i) { const int row = (lane >> 3) + 8 * i, ch = lane & 7; *(u32x4*)(Ks + row * WP + ch * 8) = R.k[i]; *(u32x4*)(Vs + row * WP + ch * 8) = R.v[i]; }
}

DI void band_load(KVRegs& R, const bf16* Kg, const bf16* Vg, int NP, int kstart, int dil, int roff, int lane) {
#pragma unroll
  for (int i = 0; i < 4; ++i) {
    const int row = (lane >> 3) + 8 * i, ch = lane & 7; int k = kstart + row; if (k < 0) k = 0;
    const size_t off = (size_t)(dil * k + roff) * NP + ch * 8;
    R.k[i] = *(const u32x4*)(Kg + off); R.v[i] = *(const u32x4*)(Vg + off);
  }
}
template <int DVB>
DI void band_run(const bf16* Kg, const bf16* Vg, int NP, int kbase, int nsteps, int dil, int roff, int qidx, int win,
                 const bf16x8 (&qf)[4], f32x16 (&o)[DVB], float& m, float& l, float c2, bf16* Ks, bf16* Vs, int lane) {
  const int h = lane >> 5;
  KVRegs R; band_load(R, Kg, Vg, NP, kbase, dil, roff, lane);
  for (int j = 0; j < nsteps; ++j) {
    lds_fence();
    kv_store(R, Ks, Vs, lane);
    lds_fence();
    if (j + 1 < nsteps) band_load(R, Kg, Vg, NP, kbase + 32 * (j + 1), dil, roff, lane);
    const int kb = kbase + 32 * j, lo_r = (qidx - win > 0 ? qidx - win : 0) - kb;
    const unsigned vm = lane_rows(row_range_mask(lo_r, qidx - kb), h);
    attn_step32<DVB>(Ks, WP, Vs, WP, qf, o, m, l, vm, c2, lane);
  }
}

DI void write_o64(const f32x16 (&o)[2], float linv, const bf16* gate_row, bf16* y_row, int h) {
#pragma unroll
  for (int d = 0; d < 2; ++d)
#pragma unroll
    for (int g = 0; g < 4; ++g) {
      const int dd = 32 * d + 8 * g + 4 * h;
      const u32x2 gv = *(const u32x2*)(gate_row + dd);
      const float g0 = __uint_as_float(gv.x << 16), g1 = __uint_as_float(gv.x & 0xffff0000u), g2 = __uint_as_float(gv.y << 16), g3 = __uint_as_float(gv.y & 0xffff0000u);
      u32x2 w; w.x = cvtpk(o[d][4 * g] * linv * g0, o[d][4 * g + 1] * linv * g1); w.y = cvtpk(o[d][4 * g + 2] * linv * g2, o[d][4 * g + 3] * linv * g3);
      *(u32x2*)(y_row + dd) = w;
    }
}

DI void load_q(bf16x8 (&qf)[4], const bf16* qrow, int h) {
#pragma unroll
  for (int t = 0; t < 4; ++t) qf[t] = *(const bf16x8*)(qrow + t * 16 + h * 8);
}
template <int DVB> DI void zero_o(f32x16 (&o)[DVB]) {
#pragma unroll
  for (int d = 0; d < DVB; ++d)
#pragma unroll
    for (int i = 0; i < 16; ++i) o[d][i] = 0.f;
}

DI void mixerB_tile(const Params& p, int item, bf16* Ks, bf16* Vs, int lane) {
  const bf16* PE = (const bf16*)(p.ws + WS_PE); bf16* Y = (bf16*)(p.ws + WS_Y);
  const int qblk = item & 255, head = (item >> 8) & 7, b = item >> 11;
  const int r32 = lane & 31, h = lane >> 5, q0 = qblk * 32, kvh = head >> 2;
  const size_t rowb = (size_t)b * SEQ;
  bf16x8 qf[4]; load_q(qf, PE + (rowb + q0 + r32) * NPE + E_BQ + head * 64, h);
  f32x16 o[2]; zero_o<2>(o);
  const float sink2 = p.in[I_B_SINKS][head] * LOG2E;
  float m = sink2, l = (h == 0) ? 1.f : 0.f;
  band_run<2>(PE + rowb * NPE + E_BK + kvh * 64, PE + rowb * NPE + E_BV + kvh * 64, NPE, q0 - 128, 5, 1, 0, q0 + r32, 127, qf, o, m, l, 0.125f * LOG2E, Ks, Vs, lane);
  l += __shfl_xor(l, 32);
  const size_t tok = rowb + q0 + r32;
  write_o64(o, 1.f / l, PE + tok * NPE + E_BG + head * 64, Y + tok * DM + 512 + head * 64, h);
}

DI void mixerC_tile(const Params& p, int item, bf16* Ks, bf16* Vs, int lane) {
  const bf16* PO = (const bf16*)(p.ws + WS_PE); bf16* Y = (bf16*)(p.ws + WS_Y);
  const int qt = item & 15, r16 = (item >> 4) & 15, head = (item >> 8) & 7, b = item >> 11;
  const int r32 = lane & 31, h = lane >> 5, qi0 = qt * 32;
  const size_t rowb = (size_t)b * SEQ;
  const int t = 16 * (qi0 + r32) + r16;
  bf16x8 qf[4]; load_q(qf, PO + (rowb + t) * NPO + O_CQ + head * 64, h);
  f32x16 o[2]; zero_o<2>(o);
  float m = -1e30f, l = 0.f;
  const bf16* Kg = PO + rowb * NPO + O_CK + head * 64; const bf16* Vg = PO + rowb * NPO + O_CV + head * 64;
  const float c2 = 0.125f * LOG2E;
  band_run<2>(Kg, Vg, NPO, qi0 - 128, 5, 16, r16, qi0 + r32, 128, qf, o, m, l, c2, Ks, Vs, lane);
  band_run<2>(Kg, Vg, NPO, 4 * qi0 + (r16 >> 2) - 128, 8, 4, r16 & 3, 4 * (qi0 + r32) + (r16 >> 2), 128, qf, o, m, l, c2, Ks, Vs, lane);
  band_run<2>(Kg, Vg, NPO, 16 * qi0 + r16 - 128, 20, 1, 0, t, 128, qf, o, m, l, c2, Ks, Vs, lane);
  l += __shfl_xor(l, 32);
  const size_t tok = rowb + t;
  write_o64(o, 1.f / l, PO + tok * NPO + O_CG + head * 64, Y + tok * DM + head * 64, h);
}

DI void mixerA_item(const Params& p, int item, bf16* Ks, bf16* Vs, int lane) {
  const bf16* PE = (const bf16*)(p.ws + WS_PE); bf16* Y = (bf16*)(p.ws + WS_Y);
  const unsigned short* SEL = (const unsigned short*)(p.ws + WS_SEL) + (size_t)item * 256;
  const int t = item & (SEQ - 1), b = item >> 13;
  const int r32 = lane & 31, h = lane >> 5, head = r32 & 7;
  const size_t rowb = (size_t)b * SEQ;
  const int count = (t + 1 < 256) ? t + 1 : 256, nsteps = (count + 31) >> 5;
  bf16x8 qf[4]; load_q(qf, PE + (size_t)item * NPE + E_AQ + head * 64, h);
  f32x16 o[2]; zero_o<2>(o);
  float m = -1e30f, l = 0.f;
  const bf16* Kg = PE + rowb * NPE + E_AK; const bf16* Vg = PE + rowb * NPE + E_AV;
  KVRegs R;
  unsigned short* sel_l = (unsigned short*)(Vs + 32 * WP);
  lds_fence();
  *(u32x2*)(sel_l + 4 * lane) = *(const u32x2*)(SEL + 4 * lane);
  lds_fence();
#define A_LOAD(j) do { _Pragma("unroll") for (int i = 0; i < 4; ++i) { const int row = (lane >> 3) + 8 * i, ch = lane & 7, e = 32 * (j) + row; \
      const int tokk = (e < count) ? (int)sel_l[e] : 0; const size_t off = (size_t)tokk * NPE + ch * 8; R.k[i] = *(const u32x4*)(Kg + off); R.v[i] = *(const u32x4*)(Vg + off); } } while (0)
  A_LOAD(0);
  for (int j = 0; j < nsteps; ++j) {
    lds_fence();
    kv_store(R, Ks, Vs, lane);
    lds_fence();
    if (j + 1 < nsteps) A_LOAD(j + 1);
    const unsigned vm = lane_rows(row_range_mask(0, count - 1 - 32 * j), h);
    attn_step32<2>(Ks, WP, Vs, WP, qf, o, m, l, vm, 0.125f * LOG2E, lane);
  }
#undef A_LOAD
  l += __shfl_xor(l, 32);
  if (r32 < 8) write_o64(o, 1.f / l, PE + (size_t)item * NPE + E_AG + head * 64, Y + (size_t)item * DM + head * 64, h);
}

DI unsigned f2ord(float f) { f += 0.f; const unsigned u = __float_as_uint(f); return (u & 0x80000000u) ? ~u : (u | 0x80000000u); }
DI int block_excl_scan(int v, int* tmp, int* tot) {
  const int lane = threadIdx.x & 63, wid = threadIdx.x >> 6;
  int inc = v;
#pragma unroll
  for (int o = 1; o < 64; o <<= 1) { const int u = __shfl_up(inc, o); if (lane >= o) inc += u; }
  if (lane == 63) tmp[wid] = inc;
  __syncthreads();
  int base = 0, total = 0;
#pragma unroll
  for (int w = 0; w < 8; ++w) { const int x = tmp[w]; if (w < wid) base += x; total += x; }
  *tot = total;
  return base + inc - v;
}

DI float dpp_sum8(float v) {
  v += __builtin_bit_cast(float, __builtin_amdgcn_mov_dpp(__builtin_bit_cast(int, v), 0xB1, 0xF, 0xF, true));
  v += __builtin_bit_cast(float, __builtin_amdgcn_mov_dpp(__builtin_bit_cast(int, v), 0x4E, 0xF, 0xF, true));
  v += __builtin_bit_cast(float, __builtin_amdgcn_mov_dpp(__builtin_bit_cast(int, v), 0x141, 0xF, 0xF, true));
  return v;
}
DI void hist_find(const int* hist, int* misc, int need, int& digit, int& nneed, int& cnt) {
  const int tid = threadIdx.x;
  typedef int i32x4 __attribute__((ext_vector_type(4)));
  const i32x4 h0 = *(const i32x4*)(hist + tid * 8), h1 = *(const i32x4*)(hist + tid * 8 + 4);
  int hh[8] = {h0.x, h0.y, h0.z, h0.w, h1.x, h1.y, h1.z, h1.w}; int tot = 0;
#pragma unroll
  for (int k = 0; k < 8; ++k) tot += hh[k];
  int total; const int ex = block_excl_scan(tot, misc, &total);
  int above = total - ex - tot;
#pragma unroll
  for (int k = 7; k >= 0; --k) { const int c = hh[k]; if (above < need && above + c >= need) { misc[16] = tid * 8 + k; misc[17] = need - above; misc[18] = c; } above += c; }
  __syncthreads();
  digit = misc[16]; nneed = misc[17]; cnt = misc[18];
  __syncthreads();
}
DI unsigned long long mkcmp(float v, int idx) { return ((unsigned long long)f2ord(v) << 16) | ((unsigned long long)(8191 - idx) << 3); }
DI float ord2f(unsigned k) { return __uint_as_float((k & 0x80000000u) ? (k ^ 0x80000000u) : ~k); }
DI float half_sum(float v) { auto rr = __builtin_amdgcn_permlane32_swap(__float_as_uint(v), __float_as_uint(v), false, false); return __uint_as_float(rr[0]) + __uint_as_float(rr[1]); }

constexpr int CL_CAP = 512;
DI void select_slow(const float* scq, int n, unsigned short* out, float lo, float hi, int* hist, int* misc, unsigned long long* clist) {
  const int tid = opaque_tid();
    const float scale = (hi > lo) ? 4095.f / (hi - lo) : 0.f;
    for (int i = tid; i < 4096; i += 512) hist[i] = 0;
    if (tid == 0) misc[20] = 0;
    __syncthreads();
    float val[16]; int bin[16];
#pragma unroll
    for (int i = 0; i < 16; ++i) { const int idx = tid + 512 * i; const float v = (idx < n) ? scq[idx] : lo; val[i] = v;
      int bb = (int)((v - lo) * scale); bb = bb < 0 ? 0 : (bb > 4095 ? 4095 : bb); bin[i] = bb; if (idx < n) atomicAdd(&hist[bb], 1); }
    __syncthreads();
    int bstar, need, cnt;
    hist_find(hist, misc, 256, bstar, need, cnt);
    unsigned long long T = 0ull;
    if (cnt != need) {
      if (cnt <= CL_CAP) {
#pragma unroll
        for (int i = 0; i < 16; ++i) { const int idx = tid + 512 * i; if (idx < n && bin[i] == bstar) { const int slot = atomicAdd(&misc[20], 1); clist[slot] = mkcmp(val[i], idx); } }
        __syncthreads();
        if (tid < cnt) { const unsigned long long c = clist[tid]; int rank = 0; for (int jx = 0; jx < cnt; ++jx) rank += (clist[jx] > c) ? 1 : 0;
          if (rank == need - 1) { misc[21] = (int)(unsigned)(c & 0xffffffffull); misc[22] = (int)(unsigned)(c >> 32); } }
        __syncthreads();
        T = ((unsigned long long)(unsigned)misc[22] << 32) | (unsigned long long)(unsigned)misc[21];
      } else {
        unsigned long long prefix = 0ull; int shift = 36;
        for (int pass = 0; pass < 4; ++pass) {
          for (int i = tid; i < 4096; i += 512) hist[i] = 0;
          __syncthreads();
#pragma unroll
          for (int i = 0; i < 16; ++i) { const int idx = tid + 512 * i; if (idx < n && bin[i] == bstar) { const unsigned long long c = mkcmp(val[i], idx); if (pass == 0 || (c >> (shift + 12)) == prefix) atomicAdd(&hist[(int)((c >> shift) & 4095ull)], 1); } }
          __syncthreads();
          int digit, nneed, c2;
          hist_find(hist, misc, need, digit, nneed, c2);
          prefix = (prefix << 12) | (unsigned long long)digit; need = nneed;
          if (c2 == need) break;
          shift -= 12;
        }
        T = prefix << shift;
      }
    }
    int mycnt = 0; unsigned selm = 0;
#pragma unroll
    for (int i = 0; i < 16; ++i) { const int idx = tid + 512 * i;
      bool sel = false;
      if (idx < n) { if (bin[i] > bstar) sel = true; else if (bin[i] == bstar) sel = (mkcmp(val[i], idx) >= T); }
      if (sel) { ++mycnt; selm |= (1u << i); } }
    int total; int pos = block_excl_scan(mycnt, misc + 8, &total);
#pragma unroll
    for (int i = 0; i < 16; ++i) { if ((selm >> i) & 1u) { if (pos < 256) out[pos] = (unsigned short)(tid + 512 * i); ++pos; } }
    __syncthreads();
}

DI void sel_load_qw(const Params& p, int item, bf16x8 (&qf)[4], float (&wq)[16], int lane) {
  const bf16* PE = (const bf16*)(p.ws + WS_PE); const float* IW = (const float*)(p.ws + WS_IW);
  const int r32 = lane & 31, h = lane >> 5, b = item >> 11, t0 = (item & 2047) * 4; const size_t rowb = (size_t)b * SEQ;
  load_q(qf, PE + (rowb + t0 + (r32 >> 3)) * NPE + E_IQ + (r32 & 7) * 64, h);
#pragma unroll
  for (int q = 0; q < 4; ++q) { const f32x4 w4 = *(const f32x4*)(IW + (rowb + t0 + q) * 8 + 4 * h);
    wq[4 * q] = w4.x * 0.04419417382415922f; wq[4 * q + 1] = w4.y * 0.04419417382415922f; wq[4 * q + 2] = w4.z * 0.04419417382415922f; wq[4 * q + 3] = w4.w * 0.04419417382415922f; }
}
DI void selectA_item(const Params& p, int item, int next_item, char* lds, bf16x8 (&qf)[4], float (&wq)[16]) {
  const bf16* PE = (const bf16*)(p.ws + WS_PE);
  const float* IW = (const float*)(p.ws + WS_IW);
  unsigned short* SEL = (unsigned short*)(p.ws + WS_SEL);
  float* sc = (float*)lds;
  int* hist = (int*)(lds + 4 * 8192 * 4);
  int* misc = hist + 4096;
  unsigned* mm = (unsigned*)(misc + 24);
  unsigned long long* clist = (unsigned long long*)(misc + 96);
  const int tid = opaque_tid(), lane = tid & 63, wid = tid >> 6, r32 = lane & 31, h = lane >> 5;
  const int b = item >> 11, t0 = (item & 2047) * 4;
  const size_t rowb = (size_t)b * SEQ;
  const int nk = t0 + 4, ntile = (nk + 31) >> 5;
  const f32x4 pcv = ((const f32x4*)p.in[I_P])[(size_t)item * 512 + tid];
  if (tid < 4) { mm[tid * 2] = 0xFFFFFFFFu; mm[tid * 2 + 1] = 0u; }
  lds_barrier();
  const bf16* Kt = (const bf16*)(p.ws + WS_IKS) + (size_t)b * 256 * 2048 + lane * 8;
  {
    bf16x8 kf[4], kn[4];
#pragma unroll
    for (int t = 0; t < 4; ++t) { kf[t] = (bf16x8){0, 0, 0, 0, 0, 0, 0, 0}; kn[t] = kf[t]; }
    if (wid < ntile) {
#pragma unroll
      for (int t = 0; t < 4; ++t) kf[t] = *(const bf16x8*)(Kt + (size_t)wid * 2048 + t * 512);
    }
    float lo0 = INFINITY, hi0 = -INFINITY, lo1 = INFINITY, hi1 = -INFINITY;
    for (int kt = wid; kt < ntile; kt += 8) {
      if (kt + 8 < ntile) {
#pragma unroll
        for (int t = 0; t < 4; ++t) kn[t] = *(const bf16x8*)(Kt + (size_t)(kt + 8) * 2048 + t * 512);
      }
      f32x16 s;
#pragma unroll
      for (int i = 0; i < 16; ++i) s[i] = 0.f;
#pragma unroll
      for (int t = 0; t < 4; ++t) s = mfma32(qf[t], kf[t], s);
      float v[4];
#pragma unroll
      for (int q = 0; q < 4; ++q) {
        float a = wq[4 * q] * fmaxf(s[4 * q], 0.f);
#pragma unroll
        for (int jj = 1; jj < 4; ++jj) a += wq[4 * q + jj] * fmaxf(s[4 * q + jj], 0.f);
        v[q] = half_sum(a) + 0.f;
      }
      const float va = h ? v[2] : v[0], vb = h ? v[3] : v[1];
      const int key = kt * 32 + r32;
      sc[(2 * h) * 8192 + key] = va; sc[(2 * h + 1) * 8192 + key] = vb;
      lo0 = fminf(lo0, va); hi0 = fmaxf(hi0, va); lo1 = fminf(lo1, vb); hi1 = fmaxf(hi1, vb);
#pragma unroll
      for (int t = 0; t < 4; ++t) kf[t] = kn[t];
    }
    if (wid < ntile) {
#pragma unroll
      for (int o = 1; o < 32; o <<= 1) { lo0 = fminf(lo0, __shfl_xor(lo0, o)); hi0 = fmaxf(hi0, __shfl_xor(hi0, o)); lo1 = fminf(lo1, __shfl_xor(lo1, o)); hi1 = fmaxf(hi1, __shfl_xor(hi1, o)); }
      if (r32 == 0) { atomicMin(&mm[(2 * h) * 2], f2ord(lo0)); atomicMax(&mm[(2 * h) * 2 + 1], f2ord(hi0)); atomicMin(&mm[(2 * h + 1) * 2], f2ord(lo1)); atomicMax(&mm[(2 * h + 1) * 2 + 1], f2ord(hi1)); }
    }
  }
  if (next_item >= 0) sel_load_qw(p, next_item, qf, wq, lane);
  { u32x2 w; w.x = cvtpk(pcv.x, pcv.y); w.y = cvtpk(pcv.z, pcv.w); ((u32x2*)(p.ws + WS_PBF))[(size_t)item * 512 + tid] = w; }
  lds_barrier();
  {
    const int g = wid >> 1, gt = tid & 127, upper = wid & 1;
    const int t = t0 + g, n = t + 1;
    const bool big = n > 256;
    const float* scq = sc + g * 8192;
    unsigned short* out = SEL + (rowb + t) * 256;
    int* histq = hist + g * 1024;
    unsigned long long* clq = clist + g * 128;
    int* mq = misc + 32 + g * 8;
    const float lo = ord2f(mm[g * 2]), hi = ord2f(mm[g * 2 + 1]);
    const float scale = (hi > lo) ? 1023.f / (hi - lo) : 0.f;
    for (int i = gt; i < 1024; i += 128) histq[i] = 0;
    if (gt == 0) { mq[0] = 0; mq[6] = 0; }
    lds_barrier();
    float uu[64];
#pragma unroll
    for (int i = 0; i < 64; ++i) { const int idx = gt + 128 * i; const float v = (idx < n) ? scq[idx] : lo; const float u = (v - lo) * scale; uu[i] = u;
      if (big && idx < n) { int bb = (int)u; bb = bb > 1023 ? 1023 : bb; atomicAdd(&histq[bb], 1); } }
    lds_barrier();
    typedef int i32x4 __attribute__((ext_vector_type(4)));
    const i32x4 h0 = *(const i32x4*)(histq + gt * 8), h1 = *(const i32x4*)(histq + gt * 8 + 4);
    const int hh[8] = {h0.x, h0.y, h0.z, h0.w, h1.x, h1.y, h1.z, h1.w};
    int tot = 0;
#pragma unroll
    for (int k = 0; k < 8; ++k) tot += hh[k];
    int inc = tot;
#pragma unroll
    for (int o = 1; o < 64; o <<= 1) { const int ux = __shfl_down(inc, o); if (lane + o < 64) inc += ux; }
    if (lane == 0) misc[wid] = inc;
    lds_barrier();
    {
      int above = inc - tot + (upper ? 0 : misc[wid + 1]);
      if (big) {
#pragma unroll
        for (int k = 7; k >= 0; --k) { const int c = hh[k]; if (above < 256 && above + c >= 256) { mq[1] = gt * 8 + k; mq[2] = 256 - above; mq[3] = c; } above += c; }
      }
    }
    lds_barrier();
    const int bstar = mq[1], need = mq[2], cnt = mq[3];
    const float flo = (float)bstar, fhi = (bstar >= 1023) ? INFINITY : (float)(bstar + 1);
    const bool tie = big && cnt != need;
    if (tie) {
      if (cnt <= 128) {
#pragma unroll
        for (int i = 0; i < 64; ++i) { const int idx = gt + 128 * i; if (idx < n && uu[i] >= flo && uu[i] < fhi) { const int slot = atomicAdd(&mq[0], 1); clq[slot] = mkcmp(scq[idx], idx); } }
      } else if (gt == 0) mq[6] = 1;
    }
    lds_barrier();
    if (tie && cnt <= 128 && gt < cnt) { const unsigned long long c = clq[gt]; int rank = 0; for (int jx = 0; jx < cnt; ++jx) rank += (clq[jx] > c) ? 1 : 0;
      if (rank == need - 1) { mq[4] = (int)(unsigned)(c & 0xffffffffull); mq[5] = (int)(unsigned)(c >> 32); } }
    lds_barrier();
    const unsigned long long T = tie ? (((unsigned long long)(unsigned)mq[5] << 32) | (unsigned long long)(unsigned)mq[4]) : 0ull;
    const bool fast = big && !(tie && cnt > 128);
    unsigned long long selm = 0ull;
    if (fast) {
#pragma unroll
      for (int i = 0; i < 64; ++i) { const int idx = gt + 128 * i;
        if (idx < n) { const float u = uu[i]; bool sel = u >= fhi; if (!sel && u >= flo) sel = !tie || (mkcmp(scq[idx], idx) >= T); if (sel) selm |= (1ull << i); } }
    }
    const int mycnt = __popcll(selm);
    int pinc = mycnt;
#pragma unroll
    for (int o = 1; o < 64; o <<= 1) { const int ux = __shfl_up(pinc, o); if (lane >= o) pinc += ux; }
    if (lane == 63) misc[8 + wid] = pinc;
    lds_barrier();
    if (fast) {
      int pos = pinc - mycnt + (upper ? misc[8 + wid - 1] : 0);
      while (selm) { const int i = __ffsll((long long)selm) - 1; selm &= selm - 1ull; if (pos < 256) out[pos] = (unsigned short)(gt + 128 * i); ++pos; }
    } else if (!big) {
      for (int i = gt; i < n; i += 128) out[i] = (unsigned short)i;
    }
    lds_barrier();
  }
  for (int q = 0; q < 4; ++q) {
    if (misc[32 + q * 8 + 6]) { const int t = t0 + q; select_slow(sc + q * 8192, t + 1, SEL + (rowb + t) * 256, ord2f(mm[q * 2]), ord2f(mm[q * 2 + 1]), hist, misc, clist); }
  }
  lds_barrier();
}

constexpr int DKP = 72, DVP = 136;
constexpr int D_STAGE = (64 * DKP * 2 + 64 * DVP) * 2;
DI void mixerD_unit(const Params& p, int b, int head, int qb, char* lds) {
  const bf16* PO = (const bf16*)(p.ws + WS_PE); bf16* Y = (bf16*)(p.ws + WS_Y);
  const int tid = opaque_tid(), lane = tid & 63, wid = tid >> 6, r32 = lane & 31, h = lane >> 5;
  const int map = wid & 1, qsub = wid >> 1;
  const size_t rowb = (size_t)b * SEQ;
  const int qpos = 128 * qb + 32 * qsub + r32;
  bf16x8 qf[4]; load_q(qf, PO + (rowb + qpos) * NPO + O_DQ + (2 * head + map) * 64, h);
  f32x16 o[4]; zero_o<4>(o);
  float m = -1e30f, l = 0.f;
  const int nsteps = 2 * qb + 2;
  const bf16* K1g = PO + rowb * NPO + O_DK + (2 * head) * 64;
  const bf16* K2g = K1g + 64;
  const bf16* Vg = PO + rowb * NPO + O_DV + head * 128;
  u32x4 rk1, rk2, rv[2];
#define D_LOAD(j) do { const int row = tid >> 3, ch = tid & 7; const size_t off = (size_t)((j) * 64 + row) * NPO + ch * 8; rk1 = *(const u32x4*)(K1g + off); rk2 = *(const u32x4*)(K2g + off); \
    _Pragma("unroll") for (int i = 0; i < 2; ++i) { const int c = tid + 512 * i, vr = c >> 4, vc = c & 15; rv[i] = *(const u32x4*)(Vg + (size_t)((j) * 64 + vr) * NPO + vc * 8); } } while (0)
  __syncthreads();
  D_LOAD(0);
  for (int j = 0; j < nsteps; ++j) {
    char* st = lds + (j & 1) * D_STAGE;
    bf16* K1s = (bf16*)st; bf16* K2s = K1s + 64 * DKP; bf16* Vs = K2s + 64 * DKP;
    { const int row = tid >> 3, ch = tid & 7; *(u32x4*)(K1s + row * DKP + ch * 8) = rk1; *(u32x4*)(K2s + row * DKP + ch * 8) = rk2;
#pragma unroll
      for (int i = 0; i < 2; ++i) { const int c = tid + 512 * i, vr = c >> 4, vc = c & 15; *(u32x4*)(Vs + vr * DVP + vc * 8) = rv[i]; } }
    __syncthreads();
    if (j + 1 < nsteps) D_LOAD(j + 1);
    const bf16* Ks = map ? K2s : K1s;
#pragma unroll
    for (int sub = 0; sub < 2; ++sub) {
      const int k0 = j * 64 + sub * 32;
      if (k0 <= 128 * qb + 32 * qsub + 31) {
        if (k0 + 31 <= 128 * qb + 32 * qsub) {
          attn_step32<4, false>(Ks + sub * 32 * DKP, DKP, Vs + sub * 32 * DVP, DVP, qf, o, m, l, 0xffffu, 0.125f * LOG2E, lane);
        } else {
          unsigned vm = 0;
#pragma unroll
          for (int i = 0; i < 16; ++i) if (k0 + crow(i, h) <= qpos) vm |= (1u << i);
          attn_step32<4, true>(Ks + sub * 32 * DKP, DKP, Vs + sub * 32 * DVP, DVP, qf, o, m, l, vm, 0.125f * LOG2E, lane);
        }
      }
    }
  }
#undef D_LOAD
  l += __shfl_xor(l, 32);
  const float linv = 1.f / l;
  __syncthreads();
  float* xch = (float*)lds + qsub * 4096;
  if (map == 1) {
#pragma unroll
    for (int d = 0; d < 4; ++d)
#pragma unroll
      for (int i = 0; i < 16; ++i) xch[(d * 16 + i) * 64 + lane] = o[d][i] * linv;
  }
  __syncthreads();
  if (map == 0) {
    const float lam = *(const float*)(p.ws + WS_LAM);
    float ssq = 0.f;
#pragma unroll
    for (int d = 0; d < 4; ++d)
#pragma unroll
      for (int i = 0; i < 16; ++i) { const float a = o[d][i] * linv - lam * xch[(d * 16 + i) * 64 + lane]; o[d][i] = a; ssq += a * a; }
    ssq += __shfl_xor(ssq, 32);
    const float lambda_init = 0.8f - 0.6f * expf(-0.3f);
    const float rn = rsqrtf(ssq * (1.f / 128.f) + EPS) * (1.f - lambda_init);
    const size_t tok = rowb + qpos;
    const bf16* gate = PO + tok * NPO + O_DG + head * 128;
    bf16* y = Y + tok * DM + 512 + head * 128;
    const float* sg = p.in[I_SUB_GAIN];
#pragma unroll
    for (int d = 0; d < 4; ++d)
#pragma unroll
      for (int g = 0; g < 4; ++g) {
        const int dd = 32 * d + 8 * g + 4 * h;
        const u32x2 gv = *(const u32x2*)(gate + dd); const f32x4 s4 = *(const f32x4*)(sg + dd);
        const float g0 = __uint_as_float(gv.x << 16), g1 = __uint_as_float(gv.x & 0xffff0000u), g2 = __uint_as_float(gv.y << 16), g3 = __uint_as_float(gv.y & 0xffff0000u);
        u32x2 w; w.x = cvtpk(o[d][4 * g] * rn * s4.x * g0, o[d][4 * g + 1] * rn * s4.y * g1); w.y = cvtpk(o[d][4 * g + 2] * rn * s4.z * g2, o[d][4 * g + 3] * rn * s4.w * g3);
        *(u32x2*)(y + dd) = w;
      }
  }
  __syncthreads();
}

#define XB_TMO      128
#define XB_XCNT(j)  (256  + 64 * (j))
#define XB_XSUB(j)  (1280 + 64 * (j))
#define XB_XGEN(j)  (2304 + 64 * (j))
#define XB_TOP      3328
#define XB_TOPGEN   3392
#define XCD_BAR_WORDS 3456
#define XB_SPIN_CAP (1u << 18)

__device__ __forceinline__ unsigned xb_ld(unsigned* p)              { return __hip_atomic_load(p, __ATOMIC_RELAXED, __HIP_MEMORY_SCOPE_AGENT); }
__device__ __forceinline__ unsigned xb_add(unsigned* p, unsigned v) { return __hip_atomic_fetch_add(p, v, __ATOMIC_RELAXED, __HIP_MEMORY_SCOPE_AGENT); }
__device__ __forceinline__ unsigned xb_xcc_id() { return (unsigned)__builtin_amdgcn_s_getreg((3 << 11) | 20) & 0xFu; }
#define XB_SPIN(cond, bar) do { unsigned _sp = 0; while (cond) { __builtin_amdgcn_s_sleep(1); \
    if ((++_sp & 255u) == 0u) { if (xb_ld(&(bar)[XB_TMO])) break; if (_sp > XB_SPIN_CAP) { atomicAdd(&(bar)[XB_TMO], 1u); break; } } } } while (0)

struct XcdBarrier {
    unsigned* bar; unsigned x;
    volatile LAS unsigned* st;
};

__device__ __forceinline__ XcdBarrier xcd_barrier_post(unsigned* bar, volatile LAS unsigned* st) {
    XcdBarrier b; b.bar = bar; b.x = xb_xcc_id(); b.st = st;
    if (threadIdx.x == 0) (void)xb_add(&bar[XB_XCNT(b.x)], 1u);
    return b;
}
__device__ __forceinline__ void xcd_barrier_complete(unsigned* bar, unsigned x, unsigned& nloc, unsigned& nx) {
    const unsigned G = gridDim.x * gridDim.y * gridDim.z;
    unsigned sum, cnt, mine, sp = 0u;
    for (;;) {
        sum = 0u; cnt = 0u; mine = 0u;
#pragma unroll
        for (unsigned j = 0; j < 16; ++j) { const unsigned c = xb_ld(&bar[XB_XCNT(j)]); sum += c; cnt += (c > 0u) ? 1u : 0u; mine = (j == x) ? c : mine; }
        if (sum == G) break;
        __builtin_amdgcn_s_sleep(1);
        if ((++sp & 255u) == 0u) { if (xb_ld(&bar[XB_TMO])) break; if (sp > XB_SPIN_CAP) { atomicAdd(&bar[XB_TMO], 1u); break; } }
    }
    nloc = mine > 0u ? mine : 1u; nx = cnt > 0u ? cnt : 1u;
}

__device__ __forceinline__ void xcd_barrier(const XcdBarrier& b) {
    asm volatile("s_waitcnt vmcnt(0)" ::: "memory");
    __syncthreads();
    if (threadIdx.x == 0) {
        unsigned* bar = b.bar;
        __builtin_amdgcn_s_waitcnt(0);
        unsigned nloc = b.st[0], nx = b.st[1];
        if (nloc == 0u) { xcd_barrier_complete(bar, b.x, nloc, nx); b.st[0] = nloc; b.st[1] = nx; }
        const unsigned old = xb_add(&bar[XB_XSUB(b.x)], 1u);
        const unsigned gen = old / nloc;
        if (old + 1u == (gen + 1u) * nloc) {
            __builtin_amdgcn_fence(__ATOMIC_RELEASE, "agent");
            asm volatile("s_waitcnt vmcnt(0)" ::: "memory");
            const unsigned og = xb_add(&bar[XB_TOP], 1u);
            const unsigned tg = og / nx;
            if (og + 1u == (tg + 1u) * nx) xb_add(&bar[XB_TOPGEN], 1u);
            else XB_SPIN(xb_ld(&bar[XB_TOPGEN]) == tg, bar);
            __builtin_amdgcn_fence(__ATOMIC_ACQUIRE, "agent");
            xb_add(&bar[XB_XGEN(b.x)], 1u);
            asm volatile("s_waitcnt vmcnt(0)" ::: "memory");
        } else {
            XB_SPIN(xb_ld(&bar[XB_XGEN(b.x)]) == gen, bar);
            __builtin_amdgcn_fence(__ATOMIC_ACQUIRE, "agent");
            asm volatile("s_waitcnt vmcnt(0)" ::: "memory");
        }
    }
    __syncthreads();
}


__global__ void __launch_bounds__(NTHREADS) fwd_kernel(Params p) {
  extern __shared__ __attribute__((aligned(16))) char smem[];
  cg::grid_group grid = cg::this_grid();
  char* lds = smem;
  volatile LAS unsigned* xb_st = (volatile LAS unsigned*)((LAS char*)smem + (LDS_BYTES - 16));
  if (threadIdx.x < 2) xb_st[threadIdx.x] = 0u;
  __syncthreads();
  const XcdBarrier xbar = xcd_barrier_post((unsigned*)(p.ws + WS_BAR), xb_st);
#define FRESH_IDS const int tid = opaque_tid(), lane = tid & 63, wid = tid >> 6; const int gw = blockIdx.x * 8 + wid, ngw = gridDim.x * 8; bf16* Ks = (bf16*)(lds + wid * WAVE_LDS); bf16* Vs = Ks + 32 * WP; (void)gw; (void)ngw; (void)Ks; (void)Vs; (void)lane;

  phase_prologue(p, lds);
  if (p.ws == nullptr) grid.sync();
  xcd_barrier(xbar);
  for (int rep = 0; rep < REP_GEMM; ++rep) phase_inproj(p, 0, lds);
  xcd_barrier(xbar);
#if EN_A
  for (int rep = 0; rep < REP_SELA; ++rep) { FRESH_IDS
#define SEL_ITEM(k) ((k) * (int)gridDim.x + (((k) & 1) ? (int)gridDim.x - 1 - (int)blockIdx.x : (int)blockIdx.x))
    bf16x8 sqf[4]; float swq[16];
    if (SEL_ITEM(0) < 2 * 2048) sel_load_qw(p, SEL_ITEM(0), sqf, swq, lane);
    for (int k = 0; k * (int)gridDim.x < 2 * 2048; ++k) { const int it = SEL_ITEM(k); int nx = SEL_ITEM(k + 1); if (nx >= 2 * 2048) nx = -1; if (it < 2 * 2048) selectA_item(p, it, nx, lds, sqf, swq); }
#undef SEL_ITEM
  }
  xcd_barrier(xbar);
  { FRESH_IDS for (int rep = 0; rep < REP_AATT; ++rep) for (int it = gw; it < NTOK; it += ngw) mixerA_item(p, it, Ks, Vs, lane); }
#else
  { unsigned* y = (unsigned*)(p.ws + WS_Y); for (int i = blockIdx.x * NTHREADS + (int)threadIdx.x; i < NTOK * 256; i += gridDim.x * NTHREADS) { const int row = i >> 8, c = i & 255; y[row * 512 + c] = 0u; } }
#endif
#if EN_B
  { FRESH_IDS for (int it = gw; it < 4096; it += ngw) mixerB_tile(p, it, Ks, Vs, lane); }
#else
  { unsigned* y = (unsigned*)(p.ws + WS_Y); for (int i = blockIdx.x * NTHREADS + (int)threadIdx.x; i < NTOK * 256; i += gridDim.x * NTHREADS) { const int row = i >> 8, c = i & 255; y[row * 512 + 256 + c] = 0u; } }
#endif
  xcd_barrier(xbar);
  phase_outproj(p, 0, lds);
  xcd_barrier(xbar);
  phase_ple(p, 0, lds);
  xcd_barrier(xbar);
  phase_inproj(p, 1, lds);
  xcd_barrier(xbar);
#if EN_D
  for (int rep = 0; rep < REP_D; ++rep) {
#pragma unroll 1
    for (int u2 = blockIdx.x * 2; u2 < 512; u2 += gridDim.x * 2) {
#pragma unroll 1
      for (int k = 0; k < 2; ++k) { const int u = u2 >> 1, bh = u >> 5, pr = u & 31; mixerD_unit(p, bh >> 2, bh & 3, k ? 63 - pr : pr, lds); }
    }
  }
#else
  { unsigned* y = (unsigned*)(p.ws + WS_Y); for (int i = blockIdx.x * NTHREADS + (int)threadIdx.x; i < NTOK * 256; i += gridDim.x * NTHREADS) { const int row = i >> 8, c = i & 255; y[row * 512 + 256 + c] = 0u; } }
#endif
#if EN_C
  __syncthreads();
  { FRESH_IDS for (int rep = 0; rep < REP_C; ++rep) for (int it = gw; it < 4096; it += ngw) mixerC_tile(p, it, Ks, Vs, lane); }
#else
  { unsigned* y = (unsigned*)(p.ws + WS_Y); for (int i = blockIdx.x * NTHREADS + (int)threadIdx.x; i < NTOK * 256; i += gridDim.x * NTHREADS) { const int row = i >> 8, c = i & 255; y[row * 512 + c] = 0u; } }
#endif
  xcd_barrier(xbar);
  phase_outproj(p, 1, lds);
  xcd_barrier(xbar);
  phase_ple(p, 1, lds);
}

extern "C" void kernel_launch(void* const* d_in, const int* in_sizes, int n_in, void* d_out, int out_size, void* d_ws, size_t ws_size, hipStream_t stream) {
  static int grid_blocks = 0;
  if (!grid_blocks) {
    int dev = 0, cus = 0, per_cu = 0;
    hipGetDevice(&dev);
    hipDeviceGetAttribute(&cus, hipDeviceAttributeMultiprocessorCount, dev);
    hipFuncSetAttribute((const void*)fwd_kernel, hipFuncAttributeMaxDynamicSharedMemorySize, LDS_BYTES);
    hipOccupancyMaxActiveBlocksPerMultiprocessor(&per_cu, (const void*)fwd_kernel, NTHREADS, LDS_BYTES);
    if (per_cu < 1) per_cu = 1;
    grid_blocks = cus * per_cu;
    if (grid_blocks > 256) grid_blocks = 256;
  }
  Params p{};
  for (int i = 0; i < 25; ++i) p.in[i] = (const float*)d_in[i];
  p.out = (float*)d_out; p.ws = (unsigned char*)d_ws;
  for (int i = 0; i < 32; ++i) p.inv_freq[i] = (float)pow(10000.0, -(double)i / 32.0);
  (void)hipMemsetAsync((char*)d_ws + WS_BAR, 0, 16384, stream);
  void* args[] = {&p};
  hipError_t e = hipLaunchCooperativeKernel((const void*)fwd_kernel, dim3(grid_blocks), dim3(NTHREADS), args, LDS_BYTES, stream);
  if (e != hipSuccess) fprintf(stderr, "cooperative launch failed: %s (grid %d)\n", hipGetErrorString(e), grid_blocks);
}
```

```cpp
#include <hip/hip_runtime.h>
#include <hip/hip_cooperative_groups.h>
#include <cstdio>
#include <cmath>
namespace cg = cooperative_groups;

#ifndef REP_GEMM
#define REP_GEMM 1
#endif
#ifndef REP_SELA
#define REP_SELA 1
#endif
#ifndef REP_D
#define REP_D 1
#endif
#ifndef REP_C
#define REP_C 1
#endif
#ifndef REP_AATT
#define REP_AATT 1
#endif
#ifndef EN_A
#define EN_A 1
#endif
#ifndef EN_B
#define EN_B 1
#endif
#ifndef EN_C
#define EN_C 1
#endif
#ifndef EN_D
#define EN_D 1
#endif

typedef unsigned short bf16;
typedef short bf16x8 __attribute__((ext_vector_type(8)));
typedef short s16x4 __attribute__((ext_vector_type(4)));
typedef float f32x4 __attribute__((ext_vector_type(4)));
typedef float f32x16 __attribute__((ext_vector_type(16)));
typedef unsigned u32x4 __attribute__((ext_vector_type(4)));
typedef unsigned u32x2 __attribute__((ext_vector_type(2)));
typedef float f32x2_t __attribute__((ext_vector_type(2)));
typedef __bf16 bf16x2_t __attribute__((ext_vector_type(2)));
#define LAS __attribute__((address_space(3)))
#define DI __device__ __forceinline__

constexpr int SEQ = 8192, NTOK = 16384, DM = 1024;
constexpr int NPE = 3072, NPO = 4096;
constexpr float EPS = 1e-6f;
constexpr float LOG2E = 1.4426950408889634f;
constexpr int NTHREADS = 512;
constexpr int LDS_BYTES = 150 * 1024;

constexpr size_t MiB = 1u << 20;
constexpr size_t WS_PE = 0;
constexpr size_t WS_ACT = 128 * MiB;
constexpr size_t WS_Y = 160 * MiB;
constexpr size_t WS_WINE = 192 * MiB;
constexpr size_t WS_WOUTE = 198 * MiB;
constexpr size_t WS_WINO = 200 * MiB;
constexpr size_t WS_WOUTO = 208 * MiB;
constexpr size_t WS_WG0 = 210 * MiB;
constexpr size_t WS_WG1 = 212 * MiB;
constexpr size_t WS_WP0 = 214 * MiB;
constexpr size_t WS_WP1 = 215 * MiB;
constexpr size_t WS_ROPE = 216 * MiB;
constexpr size_t WS_SEL = 218 * MiB;
constexpr size_t WS_IW = 226 * MiB;
constexpr size_t WS_SS = 227 * MiB;
constexpr size_t WS_LAM = 228 * MiB;
constexpr size_t WS_BAR = 250 * MiB;
constexpr size_t WS_PBF = 232 * MiB;
constexpr size_t WS_IKS = 229 * MiB;

struct Params {
  const float* in[25];
  float* out;
  unsigned char* ws;
  float inv_freq[32];
};
enum { I_X = 0, I_P, I_NORM_GAIN, I_W_IN_EVEN, I_W_OUT_EVEN, I_A_Q_GAIN, I_A_K_GAIN, I_IDX_K_GAIN, I_B_Q_GAIN, I_B_K_GAIN, I_B_SINKS,
       I_W_IN_ODD, I_W_OUT_ODD, I_C_Q_GAIN, I_C_K_GAIN, I_D_Q_GAIN, I_D_K_GAIN, I_LQ1, I_LK1, I_LQ2, I_LK2, I_SUB_GAIN, I_PLE_NORM_GAIN,
       I_W_PLE_GATE, I_W_PLE_PROJ };

DI unsigned cvtpk(float lo, float hi) { f32x2_t v = {lo, hi}; bf16x2_t b = __builtin_convertvector(v, bf16x2_t); return __builtin_bit_cast(unsigned, b); }
DI float bf2f(bf16 b) { return __uint_as_float(((unsigned)b) << 16); }
DI float fexp2(float x) { return __builtin_amdgcn_exp2f(x); }
DI f32x16 mfma32(bf16x8 a, bf16x8 b, f32x16 c) { return __builtin_amdgcn_mfma_f32_32x32x16_bf16(a, b, c, 0, 0, 0); }
DI f32x4 mfma16(bf16x8 a, bf16x8 b, f32x4 c) { return __builtin_amdgcn_mfma_f32_16x16x32_bf16(a, b, c, 0, 0, 0); }
DI int crow(int i, int h) { return (i & 3) + 8 * (i >> 2) + 4 * h; }
DI s16x4 trread(const bf16* p) { return __builtin_bit_cast(s16x4, __builtin_amdgcn_ds_read_tr16_b64_v4i16((LAS s16x4*)p)); }
DI int opaque_tid() { int t = threadIdx.x; asm volatile("" : "+v"(t)); return t; }
DI void lds_barrier() { asm volatile("s_waitcnt lgkmcnt(0)" ::: "memory"); __builtin_amdgcn_s_barrier(); asm volatile("" ::: "memory"); }
DI void lds_fence() { asm volatile("s_waitcnt lgkmcnt(0)" ::: "memory"); __builtin_amdgcn_wave_barrier(); }

__host__ __device__ __forceinline__ int phys_col(int n) { return (n & ~255) + 128 * ((n >> 5) & 1) + 32 * ((n >> 6) & 3) + (n & 31); }
DI int map_even(int n) { return n < 1216 ? n : (n < 1224 ? 3008 + (n - 1216) : n - 8); }
DI void transpose_tile(const float* W, int K, int N, bf16* WT, int mapmode, int tile, float* scr) {
  const int tid = opaque_tid();
  const int ntn = (N + 63) >> 6, kt = tile / ntn, nt = tile % ntn, k0 = kt * 64, n0 = nt * 64;
#pragma unroll
  for (int i = 0; i < 8; ++i) {
    const int kk = (tid >> 6) + 8 * i, nn = tid & 63, n = n0 + nn;
    scr[kk * 65 + nn] = (n < N) ? W[(size_t)(k0 + kk) * N + n] : 0.f;
  }
  __syncthreads();
  {
    const int nn = tid >> 3, kc = tid & 7, n = n0 + nn;
    if (n < N) {
      const int dst = mapmode == 1 ? phys_col(map_even(n)) : (mapmode == 2 ? phys_col(n) : n);
      const float* s = scr + (kc * 8) * 65 + nn;
      u32x4 o; o.x = cvtpk(s[0], s[65]); o.y = cvtpk(s[2 * 65], s[3 * 65]); o.z = cvtpk(s[4 * 65], s[5 * 65]); o.w = cvtpk(s[6 * 65], s[7 * 65]);
      *(u32x4*)(WT + (size_t)dst * K + k0 + kc * 8) = o;
    }
  }
  __syncthreads();
}

DI float wave_sum(float v) {
#pragma unroll
  for (int o = 1; o < 64; o <<= 1) v += __shfl_xor(v, o);
  return v;
}

DI void phase_prologue(const Params& p, char* lds) {
  const int tid = opaque_tid(), lane = tid & 63, wid = tid >> 6;
  const int nb = gridDim.x, bid = blockIdx.x;
  unsigned char* ws = p.ws;
  float* scr = (float*)lds;
  const int T0 = 16 * 48, T1 = 256, T2 = 16 * 64, T3 = 256, T4 = 256, T5 = 256, T6 = 64, T7 = 64;
  const int NT = T0 + T1 + T2 + T3 + T4 + T5 + T6 + T7;
  for (int it = bid; it < NT; it += nb) {
    int r = it;
    if (r < T0) { transpose_tile(p.in[I_W_IN_EVEN], 1024, 3016, (bf16*)(ws + WS_WINE), 1, r, scr); continue; } r -= T0;
    if (r < T1) { transpose_tile(p.in[I_W_OUT_EVEN], 1024, 1024, (bf16*)(ws + WS_WOUTE), 0, r, scr); continue; } r -= T1;
    if (r < T2) { transpose_tile(p.in[I_W_IN_ODD], 1024, 4096, (bf16*)(ws + WS_WINO), 2, r, scr); continue; } r -= T2;
    if (r < T3) { transpose_tile(p.in[I_W_OUT_ODD], 1024, 1024, (bf16*)(ws + WS_WOUTO), 0, r, scr); continue; } r -= T3;
    if (r < T4) { transpose_tile(p.in[I_W_PLE_GATE], 1024, 1024, (bf16*)(ws + WS_WG0), 0, r, scr); continue; } r -= T4;
    if (r < T5) { transpose_tile(p.in[I_W_PLE_GATE] + 1024 * 1024, 1024, 1024, (bf16*)(ws + WS_WG1), 0, r, scr); continue; } r -= T5;
    if (r < T6) { transpose_tile(p.in[I_W_PLE_PROJ], 256, 1024, (bf16*)(ws + WS_WP0), 0, r, scr); continue; } r -= T6;
    transpose_tile(p.in[I_W_PLE_PROJ] + 256 * 1024, 256, 1024, (bf16*)(ws + WS_WP1), 0, r, scr);
  }
  const int gt = bid * NTHREADS + tid, ngt = nb * NTHREADS;
  { unsigned* z = (unsigned*)(ws + WS_WINE); for (int i = gt; i < 56 * 512; i += ngt) z[(size_t)phys_col(3016 + (i >> 9)) * 512 + (i & 511)] = 0u; }
  { float* ss = (float*)(ws + WS_SS); for (int i = gt; i < 3 * NTOK; i += ngt) ss[i] = 0.f; }
  { float2* tab = (float2*)(ws + WS_ROPE);
    for (int i = gt; i < SEQ * 32; i += ngt) {
      const int pos = i >> 5, k = i & 31;
      const float ang = (float)pos * p.inv_freq[k];
      double rev = (double)ang * 0.15915494309189535; rev -= floor(rev);
      const float rf = (float)rev;
      tab[i] = make_float2(__builtin_amdgcn_cosf(rf), __builtin_amdgcn_sinf(rf));
    } }
  if (bid == 0 && wid == 0) {
    const float a = wave_sum(p.in[I_LQ1][lane] * p.in[I_LK1][lane]);
    const float b = wave_sum(p.in[I_LQ2][lane] * p.in[I_LK2][lane]);
    const float lambda_init = 0.8f - 0.6f * expf(-0.3f);
    if (lane == 0) *(float*)(ws + WS_LAM) = expf(a) - expf(b) + lambda_init;
  }
  { const float* x = p.in[I_X]; const float* g = p.in[I_NORM_GAIN]; bf16* H = (bf16*)(ws + WS_ACT);
    const int gw = bid * 8 + wid, ngw = nb * 8;
    for (int m = gw; m < NTOK; m += ngw) {
      const f32x4* xr = (const f32x4*)(x + (size_t)m * DM) + lane;
      f32x4 v[4]; float s = 0.f;
#pragma unroll
      for (int j = 0; j < 4; ++j) { v[j] = xr[64 * j]; s += v[j].x * v[j].x + v[j].y * v[j].y + v[j].z * v[j].z + v[j].w * v[j].w; }
      const float rstd = rsqrtf(wave_sum(s) * (1.f / DM) + EPS);
      u32x2* o = (u32x2*)(H + (size_t)m * DM) + lane;
#pragma unroll
      for (int j = 0; j < 4; ++j) { const f32x4 gg = *((const f32x4*)g + lane + 64 * j); u32x2 w; w.x = cvtpk(v[j].x * rstd * gg.x, v[j].y * rstd * gg.y); w.y = cvtpk(v[j].z * rstd * gg.z, v[j].w * rstd * gg.w); o[64 * j] = w; }
    } }
}

namespace pg8 {
#define PG8_LAS __attribute__((address_space(3)))
typedef unsigned short bf16_t;
typedef short bf16x8 __attribute__((ext_vector_type(8)));
typedef float f32x4 __attribute__((ext_vector_type(4)));
typedef unsigned u32x4 __attribute__((ext_vector_type(4)));
constexpr int BM = 256, BK = 64, HALF = 128, HTB = HALF * BK * 2  , STAGE_BYTES = 8 * HTB, NXCD = 8, WGM = 8;

__host__ __device__ __forceinline__ int lds_byte(int r, int c) { const int st = (r >> 4) * 2 + (c >> 5), rr = r & 15, cc = c & 31, ob = rr * 64 + cc * 2; return st * 1024 + (ob ^ (((ob >> 9) & 1) << 5)); }
__host__ __device__ __forceinline__ void stage_rc(int b, int& R, int& C) { const int st = b / 1024, sb = b % 1024, swz = sb ^ (((sb >> 9) & 1) << 5); R = (st >> 1) * 16 + swz / 64; C = (st & 1) * 32 + (swz % 64) / 2; }
__host__ __device__ __forceinline__ int perm32(int rho) { const int n = rho >> 4, i = rho & 15; return 8 * (i >> 2) + 4 * n + (i & 3); }

struct Unit { int pm, pn; };
struct Gemm { const bf16_t* A; const bf16_t* Bt; int M, N, K; };

struct StaticOrder {
    int nM, nN, nwg, G, c;
    __host__ __device__ void init(int M, int N, int G_, int c_) { nM = M / BM; nN = N / BM; nwg = nM * nN; G = G_; c = c_; }
    __host__ __device__ bool next(int i, Unit& u) const {
        const long L = (long)i * G + c; if (L >= nwg) return false;
        int wgid = (int)L; { const int q = nwg / NXCD, r = nwg % NXCD, xcd = wgid % NXCD, off = wgid / NXCD; wgid = (xcd < r ? xcd * (q + 1) : r * (q + 1) + (xcd - r) * q) + off; }
        const int nig = WGM * nN, gid = wgid / nig, fm = gid * WGM, gsz = (nM - fm) < WGM ? (nM - fm) : WGM;
        u.pm = fm + ((wgid % nig) % gsz); u.pn = (wgid % nig) / gsz; return true;
    }
    __device__ __forceinline__ void a_ready(const Unit&) const {}
    __device__ __forceinline__ void done(const Unit&) const {}
};
__device__ __forceinline__ unsigned cvt_pk_bf16(float lo, float hi) { unsigned r; asm volatile("v_cvt_pk_bf16_f32 %0, %1, %2" : "=v"(r) : "v"(lo), "v"(hi)); return r; }
template <class Epi, class Sched, bool ALIGN_EPI = false, bool SP2 = false>
__device__ __forceinline__ void gemm_phase(PG8_LAS unsigned char* lds, const Gemm g, const Sched& S, const Epi& E) {
    int tid_ = threadIdx.x; asm volatile("" : "+v"(tid_));
    const int tid = tid_, wid = __builtin_amdgcn_readfirstlane(tid >> 6), lane = tid & 63, wr = wid >> 2, wc = wid & 3, fr = lane & 15, fq = lane >> 4;
    const int K = g.K, nt = K / BK;
    unsigned voffA[2], voffB[2];
#pragma unroll
    for (int i = 0; i < 2; ++i) { int R, C; stage_rc(tid * 16 + i * 8192, R, C); const int Rb = Epi::PERM ? ((R & ~31) + perm32(R & 31)) : R;
        voffA[i] = (unsigned)(R * K + C) * 2u; voffB[i] = (unsigned)(Rb * K + C) * 2u; }
    const size_t kstep = (size_t)(BK * 2);
    const size_t hstep = (size_t)HALF * K * 2;
    const size_t tstep = 2 * hstep;
    const unsigned ldsw = (unsigned)wid * 1024u;
    const int aoff = lds_byte(wr * 64 + fr, fq * 8), boff = lds_byte(wc * 32 + fr, fq * 8);
#define PG8_SA(b, h) (((b) * 2 + (h)) * HTB)
#define PG8_SB(b, h) ((4 + (b) * 2 + (h)) * HTB)
#define PG8_STAGE(bufoff, gbase, voff) do { _Pragma("unroll") for (int _i = 0; _i < 2; ++_i) \
        __builtin_amdgcn_global_load_lds((const unsigned*)((const char*)(gbase) + (voff)[_i]), (PG8_LAS unsigned*)(lds + (bufoff) + ldsw + _i * 8192), 16, 0, 0); } while (0)
#define PG8_LDA(dst, b, h) do { _Pragma("unroll") for (int m = 0; m < 4; ++m) _Pragma("unroll") for (int k = 0; k < 2; ++k) dst[m][k] = *(const PG8_LAS bf16x8*)(lds + PG8_SA(b, h) + aoff + m * 2048 + k * 1024); } while (0)
#define PG8_LDB(dst, b, h) do { _Pragma("unroll") for (int n = 0; n < 2; ++n) _Pragma("unroll") for (int k = 0; k < 2; ++k) dst[n][k] = *(const PG8_LAS bf16x8*)(lds + PG8_SB(b, h) + boff + n * 2048 + k * 1024); } while (0)
#define PG8_MMA(ai, bj, At, Bt) do { __builtin_amdgcn_s_setprio(1); _Pragma("unroll") for (int m = 0; m < 4; ++m) _Pragma("unroll") for (int n = 0; n < 2; ++n) _Pragma("unroll") for (int k = 0; k < 2; ++k) \
        acc[ai][bj][m][n] = __builtin_amdgcn_mfma_f32_16x16x32_bf16(Bt[n][k], At[m][k], acc[ai][bj][m][n], 0, 0, 0); __builtin_amdgcn_s_setprio(0); } while (0)
#define PG8_WAIT_V(n) asm volatile("s_waitcnt vmcnt(" #n ")" ::: "memory")
#define PG8_WAIT_L(n) asm volatile("s_waitcnt lgkmcnt(" #n ")" ::: "memory")
#define PG8_BAR __builtin_amdgcn_s_barrier()
#define PG8_SCHED __builtin_amdgcn_sched_barrier(0)
    Unit cur, nxt; int ui = 0;
    if (!S.next(0, cur)) return;
    f32x4 acc[2][2][4][2];
#pragma unroll
    for (int a = 0; a < 2; ++a)
#pragma unroll
        for (int b = 0; b < 2; ++b)
#pragma unroll
            for (int m = 0; m < 4; ++m)
#pragma unroll
                for (int n = 0; n < 2; ++n) acc[a][b][m][n] = (f32x4){0.f, 0.f, 0.f, 0.f};
    bf16x8 At[4][2], B0[2][2], B1[2][2];
    const char* cA = (const char*)g.A + (size_t)cur.pm * tstep; const char* cB = (const char*)g.Bt + (size_t)cur.pn * tstep;
    S.a_ready(cur);
    if constexpr (SP2) {
        PG8_STAGE(PG8_SB(0, 0), cB, voffB); PG8_STAGE(PG8_SB(0, 1), cB + hstep, voffB); PG8_STAGE(PG8_SA(0, 0), cA, voffA); PG8_STAGE(PG8_SA(0, 1), cA + hstep, voffA);
        if (wr == 1) PG8_BAR;
        PG8_WAIT_V(2); PG8_BAR;
        PG8_STAGE(PG8_SB(1, 0), cB + kstep, voffB); PG8_STAGE(PG8_SA(1, 0), cA + kstep, voffA); PG8_STAGE(PG8_SB(1, 1), cB + hstep + kstep, voffB);
        PG8_WAIT_V(6); PG8_BAR;
    } else {
        PG8_STAGE(PG8_SB(0, 0), cB, voffB); PG8_STAGE(PG8_SA(0, 0), cA, voffA); PG8_STAGE(PG8_SB(0, 1), cB + hstep, voffB); PG8_STAGE(PG8_SA(0, 1), cA + hstep, voffA);
        if (wr == 1) PG8_BAR;
        PG8_WAIT_V(4); PG8_BAR;
        PG8_STAGE(PG8_SB(1, 0), cB + kstep, voffB); PG8_STAGE(PG8_SA(1, 0), cA + kstep, voffA); PG8_STAGE(PG8_SB(1, 1), cB + hstep + kstep, voffB);
        PG8_WAIT_V(6); PG8_BAR;
    }
    for (;;) {
        const bool has_next = S.next(ui + 1, nxt);
        const char* nA = has_next ? (const char*)g.A + (size_t)nxt.pm * tstep : cA; const char* nB = has_next ? (const char*)g.Bt + (size_t)nxt.pn * tstep : cB;
        for (int t = 0; t < nt; t += 2) {
            const bool last = (t == nt - 2);
            const char* a1 = cA + (size_t)(t + 1) * kstep;
            const char* a2 = last ? nA : cA + (size_t)(t + 2) * kstep; const char* b2 = last ? nB : cB + (size_t)(t + 2) * kstep;
            const char* a3 = a2 + kstep; const char* b3 = b2 + kstep;
            if (last && has_next) S.a_ready(nxt);
            if constexpr (SP2) {
            PG8_LDB(B0, 0, 0); PG8_LDB(B1, 0, 1); PG8_SCHED; PG8_LDA(At, 0, 0); PG8_STAGE(PG8_SA(1, 1), a1 + hstep, voffA);
            PG8_WAIT_V(8); PG8_WAIT_L(0); PG8_BAR; PG8_MMA(0, 0, At, B0); PG8_MMA(0, 1, At, B1); PG8_BAR; PG8_SCHED;
            PG8_LDA(At, 0, 1); PG8_STAGE(PG8_SB(0, 0), b2, voffB); PG8_STAGE(PG8_SB(0, 1), b2 + hstep, voffB); PG8_STAGE(PG8_SA(0, 0), a2, voffA);
            PG8_WAIT_V(8); PG8_WAIT_L(0); PG8_BAR; PG8_MMA(1, 0, At, B0); PG8_MMA(1, 1, At, B1); PG8_BAR; PG8_SCHED;
            PG8_LDB(B0, 1, 0); PG8_LDB(B1, 1, 1); PG8_SCHED; PG8_LDA(At, 1, 0); PG8_STAGE(PG8_SA(0, 1), a2 + hstep, voffA);
            PG8_WAIT_V(8); PG8_WAIT_L(0); PG8_BAR; PG8_MMA(0, 0, At, B0); PG8_MMA(0, 1, At, B1); PG8_BAR; PG8_SCHED;
            PG8_LDA(At, 1, 1); PG8_STAGE(PG8_SB(1, 0), b3, voffB); PG8_STAGE(PG8_SB(1, 1), b3 + hstep, voffB); PG8_STAGE(PG8_SA(1, 0), a3, voffA);
            PG8_WAIT_V(8); PG8_WAIT_L(0); PG8_BAR; PG8_MMA(1, 0, At, B0); PG8_MMA(1, 1, At, B1); PG8_BAR; PG8_SCHED;
            } else {
            PG8_LDB(B0, 0, 0); PG8_SCHED; PG8_LDA(At, 0, 0); PG8_STAGE(PG8_SA(1, 1), a1 + hstep, voffA);
            PG8_WAIT_L(8); PG8_BAR; PG8_WAIT_L(0); PG8_MMA(0, 0, At, B0); PG8_BAR; PG8_SCHED;
            PG8_LDB(B1, 0, 1); PG8_STAGE(PG8_SB(0, 0), b2, voffB);
            PG8_BAR; PG8_WAIT_L(0); PG8_MMA(0, 1, At, B1); PG8_BAR;
            PG8_LDA(At, 0, 1); PG8_STAGE(PG8_SA(0, 0), a2, voffA);
            PG8_BAR; PG8_WAIT_L(0); PG8_MMA(1, 0, At, B0); PG8_BAR; PG8_SCHED;
            PG8_STAGE(PG8_SB(0, 1), b2 + hstep, voffB);
            PG8_WAIT_V(6); PG8_BAR; PG8_MMA(1, 1, At, B1); PG8_BAR;
            PG8_LDB(B0, 1, 0); PG8_SCHED; PG8_LDA(At, 1, 0); PG8_STAGE(PG8_SA(0, 1), a2 + hstep, voffA);
            PG8_WAIT_L(8); PG8_BAR; PG8_WAIT_L(0); PG8_MMA(0, 0, At, B0); PG8_BAR; PG8_SCHED;
            PG8_LDB(B1, 1, 1); PG8_STAGE(PG8_SB(1, 0), b3, voffB);
            PG8_BAR; PG8_WAIT_L(0); PG8_MMA(0, 1, At, B1); PG8_BAR;
            PG8_LDA(At, 1, 1); PG8_STAGE(PG8_SA(1, 0), a3, voffA);
            PG8_BAR; PG8_WAIT_L(0); PG8_MMA(1, 0, At, B0); PG8_BAR; PG8_SCHED;
            PG8_STAGE(PG8_SB(1, 1), b3 + hstep, voffB);
            PG8_WAIT_V(6); PG8_BAR; PG8_MMA(1, 1, At, B1); PG8_BAR;
            }
        }
        if constexpr (ALIGN_EPI) { if (wr == 0) PG8_BAR; }
        if constexpr (!Epi::AFTER_DRAIN) { E(acc, cur, wr, wc, fr, fq); S.done(cur); }
        if (!has_next) break;
#pragma unroll
        for (int a = 0; a < 2; ++a)
#pragma unroll
            for (int b = 0; b < 2; ++b)
#pragma unroll
                for (int m = 0; m < 4; ++m)
#pragma unroll
                    for (int n = 0; n < 2; ++n) acc[a][b][m][n] = (f32x4){0.f, 0.f, 0.f, 0.f};
        cur = nxt; cA = nA; cB = nB; ++ui;
        if constexpr (ALIGN_EPI) { if (wr == 1) PG8_BAR; }
    }
    PG8_WAIT_V(0);
    if constexpr (!ALIGN_EPI) { if (wr == 0) PG8_BAR; }
    PG8_BAR;
    if constexpr (Epi::AFTER_DRAIN) { E.fused(acc, cur, wr, wc, fr, fq, lds, wid, lane); S.done(cur); }
#undef PG8_SA
#undef PG8_SB
#undef PG8_STAGE
#undef PG8_LDA
#undef PG8_LDB
#undef PG8_MMA
#undef PG8_WAIT_V
#undef PG8_WAIT_L
#undef PG8_BAR
#undef PG8_SCHED
}
}

enum { T_PLAIN = 0, T_NR = 1, T_ROPE = 2, T_SILU = 3, T_IW = 4 };
DI void slot_info(const Params& p, int layer, int slot, int& type, const float*& gain) {
  gain = nullptr;
  if (layer == 0) {
    if (slot < 8) { type = T_NR; gain = p.in[I_A_Q_GAIN]; }
    else if (slot == 8) { type = T_NR; gain = p.in[I_A_K_GAIN]; }
    else if (slot == 9) type = T_PLAIN;
    else if (slot < 18) type = T_ROPE;
    else if (slot == 18) { type = T_NR; gain = p.in[I_IDX_K_GAIN]; }
    else if (slot < 27) type = T_SILU;
    else if (slot < 35) { type = T_NR; gain = p.in[I_B_Q_GAIN]; }
    else if (slot < 37) { type = T_NR; gain = p.in[I_B_K_GAIN]; }
    else if (slot < 39) type = T_PLAIN;
    else if (slot < 47) type = T_SILU;
    else type = T_IW;
  } else {
    if (slot < 8) { type = T_NR; gain = p.in[I_C_Q_GAIN]; }
    else if (slot < 16) { type = T_NR; gain = p.in[I_C_K_GAIN]; }
    else if (slot < 24) type = T_PLAIN;
    else if (slot < 32) type = T_SILU;
    else if (slot < 40) { type = T_NR; gain = p.in[I_D_Q_GAIN]; }
    else if (slot < 48) { type = T_NR; gain = p.in[I_D_K_GAIN]; }
    else if (slot < 56) type = T_PLAIN;
    else type = T_SILU;
  }
}
constexpr int E_AQ = 0, E_AK = 512, E_AV = 576, E_IQ = 640, E_IK = 1152, E_AG = 1216, E_BQ = 1728, E_BK = 2240, E_BV = 2368, E_BG = 2496;
constexpr int O_CQ = 0, O_CK = 512, O_CV = 1024, O_CG = 1536, O_DQ = 2048, O_DK = 2560, O_DV = 3072, O_DG = 3584;

typedef pg8::f32x4 (AccT)[2][2][4][2];

struct EpiInProj {
  static constexpr bool PERM = false, AFTER_DRAIN = false;
  const Params& p; int layer;
  DI void operator()(const f32x4 (&acc)[2][2][4][2], const pg8::Unit& u, int wr, int wc, int fr, int fq) const {
    unsigned char* ws = p.ws;
    const int NP = layer == 0 ? NPE : NPO;
    bf16* PE = (bf16*)(ws + WS_PE);
    const float2* rope = (const float2*)(ws + WS_ROPE);
    const float* ss1 = (const float*)(ws + WS_SS);
    float* IW = (float*)(ws + WS_IW);
    const int slot = u.pn * 4 + wc;
    int type; const float* gain; slot_info(p, layer, slot, type, gain);
#pragma unroll
    for (int ai = 0; ai < 2; ++ai)
#pragma unroll
      for (int m = 0; m < 4; ++m) {
        const int row = u.pm * 256 + ai * 128 + wr * 64 + m * 16 + fr, pos = row & (SEQ - 1);
        float sc = 1.f;
        if (layer == 1) sc = rsqrtf(ss1[row] * (1.f / DM) + EPS);
        f32x4 v1[2], v2[2];
#pragma unroll
        for (int n = 0; n < 2; ++n) { v1[n] = acc[ai][0][m][n] * sc; v2[n] = acc[ai][1][m][n] * sc; }
        if (type == T_NR) {
          float s = 0.f;
#pragma unroll
          for (int n = 0; n < 2; ++n) s += v1[n].x * v1[n].x + v1[n].y * v1[n].y + v1[n].z * v1[n].z + v1[n].w * v1[n].w + v2[n].x * v2[n].x + v2[n].y * v2[n].y + v2[n].z * v2[n].z + v2[n].w * v2[n].w;
          s += __shfl_xor(s, 16); s += __shfl_xor(s, 32);
          const float rn = rsqrtf(s * (1.f / 64.f) + EPS);
#pragma unroll
          for (int n = 0; n < 2; ++n) { const f32x4 g1 = *(const f32x4*)(gain + n * 16 + fq * 4), g2 = *(const f32x4*)(gain + 32 + n * 16 + fq * 4); v1[n] = v1[n] * rn * g1; v2[n] = v2[n] * rn * g2; }
        }
        if (type == T_NR || type == T_ROPE) {
#pragma unroll
          for (int n = 0; n < 2; ++n) {
            const f32x4* cs = (const f32x4*)(rope + (size_t)pos * 32 + n * 16 + fq * 4);
            const f32x4 c01 = cs[0], c23 = cs[1];
            const f32x4 x1 = v1[n], x2 = v2[n];
            f32x4 o1, o2;
            o1.x = x1.x * c01.x - x2.x * c01.y; o2.x = x2.x * c01.x + x1.x * c01.y;
            o1.y = x1.y * c01.z - x2.y * c01.w; o2.y = x2.y * c01.z + x1.y * c01.w;
            o1.z = x1.z * c23.x - x2.z * c23.y; o2.z = x2.z * c23.x + x1.z * c23.y;
            o1.w = x1.w * c23.z - x2.w * c23.w; o2.w = x2.w * c23.z + x1.w * c23.w;
            v1[n] = o1; v2[n] = o2;
          }
        }
        if (type == T_SILU) {
#pragma unroll
          for (int n = 0; n < 2; ++n)
#pragma unroll
            for (int j = 0; j < 4; ++j) { const float a = v1[n][j]; v1[n][j] = a / (1.f + __expf(-a)); const float b = v2[n][j]; v2[n][j] = b / (1.f + __expf(-b)); }
        }
        if (type == T_IW) {
          if (fq < 2) *(f32x4*)(IW + (size_t)row * 8 + fq * 4) = v1[0];
        } else {
          bf16* dst = PE + (size_t)row * NP + slot * 64 + fq * 4;
#pragma unroll
          for (int n = 0; n < 2; ++n) {
            u32x2 w1, w2; w1.x = cvtpk(v1[n].x, v1[n].y); w1.y = cvtpk(v1[n].z, v1[n].w); w2.x = cvtpk(v2[n].x, v2[n].y); w2.y = cvtpk(v2[n].z, v2[n].w);
            *(u32x2*)(dst + n * 16) = w1; *(u32x2*)(dst + 32 + n * 16) = w2;
            if (layer == 0 && slot == 18) { bf16* IKS = (bf16*)(ws + WS_IKS); const int key = row & (SEQ - 1);
              bf16* base = IKS + (((size_t)(row >> 13) * 256 + (key >> 5)) * 4) * 512 + ((fq >> 1) * 32 + (key & 31)) * 8 + (fq & 1) * 4;
              *(u32x2*)(base + (size_t)n * 512) = w1; *(u32x2*)(base + (size_t)(n + 2) * 512) = w2; }
          }
        }
        asm volatile("" ::: "memory");
      }
  }
};

DI void phase_inproj(const Params& p, int layer, char* lds) {
  unsigned char* ws = p.ws;
  const int NP = layer == 0 ? NPE : NPO;
  pg8::Gemm g{(const bf16*)(ws + (layer == 0 ? WS_ACT : WS_Y)), (const bf16*)(ws + (layer == 0 ? WS_WINE : WS_WINO)), NTOK, NP, DM};
  pg8::StaticOrder S; S.init(NTOK, NP, (int)gridDim.x, (int)blockIdx.x);
  EpiInProj E{p, layer};
  pg8::gemm_phase<EpiInProj, pg8::StaticOrder, true, true>((PG8_LAS unsigned char*)lds, g, S, E);
}

struct EpiOutProj {
  static constexpr bool PERM = false, AFTER_DRAIN = false;
  const float* xin; bf16* X1B; bf16* XG; const float* pg; float* ss;
  DI void operator()(const f32x4 (&acc)[2][2][4][2], const pg8::Unit& u, int wr, int wc, int fr, int fq) const {
#pragma unroll
    for (int ai = 0; ai < 2; ++ai)
#pragma unroll
      for (int m = 0; m < 4; ++m) {
        const int row = u.pm * 256 + ai * 128 + wr * 64 + m * 16 + fr; float rs = 0.f;
#pragma unroll
        for (int bj = 0; bj < 2; ++bj)
#pragma unroll
          for (int n = 0; n < 2; ++n) {
            const int col = u.pn * 256 + bj * 128 + wc * 32 + n * 16 + fq * 4; const size_t off = (size_t)row * DM + col;
            const f32x4 xn = *(const f32x4*)(xin + off) + acc[ai][bj][m][n];
            { u32x2 wx; wx.x = cvtpk(xn.x, xn.y); wx.y = cvtpk(xn.z, xn.w); *(u32x2*)(X1B + off) = wx; }
            rs += xn.x * xn.x + xn.y * xn.y + xn.z * xn.z + xn.w * xn.w;
            const f32x4 gg = *(const f32x4*)(pg + col);
            u32x2 w; w.x = cvtpk(xn.x * gg.x, xn.y * gg.y); w.y = cvtpk(xn.z * gg.z, xn.w * gg.w); *(u32x2*)(XG + off) = w;
          }
        rs += __shfl_xor(rs, 16); rs += __shfl_xor(rs, 32);
        if (fq == 0) atomicAdd(ss + row, rs);
        asm volatile("" ::: "memory");
      }
  }
};
DI void phase_outproj(const Params& p, int layer, char* lds) {
  unsigned char* ws = p.ws;
  pg8::Gemm g{(const bf16*)(ws + WS_Y), (const bf16*)(ws + (layer == 0 ? WS_WOUTE : WS_WOUTO)), NTOK, DM, DM};
  pg8::StaticOrder S; S.init(NTOK, DM, (int)gridDim.x, (int)blockIdx.x);
  EpiOutProj E{layer == 0 ? p.in[I_X] : p.out, (bf16*)(ws + WS_PE + 64 * MiB), (bf16*)(ws + WS_ACT), p.in[I_PLE_NORM_GAIN] + layer * DM, (float*)(ws + WS_SS) + (layer == 0 ? 1 : 2) * NTOK};
  pg8::gemm_phase<EpiOutProj, pg8::StaticOrder, true, true>((PG8_LAS unsigned char*)lds, g, S, E);
}

struct EpiPleProj {
  static constexpr bool PERM = false, AFTER_DRAIN = false;
  bf16* PT;
  DI void operator()(const f32x4 (&acc)[2][2][4][2], const pg8::Unit& u, int wr, int wc, int fr, int fq) const {
#pragma unroll
    for (int ai = 0; ai < 2; ++ai)
#pragma unroll
      for (int m = 0; m < 4; ++m) {
        const int row = u.pm * 256 + ai * 128 + wr * 64 + m * 16 + fr;
#pragma unroll
        for (int bj = 0; bj < 2; ++bj)
#pragma unroll
          for (int n = 0; n < 2; ++n) { const f32x4 a = acc[ai][bj][m][n]; u32x2 w; w.x = cvtpk(a.x, a.y); w.y = cvtpk(a.z, a.w); *(u32x2*)(PT + (size_t)row * DM + u.pn * 256 + bj * 128 + wc * 32 + n * 16 + fq * 4) = w; }
      }
  }
};
struct EpiPleGate {
  static constexpr bool PERM = false, AFTER_DRAIN = false;
  const bf16* PT; const bf16* X1B; float* out; const float* ssx; float* ss1; bf16* H; const float* ng1; int layer;
  DI void operator()(const f32x4 (&acc)[2][2][4][2], const pg8::Unit& u, int wr, int wc, int fr, int fq) const {
#pragma unroll
    for (int ai = 0; ai < 2; ++ai)
#pragma unroll
      for (int m = 0; m < 4; ++m) {
        const int row = u.pm * 256 + ai * 128 + wr * 64 + m * 16 + fr; float rs = 0.f;
        const float rstd = rsqrtf(ssx[row] * (1.f / DM) + EPS);
#pragma unroll
        for (int bj = 0; bj < 2; ++bj)
#pragma unroll
          for (int n = 0; n < 2; ++n) {
            const int col = u.pn * 256 + bj * 128 + wc * 32 + n * 16 + fq * 4; const size_t off = (size_t)row * DM + col;
            f32x4 g;
#pragma unroll
            for (int j = 0; j < 4; ++j) g[j] = 1.f / (1.f + __expf(-rstd * acc[ai][bj][m][n][j]));
            const u32x2 pw = *(const u32x2*)(PT + off); f32x4 pp; pp.x = __uint_as_float(pw.x << 16); pp.y = __uint_as_float(pw.x & 0xffff0000u); pp.z = __uint_as_float(pw.y << 16); pp.w = __uint_as_float(pw.y & 0xffff0000u);
            const u32x2 xw = *(const u32x2*)(X1B + off); f32x4 x1; x1.x = __uint_as_float(xw.x << 16); x1.y = __uint_as_float(xw.x & 0xffff0000u); x1.z = __uint_as_float(xw.y << 16); x1.w = __uint_as_float(xw.y & 0xffff0000u);
            const f32x4 xn = x1 + pp * g;
            *(f32x4*)(out + off) = xn;
            if (layer == 0) {
              rs += xn.x * xn.x + xn.y * xn.y + xn.z * xn.z + xn.w * xn.w;
              const f32x4 gg = *(const f32x4*)(ng1 + col);
              u32x2 w; w.x = cvtpk(xn.x * gg.x, xn.y * gg.y); w.y = cvtpk(xn.z * gg.z, xn.w * gg.w); *(u32x2*)(H + off) = w;
            }
          }
        if (layer == 0) { rs += __shfl_xor(rs, 16); rs += __shfl_xor(rs, 32); if (fq == 0) atomicAdd(ss1 + row, rs); }
        asm volatile("" ::: "memory");
      }
  }
};
DI void phase_ple(const Params& p, int layer, char* lds) {
  unsigned char* ws = p.ws;
  bf16* PT = (bf16*)(ws + WS_PE);
  pg8::StaticOrder S; S.init(NTOK, DM, (int)gridDim.x, (int)blockIdx.x);
  { pg8::Gemm g{(const bf16*)(ws + WS_PBF) + (size_t)layer * NTOK * 256, (const bf16*)(ws + (layer == 0 ? WS_WP0 : WS_WP1)), NTOK, DM, 256};
    EpiPleProj E{PT};
    pg8::gemm_phase<EpiPleProj, pg8::StaticOrder, true, true>((PG8_LAS unsigned char*)lds, g, S, E); }
  { pg8::Gemm g{(const bf16*)(ws + WS_ACT), (const bf16*)(ws + (layer == 0 ? WS_WG0 : WS_WG1)), NTOK, DM, DM};
    EpiPleGate E{PT, (const bf16*)(ws + WS_PE + 64 * MiB), p.out, (const float*)(ws + WS_SS) + (layer == 0 ? 1 : 2) * NTOK, (float*)(ws + WS_SS), (bf16*)(ws + WS_Y), p.in[I_NORM_GAIN] + DM, layer};
    pg8::gemm_phase<EpiPleGate, pg8::StaticOrder, true, true>((PG8_LAS unsigned char*)lds, g, S, E); }
}

DI float half_max(float v) { auto rr = __builtin_amdgcn_permlane32_swap(__float_as_uint(v), __float_as_uint(v), false, false); return fmaxf(__uint_as_float(rr[0]), __uint_as_float(rr[1])); }
template <int DVB, bool MASKED = true>
DI void attn_step32(const bf16* Kt, int KP, const bf16* Vt, int VP, const bf16x8 (&qf)[4], f32x16 (&o)[DVB], float& m, float& l, unsigned vmask, float c2, int lane) {
  const int r32 = lane & 31, h = lane >> 5;
  f32x16 s;
#pragma unroll
  for (int i = 0; i < 16; ++i) s[i] = 0.f;
#pragma unroll
  for (int t = 0; t < 4; ++t) { const bf16x8 kf = *(const bf16x8*)(Kt + r32 * KP + t * 16 + h * 8); s = mfma32(kf, qf[t], s); }
  float mx = -INFINITY;
#pragma unroll
  for (int i = 0; i < 16; ++i) { if (MASKED) { s[i] = ((vmask >> i) & 1u) ? s[i] : -INFINITY; } mx = fmaxf(mx, s[i]); }
  mx = half_max(mx);
  const float mxs = mx * c2;
  if (__any(mxs > m + 6.f)) {
    const float mn = fmaxf(m, mxs);
    const float alpha = fexp2(m - mn); l *= alpha;
#pragma unroll
    for (int d = 0; d < DVB; ++d)
#pragma unroll
      for (int i = 0; i < 16; ++i) o[d][i] *= alpha;
    m = mn;
  }
  float ps = 0.f; const float negm = -m;
#pragma unroll
  for (int i = 0; i < 16; ++i) { const float pv = fexp2(__builtin_fmaf(s[i], c2, negm)); s[i] = pv; ps += pv; }
  l += ps;
  bf16x8 pf[2];
  { u32x4 a, b; a.x = cvtpk(s[0], s[1]); a.y = cvtpk(s[2], s[3]); a.z = cvtpk(s[4], s[5]); a.w = cvtpk(s[6], s[7]);
    b.x = cvtpk(s[8], s[9]); b.y = cvtpk(s[10], s[11]); b.z = cvtpk(s[12], s[13]); b.w = cvtpk(s[14], s[15]);
    pf[0] = __builtin_bit_cast(bf16x8, a); pf[1] = __builtin_bit_cast(bf16x8, b); }
  const int i16 = lane & 15, q = i16 >> 2, pp = i16 & 3, blk = (lane >> 4) & 1;
#pragma unroll
  for (int d = 0; d < DVB; ++d)
#pragma unroll
    for (int sk = 0; sk < 2; ++sk) {
      const s16x4 lo = trread(Vt + (16 * sk + 4 * h + q) * VP + 32 * d + 16 * blk + 4 * pp);
      const s16x4 hi = trread(Vt + (16 * sk + 8 + 4 * h + q) * VP + 32 * d + 16 * blk + 4 * pp);
      const bf16x8 vf = __builtin_shufflevector(lo, hi, 0, 1, 2, 3, 4, 5, 6, 7);
      o[d] = mfma32(vf, pf[sk], o[d]);
    }
}

DI unsigned row_range_mask(int lo, int hi) {
  lo = lo < 0 ? 0 : lo; hi = hi > 31 ? 31 : hi;
  if (hi < lo) return 0u;
  const unsigned upto_hi = (hi >= 31) ? 0xffffffffu : ((1u << (hi + 1)) - 1u);
  return upto_hi & ~((1u << lo) - 1u);
}
DI unsigned lane_rows(unsigned m32, int h) {
  const unsigned t = m32 >> (4 * h);
  return (t & 0xFu) | ((t >> 4) & 0xF0u) | ((t >> 8) & 0xF00u) | ((t >> 12) & 0xF000u);
}
constexpr int WP = 72;
constexpr int WAVE_LDS = 2 * 32 * WP * 2 + 512;

struct KVRegs { u32x4 k[4], v[4]; };
DI void kv_store(const KVRegs& R, bf16* Ks, bf16* Vs, int lane) {
#pragma unroll
  for (int i = 0; i < 4; ++i) { const int row = (lane >> 3) + 8 * i, ch = lane & 7; *(u32x4*)(Ks + row * WP + ch * 8) = R.k[i]; *(u32x4*)(Vs + row * WP + ch * 8) = R.v[i]; }
}

DI void band_load(KVRegs& R, const bf16* Kg, const bf16* Vg, int NP, int kstart, int dil, int roff, int lane) {
#pragma unroll
  for (int i = 0; i < 4; ++i) {
    const int row = (lane >> 3) + 8 * i, ch = lane & 7; int k = kstart + row; if (k < 0) k = 0;
    const size_t off = (size_t)(dil * k + roff) * NP + ch * 8;
    R.k[i] = *(const u32x4*)(Kg + off); R.v[i] = *(const u32x4*)(Vg + off);
  }
}
template <int DVB>
DI void band_run(const bf16* Kg, const bf16* Vg, int NP, int kbase, int nsteps, int dil, int roff, int qidx, int win,
                 const bf16x8 (&qf)[4], f32x16 (&o)[DVB], float& m, float& l, float c2, bf16* Ks, bf16* Vs, int lane) {
  const int h = lane >> 5;
  KVRegs R; band_load(R, Kg, Vg, NP, kbase, dil, roff, lane);
  for (int j = 0; j < nsteps; ++j) {
    lds_fence();
    kv_store(R, Ks, Vs, lane);
    lds_fence();
    if (j + 1 < nsteps) band_load(R, Kg, Vg, NP, kbase + 32 * (j + 1), dil, roff, lane);
    const int kb = kbase + 32 * j, lo_r = (qidx - win > 0 ? qidx - win : 0) - kb;
    const unsigned vm = lane_rows(row_range_mask(lo_r, qidx - kb), h);
    attn_step32<DVB>(Ks, WP, Vs, WP, qf, o, m, l, vm, c2, lane);
  }
}

DI void write_o64(const f32x16 (&o)[2], float linv, const bf16* gate_row, bf16* y_row, int h) {
#pragma unroll
  for (int d = 0; d < 2; ++d)
#pragma unroll
    for (int g = 0; g < 4; ++g) {
      const int dd = 32 * d + 8 * g + 4 * h;
      const u32x2 gv = *(const u32x2*)(gate_row + dd);
      const float g0 = __uint_as_float(gv.x << 16), g1 = __uint_as_float(gv.x & 0xffff0000u), g2 = __uint_as_float(gv.y << 16), g3 = __uint_as_float(gv.y & 0xffff0000u);
      u32x2 w; w.x = cvtpk(o[d][4 * g] * linv * g0, o[d][4 * g + 1] * linv * g1); w.y = cvtpk(o[d][4 * g + 2] * linv * g2, o[d][4 * g + 3] * linv * g3);
      *(u32x2*)(y_row + dd) = w;
    }
}

DI void load_q(bf16x8 (&qf)[4], const bf16* qrow, int h) {
#pragma unroll
  for (int t = 0; t < 4; ++t) qf[t] = *(const bf16x8*)(qrow + t * 16 + h * 8);
}
template <int DVB> DI void zero_o(f32x16 (&o)[DVB]) {
#pragma unroll
  for (int d = 0; d < DVB; ++d)
#pragma unroll
    for (int i = 0; i < 16; ++i) o[d][i] = 0.f;
}

DI void mixerB_tile(const Params& p, int item, bf16* Ks, bf16* Vs, int lane) {
  const bf16* PE = (const bf16*)(p.ws + WS_PE); bf16* Y = (bf16*)(p.ws + WS_Y);
  const int qblk = item & 255, head = (item >> 8) & 7, b = item >> 11;
  const int r32 = lane & 31, h = lane >> 5, q0 = qblk * 32, kvh = head >> 2;
  const size_t rowb = (size_t)b * SEQ;
  bf16x8 qf[4]; load_q(qf, PE + (rowb + q0 + r32) * NPE + E_BQ + head * 64, h);
  f32x16 o[2]; zero_o<2>(o);
  const float sink2 = p.in[I_B_SINKS][head] * LOG2E;
  float m = sink2, l = (h == 0) ? 1.f : 0.f;
  band_run<2>(PE + rowb * NPE + E_BK + kvh * 64, PE + rowb * NPE + E_BV + kvh * 64, NPE, q0 - 128, 5, 1, 0, q0 + r32, 127, qf, o, m, l, 0.125f * LOG2E, Ks, Vs, lane);
  l += __shfl_xor(l, 32);
  const size_t tok = rowb + q0 + r32;
  write_o64(o, 1.f / l, PE + tok * NPE + E_BG + head * 64, Y + tok * DM + 512 + head * 64, h);
}

DI void mixerC_tile(const Params& p, int item, bf16* Ks, bf16* Vs, int lane) {
  const bf16* PO = (const bf16*)(p.ws + WS_PE); bf16* Y = (bf16*)(p.ws + WS_Y);
  const int qt = item & 15, r16 = (item >> 4) & 15, head = (item >> 8) & 7, b = item >> 11;
  const int r32 = lane & 31, h = lane >> 5, qi0 = qt * 32;
  const size_t rowb = (size_t)b * SEQ;
  const int t = 16 * (qi0 + r32) + r16;
  bf16x8 qf[4]; load_q(qf, PO + (rowb + t) * NPO + O_CQ + head * 64, h);
  f32x16 o[2]; zero_o<2>(o);
  float m = -1e30f, l = 0.f;
  const bf16* Kg = PO + rowb * NPO + O_CK + head * 64; const bf16* Vg = PO + rowb * NPO + O_CV + head * 64;
  const float c2 = 0.125f * LOG2E;
  band_run<2>(Kg, Vg, NPO, qi0 - 128, 5, 16, r16, qi0 + r32, 128, qf, o, m, l, c2, Ks, Vs, lane);
  band_run<2>(Kg, Vg, NPO, 4 * qi0 + (r16 >> 2) - 128, 8, 4, r16 & 3, 4 * (qi0 + r32) + (r16 >> 2), 128, qf, o, m, l, c2, Ks, Vs, lane);
  band_run<2>(Kg, Vg, NPO, 16 * qi0 + r16 - 128, 20, 1, 0, t, 128, qf, o, m, l, c2, Ks, Vs, lane);
  l += __shfl_xor(l, 32);
  const size_t tok = rowb + t;
  write_o64(o, 1.f / l, PO + tok * NPO + O_CG + head * 64, Y + tok * DM + head * 64, h);
}

DI void attn_step16(const bf16* Kt, const bf16* Vt, const bf16x8 (&qf)[2], f32x4 (&o)[4], float& m, float& l, int nvalid  , float c2, int lane) {
  const int c = lane & 15, qd = lane >> 4;
  f32x4 s0 = {0.f, 0.f, 0.f, 0.f}, s1 = {0.f, 0.f, 0.f, 0.f};
#pragma unroll
  for (int ks = 0; ks < 2; ++ks) {
    const bf16x8 k0 = *(const bf16x8*)(Kt + c * WP + ks * 32 + qd * 8);
    const bf16x8 k1 = *(const bf16x8*)(Kt + (16 + c) * WP + ks * 32 + qd * 8);
    s0 = mfma16(k0, qf[ks], s0); s1 = mfma16(k1, qf[ks], s1);
  }
  float mx = -INFINITY;
#pragma unroll
  for (int j = 0; j < 4; ++j) { if (4 * qd + j >= nvalid) s0[j] = -INFINITY; if (16 + 4 * qd + j >= nvalid) s1[j] = -INFINITY; mx = fmaxf(mx, fmaxf(s0[j], s1[j])); }
  mx = fmaxf(mx, __shfl_xor(mx, 16)); mx = fmaxf(mx, __shfl_xor(mx, 32));
  const float mxs = mx * c2;
  if (__any(mxs > m + 6.f)) {
    const float mn = fmaxf(m, mxs); const float alpha = fexp2(m - mn); l *= alpha;
#pragma unroll
    for (int d = 0; d < 4; ++d) o[d] = o[d] * alpha;
    m = mn;
  }
  const float negm = -m; float ps = 0.f;
#pragma unroll
  for (int j = 0; j < 4; ++j) { s0[j] = fexp2(__builtin_fmaf(s0[j], c2, negm)); s1[j] = fexp2(__builtin_fmaf(s1[j], c2, negm)); ps += s0[j] + s1[j]; }
  l += ps;
  u32x4 pw; pw.x = cvtpk(s0[0], s0[1]); pw.y = cvtpk(s0[2], s0[3]); pw.z = cvtpk(s1[0], s1[1]); pw.w = cvtpk(s1[2], s1[3]);
  const bf16x8 pf = __builtin_bit_cast(bf16x8, pw);
  const int i16 = lane & 15, rq = i16 >> 2, pp = i16 & 3;
#pragma unroll
  for (int dt = 0; dt < 4; ++dt) {
    const s16x4 lo = trread(Vt + (4 * qd + rq) * WP + 16 * dt + 4 * pp);
    const s16x4 hi = trread(Vt + (16 + 4 * qd + rq) * WP + 16 * dt + 4 * pp);
    const bf16x8 vf = __builtin_shufflevector(lo, hi, 0, 1, 2, 3, 4, 5, 6, 7);
    o[dt] = mfma16(vf, pf, o[dt]);
  }
}

DI void mixerA_item(const Params& p, int item, bf16* Ks, bf16* Vs, int lane) {
  const bf16* PE = (const bf16*)(p.ws + WS_PE); bf16* Y = (bf16*)(p.ws + WS_Y);
  const unsigned short* SEL = (const unsigned short*)(p.ws + WS_SEL) + (size_t)item * 256;
  const int t = item & (SEQ - 1), b = item >> 13;
  const int c = lane & 15, qd = lane >> 4, head = c & 7;
  const size_t rowb = (size_t)b * SEQ;
  const int count = (t + 1 < 256) ? t + 1 : 256, nsteps = (count + 31) >> 5;
  bf16x8 qf[2];
#pragma unroll
  for (int ks = 0; ks < 2; ++ks) qf[ks] = *(const bf16x8*)(PE + (size_t)item * NPE + E_AQ + head * 64 + ks * 32 + qd * 8);
  f32x4 o[4];
#pragma unroll
  for (int d = 0; d < 4; ++d) o[d] = (f32x4){0.f, 0.f, 0.f, 0.f};
  float m = -1e30f, l = 0.f;
  const bf16* Kg = PE + rowb * NPE + E_AK; const bf16* Vg = PE + rowb * NPE + E_AV;
  KVRegs R;
  unsigned short* sel_l = (unsigned short*)(Vs + 32 * WP);
  lds_fence();
  *(u32x2*)(sel_l + 4 * lane) = *(const u32x2*)(SEL + 4 * lane);
  lds_fence();
#define A_LOAD(j) do { _Pragma("unroll") for (int i = 0; i < 4; ++i) { const int row = (lane >> 3) + 8 * i, ch = lane & 7, e = 32 * (j) + row; \
      const int tokk = (e < count) ? (int)sel_l[e] : 0; const size_t off = (size_t)tokk * NPE + ch * 8; R.k[i] = *(const u32x4*)(Kg + off); R.v[i] = *(const u32x4*)(Vg + off); } } while (0)
  A_LOAD(0);
  for (int j = 0; j < nsteps; ++j) {
    lds_fence();
    kv_store(R, Ks, Vs, lane);
    lds_fence();
    if (j + 1 < nsteps) A_LOAD(j + 1);
    attn_step16(Ks, Vs, qf, o, m, l, count - 32 * j, 0.125f * LOG2E, lane);
  }
#undef A_LOAD
  l += __shfl_xor(l, 16); l += __shfl_xor(l, 32);
  if (c < 8) {
    const float linv = 1.f / l;
    const bf16* gate_row = PE + (size_t)item * NPE + E_AG + head * 64; bf16* y_row = Y + (size_t)item * DM + head * 64;
#pragma unroll
    for (int dt = 0; dt < 4; ++dt) {
      const int dd = 16 * dt + 4 * qd;
      const u32x2 gv = *(const u32x2*)(gate_row + dd);
      const float g0 = __uint_as_float(gv.x << 16), g1 = __uint_as_float(gv.x & 0xffff0000u), g2 = __uint_as_float(gv.y << 16), g3 = __uint_as_float(gv.y & 0xffff0000u);
      u32x2 w; w.x = cvtpk(o[dt][0] * linv * g0, o[dt][1] * linv * g1); w.y = cvtpk(o[dt][2] * linv * g2, o[dt][3] * linv * g3);
      *(u32x2*)(y_row + dd) = w;
    }
  }
}

DI unsigned f2ord(float f) { f += 0.f; const unsigned u = __float_as_uint(f); return (u & 0x80000000u) ? ~u : (u | 0x80000000u); }
DI int block_excl_scan(int v, int* tmp, int* tot) {
  const int lane = threadIdx.x & 63, wid = threadIdx.x >> 6;
  int inc = v;
#pragma unroll
  for (int o = 1; o < 64; o <<= 1) { const int u = __shfl_up(inc, o); if (lane >= o) inc += u; }
  if (lane == 63) tmp[wid] = inc;
  __syncthreads();
  int base = 0, total = 0;
#pragma unroll
  for (int w = 0; w < 8; ++w) { const int x = tmp[w]; if (w < wid) base += x; total += x; }
  *tot = total;
  return base + inc - v;
}

DI float dpp_sum8(float v) {
  v += __builtin_bit_cast(float, __builtin_amdgcn_mov_dpp(__builtin_bit_cast(int, v), 0xB1, 0xF, 0xF, true));
  v += __builtin_bit_cast(float, __builtin_amdgcn_mov_dpp(__builtin_bit_cast(int, v), 0x4E, 0xF, 0xF, true));
  v += __builtin_bit_cast(float, __builtin_amdgcn_mov_dpp(__builtin_bit_cast(int, v), 0x141, 0xF, 0xF, true));
  return v;
}
DI void hist_find(const int* hist, int* misc, int need, int& digit, int& nneed, int& cnt) {
  const int tid = threadIdx.x;
  typedef int i32x4 __attribute__((ext_vector_type(4)));
  const i32x4 h0 = *(const i32x4*)(hist + tid * 8), h1 = *(const i32x4*)(hist + tid * 8 + 4);
  int hh[8] = {h0.x, h0.y, h0.z, h0.w, h1.x, h1.y, h1.z, h1.w}; int tot = 0;
#pragma unroll
  for (int k = 0; k < 8; ++k) tot += hh[k];
  int total; const int ex = block_excl_scan(tot, misc, &total);
  int above = total - ex - tot;
#pragma unroll
  for (int k = 7; k >= 0; --k) { const int c = hh[k]; if (above < need && above + c >= need) { misc[16] = tid * 8 + k; misc[17] = need - above; misc[18] = c; } above += c; }
  __syncthreads();
  digit = misc[16]; nneed = misc[17]; cnt = misc[18];
  __syncthreads();
}
DI unsigned long long mkcmp(float v, int idx) { return ((unsigned long long)f2ord(v) << 16) | ((unsigned long long)(8191 - idx) << 3); }
DI float ord2f(unsigned k) { return __uint_as_float((k & 0x80000000u) ? (k ^ 0x80000000u) : ~k); }
DI float half_sum(float v) { auto rr = __builtin_amdgcn_permlane32_swap(__float_as_uint(v), __float_as_uint(v), false, false); return __uint_as_float(rr[0]) + __uint_as_float(rr[1]); }

constexpr int CL_CAP = 512;
DI void select_slow(const float* scq, int n, unsigned short* out, float lo, float hi, int* hist, int* misc, unsigned long long* clist) {
  const int tid = opaque_tid();
    const float scale = (hi > lo) ? 4095.f / (hi - lo) : 0.f;
    for (int i = tid; i < 4096; i += 512) hist[i] = 0;
    if (tid == 0) misc[20] = 0;
    __syncthreads();
    float val[16]; int bin[16];
#pragma unroll
    for (int i = 0; i < 16; ++i) { const int idx = tid + 512 * i; const float v = (idx < n) ? scq[idx] : lo; val[i] = v;
      int bb = (int)((v - lo) * scale); bb = bb < 0 ? 0 : (bb > 4095 ? 4095 : bb); bin[i] = bb; if (idx < n) atomicAdd(&hist[bb], 1); }
    __syncthreads();
    int bstar, need, cnt;
    hist_find(hist, misc, 256, bstar, need, cnt);
    unsigned long long T = 0ull;
    if (cnt != need) {
      if (cnt <= CL_CAP) {
#pragma unroll
        for (int i = 0; i < 16; ++i) { const int idx = tid + 512 * i; if (idx < n && bin[i] == bstar) { const int slot = atomicAdd(&misc[20], 1); clist[slot] = mkcmp(val[i], idx); } }
        __syncthreads();
        if (tid < cnt) { const unsigned long long c = clist[tid]; int rank = 0; for (int jx = 0; jx < cnt; ++jx) rank += (clist[jx] > c) ? 1 : 0;
          if (rank == need - 1) { misc[21] = (int)(unsigned)(c & 0xffffffffull); misc[22] = (int)(unsigned)(c >> 32); } }
        __syncthreads();
        T = ((unsigned long long)(unsigned)misc[22] << 32) | (unsigned long long)(unsigned)misc[21];
      } else {
        unsigned long long prefix = 0ull; int shift = 36;
        for (int pass = 0; pass < 4; ++pass) {
          for (int i = tid; i < 4096; i += 512) hist[i] = 0;
          __syncthreads();
#pragma unroll
          for (int i = 0; i < 16; ++i) { const int idx = tid + 512 * i; if (idx < n && bin[i] == bstar) { const unsigned long long c = mkcmp(val[i], idx); if (pass == 0 || (c >> (shift + 12)) == prefix) atomicAdd(&hist[(int)((c >> shift) & 4095ull)], 1); } }
          __syncthreads();
          int digit, nneed, c2;
          hist_find(hist, misc, need, digit, nneed, c2);
          prefix = (prefix << 12) | (unsigned long long)digit; need = nneed;
          if (c2 == need) break;
          shift -= 12;
        }
        T = prefix << shift;
      }
    }
    int mycnt = 0; unsigned selm = 0;
#pragma unroll
    for (int i = 0; i < 16; ++i) { const int idx = tid + 512 * i;
      bool sel = false;
      if (idx < n) { if (bin[i] > bstar) sel = true; else if (bin[i] == bstar) sel = (mkcmp(val[i], idx) >= T); }
      if (sel) { ++mycnt; selm |= (1u << i); } }
    int total; int pos = block_excl_scan(mycnt, misc + 8, &total);
#pragma unroll
    for (int i = 0; i < 16; ++i) { if ((selm >> i) & 1u) { if (pos < 256) out[pos] = (unsigned short)(tid + 512 * i); ++pos; } }
    __syncthreads();
}

DI void sel_load_qw(const Params& p, int item, bf16x8 (&qf)[4], float (&wq)[16], int lane) {
  const bf16* PE = (const bf16*)(p.ws + WS_PE); const float* IW = (const float*)(p.ws + WS_IW);
  const int r32 = lane & 31, h = lane >> 5, b = item >> 11, t0 = (item & 2047) * 4; const size_t rowb = (size_t)b * SEQ;
  load_q(qf, PE + (rowb + t0 + (r32 >> 3)) * NPE + E_IQ + (r32 & 7) * 64, h);
#pragma unroll
  for (int q = 0; q < 4; ++q) { const f32x4 w4 = *(const f32x4*)(IW + (rowb + t0 + q) * 8 + 4 * h);
    wq[4 * q] = w4.x * 0.04419417382415922f; wq[4 * q + 1] = w4.y * 0.04419417382415922f; wq[4 * q + 2] = w4.z * 0.04419417382415922f; wq[4 * q + 3] = w4.w * 0.04419417382415922f; }
}
DI void selectA_item(const Params& p, int item, int next_item, char* lds, bf16x8 (&qf)[4], float (&wq)[16]) {
  const bf16* PE = (const bf16*)(p.ws + WS_PE);
  const float* IW = (const float*)(p.ws + WS_IW);
  unsigned short* SEL = (unsigned short*)(p.ws + WS_SEL);
  float* sc = (float*)lds;
  int* hist = (int*)(lds + 4 * 8192 * 4);
  int* misc = hist + 4096;
  unsigned* mm = (unsigned*)(misc + 24);
  unsigned long long* clist = (unsigned long long*)(misc + 96);
  const int tid = opaque_tid(), lane = tid & 63, wid = tid >> 6, r32 = lane & 31, h = lane >> 5;
  const int b = item >> 11, t0 = (item & 2047) * 4;
  const size_t rowb = (size_t)b * SEQ;
  const int nk = t0 + 4, ntile = (nk + 31) >> 5;
  const f32x4 pcv = ((const f32x4*)p.in[I_P])[(size_t)item * 512 + tid];
  if (tid < 4) { mm[tid * 2] = 0xFFFFFFFFu; mm[tid * 2 + 1] = 0u; }
  lds_barrier();
  const bf16* Kt = (const bf16*)(p.ws + WS_IKS) + (size_t)b * 256 * 2048 + lane * 8;
  {
    bf16x8 kf[4], kn[4];
#pragma unroll
    for (int t = 0; t < 4; ++t) { kf[t] = (bf16x8){0, 0, 0, 0, 0, 0, 0, 0}; kn[t] = kf[t]; }
    if (wid < ntile) {
#pragma unroll
      for (int t = 0; t < 4; ++t) kf[t] = *(const bf16x8*)(Kt + (size_t)wid * 2048 + t * 512);
    }
    float lo0 = INFINITY, hi0 = -INFINITY, lo1 = INFINITY, hi1 = -INFINITY;
    for (int kt = wid; kt < ntile; kt += 8) {
      if (kt + 8 < ntile) {
#pragma unroll
        for (int t = 0; t < 4; ++t) kn[t] = *(const bf16x8*)(Kt + (size_t)(kt + 8) * 2048 + t * 512);
      }
      f32x16 s;
#pragma unroll
      for (int i = 0; i < 16; ++i) s[i] = 0.f;
#pragma unroll
      for (int t = 0; t < 4; ++t) s = mfma32(qf[t], kf[t], s);
      float v[4];
#pragma unroll
      for (int q = 0; q < 4; ++q) {
        float a = wq[4 * q] * fmaxf(s[4 * q], 0.f);
#pragma unroll
        for (int jj = 1; jj < 4; ++jj) a += wq[4 * q + jj] * fmaxf(s[4 * q + jj], 0.f);
        v[q] = half_sum(a) + 0.f;
      }
      const float va = h ? v[2] : v[0], vb = h ? v[3] : v[1];
      const int key = kt * 32 + r32;
      sc[(2 * h) * 8192 + key] = va; sc[(2 * h + 1) * 8192 + key] = vb;
      lo0 = fminf(lo0, va); hi0 = fmaxf(hi0, va); lo1 = fminf(lo1, vb); hi1 = fmaxf(hi1, vb);
#pragma unroll
      for (int t = 0; t < 4; ++t) kf[t] = kn[t];
    }
    if (wid < ntile) {
#pragma unroll
      for (int o = 1; o < 32; o <<= 1) { lo0 = fminf(lo0, __shfl_xor(lo0, o)); hi0 = fmaxf(hi0, __shfl_xor(hi0, o)); lo1 = fminf(lo1, __shfl_xor(lo1, o)); hi1 = fmaxf(hi1, __shfl_xor(hi1, o)); }
      if (r32 == 0) { atomicMin(&mm[(2 * h) * 2], f2ord(lo0)); atomicMax(&mm[(2 * h) * 2 + 1], f2ord(hi0)); atomicMin(&mm[(2 * h + 1) * 2], f2ord(lo1)); atomicMax(&mm[(2 * h + 1) * 2 + 1], f2ord(hi1)); }
    }
  }
  if (next_item >= 0) sel_load_qw(p, next_item, qf, wq, lane);
  { u32x2 w; w.x = cvtpk(pcv.x, pcv.y); w.y = cvtpk(pcv.z, pcv.w); ((u32x2*)(p.ws + WS_PBF))[(size_t)item * 512 + tid] = w; }
  lds_barrier();
  {
    const int g = wid >> 1, gt = tid & 127, upper = wid & 1;
    const int t = t0 + g, n = t + 1;
    const bool big = n > 256;
    const float* scq = sc + g * 8192;
    unsigned short* out = SEL + (rowb + t) * 256;
    int* histq = hist + g * 1024;
    unsigned long long* clq = clist + g * 128;
    int* mq = misc + 32 + g * 8;
    const float lo = ord2f(mm[g * 2]), hi = ord2f(mm[g * 2 + 1]);
    const float scale = (hi > lo) ? 1023.f / (hi - lo) : 0.f;
    for (int i = gt; i < 1024; i += 128) histq[i] = 0;
    if (gt == 0) { mq[0] = 0; mq[6] = 0; }
    lds_barrier();
    float uu[64];
#pragma unroll
    for (int i = 0; i < 64; ++i) { const int idx = gt + 128 * i; const float v = (idx < n) ? scq[idx] : lo; const float u = (v - lo) * scale; uu[i] = u;
      if (big && idx < n) { int bb = (int)u; bb = bb > 1023 ? 1023 : bb; atomicAdd(&histq[bb], 1); } }
    lds_barrier();
    typedef int i32x4 __attribute__((ext_vector_type(4)));
    const i32x4 h0 = *(const i32x4*)(histq + gt * 8), h1 = *(const i32x4*)(histq + gt * 8 + 4);
    const int hh[8] = {h0.x, h0.y, h0.z, h0.w, h1.x, h1.y, h1.z, h1.w};
    int tot = 0;
#pragma unroll
    for (int k = 0; k < 8; ++k) tot += hh[k];
    int inc = tot;
#pragma unroll
    for (int o = 1; o < 64; o <<= 1) { const int ux = __shfl_down(inc, o); if (lane + o < 64) inc += ux; }
    if (lane == 0) misc[wid] = inc;
    lds_barrier();
    {
      int above = inc - tot + (upper ? 0 : misc[wid + 1]);
      if (big) {
#pragma unroll
        for (int k = 7; k >= 0; --k) { const int c = hh[k]; if (above < 256 && above + c >= 256) { mq[1] = gt * 8 + k; mq[2] = 256 - above; mq[3] = c; } above += c; }
      }
    }
    lds_barrier();
    const int bstar = mq[1], need = mq[2], cnt = mq[3];
    const float flo = (float)bstar, fhi = (bstar >= 1023) ? INFINITY : (float)(bstar + 1);
    const bool tie = big && cnt != need;
    if (tie) {
      if (cnt <= 128) {
#pragma unroll
        for (int i = 0; i < 64; ++i) { const int idx = gt + 128 * i; if (idx < n && uu[i] >= flo && uu[i] < fhi) { const int slot = atomicAdd(&mq[0], 1); clq[slot] = mkcmp(scq[idx], idx); } }
      } else if (gt == 0) mq[6] = 1;
    }
    lds_barrier();
    if (tie && cnt <= 128 && gt < cnt) { const unsigned long long c = clq[gt]; int rank = 0; for (int jx = 0; jx < cnt; ++jx) rank += (clq[jx] > c) ? 1 : 0;
      if (rank == need - 1) { mq[4] = (int)(unsigned)(c & 0xffffffffull); mq[5] = (int)(unsigned)(c >> 32); } }
    lds_barrier();
    const unsigned long long T = tie ? (((unsigned long long)(unsigned)mq[5] << 32) | (unsigned long long)(unsigned)mq[4]) : 0ull;
    const bool fast = big && !(tie && cnt > 128);
    unsigned long long selm = 0ull;
    if (fast) {
#pragma unroll
      for (int i = 0; i < 64; ++i) { const int idx = gt + 128 * i;
        if (idx < n) { const float u = uu[i]; bool sel = u >= fhi; if (!sel && u >= flo) sel = !tie || (mkcmp(scq[idx], idx) >= T); if (sel) selm |= (1ull << i); } }
    }
    const int mycnt = __popcll(selm);
    int pinc = mycnt;
#pragma unroll
    for (int o = 1; o < 64; o <<= 1) { const int ux = __shfl_up(pinc, o); if (lane >= o) pinc += ux; }
    if (lane == 63) misc[8 + wid] = pinc;
    lds_barrier();
    if (fast) {
      int pos = pinc - mycnt + (upper ? misc[8 + wid - 1] : 0);
      while (selm) { const int i = __ffsll((long long)selm) - 1; selm &= selm - 1ull; if (pos < 256) out[pos] = (unsigned short)(gt + 128 * i); ++pos; }
    } else if (!big) {
      for (int i = gt; i < n; i += 128) out[i] = (unsigned short)i;
    }
    lds_barrier();
  }
  for (int q = 0; q < 4; ++q) {
    if (misc[32 + q * 8 + 6]) { const int t = t0 + q; select_slow(sc + q * 8192, t + 1, SEL + (rowb + t) * 256, ord2f(mm[q * 2]), ord2f(mm[q * 2 + 1]), hist, misc, clist); }
  }
  lds_barrier();
}

constexpr int DKP = 72, DVP = 136;
constexpr int D_STAGE = (64 * DKP * 2 + 64 * DVP) * 2;
DI void mixerD_unit(const Params& p, int b, int head, int qb, char* lds) {
  const bf16* PO = (const bf16*)(p.ws + WS_PE); bf16* Y = (bf16*)(p.ws + WS_Y);
  const int tid = opaque_tid(), lane = tid & 63, wid = tid >> 6, r32 = lane & 31, h = lane >> 5;
  const int map = wid & 1, qsub = wid >> 1;
  const size_t rowb = (size_t)b * SEQ;
  const int qpos = 128 * qb + 32 * qsub + r32;
  bf16x8 qf[4]; load_q(qf, PO + (rowb + qpos) * NPO + O_DQ + (2 * head + map) * 64, h);
  f32x16 o[4]; zero_o<4>(o);
  float m = -1e30f, l = 0.f;
  const int nsteps = 2 * qb + 2;
  const bf16* K1g = PO + rowb * NPO + O_DK + (2 * head) * 64;
  const bf16* K2g = K1g + 64;
  const bf16* Vg = PO + rowb * NPO + O_DV + head * 128;
  u32x4 rk1, rk2, rv[2];
#define D_LOAD(j) do { const int row = tid >> 3, ch = tid & 7; const size_t off = (size_t)((j) * 64 + row) * NPO + ch * 8; rk1 = *(const u32x4*)(K1g + off); rk2 = *(const u32x4*)(K2g + off); \
    _Pragma("unroll") for (int i = 0; i < 2; ++i) { const int c = tid + 512 * i, vr = c >> 4, vc = c & 15; rv[i] = *(const u32x4*)(Vg + (size_t)((j) * 64 + vr) * NPO + vc * 8); } } while (0)
  __syncthreads();
  D_LOAD(0);
  for (int j = 0; j < nsteps; ++j) {
    char* st = lds + (j & 1) * D_STAGE;
    bf16* K1s = (bf16*)st; bf16* K2s = K1s + 64 * DKP; bf16* Vs = K2s + 64 * DKP;
    { const int row = tid >> 3, ch = tid & 7; *(u32x4*)(K1s + row * DKP + ch * 8) = rk1; *(u32x4*)(K2s + row * DKP + ch * 8) = rk2;
#pragma unroll
      for (int i = 0; i < 2; ++i) { const int c = tid + 512 * i, vr = c >> 4, vc = c & 15; *(u32x4*)(Vs + vr * DVP + vc * 8) = rv[i]; } }
    __syncthreads();
    if (j + 1 < nsteps) D_LOAD(j + 1);
    const bf16* Ks = map ? K2s : K1s;
#pragma unroll
    for (int sub = 0; sub < 2; ++sub) {
      const int k0 = j * 64 + sub * 32;
      if (k0 <= 128 * qb + 32 * qsub + 31) {
        if (k0 + 31 <= 128 * qb + 32 * qsub) {
          attn_step32<4, false>(Ks + sub * 32 * DKP, DKP, Vs + sub * 32 * DVP, DVP, qf, o, m, l, 0xffffu, 0.125f * LOG2E, lane);
        } else {
          unsigned vm = 0;
#pragma unroll
          for (int i = 0; i < 16; ++i) if (k0 + crow(i, h) <= qpos) vm |= (1u << i);
          attn_step32<4, true>(Ks + sub * 32 * DKP, DKP, Vs + sub * 32 * DVP, DVP, qf, o, m, l, vm, 0.125f * LOG2E, lane);
        }
      }
    }
  }
#undef D_LOAD
  l += __shfl_xor(l, 32);
  const float linv = 1.f / l;
  __syncthreads();
  float* xch = (float*)lds + qsub * 4096;
  if (map == 1) {
#pragma unroll
    for (int d = 0; d < 4; ++d)
#pragma unroll
      for (int i = 0; i < 16; ++i) xch[(d * 16 + i) * 64 + lane] = o[d][i] * linv;
  }
  __syncthreads();
  if (map == 0) {
    const float lam = *(const float*)(p.ws + WS_LAM);
    float ssq = 0.f;
#pragma unroll
    for (int d = 0; d < 4; ++d)
#pragma unroll
      for (int i = 0; i < 16; ++i) { const float a = o[d][i] * linv - lam * xch[(d * 16 + i) * 64 + lane]; o[d][i] = a; ssq += a * a; }
    ssq += __shfl_xor(ssq, 32);
    const float lambda_init = 0.8f - 0.6f * expf(-0.3f);
    const float rn = rsqrtf(ssq * (1.f / 128.f) + EPS) * (1.f - lambda_init);
    const size_t tok = rowb + qpos;
    const bf16* gate = PO + tok * NPO + O_DG + head * 128;
    bf16* y = Y + tok * DM + 512 + head * 128;
    const float* sg = p.in[I_SUB_GAIN];
#pragma unroll
    for (int d = 0; d < 4; ++d)
#pragma unroll
      for (int g = 0; g < 4; ++g) {
        const int dd = 32 * d + 8 * g + 4 * h;
        const u32x2 gv = *(const u32x2*)(gate + dd); const f32x4 s4 = *(const f32x4*)(sg + dd);
        const float g0 = __uint_as_float(gv.x << 16), g1 = __uint_as_float(gv.x & 0xffff0000u), g2 = __uint_as_float(gv.y << 16), g3 = __uint_as_float(gv.y & 0xffff0000u);
        u32x2 w; w.x = cvtpk(o[d][4 * g] * rn * s4.x * g0, o[d][4 * g + 1] * rn * s4.y * g1); w.y = cvtpk(o[d][4 * g + 2] * rn * s4.z * g2, o[d][4 * g + 3] * rn * s4.w * g3);
        *(u32x2*)(y + dd) = w;
      }
  }
  __syncthreads();
}

#define XB_TMO      128
#define XB_XCNT(j)  (256  + 64 * (j))
#define XB_XSUB(j)  (1280 + 64 * (j))
#define XB_XGEN(j)  (2304 + 64 * (j))
#define XB_TOP      3328
#define XB_TOPGEN   3392
#define XCD_BAR_WORDS 3456
#define XB_SPIN_CAP (1u << 18)

__device__ __forceinline__ unsigned xb_ld(unsigned* p)              { return __hip_atomic_load(p, __ATOMIC_RELAXED, __HIP_MEMORY_SCOPE_AGENT); }
__device__ __forceinline__ unsigned xb_add(unsigned* p, unsigned v) { return __hip_atomic_fetch_add(p, v, __ATOMIC_RELAXED, __HIP_MEMORY_SCOPE_AGENT); }
__device__ __forceinline__ unsigned xb_xcc_id() { return (unsigned)__builtin_amdgcn_s_getreg((3 << 11) | 20) & 0xFu; }
#define XB_SPIN(cond, bar) do { unsigned _sp = 0; while (cond) { __builtin_amdgcn_s_sleep(1); \
    if ((++_sp & 255u) == 0u) { if (xb_ld(&(bar)[XB_TMO])) break; if (_sp > XB_SPIN_CAP) { atomicAdd(&(bar)[XB_TMO], 1u); break; } } } } while (0)

struct XcdBarrier {
    unsigned* bar; unsigned x;
    volatile LAS unsigned* st;
};

__device__ __forceinline__ XcdBarrier xcd_barrier_post(unsigned* bar, volatile LAS unsigned* st) {
    XcdBarrier b; b.bar = bar; b.x = xb_xcc_id(); b.st = st;
    if (threadIdx.x == 0) (void)xb_add(&bar[XB_XCNT(b.x)], 1u);
    return b;
}
__device__ __forceinline__ void xcd_barrier_complete(unsigned* bar, unsigned x, unsigned& nloc, unsigned& nx) {
    const unsigned G = gridDim.x * gridDim.y * gridDim.z;
    unsigned sum, cnt, mine, sp = 0u;
    for (;;) {
        sum = 0u; cnt = 0u; mine = 0u;
#pragma unroll
        for (unsigned j = 0; j < 16; ++j) { const unsigned c = xb_ld(&bar[XB_XCNT(j)]); sum += c; cnt += (c > 0u) ? 1u : 0u; mine = (j == x) ? c : mine; }
        if (sum == G) break;
        __builtin_amdgcn_s_sleep(1);
        if ((++sp & 255u) == 0u) { if (xb_ld(&bar[XB_TMO])) break; if (sp > XB_SPIN_CAP) { atomicAdd(&bar[XB_TMO], 1u); break; } }
    }
    nloc = mine > 0u ? mine : 1u; nx = cnt > 0u ? cnt : 1u;
}

__device__ __forceinline__ void xcd_barrier(const XcdBarrier& b) {
    asm volatile("s_waitcnt vmcnt(0)" ::: "memory");
    __syncthreads();
    if (threadIdx.x == 0) {
        unsigned* bar = b.bar;
        __builtin_amdgcn_s_waitcnt(0);
        unsigned nloc = b.st[0], nx = b.st[1];
        if (nloc == 0u) { xcd_barrier_complete(bar, b.x, nloc, nx); b.st[0] = nloc; b.st[1] = nx; }
        const unsigned old = xb_add(&bar[XB_XSUB(b.x)], 1u);
        const unsigned gen = old / nloc;
        if (old + 1u == (gen + 1u) * nloc) {
            __builtin_amdgcn_fence(__ATOMIC_RELEASE, "agent");
            asm volatile("s_waitcnt vmcnt(0)" ::: "memory");
            const unsigned og = xb_add(&bar[XB_TOP], 1u);
            const unsigned tg = og / nx;
            if (og + 1u == (tg + 1u) * nx) xb_add(&bar[XB_TOPGEN], 1u);
            else XB_SPIN(xb_ld(&bar[XB_TOPGEN]) == tg, bar);
            __builtin_amdgcn_fence(__ATOMIC_ACQUIRE, "agent");
            xb_add(&bar[XB_XGEN(b.x)], 1u);
            asm volatile("s_waitcnt vmcnt(0)" ::: "memory");
        } else {
            XB_SPIN(xb_ld(&bar[XB_XGEN(b.x)]) == gen, bar);
            __builtin_amdgcn_fence(__ATOMIC_ACQUIRE, "agent");
            asm volatile("s_waitcnt vmcnt(0)" ::: "memory");
        }
    }
    __syncthreads();
}


__global__ void __launch_bounds__(NTHREADS) fwd_kernel(Params p) {
  extern __shared__ __attribute__((aligned(16))) char smem[];
  cg::grid_group grid = cg::this_grid();
  char* lds = smem;
  volatile LAS unsigned* xb_st = (volatile LAS unsigned*)((LAS char*)smem + (LDS_BYTES - 16));
  if (threadIdx.x < 2) xb_st[threadIdx.x] = 0u;
  __syncthreads();
  const XcdBarrier xbar = xcd_barrier_post((unsigned*)(p.ws + WS_BAR), xb_st);
#define FRESH_IDS const int tid = opaque_tid(), lane = tid & 63, wid = tid >> 6; const int gw = blockIdx.x * 8 + wid, ngw = gridDim.x * 8; bf16* Ks = (bf16*)(lds + wid * WAVE_LDS); bf16* Vs = Ks + 32 * WP; (void)gw; (void)ngw; (void)Ks; (void)Vs; (void)lane;

  phase_prologue(p, lds);
  if (p.ws == nullptr) grid.sync();
  xcd_barrier(xbar);
  for (int rep = 0; rep < REP_GEMM; ++rep) phase_inproj(p, 0, lds);
  xcd_barrier(xbar);
#if EN_A
  for (int rep = 0; rep < REP_SELA; ++rep) { FRESH_IDS
#define SEL_ITEM(k) ((k) * (int)gridDim.x + (((k) & 1) ? (int)gridDim.x - 1 - (int)blockIdx.x : (int)blockIdx.x))
    bf16x8 sqf[4]; float swq[16];
    if (SEL_ITEM(0) < 2 * 2048) sel_load_qw(p, SEL_ITEM(0), sqf, swq, lane);
    for (int k = 0; k * (int)gridDim.x < 2 * 2048; ++k) { const int it = SEL_ITEM(k); int nx = SEL_ITEM(k + 1); if (nx >= 2 * 2048) nx = -1; if (it < 2 * 2048) selectA_item(p, it, nx, lds, sqf, swq); }
#undef SEL_ITEM
  }
  xcd_barrier(xbar);
  { FRESH_IDS for (int rep = 0; rep < REP_AATT; ++rep) for (int it = gw; it < NTOK; it += ngw) mixerA_item(p, it, Ks, Vs, lane); }
#else
  { unsigned* y = (unsigned*)(p.ws + WS_Y); for (int i = blockIdx.x * NTHREADS + (int)threadIdx.x; i < NTOK * 256; i += gridDim.x * NTHREADS) { const int row = i >> 8, c = i & 255; y[row * 512 + c] = 0u; } }
#endif
#if EN_B
  { FRESH_IDS for (int it = gw; it < 4096; it += ngw) mixerB_tile(p, it, Ks, Vs, lane); }
#else
  { unsigned* y = (unsigned*)(p.ws + WS_Y); for (int i = blockIdx.x * NTHREADS + (int)threadIdx.x; i < NTOK * 256; i += gridDim.x * NTHREADS) { const int row = i >> 8, c = i & 255; y[row * 512 + 256 + c] = 0u; } }
#endif
  xcd_barrier(xbar);
  phase_outproj(p, 0, lds);
  xcd_barrier(xbar);
  phase_ple(p, 0, lds);
  xcd_barrier(xbar);
  phase_inproj(p, 1, lds);
  xcd_barrier(xbar);
#if EN_D
  for (int rep = 0; rep < REP_D; ++rep) {
#pragma unroll 1
    for (int u2 = blockIdx.x * 2; u2 < 512; u2 += gridDim.x * 2) {
#pragma unroll 1
      for (int k = 0; k < 2; ++k) { const int u = u2 >> 1, bh = u >> 5, pr = u & 31; mixerD_unit(p, bh >> 2, bh & 3, k ? 63 - pr : pr, lds); }
    }
  }
#else
  { unsigned* y = (unsigned*)(p.ws + WS_Y); for (int i = blockIdx.x * NTHREADS + (int)threadIdx.x; i < NTOK * 256; i += gridDim.x * NTHREADS) { const int row = i >> 8, c = i & 255; y[row * 512 + 256 + c] = 0u; } }
#endif
#if EN_C
  __syncthreads();
  { FRESH_IDS for (int rep = 0; rep < REP_C; ++rep) for (int it = gw; it < 4096; it += ngw) mixerC_tile(p, it, Ks, Vs, lane); }
#else
  { unsigned* y = (unsigned*)(p.ws + WS_Y); for (int i = blockIdx.x * NTHREADS + (int)threadIdx.x; i < NTOK * 256; i += gridDim.x * NTHREADS) { const int row = i >> 8, c = i & 255; y[row * 512 + c] = 0u; } }
#endif
  xcd_barrier(xbar);
  phase_outproj(p, 1, lds);
  xcd_barrier(xbar);
  phase_ple(p, 1, lds);
}

extern "C" void kernel_launch(void* const* d_in, const int* in_sizes, int n_in, void* d_out, int out_size, void* d_ws, size_t ws_size, hipStream_t stream) {
  static int grid_blocks = 0;
  if (!grid_blocks) {
    int dev = 0, cus = 0, per_cu = 0;
    hipGetDevice(&dev);
    hipDeviceGetAttribute(&cus, hipDeviceAttributeMultiprocessorCount, dev);
    hipFuncSetAttribute((const void*)fwd_kernel, hipFuncAttributeMaxDynamicSharedMemorySize, LDS_BYTES);
    hipOccupancyMaxActiveBlocksPerMultiprocessor(&per_cu, (const void*)fwd_kernel, NTHREADS, LDS_BYTES);
    if (per_cu < 1) per_cu = 1;
    grid_blocks = cus * per_cu;
    if (grid_blocks > 256) grid_blocks = 256;
  }
  Params p{};
  for (int i = 0; i < 25; ++i) p.in[i] = (const float*)d_in[i];
  p.out = (float*)d_out; p.ws = (unsigned char*)d_ws;
  for (int i = 0; i < 32; ++i) p.inv_freq[i] = (float)pow(10000.0, -(double)i / 32.0);
  (void)hipMemsetAsync((char*)d_ws + WS_BAR, 0, 16384, stream);
  void* args[] = {&p};
  hipError_t e = hipLaunchCooperativeKernel((const void*)fwd_kernel, dim3(grid_blocks), dim3(NTHREADS), args, LDS_BYTES, stream);
  if (e != hipSuccess) fprintf(stderr, "cooperative launch failed: %s (grid %d)\n", hipGetErrorString(e), grid_blocks);
}
```

```cpp
#include <hip/hip_runtime.h>
#include <hip/hip_cooperative_groups.h>
#include <cstdio>
#include <cmath>
namespace cg = cooperative_groups;

#ifndef REP_GEMM
#define REP_GEMM 1
#endif
#ifndef REP_SELA
#define REP_SELA 1
#endif
#ifndef REP_D
#define REP_D 1
#endif
#ifndef REP_C
#define REP_C 1
#endif
#ifndef REP_AATT
#define REP_AATT 1
#endif
#ifndef EN_A
#define EN_A 1
#endif
#ifndef EN_B
#define EN_B 1
#endif
#ifndef EN_C
#define EN_C 1
#endif
#ifndef EN_D
#define EN_D 1
#endif

typedef unsigned short bf16;
typedef short bf16x8 __attribute__((ext_vector_type(8)));
typedef short s16x4 __attribute__((ext_vector_type(4)));
typedef float f32x4 __attribute__((ext_vector_type(4)));
typedef float f32x16 __attribute__((ext_vector_type(16)));
typedef unsigned u32x4 __attribute__((ext_vector_type(4)));
typedef unsigned u32x2 __attribute__((ext_vector_type(2)));
typedef float f32x2_t __attribute__((ext_vector_type(2)));
typedef __bf16 bf16x2_t __attribute__((ext_vector_type(2)));
#define LAS __attribute__((address_space(3)))
#define DI __device__ __forceinline__

constexpr int SEQ = 8192, NTOK = 16384, DM = 1024;
constexpr int NPE = 3072, NPO = 4096;
constexpr float EPS = 1e-6f;
constexpr float LOG2E = 1.4426950408889634f;
constexpr int NTHREADS = 512;
constexpr int LDS_BYTES = 150 * 1024;

constexpr size_t MiB = 1u << 20;
constexpr size_t WS_PE = 0;
constexpr size_t WS_ACT = 128 * MiB;
constexpr size_t WS_Y = 160 * MiB;
constexpr size_t WS_WINE = 192 * MiB;
constexpr size_t WS_WOUTE = 198 * MiB;
constexpr size_t WS_WINO = 200 * MiB;
constexpr size_t WS_WOUTO = 208 * MiB;
constexpr size_t WS_WG0 = 210 * MiB;
constexpr size_t WS_WG1 = 212 * MiB;
constexpr size_t WS_WP0 = 214 * MiB;
constexpr size_t WS_WP1 = 215 * MiB;
constexpr size_t WS_ROPE = 216 * MiB;
constexpr size_t WS_SEL = 218 * MiB;
constexpr size_t WS_IW = 226 * MiB;
constexpr size_t WS_SS = 227 * MiB;
constexpr size_t WS_LAM = 228 * MiB;
constexpr size_t WS_BAR = 250 * MiB;
constexpr size_t WS_PBF = 232 * MiB;
constexpr size_t WS_IKS = 229 * MiB;

struct Params {
  const float* in[25];
  float* out;
  unsigned char* ws;
  float inv_freq[32];
};
enum { I_X = 0, I_P, I_NORM_GAIN, I_W_IN_EVEN, I_W_OUT_EVEN, I_A_Q_GAIN, I_A_K_GAIN, I_IDX_K_GAIN, I_B_Q_GAIN, I_B_K_GAIN, I_B_SINKS,
       I_W_IN_ODD, I_W_OUT_ODD, I_C_Q_GAIN, I_C_K_GAIN, I_D_Q_GAIN, I_D_K_GAIN, I_LQ1, I_LK1, I_LQ2, I_LK2, I_SUB_GAIN, I_PLE_NORM_GAIN,
       I_W_PLE_GATE, I_W_PLE_PROJ };

DI unsigned cvtpk(float lo, float hi) { f32x2_t v = {lo, hi}; bf16x2_t b = __builtin_convertvector(v, bf16x2_t); return __builtin_bit_cast(unsigned, b); }
DI float bf2f(bf16 b) { return __uint_as_float(((unsigned)b) << 16); }
DI float fexp2(float x) { return __builtin_amdgcn_exp2f(x); }
DI f32x16 mfma32(bf16x8 a, bf16x8 b, f32x16 c) { return __builtin_amdgcn_mfma_f32_32x32x16_bf16(a, b, c, 0, 0, 0); }
DI f32x4 mfma16(bf16x8 a, bf16x8 b, f32x4 c) { return __builtin_amdgcn_mfma_f32_16x16x32_bf16(a, b, c, 0, 0, 0); }
DI int crow(int i, int h) { return (i & 3) + 8 * (i >> 2) + 4 * h; }
DI s16x4 trread(const bf16* p) { return __builtin_bit_cast(s16x4, __builtin_amdgcn_ds_read_tr16_b64_v4i16((LAS s16x4*)p)); }
DI int opaque_tid() { int t = threadIdx.x; asm volatile("" : "+v"(t)); return t; }
DI void lds_barrier() { asm volatile("s_waitcnt lgkmcnt(0)" ::: "memory"); __builtin_amdgcn_s_barrier(); asm volatile("" ::: "memory"); }
DI void lds_fence() { asm volatile("s_waitcnt lgkmcnt(0)" ::: "memory"); __builtin_amdgcn_wave_barrier(); }

__host__ __device__ __forceinline__ int phys_col(int n) { return (n & ~255) + 128 * ((n >> 5) & 1) + 32 * ((n >> 6) & 3) + (n & 31); }
DI int map_even(int n) { return n < 1216 ? n : (n < 1224 ? 3008 + (n - 1216) : n - 8); }
DI void transpose_tile(const float* W, int K, int N, bf16* WT, int mapmode, int tile, float* scr) {
  const int tid = opaque_tid();
  const int ntn = (N + 63) >> 6, kt = tile / ntn, nt = tile % ntn, k0 = kt * 64, n0 = nt * 64;
#pragma unroll
  for (int i = 0; i < 8; ++i) {
    const int kk = (tid >> 6) + 8 * i, nn = tid & 63, n = n0 + nn;
    scr[kk * 65 + nn] = (n < N) ? W[(size_t)(k0 + kk) * N + n] : 0.f;
  }
  __syncthreads();
  {
    const int nn = tid >> 3, kc = tid & 7, n = n0 + nn;
    if (n < N) {
      const int dst = mapmode == 1 ? phys_col(map_even(n)) : (mapmode == 2 ? phys_col(n) : n);
      const float* s = scr + (kc * 8) * 65 + nn;
      u32x4 o; o.x = cvtpk(s[0], s[65]); o.y = cvtpk(s[2 * 65], s[3 * 65]); o.z = cvtpk(s[4 * 65], s[5 * 65]); o.w = cvtpk(s[6 * 65], s[7 * 65]);
      *(u32x4*)(WT + (size_t)dst * K + k0 + kc * 8) = o;
    }
  }
  __syncthreads();
}

DI float wave_sum(float v) {
#pragma unroll
  for (int o = 1; o < 64; o <<= 1) v += __shfl_xor(v, o);
  return v;
}

DI void phase_prologue(const Params& p, char* lds) {
  const int tid = opaque_tid(), lane = tid & 63, wid = tid >> 6;
  const int nb = gridDim.x, bid = blockIdx.x;
  unsigned char* ws = p.ws;
  float* scr = (float*)lds;
  const int T0 = 16 * 48, T1 = 256, T2 = 16 * 64, T3 = 256, T4 = 256, T5 = 256, T6 = 64, T7 = 64;
  const int NT = T0 + T1 + T2 + T3 + T4 + T5 + T6 + T7;
  for (int it = bid; it < NT; it += nb) {
    int r = it;
    if (r < T0) { transpose_tile(p.in[I_W_IN_EVEN], 1024, 3016, (bf16*)(ws + WS_WINE), 1, r, scr); continue; } r -= T0;
    if (r < T1) { transpose_tile(p.in[I_W_OUT_EVEN], 1024, 1024, (bf16*)(ws + WS_WOUTE), 0, r, scr); continue; } r -= T1;
    if (r < T2) { transpose_tile(p.in[I_W_IN_ODD], 1024, 4096, (bf16*)(ws + WS_WINO), 2, r, scr); continue; } r -= T2;
    if (r < T3) { transpose_tile(p.in[I_W_OUT_ODD], 1024, 1024, (bf16*)(ws + WS_WOUTO), 0, r, scr); continue; } r -= T3;
    if (r < T4) { transpose_tile(p.in[I_W_PLE_GATE], 1024, 1024, (bf16*)(ws + WS_WG0), 0, r, scr); continue; } r -= T4;
    if (r < T5) { transpose_tile(p.in[I_W_PLE_GATE] + 1024 * 1024, 1024, 1024, (bf16*)(ws + WS_WG1), 0, r, scr); continue; } r -= T5;
    if (r < T6) { transpose_tile(p.in[I_W_PLE_PROJ], 256, 1024, (bf16*)(ws + WS_WP0), 0, r, scr); continue; } r -= T6;
    transpose_tile(p.in[I_W_PLE_PROJ] + 256 * 1024, 256, 1024, (bf16*)(ws + WS_WP1), 0, r, scr);
  }
  const int gt = bid * NTHREADS + tid, ngt = nb * NTHREADS;
  { unsigned* z = (unsigned*)(ws + WS_WINE); for (int i = gt; i < 56 * 512; i += ngt) z[(size_t)phys_col(3016 + (i >> 9)) * 512 + (i & 511)] = 0u; }
  { float* ss = (float*)(ws + WS_SS); for (int i = gt; i < 3 * NTOK; i += ngt) ss[i] = 0.f; }
  { float2* tab = (float2*)(ws + WS_ROPE);
    for (int i = gt; i < SEQ * 32; i += ngt) {
      const int pos = i >> 5, k = i & 31;
      const float ang = (float)pos * p.inv_freq[k];
      double rev = (double)ang * 0.15915494309189535; rev -= floor(rev);
      const float rf = (float)rev;
      tab[i] = make_float2(__builtin_amdgcn_cosf(rf), __builtin_amdgcn_sinf(rf));
    } }
  if (bid == 0 && wid == 0) {
    const float a = wave_sum(p.in[I_LQ1][lane] * p.in[I_LK1][lane]);
    const float b = wave_sum(p.in[I_LQ2][lane] * p.in[I_LK2][lane]);
    const float lambda_init = 0.8f - 0.6f * expf(-0.3f);
    if (lane == 0) *(float*)(ws + WS_LAM) = expf(a) - expf(b) + lambda_init;
  }
  { const float* x = p.in[I_X]; const float* g = p.in[I_NORM_GAIN]; bf16* H = (bf16*)(ws + WS_ACT);
    const int gw = bid * 8 + wid, ngw = nb * 8;
    for (int m = gw; m < NTOK; m += ngw) {
      const f32x4* xr = (const f32x4*)(x + (size_t)m * DM) + lane;
      f32x4 v[4]; float s = 0.f;
#pragma unroll
      for (int j = 0; j < 4; ++j) { v[j] = xr[64 * j]; s += v[j].x * v[j].x + v[j].y * v[j].y + v[j].z * v[j].z + v[j].w * v[j].w; }
      const float rstd = rsqrtf(wave_sum(s) * (1.f / DM) + EPS);
      u32x2* o = (u32x2*)(H + (size_t)m * DM) + lane;
#pragma unroll
      for (int j = 0; j < 4; ++j) { const f32x4 gg = *((const f32x4*)g + lane + 64 * j); u32x2 w; w.x = cvtpk(v[j].x * rstd * gg.x, v[j].y * rstd * gg.y); w.y = cvtpk(v[j].z * rstd * gg.z, v[j].w * rstd * gg.w); o[64 * j] = w; }
    } }
}

namespace pg8 {
#define PG8_LAS __attribute__((address_space(3)))
typedef unsigned short bf16_t;
typedef short bf16x8 __attribute__((ext_vector_type(8)));
typedef float f32x4 __attribute__((ext_vector_type(4)));
typedef unsigned u32x4 __attribute__((ext_vector_type(4)));
constexpr int BM = 256, BK = 64, HALF = 128, HTB = HALF * BK * 2  , STAGE_BYTES = 8 * HTB, NXCD = 8, WGM = 8;

__host__ __device__ __forceinline__ int lds_byte(int r, int c) { const int st = (r >> 4) * 2 + (c >> 5), rr = r & 15, cc = c & 31, ob = rr * 64 + cc * 2; return st * 1024 + (ob ^ (((ob >> 9) & 1) << 5)); }
__host__ __device__ __forceinline__ void stage_rc(int b, int& R, int& C) { const int st = b / 1024, sb = b % 1024, swz = sb ^ (((sb >> 9) & 1) << 5); R = (st >> 1) * 16 + swz / 64; C = (st & 1) * 32 + (swz % 64) / 2; }
__host__ __device__ __forceinline__ int perm32(int rho) { const int n = rho >> 4, i = rho & 15; return 8 * (i >> 2) + 4 * n + (i & 3); }

struct Unit { int pm, pn; };
struct Gemm { const bf16_t* A; const bf16_t* Bt; int M, N, K; };

struct StaticOrder {
    int nM, nN, nwg, G, c;
    __host__ __device__ void init(int M, int N, int G_, int c_) { nM = M / BM; nN = N / BM; nwg = nM * nN; G = G_; c = c_; }
    __host__ __device__ bool next(int i, Unit& u) const {
        const long L = (long)i * G + c; if (L >= nwg) return false;
        int wgid = (int)L; { const int q = nwg / NXCD, r = nwg % NXCD, xcd = wgid % NXCD, off = wgid / NXCD; wgid = (xcd < r ? xcd * (q + 1) : r * (q + 1) + (xcd - r) * q) + off; }
        const int nig = WGM * nN, gid = wgid / nig, fm = gid * WGM, gsz = (nM - fm) < WGM ? (nM - fm) : WGM;
        u.pm = fm + ((wgid % nig) % gsz); u.pn = (wgid % nig) / gsz; return true;
    }
    __device__ __forceinline__ void a_ready(const Unit&) const {}
    __device__ __forceinline__ void done(const Unit&) const {}
};
__device__ __forceinline__ unsigned cvt_pk_bf16(float lo, float hi) { unsigned r; asm volatile("v_cvt_pk_bf16_f32 %0, %1, %2" : "=v"(r) : "v"(lo), "v"(hi)); return r; }
template <class Epi, class Sched, bool ALIGN_EPI = false, bool SP2 = false>
__device__ __forceinline__ void gemm_phase(PG8_LAS unsigned char* lds, const Gemm g, const Sched& S, const Epi& E) {
    int tid_ = threadIdx.x; asm volatile("" : "+v"(tid_));
    const int tid = tid_, wid = __builtin_amdgcn_readfirstlane(tid >> 6), lane = tid & 63, wr = wid >> 2, wc = wid & 3, fr = lane & 15, fq = lane >> 4;
    const int K = g.K, nt = K / BK;
    unsigned voffA[2], voffB[2];
#pragma unroll
    for (int i = 0; i < 2; ++i) { int R, C; stage_rc(tid * 16 + i * 8192, R, C); const int Rb = Epi::PERM ? ((R & ~31) + perm32(R & 31)) : R;
        voffA[i] = (unsigned)(R * K + C) * 2u; voffB[i] = (unsigned)(Rb * K + C) * 2u; }
    const size_t kstep = (size_t)(BK * 2);
    const size_t hstep = (size_t)HALF * K * 2;
    const size_t tstep = 2 * hstep;
    const unsigned ldsw = (unsigned)wid * 1024u;
    const int aoff = lds_byte(wr * 64 + fr, fq * 8), boff = lds_byte(wc * 32 + fr, fq * 8);
#define PG8_SA(b, h) (((b) * 2 + (h)) * HTB)
#define PG8_SB(b, h) ((4 + (b) * 2 + (h)) * HTB)
#define PG8_STAGE(bufoff, gbase, voff) do { _Pragma("unroll") for (int _i = 0; _i < 2; ++_i) \
        __builtin_amdgcn_global_load_lds((const unsigned*)((const char*)(gbase) + (voff)[_i]), (PG8_LAS unsigned*)(lds + (bufoff) + ldsw + _i * 8192), 16, 0, 0); } while (0)
#define PG8_LDA(dst, b, h) do { _Pragma("unroll") for (int m = 0; m < 4; ++m) _Pragma("unroll") for (int k = 0; k < 2; ++k) dst[m][k] = *(const PG8_LAS bf16x8*)(lds + PG8_SA(b, h) + aoff + m * 2048 + k * 1024); } while (0)
#define PG8_LDB(dst, b, h) do { _Pragma("unroll") for (int n = 0; n < 2; ++n) _Pragma("unroll") for (int k = 0; k < 2; ++k) dst[n][k] = *(const PG8_LAS bf16x8*)(lds + PG8_SB(b, h) + boff + n * 2048 + k * 1024); } while (0)
#define PG8_MMA(ai, bj, At, Bt) do { __builtin_amdgcn_s_setprio(1); _Pragma("unroll") for (int m = 0; m < 4; ++m) _Pragma("unroll") for (int n = 0; n < 2; ++n) _Pragma("unroll") for (int k = 0; k < 2; ++k) \
        acc[ai][bj][m][n] = __builtin_amdgcn_mfma_f32_16x16x32_bf16(Bt[n][k], At[m][k], acc[ai][bj][m][n], 0, 0, 0); __builtin_amdgcn_s_setprio(0); } while (0)
#define PG8_WAIT_V(n) asm volatile("s_waitcnt vmcnt(" #n ")" ::: "memory")
#define PG8_WAIT_L(n) asm volatile("s_waitcnt lgkmcnt(" #n ")" ::: "memory")
#define PG8_BAR __builtin_amdgcn_s_barrier()
#define PG8_SCHED __builtin_amdgcn_sched_barrier(0)
    Unit cur, nxt; int ui = 0;
    if (!S.next(0, cur)) return;
    f32x4 acc[2][2][4][2];
#pragma unroll
    for (int a = 0; a < 2; ++a)
#pragma unroll
        for (int b = 0; b < 2; ++b)
#pragma unroll
            for (int m = 0; m < 4; ++m)
#pragma unroll
                for (int n = 0; n < 2; ++n) acc[a][b][m][n] = (f32x4){0.f, 0.f, 0.f, 0.f};
    bf16x8 At[4][2], B0[2][2], B1[2][2];
    const char* cA = (const char*)g.A + (size_t)cur.pm * tstep; const char* cB = (const char*)g.Bt + (size_t)cur.pn * tstep;
    S.a_ready(cur);
    if constexpr (SP2) {
        PG8_STAGE(PG8_SB(0, 0), cB, voffB); PG8_STAGE(PG8_SB(0, 1), cB + hstep, voffB); PG8_STAGE(PG8_SA(0, 0), cA, voffA); PG8_STAGE(PG8_SA(0, 1), cA + hstep, voffA);
        if (wr == 1) PG8_BAR;
        PG8_WAIT_V(2); PG8_BAR;
        PG8_STAGE(PG8_SB(1, 0), cB + kstep, voffB); PG8_STAGE(PG8_SA(1, 0), cA + kstep, voffA); PG8_STAGE(PG8_SB(1, 1), cB + hstep + kstep, voffB);
        PG8_WAIT_V(6); PG8_BAR;
    } else {
        PG8_STAGE(PG8_SB(0, 0), cB, voffB); PG8_STAGE(PG8_SA(0, 0), cA, voffA); PG8_STAGE(PG8_SB(0, 1), cB + hstep, voffB); PG8_STAGE(PG8_SA(0, 1), cA + hstep, voffA);
        if (wr == 1) PG8_BAR;
        PG8_WAIT_V(4); PG8_BAR;
        PG8_STAGE(PG8_SB(1, 0), cB + kstep, voffB); PG8_STAGE(PG8_SA(1, 0), cA + kstep, voffA); PG8_STAGE(PG8_SB(1, 1), cB + hstep + kstep, voffB);
        PG8_WAIT_V(6); PG8_BAR;
    }
    for (;;) {
        const bool has_next = S.next(ui + 1, nxt);
        const char* nA = has_next ? (const char*)g.A + (size_t)nxt.pm * tstep : cA; const char* nB = has_next ? (const char*)g.Bt + (size_t)nxt.pn * tstep : cB;
        for (int t = 0; t < nt; t += 2) {
            const bool last = (t == nt - 2);
            const char* a1 = cA + (size_t)(t + 1) * kstep;
            const char* a2 = last ? nA : cA + (size_t)(t + 2) * kstep; const char* b2 = last ? nB : cB + (size_t)(t + 2) * kstep;
            const char* a3 = a2 + kstep; const char* b3 = b2 + kstep;
            if (last && has_next) S.a_ready(nxt);
            if constexpr (SP2) {
            PG8_LDB(B0, 0, 0); PG8_LDB(B1, 0, 1); PG8_SCHED; PG8_LDA(At, 0, 0); PG8_STAGE(PG8_SA(1, 1), a1 + hstep, voffA);
            PG8_WAIT_V(8); PG8_WAIT_L(0); PG8_BAR; PG8_MMA(0, 0, At, B0); PG8_MMA(0, 1, At, B1); PG8_BAR; PG8_SCHED;
            PG8_LDA(At, 0, 1); PG8_STAGE(PG8_SB(0, 0), b2, voffB); PG8_STAGE(PG8_SB(0, 1), b2 + hstep, voffB); PG8_STAGE(PG8_SA(0, 0), a2, voffA);
            PG8_WAIT_V(8); PG8_WAIT_L(0); PG8_BAR; PG8_MMA(1, 0, At, B0); PG8_MMA(1, 1, At, B1); PG8_BAR; PG8_SCHED;
            PG8_LDB(B0, 1, 0); PG8_LDB(B1, 1, 1); PG8_SCHED; PG8_LDA(At, 1, 0); PG8_STAGE(PG8_SA(0, 1), a2 + hstep, voffA);
            PG8_WAIT_V(8); PG8_WAIT_L(0); PG8_BAR; PG8_MMA(0, 0, At, B0); PG8_MMA(0, 1, At, B1); PG8_BAR; PG8_SCHED;
            PG8_LDA(At, 1, 1); PG8_STAGE(PG8_SB(1, 0), b3, voffB); PG8_STAGE(PG8_SB(1, 1), b3 + hstep, voffB); PG8_STAGE(PG8_SA(1, 0), a3, voffA);
            PG8_WAIT_V(8); PG8_WAIT_L(0); PG8_BAR; PG8_MMA(1, 0, At, B0); PG8_MMA(1, 1, At, B1); PG8_BAR; PG8_SCHED;
            } else {
            PG8_LDB(B0, 0, 0); PG8_SCHED; PG8_LDA(At, 0, 0); PG8_STAGE(PG8_SA(1, 1), a1 + hstep, voffA);
            PG8_WAIT_L(8); PG8_BAR; PG8_WAIT_L(0); PG8_MMA(0, 0, At, B0); PG8_BAR; PG8_SCHED;
            PG8_LDB(B1, 0, 1); PG8_STAGE(PG8_SB(0, 0), b2, voffB);
            PG8_BAR; PG8_WAIT_L(0); PG8_MMA(0, 1, At, B1); PG8_BAR;
            PG8_LDA(At, 0, 1); PG8_STAGE(PG8_SA(0, 0), a2, voffA);
            PG8_BAR; PG8_WAIT_L(0); PG8_MMA(1, 0, At, B0); PG8_BAR; PG8_SCHED;
            PG8_STAGE(PG8_SB(0, 1), b2 + hstep, voffB);
            PG8_WAIT_V(6); PG8_BAR; PG8_MMA(1, 1, At, B1); PG8_BAR;
            PG8_LDB(B0, 1, 0); PG8_SCHED; PG8_LDA(At, 1, 0); PG8_STAGE(PG8_SA(0, 1), a2 + hstep, voffA);
            PG8_WAIT_L(8); PG8_BAR; PG8_WAIT_L(0); PG8_MMA(0, 0, At, B0); PG8_BAR; PG8_SCHED;
            PG8_LDB(B1, 1, 1); PG8_STAGE(PG8_SB(1, 0), b3, voffB);
            PG8_BAR; PG8_WAIT_L(0); PG8_MMA(0, 1, At, B1); PG8_BAR;
            PG8_LDA(At, 1, 1); PG8_STAGE(PG8_SA(1, 0), a3, voffA);
            PG8_BAR; PG8_WAIT_L(0); PG8_MMA(1, 0, At, B0); PG8_BAR; PG8_SCHED;
            PG8_STAGE(PG8_SB(1, 1), b3 + hstep, voffB);
            PG8_WAIT_V(6); PG8_BAR; PG8_MMA(1, 1, At, B1); PG8_BAR;
            }
        }
        if constexpr (ALIGN_EPI) { if (wr == 0) PG8_BAR; }
        if constexpr (!Epi::AFTER_DRAIN) { E(acc, cur, wr, wc, fr, fq); S.done(cur); }
        if (!has_next) break;
#pragma unroll
        for (int a = 0; a < 2; ++a)
#pragma unroll
            for (int b = 0; b < 2; ++b)
#pragma unroll
                for (int m = 0; m < 4; ++m)
#pragma unroll
                    for (int n = 0; n < 2; ++n) acc[a][b][m][n] = (f32x4){0.f, 0.f, 0.f, 0.f};
        cur = nxt; cA = nA; cB = nB; ++ui;
        if constexpr (ALIGN_EPI) { if (wr == 1) PG8_BAR; }
    }
    PG8_WAIT_V(0);
    if constexpr (!ALIGN_EPI) { if (wr == 0) PG8_BAR; }
    PG8_BAR;
    if constexpr (Epi::AFTER_DRAIN) { E.fused(acc, cur, wr, wc, fr, fq, lds, wid, lane); S.done(cur); }
#undef PG8_SA
#undef PG8_SB
#undef PG8_STAGE
#undef PG8_LDA
#undef PG8_LDB
#undef PG8_MMA
#undef PG8_WAIT_V
#undef PG8_WAIT_L
#undef PG8_BAR
#undef PG8_SCHED
}
}

enum { T_PLAIN = 0, T_NR = 1, T_ROPE = 2, T_SILU = 3, T_IW = 4 };
DI void slot_info(const Params& p, int layer, int slot, int& type, const float*& gain) {
  gain = nullptr;
  if (layer == 0) {
    if (slot < 8) { type = T_NR; gain = p.in[I_A_Q_GAIN]; }
    else if (slot == 8) { type = T_NR; gain = p.in[I_A_K_GAIN]; }
    else if (slot == 9) type = T_PLAIN;
    else if (slot < 18) type = T_ROPE;
    else if (slot == 18) { type = T_NR; gain = p.in[I_IDX_K_GAIN]; }
    else if (slot < 27) type = T_SILU;
    else if (slot < 35) { type = T_NR; gain = p.in[I_B_Q_GAIN]; }
    else if (slot < 37) { type = T_NR; gain = p.in[I_B_K_GAIN]; }
    else if (slot < 39) type = T_PLAIN;
    else if (slot < 47) type = T_SILU;
    else type = T_IW;
  } else {
    if (slot < 8) { type = T_NR; gain = p.in[I_C_Q_GAIN]; }
    else if (slot < 16) { type = T_NR; gain = p.in[I_C_K_GAIN]; }
    else if (slot < 24) type = T_PLAIN;
    else if (slot < 32) type = T_SILU;
    else if (slot < 40) { type = T_NR; gain = p.in[I_D_Q_GAIN]; }
    else if (slot < 48) { type = T_NR; gain = p.in[I_D_K_GAIN]; }
    else if (slot < 56) type = T_PLAIN;
    else type = T_SILU;
  }
}
constexpr int E_AQ = 0, E_AK = 512, E_AV = 576, E_IQ = 640, E_IK = 1152, E_AG = 1216, E_BQ = 1728, E_BK = 2240, E_BV = 2368, E_BG = 2496;
constexpr int O_CQ = 0, O_CK = 512, O_CV = 1024, O_CG = 1536, O_DQ = 2048, O_DK = 2560, O_DV = 3072, O_DG = 3584;

typedef pg8::f32x4 (AccT)[2][2][4][2];

struct EpiInProj {
  static constexpr bool PERM = false, AFTER_DRAIN = false;
  const Params& p; int layer;
  DI void operator()(const f32x4 (&acc)[2][2][4][2], const pg8::Unit& u, int wr, int wc, int fr, int fq) const {
    unsigned char* ws = p.ws;
    const int NP = layer == 0 ? NPE : NPO;
    bf16* PE = (bf16*)(ws + WS_PE);
    const float2* rope = (const float2*)(ws + WS_ROPE);
    const float* ss1 = (const float*)(ws + WS_SS);
    float* IW = (float*)(ws + WS_IW);
    const int slot = u.pn * 4 + wc;
    int type; const float* gain; slot_info(p, layer, slot, type, gain);
#pragma unroll
    for (int ai = 0; ai < 2; ++ai)
#pragma unroll
      for (int m = 0; m < 4; ++m) {
        const int row = u.pm * 256 + ai * 128 + wr * 64 + m * 16 + fr, pos = row & (SEQ - 1);
        float sc = 1.f;
        if (layer == 1) sc = rsqrtf(ss1[row] * (1.f / DM) + EPS);
        f32x4 v1[2], v2[2];
#pragma unroll
        for (int n = 0; n < 2; ++n) { v1[n] = acc[ai][0][m][n] * sc; v2[n] = acc[ai][1][m][n] * sc; }
        if (type == T_NR) {
          float s = 0.f;
#pragma unroll
          for (int n = 0; n < 2; ++n) s += v1[n].x * v1[n].x + v1[n].y * v1[n].y + v1[n].z * v1[n].z + v1[n].w * v1[n].w + v2[n].x * v2[n].x + v2[n].y * v2[n].y + v2[n].z * v2[n].z + v2[n].w * v2[n].w;
          s += __shfl_xor(s, 16); s += __shfl_xor(s, 32);
          const float rn = rsqrtf(s * (1.f / 64.f) + EPS);
#pragma unroll
          for (int n = 0; n < 2; ++n) { const f32x4 g1 = *(const f32x4*)(gain + n * 16 + fq * 4), g2 = *(const f32x4*)(gain + 32 + n * 16 + fq * 4); v1[n] = v1[n] * rn * g1; v2[n] = v2[n] * rn * g2; }
        }
        if (type == T_NR || type == T_ROPE) {
#pragma unroll
          for (int n = 0; n < 2; ++n) {
            const f32x4* cs = (const f32x4*)(rope + (size_t)pos * 32 + n * 16 + fq * 4);
            const f32x4 c01 = cs[0], c23 = cs[1];
            const f32x4 x1 = v1[n], x2 = v2[n];
            f32x4 o1, o2;
            o1.x = x1.x * c01.x - x2.x * c01.y; o2.x = x2.x * c01.x + x1.x * c01.y;
            o1.y = x1.y * c01.z - x2.y * c01.w; o2.y = x2.y * c01.z + x1.y * c01.w;
            o1.z = x1.z * c23.x - x2.z * c23.y; o2.z = x2.z * c23.x + x1.z * c23.y;
            o1.w = x1.w * c23.z - x2.w * c23.w; o2.w = x2.w * c23.z + x1.w * c23.w;
            v1[n] = o1; v2[n] = o2;
          }
        }
        if (type == T_SILU) {
#pragma unroll
          for (int n = 0; n < 2; ++n)
#pragma unroll
            for (int j = 0; j < 4; ++j) { const float a = v1[n][j]; v1[n][j] = a / (1.f + __expf(-a)); const float b = v2[n][j]; v2[n][j] = b / (1.f + __expf(-b)); }
        }
        if (type == T_IW) {
          if (fq < 2) *(f32x4*)(IW + (size_t)row * 8 + fq * 4) = v1[0];
        } else {
          bf16* dst = PE + (size_t)row * NP + slot * 64 + fq * 4;
#pragma unroll
          for (int n = 0; n < 2; ++n) {
            u32x2 w1, w2; w1.x = cvtpk(v1[n].x, v1[n].y); w1.y = cvtpk(v1[n].z, v1[n].w); w2.x = cvtpk(v2[n].x, v2[n].y); w2.y = cvtpk(v2[n].z, v2[n].w);
            *(u32x2*)(dst + n * 16) = w1; *(u32x2*)(dst + 32 + n * 16) = w2;
            if (layer == 0 && slot == 18) { bf16* IKS = (bf16*)(ws + WS_IKS); const int key = row & (SEQ - 1);
              bf16* base = IKS + (((size_t)(row >> 13) * 256 + (key >> 5)) * 4) * 512 + ((fq >> 1) * 32 + (key & 31)) * 8 + (fq & 1) * 4;
              *(u32x2*)(base + (size_t)n * 512) = w1; *(u32x2*)(base + (size_t)(n + 2) * 512) = w2; }
          }
        }
        asm volatile("" ::: "memory");
      }
  }
};

DI void phase_inproj(const Params& p, int layer, char* lds) {
  unsigned char* ws = p.ws;
  const int NP = layer == 0 ? NPE : NPO;
  pg8::Gemm g{(const bf16*)(ws + (layer == 0 ? WS_ACT : WS_Y)), (const bf16*)(ws + (layer == 0 ? WS_WINE : WS_WINO)), NTOK, NP, DM};
  pg8::StaticOrder S; S.init(NTOK, NP, (int)gridDim.x, (int)blockIdx.x);
  EpiInProj E{p, layer};
  pg8::gemm_phase<EpiInProj, pg8::StaticOrder, true, true>((PG8_LAS unsigned char*)lds, g, S, E);
}

struct EpiOutProj {
  static constexpr bool PERM = false, AFTER_DRAIN = false;
  const float* xin; bf16* X1B; bf16* XG; const float* pg; float* ss;
  DI void operator()(const f32x4 (&acc)[2][2][4][2], const pg8::Unit& u, int wr, int wc, int fr, int fq) const {
#pragma unroll
    for (int ai = 0; ai < 2; ++ai)
#pragma unroll
      for (int m = 0; m < 4; ++m) {
        const int row = u.pm * 256 + ai * 128 + wr * 64 + m * 16 + fr; float rs = 0.f;
#pragma unroll
        for (int bj = 0; bj < 2; ++bj)
#pragma unroll
          for (int n = 0; n < 2; ++n) {
            const int col = u.pn * 256 + bj * 128 + wc * 32 + n * 16 + fq * 4; const size_t off = (size_t)row * DM + col;
            const f32x4 xn = *(const f32x4*)(xin + off) + acc[ai][bj][m][n];
            { u32x2 wx; wx.x = cvtpk(xn.x, xn.y); wx.y = cvtpk(xn.z, xn.w); *(u32x2*)(X1B + off) = wx; }
            rs += xn.x * xn.x + xn.y * xn.y + xn.z * xn.z + xn.w * xn.w;
            const f32x4 gg = *(const f32x4*)(pg + col);
            u32x2 w; w.x = cvtpk(xn.x * gg.x, xn.y * gg.y); w.y = cvtpk(xn.z * gg.z, xn.w * gg.w); *(u32x2*)(XG + off) = w;
          }
        rs += __shfl_xor(rs, 16); rs += __shfl_xor(rs, 32);
        if (fq == 0) atomicAdd(ss + row, rs);
        asm volatile("" ::: "memory");
      }
  }
};
DI void phase_outproj(const Params& p, int layer, char* lds) {
  unsigned char* ws = p.ws;
  pg8::Gemm g{(const bf16*)(ws + WS_Y), (const bf16*)(ws + (layer == 0 ? WS_WOUTE : WS_WOUTO)), NTOK, DM, DM};
  pg8::StaticOrder S; S.init(NTOK, DM, (int)gridDim.x, (int)blockIdx.x);
  EpiOutProj E{layer == 0 ? p.in[I_X] : p.out, (bf16*)(ws + WS_PE + 64 * MiB), (bf16*)(ws + WS_ACT), p.in[I_PLE_NORM_GAIN] + layer * DM, (float*)(ws + WS_SS) + (layer == 0 ? 1 : 2) * NTOK};
  pg8::gemm_phase<EpiOutProj, pg8::StaticOrder, true, true>((PG8_LAS unsigned char*)lds, g, S, E);
}

struct EpiPleProj {
  static constexpr bool PERM = false, AFTER_DRAIN = false;
  bf16* PT;
  DI void operator()(const f32x4 (&acc)[2][2][4][2], const pg8::Unit& u, int wr, int wc, int fr, int fq) const {
#pragma unroll
    for (int ai = 0; ai < 2; ++ai)
#pragma unroll
      for (int m = 0; m < 4; ++m) {
        const int row = u.pm * 256 + ai * 128 + wr * 64 + m * 16 + fr;
#pragma unroll
        for (int bj = 0; bj < 2; ++bj)
#pragma unroll
          for (int n = 0; n < 2; ++n) { const f32x4 a = acc[ai][bj][m][n]; u32x2 w; w.x = cvtpk(a.x, a.y); w.y = cvtpk(a.z, a.w); *(u32x2*)(PT + (size_t)row * DM + u.pn * 256 + bj * 128 + wc * 32 + n * 16 + fq * 4) = w; }
      }
  }
};
struct EpiPleGate {
  static constexpr bool PERM = false, AFTER_DRAIN = false;
  const bf16* PT; const bf16* X1B; float* out; const float* ssx; float* ss1; bf16* H; const float* ng1; int layer;
  DI void operator()(const f32x4 (&acc)[2][2][4][2], const pg8::Unit& u, int wr, int wc, int fr, int fq) const {
#pragma unroll
    for (int ai = 0; ai < 2; ++ai)
#pragma unroll
      for (int m = 0; m < 4; ++m) {
        const int row = u.pm * 256 + ai * 128 + wr * 64 + m * 16 + fr; float rs = 0.f;
        const float rstd = rsqrtf(ssx[row] * (1.f / DM) + EPS);
#pragma unroll
        for (int bj = 0; bj < 2; ++bj)
#pragma unroll
          for (int n = 0; n < 2; ++n) {
            const int col = u.pn * 256 + bj * 128 + wc * 32 + n * 16 + fq * 4; const size_t off = (size_t)row * DM + col;
            f32x4 g;
#pragma unroll
            for (int j = 0; j < 4; ++j) g[j] = 1.f / (1.f + __expf(-rstd * acc[ai][bj][m][n][j]));
            const u32x2 pw = *(const u32x2*)(PT + off); f32x4 pp; pp.x = __uint_as_float(pw.x << 16); pp.y = __uint_as_float(pw.x & 0xffff0000u); pp.z = __uint_as_float(pw.y << 16); pp.w = __uint_as_float(pw.y & 0xffff0000u);
            const u32x2 xw = *(const u32x2*)(X1B + off); f32x4 x1; x1.x = __uint_as_float(xw.x << 16); x1.y = __uint_as_float(xw.x & 0xffff0000u); x1.z = __uint_as_float(xw.y << 16); x1.w = __uint_as_float(xw.y & 0xffff0000u);
            const f32x4 xn = x1 + pp * g;
            *(f32x4*)(out + off) = xn;
            if (layer == 0) {
              rs += xn.x * xn.x + xn.y * xn.y + xn.z * xn.z + xn.w * xn.w;
              const f32x4 gg = *(const f32x4*)(ng1 + col);
              u32x2 w; w.x = cvtpk(xn.x * gg.x, xn.y * gg.y); w.y = cvtpk(xn.z * gg.z, xn.w * gg.w); *(u32x2*)(H + off) = w;
            }
          }
        if (layer == 0) { rs += __shfl_xor(rs, 16); rs += __shfl_xor(rs, 32); if (fq == 0) atomicAdd(ss1 + row, rs); }
        asm volatile("" ::: "memory");
      }
  }
};
DI void phase_ple(const Params& p, int layer, char* lds) {
  unsigned char* ws = p.ws;
  bf16* PT = (bf16*)(ws + WS_PE);
  pg8::StaticOrder S; S.init(NTOK, DM, (int)gridDim.x, (int)blockIdx.x);
  { pg8::Gemm g{(const bf16*)(ws + WS_PBF) + (size_t)layer * NTOK * 256, (const bf16*)(ws + (layer == 0 ? WS_WP0 : WS_WP1)), NTOK, DM, 256};
    EpiPleProj E{PT};
    pg8::gemm_phase<EpiPleProj, pg8::StaticOrder, true, true>((PG8_LAS unsigned char*)lds, g, S, E); }
  { pg8::Gemm g{(const bf16*)(ws + WS_ACT), (const bf16*)(ws + (layer == 0 ? WS_WG0 : WS_WG1)), NTOK, DM, DM};
    EpiPleGate E{PT, (const bf16*)(ws + WS_PE + 64 * MiB), p.out, (const float*)(ws + WS_SS) + (layer == 0 ? 1 : 2) * NTOK, (float*)(ws + WS_SS), (bf16*)(ws + WS_Y), p.in[I_NORM_GAIN] + DM, layer};
    pg8::gemm_phase<EpiPleGate, pg8::StaticOrder, true, true>((PG8_LAS unsigned char*)lds, g, S, E); }
}

DI float half_max(float v) { auto rr = __builtin_amdgcn_permlane32_swap(__float_as_uint(v), __float_as_uint(v), false, false); return fmaxf(__uint_as_float(rr[0]), __uint_as_float(rr[1])); }
template <int DVB, bool MASKED = true>
DI void attn_step32(const bf16* Kt, int KP, const bf16* Vt, int VP, const bf16x8 (&qf)[4], f32x16 (&o)[DVB], float& m, float& l, unsigned vmask, float c2, int lane) {
  const int r32 = lane & 31, h = lane >> 5;
  f32x16 s;
#pragma unroll
  for (int i = 0; i < 16; ++i) s[i] = 0.f;
#pragma unroll
  for (int t = 0; t < 4; ++t) { const bf16x8 kf = *(const bf16x8*)(Kt + r32 * KP + t * 16 + h * 8); s = mfma32(kf, qf[t], s); }
  float mx = -INFINITY;
#pragma unroll
  for (int i = 0; i < 16; ++i) { if (MASKED) { s[i] = ((vmask >> i) & 1u) ? s[i] : -INFINITY; } mx = fmaxf(mx, s[i]); }
  mx = half_max(mx);
  const float mxs = mx * c2;
  if (__any(mxs > m + 6.f)) {
    const float mn = fmaxf(m, mxs);
    const float alpha = fexp2(m - mn); l *= alpha;
#pragma unroll
    for (int d = 0; d < DVB; ++d)
#pragma unroll
      for (int i = 0; i < 16; ++i) o[d][i] *= alpha;
    m = mn;
  }
  float ps = 0.f; const float negm = -m;
#pragma unroll
  for (int i = 0; i < 16; ++i) { const float pv = fexp2(__builtin_fmaf(s[i], c2, negm)); s[i] = pv; ps += pv; }
  l += ps;
  bf16x8 pf[2];
  { u32x4 a, b; a.x = cvtpk(s[0], s[1]); a.y = cvtpk(s[2], s[3]); a.z = cvtpk(s[4], s[5]); a.w = cvtpk(s[6], s[7]);
    b.x = cvtpk(s[8], s[9]); b.y = cvtpk(s[10], s[11]); b.z = cvtpk(s[12], s[13]); b.w = cvtpk(s[14], s[15]);
    pf[0] = __builtin_bit_cast(bf16x8, a); pf[1] = __builtin_bit_cast(bf16x8, b); }
  const int i16 = lane & 15, q = i16 >> 2, pp = i16 & 3, blk = (lane >> 4) & 1;
#pragma unroll
  for (int d = 0; d < DVB; ++d)
#pragma unroll
    for (int sk = 0; sk < 2; ++sk) {
      const s16x4 lo = trread(Vt + (16 * sk + 4 * h + q) * VP + 32 * d + 16 * blk + 4 * pp);
      const s16x4 hi = trread(Vt + (16 * sk + 8 + 4 * h + q) * VP + 32 * d + 16 * blk + 4 * pp);
      const bf16x8 vf = __builtin_shufflevector(lo, hi, 0, 1, 2, 3, 4, 5, 6, 7);
      o[d] = mfma32(vf, pf[sk], o[d]);
    }
}

DI unsigned row_range_mask(int lo, int hi) {
  lo = lo < 0 ? 0 : lo; hi = hi > 31 ? 31 : hi;
  if (hi < lo) return 0u;
  const unsigned upto_hi = (hi >= 31) ? 0xffffffffu : ((1u << (hi + 1)) - 1u);
  return upto_hi & ~((1u << lo) - 1u);
}
DI unsigned lane_rows(unsigned m32, int h) {
  const unsigned t = m32 >> (4 * h);
  return (t & 0xFu) | ((t >> 4) & 0xF0u) | ((t >> 8) & 0xF00u) | ((t >> 12) & 0xF000u);
}
constexpr int WP = 72;
constexpr int WAVE_LDS = 2 * 32 * WP * 2 + 512;

struct KVRegs { u32x4 k[4], v[4]; };
DI void kv_store(const KVRegs& R, bf16* Ks, bf16* Vs, int lane) {
#pragma unroll
  for (int i = 0; i < 4; ++i) { const int row = (lane >> 3) + 8 * i, ch = lane & 7; *(u32x4*)(Ks + row * WP + ch * 8) = R.k[i]; *(u32x4*)(Vs + row * WP + ch * 8) = R.v[i]; }
}

DI void band_load(KVRegs& R, const bf16* Kg, const bf16* Vg, int NP, int kstart, int dil, int roff, int lane) {
#pragma unroll
  for (int i = 0; i < 4; ++i) {
    const int row = (lane >> 3) + 8 * i, ch = lane & 7; int k = kstart + row; if (k < 0) k = 0;
    const size_t off = (size_t)(dil * k + roff) * NP + ch * 8;
    R.k[i] = *(const u32x4*)(Kg + off); R.v[i] = *(const u32x4*)(Vg + off);
  }
}
template <int DVB>
DI void band_run(const bf16* Kg, const bf16* Vg, int NP, int kbase, int nsteps, int dil, int roff, int qidx, int win,
                 const bf16x8 (&qf)[4], f32x16 (&o)[DVB], float& m, float& l, float c2, bf16* Ks, bf16* Vs, int lane) {
  const int h = lane >> 5;
  KVRegs R; band_load(R, Kg, Vg, NP, kbase, dil, roff, lane);
  for (int j = 0; j < nsteps; ++j) {
    lds_fence();
    kv_store(R, Ks, Vs, lane);
    lds_fence();
    if (j + 1 < nsteps) band_load(R, Kg, Vg, NP, kbase + 32 * (j + 1), dil, roff, lane);
    const int kb = kbase + 32 * j, lo_r = (qidx - win > 0 ? qidx - win : 0) - kb;
    const unsigned vm = lane_rows(row_range_mask(lo_r, qidx - kb), h);
    attn_step32<DVB>(Ks, WP, Vs, WP, qf, o, m, l, vm, c2, lane);
  }
}

DI void write_o64(const f32x16 (&o)[2], float linv, const bf16* gate_row, bf16* y_row, int h) {
#pragma unroll
  for (int d = 0; d < 2; ++d)
#pragma unroll
    for (int g = 0; g < 4; ++g) {
      const int dd = 32 * d + 8 * g + 4 * h;
      const u32x2 gv = *(const u32x2*)(gate_row + dd);
      const float g0 = __uint_as_float(gv.x << 16), g1 = __uint_as_float(gv.x & 0xffff0000u), g2 = __uint_as_float(gv.y << 16), g3 = __uint_as_float(gv.y & 0xffff0000u);
      u32x2 w; w.x = cvtpk(o[d][4 * g] * linv * g0, o[d][4 * g + 1] * linv * g1); w.y = cvtpk(o[d][4 * g + 2] * linv * g2, o[d][4 * g + 3] * linv * g3);
      *(u32x2*)(y_row + dd) = w;
    }
}

DI void load_q(bf16x8 (&qf)[4], const bf16* qrow, int h) {
#pragma unroll
  for (int t = 0; t < 4; ++t) qf[t] = *(const bf16x8*)(qrow + t * 16 + h * 8);
}
template <int DVB> DI void zero_o(f32x16 (&o)[DVB]) {
#pragma unroll
  for (int d = 0; d < DVB; ++d)
#pragma unroll
    for (int i = 0; i < 16; ++i) o[d][i] = 0.f;
}

DI void mixerB_tile(const Params& p, int item, bf16* Ks, bf16* Vs, int lane) {
  const bf16* PE = (const bf16*)(p.ws + WS_PE); bf16* Y = (bf16*)(p.ws + WS_Y);
  const int qblk = item & 255, head = (item >> 8) & 7, b = item >> 11;
  const int r32 = lane & 31, h = lane >> 5, q0 = qblk * 32, kvh = head >> 2;
  const size_t rowb = (size_t)b * SEQ;
  bf16x8 qf[4]; load_q(qf, PE + (rowb + q0 + r32) * NPE + E_BQ + head * 64, h);
  f32x16 o[2]; zero_o<2>(o);
  const float sink2 = p.in[I_B_SINKS][head] * LOG2E;
  float m = sink2, l = (h == 0) ? 1.f : 0.f;
  band_run<2>(PE + rowb * NPE + E_BK + kvh * 64, PE + rowb * NPE + E_BV + kvh * 64, NPE, q0 - 128, 5, 1, 0, q0 + r32, 127, qf, o, m, l, 0.125f * LOG2E, Ks, Vs, lane);
  l += __shfl_xor(l, 32);
  const size_t tok = rowb + q0 + r32;
  write_o64(o, 1.f / l, PE + tok * NPE + E_BG + head * 64, Y + tok * DM + 512 + head * 64, h);
}

DI void mixerC_tile(const Params& p, int item, bf16* Ks, bf16* Vs, int lane) {
  const bf16* PO = (const bf16*)(p.ws + WS_PE); bf16* Y = (bf16*)(p.ws + WS_Y);
  const int qt = item & 15, r16 = (item >> 4) & 15, head = (item >> 8) & 7, b = item >> 11;
  const int r32 = lane & 31, h = lane >> 5, qi0 = qt * 32;
  const size_t rowb = (size_t)b * SEQ;
  const int t = 16 * (qi0 + r32) + r16;
  bf16x8 qf[4]; load_q(qf, PO + (rowb + t) * NPO + O_CQ + head * 64, h);
  f32x16 o[2]; zero_o<2>(o);
  float m = -1e30f, l = 0.f;
  const bf16* Kg = PO + rowb * NPO + O_CK + head * 64; const bf16* Vg = PO + rowb * NPO + O_CV + head * 64;
  const float c2 = 0.125f * LOG2E;
  band_run<2>(Kg, Vg, NPO, qi0 - 128, 5, 16, r16, qi0 + r32, 128, qf, o, m, l, c2, Ks, Vs, lane);
  band_run<2>(Kg, Vg, NPO, 4 * qi0 + (r16 >> 2) - 128, 8, 4, r16 & 3, 4 * (qi0 + r32) + (r16 >> 2), 128, qf, o, m, l, c2, Ks, Vs, lane);
  band_run<2>(Kg, Vg, NPO, 16 * qi0 + r16 - 128, 20, 1, 0, t, 128, qf, o, m, l, c2, Ks, Vs, lane);
  l += __shfl_xor(l, 32);
  const size_t tok = rowb + t;
  write_o64(o, 1.f / l, PO + tok * NPO + O_CG + head * 64, Y + tok * DM + head * 64, h);
}

DI void attn_step16(const bf16* Kt, const bf16* Vt, const bf16x8 (&qf)[2], f32x4 (&o)[4], float& m, float& l, int nvalid  , float c2, int lane) {
  const int c = lane & 15, qd = lane >> 4;
  f32x4 s0 = {0.f, 0.f, 0.f, 0.f}, s1 = {0.f, 0.f, 0.f, 0.f};
#pragma unroll
  for (int ks = 0; ks < 2; ++ks) {
    const bf16x8 k0 = *(const bf16x8*)(Kt + c * WP + ks * 32 + qd * 8);
    const bf16x8 k1 = *(const bf16x8*)(Kt + (16 + c) * WP + ks * 32 + qd * 8);
    s0 = mfma16(k0, qf[ks], s0); s1 = mfma16(k1, qf[ks], s1);
  }
  float mx = -INFINITY;
#pragma unroll
  for (int j = 0; j < 4; ++j) { if (4 * qd + j >= nvalid) s0[j] = -INFINITY; if (16 + 4 * qd + j >= nvalid) s1[j] = -INFINITY; mx = fmaxf(mx, fmaxf(s0[j], s1[j])); }
  mx = fmaxf(mx, __shfl_xor(mx, 16)); mx = fmaxf(mx, __shfl_xor(mx, 32));
  const float mxs = mx * c2;
  if (__any(mxs > m + 6.f)) {
    const float mn = fmaxf(m, mxs); const float alpha = fexp2(m - mn); l *= alpha;
#pragma unroll
    for (int d = 0; d < 4; ++d) o[d] = o[d] * alpha;
    m = mn;
  }
  const float negm = -m; float ps = 0.f;
#pragma unroll
  for (int j = 0; j < 4; ++j) { s0[j] = fexp2(__builtin_fmaf(s0[j], c2, negm)); s1[j] = fexp2(__builtin_fmaf(s1[j], c2, negm)); ps += s0[j] + s1[j]; }
  l += ps;
  u32x4 pw; pw.x = cvtpk(s0[0], s0[1]); pw.y = cvtpk(s0[2], s0[3]); pw.z = cvtpk(s1[0], s1[1]); pw.w = cvtpk(s1[2], s1[3]);
  const bf16x8 pf = __builtin_bit_cast(bf16x8, pw);
  const int i16 = lane & 15, rq = i16 >> 2, pp = i16 & 3;
#pragma unroll
  for (int dt = 0; dt < 4; ++dt) {
    const s16x4 lo = trread(Vt + (4 * qd + rq) * WP + 16 * dt + 4 * pp);
    const s16x4 hi = trread(Vt + (16 + 4 * qd + rq) * WP + 16 * dt + 4 * pp);
    const bf16x8 vf = __builtin_shufflevector(lo, hi, 0, 1, 2, 3, 4, 5, 6, 7);
    o[dt] = mfma16(vf, pf, o[dt]);
  }
}

DI void mixerA_item(const Params& p, int item, bf16* Ks, bf16* Vs, int lane) {
  const bf16* PE = (const bf16*)(p.ws + WS_PE); bf16* Y = (bf16*)(p.ws + WS_Y);
  const unsigned short* SEL = (const unsigned short*)(p.ws + WS_SEL) + (size_t)item * 256;
  const int t = item & (SEQ - 1), b = item >> 13;
  const int c = lane & 15, qd = lane >> 4, head = c & 7;
  const size_t rowb = (size_t)b * SEQ;
  const int count = (t + 1 < 256) ? t + 1 : 256, nsteps = (count + 31) >> 5;
  bf16x8 qf[2];
#pragma unroll
  for (int ks = 0; ks < 2; ++ks) qf[ks] = *(const bf16x8*)(PE + (size_t)item * NPE + E_AQ + head * 64 + ks * 32 + qd * 8);
  f32x4 o[4];
#pragma unroll
  for (int d = 0; d < 4; ++d) o[d] = (f32x4){0.f, 0.f, 0.f, 0.f};
  float m = -1e30f, l = 0.f;
  const bf16* Kg = PE + rowb * NPE + E_AK; const bf16* Vg = PE + rowb * NPE + E_AV;
  KVRegs R;
  unsigned short* sel_l = (unsigned short*)(Vs + 32 * WP);
  lds_fence();
  *(u32x2*)(sel_l + 4 * lane) = *(const u32x2*)(SEL + 4 * lane);
  lds_fence();
#define A_LOAD(j) do { _Pragma("unroll") for (int i = 0; i < 4; ++i) { const int row = (lane >> 3) + 8 * i, ch = lane & 7, e = 32 * (j) + row; \
      const int tokk = (e < count) ? (int)sel_l[e] : 0; const size_t off = (size_t)tokk * NPE + ch * 8; R.k[i] = *(const u32x4*)(Kg + off); R.v[i] = *(const u32x4*)(Vg + off); } } while (0)
  A_LOAD(0);
  for (int j = 0; j < nsteps; ++j) {
    lds_fence();
    kv_store(R, Ks, Vs, lane);
    lds_fence();
    if (j + 1 < nsteps) A_LOAD(j + 1);
    attn_step16(Ks, Vs, qf, o, m, l, count - 32 * j, 0.125f * LOG2E, lane);
  }
#undef A_LOAD
  l += __shfl_xor(l, 16); l += __shfl_xor(l, 32);
  if (c < 8) {
    const float linv = 1.f / l;
    const bf16* gate_row = PE + (size_t)item * NPE + E_AG + head * 64; bf16* y_row = Y + (size_t)item * DM + head * 64;
#pragma unroll
    for (int dt = 0; dt < 4; ++dt) {
      const int dd = 16 * dt + 4 * qd;
      const u32x2 gv = *(const u32x2*)(gate_row + dd);
      const float g0 = __uint_as_float(gv.x << 16), g1 = __uint_as_float(gv.x & 0xffff0000u), g2 = __uint_as_float(gv.y << 16), g3 = __uint_as_float(gv.y & 0xffff0000u);
      u32x2 w; w.x = cvtpk(o[dt][0] * linv * g0, o[dt][1] * linv * g1); w.y = cvtpk(o[dt][2] * linv * g2, o[dt][3] * linv * g3);
      *(u32x2*)(y_row + dd) = w;
    }
  }
}

DI unsigned f2ord(float f) { f += 0.f; const unsigned u = __float_as_uint(f); return (u & 0x80000000u) ? ~u : (u | 0x80000000u); }
DI int block_excl_scan(int v, int* tmp, int* tot) {
  const int lane = threadIdx.x & 63, wid = threadIdx.x >> 6;
  int inc = v;
#pragma unroll
  for (int o = 1; o < 64; o <<= 1) { const int u = __shfl_up(inc, o); if (lane >= o) inc += u; }
  if (lane == 63) tmp[wid] = inc;
  __syncthreads();
  int base = 0, total = 0;
#pragma unroll
  for (int w = 0; w < 8; ++w) { const int x = tmp[w]; if (w < wid) base += x; total += x; }
  *tot = total;
  return base + inc - v;
}

DI float dpp_sum8(float v) {
  v += __builtin_bit_cast(float, __builtin_amdgcn_mov_dpp(__builtin_bit_cast(int, v), 0xB1, 0xF, 0xF, true));
  v += __builtin_bit_cast(float, __builtin_amdgcn_mov_dpp(__builtin_bit_cast(int, v), 0x4E, 0xF, 0xF, true));
  v += __builtin_bit_cast(float, __builtin_amdgcn_mov_dpp(__builtin_bit_cast(int, v), 0x141, 0xF, 0xF, true));
  return v;
}
DI void hist_find(const int* hist, int* misc, int need, int& digit, int& nneed, int& cnt) {
  const int tid = threadIdx.x;
  typedef int i32x4 __attribute__((ext_vector_type(4)));
  const i32x4 h0 = *(const i32x4*)(hist + tid * 8), h1 = *(const i32x4*)(hist + tid * 8 + 4);
  int hh[8] = {h0.x, h0.y, h0.z, h0.w, h1.x, h1.y, h1.z, h1.w}; int tot = 0;
#pragma unroll
  for (int k = 0; k < 8; ++k) tot += hh[k];
  int total; const int ex = block_excl_scan(tot, misc, &total);
  int above = total - ex - tot;
#pragma unroll
  for (int k = 7; k >= 0; --k) { const int c = hh[k]; if (above < need && above + c >= need) { misc[16] = tid * 8 + k; misc[17] = need - above; misc[18] = c; } above += c; }
  __syncthreads();
  digit = misc[16]; nneed = misc[17]; cnt = misc[18];
  __syncthreads();
}
DI unsigned long long mkcmp(float v, int idx) { return ((unsigned long long)f2ord(v) << 16) | ((unsigned long long)(8191 - idx) << 3); }
DI float ord2f(unsigned k) { return __uint_as_float((k & 0x80000000u) ? (k ^ 0x80000000u) : ~k); }
DI float half_sum(float v) { auto rr = __builtin_amdgcn_permlane32_swap(__float_as_uint(v), __float_as_uint(v), false, false); return __uint_as_float(rr[0]) + __uint_as_float(rr[1]); }

constexpr int CL_CAP = 512;
DI void select_slow(const float* scq, int n, unsigned short* out, float lo, float hi, int* hist, int* misc, unsigned long long* clist) {
  const int tid = opaque_tid();
    const float scale = (hi > lo) ? 4095.f / (hi - lo) : 0.f;
    for (int i = tid; i < 4096; i += 512) hist[i] = 0;
    if (tid == 0) misc[20] = 0;
    __syncthreads();
    float val[16]; int bin[16];
#pragma unroll
    for (int i = 0; i < 16; ++i) { const int idx = tid + 512 * i; const float v = (idx < n) ? scq[idx] : lo; val[i] = v;
      int bb = (int)((v - lo) * scale); bb = bb < 0 ? 0 : (bb > 4095 ? 4095 : bb); bin[i] = bb; if (idx < n) atomicAdd(&hist[bb], 1); }
    __syncthreads();
    int bstar, need, cnt;
    hist_find(hist, misc, 256, bstar, need, cnt);
    unsigned long long T = 0ull;
    if (cnt != need) {
      if (cnt <= CL_CAP) {
#pragma unroll
        for (int i = 0; i < 16; ++i) { const int idx = tid + 512 * i; if (idx < n && bin[i] == bstar) { const int slot = atomicAdd(&misc[20], 1); clist[slot] = mkcmp(val[i], idx); } }
        __syncthreads();
        if (tid < cnt) { const unsigned long long c = clist[tid]; int rank = 0; for (int jx = 0; jx < cnt; ++jx) rank += (clist[jx] > c) ? 1 : 0;
          if (rank == need - 1) { misc[21] = (int)(unsigned)(c & 0xffffffffull); misc[22] = (int)(unsigned)(c >> 32); } }
        __syncthreads();
        T = ((unsigned long long)(unsigned)misc[22] << 32) | (unsigned long long)(unsigned)misc[21];
      } else {
        unsigned long long prefix = 0ull; int shift = 36;
        for (int pass = 0; pass < 4; ++pass) {
          for (int i = tid; i < 4096; i += 512) hist[i] = 0;
          __syncthreads();
#pragma unroll
          for (int i = 0; i < 16; ++i) { const int idx = tid + 512 * i; if (idx < n && bin[i] == bstar) { const unsigned long long c = mkcmp(val[i], idx); if (pass == 0 || (c >> (shift + 12)) == prefix) atomicAdd(&hist[(int)((c >> shift) & 4095ull)], 1); } }
          __syncthreads();
          int digit, nneed, c2;
          hist_find(hist, misc, need, digit, nneed, c2);
          prefix = (prefix << 12) | (unsigned long long)digit; need = nneed;
          if (c2 == need) break;
          shift -= 12;
        }
        T = prefix << shift;
      }
    }
    int mycnt = 0; unsigned selm = 0;
#pragma unroll
    for (int i = 0; i < 16; ++i) { const int idx = tid + 512 * i;
      bool sel = false;
      if (idx < n) { if (bin[i] > bstar) sel = true; else if (bin[i] == bstar) sel = (mkcmp(val[i], idx) >= T); }
      if (sel) { ++mycnt; selm |= (1u << i); } }
    int total; int pos = block_excl_scan(mycnt, misc + 8, &total);
#pragma unroll
    for (int i = 0; i < 16; ++i) { if ((selm >> i) & 1u) { if (pos < 256) out[pos] = (unsigned short)(tid + 512 * i); ++pos; } }
    __syncthreads();
}

DI void sel_load_qw(const Params& p, int item, bf16x8 (&qf)[4], float (&wq)[16], int lane) {
  const bf16* PE = (const bf16*)(p.ws + WS_PE); const float* IW = (const float*)(p.ws + WS_IW);
  const int r32 = lane & 31, h = lane >> 5, b = item >> 11, t0 = (item & 2047) * 4; const size_t rowb = (size_t)b * SEQ;
  load_q(qf, PE + (rowb + t0 + (r32 >> 3)) * NPE + E_IQ + (r32 & 7) * 64, h);
#pragma unroll
  for (int q = 0; q < 4; ++q) { const f32x4 w4 = *(const f32x4*)(IW + (rowb + t0 + q) * 8 + 4 * h);
    wq[4 * q] = w4.x * 0.04419417382415922f; wq[4 * q + 1] = w4.y * 0.04419417382415922f; wq[4 * q + 2] = w4.z * 0.04419417382415922f; wq[4 * q + 3] = w4.w * 0.04419417382415922f; }
}
DI void selectA_item(const Params& p, int item, int next_item, char* lds, bf16x8 (&qf)[4], float (&wq)[16]) {
  const bf16* PE = (const bf16*)(p.ws + WS_PE);
  const float* IW = (const float*)(p.ws + WS_IW);
  unsigned short* SEL = (unsigned short*)(p.ws + WS_SEL);
  float* sc = (float*)lds;
  int* hist = (int*)(lds + 4 * 8192 * 4);
  int* misc = hist + 4096;
  unsigned* mm = (unsigned*)(misc + 24);
  unsigned long long* clist = (unsigned long long*)(misc + 96);
  const int tid = opaque_tid(), lane = tid & 63, wid = tid >> 6, r32 = lane & 31, h = lane >> 5;
  const int b = item >> 11, t0 = (item & 2047) * 4;
  const size_t rowb = (size_t)b * SEQ;
  const int nk = t0 + 4, ntile = (nk + 31) >> 5;
  const f32x4 pcv = ((const f32x4*)p.in[I_P])[(size_t)item * 512 + tid];
  if (tid < 4) { mm[tid * 2] = 0xFFFFFFFFu; mm[tid * 2 + 1] = 0u; }
  lds_barrier();
  const bf16* Kt = (const bf16*)(p.ws + WS_IKS) + (size_t)b * 256 * 2048 + lane * 8;
  {
    bf16x8 kf[4], kn[4];
#pragma unroll
    for (int t = 0; t < 4; ++t) { kf[t] = (bf16x8){0, 0, 0, 0, 0, 0, 0, 0}; kn[t] = kf[t]; }
    if (wid < ntile) {
#pragma unroll
      for (int t = 0; t < 4; ++t) kf[t] = *(const bf16x8*)(Kt + (size_t)wid * 2048 + t * 512);
    }
    float lo0 = INFINITY, hi0 = -INFINITY, lo1 = INFINITY, hi1 = -INFINITY;
    for (int kt = wid; kt < ntile; kt += 8) {
      if (kt + 8 < ntile) {
#pragma unroll
        for (int t = 0; t < 4; ++t) kn[t] = *(const bf16x8*)(Kt + (size_t)(kt + 8) * 2048 + t * 512);
      }
      f32x16 s;
#pragma unroll
      for (int i = 0; i < 16; ++i) s[i] = 0.f;
#pragma unroll
      for (int t = 0; t < 4; ++t) s = mfma32(qf[t], kf[t], s);
      float v[4];
#pragma unroll
      for (int q = 0; q < 4; ++q) {
        float a = wq[4 * q] * fmaxf(s[4 * q], 0.f);
#pragma unroll
        for (int jj = 1; jj < 4; ++jj) a += wq[4 * q + jj] * fmaxf(s[4 * q + jj], 0.f);
        v[q] = half_sum(a) + 0.f;
      }
      const float va = h ? v[2] : v[0], vb = h ? v[3] : v[1];
      const int key = kt * 32 + r32;
      sc[(2 * h) * 8192 + key] = va; sc[(2 * h + 1) * 8192 + key] = vb;
      lo0 = fminf(lo0, va); hi0 = fmaxf(hi0, va); lo1 = fminf(lo1, vb); hi1 = fmaxf(hi1, vb);
#pragma unroll
      for (int t = 0; t < 4; ++t) kf[t] = kn[t];
    }
    if (wid < ntile) {
#pragma unroll
      for (int o = 1; o < 32; o <<= 1) { lo0 = fminf(lo0, __shfl_xor(lo0, o)); hi0 = fmaxf(hi0, __shfl_xor(hi0, o)); lo1 = fminf(lo1, __shfl_xor(lo1, o)); hi1 = fmaxf(hi1, __shfl_xor(hi1, o)); }
      if (r32 == 0) { atomicMin(&mm[(2 * h) * 2], f2ord(lo0)); atomicMax(&mm[(2 * h) * 2 + 1], f2ord(hi0)); atomicMin(&mm[(2 * h + 1) * 2], f2ord(lo1)); atomicMax(&mm[(2 * h + 1) * 2 + 1], f2ord(hi1)); }
    }
  }
  if (next_item >= 0) sel_load_qw(p, next_item, qf, wq, lane);
  { u32x2 w; w.x = cvtpk(pcv.x, pcv.y); w.y = cvtpk(pcv.z, pcv.w); ((u32x2*)(p.ws + WS_PBF))[(size_t)item * 512 + tid] = w; }
  lds_barrier();
  {
    const int g = wid >> 1, gt = tid & 127, upper = wid & 1;
    const int t = t0 + g, n = t + 1;
    const bool big = n > 256;
    const float* scq = sc + g * 8192;
    unsigned short* out = SEL + (rowb + t) * 256;
    int* histq = hist + g * 1024;
    unsigned long long* clq = clist + g * 128;
    int* mq = misc + 32 + g * 8;
    const float lo = ord2f(mm[g * 2]), hi = ord2f(mm[g * 2 + 1]);
    const float scale = (hi > lo) ? 1023.f / (hi - lo) : 0.f;
    for (int i = gt; i < 1024; i += 128) histq[i] = 0;
    if (gt == 0) { mq[0] = 0; mq[6] = 0; }
    lds_barrier();
    float uu[64];
#pragma unroll
    for (int i = 0; i < 64; ++i) { const int idx = gt + 128 * i; const float v = (idx < n) ? scq[idx] : lo; const float u = (v - lo) * scale; uu[i] = u;
      if (big && idx < n) { int bb = (int)u; bb = bb > 1023 ? 1023 : bb; atomicAdd(&histq[bb], 1); } }
    lds_barrier();
    typedef int i32x4 __attribute__((ext_vector_type(4)));
    const i32x4 h0 = *(const i32x4*)(histq + gt * 8), h1 = *(const i32x4*)(histq + gt * 8 + 4);
    const int hh[8] = {h0.x, h0.y, h0.z, h0.w, h1.x, h1.y, h1.z, h1.w};
    int tot = 0;
#pragma unroll
    for (int k = 0; k < 8; ++k) tot += hh[k];
    int inc = tot;
#pragma unroll
    for (int o = 1; o < 64; o <<= 1) { const int ux = __shfl_down(inc, o); if (lane + o < 64) inc += ux; }
    if (lane == 0) misc[wid] = inc;
    lds_barrier();
    {
      int above = inc - tot + (upper ? 0 : misc[wid + 1]);
      if (big) {
#pragma unroll
        for (int k = 7; k >= 0; --k) { const int c = hh[k]; if (above < 256 && above + c >= 256) { mq[1] = gt * 8 + k; mq[2] = 256 - above; mq[3] = c; } above += c; }
      }
    }
    lds_barrier();
    const int bstar = mq[1], need = mq[2], cnt = mq[3];
    const float flo = (float)bstar, fhi = (bstar >= 1023) ? INFINITY : (float)(bstar + 1);
    const bool tie = big && cnt != need;
    if (tie) {
      if (cnt <= 128) {
#pragma unroll
        for (int i = 0; i < 64; ++i) { const int idx = gt + 128 * i; if (idx < n && uu[i] >= flo && uu[i] < fhi) { const int slot = atomicAdd(&mq[0], 1); clq[slot] = mkcmp(scq[idx], idx); } }
      } else if (gt == 0) mq[6] = 1;
    }
    lds_barrier();
    if (tie && cnt <= 128 && gt < cnt) { const unsigned long long c = clq[gt]; int rank = 0; for (int jx = 0; jx < cnt; ++jx) rank += (clq[jx] > c) ? 1 : 0;
      if (rank == need - 1) { mq[4] = (int)(unsigned)(c & 0xffffffffull); mq[5] = (int)(unsigned)(c >> 32); } }
    lds_barrier();
    const unsigned long long T = tie ? (((unsigned long long)(unsigned)mq[5] << 32) | (unsigned long long)(unsigned)mq[4]) : 0ull;
    const bool fast = big && !(tie && cnt > 128);
    unsigned long long selm = 0ull;
    if (fast) {
#pragma unroll
      for (int i = 0; i < 64; ++i) { const int idx = gt + 128 * i;
        if (idx < n) { const float u = uu[i]; bool sel = u >= fhi; if (!sel && u >= flo) sel = !tie || (mkcmp(scq[idx], idx) >= T); if (sel) selm |= (1ull << i); } }
    }
    const int mycnt = __popcll(selm);
    int pinc = mycnt;
#pragma unroll
    for (int o = 1; o < 64; o <<= 1) { const int ux = __shfl_up(pinc, o); if (lane >= o) pinc += ux; }
    if (lane == 63) misc[8 + wid] = pinc;
    lds_barrier();
    if (fast) {
      int pos = pinc - mycnt + (upper ? misc[8 + wid - 1] : 0);
      while (selm) { const int i = __ffsll((long long)selm) - 1; selm &= selm - 1ull; if (pos < 256) out[pos] = (unsigned short)(gt + 128 * i); ++pos; }
    } else if (!big) {
      for (int i = gt; i < n; i += 128) out[i] = (unsigned short)i;
    }
    lds_barrier();
  }
  for (int q = 0; q < 4; ++q) {
    if (misc[32 + q * 8 + 6]) { const int t = t0 + q; select_slow(sc + q * 8192, t + 1, SEL + (rowb + t) * 256, ord2f(mm[q * 2]), ord2f(mm[q * 2 + 1]), hist, misc, clist); }
  }
  lds_barrier();
}

constexpr int DKP = 72, DVP = 136;
constexpr int D_STAGE = (64 * DKP * 2 + 64 * DVP) * 2;
DI void mixerD_unit(const Params& p, int b, int head, int qb, char* lds) {
  const bf16* PO = (const bf16*)(p.ws + WS_PE); bf16* Y = (bf16*)(p.ws + WS_Y);
  const int tid = opaque_tid(), lane = tid & 63, wid = tid >> 6, r32 = lane & 31, h = lane >> 5;
  const int map = wid & 1, qsub = wid >> 1;
  const size_t rowb = (size_t)b * SEQ;
  const int qpos = 128 * qb + 32 * qsub + r32;
  bf16x8 qf[4]; load_q(qf, PO + (rowb + qpos) * NPO + O_DQ + (2 * head + map) * 64, h);
  f32x16 o[4]; zero_o<4>(o);
  float m = -1e30f, l = 0.f;
  const int nsteps = 2 * qb + 2;
  const bf16* K1g = PO + rowb * NPO + O_DK + (2 * head) * 64;
  const bf16* K2g = K1g + 64;
  const bf16* Vg = PO + rowb * NPO + O_DV + head * 128;
  u32x4 rk1, rk2, rv[2];
#define D_LOAD(j) do { const int row = tid >> 3, ch = tid & 7; const size_t off = (size_t)((j) * 64 + row) * NPO + ch * 8; rk1 = *(const u32x4*)(K1g + off); rk2 = *(const u32x4*)(K2g + off); \
    _Pragma("unroll") for (int i = 0; i < 2; ++i) { const int c = tid + 512 * i, vr = c >> 4, vc = c & 15; rv[i] = *(const u32x4*)(Vg + (size_t)((j) * 64 + vr) * NPO + vc * 8); } } while (0)
  __syncthreads();
  D_LOAD(0);
  for (int j = 0; j < nsteps; ++j) {
    char* st = lds + (j & 1) * D_STAGE;
    bf16* K1s = (bf16*)st; bf16* K2s = K1s + 64 * DKP; bf16* Vs = K2s + 64 * DKP;
    { const int row = tid >> 3, ch = tid & 7; *(u32x4*)(K1s + row * DKP + ch * 8) = rk1; *(u32x4*)(K2s + row * DKP + ch * 8) = rk2;
#pragma unroll
      for (int i = 0; i < 2; ++i) { const int c = tid + 512 * i, vr = c >> 4, vc = c & 15; *(u32x4*)(Vs + vr * DVP + vc * 8) = rv[i]; } }
    __syncthreads();
    if (j + 1 < nsteps) D_LOAD(j + 1);
    const bf16* Ks = map ? K2s : K1s;
#pragma unroll
    for (int sub = 0; sub < 2; ++sub) {
      const int k0 = j * 64 + sub * 32;
      if (k0 <= 128 * qb + 32 * qsub + 31) {
        if (k0 + 31 <= 128 * qb + 32 * qsub) {
          attn_step32<4, false>(Ks + sub * 32 * DKP, DKP, Vs + sub * 32 * DVP, DVP, qf, o, m, l, 0xffffu, 0.125f * LOG2E, lane);
        } else {
          unsigned vm = 0;
#pragma unroll
          for (int i = 0; i < 16; ++i) if (k0 + crow(i, h) <= qpos) vm |= (1u << i);
          attn_step32<4, true>(Ks + sub * 32 * DKP, DKP, Vs + sub * 32 * DVP, DVP, qf, o, m, l, vm, 0.125f * LOG2E, lane);
        }
      }
    }
  }
#undef D_LOAD
  l += __shfl_xor(l, 32);
  const float linv = 1.f / l;
  __syncthreads();
  float* xch = (float*)lds + qsub * 4096;
  if (map == 1) {
#pragma unroll
    for (int d = 0; d < 4; ++d)
#pragma unroll
      for (int i = 0; i < 16; ++i) xch[(d * 16 + i) * 64 + lane] = o[d][i] * linv;
  }
  __syncthreads();
  if (map == 0) {
    const float lam = *(const float*)(p.ws + WS_LAM);
    float ssq = 0.f;
#pragma unroll
    for (int d = 0; d < 4; ++d)
#pragma unroll
      for (int i = 0; i < 16; ++i) { const float a = o[d][i] * linv - lam * xch[(d * 16 + i) * 64 + lane]; o[d][i] = a; ssq += a * a; }
    ssq += __shfl_xor(ssq, 32);
    const float lambda_init = 0.8f - 0.6f * expf(-0.3f);
    const float rn = rsqrtf(ssq * (1.f / 128.f) + EPS) * (1.f - lambda_init);
    const size_t tok = rowb + qpos;
    const bf16* gate = PO + tok * NPO + O_DG + head * 128;
    bf16* y = Y + tok * DM + 512 + head * 128;
    const float* sg = p.in[I_SUB_GAIN];
#pragma unroll
    for (int d = 0; d < 4; ++d)
#pragma unroll
      for (int g = 0; g < 4; ++g) {
        const int dd = 32 * d + 8 * g + 4 * h;
        const u32x2 gv = *(const u32x2*)(gate + dd); const f32x4 s4 = *(const f32x4*)(sg + dd);
        const float g0 = __uint_as_float(gv.x << 16), g1 = __uint_as_float(gv.x & 0xffff0000u), g2 = __uint_as_float(gv.y << 16), g3 = __uint_as_float(gv.y & 0xffff0000u);
        u32x2 w; w.x = cvtpk(o[d][4 * g] * rn * s4.x * g0, o[d][4 * g + 1] * rn * s4.y * g1); w.y = cvtpk(o[d][4 * g + 2] * rn * s4.z * g2, o[d][4 * g + 3] * rn * s4.w * g3);
        *(u32x2*)(y + dd) = w;
      }
  }
  __syncthreads();
}

#define XB_TMO      128
#define XB_XCNT(j)  (256  + 64 * (j))
#define XB_XSUB(j)  (1280 + 64 * (j))
#define XB_XGEN(j)  (2304 + 64 * (j))
#define XB_TOP      3328
#define XB_TOPGEN   3392
#define XCD_BAR_WORDS 3456
#define XB_SPIN_CAP (1u << 18)

__device__ __forceinline__ unsigned xb_ld(unsigned* p)              { return __hip_atomic_load(p, __ATOMIC_RELAXED, __HIP_MEMORY_SCOPE_AGENT); }
__device__ __forceinline__ unsigned xb_add(unsigned* p, unsigned v) { return __hip_atomic_fetch_add(p, v, __ATOMIC_RELAXED, __HIP_MEMORY_SCOPE_AGENT); }
__device__ __forceinline__ unsigned xb_xcc_id() { return (unsigned)__builtin_amdgcn_s_getreg((3 << 11) | 20) & 0xFu; }
#define XB_SPIN(cond, bar) do { unsigned _sp = 0; while (cond) { __builtin_amdgcn_s_sleep(1); \
    if ((++_sp & 255u) == 0u) { if (xb_ld(&(bar)[XB_TMO])) break; if (_sp > XB_SPIN_CAP) { atomicAdd(&(bar)[XB_TMO], 1u); break; } } } } while (0)

struct XcdBarrier {
    unsigned* bar; unsigned x;
    volatile LAS unsigned* st;
};

__device__ __forceinline__ XcdBarrier xcd_barrier_post(unsigned* bar, volatile LAS unsigned* st) {
    XcdBarrier b; b.bar = bar; b.x = xb_xcc_id(); b.st = st;
    if (threadIdx.x == 0) (void)xb_add(&bar[XB_XCNT(b.x)], 1u);
    return b;
}
__device__ __forceinline__ void xcd_barrier_complete(unsigned* bar, unsigned x, unsigned& nloc, unsigned& nx) {
    const unsigned G = gridDim.x * gridDim.y * gridDim.z;
    unsigned sum, cnt, mine, sp = 0u;
    for (;;) {
        sum = 0u; cnt = 0u; mine = 0u;
#pragma unroll
        for (unsigned j = 0; j < 16; ++j) { const unsigned c = xb_ld(&bar[XB_XCNT(j)]); sum += c; cnt += (c > 0u) ? 1u : 0u; mine = (j == x) ? c : mine; }
        if (sum == G) break;
        __builtin_amdgcn_s_sleep(1);
        if ((++sp & 255u) == 0u) { if (xb_ld(&bar[XB_TMO])) break; if (sp > XB_SPIN_CAP) { atomicAdd(&bar[XB_TMO], 1u); break; } }
    }
    nloc = mine > 0u ? mine : 1u; nx = cnt > 0u ? cnt : 1u;
}

__device__ __forceinline__ void xcd_barrier(const XcdBarrier& b) {
    asm volatile("s_waitcnt vmcnt(0)" ::: "memory");
    __syncthreads();
    if (threadIdx.x == 0) {
        unsigned* bar = b.bar;
        __builtin_amdgcn_s_waitcnt(0);
        unsigned nloc = b.st[0], nx = b.st[1];
        if (nloc == 0u) { xcd_barrier_complete(bar, b.x, nloc, nx); b.st[0] = nloc; b.st[1] = nx; }
        const unsigned old = xb_add(&bar[XB_XSUB(b.x)], 1u);
        const unsigned gen = old / nloc;
        if (old + 1u == (gen + 1u) * nloc) {
            __builtin_amdgcn_fence(__ATOMIC_RELEASE, "agent");
            asm volatile("s_waitcnt vmcnt(0)" ::: "memory");
            const unsigned og = xb_add(&bar[XB_TOP], 1u);
            const unsigned tg = og / nx;
            if (og + 1u == (tg + 1u) * nx) xb_add(&bar[XB_TOPGEN], 1u);
            else XB_SPIN(xb_ld(&bar[XB_TOPGEN]) == tg, bar);
            __builtin_amdgcn_fence(__ATOMIC_ACQUIRE, "agent");
            xb_add(&bar[XB_XGEN(b.x)], 1u);
            asm volatile("s_waitcnt vmcnt(0)" ::: "memory");
        } else {
            XB_SPIN(xb_ld(&bar[XB_XGEN(b.x)]) == gen, bar);
            __builtin_amdgcn_fence(__ATOMIC_ACQUIRE, "agent");
            asm volatile("s_waitcnt vmcnt(0)" ::: "memory");
        }
    }
    __syncthreads();
}


__global__ void __launch_bounds__(NTHREADS) fwd_kernel(Params p) {
  extern __shared__ __attribute__((aligned(16))) char smem[];
  cg::grid_group grid = cg::this_grid();
  char* lds = smem;
  volatile LAS unsigned* xb_st = (volatile LAS unsigned*)((LAS char*)smem + (LDS_BYTES - 16));
  if (threadIdx.x < 2) xb_st[threadIdx.x] = 0u;
  __syncthreads();
  const XcdBarrier xbar = xcd_barrier_post((unsigned*)(p.ws + WS_BAR), xb_st);
#define FRESH_IDS const int tid = opaque_tid(), lane = tid & 63, wid = tid >> 6; const int gw = blockIdx.x * 8 + wid, ngw = gridDim.x * 8; bf16* Ks = (bf16*)(lds + wid * WAVE_LDS); bf16* Vs = Ks + 32 * WP; (void)gw; (void)ngw; (void)Ks; (void)Vs; (void)lane;

  phase_prologue(p, lds);
  if (p.ws == nullptr) grid.sync();
  xcd_barrier(xbar);
  for (int rep = 0; rep < REP_GEMM; ++rep) phase_inproj(p, 0, lds);
  xcd_barrier(xbar);
#if EN_A
  for (int rep = 0; rep < REP_SELA; ++rep) { FRESH_IDS
#define SEL_ITEM(k) ((k) * (int)gridDim.x + (((k) & 1) ? (int)gridDim.x - 1 - (int)blockIdx.x : (int)blockIdx.x))
    bf16x8 sqf[4]; float swq[16];
    if (SEL_ITEM(0) < 2 * 2048) sel_load_qw(p, SEL_ITEM(0), sqf, swq, lane);
    for (int k = 0; k * (int)gridDim.x < 2 * 2048; ++k) { const int it = SEL_ITEM(k); int nx = SEL_ITEM(k + 1); if (nx >= 2 * 2048) nx = -1; if (it < 2 * 2048) selectA_item(p, it, nx, lds, sqf, swq); }
#undef SEL_ITEM
  }
  __syncthreads();
  { FRESH_IDS
#define SEL_ITEM(k) ((k) * (int)gridDim.x + (((k) & 1) ? (int)gridDim.x - 1 - (int)blockIdx.x : (int)blockIdx.x))
    const int nK = (2 * 2048 + (int)gridDim.x - 1) / (int)gridDim.x;
    for (int rep = 0; rep < REP_AATT; ++rep)
      for (int s2 = wid; s2 < nK * 4; s2 += 8) { const int it = SEL_ITEM(s2 >> 2); if (it < 2 * 2048) mixerA_item(p, (it >> 11) * SEQ + (it & 2047) * 4 + (s2 & 3), Ks, Vs, lane); }
#undef SEL_ITEM
  }
#else
  { unsigned* y = (unsigned*)(p.ws + WS_Y); for (int i = blockIdx.x * NTHREADS + (int)threadIdx.x; i < NTOK * 256; i += gridDim.x * NTHREADS) { const int row = i >> 8, c = i & 255; y[row * 512 + c] = 0u; } }
#endif
#if EN_B
  { FRESH_IDS for (int it = gw; it < 4096; it += ngw) mixerB_tile(p, it, Ks, Vs, lane); }
#else
  { unsigned* y = (unsigned*)(p.ws + WS_Y); for (int i = blockIdx.x * NTHREADS + (int)threadIdx.x; i < NTOK * 256; i += gridDim.x * NTHREADS) { const int row = i >> 8, c = i & 255; y[row * 512 + 256 + c] = 0u; } }
#endif
  xcd_barrier(xbar);
  phase_outproj(p, 0, lds);
  xcd_barrier(xbar);
  phase_ple(p, 0, lds);
  xcd_barrier(xbar);
  phase_inproj(p, 1, lds);
  xcd_barrier(xbar);
#if EN_D
  for (int rep = 0; rep < REP_D; ++rep) {
#pragma unroll 1
    for (int u2 = blockIdx.x * 2; u2 < 512; u2 += gridDim.x * 2) {
#pragma unroll 1
      for (int k = 0; k < 2; ++k) { const int u = u2 >> 1, bh = u >> 5, pr = u & 31; mixerD_unit(p, bh >> 2, bh & 3, k ? 63 - pr : pr, lds); }
    }
  }
#else
  { unsigned* y = (unsigned*)(p.ws + WS_Y); for (int i = blockIdx.x * NTHREADS + (int)threadIdx.x; i < NTOK * 256; i += gridDim.x * NTHREADS) { const int row = i >> 8, c = i & 255; y[row * 512 + 256 + c] = 0u; } }
#endif
#if EN_C
  __syncthreads();
  { FRESH_IDS for (int rep = 0; rep < REP_C; ++rep) for (int it = gw; it < 4096; it += ngw) mixerC_tile(p, it, Ks, Vs, lane); }
#else
  { unsigned* y = (unsigned*)(p.ws + WS_Y); for (int i = blockIdx.x * NTHREADS + (int)threadIdx.x; i < NTOK * 256; i += gridDim.x * NTHREADS) { const int row = i >> 8, c = i & 255; y[row * 512 + c] = 0u; } }
#endif
  xcd_barrier(xbar);
  phase_outproj(p, 1, lds);
  xcd_barrier(xbar);
  phase_ple(p, 1, lds);
}

extern "C" void kernel_launch(void* const* d_in, const int* in_sizes, int n_in, void* d_out, int out_size, void* d_ws, size_t ws_size, hipStream_t stream) {
  static int grid_blocks = 0;
  if (!grid_blocks) {
    int dev = 0, cus = 0, per_cu = 0;
    hipGetDevice(&dev);
    hipDeviceGetAttribute(&cus, hipDeviceAttributeMultiprocessorCount, dev);
    hipFuncSetAttribute((const void*)fwd_kernel, hipFuncAttributeMaxDynamicSharedMemorySize, LDS_BYTES);
    hipOccupancyMaxActiveBlocksPerMultiprocessor(&per_cu, (const void*)fwd_kernel, NTHREADS, LDS_BYTES);
    if (per_cu < 1) per_cu = 1;
    grid_blocks = cus * per_cu;
    if (grid_blocks > 256) grid_blocks = 256;
  }
  Params p{};
  for (int i = 0; i < 25; ++i) p.in[i] = (const float*)d_in[i];
  p.out = (float*)d_out; p.ws = (unsigned char*)d_ws;
  for (int i = 0; i < 32; ++i) p.inv_freq[i] = (float)pow(10000.0, -(double)i / 32.0);
  (void)hipMemsetAsync((char*)d_ws + WS_BAR, 0, 16384, stream);
  void* args[] = {&p};
  hipError_t e = hipLaunchCooperativeKernel((const void*)fwd_kernel, dim3(grid_blocks), dim3(NTHREADS), args, LDS_BYTES, stream);
  if (e != hipSuccess) fprintf(stderr, "cooperative launch failed: %s (grid %d)\n", hipGetErrorString(e), grid_blocks);
}
```

```cpp
#include <hip/hip_runtime.h>
#include <hip/hip_cooperative_groups.h>
#include <cstdio>
#include <cmath>
namespace cg = cooperative_groups;

#ifndef REP_GEMM
#define REP_GEMM 1
#endif
#ifndef REP_SELA
#define REP_SELA 1
#endif
#ifndef REP_D
#define REP_D 1
#endif
#ifndef REP_C
#define REP_C 1
#endif
#ifndef REP_AATT
#define REP_AATT 1
#endif
#ifndef EN_A
#define EN_A 1
#endif
#ifndef EN_B
#define EN_B 1
#endif
#ifndef EN_C
#define EN_C 1
#endif
#ifndef EN_D
#define EN_D 1
#endif

typedef unsigned short bf16;
typedef short bf16x8 __attribute__((ext_vector_type(8)));
typedef short s16x4 __attribute__((ext_vector_type(4)));
typedef float f32x4 __attribute__((ext_vector_type(4)));
typedef float f32x16 __attribute__((ext_vector_type(16)));
typedef unsigned u32x4 __attribute__((ext_vector_type(4)));
typedef unsigned u32x2 __attribute__((ext_vector_type(2)));
typedef float f32x2_t __attribute__((ext_vector_type(2)));
typedef __bf16 bf16x2_t __attribute__((ext_vector_type(2)));
#define LAS __attribute__((address_space(3)))
#define DI __device__ __forceinline__

constexpr int SEQ = 8192, NTOK = 16384, DM = 1024;
constexpr int NPE = 3072, NPO = 4096;
constexpr float EPS = 1e-6f;
constexpr float LOG2E = 1.4426950408889634f;
constexpr int NTHREADS = 512;
constexpr int LDS_BYTES = 150 * 1024;

constexpr size_t MiB = 1u << 20;
constexpr size_t WS_PE = 0;
constexpr size_t WS_ACT = 128 * MiB;
constexpr size_t WS_Y = 160 * MiB;
constexpr size_t WS_WINE = 192 * MiB;
constexpr size_t WS_WOUTE = 198 * MiB;
constexpr size_t WS_WINO = 200 * MiB;
constexpr size_t WS_WOUTO = 208 * MiB;
constexpr size_t WS_WG0 = 210 * MiB;
constexpr size_t WS_WG1 = 212 * MiB;
constexpr size_t WS_WP0 = 214 * MiB;
constexpr size_t WS_WP1 = 215 * MiB;
constexpr size_t WS_ROPE = 216 * MiB;
constexpr size_t WS_SEL = 218 * MiB;
constexpr size_t WS_IW = 226 * MiB;
constexpr size_t WS_SS = 227 * MiB;
constexpr size_t WS_LAM = 228 * MiB;
constexpr size_t WS_BAR = 250 * MiB;
constexpr size_t WS_PBF = 232 * MiB;
constexpr size_t WS_IKS = 229 * MiB;

struct Params {
  const float* in[25];
  float* out;
  unsigned char* ws;
  float inv_freq[32];
};
enum { I_X = 0, I_P, I_NORM_GAIN, I_W_IN_EVEN, I_W_OUT_EVEN, I_A_Q_GAIN, I_A_K_GAIN, I_IDX_K_GAIN, I_B_Q_GAIN, I_B_K_GAIN, I_B_SINKS,
       I_W_IN_ODD, I_W_OUT_ODD, I_C_Q_GAIN, I_C_K_GAIN, I_D_Q_GAIN, I_D_K_GAIN, I_LQ1, I_LK1, I_LQ2, I_LK2, I_SUB_GAIN, I_PLE_NORM_GAIN,
       I_W_PLE_GATE, I_W_PLE_PROJ };

DI unsigned cvtpk(float lo, float hi) { f32x2_t v = {lo, hi}; bf16x2_t b = __builtin_convertvector(v, bf16x2_t); return __builtin_bit_cast(unsigned, b); }
DI float bf2f(bf16 b) { return __uint_as_float(((unsigned)b) << 16); }
DI float fexp2(float x) { return __builtin_amdgcn_exp2f(x); }
DI f32x16 mfma32(bf16x8 a, bf16x8 b, f32x16 c) { return __builtin_amdgcn_mfma_f32_32x32x16_bf16(a, b, c, 0, 0, 0); }
DI f32x4 mfma16(bf16x8 a, bf16x8 b, f32x4 c) { return __builtin_amdgcn_mfma_f32_16x16x32_bf16(a, b, c, 0, 0, 0); }
DI int crow(int i, int h) { return (i & 3) + 8 * (i >> 2) + 4 * h; }
DI s16x4 trread(const bf16* p) { return __builtin_bit_cast(s16x4, __builtin_amdgcn_ds_read_tr16_b64_v4i16((LAS s16x4*)p)); }
DI int opaque_tid() { int t = threadIdx.x; asm volatile("" : "+v"(t)); return t; }
DI void lds_barrier() { asm volatile("s_waitcnt lgkmcnt(0)" ::: "memory"); __builtin_amdgcn_s_barrier(); asm volatile("" ::: "memory"); }
DI void lds_fence() { asm volatile("s_waitcnt lgkmcnt(0)" ::: "memory"); __builtin_amdgcn_wave_barrier(); }

__host__ __device__ __forceinline__ int phys_col(int n) { return (n & ~255) + 128 * ((n >> 5) & 1) + 32 * ((n >> 6) & 3) + (n & 31); }
DI int map_even(int n) { return n < 1216 ? n : (n < 1224 ? 3008 + (n - 1216) : n - 8); }
DI void transpose_tile(const float* W, int K, int N, bf16* WT, int mapmode, int tile, float* scr) {
  const int tid = opaque_tid();
  const int ntn = (N + 63) >> 6, kt = tile / ntn, nt = tile % ntn, k0 = kt * 64, n0 = nt * 64;
#pragma unroll
  for (int i = 0; i < 8; ++i) {
    const int kk = (tid >> 6) + 8 * i, nn = tid & 63, n = n0 + nn;
    scr[kk * 65 + nn] = (n < N) ? W[(size_t)(k0 + kk) * N + n] : 0.f;
  }
  __syncthreads();
  {
    const int nn = tid >> 3, kc = tid & 7, n = n0 + nn;
    if (n < N) {
      const int dst = mapmode == 1 ? phys_col(map_even(n)) : (mapmode == 2 ? phys_col(n) : n);
      const float* s = scr + (kc * 8) * 65 + nn;
      u32x4 o; o.x = cvtpk(s[0], s[65]); o.y = cvtpk(s[2 * 65], s[3 * 65]); o.z = cvtpk(s[4 * 65], s[5 * 65]); o.w = cvtpk(s[6 * 65], s[7 * 65]);
      *(u32x4*)(WT + (size_t)dst * K + k0 + kc * 8) = o;
    }
  }
  __syncthreads();
}

DI float wave_sum(float v) {
#pragma unroll
  for (int o = 1; o < 64; o <<= 1) v += __shfl_xor(v, o);
  return v;
}

DI void phase_prologue(const Params& p, char* lds) {
  const int tid = opaque_tid(), lane = tid & 63, wid = tid >> 6;
  const int nb = gridDim.x, bid = blockIdx.x;
  unsigned char* ws = p.ws;
  float* scr = (float*)lds;
  const int T0 = 16 * 48, T1 = 256, T2 = 16 * 64, T3 = 256, T4 = 256, T5 = 256, T6 = 64, T7 = 64;
  const int NT = T0 + T1 + T2 + T3 + T4 + T5 + T6 + T7;
  for (int it = bid; it < NT; it += nb) {
    int r = it;
    if (r < T0) { transpose_tile(p.in[I_W_IN_EVEN], 1024, 3016, (bf16*)(ws + WS_WINE), 1, r, scr); continue; } r -= T0;
    if (r < T1) { transpose_tile(p.in[I_W_OUT_EVEN], 1024, 1024, (bf16*)(ws + WS_WOUTE), 0, r, scr); continue; } r -= T1;
    if (r < T2) { transpose_tile(p.in[I_W_IN_ODD], 1024, 4096, (bf16*)(ws + WS_WINO), 2, r, scr); continue; } r -= T2;
    if (r < T3) { transpose_tile(p.in[I_W_OUT_ODD], 1024, 1024, (bf16*)(ws + WS_WOUTO), 0, r, scr); continue; } r -= T3;
    if (r < T4) { transpose_tile(p.in[I_W_PLE_GATE], 1024, 1024, (bf16*)(ws + WS_WG0), 0, r, scr); continue; } r -= T4;
    if (r < T5) { transpose_tile(p.in[I_W_PLE_GATE] + 1024 * 1024, 1024, 1024, (bf16*)(ws + WS_WG1), 0, r, scr); continue; } r -= T5;
    if (r < T6) { transpose_tile(p.in[I_W_PLE_PROJ], 256, 1024, (bf16*)(ws + WS_WP0), 0, r, scr); continue; } r -= T6;
    transpose_tile(p.in[I_W_PLE_PROJ] + 256 * 1024, 256, 1024, (bf16*)(ws + WS_WP1), 0, r, scr);
  }
  const int gt = bid * NTHREADS + tid, ngt = nb * NTHREADS;
  { unsigned* z = (unsigned*)(ws + WS_WINE); for (int i = gt; i < 56 * 512; i += ngt) z[(size_t)phys_col(3016 + (i >> 9)) * 512 + (i & 511)] = 0u; }
  { float* ss = (float*)(ws + WS_SS); for (int i = gt; i < 3 * NTOK; i += ngt) ss[i] = 0.f; }
  { float2* tab = (float2*)(ws + WS_ROPE);
    for (int i = gt; i < SEQ * 32; i += ngt) {
      const int pos = i >> 5, k = i & 31;
      const float ang = (float)pos * p.inv_freq[k];
      double rev = (double)ang * 0.15915494309189535; rev -= floor(rev);
      const float rf = (float)rev;
      tab[i] = make_float2(__builtin_amdgcn_cosf(rf), __builtin_amdgcn_sinf(rf));
    } }
  if (bid == 0 && wid == 0) {
    const float a = wave_sum(p.in[I_LQ1][lane] * p.in[I_LK1][lane]);
    const float b = wave_sum(p.in[I_LQ2][lane] * p.in[I_LK2][lane]);
    const float lambda_init = 0.8f - 0.6f * expf(-0.3f);
    if (lane == 0) *(float*)(ws + WS_LAM) = expf(a) - expf(b) + lambda_init;
  }
  { const float* x = p.in[I_X]; const float* g = p.in[I_NORM_GAIN]; bf16* H = (bf16*)(ws + WS_ACT);
    const int gw = bid * 8 + wid, ngw = nb * 8;
    for (int m = gw; m < NTOK; m += ngw) {
      const f32x4* xr = (const f32x4*)(x + (size_t)m * DM) + lane;
      f32x4 v[4]; float s = 0.f;
#pragma unroll
      for (int j = 0; j < 4; ++j) { v[j] = xr[64 * j]; s += v[j].x * v[j].x + v[j].y * v[j].y + v[j].z * v[j].z + v[j].w * v[j].w; }
      const float rstd = rsqrtf(wave_sum(s) * (1.f / DM) + EPS);
      u32x2* o = (u32x2*)(H + (size_t)m * DM) + lane;
#pragma unroll
      for (int j = 0; j < 4; ++j) { const f32x4 gg = *((const f32x4*)g + lane + 64 * j); u32x2 w; w.x = cvtpk(v[j].x * rstd * gg.x, v[j].y * rstd * gg.y); w.y = cvtpk(v[j].z * rstd * gg.z, v[j].w * rstd * gg.w); o[64 * j] = w; }
    } }
}

namespace pg8 {
#define PG8_LAS __attribute__((address_space(3)))
typedef unsigned short bf16_t;
typedef short bf16x8 __attribute__((ext_vector_type(8)));
typedef float f32x4 __attribute__((ext_vector_type(4)));
typedef unsigned u32x4 __attribute__((ext_vector_type(4)));
constexpr int BM = 256, BK = 64, HALF = 128, HTB = HALF * BK * 2  , STAGE_BYTES = 8 * HTB, NXCD = 8, WGM = 8;

__host__ __device__ __forceinline__ int lds_byte(int r, int c) { const int st = (r >> 4) * 2 + (c >> 5), rr = r & 15, cc = c & 31, ob = rr * 64 + cc * 2; return st * 1024 + (ob ^ (((ob >> 9) & 1) << 5)); }
__host__ __device__ __forceinline__ void stage_rc(int b, int& R, int& C) { const int st = b / 1024, sb = b % 1024, swz = sb ^ (((sb >> 9) & 1) << 5); R = (st >> 1) * 16 + swz / 64; C = (st & 1) * 32 + (swz % 64) / 2; }
__host__ __device__ __forceinline__ int perm32(int rho) { const int n = rho >> 4, i = rho & 15; return 8 * (i >> 2) + 4 * n + (i & 3); }

struct Unit { int pm, pn; };
struct Gemm { const bf16_t* A; const bf16_t* Bt; int M, N, K; };

struct StaticOrder {
    int nM, nN, nwg, G, c;
    __host__ __device__ void init(int M, int N, int G_, int c_) { nM = M / BM; nN = N / BM; nwg = nM * nN; G = G_; c = c_; }
    __host__ __device__ bool next(int i, Unit& u) const {
        const long L = (long)i * G + c; if (L >= nwg) return false;
        int wgid = (int)L; { const int q = nwg / NXCD, r = nwg % NXCD, xcd = wgid % NXCD, off = wgid / NXCD; wgid = (xcd < r ? xcd * (q + 1) : r * (q + 1) + (xcd - r) * q) + off; }
        const int nig = WGM * nN, gid = wgid / nig, fm = gid * WGM, gsz = (nM - fm) < WGM ? (nM - fm) : WGM;
        u.pm = fm + ((wgid % nig) % gsz); u.pn = (wgid % nig) / gsz; return true;
    }
    __device__ __forceinline__ void a_ready(const Unit&) const {}
    __device__ __forceinline__ void done(const Unit&) const {}
};
__device__ __forceinline__ unsigned cvt_pk_bf16(float lo, float hi) { unsigned r; asm volatile("v_cvt_pk_bf16_f32 %0, %1, %2" : "=v"(r) : "v"(lo), "v"(hi)); return r; }
template <class Epi, class Sched, bool ALIGN_EPI = false, bool SP2 = false>
__device__ __forceinline__ void gemm_phase(PG8_LAS unsigned char* lds, const Gemm g, const Sched& S, const Epi& E) {
    int tid_ = threadIdx.x; asm volatile("" : "+v"(tid_));
    const int tid = tid_, wid = __builtin_amdgcn_readfirstlane(tid >> 6), lane = tid & 63, wr = wid >> 2, wc = wid & 3, fr = lane & 15, fq = lane >> 4;
    const int K = g.K, nt = K / BK;
    unsigned voffA[2], voffB[2];
#pragma unroll
    for (int i = 0; i < 2; ++i) { int R, C; stage_rc(tid * 16 + i * 8192, R, C); const int Rb = Epi::PERM ? ((R & ~31) + perm32(R & 31)) : R;
        voffA[i] = (unsigned)(R * K + C) * 2u; voffB[i] = (unsigned)(Rb * K + C) * 2u; }
    const size_t kstep = (size_t)(BK * 2);
    const size_t hstep = (size_t)HALF * K * 2;
    const size_t tstep = 2 * hstep;
    const unsigned ldsw = (unsigned)wid * 1024u;
    const int aoff = lds_byte(wr * 64 + fr, fq * 8), boff = lds_byte(wc * 32 + fr, fq * 8);
#define PG8_SA(b, h) (((b) * 2 + (h)) * HTB)
#define PG8_SB(b, h) ((4 + (b) * 2 + (h)) * HTB)
#define PG8_STAGE(bufoff, gbase, voff) do { _Pragma("unroll") for (int _i = 0; _i < 2; ++_i) \
        __builtin_amdgcn_global_load_lds((const unsigned*)((const char*)(gbase) + (voff)[_i]), (PG8_LAS unsigned*)(lds + (bufoff) + ldsw + _i * 8192), 16, 0, 0); } while (0)
#define PG8_LDA(dst, b, h) do { _Pragma("unroll") for (int m = 0; m < 4; ++m) _Pragma("unroll") for (int k = 0; k < 2; ++k) dst[m][k] = *(const PG8_LAS bf16x8*)(lds + PG8_SA(b, h) + aoff + m * 2048 + k * 1024); } while (0)
#define PG8_LDB(dst, b, h) do { _Pragma("unroll") for (int n = 0; n < 2; ++n) _Pragma("unroll") for (int k = 0; k < 2; ++k) dst[n][k] = *(const PG8_LAS bf16x8*)(lds + PG8_SB(b, h) + boff + n * 2048 + k * 1024); } while (0)
#define PG8_MMA(ai, bj, At, Bt) do { __builtin_amdgcn_s_setprio(1); _Pragma("unroll") for (int m = 0; m < 4; ++m) _Pragma("unroll") for (int n = 0; n < 2; ++n) _Pragma("unroll") for (int k = 0; k < 2; ++k) \
        acc[ai][bj][m][n] = __builtin_amdgcn_mfma_f32_16x16x32_bf16(Bt[n][k], At[m][k], acc[ai][bj][m][n], 0, 0, 0); __builtin_amdgcn_s_setprio(0); } while (0)
#define PG8_WAIT_V(n) asm volatile("s_waitcnt vmcnt(" #n ")" ::: "memory")
#define PG8_WAIT_L(n) asm volatile("s_waitcnt lgkmcnt(" #n ")" ::: "memory")
#define PG8_BAR __builtin_amdgcn_s_barrier()
#define PG8_SCHED __builtin_amdgcn_sched_barrier(0)
    Unit cur, nxt; int ui = 0;
    if (!S.next(0, cur)) return;
    f32x4 acc[2][2][4][2];
#pragma unroll
    for (int a = 0; a < 2; ++a)
#pragma unroll
        for (int b = 0; b < 2; ++b)
#pragma unroll
            for (int m = 0; m < 4; ++m)
#pragma unroll
                for (int n = 0; n < 2; ++n) acc[a][b][m][n] = (f32x4){0.f, 0.f, 0.f, 0.f};
    bf16x8 At[4][2], B0[2][2], B1[2][2];
    const char* cA = (const char*)g.A + (size_t)cur.pm * tstep; const char* cB = (const char*)g.Bt + (size_t)cur.pn * tstep;
    S.a_ready(cur);
    if constexpr (SP2) {
        PG8_STAGE(PG8_SB(0, 0), cB, voffB); PG8_STAGE(PG8_SB(0, 1), cB + hstep, voffB); PG8_STAGE(PG8_SA(0, 0), cA, voffA); PG8_STAGE(PG8_SA(0, 1), cA + hstep, voffA);
        if (wr == 1) PG8_BAR;
        PG8_WAIT_V(2); PG8_BAR;
        PG8_STAGE(PG8_SB(1, 0), cB + kstep, voffB); PG8_STAGE(PG8_SA(1, 0), cA + kstep, voffA); PG8_STAGE(PG8_SB(1, 1), cB + hstep + kstep, voffB);
        PG8_WAIT_V(6); PG8_BAR;
    } else {
        PG8_STAGE(PG8_SB(0, 0), cB, voffB); PG8_STAGE(PG8_SA(0, 0), cA, voffA); PG8_STAGE(PG8_SB(0, 1), cB + hstep, voffB); PG8_STAGE(PG8_SA(0, 1), cA + hstep, voffA);
        if (wr == 1) PG8_BAR;
        PG8_WAIT_V(4); PG8_BAR;
        PG8_STAGE(PG8_SB(1, 0), cB + kstep, voffB); PG8_STAGE(PG8_SA(1, 0), cA + kstep, voffA); PG8_STAGE(PG8_SB(1, 1), cB + hstep + kstep, voffB);
        PG8_WAIT_V(6); PG8_BAR;
    }
    for (;;) {
        const bool has_next = S.next(ui + 1, nxt);
        const char* nA = has_next ? (const char*)g.A + (size_t)nxt.pm * tstep : cA; const char* nB = has_next ? (const char*)g.Bt + (size_t)nxt.pn * tstep : cB;
        for (int t = 0; t < nt; t += 2) {
            const bool last = (t == nt - 2);
            const char* a1 = cA + (size_t)(t + 1) * kstep;
            const char* a2 = last ? nA : cA + (size_t)(t + 2) * kstep; const char* b2 = last ? nB : cB + (size_t)(t + 2) * kstep;
            const char* a3 = a2 + kstep; const char* b3 = b2 + kstep;
            if (last && has_next) S.a_ready(nxt);
            if constexpr (SP2) {
            PG8_LDB(B0, 0, 0); PG8_LDB(B1, 0, 1); PG8_SCHED; PG8_LDA(At, 0, 0); PG8_STAGE(PG8_SA(1, 1), a1 + hstep, voffA);
            PG8_WAIT_V(8); PG8_WAIT_L(0); PG8_BAR; PG8_MMA(0, 0, At, B0); PG8_MMA(0, 1, At, B1); PG8_BAR; PG8_SCHED;
            PG8_LDA(At, 0, 1); PG8_STAGE(PG8_SB(0, 0), b2, voffB); PG8_STAGE(PG8_SB(0, 1), b2 + hstep, voffB); PG8_STAGE(PG8_SA(0, 0), a2, voffA);
            PG8_WAIT_V(8); PG8_WAIT_L(0); PG8_BAR; PG8_MMA(1, 0, At, B0); PG8_MMA(1, 1, At, B1); PG8_BAR; PG8_SCHED;
            PG8_LDB(B0, 1, 0); PG8_LDB(B1, 1, 1); PG8_SCHED; PG8_LDA(At, 1, 0); PG8_STAGE(PG8_SA(0, 1), a2 + hstep, voffA);
            PG8_WAIT_V(8); PG8_WAIT_L(0); PG8_BAR; PG8_MMA(0, 0, At, B0); PG8_MMA(0, 1, At, B1); PG8_BAR; PG8_SCHED;
            PG8_LDA(At, 1, 1); PG8_STAGE(PG8_SB(1, 0), b3, voffB); PG8_STAGE(PG8_SB(1, 1), b3 + hstep, voffB); PG8_STAGE(PG8_SA(1, 0), a3, voffA);
            PG8_WAIT_V(8); PG8_WAIT_L(0); PG8_BAR; PG8_MMA(1, 0, At, B0); PG8_MMA(1, 1, At, B1); PG8_BAR; PG8_SCHED;
            } else {
            PG8_LDB(B0, 0, 0); PG8_SCHED; PG8_LDA(At, 0, 0); PG8_STAGE(PG8_SA(1, 1), a1 + hstep, voffA);
            PG8_WAIT_L(8); PG8_BAR; PG8_WAIT_L(0); PG8_MMA(0, 0, At, B0); PG8_BAR; PG8_SCHED;
            PG8_LDB(B1, 0, 1); PG8_STAGE(PG8_SB(0, 0), b2, voffB);
            PG8_BAR; PG8_WAIT_L(0); PG8_MMA(0, 1, At, B1); PG8_BAR;
            PG8_LDA(At, 0, 1); PG8_STAGE(PG8_SA(0, 0), a2, voffA);
            PG8_BAR; PG8_WAIT_L(0); PG8_MMA(1, 0, At, B0); PG8_BAR; PG8_SCHED;
            PG8_STAGE(PG8_SB(0, 1), b2 + hstep, voffB);
            PG8_WAIT_V(6); PG8_BAR; PG8_MMA(1, 1, At, B1); PG8_BAR;
            PG8_LDB(B0, 1, 0); PG8_SCHED; PG8_LDA(At, 1, 0); PG8_STAGE(PG8_SA(0, 1), a2 + hstep, voffA);
            PG8_WAIT_L(8); PG8_BAR; PG8_WAIT_L(0); PG8_MMA(0, 0, At, B0); PG8_BAR; PG8_SCHED;
            PG8_LDB(B1, 1, 1); PG8_STAGE(PG8_SB(1, 0), b3, voffB);
            PG8_BAR; PG8_WAIT_L(0); PG8_MMA(0, 1, At, B1); PG8_BAR;
            PG8_LDA(At, 1, 1); PG8_STAGE(PG8_SA(1, 0), a3, voffA);
            PG8_BAR; PG8_WAIT_L(0); PG8_MMA(1, 0, At, B0); PG8_BAR; PG8_SCHED;
            PG8_STAGE(PG8_SB(1, 1), b3 + hstep, voffB);
            PG8_WAIT_V(6); PG8_BAR; PG8_MMA(1, 1, At, B1); PG8_BAR;
            }
        }
        if constexpr (ALIGN_EPI) { if (wr == 0) PG8_BAR; }
        if constexpr (!Epi::AFTER_DRAIN) { E(acc, cur, wr, wc, fr, fq); S.done(cur); }
        if (!has_next) break;
#pragma unroll
        for (int a = 0; a < 2; ++a)
#pragma unroll
            for (int b = 0; b < 2; ++b)
#pragma unroll
                for (int m = 0; m < 4; ++m)
#pragma unroll
                    for (int n = 0; n < 2; ++n) acc[a][b][m][n] = (f32x4){0.f, 0.f, 0.f, 0.f};
        cur = nxt; cA = nA; cB = nB; ++ui;
        if constexpr (ALIGN_EPI) { if (wr == 1) PG8_BAR; }
    }
    PG8_WAIT_V(0);
    if constexpr (!ALIGN_EPI) { if (wr == 0) PG8_BAR; }
    PG8_BAR;
    if constexpr (Epi::AFTER_DRAIN) { E.fused(acc, cur, wr, wc, fr, fq, lds, wid, lane); S.done(cur); }
#undef PG8_SA
#undef PG8_SB
#undef PG8_STAGE
#undef PG8_LDA
#undef PG8_LDB
#undef PG8_MMA
#undef PG8_WAIT_V
#undef PG8_WAIT_L
#undef PG8_BAR
#undef PG8_SCHED
}
}

enum { T_PLAIN = 0, T_NR = 1, T_ROPE = 2, T_SILU = 3, T_IW = 4 };
DI void slot_info(const Params& p, int layer, int slot, int& type, const float*& gain) {
  gain = nullptr;
  if (layer == 0) {
    if (slot < 8) { type = T_NR; gain = p.in[I_A_Q_GAIN]; }
    else if (slot == 8) { type = T_NR; gain = p.in[I_A_K_GAIN]; }
    else if (slot == 9) type = T_PLAIN;
    else if (slot < 18) type = T_ROPE;
    else if (slot == 18) { type = T_NR; gain = p.in[I_IDX_K_GAIN]; }
    else if (slot < 27) type = T_SILU;
    else if (slot < 35) { type = T_NR; gain = p.in[I_B_Q_GAIN]; }
    else if (slot < 37) { type = T_NR; gain = p.in[I_B_K_GAIN]; }
    else if (slot < 39) type = T_PLAIN;
    else if (slot < 47) type = T_SILU;
    else type = T_IW;
  } else {
    if (slot < 8) { type = T_NR; gain = p.in[I_C_Q_GAIN]; }
    else if (slot < 16) { type = T_NR; gain = p.in[I_C_K_GAIN]; }
    else if (slot < 24) type = T_PLAIN;
    else if (slot < 32) type = T_SILU;
    else if (slot < 40) { type = T_NR; gain = p.in[I_D_Q_GAIN]; }
    else if (slot < 48) { type = T_NR; gain = p.in[I_D_K_GAIN]; }
    else if (slot < 56) type = T_PLAIN;
    else type = T_SILU;
  }
}
constexpr int E_AQ = 0, E_AK = 512, E_AV = 576, E_IQ = 640, E_IK = 1152, E_AG = 1216, E_BQ = 1728, E_BK = 2240, E_BV = 2368, E_BG = 2496;
constexpr int O_CQ = 0, O_CK = 512, O_CV = 1024, O_CG = 1536, O_DQ = 2048, O_DK = 2560, O_DV = 3072, O_DG = 3584;

typedef pg8::f32x4 (AccT)[2][2][4][2];

struct EpiInProj {
  static constexpr bool PERM = false, AFTER_DRAIN = false;
  const Params& p; int layer;
  DI void operator()(const f32x4 (&acc)[2][2][4][2], const pg8::Unit& u, int wr, int wc, int fr, int fq) const {
    unsigned char* ws = p.ws;
    const int NP = layer == 0 ? NPE : NPO;
    bf16* PE = (bf16*)(ws + WS_PE);
    const float2* rope = (const float2*)(ws + WS_ROPE);
    const float* ss1 = (const float*)(ws + WS_SS);
    float* IW = (float*)(ws + WS_IW);
    const int slot = u.pn * 4 + wc;
    int type; const float* gain; slot_info(p, layer, slot, type, gain);
#pragma unroll
    for (int ai = 0; ai < 2; ++ai)
#pragma unroll
      for (int m = 0; m < 4; ++m) {
        const int row = u.pm * 256 + ai * 128 + wr * 64 + m * 16 + fr, pos = row & (SEQ - 1);
        float sc = 1.f;
        if (layer == 1) sc = rsqrtf(ss1[row] * (1.f / DM) + EPS);
        f32x4 v1[2], v2[2];
#pragma unroll
        for (int n = 0; n < 2; ++n) { v1[n] = acc[ai][0][m][n] * sc; v2[n] = acc[ai][1][m][n] * sc; }
        if (type == T_NR) {
          float s = 0.f;
#pragma unroll
          for (int n = 0; n < 2; ++n) s += v1[n].x * v1[n].x + v1[n].y * v1[n].y + v1[n].z * v1[n].z + v1[n].w * v1[n].w + v2[n].x * v2[n].x + v2[n].y * v2[n].y + v2[n].z * v2[n].z + v2[n].w * v2[n].w;
          s += __shfl_xor(s, 16); s += __shfl_xor(s, 32);
          const float rn = rsqrtf(s * (1.f / 64.f) + EPS);
#pragma unroll
          for (int n = 0; n < 2; ++n) { const f32x4 g1 = *(const f32x4*)(gain + n * 16 + fq * 4), g2 = *(const f32x4*)(gain + 32 + n * 16 + fq * 4); v1[n] = v1[n] * rn * g1; v2[n] = v2[n] * rn * g2; }
        }
        if (type == T_NR || type == T_ROPE) {
#pragma unroll
          for (int n = 0; n < 2; ++n) {
            const f32x4* cs = (const f32x4*)(rope + (size_t)pos * 32 + n * 16 + fq * 4);
            const f32x4 c01 = cs[0], c23 = cs[1];
            const f32x4 x1 = v1[n], x2 = v2[n];
            f32x4 o1, o2;
            o1.x = x1.x * c01.x - x2.x * c01.y; o2.x = x2.x * c01.x + x1.x * c01.y;
            o1.y = x1.y * c01.z - x2.y * c01.w; o2.y = x2.y * c01.z + x1.y * c01.w;
            o1.z = x1.z * c23.x - x2.z * c23.y; o2.z = x2.z * c23.x + x1.z * c23.y;
            o1.w = x1.w * c23.z - x2.w * c23.w; o2.w = x2.w * c23.z + x1.w * c23.w;
            v1[n] = o1; v2[n] = o2;
          }
        }
        if (type == T_SILU) {
#pragma unroll
          for (int n = 0; n < 2; ++n)
#pragma unroll
            for (int j = 0; j < 4; ++j) { const float a = v1[n][j]; v1[n][j] = a / (1.f + __expf(-a)); const float b = v2[n][j]; v2[n][j] = b / (1.f + __expf(-b)); }
        }
        if (type == T_IW) {
          if (fq < 2) *(f32x4*)(IW + (size_t)row * 8 + fq * 4) = v1[0];
        } else {
          bf16* dst = PE + (size_t)row * NP + slot * 64 + fq * 4;
#pragma unroll
          for (int n = 0; n < 2; ++n) {
            u32x2 w1, w2; w1.x = cvtpk(v1[n].x, v1[n].y); w1.y = cvtpk(v1[n].z, v1[n].w); w2.x = cvtpk(v2[n].x, v2[n].y); w2.y = cvtpk(v2[n].z, v2[n].w);
            *(u32x2*)(dst + n * 16) = w1; *(u32x2*)(dst + 32 + n * 16) = w2;
            if (layer == 0 && slot == 18) { bf16* IKS = (bf16*)(ws + WS_IKS); const int key = row & (SEQ - 1);
              bf16* base = IKS + (((size_t)(row >> 13) * 256 + (key >> 5)) * 4) * 512 + ((fq >> 1) * 32 + (key & 31)) * 8 + (fq & 1) * 4;
              *(u32x2*)(base + (size_t)n * 512) = w1; *(u32x2*)(base + (size_t)(n + 2) * 512) = w2; }
          }
        }
        asm volatile("" ::: "memory");
      }
  }
};

DI void phase_inproj(const Params& p, int layer, char* lds) {
  unsigned char* ws = p.ws;
  const int NP = layer == 0 ? NPE : NPO;
  pg8::Gemm g{(const bf16*)(ws + (layer == 0 ? WS_ACT : WS_Y)), (const bf16*)(ws + (layer == 0 ? WS_WINE : WS_WINO)), NTOK, NP, DM};
  pg8::StaticOrder S; S.init(NTOK, NP, (int)gridDim.x, (int)blockIdx.x);
  EpiInProj E{p, layer};
  pg8::gemm_phase<EpiInProj, pg8::StaticOrder, true, true>((PG8_LAS unsigned char*)lds, g, S, E);
}

struct EpiOutProj {
  static constexpr bool PERM = false, AFTER_DRAIN = false;
  const float* xin; bf16* X1B; bf16* XG; const float* pg; float* ss;
  DI void operator()(const f32x4 (&acc)[2][2][4][2], const pg8::Unit& u, int wr, int wc, int fr, int fq) const {
#pragma unroll
    for (int ai = 0; ai < 2; ++ai)
#pragma unroll
      for (int m = 0; m < 4; ++m) {
        const int row = u.pm * 256 + ai * 128 + wr * 64 + m * 16 + fr; float rs = 0.f;
#pragma unroll
        for (int bj = 0; bj < 2; ++bj)
#pragma unroll
          for (int n = 0; n < 2; ++n) {
            const int col = u.pn * 256 + bj * 128 + wc * 32 + n * 16 + fq * 4; const size_t off = (size_t)row * DM + col;
            const f32x4 xn = *(const f32x4*)(xin + off) + acc[ai][bj][m][n];
            { u32x2 wx; wx.x = cvtpk(xn.x, xn.y); wx.y = cvtpk(xn.z, xn.w); *(u32x2*)(X1B + off) = wx; }
            rs += xn.x * xn.x + xn.y * xn.y + xn.z * xn.z + xn.w * xn.w;
            const f32x4 gg = *(const f32x4*)(pg + col);
            u32x2 w; w.x = cvtpk(xn.x * gg.x, xn.y * gg.y); w.y = cvtpk(xn.z * gg.z, xn.w * gg.w); *(u32x2*)(XG + off) = w;
          }
        rs += __shfl_xor(rs, 16); rs += __shfl_xor(rs, 32);
        if (fq == 0) atomicAdd(ss + row, rs);
        asm volatile("" ::: "memory");
      }
  }
};
DI void phase_outproj(const Params& p, int layer, char* lds) {
  unsigned char* ws = p.ws;
  pg8::Gemm g{(const bf16*)(ws + WS_Y), (const bf16*)(ws + (layer == 0 ? WS_WOUTE : WS_WOUTO)), NTOK, DM, DM};
  pg8::StaticOrder S; S.init(NTOK, DM, (int)gridDim.x, (int)blockIdx.x);
  EpiOutProj E{layer == 0 ? p.in[I_X] : p.out, (bf16*)(ws + WS_PE + 64 * MiB), (bf16*)(ws + WS_ACT), p.in[I_PLE_NORM_GAIN] + layer * DM, (float*)(ws + WS_SS) + (layer == 0 ? 1 : 2) * NTOK};
  pg8::gemm_phase<EpiOutProj, pg8::StaticOrder, true, true>((PG8_LAS unsigned char*)lds, g, S, E);
}

struct EpiPleProj {
  static constexpr bool PERM = false, AFTER_DRAIN = false;
  bf16* PT;
  DI void operator()(const f32x4 (&acc)[2][2][4][2], const pg8::Unit& u, int wr, int wc, int fr, int fq) const {
#pragma unroll
    for (int ai = 0; ai < 2; ++ai)
#pragma unroll
      for (int m = 0; m < 4; ++m) {
        const int row = u.pm * 256 + ai * 128 + wr * 64 + m * 16 + fr;
#pragma unroll
        for (int bj = 0; bj < 2; ++bj)
#pragma unroll
          for (int n = 0; n < 2; ++n) { const f32x4 a = acc[ai][bj][m][n]; u32x2 w; w.x = cvtpk(a.x, a.y); w.y = cvtpk(a.z, a.w); *(u32x2*)(PT + (size_t)row * DM + u.pn * 256 + bj * 128 + wc * 32 + n * 16 + fq * 4) = w; }
      }
  }
};
struct EpiPleGate {
  static constexpr bool PERM = false, AFTER_DRAIN = false;
  const bf16* PT; const bf16* X1B; float* out; const float* ssx; float* ss1; bf16* H; const float* ng1; int layer;
  DI void operator()(const f32x4 (&acc)[2][2][4][2], const pg8::Unit& u, int wr, int wc, int fr, int fq) const {
#pragma unroll
    for (int ai = 0; ai < 2; ++ai)
#pragma unroll
      for (int m = 0; m < 4; ++m) {
        const int row = u.pm * 256 + ai * 128 + wr * 64 + m * 16 + fr; float rs = 0.f;
        const float rstd = rsqrtf(ssx[row] * (1.f / DM) + EPS);
#pragma unroll
        for (int bj = 0; bj < 2; ++bj)
#pragma unroll
          for (int n = 0; n < 2; ++n) {
            const int col = u.pn * 256 + bj * 128 + wc * 32 + n * 16 + fq * 4; const size_t off = (size_t)row * DM + col;
            f32x4 g;
#pragma unroll
            for (int j = 0; j < 4; ++j) g[j] = 1.f / (1.f + __expf(-rstd * acc[ai][bj][m][n][j]));
            const u32x2 pw = *(const u32x2*)(PT + off); f32x4 pp; pp.x = __uint_as_float(pw.x << 16); pp.y = __uint_as_float(pw.x & 0xffff0000u); pp.z = __uint_as_float(pw.y << 16); pp.w = __uint_as_float(pw.y & 0xffff0000u);
            const u32x2 xw = *(const u32x2*)(X1B + off); f32x4 x1; x1.x = __uint_as_float(xw.x << 16); x1.y = __uint_as_float(xw.x & 0xffff0000u); x1.z = __uint_as_float(xw.y << 16); x1.w = __uint_as_float(xw.y & 0xffff0000u);
            const f32x4 xn = x1 + pp * g;
            *(f32x4*)(out + off) = xn;
            if (layer == 0) {
              rs += xn.x * xn.x + xn.y * xn.y + xn.z * xn.z + xn.w * xn.w;
              const f32x4 gg = *(const f32x4*)(ng1 + col);
              u32x2 w; w.x = cvtpk(xn.x * gg.x, xn.y * gg.y); w.y = cvtpk(xn.z * gg.z, xn.w * gg.w); *(u32x2*)(H + off) = w;
            }
          }
        if (layer == 0) { rs += __shfl_xor(rs, 16); rs += __shfl_xor(rs, 32); if (fq == 0) atomicAdd(ss1 + row, rs); }
        asm volatile("" ::: "memory");
      }
  }
};
DI void phase_ple(const Params& p, int layer, char* lds) {
  unsigned char* ws = p.ws;
  bf16* PT = (bf16*)(ws + WS_PE);
  pg8::StaticOrder S; S.init(NTOK, DM, (int)gridDim.x, (int)blockIdx.x);
  { pg8::Gemm g{(const bf16*)(ws + WS_PBF) + (size_t)layer * NTOK * 256, (const bf16*)(ws + (layer == 0 ? WS_WP0 : WS_WP1)), NTOK, DM, 256};
    EpiPleProj E{PT};
    pg8::gemm_phase<EpiPleProj, pg8::StaticOrder, true, true>((PG8_LAS unsigned char*)lds, g, S, E); }
  { pg8::Gemm g{(const bf16*)(ws + WS_ACT), (const bf16*)(ws + (layer == 0 ? WS_WG0 : WS_WG1)), NTOK, DM, DM};
    EpiPleGate E{PT, (const bf16*)(ws + WS_PE + 64 * MiB), p.out, (const float*)(ws + WS_SS) + (layer == 0 ? 1 : 2) * NTOK, (float*)(ws + WS_SS), (bf16*)(ws + WS_Y), p.in[I_NORM_GAIN] + DM, layer};
    pg8::gemm_phase<EpiPleGate, pg8::StaticOrder, true, true>((PG8_LAS unsigned char*)lds, g, S, E); }
}

DI float half_max(float v) { auto rr = __builtin_amdgcn_permlane32_swap(__float_as_uint(v), __float_as_uint(v), false, false); return fmaxf(__uint_as_float(rr[0]), __uint_as_float(rr[1])); }
template <int DVB, bool MASKED = true>
DI void attn_step32(const bf16* Kt, int KP, const bf16* Vt, int VP, const bf16x8 (&qf)[4], f32x16 (&o)[DVB], float& m, float& l, unsigned vmask, float c2, int lane) {
  const int r32 = lane & 31, h = lane >> 5;
  f32x16 s;
#pragma unroll
  for (int i = 0; i < 16; ++i) s[i] = 0.f;
#pragma unroll
  for (int t = 0; t < 4; ++t) { const bf16x8 kf = *(const bf16x8*)(Kt + r32 * KP + t * 16 + h * 8); s = mfma32(kf, qf[t], s); }
  float mx = -INFINITY;
#pragma unroll
  for (int i = 0; i < 16; ++i) { if (MASKED) { s[i] = ((vmask >> i) & 1u) ? s[i] : -INFINITY; } mx = fmaxf(mx, s[i]); }
  mx = half_max(mx);
  const float mxs = mx * c2;
  if (__any(mxs > m + 6.f)) {
    const float mn = fmaxf(m, mxs);
    const float alpha = fexp2(m - mn); l *= alpha;
#pragma unroll
    for (int d = 0; d < DVB; ++d)
#pragma unroll
      for (int i = 0; i < 16; ++i) o[d][i] *= alpha;
    m = mn;
  }
  float ps = 0.f; const float negm = -m;
#pragma unroll
  for (int i = 0; i < 16; ++i) { const float pv = fexp2(__builtin_fmaf(s[i], c2, negm)); s[i] = pv; ps += pv; }
  l += ps;
  bf16x8 pf[2];
  { u32x4 a, b; a.x = cvtpk(s[0], s[1]); a.y = cvtpk(s[2], s[3]); a.z = cvtpk(s[4], s[5]); a.w = cvtpk(s[6], s[7]);
    b.x = cvtpk(s[8], s[9]); b.y = cvtpk(s[10], s[11]); b.z = cvtpk(s[12], s[13]); b.w = cvtpk(s[14], s[15]);
    pf[0] = __builtin_bit_cast(bf16x8, a); pf[1] = __builtin_bit_cast(bf16x8, b); }
  const int i16 = lane & 15, q = i16 >> 2, pp = i16 & 3, blk = (lane >> 4) & 1;
#pragma unroll
  for (int d = 0; d < DVB; ++d)
#pragma unroll
    for (int sk = 0; sk < 2; ++sk) {
      const s16x4 lo = trread(Vt + (16 * sk + 4 * h + q) * VP + 32 * d + 16 * blk + 4 * pp);
      const s16x4 hi = trread(Vt + (16 * sk + 8 + 4 * h + q) * VP + 32 * d + 16 * blk + 4 * pp);
      const bf16x8 vf = __builtin_shufflevector(lo, hi, 0, 1, 2, 3, 4, 5, 6, 7);
      o[d] = mfma32(vf, pf[sk], o[d]);
    }
}

DI unsigned row_range_mask(int lo, int hi) {
  lo = lo < 0 ? 0 : lo; hi = hi > 31 ? 31 : hi;
  if (hi < lo) return 0u;
  const unsigned upto_hi = (hi >= 31) ? 0xffffffffu : ((1u << (hi + 1)) - 1u);
  return upto_hi & ~((1u << lo) - 1u);
}
DI unsigned lane_rows(unsigned m32, int h) {
  const unsigned t = m32 >> (4 * h);
  return (t & 0xFu) | ((t >> 4) & 0xF0u) | ((t >> 8) & 0xF00u) | ((t >> 12) & 0xF000u);
}
constexpr int WP = 72;
constexpr int WAVE_LDS = 2 * 32 * WP * 2 + 512;

struct KVRegs { u32x4 k[4], v[4]; };
DI void kv_store(const KVRegs& R, bf16* Ks, bf16* Vs, int lane) {
#pragma unroll
  for (int i = 0; i < 4; ++i) { const int row = (lane >> 3) + 8 * i, ch = lane & 7; *(u32x4*)(Ks + row * WP + ch * 8) = R.k[i]; *(u32x4*)(Vs + row * WP + ch * 8) = R.v[i]; }
}

DI void band_load(KVRegs& R, const bf16* Kg, const bf16* Vg, int NP, int kstart, int dil, int roff, int lane) {
#pragma unroll
  for (int i = 0; i < 4; ++i) {
    const int row = (lane >> 3) + 8 * i, ch = lane & 7; int k = kstart + row; if (k < 0) k = 0;
    const size_t off = (size_t)(dil * k + roff) * NP + ch * 8;
    R.k[i] = *(const u32x4*)(Kg + off); R.v[i] = *(const u32x4*)(Vg + off);
  }
}
template <int DVB>
DI void band_run(const bf16* Kg, const bf16* Vg, int NP, int kbase, int nsteps, int dil, int roff, int qidx, int win,
                 const bf16x8 (&qf)[4], f32x16 (&o)[DVB], float& m, float& l, float c2, bf16* Ks, bf16* Vs, int lane) {
  const int h = lane >> 5;
  KVRegs R; band_load(R, Kg, Vg, NP, kbase, dil, roff, lane);
  for (int j = 0; j < nsteps; ++j) {
    lds_fence();
    kv_store(R, Ks, Vs, lane);
    lds_fence();
    if (j + 1 < nsteps) band_load(R, Kg, Vg, NP, kbase + 32 * (j + 1), dil, roff, lane);
    const int kb = kbase + 32 * j, lo_r = (qidx - win > 0 ? qidx - win : 0) - kb;
    const unsigned vm = lane_rows(row_range_mask(lo_r, qidx - kb), h);
    attn_step32<DVB>(Ks, WP, Vs, WP, qf, o, m, l, vm, c2, lane);
  }
}

DI void write_o64(const f32x16 (&o)[2], float linv, const bf16* gate_row, bf16* y_row, int h) {
#pragma unroll
  for (int d = 0; d < 2; ++d)
#pragma unroll
    for (int g = 0; g < 4; ++g) {
      const int dd = 32 * d + 8 * g + 4 * h;
      const u32x2 gv = *(const u32x2*)(gate_row + dd);
      const float g0 = __uint_as_float(gv.x << 16), g1 = __uint_as_float(gv.x & 0xffff0000u), g2 = __uint_as_float(gv.y << 16), g3 = __uint_as_float(gv.y & 0xffff0000u);
      u32x2 w; w.x = cvtpk(o[d][4 * g] * linv * g0, o[d][4 * g + 1] * linv * g1); w.y = cvtpk(o[d][4 * g + 2] * linv * g2, o[d][4 * g + 3] * linv * g3);
      *(u32x2*)(y_row + dd) = w;
    }
}

DI void load_q(bf16x8 (&qf)[4], const bf16* qrow, int h) {
#pragma unroll
  for (int t = 0; t < 4; ++t) qf[t] = *(const bf16x8*)(qrow + t * 16 + h * 8);
}
template <int DVB> DI void zero_o(f32x16 (&o)[DVB]) {
#pragma unroll
  for (int d = 0; d < DVB; ++d)
#pragma unroll
    for (int i = 0; i < 16; ++i) o[d][i] = 0.f;
}

DI void mixerB_tile(const Params& p, int item, bf16* Ks, bf16* Vs, int lane) {
  const bf16* PE = (const bf16*)(p.ws + WS_PE); bf16* Y = (bf16*)(p.ws + WS_Y);
  const int qblk = item & 255, head = (item >> 8) & 7, b = item >> 11;
  const int r32 = lane & 31, h = lane >> 5, q0 = qblk * 32, kvh = head >> 2;
  const size_t rowb = (size_t)b * SEQ;
  bf16x8 qf[4]; load_q(qf, PE + (rowb + q0 + r32) * NPE + E_BQ + head * 64, h);
  f32x16 o[2]; zero_o<2>(o);
  const float sink2 = p.in[I_B_SINKS][head] * LOG2E;
  float m = sink2, l = (h == 0) ? 1.f : 0.f;
  band_run<2>(PE + rowb * NPE + E_BK + kvh * 64, PE + rowb * NPE + E_BV + kvh * 64, NPE, q0 - 128, 5, 1, 0, q0 + r32, 127, qf, o, m, l, 0.125f * LOG2E, Ks, Vs, lane);
  l += __shfl_xor(l, 32);
  const size_t tok = rowb + q0 + r32;
  write_o64(o, 1.f / l, PE + tok * NPE + E_BG + head * 64, Y + tok * DM + 512 + head * 64, h);
}

DI void mixerC_tile(const Params& p, int item, bf16* Ks, bf16* Vs, int lane) {
  const bf16* PO = (const bf16*)(p.ws + WS_PE); bf16* Y = (bf16*)(p.ws + WS_Y);
  const int qt = item & 15, r16 = (item >> 4) & 15, head = (item >> 8) & 7, b = item >> 11;
  const int r32 = lane & 31, h = lane >> 5, qi0 = qt * 32;
  const size_t rowb = (size_t)b * SEQ;
  const int t = 16 * (qi0 + r32) + r16;
  bf16x8 qf[4]; load_q(qf, PO + (rowb + t) * NPO + O_CQ + head * 64, h);
  f32x16 o[2]; zero_o<2>(o);
  float m = -1e30f, l = 0.f;
  const bf16* Kg = PO + rowb * NPO + O_CK + head * 64; const bf16* Vg = PO + rowb * NPO + O_CV + head * 64;
  const float c2 = 0.125f * LOG2E;
  band_run<2>(Kg, Vg, NPO, qi0 - 128, 5, 16, r16, qi0 + r32, 128, qf, o, m, l, c2, Ks, Vs, lane);
  band_run<2>(Kg, Vg, NPO, 4 * qi0 + (r16 >> 2) - 128, 8, 4, r16 & 3, 4 * (qi0 + r32) + (r16 >> 2), 128, qf, o, m, l, c2, Ks, Vs, lane);
  band_run<2>(Kg, Vg, NPO, 16 * qi0 + r16 - 128, 20, 1, 0, t, 128, qf, o, m, l, c2, Ks, Vs, lane);
  l += __shfl_xor(l, 32);
  const size_t tok = rowb + t;
  write_o64(o, 1.f / l, PO + tok * NPO + O_CG + head * 64, Y + tok * DM + head * 64, h);
}

DI void attn_step16(const bf16* Kt, const bf16* Vt, const bf16x8 (&qf)[2], f32x4 (&o)[4], float& m, float& l, int nvalid  , float c2, int lane) {
  const int c = lane & 15, qd = lane >> 4;
  f32x4 s0 = {0.f, 0.f, 0.f, 0.f}, s1 = {0.f, 0.f, 0.f, 0.f};
#pragma unroll
  for (int ks = 0; ks < 2; ++ks) {
    const bf16x8 k0 = *(const bf16x8*)(Kt + c * WP + ks * 32 + qd * 8);
    const bf16x8 k1 = *(const bf16x8*)(Kt + (16 + c) * WP + ks * 32 + qd * 8);
    s0 = mfma16(k0, qf[ks], s0); s1 = mfma16(k1, qf[ks], s1);
  }
  float mx = -INFINITY;
#pragma unroll
  for (int j = 0; j < 4; ++j) { if (4 * qd + j >= nvalid) s0[j] = -INFINITY; if (16 + 4 * qd + j >= nvalid) s1[j] = -INFINITY; mx = fmaxf(mx, fmaxf(s0[j], s1[j])); }
  mx = fmaxf(mx, __shfl_xor(mx, 16)); mx = fmaxf(mx, __shfl_xor(mx, 32));
  const float mxs = mx * c2;
  if (__any(mxs > m + 6.f)) {
    const float mn = fmaxf(m, mxs); const float alpha = fexp2(m - mn); l *= alpha;
#pragma unroll
    for (int d = 0; d < 4; ++d) o[d] = o[d] * alpha;
    m = mn;
  }
  const float negm = -m; float ps = 0.f;
#pragma unroll
  for (int j = 0; j < 4; ++j) { s0[j] = fexp2(__builtin_fmaf(s0[j], c2, negm)); s1[j] = fexp2(__builtin_fmaf(s1[j], c2, negm)); ps += s0[j] + s1[j]; }
  l += ps;
  u32x4 pw; pw.x = cvtpk(s0[0], s0[1]); pw.y = cvtpk(s0[2], s0[3]); pw.z = cvtpk(s1[0], s1[1]); pw.w = cvtpk(s1[2], s1[3]);
  const bf16x8 pf = __builtin_bit_cast(bf16x8, pw);
  const int i16 = lane & 15, rq = i16 >> 2, pp = i16 & 3;
#pragma unroll
  for (int dt = 0; dt < 4; ++dt) {
    const s16x4 lo = trread(Vt + (4 * qd + rq) * WP + 16 * dt + 4 * pp);
    const s16x4 hi = trread(Vt + (16 + 4 * qd + rq) * WP + 16 * dt + 4 * pp);
    const bf16x8 vf = __builtin_shufflevector(lo, hi, 0, 1, 2, 3, 4, 5, 6, 7);
    o[dt] = mfma16(vf, pf, o[dt]);
  }
}

DI void mixerA_item(const Params& p, int item, bf16* Ks, bf16* Vs, int lane) {
  const bf16* PE = (const bf16*)(p.ws + WS_PE); bf16* Y = (bf16*)(p.ws + WS_Y);
  const unsigned short* SEL = (const unsigned short*)(p.ws + WS_SEL) + (size_t)item * 256;
  const int t = item & (SEQ - 1), b = item >> 13;
  const int c = lane & 15, qd = lane >> 4, head = c & 7;
  const size_t rowb = (size_t)b * SEQ;
  const int count = (t + 1 < 256) ? t + 1 : 256, nsteps = (count + 31) >> 5;
  bf16x8 qf[2];
#pragma unroll
  for (int ks = 0; ks < 2; ++ks) qf[ks] = *(const bf16x8*)(PE + (size_t)item * NPE + E_AQ + head * 64 + ks * 32 + qd * 8);
  f32x4 o[4];
#pragma unroll
  for (int d = 0; d < 4; ++d) o[d] = (f32x4){0.f, 0.f, 0.f, 0.f};
  float m = -1e30f, l = 0.f;
  const bf16* Kg = PE + rowb * NPE + E_AK; const bf16* Vg = PE + rowb * NPE + E_AV;
  KVRegs R;
  unsigned short* sel_l = (unsigned short*)(Vs + 32 * WP);
  lds_fence();
  *(u32x2*)(sel_l + 4 * lane) = *(const u32x2*)(SEL + 4 * lane);
  lds_fence();
#define A_LOAD(j) do { _Pragma("unroll") for (int i = 0; i < 4; ++i) { const int row = (lane >> 3) + 8 * i, ch = lane & 7, e = 32 * (j) + row; \
      const int tokk = (e < count) ? (int)sel_l[e] : 0; const size_t off = (size_t)tokk * NPE + ch * 8; R.k[i] = *(const u32x4*)(Kg + off); R.v[i] = *(const u32x4*)(Vg + off); } } while (0)
  A_LOAD(0);
  for (int j = 0; j < nsteps; ++j) {
    lds_fence();
    kv_store(R, Ks, Vs, lane);
    lds_fence();
    if (j + 1 < nsteps) A_LOAD(j + 1);
    attn_step16(Ks, Vs, qf, o, m, l, count - 32 * j, 0.125f * LOG2E, lane);
  }
#undef A_LOAD
  l += __shfl_xor(l, 16); l += __shfl_xor(l, 32);
  if (c < 8) {
    const float linv = 1.f / l;
    const bf16* gate_row = PE + (size_t)item * NPE + E_AG + head * 64; bf16* y_row = Y + (size_t)item * DM + head * 64;
#pragma unroll
    for (int dt = 0; dt < 4; ++dt) {
      const int dd = 16 * dt + 4 * qd;
      const u32x2 gv = *(const u32x2*)(gate_row + dd);
      const float g0 = __uint_as_float(gv.x << 16), g1 = __uint_as_float(gv.x & 0xffff0000u), g2 = __uint_as_float(gv.y << 16), g3 = __uint_as_float(gv.y & 0xffff0000u);
      u32x2 w; w.x = cvtpk(o[dt][0] * linv * g0, o[dt][1] * linv * g1); w.y = cvtpk(o[dt][2] * linv * g2, o[dt][3] * linv * g3);
      *(u32x2*)(y_row + dd) = w;
    }
  }
}

DI unsigned f2ord(float f) { f += 0.f; const unsigned u = __float_as_uint(f); return (u & 0x80000000u) ? ~u : (u | 0x80000000u); }
DI int block_excl_scan(int v, int* tmp, int* tot) {
  const int lane = threadIdx.x & 63, wid = threadIdx.x >> 6;
  int inc = v;
#pragma unroll
  for (int o = 1; o < 64; o <<= 1) { const int u = __shfl_up(inc, o); if (lane >= o) inc += u; }
  if (lane == 63) tmp[wid] = inc;
  __syncthreads();
  int base = 0, total = 0;
#pragma unroll
  for (int w = 0; w < 8; ++w) { const int x = tmp[w]; if (w < wid) base += x; total += x; }
  *tot = total;
  return base + inc - v;
}

DI float dpp_sum8(float v) {
  v += __builtin_bit_cast(float, __builtin_amdgcn_mov_dpp(__builtin_bit_cast(int, v), 0xB1, 0xF, 0xF, true));
  v += __builtin_bit_cast(float, __builtin_amdgcn_mov_dpp(__builtin_bit_cast(int, v), 0x4E, 0xF, 0xF, true));
  v += __builtin_bit_cast(float, __builtin_amdgcn_mov_dpp(__builtin_bit_cast(int, v), 0x141, 0xF, 0xF, true));
  return v;
}
DI void hist_find(const int* hist, int* misc, int need, int& digit, int& nneed, int& cnt) {
  const int tid = threadIdx.x;
  typedef int i32x4 __attribute__((ext_vector_type(4)));
  const i32x4 h0 = *(const i32x4*)(hist + tid * 8), h1 = *(const i32x4*)(hist + tid * 8 + 4);
  int hh[8] = {h0.x, h0.y, h0.z, h0.w, h1.x, h1.y, h1.z, h1.w}; int tot = 0;
#pragma unroll
  for (int k = 0; k < 8; ++k) tot += hh[k];
  int total; const int ex = block_excl_scan(tot, misc, &total);
  int above = total - ex - tot;
#pragma unroll
  for (int k = 7; k >= 0; --k) { const int c = hh[k]; if (above < need && above + c >= need) { misc[16] = tid * 8 + k; misc[17] = need - above; misc[18] = c; } above += c; }
  __syncthreads();
  digit = misc[16]; nneed = misc[17]; cnt = misc[18];
  __syncthreads();
}
DI unsigned long long mkcmp(float v, int idx) { return ((unsigned long long)f2ord(v) << 16) | ((unsigned long long)(8191 - idx) << 3); }
DI float ord2f(unsigned k) { return __uint_as_float((k & 0x80000000u) ? (k ^ 0x80000000u) : ~k); }
DI float half_sum(float v) { auto rr = __builtin_amdgcn_permlane32_swap(__float_as_uint(v), __float_as_uint(v), false, false); return __uint_as_float(rr[0]) + __uint_as_float(rr[1]); }

constexpr int CL_CAP = 512;
DI void select_slow(const float* scq, int n, unsigned short* out, float lo, float hi, int* hist, int* misc, unsigned long long* clist) {
  const int tid = opaque_tid();
    const float scale = (hi > lo) ? 4095.f / (hi - lo) : 0.f;
    for (int i = tid; i < 4096; i += 512) hist[i] = 0;
    if (tid == 0) misc[20] = 0;
    __syncthreads();
    float val[16]; int bin[16];
#pragma unroll
    for (int i = 0; i < 16; ++i) { const int idx = tid + 512 * i; const float v = (idx < n) ? scq[idx] : lo; val[i] = v;
      int bb = (int)((v - lo) * scale); bb = bb < 0 ? 0 : (bb > 4095 ? 4095 : bb); bin[i] = bb; if (idx < n) atomicAdd(&hist[bb], 1); }
    __syncthreads();
    int bstar, need, cnt;
    hist_find(hist, misc, 256, bstar, need, cnt);
    unsigned long long T = 0ull;
    if (cnt != need) {
      if (cnt <= CL_CAP) {
#pragma unroll
        for (int i = 0; i < 16; ++i) { const int idx = tid + 512 * i; if (idx < n && bin[i] == bstar) { const int slot = atomicAdd(&misc[20], 1); clist[slot] = mkcmp(val[i], idx); } }
        __syncthreads();
        if (tid < cnt) { const unsigned long long c = clist[tid]; int rank = 0; for (int jx = 0; jx < cnt; ++jx) rank += (clist[jx] > c) ? 1 : 0;
          if (rank == need - 1) { misc[21] = (int)(unsigned)(c & 0xffffffffull); misc[22] = (int)(unsigned)(c >> 32); } }
        __syncthreads();
        T = ((unsigned long long)(unsigned)misc[22] << 32) | (unsigned long long)(unsigned)misc[21];
      } else {
        unsigned long long prefix = 0ull; int shift = 36;
        for (int pass = 0; pass < 4; ++pass) {
          for (int i = tid; i < 4096; i += 512) hist[i] = 0;
          __syncthreads();
#pragma unroll
          for (int i = 0; i < 16; ++i) { const int idx = tid + 512 * i; if (idx < n && bin[i] == bstar) { const unsigned long long c = mkcmp(val[i], idx); if (pass == 0 || (c >> (shift + 12)) == prefix) atomicAdd(&hist[(int)((c >> shift) & 4095ull)], 1); } }
          __syncthreads();
          int digit, nneed, c2;
          hist_find(hist, misc, need, digit, nneed, c2);
          prefix = (prefix << 12) | (unsigned long long)digit; need = nneed;
          if (c2 == need) break;
          shift -= 12;
        }
        T = prefix << shift;
      }
    }
    int mycnt = 0; unsigned selm = 0;
#pragma unroll
    for (int i = 0; i < 16; ++i) { const int idx = tid + 512 * i;
      bool sel = false;
      if (idx < n) { if (bin[i] > bstar) sel = true; else if (bin[i] == bstar) sel = (mkcmp(val[i], idx) >= T); }
      if (sel) { ++mycnt; selm |= (1u << i); } }
    int total; int pos = block_excl_scan(mycnt, misc + 8, &total);
#pragma unroll
    for (int i = 0; i < 16; ++i) { if ((selm >> i) & 1u) { if (pos < 256) out[pos] = (unsigned short)(tid + 512 * i); ++pos; } }
    __syncthreads();
}

DI void sel_load_qw(const Params& p, int item, bf16x8 (&qf)[4], float (&wq)[16], int lane) {
  const bf16* PE = (const bf16*)(p.ws + WS_PE); const float* IW = (const float*)(p.ws + WS_IW);
  const int r32 = lane & 31, h = lane >> 5, b = item >> 11, t0 = (item & 2047) * 4; const size_t rowb = (size_t)b * SEQ;
  load_q(qf, PE + (rowb + t0 + (r32 >> 3)) * NPE + E_IQ + (r32 & 7) * 64, h);
#pragma unroll
  for (int q = 0; q < 4; ++q) { const f32x4 w4 = *(const f32x4*)(IW + (rowb + t0 + q) * 8 + 4 * h);
    wq[4 * q] = w4.x * 0.04419417382415922f; wq[4 * q + 1] = w4.y * 0.04419417382415922f; wq[4 * q + 2] = w4.z * 0.04419417382415922f; wq[4 * q + 3] = w4.w * 0.04419417382415922f; }
}
DI void selectA_item(const Params& p, int item, int next_item, char* lds, bf16x8 (&qf)[4], float (&wq)[16]) {
  const bf16* PE = (const bf16*)(p.ws + WS_PE);
  const float* IW = (const float*)(p.ws + WS_IW);
  unsigned short* SEL = (unsigned short*)(p.ws + WS_SEL);
  float* sc = (float*)lds;
  int* hist = (int*)(lds + 4 * 8192 * 4);
  int* misc = hist + 4096;
  unsigned* mm = (unsigned*)(misc + 24);
  unsigned long long* clist = (unsigned long long*)(misc + 96);
  const int tid = opaque_tid(), lane = tid & 63, wid = tid >> 6, r32 = lane & 31, h = lane >> 5;
  const int b = item >> 11, t0 = (item & 2047) * 4;
  const size_t rowb = (size_t)b * SEQ;
  const int nk = t0 + 4, ntile = (nk + 31) >> 5;
  const f32x4 pcv = ((const f32x4*)p.in[I_P])[(size_t)item * 512 + tid];
  if (tid < 4) { mm[tid * 2] = 0xFFFFFFFFu; mm[tid * 2 + 1] = 0u; }
  lds_barrier();
  const bf16* Kt = (const bf16*)(p.ws + WS_IKS) + (size_t)b * 256 * 2048 + lane * 8;
  {
    bf16x8 kf[4], kn[4];
#pragma unroll
    for (int t = 0; t < 4; ++t) { kf[t] = (bf16x8){0, 0, 0, 0, 0, 0, 0, 0}; kn[t] = kf[t]; }
    if (wid < ntile) {
#pragma unroll
      for (int t = 0; t < 4; ++t) kf[t] = *(const bf16x8*)(Kt + (size_t)wid * 2048 + t * 512);
    }
    float lo0 = INFINITY, hi0 = -INFINITY, lo1 = INFINITY, hi1 = -INFINITY;
    for (int kt = wid; kt < ntile; kt += 8) {
      if (kt + 8 < ntile) {
#pragma unroll
        for (int t = 0; t < 4; ++t) kn[t] = *(const bf16x8*)(Kt + (size_t)(kt + 8) * 2048 + t * 512);
      }
      f32x16 s;
#pragma unroll
      for (int i = 0; i < 16; ++i) s[i] = 0.f;
#pragma unroll
      for (int t = 0; t < 4; ++t) s = mfma32(qf[t], kf[t], s);
      float v[4];
#pragma unroll
      for (int q = 0; q < 4; ++q) {
        float a = wq[4 * q] * fmaxf(s[4 * q], 0.f);
#pragma unroll
        for (int jj = 1; jj < 4; ++jj) a += wq[4 * q + jj] * fmaxf(s[4 * q + jj], 0.f);
        v[q] = half_sum(a) + 0.f;
      }
      const float va = h ? v[2] : v[0], vb = h ? v[3] : v[1];
      const int key = kt * 32 + r32;
      sc[(2 * h) * 8192 + key] = va; sc[(2 * h + 1) * 8192 + key] = vb;
      lo0 = fminf(lo0, va); hi0 = fmaxf(hi0, va); lo1 = fminf(lo1, vb); hi1 = fmaxf(hi1, vb);
#pragma unroll
      for (int t = 0; t < 4; ++t) kf[t] = kn[t];
    }
    if (wid < ntile) {
#pragma unroll
      for (int o = 1; o < 32; o <<= 1) { lo0 = fminf(lo0, __shfl_xor(lo0, o)); hi0 = fmaxf(hi0, __shfl_xor(hi0, o)); lo1 = fminf(lo1, __shfl_xor(lo1, o)); hi1 = fmaxf(hi1, __shfl_xor(hi1, o)); }
      if (r32 == 0) { atomicMin(&mm[(2 * h) * 2], f2ord(lo0)); atomicMax(&mm[(2 * h) * 2 + 1], f2ord(hi0)); atomicMin(&mm[(2 * h + 1) * 2], f2ord(lo1)); atomicMax(&mm[(2 * h + 1) * 2 + 1], f2ord(hi1)); }
    }
  }
  if (next_item >= 0) sel_load_qw(p, next_item, qf, wq, lane);
  { u32x2 w; w.x = cvtpk(pcv.x, pcv.y); w.y = cvtpk(pcv.z, pcv.w); ((u32x2*)(p.ws + WS_PBF))[(size_t)item * 512 + tid] = w; }
  lds_barrier();
  {
    const int g = wid >> 1, gt = tid & 127, upper = wid & 1;
    const int t = t0 + g, n = t + 1;
    const bool big = n > 256;
    const float* scq = sc + g * 8192;
    unsigned short* out = SEL + (rowb + t) * 256;
    int* histq = hist + g * 1024;
    unsigned long long* clq = clist + g * 128;
    int* mq = misc + 32 + g * 8;
    const float lo = ord2f(mm[g * 2]), hi = ord2f(mm[g * 2 + 1]);
    const float scale = (hi > lo) ? 1023.f / (hi - lo) : 0.f;
    for (int i = gt; i < 1024; i += 128) histq[i] = 0;
    if (gt == 0) { mq[0] = 0; mq[6] = 0; }
    lds_barrier();
    float uu[64];
#pragma unroll
    for (int i = 0; i < 64; ++i) { const int idx = gt + 128 * i; const float v = (idx < n) ? scq[idx] : lo; const float u = (v - lo) * scale; uu[i] = u;
      if (big && idx < n) { int bb = (int)u; bb = bb > 1023 ? 1023 : bb; atomicAdd(&histq[bb], 1); } }
    lds_barrier();
    typedef int i32x4 __attribute__((ext_vector_type(4)));
    const i32x4 h0 = *(const i32x4*)(histq + gt * 8), h1 = *(const i32x4*)(histq + gt * 8 + 4);
    const int hh[8] = {h0.x, h0.y, h0.z, h0.w, h1.x, h1.y, h1.z, h1.w};
    int tot = 0;
#pragma unroll
    for (int k = 0; k < 8; ++k) tot += hh[k];
    int inc = tot;
#pragma unroll
    for (int o = 1; o < 64; o <<= 1) { const int ux = __shfl_down(inc, o); if (lane + o < 64) inc += ux; }
    if (lane == 0) misc[wid] = inc;
    lds_barrier();
    {
      int above = inc - tot + (upper ? 0 : misc[wid + 1]);
      if (big) {
#pragma unroll
        for (int k = 7; k >= 0; --k) { const int c = hh[k]; if (above < 256 && above + c >= 256) { mq[1] = gt * 8 + k; mq[2] = 256 - above; mq[3] = c; } above += c; }
      }
    }
    lds_barrier();
    const int bstar = mq[1], need = mq[2], cnt = mq[3];
    const float flo = (float)bstar, fhi = (bstar >= 1023) ? INFINITY : (float)(bstar + 1);
    const bool tie = big && cnt != need;
    if (tie) {
      if (cnt <= 128) {
#pragma unroll
        for (int i = 0; i < 64; ++i) { const int idx = gt + 128 * i; if (idx < n && uu[i] >= flo && uu[i] < fhi) { const int slot = atomicAdd(&mq[0], 1); clq[slot] = mkcmp(scq[idx], idx); } }
      } else if (gt == 0) mq[6] = 1;
    }
    lds_barrier();
    if (tie && cnt <= 128 && gt < cnt) { const unsigned long long c = clq[gt]; int rank = 0; for (int jx = 0; jx < cnt; ++jx) rank += (clq[jx] > c) ? 1 : 0;
      if (rank == need - 1) { mq[4] = (int)(unsigned)(c & 0xffffffffull); mq[5] = (int)(unsigned)(c >> 32); } }
    lds_barrier();
    const unsigned long long T = tie ? (((unsigned long long)(unsigned)mq[5] << 32) | (unsigned long long)(unsigned)mq[4]) : 0ull;
    const bool fast = big && !(tie && cnt > 128);
    unsigned long long selm = 0ull;
    if (fast) {
#pragma unroll
      for (int i = 0; i < 64; ++i) { const int idx = gt + 128 * i;
        if (idx < n) { const float u = uu[i]; bool sel = u >= fhi; if (!sel && u >= flo) sel = !tie || (mkcmp(scq[idx], idx) >= T); if (sel) selm |= (1ull << i); } }
    }
    const int mycnt = __popcll(selm);
    int pinc = mycnt;
#pragma unroll
    for (int o = 1; o < 64; o <<= 1) { const int ux = __shfl_up(pinc, o); if (lane >= o) pinc += ux; }
    if (lane == 63) misc[8 + wid] = pinc;
    lds_barrier();
    if (fast) {
      int pos = pinc - mycnt + (upper ? misc[8 + wid - 1] : 0);
      while (selm) { const int i = __ffsll((long long)selm) - 1; selm &= selm - 1ull; if (pos < 256) out[pos] = (unsigned short)(gt + 128 * i); ++pos; }
    } else if (!big) {
      for (int i = gt; i < n; i += 128) out[i] = (unsigned short)i;
    }
    lds_barrier();
  }
  for (int q = 0; q < 4; ++q) {
    if (misc[32 + q * 8 + 6]) { const int t = t0 + q; select_slow(sc + q * 8192, t + 1, SEL + (rowb + t) * 256, ord2f(mm[q * 2]), ord2f(mm[q * 2 + 1]), hist, misc, clist); }
  }
  lds_barrier();
}

constexpr int DKP = 72, DVP = 136;
constexpr int D_STAGE = (64 * DKP * 2 + 64 * DVP) * 2;
DI void mixerD_unit(const Params& p, int b, int head, int qb, char* lds) {
  const bf16* PO = (const bf16*)(p.ws + WS_PE); bf16* Y = (bf16*)(p.ws + WS_Y);
  const int tid = opaque_tid(), lane = tid & 63, wid = tid >> 6, r32 = lane & 31, h = lane >> 5;
  const int map = wid & 1, qsub = wid >> 1;
  const size_t rowb = (size_t)b * SEQ;
  const int qpos = 128 * qb + 32 * qsub + r32;
  bf16x8 qf[4]; load_q(qf, PO + (rowb + qpos) * NPO + O_DQ + (2 * head + map) * 64, h);
  f32x16 o[4]; zero_o<4>(o);
  float m = -1e30f, l = 0.f;
  const int nsteps = 2 * qb + 2;
  const bf16* K1g = PO + rowb * NPO + O_DK + (2 * head) * 64;
  const bf16* K2g = K1g + 64;
  const bf16* Vg = PO + rowb * NPO + O_DV + head * 128;
  u32x4 rk1, rk2, rv[2];
#define D_LOAD(j) do { const int row = tid >> 3, ch = tid & 7; const size_t off = (size_t)((j) * 64 + row) * NPO + ch * 8; rk1 = *(const u32x4*)(K1g + off); rk2 = *(const u32x4*)(K2g + off); \
    _Pragma("unroll") for (int i = 0; i < 2; ++i) { const int c = tid + 512 * i, vr = c >> 4, vc = c & 15; rv[i] = *(const u32x4*)(Vg + (size_t)((j) * 64 + vr) * NPO + vc * 8); } } while (0)
  __syncthreads();
  D_LOAD(0);
  for (int j = 0; j < nsteps; ++j) {
    char* st = lds + (j & 1) * D_STAGE;
    bf16* K1s = (bf16*)st; bf16* K2s = K1s + 64 * DKP; bf16* Vs = K2s + 64 * DKP;
    { const int row = tid >> 3, ch = tid & 7; *(u32x4*)(K1s + row * DKP + ch * 8) = rk1; *(u32x4*)(K2s + row * DKP + ch * 8) = rk2;
#pragma unroll
      for (int i = 0; i < 2; ++i) { const int c = tid + 512 * i, vr = c >> 4, vc = c & 15; *(u32x4*)(Vs + vr * DVP + vc * 8) = rv[i]; } }
    __syncthreads();
    if (j + 1 < nsteps) D_LOAD(j + 1);
    const bf16* Ks = map ? K2s : K1s;
#pragma unroll
    for (int sub = 0; sub < 2; ++sub) {
      const int k0 = j * 64 + sub * 32;
      if (k0 <= 128 * qb + 32 * qsub + 31) {
        if (k0 + 31 <= 128 * qb + 32 * qsub) {
          attn_step32<4, false>(Ks + sub * 32 * DKP, DKP, Vs + sub * 32 * DVP, DVP, qf, o, m, l, 0xffffu, 0.125f * LOG2E, lane);
        } else {
          unsigned vm = 0;
#pragma unroll
          for (int i = 0; i < 16; ++i) if (k0 + crow(i, h) <= qpos) vm |= (1u << i);
          attn_step32<4, true>(Ks + sub * 32 * DKP, DKP, Vs + sub * 32 * DVP, DVP, qf, o, m, l, vm, 0.125f * LOG2E, lane);
        }
      }
    }
  }
#undef D_LOAD
  l += __shfl_xor(l, 32);
  const float linv = 1.f / l;
  __syncthreads();
  float* xch = (float*)lds + qsub * 4096;
  if (map == 1) {
#pragma unroll
    for (int d = 0; d < 4; ++d)
#pragma unroll
      for (int i = 0; i < 16; ++i) xch[(d * 16 + i) * 64 + lane] = o[d][i] * linv;
  }
  __syncthreads();
  if (map == 0) {
    const float lam = *(const float*)(p.ws + WS_LAM);
    float ssq = 0.f;
#pragma unroll
    for (int d = 0; d < 4; ++d)
#pragma unroll
      for (int i = 0; i < 16; ++i) { const float a = o[d][i] * linv - lam * xch[(d * 16 + i) * 64 + lane]; o[d][i] = a; ssq += a * a; }
    ssq += __shfl_xor(ssq, 32);
    const float lambda_init = 0.8f - 0.6f * expf(-0.3f);
    const float rn = rsqrtf(ssq * (1.f / 128.f) + EPS) * (1.f - lambda_init);
    const size_t tok = rowb + qpos;
    const bf16* gate = PO + tok * NPO + O_DG + head * 128;
    bf16* y = Y + tok * DM + 512 + head * 128;
    const float* sg = p.in[I_SUB_GAIN];
#pragma unroll
    for (int d = 0; d < 4; ++d)
#pragma unroll
      for (int g = 0; g < 4; ++g) {
        const int dd = 32 * d + 8 * g + 4 * h;
        const u32x2 gv = *(const u32x2*)(gate + dd); const f32x4 s4 = *(const f32x4*)(sg + dd);
        const float g0 = __uint_as_float(gv.x << 16), g1 = __uint_as_float(gv.x & 0xffff0000u), g2 = __uint_as_float(gv.y << 16), g3 = __uint_as_float(gv.y & 0xffff0000u);
        u32x2 w; w.x = cvtpk(o[d][4 * g] * rn * s4.x * g0, o[d][4 * g + 1] * rn * s4.y * g1); w.y = cvtpk(o[d][4 * g + 2] * rn * s4.z * g2, o[d][4 * g + 3] * rn * s4.w * g3);
        *(u32x2*)(y + dd) = w;
      }
  }
  __syncthreads();
}

#define XB_TMO      128
#define XB_XCNT(j)  (256  + 64 * (j))
#define XB_XSUB(j)  (1280 + 64 * (j))
#define XB_XGEN(j)  (2304 + 64 * (j))
#define XB_TOP      3328
#define XB_TOPGEN   3392
#define XCD_BAR_WORDS 3456
#define XB_SPIN_CAP (1u << 18)

__device__ __forceinline__ unsigned xb_ld(unsigned* p)              { return __hip_atomic_load(p, __ATOMIC_RELAXED, __HIP_MEMORY_SCOPE_AGENT); }
__device__ __forceinline__ unsigned xb_add(unsigned* p, unsigned v) { return __hip_atomic_fetch_add(p, v, __ATOMIC_RELAXED, __HIP_MEMORY_SCOPE_AGENT); }
__device__ __forceinline__ unsigned xb_xcc_id() { return (unsigned)__builtin_amdgcn_s_getreg((3 << 11) | 20) & 0xFu; }
#define XB_SPIN(cond, bar) do { unsigned _sp = 0; while (cond) { __builtin_amdgcn_s_sleep(1); \
    if ((++_sp & 255u) == 0u) { if (xb_ld(&(bar)[XB_TMO])) break; if (_sp > XB_SPIN_CAP) { atomicAdd(&(bar)[XB_TMO], 1u); break; } } } } while (0)

struct XcdBarrier {
    unsigned* bar; unsigned x;
    volatile LAS unsigned* st;
};

__device__ __forceinline__ XcdBarrier xcd_barrier_post(unsigned* bar, volatile LAS unsigned* st) {
    XcdBarrier b; b.bar = bar; b.x = xb_xcc_id(); b.st = st;
    if (threadIdx.x == 0) (void)xb_add(&bar[XB_XCNT(b.x)], 1u);
    return b;
}
__device__ __forceinline__ void xcd_barrier_complete(unsigned* bar, unsigned x, unsigned& nloc, unsigned& nx) {
    const unsigned G = gridDim.x * gridDim.y * gridDim.z;
    unsigned sum, cnt, mine, sp = 0u;
    for (;;) {
        sum = 0u; cnt = 0u; mine = 0u;
#pragma unroll
        for (unsigned j = 0; j < 16; ++j) { const unsigned c = xb_ld(&bar[XB_XCNT(j)]); sum += c; cnt += (c > 0u) ? 1u : 0u; mine = (j == x) ? c : mine; }
        if (sum == G) break;
        __builtin_amdgcn_s_sleep(1);
        if ((++sp & 255u) == 0u) { if (xb_ld(&bar[XB_TMO])) break; if (sp > XB_SPIN_CAP) { atomicAdd(&bar[XB_TMO], 1u); break; } }
    }
    nloc = mine > 0u ? mine : 1u; nx = cnt > 0u ? cnt : 1u;
}

__device__ __forceinline__ void xcd_barrier(const XcdBarrier& b) {
    asm volatile("s_waitcnt vmcnt(0)" ::: "memory");
    __syncthreads();
    if (threadIdx.x == 0) {
        unsigned* bar = b.bar;
        __builtin_amdgcn_s_waitcnt(0);
        unsigned nloc = b.st[0], nx = b.st[1];
        if (nloc == 0u) { xcd_barrier_complete(bar, b.x, nloc, nx); b.st[0] = nloc; b.st[1] = nx; }
        const unsigned old = xb_add(&bar[XB_XSUB(b.x)], 1u);
        const unsigned gen = old / nloc;
        if (old + 1u == (gen + 1u) * nloc) {
            __builtin_amdgcn_fence(__ATOMIC_RELEASE, "agent");
            asm volatile("s_waitcnt vmcnt(0)" ::: "memory");
            const unsigned og = xb_add(&bar[XB_TOP], 1u);
            const unsigned tg = og / nx;
            if (og + 1u == (tg + 1u) * nx) xb_add(&bar[XB_TOPGEN], 1u);
            else XB_SPIN(xb_ld(&bar[XB_TOPGEN]) == tg, bar);
            __builtin_amdgcn_fence(__ATOMIC_ACQUIRE, "agent");
            xb_add(&bar[XB_XGEN(b.x)], 1u);
            asm volatile("s_waitcnt vmcnt(0)" ::: "memory");
        } else {
            XB_SPIN(xb_ld(&bar[XB_XGEN(b.x)]) == gen, bar);
            __builtin_amdgcn_fence(__ATOMIC_ACQUIRE, "agent");
            asm volatile("s_waitcnt vmcnt(0)" ::: "memory");
        }
    }
    __syncthreads();
}


__global__ void __launch_bounds__(NTHREADS) fwd_kernel(Params p) {
  extern __shared__ __attribute__((aligned(16))) char smem[];
  cg::grid_group grid = cg::this_grid();
  char* lds = smem;
  volatile LAS unsigned* xb_st = (volatile LAS unsigned*)((LAS char*)smem + (LDS_BYTES - 16));
  if (threadIdx.x < 2) xb_st[threadIdx.x] = 0u;
  __syncthreads();
  const XcdBarrier xbar = xcd_barrier_post((unsigned*)(p.ws + WS_BAR), xb_st);
#define FRESH_IDS const int tid = opaque_tid(), lane = tid & 63, wid = tid >> 6; const int gw = blockIdx.x * 8 + wid, ngw = gridDim.x * 8; bf16* Ks = (bf16*)(lds + wid * WAVE_LDS); bf16* Vs = Ks + 32 * WP; (void)gw; (void)ngw; (void)Ks; (void)Vs; (void)lane;

  phase_prologue(p, lds);
  if (p.ws == nullptr) grid.sync();
  xcd_barrier(xbar);
  for (int rep = 0; rep < REP_GEMM; ++rep) phase_inproj(p, 0, lds);
  xcd_barrier(xbar);
#if EN_A
  for (int rep = 0; rep < REP_SELA; ++rep) { FRESH_IDS
#define SEL_ITEM(k) ((k) * (int)gridDim.x + (((k) & 1) ? (int)gridDim.x - 1 - (int)blockIdx.x : (int)blockIdx.x))
    bf16x8 sqf[4]; float swq[16];
    if (SEL_ITEM(0) < 2 * 2048) sel_load_qw(p, SEL_ITEM(0), sqf, swq, lane);
    for (int k = 0; k * (int)gridDim.x < 2 * 2048; ++k) { const int it = SEL_ITEM(k); int nx = SEL_ITEM(k + 1); if (nx >= 2 * 2048) nx = -1; if (it < 2 * 2048) selectA_item(p, it, nx, lds, sqf, swq); }
#undef SEL_ITEM
  }
  __syncthreads();
  { FRESH_IDS
#define SEL_ITEM(k) ((k) * (int)gridDim.x + (((k) & 1) ? (int)gridDim.x - 1 - (int)blockIdx.x : (int)blockIdx.x))
    const int nK = (2 * 2048 + (int)gridDim.x - 1) / (int)gridDim.x;
    for (int rep = 0; rep < REP_AATT; ++rep)
      for (int s2 = wid; s2 < nK * 4; s2 += 8) { const int it = SEL_ITEM(s2 >> 2); if (it < 2 * 2048) mixerA_item(p, (it >> 11) * SEQ + (it & 2047) * 4 + (s2 & 3), Ks, Vs, lane); }
#undef SEL_ITEM
  }
#else
  { unsigned* y = (unsigned*)(p.ws + WS_Y); for (int i = blockIdx.x * NTHREADS + (int)threadIdx.x; i < NTOK * 256; i += gridDim.x * NTHREADS) { const int row = i >> 8, c = i & 255; y[row * 512 + c] = 0u; } }
#endif
#if EN_B
  { FRESH_IDS for (int it = gw; it < 4096; it += ngw) mixerB_tile(p, it, Ks, Vs, lane); }
#else
  { unsigned* y = (unsigned*)(p.ws + WS_Y); for (int i = blockIdx.x * NTHREADS + (int)threadIdx.x; i < NTOK * 256; i += gridDim.x * NTHREADS) { const int row = i >> 8, c = i & 255; y[row * 512 + 256 + c] = 0u; } }
#endif
  xcd_barrier(xbar);
  phase_outproj(p, 0, lds);
  xcd_barrier(xbar);
  phase_ple(p, 0, lds);
  xcd_barrier(xbar);
  phase_inproj(p, 1, lds);
  xcd_barrier(xbar);
#if EN_D
  for (int rep = 0; rep < REP_D; ++rep) {
#pragma unroll 1
    for (int u2 = blockIdx.x * 2; u2 < 512; u2 += gridDim.x * 2) {
#pragma unroll 1
      for (int k = 0; k < 2; ++k) { const int u = u2 >> 1, bh = u & 7, pr = u >> 3;
        mixerD_unit(p, bh >> 2, bh & 3, k ? 63 - pr : pr, lds); }
    }
  }
#else
  { unsigned* y = (unsigned*)(p.ws + WS_Y); for (int i = blockIdx.x * NTHREADS + (int)threadIdx.x; i < NTOK * 256; i += gridDim.x * NTHREADS) { const int row = i >> 8, c = i & 255; y[row * 512 + 256 + c] = 0u; } }
#endif
#if EN_C
  __syncthreads();
  { FRESH_IDS for (int rep = 0; rep < REP_C; ++rep) for (int it = gw; it < 4096; it += ngw) mixerC_tile(p, it, Ks, Vs, lane); }
#else
  { unsigned* y = (unsigned*)(p.ws + WS_Y); for (int i = blockIdx.x * NTHREADS + (int)threadIdx.x; i < NTOK * 256; i += gridDim.x * NTHREADS) { const int row = i >> 8, c = i & 255; y[row * 512 + c] = 0u; } }
#endif
  xcd_barrier(xbar);
  phase_outproj(p, 1, lds);
  xcd_barrier(xbar);
  phase_ple(p, 1, lds);
}

extern "C" void kernel_launch(void* const* d_in, const int* in_sizes, int n_in, void* d_out, int out_size, void* d_ws, size_t ws_size, hipStream_t stream) {
  static int grid_blocks = 0;
  if (!grid_blocks) {
    int dev = 0, cus = 0, per_cu = 0;
    hipGetDevice(&dev);
    hipDeviceGetAttribute(&cus, hipDeviceAttributeMultiprocessorCount, dev);
    hipFuncSetAttribute((const void*)fwd_kernel, hipFuncAttributeMaxDynamicSharedMemorySize, LDS_BYTES);
    hipOccupancyMaxActiveBlocksPerMultiprocessor(&per_cu, (const void*)fwd_kernel, NTHREADS, LDS_BYTES);
    if (per_cu < 1) per_cu = 1;
    grid_blocks = cus * per_cu;
    if (grid_blocks > 256) grid_blocks = 256;
  }
  Params p{};
  for (int i = 0; i < 25; ++i) p.in[i] = (const float*)d_in[i];
  p.out = (float*)d_out; p.ws = (unsigned char*)d_ws;
  for (int i = 0; i < 32; ++i) p.inv_freq[i] = (float)pow(10000.0, -(double)i / 32.0);
  (void)hipMemsetAsync((char*)d_ws + WS_BAR, 0, 16384, stream);
  void* args[] = {&p};
  hipError_t e = hipLaunchCooperativeKernel((const void*)fwd_kernel, dim3(grid_blocks), dim3(NTHREADS), args, LDS_BYTES, stream);
  if (e != hipSuccess) fprintf(stderr, "cooperative launch failed: %s (grid %d)\n", hipGetErrorString(e), grid_blocks);
}
```

```cpp
#include <hip/hip_runtime.h>
#include <hip/hip_cooperative_groups.h>
#include <cstdio>
#include <cmath>
namespace cg = cooperative_groups;

#ifndef REP_GEMM
#define REP_GEMM 1
#endif
#ifndef REP_SELA
#define REP_SELA 1
#endif
#ifndef REP_D
#define REP_D 1
#endif
#ifndef REP_C
#define REP_C 1
#endif
#ifndef REP_AATT
#define REP_AATT 1
#endif
#ifndef EN_A
#define EN_A 1
#endif
#ifndef EN_B
#define EN_B 1
#endif
#ifndef EN_C
#define EN_C 1
#endif
#ifndef EN_D
#define EN_D 1
#endif

typedef unsigned short bf16;
typedef short bf16x8 __attribute__((ext_vector_type(8)));
typedef short s16x4 __attribute__((ext_vector_type(4)));
typedef float f32x4 __attribute__((ext_vector_type(4)));
typedef float f32x16 __attribute__((ext_vector_type(16)));
typedef unsigned u32x4 __attribute__((ext_vector_type(4)));
typedef unsigned u32x2 __attribute__((ext_vector_type(2)));
typedef float f32x2_t __attribute__((ext_vector_type(2)));
typedef __bf16 bf16x2_t __attribute__((ext_vector_type(2)));
#define LAS __attribute__((address_space(3)))
#define DI __device__ __forceinline__

constexpr int SEQ = 8192, NTOK = 16384, DM = 1024;
constexpr int NPE = 3072, NPO = 4096;
constexpr float EPS = 1e-6f;
constexpr float LOG2E = 1.4426950408889634f;
constexpr int NTHREADS = 512;
constexpr int LDS_BYTES = 150 * 1024;

constexpr size_t MiB = 1u << 20;
constexpr size_t WS_PE = 0;
constexpr size_t WS_ACT = 128 * MiB;
constexpr size_t WS_Y = 160 * MiB;
constexpr size_t WS_WINE = 192 * MiB;
constexpr size_t WS_WOUTE = 198 * MiB;
constexpr size_t WS_WINO = 200 * MiB;
constexpr size_t WS_WOUTO = 208 * MiB;
constexpr size_t WS_WG0 = 210 * MiB;
constexpr size_t WS_WG1 = 212 * MiB;
constexpr size_t WS_WP0 = 214 * MiB;
constexpr size_t WS_WP1 = 215 * MiB;
constexpr size_t WS_ROPE = 216 * MiB;
constexpr size_t WS_SEL = 218 * MiB;
constexpr size_t WS_IW = 226 * MiB;
constexpr size_t WS_SS = 227 * MiB;
constexpr size_t WS_LAM = 228 * MiB;
constexpr size_t WS_BAR = 250 * MiB;
constexpr size_t WS_PBF = 232 * MiB;
constexpr size_t WS_IKS = 229 * MiB;

struct Params {
  const float* in[25];
  float* out;
  unsigned char* ws;
  float inv_freq[32];
};
enum { I_X = 0, I_P, I_NORM_GAIN, I_W_IN_EVEN, I_W_OUT_EVEN, I_A_Q_GAIN, I_A_K_GAIN, I_IDX_K_GAIN, I_B_Q_GAIN, I_B_K_GAIN, I_B_SINKS,
       I_W_IN_ODD, I_W_OUT_ODD, I_C_Q_GAIN, I_C_K_GAIN, I_D_Q_GAIN, I_D_K_GAIN, I_LQ1, I_LK1, I_LQ2, I_LK2, I_SUB_GAIN, I_PLE_NORM_GAIN,
       I_W_PLE_GATE, I_W_PLE_PROJ };

DI unsigned cvtpk(float lo, float hi) { f32x2_t v = {lo, hi}; bf16x2_t b = __builtin_convertvector(v, bf16x2_t); return __builtin_bit_cast(unsigned, b); }
DI float bf2f(bf16 b) { return __uint_as_float(((unsigned)b) << 16); }
DI float fexp2(float x) { return __builtin_amdgcn_exp2f(x); }
DI f32x16 mfma32(bf16x8 a, bf16x8 b, f32x16 c) { return __builtin_amdgcn_mfma_f32_32x32x16_bf16(a, b, c, 0, 0, 0); }
DI f32x4 mfma16(bf16x8 a, bf16x8 b, f32x4 c) { return __builtin_amdgcn_mfma_f32_16x16x32_bf16(a, b, c, 0, 0, 0); }
DI int crow(int i, int h) { return (i & 3) + 8 * (i >> 2) + 4 * h; }
DI s16x4 trread(const bf16* p) { return __builtin_bit_cast(s16x4, __builtin_amdgcn_ds_read_tr16_b64_v4i16((LAS s16x4*)p)); }
DI int opaque_tid() { int t = threadIdx.x; asm volatile("" : "+v"(t)); return t; }
DI void lds_barrier() { asm volatile("s_waitcnt lgkmcnt(0)" ::: "memory"); __builtin_amdgcn_s_barrier(); asm volatile("" ::: "memory"); }
DI void lds_fence() { asm volatile("s_waitcnt lgkmcnt(0)" ::: "memory"); __builtin_amdgcn_wave_barrier(); }

__host__ __device__ __forceinline__ int phys_col(int n) { return (n & ~255) + 128 * ((n >> 5) & 1) + 32 * ((n >> 6) & 3) + (n & 31); }
DI int map_even(int n) { return n < 1216 ? n : (n < 1224 ? 3008 + (n - 1216) : n - 8); }
DI void transpose_tile(const float* W, int K, int N, bf16* WT, int mapmode, int tile, float* scr) {
  const int tid = opaque_tid();
  const int ntn = (N + 63) >> 6, kt = tile / ntn, nt = tile % ntn, k0 = kt * 64, n0 = nt * 64;
#pragma unroll
  for (int i = 0; i < 8; ++i) {
    const int kk = (tid >> 6) + 8 * i, nn = tid & 63, n = n0 + nn;
    scr[kk * 65 + nn] = (n < N) ? W[(size_t)(k0 + kk) * N + n] : 0.f;
  }
  __syncthreads();
  {
    const int nn = tid >> 3, kc = tid & 7, n = n0 + nn;
    if (n < N) {
      const int dst = mapmode == 1 ? phys_col(map_even(n)) : (mapmode == 2 ? phys_col(n) : n);
      const float* s = scr + (kc * 8) * 65 + nn;
      u32x4 o; o.x = cvtpk(s[0], s[65]); o.y = cvtpk(s[2 * 65], s[3 * 65]); o.z = cvtpk(s[4 * 65], s[5 * 65]); o.w = cvtpk(s[6 * 65], s[7 * 65]);
      *(u32x4*)(WT + (size_t)dst * K + k0 + kc * 8) = o;
    }
  }
  __syncthreads();
}

DI float wave_sum(float v) {
#pragma unroll
  for (int o = 1; o < 64; o <<= 1) v += __shfl_xor(v, o);
  return v;
}

DI void phase_prologue(const Params& p, char* lds) {
  const int tid = opaque_tid(), lane = tid & 63, wid = tid >> 6;
  const int nb = gridDim.x, bid = blockIdx.x;
  unsigned char* ws = p.ws;
  float* scr = (float*)lds;
  const int T0 = 16 * 48, T1 = 256, T2 = 16 * 64, T3 = 256, T4 = 256, T5 = 256, T6 = 64, T7 = 64;
  const int NT = T0 + T1 + T2 + T3 + T4 + T5 + T6 + T7;
  for (int it = bid; it < NT; it += nb) {
    int r = it;
    if (r < T0) { transpose_tile(p.in[I_W_IN_EVEN], 1024, 3016, (bf16*)(ws + WS_WINE), 1, r, scr); continue; } r -= T0;
    if (r < T1) { transpose_tile(p.in[I_W_OUT_EVEN], 1024, 1024, (bf16*)(ws + WS_WOUTE), 0, r, scr); continue; } r -= T1;
    if (r < T2) { transpose_tile(p.in[I_W_IN_ODD], 1024, 4096, (bf16*)(ws + WS_WINO), 2, r, scr); continue; } r -= T2;
    if (r < T3) { transpose_tile(p.in[I_W_OUT_ODD], 1024, 1024, (bf16*)(ws + WS_WOUTO), 0, r, scr); continue; } r -= T3;
    if (r < T4) { transpose_tile(p.in[I_W_PLE_GATE], 1024, 1024, (bf16*)(ws + WS_WG0), 0, r, scr); continue; } r -= T4;
    if (r < T5) { transpose_tile(p.in[I_W_PLE_GATE] + 1024 * 1024, 1024, 1024, (bf16*)(ws + WS_WG1), 0, r, scr); continue; } r -= T5;
    if (r < T6) { transpose_tile(p.in[I_W_PLE_PROJ], 256, 1024, (bf16*)(ws + WS_WP0), 0, r, scr); continue; } r -= T6;
    transpose_tile(p.in[I_W_PLE_PROJ] + 256 * 1024, 256, 1024, (bf16*)(ws + WS_WP1), 0, r, scr);
  }
  const int gt = bid * NTHREADS + tid, ngt = nb * NTHREADS;
  { unsigned* z = (unsigned*)(ws + WS_WINE); for (int i = gt; i < 56 * 512; i += ngt) z[(size_t)phys_col(3016 + (i >> 9)) * 512 + (i & 511)] = 0u; }
  { float* ss = (float*)(ws + WS_SS); for (int i = gt; i < 3 * NTOK; i += ngt) ss[i] = 0.f; }
  { float2* tab = (float2*)(ws + WS_ROPE);
    for (int i = gt; i < SEQ * 32; i += ngt) {
      const int pos = i >> 5, k = i & 31;
      const float ang = (float)pos * p.inv_freq[k];
      double rev = (double)ang * 0.15915494309189535; rev -= floor(rev);
      const float rf = (float)rev;
      tab[i] = make_float2(__builtin_amdgcn_cosf(rf), __builtin_amdgcn_sinf(rf));
    } }
  if (bid == 0 && wid == 0) {
    const float a = wave_sum(p.in[I_LQ1][lane] * p.in[I_LK1][lane]);
    const float b = wave_sum(p.in[I_LQ2][lane] * p.in[I_LK2][lane]);
    const float lambda_init = 0.8f - 0.6f * expf(-0.3f);
    if (lane == 0) *(float*)(ws + WS_LAM) = expf(a) - expf(b) + lambda_init;
  }
  { const float* x = p.in[I_X]; const float* g = p.in[I_NORM_GAIN]; bf16* H = (bf16*)(ws + WS_ACT);
    const int gw = bid * 8 + wid, ngw = nb * 8;
    for (int m = gw; m < NTOK; m += ngw) {
      const f32x4* xr = (const f32x4*)(x + (size_t)m * DM) + lane;
      f32x4 v[4]; float s = 0.f;
#pragma unroll
      for (int j = 0; j < 4; ++j) { v[j] = xr[64 * j]; s += v[j].x * v[j].x + v[j].y * v[j].y + v[j].z * v[j].z + v[j].w * v[j].w; }
      const float rstd = rsqrtf(wave_sum(s) * (1.f / DM) + EPS);
      u32x2* o = (u32x2*)(H + (size_t)m * DM) + lane;
#pragma unroll
      for (int j = 0; j < 4; ++j) { const f32x4 gg = *((const f32x4*)g + lane + 64 * j); u32x2 w; w.x = cvtpk(v[j].x * rstd * gg.x, v[j].y * rstd * gg.y); w.y = cvtpk(v[j].z * rstd * gg.z, v[j].w * rstd * gg.w); o[64 * j] = w; }
    } }
}

namespace pg8 {
#define PG8_LAS __attribute__((address_space(3)))
typedef unsigned short bf16_t;
typedef short bf16x8 __attribute__((ext_vector_type(8)));
typedef float f32x4 __attribute__((ext_vector_type(4)));
typedef unsigned u32x4 __attribute__((ext_vector_type(4)));
constexpr int BM = 256, BK = 64, HALF = 128, HTB = HALF * BK * 2  , STAGE_BYTES = 8 * HTB, NXCD = 8, WGM = 8;

__host__ __device__ __forceinline__ int lds_byte(int r, int c) { const int st = (r >> 4) * 2 + (c >> 5), rr = r & 15, cc = c & 31, ob = rr * 64 + cc * 2; return st * 1024 + (ob ^ (((ob >> 9) & 1) << 5)); }
__host__ __device__ __forceinline__ void stage_rc(int b, int& R, int& C) { const int st = b / 1024, sb = b % 1024, swz = sb ^ (((sb >> 9) & 1) << 5); R = (st >> 1) * 16 + swz / 64; C = (st & 1) * 32 + (swz % 64) / 2; }
__host__ __device__ __forceinline__ int perm32(int rho) { const int n = rho >> 4, i = rho & 15; return 8 * (i >> 2) + 4 * n + (i & 3); }

struct Unit { int pm, pn; };
struct Gemm { const bf16_t* A; const bf16_t* Bt; int M, N, K; };

struct StaticOrder {
    int nM, nN, nwg, G, c;
    __host__ __device__ void init(int M, int N, int G_, int c_) { nM = M / BM; nN = N / BM; nwg = nM * nN; G = G_; c = c_; }
    __host__ __device__ bool next(int i, Unit& u) const {
        const long L = (long)i * G + c; if (L >= nwg) return false;
        int wgid = (int)L; { const int q = nwg / NXCD, r = nwg % NXCD, xcd = wgid % NXCD, off = wgid / NXCD; wgid = (xcd < r ? xcd * (q + 1) : r * (q + 1) + (xcd - r) * q) + off; }
        const int nig = WGM * nN, gid = wgid / nig, fm = gid * WGM, gsz = (nM - fm) < WGM ? (nM - fm) : WGM;
        u.pm = fm + ((wgid % nig) % gsz); u.pn = (wgid % nig) / gsz; return true;
    }
    __device__ __forceinline__ void a_ready(const Unit&) const {}
    __device__ __forceinline__ void done(const Unit&) const {}
};
__device__ __forceinline__ unsigned cvt_pk_bf16(float lo, float hi) { unsigned r; asm volatile("v_cvt_pk_bf16_f32 %0, %1, %2" : "=v"(r) : "v"(lo), "v"(hi)); return r; }
template <class Epi, class Sched, bool ALIGN_EPI = false, bool SP2 = false>
__device__ __forceinline__ void gemm_phase(PG8_LAS unsigned char* lds, const Gemm g, const Sched& S, const Epi& E) {
    int tid_ = threadIdx.x; asm volatile("" : "+v"(tid_));
    const int tid = tid_, wid = __builtin_amdgcn_readfirstlane(tid >> 6), lane = tid & 63, wr = wid >> 2, wc = wid & 3, fr = lane & 15, fq = lane >> 4;
    const int K = g.K, nt = K / BK;
    unsigned voffA[2], voffB[2];
#pragma unroll
    for (int i = 0; i < 2; ++i) { int R, C; stage_rc(tid * 16 + i * 8192, R, C); const int Rb = Epi::PERM ? ((R & ~31) + perm32(R & 31)) : R;
        voffA[i] = (unsigned)(R * K + C) * 2u; voffB[i] = (unsigned)(Rb * K + C) * 2u; }
    const size_t kstep = (size_t)(BK * 2);
    const size_t hstep = (size_t)HALF * K * 2;
    const size_t tstep = 2 * hstep;
    const unsigned ldsw = (unsigned)wid * 1024u;
    const int aoff = lds_byte(wr * 64 + fr, fq * 8), boff = lds_byte(wc * 32 + fr, fq * 8);
#define PG8_SA(b, h) (((b) * 2 + (h)) * HTB)
#define PG8_SB(b, h) ((4 + (b) * 2 + (h)) * HTB)
#define PG8_STAGE(bufoff, gbase, voff) do { _Pragma("unroll") for (int _i = 0; _i < 2; ++_i) \
        __builtin_amdgcn_global_load_lds((const unsigned*)((const char*)(gbase) + (voff)[_i]), (PG8_LAS unsigned*)(lds + (bufoff) + ldsw + _i * 8192), 16, 0, 0); } while (0)
#define PG8_LDA(dst, b, h) do { _Pragma("unroll") for (int m = 0; m < 4; ++m) _Pragma("unroll") for (int k = 0; k < 2; ++k) dst[m][k] = *(const PG8_LAS bf16x8*)(lds + PG8_SA(b, h) + aoff + m * 2048 + k * 1024); } while (0)
#define PG8_LDB(dst, b, h) do { _Pragma("unroll") for (int n = 0; n < 2; ++n) _Pragma("unroll") for (int k = 0; k < 2; ++k) dst[n][k] = *(const PG8_LAS bf16x8*)(lds + PG8_SB(b, h) + boff + n * 2048 + k * 1024); } while (0)
#define PG8_MMA(ai, bj, At, Bt) do { __builtin_amdgcn_s_setprio(1); _Pragma("unroll") for (int m = 0; m < 4; ++m) _Pragma("unroll") for (int n = 0; n < 2; ++n) _Pragma("unroll") for (int k = 0; k < 2; ++k) \
        acc[ai][bj][m][n] = __builtin_amdgcn_mfma_f32_16x16x32_bf16(Bt[n][k], At[m][k], acc[ai][bj][m][n], 0, 0, 0); __builtin_amdgcn_s_setprio(0); } while (0)
#define PG8_WAIT_V(n) asm volatile("s_waitcnt vmcnt(" #n ")" ::: "memory")
#define PG8_WAIT_L(n) asm volatile("s_waitcnt lgkmcnt(" #n ")" ::: "memory")
#define PG8_BAR __builtin_amdgcn_s_barrier()
#define PG8_SCHED __builtin_amdgcn_sched_barrier(0)
    Unit cur, nxt; int ui = 0;
    if (!S.next(0, cur)) return;
    f32x4 acc[2][2][4][2];
#pragma unroll
    for (int a = 0; a < 2; ++a)
#pragma unroll
        for (int b = 0; b < 2; ++b)
#pragma unroll
            for (int m = 0; m < 4; ++m)
#pragma unroll
                for (int n = 0; n < 2; ++n) acc[a][b][m][n] = (f32x4){0.f, 0.f, 0.f, 0.f};
    bf16x8 At[4][2], B0[2][2], B1[2][2];
    const char* cA = (const char*)g.A + (size_t)cur.pm * tstep; const char* cB = (const char*)g.Bt + (size_t)cur.pn * tstep;
    S.a_ready(cur);
    if constexpr (SP2) {
        PG8_STAGE(PG8_SB(0, 0), cB, voffB); PG8_STAGE(PG8_SB(0, 1), cB + hstep, voffB); PG8_STAGE(PG8_SA(0, 0), cA, voffA); PG8_STAGE(PG8_SA(0, 1), cA + hstep, voffA);
        if (wr == 1) PG8_BAR;
        PG8_WAIT_V(2); PG8_BAR;
        PG8_STAGE(PG8_SB(1, 0), cB + kstep, voffB); PG8_STAGE(PG8_SA(1, 0), cA + kstep, voffA); PG8_STAGE(PG8_SB(1, 1), cB + hstep + kstep, voffB);
        PG8_WAIT_V(6); PG8_BAR;
    } else {
        PG8_STAGE(PG8_SB(0, 0), cB, voffB); PG8_STAGE(PG8_SA(0, 0), cA, voffA); PG8_STAGE(PG8_SB(0, 1), cB + hstep, voffB); PG8_STAGE(PG8_SA(0, 1), cA + hstep, voffA);
        if (wr == 1) PG8_BAR;
        PG8_WAIT_V(4); PG8_BAR;
        PG8_STAGE(PG8_SB(1, 0), cB + kstep, voffB); PG8_STAGE(PG8_SA(1, 0), cA + kstep, voffA); PG8_STAGE(PG8_SB(1, 1), cB + hstep + kstep, voffB);
        PG8_WAIT_V(6); PG8_BAR;
    }
    for (;;) {
        const bool has_next = S.next(ui + 1, nxt);
        const char* nA = has_next ? (const char*)g.A + (size_t)nxt.pm * tstep : cA; const char* nB = has_next ? (const char*)g.Bt + (size_t)nxt.pn * tstep : cB;
        for (int t = 0; t < nt; t += 2) {
            const bool last = (t == nt - 2);
            const char* a1 = cA + (size_t)(t + 1) * kstep;
            const char* a2 = last ? nA : cA + (size_t)(t + 2) * kstep; const char* b2 = last ? nB : cB + (size_t)(t + 2) * kstep;
            const char* a3 = a2 + kstep; const char* b3 = b2 + kstep;
            if (last && has_next) S.a_ready(nxt);
            if constexpr (SP2) {
            PG8_LDB(B0, 0, 0); PG8_LDB(B1, 0, 1); PG8_SCHED; PG8_LDA(At, 0, 0); PG8_STAGE(PG8_SA(1, 1), a1 + hstep, voffA);
            PG8_WAIT_V(8); PG8_WAIT_L(0); PG8_BAR; PG8_MMA(0, 0, At, B0); PG8_MMA(0, 1, At, B1); PG8_BAR; PG8_SCHED;
            PG8_LDA(At, 0, 1); PG8_STAGE(PG8_SB(0, 0), b2, voffB); PG8_STAGE(PG8_SB(0, 1), b2 + hstep, voffB); PG8_STAGE(PG8_SA(0, 0), a2, voffA);
            PG8_WAIT_V(8); PG8_WAIT_L(0); PG8_BAR; PG8_MMA(1, 0, At, B0); PG8_MMA(1, 1, At, B1); PG8_BAR; PG8_SCHED;
            PG8_LDB(B0, 1, 0); PG8_LDB(B1, 1, 1); PG8_SCHED; PG8_LDA(At, 1, 0); PG8_STAGE(PG8_SA(0, 1), a2 + hstep, voffA);
            PG8_WAIT_V(8); PG8_WAIT_L(0); PG8_BAR; PG8_MMA(0, 0, At, B0); PG8_MMA(0, 1, At, B1); PG8_BAR; PG8_SCHED;
            PG8_LDA(At, 1, 1); PG8_STAGE(PG8_SB(1, 0), b3, voffB); PG8_STAGE(PG8_SB(1, 1), b3 + hstep, voffB); PG8_STAGE(PG8_SA(1, 0), a3, voffA);
            PG8_WAIT_V(8); PG8_WAIT_L(0); PG8_BAR; PG8_MMA(1, 0, At, B0); PG8_MMA(1, 1, At, B1); PG8_BAR; PG8_SCHED;
            } else {
            PG8_LDB(B0, 0, 0); PG8_SCHED; PG8_LDA(At, 0, 0); PG8_STAGE(PG8_SA(1, 1), a1 + hstep, voffA);
            PG8_WAIT_L(8); PG8_BAR; PG8_WAIT_L(0); PG8_MMA(0, 0, At, B0); PG8_BAR; PG8_SCHED;
            PG8_LDB(B1, 0, 1); PG8_STAGE(PG8_SB(0, 0), b2, voffB);
            PG8_BAR; PG8_WAIT_L(0); PG8_MMA(0, 1, At, B1); PG8_BAR;
            PG8_LDA(At, 0, 1); PG8_STAGE(PG8_SA(0, 0), a2, voffA);
            PG8_BAR; PG8_WAIT_L(0); PG8_MMA(1, 0, At, B0); PG8_BAR; PG8_SCHED;
            PG8_STAGE(PG8_SB(0, 1), b2 + hstep, voffB);
            PG8_WAIT_V(6); PG8_BAR; PG8_MMA(1, 1, At, B1); PG8_BAR;
            PG8_LDB(B0, 1, 0); PG8_SCHED; PG8_LDA(At, 1, 0); PG8_STAGE(PG8_SA(0, 1), a2 + hstep, voffA);
            PG8_WAIT_L(8); PG8_BAR; PG8_WAIT_L(0); PG8_MMA(0, 0, At, B0); PG8_BAR; PG8_SCHED;
            PG8_LDB(B1, 1, 1); PG8_STAGE(PG8_SB(1, 0), b3, voffB);
            PG8_BAR; PG8_WAIT_L(0); PG8_MMA(0, 1, At, B1); PG8_BAR;
            PG8_LDA(At, 1, 1); PG8_STAGE(PG8_SA(1, 0), a3, voffA);
            PG8_BAR; PG8_WAIT_L(0); PG8_MMA(1, 0, At, B0); PG8_BAR; PG8_SCHED;
            PG8_STAGE(PG8_SB(1, 1), b3 + hstep, voffB);
            PG8_WAIT_V(6); PG8_BAR; PG8_MMA(1, 1, At, B1); PG8_BAR;
            }
        }
        if constexpr (ALIGN_EPI) { if (wr == 0) PG8_BAR; }
        if constexpr (!Epi::AFTER_DRAIN) { E(acc, cur, wr, wc, fr, fq); S.done(cur); }
        if (!has_next) break;
#pragma unroll
        for (int a = 0; a < 2; ++a)
#pragma unroll
            for (int b = 0; b < 2; ++b)
#pragma unroll
                for (int m = 0; m < 4; ++m)
#pragma unroll
                    for (int n = 0; n < 2; ++n) acc[a][b][m][n] = (f32x4){0.f, 0.f, 0.f, 0.f};
        cur = nxt; cA = nA; cB = nB; ++ui;
        if constexpr (ALIGN_EPI) { if (wr == 1) PG8_BAR; }
    }
    PG8_WAIT_V(0);
    if constexpr (!ALIGN_EPI) { if (wr == 0) PG8_BAR; }
    PG8_BAR;
    if constexpr (Epi::AFTER_DRAIN) { E.fused(acc, cur, wr, wc, fr, fq, lds, wid, lane); S.done(cur); }
#undef PG8_SA
#undef PG8_SB
#undef PG8_STAGE
#undef PG8_LDA
#undef PG8_LDB
#undef PG8_MMA
#undef PG8_WAIT_V
#undef PG8_WAIT_L
#undef PG8_BAR
#undef PG8_SCHED
}
}

enum { T_PLAIN = 0, T_NR = 1, T_ROPE = 2, T_SILU = 3, T_IW = 4 };
DI void slot_info(const Params& p, int layer, int slot, int& type, const float*& gain) {
  gain = nullptr;
  if (layer == 0) {
    if (slot < 8) { type = T_NR; gain = p.in[I_A_Q_GAIN]; }
    else if (slot == 8) { type = T_NR; gain = p.in[I_A_K_GAIN]; }
    else if (slot == 9) type = T_PLAIN;
    else if (slot < 18) type = T_ROPE;
    else if (slot == 18) { type = T_NR; gain = p.in[I_IDX_K_GAIN]; }
    else if (slot < 27) type = T_SILU;
    else if (slot < 35) { type = T_NR; gain = p.in[I_B_Q_GAIN]; }
    else if (slot < 37) { type = T_NR; gain = p.in[I_B_K_GAIN]; }
    else if (slot < 39) type = T_PLAIN;
    else if (slot < 47) type = T_SILU;
    else type = T_IW;
  } else {
    if (slot < 8) { type = T_NR; gain = p.in[I_C_Q_GAIN]; }
    else if (slot < 16) { type = T_NR; gain = p.in[I_C_K_GAIN]; }
    else if (slot < 24) type = T_PLAIN;
    else if (slot < 32) type = T_SILU;
    else if (slot < 40) { type = T_NR; gain = p.in[I_D_Q_GAIN]; }
    else if (slot < 48) { type = T_NR; gain = p.in[I_D_K_GAIN]; }
    else if (slot < 56) type = T_PLAIN;
    else type = T_SILU;
  }
}
constexpr int E_AQ = 0, E_AK = 512, E_AV = 576, E_IQ = 640, E_IK = 1152, E_AG = 1216, E_BQ = 1728, E_BK = 2240, E_BV = 2368, E_BG = 2496;
constexpr int O_CQ = 0, O_CK = 512, O_CV = 1024, O_CG = 1536, O_DQ = 2048, O_DK = 2560, O_DV = 3072, O_DG = 3584;

typedef pg8::f32x4 (AccT)[2][2][4][2];

struct EpiInProj {
  static constexpr bool PERM = false, AFTER_DRAIN = false;
  const Params& p; int layer;
  DI void operator()(const f32x4 (&acc)[2][2][4][2], const pg8::Unit& u, int wr, int wc, int fr, int fq) const {
    unsigned char* ws = p.ws;
    const int NP = layer == 0 ? NPE : NPO;
    bf16* PE = (bf16*)(ws + WS_PE);
    const float2* rope = (const float2*)(ws + WS_ROPE);
    const float* ss1 = (const float*)(ws + WS_SS);
    float* IW = (float*)(ws + WS_IW);
    const int slot = u.pn * 4 + wc;
    int type; const float* gain; slot_info(p, layer, slot, type, gain);
#pragma unroll
    for (int ai = 0; ai < 2; ++ai)
#pragma unroll
      for (int m = 0; m < 4; ++m) {
        const int row = u.pm * 256 + ai * 128 + wr * 64 + m * 16 + fr, pos = row & (SEQ - 1);
        float sc = 1.f;
        if (layer == 1) sc = rsqrtf(ss1[row] * (1.f / DM) + EPS);
        f32x4 v1[2], v2[2];
#pragma unroll
        for (int n = 0; n < 2; ++n) { v1[n] = acc[ai][0][m][n] * sc; v2[n] = acc[ai][1][m][n] * sc; }
        if (type == T_NR) {
          float s = 0.f;
#pragma unroll
          for (int n = 0; n < 2; ++n) s += v1[n].x * v1[n].x + v1[n].y * v1[n].y + v1[n].z * v1[n].z + v1[n].w * v1[n].w + v2[n].x * v2[n].x + v2[n].y * v2[n].y + v2[n].z * v2[n].z + v2[n].w * v2[n].w;
          s += __shfl_xor(s, 16); s += __shfl_xor(s, 32);
          const float rn = rsqrtf(s * (1.f / 64.f) + EPS);
#pragma unroll
          for (int n = 0; n < 2; ++n) { const f32x4 g1 = *(const f32x4*)(gain + n * 16 + fq * 4), g2 = *(const f32x4*)(gain + 32 + n * 16 + fq * 4); v1[n] = v1[n] * rn * g1; v2[n] = v2[n] * rn * g2; }
        }
        if (type == T_NR || type == T_ROPE) {
#pragma unroll
          for (int n = 0; n < 2; ++n) {
            const f32x4* cs = (const f32x4*)(rope + (size_t)pos * 32 + n * 16 + fq * 4);
            const f32x4 c01 = cs[0], c23 = cs[1];
            const f32x4 x1 = v1[n], x2 = v2[n];
            f32x4 o1, o2;
            o1.x = x1.x * c01.x - x2.x * c01.y; o2.x = x2.x * c01.x + x1.x * c01.y;
            o1.y = x1.y * c01.z - x2.y * c01.w; o2.y = x2.y * c01.z + x1.y * c01.w;
            o1.z = x1.z * c23.x - x2.z * c23.y; o2.z = x2.z * c23.x + x1.z * c23.y;
            o1.w = x1.w * c23.z - x2.w * c23.w; o2.w = x2.w * c23.z + x1.w * c23.w;
            v1[n] = o1; v2[n] = o2;
          }
        }
        if (type == T_SILU) {
#pragma unroll
          for (int n = 0; n < 2; ++n)
#pragma unroll
            for (int j = 0; j < 4; ++j) { const float a = v1[n][j]; v1[n][j] = a / (1.f + __expf(-a)); const float b = v2[n][j]; v2[n][j] = b / (1.f + __expf(-b)); }
        }
        if (type == T_IW) {
          if (fq < 2) *(f32x4*)(IW + (size_t)row * 8 + fq * 4) = v1[0];
        } else {
          bf16* dst = PE + (size_t)row * NP + slot * 64 + fq * 4;
#pragma unroll
          for (int n = 0; n < 2; ++n) {
            u32x2 w1, w2; w1.x = cvtpk(v1[n].x, v1[n].y); w1.y = cvtpk(v1[n].z, v1[n].w); w2.x = cvtpk(v2[n].x, v2[n].y); w2.y = cvtpk(v2[n].z, v2[n].w);
            *(u32x2*)(dst + n * 16) = w1; *(u32x2*)(dst + 32 + n * 16) = w2;
            if (layer == 0 && slot == 18) { bf16* IKS = (bf16*)(ws + WS_IKS); const int key = row & (SEQ - 1);
              bf16* base = IKS + (((size_t)(row >> 13) * 256 + (key >> 5)) * 4) * 512 + ((fq >> 1) * 32 + (key & 31)) * 8 + (fq & 1) * 4;
              *(u32x2*)(base + (size_t)n * 512) = w1; *(u32x2*)(base + (size_t)(n + 2) * 512) = w2; }
          }
        }
        asm volatile("" ::: "memory");
      }
  }
};

DI void phase_inproj(const Params& p, int layer, char* lds) {
  unsigned char* ws = p.ws;
  const int NP = layer == 0 ? NPE : NPO;
  pg8::Gemm g{(const bf16*)(ws + (layer == 0 ? WS_ACT : WS_Y)), (const bf16*)(ws + (layer == 0 ? WS_WINE : WS_WINO)), NTOK, NP, DM};
  pg8::StaticOrder S; S.init(NTOK, NP, (int)gridDim.x, (int)blockIdx.x);
  EpiInProj E{p, layer};
  pg8::gemm_phase<EpiInProj, pg8::StaticOrder, true, true>((PG8_LAS unsigned char*)lds, g, S, E);
}

struct EpiOutProj {
  static constexpr bool PERM = false, AFTER_DRAIN = false;
  const float* xin; bf16* X1B; bf16* XG; const float* pg; float* ss;
  DI void operator()(const f32x4 (&acc)[2][2][4][2], const pg8::Unit& u, int wr, int wc, int fr, int fq) const {
#pragma unroll
    for (int ai = 0; ai < 2; ++ai)
#pragma unroll
      for (int m = 0; m < 4; ++m) {
        const int row = u.pm * 256 + ai * 128 + wr * 64 + m * 16 + fr; float rs = 0.f;
#pragma unroll
        for (int bj = 0; bj < 2; ++bj)
#pragma unroll
          for (int n = 0; n < 2; ++n) {
            const int col = u.pn * 256 + bj * 128 + wc * 32 + n * 16 + fq * 4; const size_t off = (size_t)row * DM + col;
            const f32x4 xn = *(const f32x4*)(xin + off) + acc[ai][bj][m][n];
            { u32x2 wx; wx.x = cvtpk(xn.x, xn.y); wx.y = cvtpk(xn.z, xn.w); *(u32x2*)(X1B + off) = wx; }
            rs += xn.x * xn.x + xn.y * xn.y + xn.z * xn.z + xn.w * xn.w;
            const f32x4 gg = *(const f32x4*)(pg + col);
            u32x2 w; w.x = cvtpk(xn.x * gg.x, xn.y * gg.y); w.y = cvtpk(xn.z * gg.z, xn.w * gg.w); *(u32x2*)(XG + off) = w;
          }
        rs += __shfl_xor(rs, 16); rs += __shfl_xor(rs, 32);
        if (fq == 0) atomicAdd(ss + row, rs);
        asm volatile("" ::: "memory");
      }
  }
};
DI void phase_outproj(const Params& p, int layer, char* lds) {
  unsigned char* ws = p.ws;
  pg8::Gemm g{(const bf16*)(ws + WS_Y), (const bf16*)(ws + (layer == 0 ? WS_WOUTE : WS_WOUTO)), NTOK, DM, DM};
  pg8::StaticOrder S; S.init(NTOK, DM, (int)gridDim.x, (int)blockIdx.x);
  EpiOutProj E{layer == 0 ? p.in[I_X] : p.out, (bf16*)(ws + WS_PE + 64 * MiB), (bf16*)(ws + WS_ACT), p.in[I_PLE_NORM_GAIN] + layer * DM, (float*)(ws + WS_SS) + (layer == 0 ? 1 : 2) * NTOK};
  pg8::gemm_phase<EpiOutProj, pg8::StaticOrder, true, true>((PG8_LAS unsigned char*)lds, g, S, E);
}

struct EpiPleProj {
  static constexpr bool PERM = false, AFTER_DRAIN = false;
  bf16* PT;
  DI void operator()(const f32x4 (&acc)[2][2][4][2], const pg8::Unit& u, int wr, int wc, int fr, int fq) const {
#pragma unroll
    for (int ai = 0; ai < 2; ++ai)
#pragma unroll
      for (int m = 0; m < 4; ++m) {
        const int row = u.pm * 256 + ai * 128 + wr * 64 + m * 16 + fr;
#pragma unroll
        for (int bj = 0; bj < 2; ++bj)
#pragma unroll
          for (int n = 0; n < 2; ++n) { const f32x4 a = acc[ai][bj][m][n]; u32x2 w; w.x = cvtpk(a.x, a.y); w.y = cvtpk(a.z, a.w); *(u32x2*)(PT + (size_t)row * DM + u.pn * 256 + bj * 128 + wc * 32 + n * 16 + fq * 4) = w; }
      }
  }
};
struct EpiPleGate {
  static constexpr bool PERM = false, AFTER_DRAIN = false;
  const bf16* PT; const bf16* X1B; float* out; const float* ssx; float* ss1; bf16* H; const float* ng1; int layer;
  DI void operator()(const f32x4 (&acc)[2][2][4][2], const pg8::Unit& u, int wr, int wc, int fr, int fq) const {
#pragma unroll
    for (int ai = 0; ai < 2; ++ai)
#pragma unroll
      for (int m = 0; m < 4; ++m) {
        const int row = u.pm * 256 + ai * 128 + wr * 64 + m * 16 + fr; float rs = 0.f;
        const float rstd = rsqrtf(ssx[row] * (1.f / DM) + EPS);
#pragma unroll
        for (int bj = 0; bj < 2; ++bj)
#pragma unroll
          for (int n = 0; n < 2; ++n) {
            const int col = u.pn * 256 + bj * 128 + wc * 32 + n * 16 + fq * 4; const size_t off = (size_t)row * DM + col;
            f32x4 g;
#pragma unroll
            for (int j = 0; j < 4; ++j) g[j] = 1.f / (1.f + __expf(-rstd * acc[ai][bj][m][n][j]));
            const u32x2 pw = *(const u32x2*)(PT + off); f32x4 pp; pp.x = __uint_as_float(pw.x << 16); pp.y = __uint_as_float(pw.x & 0xffff0000u); pp.z = __uint_as_float(pw.y << 16); pp.w = __uint_as_float(pw.y & 0xffff0000u);
            const u32x2 xw = *(const u32x2*)(X1B + off); f32x4 x1; x1.x = __uint_as_float(xw.x << 16); x1.y = __uint_as_float(xw.x & 0xffff0000u); x1.z = __uint_as_float(xw.y << 16); x1.w = __uint_as_float(xw.y & 0xffff0000u);
            const f32x4 xn = x1 + pp * g;
            *(f32x4*)(out + off) = xn;
            if (layer == 0) {
              rs += xn.x * xn.x + xn.y * xn.y + xn.z * xn.z + xn.w * xn.w;
              const f32x4 gg = *(const f32x4*)(ng1 + col);
              u32x2 w; w.x = cvtpk(xn.x * gg.x, xn.y * gg.y); w.y = cvtpk(xn.z * gg.z, xn.w * gg.w); *(u32x2*)(H + off) = w;
            }
          }
        if (layer == 0) { rs += __shfl_xor(rs, 16); rs += __shfl_xor(rs, 32); if (fq == 0) atomicAdd(ss1 + row, rs); }
        asm volatile("" ::: "memory");
      }
  }
};
DI void phase_ple(const Params& p, int layer, char* lds) {
  unsigned char* ws = p.ws;
  bf16* PT = (bf16*)(ws + WS_PE);
  pg8::StaticOrder S; S.init(NTOK, DM, (int)gridDim.x, (int)blockIdx.x);
  { pg8::Gemm g{(const bf16*)(ws + WS_PBF) + (size_t)layer * NTOK * 256, (const bf16*)(ws + (layer == 0 ? WS_WP0 : WS_WP1)), NTOK, DM, 256};
    EpiPleProj E{PT};
    pg8::gemm_phase<EpiPleProj, pg8::StaticOrder, true, true>((PG8_LAS unsigned char*)lds, g, S, E); }
  { pg8::Gemm g{(const bf16*)(ws + WS_ACT), (const bf16*)(ws + (layer == 0 ? WS_WG0 : WS_WG1)), NTOK, DM, DM};
    EpiPleGate E{PT, (const bf16*)(ws + WS_PE + 64 * MiB), p.out, (const float*)(ws + WS_SS) + (layer == 0 ? 1 : 2) * NTOK, (float*)(ws + WS_SS), (bf16*)(ws + WS_Y), p.in[I_NORM_GAIN] + DM, layer};
    pg8::gemm_phase<EpiPleGate, pg8::StaticOrder, true, true>((PG8_LAS unsigned char*)lds, g, S, E); }
}

DI float half_max(float v) { auto rr = __builtin_amdgcn_permlane32_swap(__float_as_uint(v), __float_as_uint(v), false, false); return fmaxf(__uint_as_float(rr[0]), __uint_as_float(rr[1])); }
template <int DVB, bool MASKED = true>
DI void attn_step32(const bf16* Kt, int KP, const bf16* Vt, int VP, const bf16x8 (&qf)[4], f32x16 (&o)[DVB], float& m, float& l, unsigned vmask, float c2, int lane) {
  const int r32 = lane & 31, h = lane >> 5;
  f32x16 s;
#pragma unroll
  for (int i = 0; i < 16; ++i) s[i] = 0.f;
#pragma unroll
  for (int t = 0; t < 4; ++t) { const bf16x8 kf = *(const bf16x8*)(Kt + r32 * KP + t * 16 + h * 8); s = mfma32(kf, qf[t], s); }
  float mx = -INFINITY;
#pragma unroll
  for (int i = 0; i < 16; ++i) { if (MASKED) { s[i] = ((vmask >> i) & 1u) ? s[i] : -INFINITY; } mx = fmaxf(mx, s[i]); }
  mx = half_max(mx);
  const float mxs = mx * c2;
  if (__any(mxs > m + 6.f)) {
    const float mn = fmaxf(m, mxs);
    const float alpha = fexp2(m - mn); l *= alpha;
#pragma unroll
    for (int d = 0; d < DVB; ++d)
#pragma unroll
      for (int i = 0; i < 16; ++i) o[d][i] *= alpha;
    m = mn;
  }
  float ps = 0.f; const float negm = -m;
#pragma unroll
  for (int i = 0; i < 16; ++i) { const float pv = fexp2(__builtin_fmaf(s[i], c2, negm)); s[i] = pv; ps += pv; }
  l += ps;
  bf16x8 pf[2];
  { u32x4 a, b; a.x = cvtpk(s[0], s[1]); a.y = cvtpk(s[2], s[3]); a.z = cvtpk(s[4], s[5]); a.w = cvtpk(s[6], s[7]);
    b.x = cvtpk(s[8], s[9]); b.y = cvtpk(s[10], s[11]); b.z = cvtpk(s[12], s[13]); b.w = cvtpk(s[14], s[15]);
    pf[0] = __builtin_bit_cast(bf16x8, a); pf[1] = __builtin_bit_cast(bf16x8, b); }
  const int i16 = lane & 15, q = i16 >> 2, pp = i16 & 3, blk = (lane >> 4) & 1;
#pragma unroll
  for (int d = 0; d < DVB; ++d)
#pragma unroll
    for (int sk = 0; sk < 2; ++sk) {
      const s16x4 lo = trread(Vt + (16 * sk + 4 * h + q) * VP + 32 * d + 16 * blk + 4 * pp);
      const s16x4 hi = trread(Vt + (16 * sk + 8 + 4 * h + q) * VP + 32 * d + 16 * blk + 4 * pp);
      const bf16x8 vf = __builtin_shufflevector(lo, hi, 0, 1, 2, 3, 4, 5, 6, 7);
      o[d] = mfma32(vf, pf[sk], o[d]);
    }
}

DI unsigned row_range_mask(int lo, int hi) {
  lo = lo < 0 ? 0 : lo; hi = hi > 31 ? 31 : hi;
  if (hi < lo) return 0u;
  const unsigned upto_hi = (hi >= 31) ? 0xffffffffu : ((1u << (hi + 1)) - 1u);
  return upto_hi & ~((1u << lo) - 1u);
}
DI unsigned lane_rows(unsigned m32, int h) {
  const unsigned t = m32 >> (4 * h);
  return (t & 0xFu) | ((t >> 4) & 0xF0u) | ((t >> 8) & 0xF00u) | ((t >> 12) & 0xF000u);
}
constexpr int WP = 72;
constexpr int WAVE_LDS = 2 * 32 * WP * 2 + 512;

struct KVRegs { u32x4 k[4], v[4]; };
DI void kv_store(const KVRegs& R, bf16* Ks, bf16* Vs, int lane) {
#pragma unroll
  for (int i = 0; i < 4; ++i) { const int row = (lane >> 3) + 8 * i, ch = lane & 7; *(u32x4*)(Ks + row * WP + ch * 8) = R.k[i]; *(u32x4*)(Vs + row * WP + ch * 8) = R.v[i]; }
}

DI void band_load(KVRegs& R, const bf16* Kg, const bf16* Vg, int NP, int kstart, int dil, int roff, int lane) {
#pragma unroll
  for (int i = 0; i < 4; ++i) {
    const int row = (lane >> 3) + 8 * i, ch = lane & 7; int k = kstart + row; if (k < 0) k = 0;
    const size_t off = (size_t)(dil * k + roff) * NP + ch * 8;
    R.k[i] = *(const u32x4*)(Kg + off); R.v[i] = *(const u32x4*)(Vg + off);
  }
}
template <int DVB>
DI void band_run(const bf16* Kg, const bf16* Vg, int NP, int kbase, int nsteps, int dil, int roff, int qidx, int win,
                 const bf16x8 (&qf)[4], f32x16 (&o)[DVB], float& m, float& l, float c2, bf16* Ks, bf16* Vs, int lane) {
  const int h = lane >> 5;
  KVRegs R; band_load(R, Kg, Vg, NP, kbase, dil, roff, lane);
  for (int j = 0; j < nsteps; ++j) {
    lds_fence();
    kv_store(R, Ks, Vs, lane);
    lds_fence();
    if (j + 1 < nsteps) band_load(R, Kg, Vg, NP, kbase + 32 * (j + 1), dil, roff, lane);
    const int kb = kbase + 32 * j, lo_r = (qidx - win > 0 ? qidx - win : 0) - kb;
    const unsigned vm = lane_rows(row_range_mask(lo_r, qidx - kb), h);
    attn_step32<DVB>(Ks, WP, Vs, WP, qf, o, m, l, vm, c2, lane);
  }
}

DI void write_o64(const f32x16 (&o)[2], float linv, const bf16* gate_row, bf16* y_row, int h) {
#pragma unroll
  for (int d = 0; d < 2; ++d)
#pragma unroll
    for (int g = 0; g < 4; ++g) {
      const int dd = 32 * d + 8 * g + 4 * h;
      const u32x2 gv = *(const u32x2*)(gate_row + dd);
      const float g0 = __uint_as_float(gv.x << 16), g1 = __uint_as_float(gv.x & 0xffff0000u), g2 = __uint_as_float(gv.y << 16), g3 = __uint_as_float(gv.y & 0xffff0000u);
      u32x2 w; w.x = cvtpk(o[d][4 * g] * linv * g0, o[d][4 * g + 1] * linv * g1); w.y = cvtpk(o[d][4 * g + 2] * linv * g2, o[d][4 * g + 3] * linv * g3);
      *(u32x2*)(y_row + dd) = w;
    }
}

DI void load_q(bf16x8 (&qf)[4], const bf16* qrow, int h) {
#pragma unroll
  for (int t = 0; t < 4; ++t) qf[t] = *(const bf16x8*)(qrow + t * 16 + h * 8);
}
template <int DVB> DI void zero_o(f32x16 (&o)[DVB]) {
#pragma unroll
  for (int d = 0; d < DVB; ++d)
#pragma unroll
    for (int i = 0; i < 16; ++i) o[d][i] = 0.f;
}

DI void mixerB_tile(const Params& p, int item, bf16* Ks, bf16* Vs, int lane) {
  const bf16* PE = (const bf16*)(p.ws + WS_PE); bf16* Y = (bf16*)(p.ws + WS_Y);
  const int qblk = item & 255, head = (item >> 8) & 7, b = item >> 11;
  const int r32 = lane & 31, h = lane >> 5, q0 = qblk * 32, kvh = head >> 2;
  const size_t rowb = (size_t)b * SEQ;
  bf16x8 qf[4]; load_q(qf, PE + (rowb + q0 + r32) * NPE + E_BQ + head * 64, h);
  f32x16 o[2]; zero_o<2>(o);
  const float sink2 = p.in[I_B_SINKS][head] * LOG2E;
  float m = sink2, l = (h == 0) ? 1.f : 0.f;
  band_run<2>(PE + rowb * NPE + E_BK + kvh * 64, PE + rowb * NPE + E_BV + kvh * 64, NPE, q0 - 128, 5, 1, 0, q0 + r32, 127, qf, o, m, l, 0.125f * LOG2E, Ks, Vs, lane);
  l += __shfl_xor(l, 32);
  const size_t tok = rowb + q0 + r32;
  write_o64(o, 1.f / l, PE + tok * NPE + E_BG + head * 64, Y + tok * DM + 512 + head * 64, h);
}

DI void mixerC_tile(const Params& p, int item, bf16* Ks, bf16* Vs, int lane) {
  const bf16* PO = (const bf16*)(p.ws + WS_PE); bf16* Y = (bf16*)(p.ws + WS_Y);
  const int qt = item & 15, r16 = (item >> 4) & 15, head = (item >> 8) & 7, b = item >> 11;
  const int r32 = lane & 31, h = lane >> 5, qi0 = qt * 32;
  const size_t rowb = (size_t)b * SEQ;
  const int t = 16 * (qi0 + r32) + r16;
  bf16x8 qf[4]; load_q(qf, PO + (rowb + t) * NPO + O_CQ + head * 64, h);
  f32x16 o[2]; zero_o<2>(o);
  float m = -1e30f, l = 0.f;
  const bf16* Kg = PO + rowb * NPO + O_CK + head * 64; const bf16* Vg = PO + rowb * NPO + O_CV + head * 64;
  const float c2 = 0.125f * LOG2E;
  band_run<2>(Kg, Vg, NPO, qi0 - 128, 5, 16, r16, qi0 + r32, 128, qf, o, m, l, c2, Ks, Vs, lane);
  band_run<2>(Kg, Vg, NPO, 4 * qi0 + (r16 >> 2) - 128, 8, 4, r16 & 3, 4 * (qi0 + r32) + (r16 >> 2), 128, qf, o, m, l, c2, Ks, Vs, lane);
  band_run<2>(Kg, Vg, NPO, 16 * qi0 + r16 - 128, 20, 1, 0, t, 128, qf, o, m, l, c2, Ks, Vs, lane);
  l += __shfl_xor(l, 32);
  const size_t tok = rowb + t;
  write_o64(o, 1.f / l, PO + tok * NPO + O_CG + head * 64, Y + tok * DM + head * 64, h);
}

DI void attn_step16(const bf16* Kt, const bf16* Vt, const bf16x8 (&qf)[2], f32x4 (&o)[4], float& m, float& l, int nvalid  , float c2, int lane) {
  const int c = lane & 15, qd = lane >> 4;
  f32x4 s0 = {0.f, 0.f, 0.f, 0.f}, s1 = {0.f, 0.f, 0.f, 0.f};
#pragma unroll
  for (int ks = 0; ks < 2; ++ks) {
    const bf16x8 k0 = *(const bf16x8*)(Kt + c * WP + ks * 32 + qd * 8);
    const bf16x8 k1 = *(const bf16x8*)(Kt + (16 + c) * WP + ks * 32 + qd * 8);
    s0 = mfma16(k0, qf[ks], s0); s1 = mfma16(k1, qf[ks], s1);
  }
  float mx = -INFINITY;
#pragma unroll
  for (int j = 0; j < 4; ++j) { if (4 * qd + j >= nvalid) s0[j] = -INFINITY; if (16 + 4 * qd + j >= nvalid) s1[j] = -INFINITY; mx = fmaxf(mx, fmaxf(s0[j], s1[j])); }
  mx = fmaxf(mx, __shfl_xor(mx, 16)); mx = fmaxf(mx, __shfl_xor(mx, 32));
  const float mxs = mx * c2;
  if (__any(mxs > m + 6.f)) {
    const float mn = fmaxf(m, mxs); const float alpha = fexp2(m - mn); l *= alpha;
#pragma unroll
    for (int d = 0; d < 4; ++d) o[d] = o[d] * alpha;
    m = mn;
  }
  const float negm = -m; float ps = 0.f;
#pragma unroll
  for (int j = 0; j < 4; ++j) { s0[j] = fexp2(__builtin_fmaf(s0[j], c2, negm)); s1[j] = fexp2(__builtin_fmaf(s1[j], c2, negm)); ps += s0[j] + s1[j]; }
  l += ps;
  u32x4 pw; pw.x = cvtpk(s0[0], s0[1]); pw.y = cvtpk(s0[2], s0[3]); pw.z = cvtpk(s1[0], s1[1]); pw.w = cvtpk(s1[2], s1[3]);
  const bf16x8 pf = __builtin_bit_cast(bf16x8, pw);
  const int i16 = lane & 15, rq = i16 >> 2, pp = i16 & 3;
#pragma unroll
  for (int dt = 0; dt < 4; ++dt) {
    const s16x4 lo = trread(Vt + (4 * qd + rq) * WP + 16 * dt + 4 * pp);
    const s16x4 hi = trread(Vt + (16 + 4 * qd + rq) * WP + 16 * dt + 4 * pp);
    const bf16x8 vf = __builtin_shufflevector(lo, hi, 0, 1, 2, 3, 4, 5, 6, 7);
    o[dt] = mfma16(vf, pf, o[dt]);
  }
}

DI void mixerA_item(const Params& p, int item, bf16* Ks, bf16* Vs, int lane) {
  const bf16* PE = (const bf16*)(p.ws + WS_PE); bf16* Y = (bf16*)(p.ws + WS_Y);
  const unsigned short* SEL = (const unsigned short*)(p.ws + WS_SEL) + (size_t)item * 256;
  const int t = item & (SEQ - 1), b = item >> 13;
  const int c = lane & 15, qd = lane >> 4, head = c & 7;
  const size_t rowb = (size_t)b * SEQ;
  const int count = (t + 1 < 256) ? t + 1 : 256, nsteps = (count + 31) >> 5;
  bf16x8 qf[2];
#pragma unroll
  for (int ks = 0; ks < 2; ++ks) qf[ks] = *(const bf16x8*)(PE + (size_t)item * NPE + E_AQ + head * 64 + ks * 32 + qd * 8);
  f32x4 o[4];
#pragma unroll
  for (int d = 0; d < 4; ++d) o[d] = (f32x4){0.f, 0.f, 0.f, 0.f};
  float m = -1e30f, l = 0.f;
  const bf16* Kg = PE + rowb * NPE + E_AK; const bf16* Vg = PE + rowb * NPE + E_AV;
  KVRegs R;
  unsigned short* sel_l = (unsigned short*)(Vs + 32 * WP);
  lds_fence();
  *(u32x2*)(sel_l + 4 * lane) = *(const u32x2*)(SEL + 4 * lane);
  lds_fence();
#define A_LOAD(j) do { _Pragma("unroll") for (int i = 0; i < 4; ++i) { const int row = (lane >> 3) + 8 * i, ch = lane & 7, e = 32 * (j) + row; \
      const int tokk = (e < count) ? (int)sel_l[e] : 0; const size_t off = (size_t)tokk * NPE + ch * 8; R.k[i] = *(const u32x4*)(Kg + off); R.v[i] = *(const u32x4*)(Vg + off); } } while (0)
  A_LOAD(0);
  for (int j = 0; j < nsteps; ++j) {
    lds_fence();
    kv_store(R, Ks, Vs, lane);
    lds_fence();
    if (j + 1 < nsteps) A_LOAD(j + 1);
    attn_step16(Ks, Vs, qf, o, m, l, count - 32 * j, 0.125f * LOG2E, lane);
  }
#undef A_LOAD
  l += __shfl_xor(l, 16); l += __shfl_xor(l, 32);
  if (c < 8) {
    const float linv = 1.f / l;
    const bf16* gate_row = PE + (size_t)item * NPE + E_AG + head * 64; bf16* y_row = Y + (size_t)item * DM + head * 64;
#pragma unroll
    for (int dt = 0; dt < 4; ++dt) {
      const int dd = 16 * dt + 4 * qd;
      const u32x2 gv = *(const u32x2*)(gate_row + dd);
      const float g0 = __uint_as_float(gv.x << 16), g1 = __uint_as_float(gv.x & 0xffff0000u), g2 = __uint_as_float(gv.y << 16), g3 = __uint_as_float(gv.y & 0xffff0000u);
      u32x2 w; w.x = cvtpk(o[dt][0] * linv * g0, o[dt][1] * linv * g1); w.y = cvtpk(o[dt][2] * linv * g2, o[dt][3] * linv * g3);
      *(u32x2*)(y_row + dd) = w;
    }
  }
}

DI unsigned f2ord(float f) { f += 0.f; const unsigned u = __float_as_uint(f); return (u & 0x80000000u) ? ~u : (u | 0x80000000u); }
DI int block_excl_scan(int v, int* tmp, int* tot) {
  const int lane = threadIdx.x & 63, wid = threadIdx.x >> 6;
  int inc = v;
#pragma unroll
  for (int o = 1; o < 64; o <<= 1) { const int u = __shfl_up(inc, o); if (lane >= o) inc += u; }
  if (lane == 63) tmp[wid] = inc;
  __syncthreads();
  int base = 0, total = 0;
#pragma unroll
  for (int w = 0; w < 8; ++w) { const int x = tmp[w]; if (w < wid) base += x; total += x; }
  *tot = total;
  return base + inc - v;
}

DI float dpp_sum8(float v) {
  v += __builtin_bit_cast(float, __builtin_amdgcn_mov_dpp(__builtin_bit_cast(int, v), 0xB1, 0xF, 0xF, true));
  v += __builtin_bit_cast(float, __builtin_amdgcn_mov_dpp(__builtin_bit_cast(int, v), 0x4E, 0xF, 0xF, true));
  v += __builtin_bit_cast(float, __builtin_amdgcn_mov_dpp(__builtin_bit_cast(int, v), 0x141, 0xF, 0xF, true));
  return v;
}
DI void hist_find(const int* hist, int* misc, int need, int& digit, int& nneed, int& cnt) {
  const int tid = threadIdx.x;
  typedef int i32x4 __attribute__((ext_vector_type(4)));
  const i32x4 h0 = *(const i32x4*)(hist + tid * 8), h1 = *(const i32x4*)(hist + tid * 8 + 4);
  int hh[8] = {h0.x, h0.y, h0.z, h0.w, h1.x, h1.y, h1.z, h1.w}; int tot = 0;
#pragma unroll
  for (int k = 0; k < 8; ++k) tot += hh[k];
  int total; const int ex = block_excl_scan(tot, misc, &total);
  int above = total - ex - tot;
#pragma unroll
  for (int k = 7; k >= 0; --k) { const int c = hh[k]; if (above < need && above + c >= need) { misc[16] = tid * 8 + k; misc[17] = need - above; misc[18] = c; } above += c; }
  __syncthreads();
  digit = misc[16]; nneed = misc[17]; cnt = misc[18];
  __syncthreads();
}
DI unsigned long long mkcmp(float v, int idx) { return ((unsigned long long)f2ord(v) << 16) | ((unsigned long long)(8191 - idx) << 3); }
DI float ord2f(unsigned k) { return __uint_as_float((k & 0x80000000u) ? (k ^ 0x80000000u) : ~k); }
DI float half_sum(float v) { auto rr = __builtin_amdgcn_permlane32_swap(__float_as_uint(v), __float_as_uint(v), false, false); return __uint_as_float(rr[0]) + __uint_as_float(rr[1]); }

constexpr int CL_CAP = 512;
DI void select_slow(const float* scq, int n, unsigned short* out, float lo, float hi, int* hist, int* misc, unsigned long long* clist) {
  const int tid = opaque_tid();
    const float scale = (hi > lo) ? 4095.f / (hi - lo) : 0.f;
    for (int i = tid; i < 4096; i += 512) hist[i] = 0;
    if (tid == 0) misc[20] = 0;
    __syncthreads();
    float val[16]; int bin[16];
#pragma unroll
    for (int i = 0; i < 16; ++i) { const int idx = tid + 512 * i; const float v = (idx < n) ? scq[idx] : lo; val[i] = v;
      int bb = (int)((v - lo) * scale); bb = bb < 0 ? 0 : (bb > 4095 ? 4095 : bb); bin[i] = bb; if (idx < n) atomicAdd(&hist[bb], 1); }
    __syncthreads();
    int bstar, need, cnt;
    hist_find(hist, misc, 256, bstar, need, cnt);
    unsigned long long T = 0ull;
    if (cnt != need) {
      if (cnt <= CL_CAP) {
#pragma unroll
        for (int i = 0; i < 16; ++i) { const int idx = tid + 512 * i; if (idx < n && bin[i] == bstar) { const int slot = atomicAdd(&misc[20], 1); clist[slot] = mkcmp(val[i], idx); } }
        __syncthreads();
        if (tid < cnt) { const unsigned long long c = clist[tid]; int rank = 0; for (int jx = 0; jx < cnt; ++jx) rank += (clist[jx] > c) ? 1 : 0;
          if (rank == need - 1) { misc[21] = (int)(unsigned)(c & 0xffffffffull); misc[22] = (int)(unsigned)(c >> 32); } }
        __syncthreads();
        T = ((unsigned long long)(unsigned)misc[22] << 32) | (unsigned long long)(unsigned)misc[21];
      } else {
        unsigned long long prefix = 0ull; int shift = 36;
        for (int pass = 0; pass < 4; ++pass) {
          for (int i = tid; i < 4096; i += 512) hist[i] = 0;
          __syncthreads();
#pragma unroll
          for (int i = 0; i < 16; ++i) { const int idx = tid + 512 * i; if (idx < n && bin[i] == bstar) { const unsigned long long c = mkcmp(val[i], idx); if (pass == 0 || (c >> (shift + 12)) == prefix) atomicAdd(&hist[(int)((c >> shift) & 4095ull)], 1); } }
          __syncthreads();
          int digit, nneed, c2;
          hist_find(hist, misc, need, digit, nneed, c2);
          prefix = (prefix << 12) | (unsigned long long)digit; need = nneed;
          if (c2 == need) break;
          shift -= 12;
        }
        T = prefix << shift;
      }
    }
    int mycnt = 0; unsigned selm = 0;
#pragma unroll
    for (int i = 0; i < 16; ++i) { const int idx = tid + 512 * i;
      bool sel = false;
      if (idx < n) { if (bin[i] > bstar) sel = true; else if (bin[i] == bstar) sel = (mkcmp(val[i], idx) >= T); }
      if (sel) { ++mycnt; selm |= (1u << i); } }
    int total; int pos = block_excl_scan(mycnt, misc + 8, &total);
#pragma unroll
    for (int i = 0; i < 16; ++i) { if ((selm >> i) & 1u) { if (pos < 256) out[pos] = (unsigned short)(tid + 512 * i); ++pos; } }
    __syncthreads();
}

DI void sel_load_qw(const Params& p, int item, bf16x8 (&qf)[4], float (&wq)[16], int lane) {
  const bf16* PE = (const bf16*)(p.ws + WS_PE); const float* IW = (const float*)(p.ws + WS_IW);
  const int r32 = lane & 31, h = lane >> 5, b = item >> 11, t0 = (item & 2047) * 4; const size_t rowb = (size_t)b * SEQ;
  load_q(qf, PE + (rowb + t0 + (r32 >> 3)) * NPE + E_IQ + (r32 & 7) * 64, h);
#pragma unroll
  for (int q = 0; q < 4; ++q) { const f32x4 w4 = *(const f32x4*)(IW + (rowb + t0 + q) * 8 + 4 * h);
    wq[4 * q] = w4.x * 0.04419417382415922f; wq[4 * q + 1] = w4.y * 0.04419417382415922f; wq[4 * q + 2] = w4.z * 0.04419417382415922f; wq[4 * q + 3] = w4.w * 0.04419417382415922f; }
}
DI void selectA_item(const Params& p, int item, int next_item, char* lds, bf16x8 (&qf)[4], float (&wq)[16]) {
  const bf16* PE = (const bf16*)(p.ws + WS_PE);
  const float* IW = (const float*)(p.ws + WS_IW);
  unsigned short* SEL = (unsigned short*)(p.ws + WS_SEL);
  float* sc = (float*)lds;
  int* hist = (int*)(lds + 4 * 8192 * 4);
  int* misc = hist + 4096;
  unsigned* mm = (unsigned*)(misc + 24);
  unsigned long long* clist = (unsigned long long*)(misc + 96);
  const int tid = opaque_tid(), lane = tid & 63, wid = tid >> 6, r32 = lane & 31, h = lane >> 5;
  const int b = item >> 11, t0 = (item & 2047) * 4;
  const size_t rowb = (size_t)b * SEQ;
  const int nk = t0 + 4, ntile = (nk + 31) >> 5;
  const f32x4 pcv = ((const f32x4*)p.in[I_P])[(size_t)item * 512 + tid];
  if (tid < 4) { mm[tid * 2] = 0xFFFFFFFFu; mm[tid * 2 + 1] = 0u; }
  lds_barrier();
  const bf16* Kt = (const bf16*)(p.ws + WS_IKS) + (size_t)b * 256 * 2048 + lane * 8;
  {
    bf16x8 kf[4], kn[4];
#pragma unroll
    for (int t = 0; t < 4; ++t) { kf[t] = (bf16x8){0, 0, 0, 0, 0, 0, 0, 0}; kn[t] = kf[t]; }
    if (wid < ntile) {
#pragma unroll
      for (int t = 0; t < 4; ++t) kf[t] = *(const bf16x8*)(Kt + (size_t)wid * 2048 + t * 512);
    }
    float lo0 = INFINITY, hi0 = -INFINITY, lo1 = INFINITY, hi1 = -INFINITY;
    for (int kt = wid; kt < ntile; kt += 8) {
      if (kt + 8 < ntile) {
#pragma unroll
        for (int t = 0; t < 4; ++t) kn[t] = *(const bf16x8*)(Kt + (size_t)(kt + 8) * 2048 + t * 512);
      }
      f32x16 s;
#pragma unroll
      for (int i = 0; i < 16; ++i) s[i] = 0.f;
#pragma unroll
      for (int t = 0; t < 4; ++t) s = mfma32(qf[t], kf[t], s);
      float v[4];
#pragma unroll
      for (int q = 0; q < 4; ++q) {
        float a = wq[4 * q] * fmaxf(s[4 * q], 0.f);
#pragma unroll
        for (int jj = 1; jj < 4; ++jj) a += wq[4 * q + jj] * fmaxf(s[4 * q + jj], 0.f);
        v[q] = half_sum(a) + 0.f;
      }
      const float va = h ? v[2] : v[0], vb = h ? v[3] : v[1];
      const int key = kt * 32 + r32;
      sc[(2 * h) * 8192 + key] = va; sc[(2 * h + 1) * 8192 + key] = vb;
      lo0 = fminf(lo0, va); hi0 = fmaxf(hi0, va); lo1 = fminf(lo1, vb); hi1 = fmaxf(hi1, vb);
#pragma unroll
      for (int t = 0; t < 4; ++t) kf[t] = kn[t];
    }
    if (wid < ntile) {
#pragma unroll
      for (int o = 1; o < 32; o <<= 1) { lo0 = fminf(lo0, __shfl_xor(lo0, o)); hi0 = fmaxf(hi0, __shfl_xor(hi0, o)); lo1 = fminf(lo1, __shfl_xor(lo1, o)); hi1 = fmaxf(hi1, __shfl_xor(hi1, o)); }
      if (r32 == 0) { atomicMin(&mm[(2 * h) * 2], f2ord(lo0)); atomicMax(&mm[(2 * h) * 2 + 1], f2ord(hi0)); atomicMin(&mm[(2 * h + 1) * 2], f2ord(lo1)); atomicMax(&mm[(2 * h + 1) * 2 + 1], f2ord(hi1)); }
    }
  }
  if (next_item >= 0) sel_load_qw(p, next_item, qf, wq, lane);
  { u32x2 w; w.x = cvtpk(pcv.x, pcv.y); w.y = cvtpk(pcv.z, pcv.w); ((u32x2*)(p.ws + WS_PBF))[(size_t)item * 512 + tid] = w; }
  lds_barrier();
  {
    const int g = wid >> 1, gt = tid & 127, upper = wid & 1;
    const int t = t0 + g, n = t + 1;
    const bool big = n > 256;
    const float* scq = sc + g * 8192;
    unsigned short* out = SEL + (rowb + t) * 256;
    int* histq = hist + g * 1024;
    unsigned long long* clq = clist + g * 128;
    int* mq = misc + 32 + g * 8;
    const float lo = ord2f(mm[g * 2]), hi = ord2f(mm[g * 2 + 1]);
    const float scale = (hi > lo) ? 1023.f / (hi - lo) : 0.f;
    for (int i = gt; i < 1024; i += 128) histq[i] = 0;
    if (gt == 0) { mq[0] = 0; mq[6] = 0; }
    lds_barrier();
    float uu[64];
#pragma unroll
    for (int i = 0; i < 64; ++i) { const int idx = gt + 128 * i; const float v = (idx < n) ? scq[idx] : lo; const float u = (v - lo) * scale; uu[i] = u;
      if (big && idx < n) { int bb = (int)u; bb = bb > 1023 ? 1023 : bb; atomicAdd(&histq[bb], 1); } }
    lds_barrier();
    typedef int i32x4 __attribute__((ext_vector_type(4)));
    const i32x4 h0 = *(const i32x4*)(histq + gt * 8), h1 = *(const i32x4*)(histq + gt * 8 + 4);
    const int hh[8] = {h0.x, h0.y, h0.z, h0.w, h1.x, h1.y, h1.z, h1.w};
    int tot = 0;
#pragma unroll
    for (int k = 0; k < 8; ++k) tot += hh[k];
    int inc = tot;
#pragma unroll
    for (int o = 1; o < 64; o <<= 1) { const int ux = __shfl_down(inc, o); if (lane + o < 64) inc += ux; }
    if (lane == 0) misc[wid] = inc;
    lds_barrier();
    {
      int above = inc - tot + (upper ? 0 : misc[wid + 1]);
      if (big) {
#pragma unroll
        for (int k = 7; k >= 0; --k) { const int c = hh[k]; if (above < 256 && above + c >= 256) { mq[1] = gt * 8 + k; mq[2] = 256 - above; mq[3] = c; } above += c; }
      }
    }
    lds_barrier();
    const int bstar = mq[1], need = mq[2], cnt = mq[3];
    const float flo = (float)bstar, fhi = (bstar >= 1023) ? INFINITY : (float)(bstar + 1);
    const bool tie = big && cnt != need;
    if (tie) {
      if (cnt <= 128) {
#pragma unroll
        for (int i = 0; i < 64; ++i) { const int idx = gt + 128 * i; if (idx < n && uu[i] >= flo && uu[i] < fhi) { const int slot = atomicAdd(&mq[0], 1); clq[slot] = mkcmp(scq[idx], idx); } }
      } else if (gt == 0) mq[6] = 1;
    }
    lds_barrier();
    if (tie && cnt <= 128 && gt < cnt) { const unsigned long long c = clq[gt]; int rank = 0; for (int jx = 0; jx < cnt; ++jx) rank += (clq[jx] > c) ? 1 : 0;
      if (rank == need - 1) { mq[4] = (int)(unsigned)(c & 0xffffffffull); mq[5] = (int)(unsigned)(c >> 32); } }
    lds_barrier();
    const unsigned long long T = tie ? (((unsigned long long)(unsigned)mq[5] << 32) | (unsigned long long)(unsigned)mq[4]) : 0ull;
    const bool fast = big && !(tie && cnt > 128);
    unsigned long long selm = 0ull;
    if (fast) {
#pragma unroll
      for (int i = 0; i < 64; ++i) { const int idx = gt + 128 * i;
        if (idx < n) { const float u = uu[i]; bool sel = u >= fhi; if (!sel && u >= flo) sel = !tie || (mkcmp(scq[idx], idx) >= T); if (sel) selm |= (1ull << i); } }
    }
    const int mycnt = __popcll(selm);
    int pinc = mycnt;
#pragma unroll
    for (int o = 1; o < 64; o <<= 1) { const int ux = __shfl_up(pinc, o); if (lane >= o) pinc += ux; }
    if (lane == 63) misc[8 + wid] = pinc;
    lds_barrier();
    if (fast) {
      int pos = pinc - mycnt + (upper ? misc[8 + wid - 1] : 0);
      while (selm) { const int i = __ffsll((long long)selm) - 1; selm &= selm - 1ull; if (pos < 256) out[pos] = (unsigned short)(gt + 128 * i); ++pos; }
    } else if (!big) {
      for (int i = gt; i < n; i += 128) out[i] = (unsigned short)i;
    }
    lds_barrier();
  }
  for (int q = 0; q < 4; ++q) {
    if (misc[32 + q * 8 + 6]) { const int t = t0 + q; select_slow(sc + q * 8192, t + 1, SEL + (rowb + t) * 256, ord2f(mm[q * 2]), ord2f(mm[q * 2 + 1]), hist, misc, clist); }
  }
  lds_barrier();
}

constexpr int DKP = 72, DVP = 136;
constexpr int D_STAGE = (64 * DKP * 2 + 64 * DVP) * 2;
DI void mixerD_unit(const Params& p, int b, int head, int qb, char* lds) {
  const bf16* PO = (const bf16*)(p.ws + WS_PE); bf16* Y = (bf16*)(p.ws + WS_Y);
  const int tid = opaque_tid(), lane = tid & 63, wid = tid >> 6, r32 = lane & 31, h = lane >> 5;
  const int map = wid & 1, qsub = wid >> 1;
  const size_t rowb = (size_t)b * SEQ;
  const int qpos = 128 * qb + 32 * qsub + r32;
  bf16x8 qf[4]; load_q(qf, PO + (rowb + qpos) * NPO + O_DQ + (2 * head + map) * 64, h);
  f32x16 o[4]; zero_o<4>(o);
  float m = -1e30f, l = 0.f;
  const int nsteps = 2 * qb + 2;
  const bf16* K1g = PO + rowb * NPO + O_DK + (2 * head) * 64;
  const bf16* K2g = K1g + 64;
  const bf16* Vg = PO + rowb * NPO + O_DV + head * 128;
  u32x4 rk1, rk2, rv[2];
#define D_LOAD(j) do { const int row = tid >> 3, ch = tid & 7; const size_t off = (size_t)((j) * 64 + row) * NPO + ch * 8; rk1 = *(const u32x4*)(K1g + off); rk2 = *(const u32x4*)(K2g + off); \
    _Pragma("unroll") for (int i = 0; i < 2; ++i) { const int c = tid + 512 * i, vr = c >> 4, vc = c & 15; rv[i] = *(const u32x4*)(Vg + (size_t)((j) * 64 + vr) * NPO + vc * 8); } } while (0)
  __syncthreads();
  D_LOAD(0);
  for (int j = 0; j < nsteps; ++j) {
    char* st = lds + (j & 1) * D_STAGE;
    bf16* K1s = (bf16*)st; bf16* K2s = K1s + 64 * DKP; bf16* Vs = K2s + 64 * DKP;
    { const int row = tid >> 3, ch = tid & 7; *(u32x4*)(K1s + row * DKP + ch * 8) = rk1; *(u32x4*)(K2s + row * DKP + ch * 8) = rk2;
#pragma unroll
      for (int i = 0; i < 2; ++i) { const int c = tid + 512 * i, vr = c >> 4, vc = c & 15; *(u32x4*)(Vs + vr * DVP + vc * 8) = rv[i]; } }
    __syncthreads();
    if (j + 1 < nsteps) D_LOAD(j + 1);
    const bf16* Ks = map ? K2s : K1s;
#pragma unroll
    for (int sub = 0; sub < 2; ++sub) {
      const int k0 = j * 64 + sub * 32;
      if (k0 <= 128 * qb + 32 * qsub + 31) {
        if (k0 + 31 <= 128 * qb + 32 * qsub) {
          attn_step32<4, false>(Ks + sub * 32 * DKP, DKP, Vs + sub * 32 * DVP, DVP, qf, o, m, l, 0xffffu, 0.125f * LOG2E, lane);
        } else {
          unsigned vm = 0;
#pragma unroll
          for (int i = 0; i < 16; ++i) if (k0 + crow(i, h) <= qpos) vm |= (1u << i);
          attn_step32<4, true>(Ks + sub * 32 * DKP, DKP, Vs + sub * 32 * DVP, DVP, qf, o, m, l, vm, 0.125f * LOG2E, lane);
        }
      }
    }
  }
#undef D_LOAD
  l += __shfl_xor(l, 32);
  const float linv = 1.f / l;
  __syncthreads();
  float* xch = (float*)lds + qsub * 4096;
  if (map == 1) {
#pragma unroll
    for (int d = 0; d < 4; ++d)
#pragma unroll
      for (int i = 0; i < 16; ++i) xch[(d * 16 + i) * 64 + lane] = o[d][i] * linv;
  }
  __syncthreads();
  if (map == 0) {
    const float lam = *(const float*)(p.ws + WS_LAM);
    float ssq = 0.f;
#pragma unroll
    for (int d = 0; d < 4; ++d)
#pragma unroll
      for (int i = 0; i < 16; ++i) { const float a = o[d][i] * linv - lam * xch[(d * 16 + i) * 64 + lane]; o[d][i] = a; ssq += a * a; }
    ssq += __shfl_xor(ssq, 32);
    const float lambda_init = 0.8f - 0.6f * expf(-0.3f);
    const float rn = rsqrtf(ssq * (1.f / 128.f) + EPS) * (1.f - lambda_init);
    const size_t tok = rowb + qpos;
    const bf16* gate = PO + tok * NPO + O_DG + head * 128;
    bf16* y = Y + tok * DM + 512 + head * 128;
    const float* sg = p.in[I_SUB_GAIN];
#pragma unroll
    for (int d = 0; d < 4; ++d)
#pragma unroll
      for (int g = 0; g < 4; ++g) {
        const int dd = 32 * d + 8 * g + 4 * h;
        const u32x2 gv = *(const u32x2*)(gate + dd); const f32x4 s4 = *(const f32x4*)(sg + dd);
        const float g0 = __uint_as_float(gv.x << 16), g1 = __uint_as_float(gv.x & 0xffff0000u), g2 = __uint_as_float(gv.y << 16), g3 = __uint_as_float(gv.y & 0xffff0000u);
        u32x2 w; w.x = cvtpk(o[d][4 * g] * rn * s4.x * g0, o[d][4 * g + 1] * rn * s4.y * g1); w.y = cvtpk(o[d][4 * g + 2] * rn * s4.z * g2, o[d][4 * g + 3] * rn * s4.w * g3);
        *(u32x2*)(y + dd) = w;
      }
  }
  __syncthreads();
}

#define XB_TMO      128
#define XB_XCNT(j)  (256  + 64 * (j))
#define XB_XSUB(j)  (1280 + 64 * (j))
#define XB_XGEN(j)  (2304 + 64 * (j))
#define XB_TOP      3328
#define XB_TOPGEN   3392
#define XCD_BAR_WORDS 3456
#define XB_SPIN_CAP (1u << 18)

__device__ __forceinline__ unsigned xb_ld(unsigned* p)              { return __hip_atomic_load(p, __ATOMIC_RELAXED, __HIP_MEMORY_SCOPE_AGENT); }
__device__ __forceinline__ unsigned xb_add(unsigned* p, unsigned v) { return __hip_atomic_fetch_add(p, v, __ATOMIC_RELAXED, __HIP_MEMORY_SCOPE_AGENT); }
__device__ __forceinline__ unsigned xb_xcc_id() { return (unsigned)__builtin_amdgcn_s_getreg((3 << 11) | 20) & 0xFu; }
#define XB_SPIN(cond, bar) do { unsigned _sp = 0; while (cond) { __builtin_amdgcn_s_sleep(1); \
    if ((++_sp & 255u) == 0u) { if (xb_ld(&(bar)[XB_TMO])) break; if (_sp > XB_SPIN_CAP) { atomicAdd(&(bar)[XB_TMO], 1u); break; } } } } while (0)

struct XcdBarrier {
    unsigned* bar; unsigned x;
    volatile LAS unsigned* st;
};

__device__ __forceinline__ XcdBarrier xcd_barrier_post(unsigned* bar, volatile LAS unsigned* st) {
    XcdBarrier b; b.bar = bar; b.x = xb_xcc_id(); b.st = st;
    if (threadIdx.x == 0) (void)xb_add(&bar[XB_XCNT(b.x)], 1u);
    return b;
}
__device__ __forceinline__ void xcd_barrier_complete(unsigned* bar, unsigned x, unsigned& nloc, unsigned& nx) {
    const unsigned G = gridDim.x * gridDim.y * gridDim.z;
    unsigned sum, cnt, mine, sp = 0u;
    for (;;) {
        sum = 0u; cnt = 0u; mine = 0u;
#pragma unroll
        for (unsigned j = 0; j < 16; ++j) { const unsigned c = xb_ld(&bar[XB_XCNT(j)]); sum += c; cnt += (c > 0u) ? 1u : 0u; mine = (j == x) ? c : mine; }
        if (sum == G) break;
        __builtin_amdgcn_s_sleep(1);
        if ((++sp & 255u) == 0u) { if (xb_ld(&bar[XB_TMO])) break; if (sp > XB_SPIN_CAP) { atomicAdd(&bar[XB_TMO], 1u); break; } }
    }
    nloc = mine > 0u ? mine : 1u; nx = cnt > 0u ? cnt : 1u;
}

__device__ __forceinline__ void xcd_barrier(const XcdBarrier& b) {
    asm volatile("s_waitcnt vmcnt(0)" ::: "memory");
    __syncthreads();
    if (threadIdx.x == 0) {
        unsigned* bar = b.bar;
        __builtin_amdgcn_s_waitcnt(0);
        unsigned nloc = b.st[0], nx = b.st[1];
        if (nloc == 0u) { xcd_barrier_complete(bar, b.x, nloc, nx); b.st[0] = nloc; b.st[1] = nx; }
        const unsigned old = xb_add(&bar[XB_XSUB(b.x)], 1u);
        const unsigned gen = old / nloc;
        if (old + 1u == (gen + 1u) * nloc) {
            __builtin_amdgcn_fence(__ATOMIC_RELEASE, "agent");
            asm volatile("s_waitcnt vmcnt(0)" ::: "memory");
            const unsigned og = xb_add(&bar[XB_TOP], 1u);
            const unsigned tg = og / nx;
            if (og + 1u == (tg + 1u) * nx) xb_add(&bar[XB_TOPGEN], 1u);
            else XB_SPIN(xb_ld(&bar[XB_TOPGEN]) == tg, bar);
            __builtin_amdgcn_fence(__ATOMIC_ACQUIRE, "agent");
            xb_add(&bar[XB_XGEN(b.x)], 1u);
            asm volatile("s_waitcnt vmcnt(0)" ::: "memory");
        } else {
            XB_SPIN(xb_ld(&bar[XB_XGEN(b.x)]) == gen, bar);
            __builtin_amdgcn_fence(__ATOMIC_ACQUIRE, "agent");
            asm volatile("s_waitcnt vmcnt(0)" ::: "memory");
        }
    }
    __syncthreads();
}


__global__ void __launch_bounds__(NTHREADS) fwd_kernel(Params p) {
  extern __shared__ __attribute__((aligned(16))) char smem[];
  cg::grid_group grid = cg::this_grid();
  char* lds = smem;
  volatile LAS unsigned* xb_st = (volatile LAS unsigned*)((LAS char*)smem + (LDS_BYTES - 16));
  if (threadIdx.x < 2) xb_st[threadIdx.x] = 0u;
  __syncthreads();
  const XcdBarrier xbar = xcd_barrier_post((unsigned*)(p.ws + WS_BAR), xb_st);
#define FRESH_IDS const int tid = opaque_tid(), lane = tid & 63, wid = tid >> 6; const int gw = blockIdx.x * 8 + wid, ngw = gridDim.x * 8; bf16* Ks = (bf16*)(lds + wid * WAVE_LDS); bf16* Vs = Ks + 32 * WP; (void)gw; (void)ngw; (void)Ks; (void)Vs; (void)lane;

  phase_prologue(p, lds);
  if (p.ws == nullptr) grid.sync();
  xcd_barrier(xbar);
  for (int rep = 0; rep < REP_GEMM; ++rep) phase_inproj(p, 0, lds);
  xcd_barrier(xbar);
#if EN_A
  for (int rep = 0; rep < REP_SELA; ++rep) { FRESH_IDS
#define SEL_ITEM(k) ((k) * (int)gridDim.x + (((k) & 1) ? (int)gridDim.x - 1 - (int)blockIdx.x : (int)blockIdx.x))
    bf16x8 sqf[4]; float swq[16];
    if (SEL_ITEM(0) < 2 * 2048) sel_load_qw(p, SEL_ITEM(0), sqf, swq, lane);
    for (int k = 0; k * (int)gridDim.x < 2 * 2048; ++k) { const int it = SEL_ITEM(k); int nx = SEL_ITEM(k + 1); if (nx >= 2 * 2048) nx = -1; if (it < 2 * 2048) selectA_item(p, it, nx, lds, sqf, swq); }
#undef SEL_ITEM
  }
  __syncthreads();
  { FRESH_IDS
#define SEL_ITEM(k) ((k) * (int)gridDim.x + (((k) & 1) ? (int)gridDim.x - 1 - (int)blockIdx.x : (int)blockIdx.x))
    const int nK = (2 * 2048 + (int)gridDim.x - 1) / (int)gridDim.x;
    for (int rep = 0; rep < REP_AATT; ++rep)
      for (int s2 = wid; s2 < nK * 4; s2 += 8) { const int it = SEL_ITEM(s2 >> 2); if (it < 2 * 2048) mixerA_item(p, (it >> 11) * SEQ + (it & 2047) * 4 + (s2 & 3), Ks, Vs, lane); }
#undef SEL_ITEM
  }
#else
  { unsigned* y = (unsigned*)(p.ws + WS_Y); for (int i = blockIdx.x * NTHREADS + (int)threadIdx.x; i < NTOK * 256; i += gridDim.x * NTHREADS) { const int row = i >> 8, c = i & 255; y[row * 512 + c] = 0u; } }
#endif
#if EN_B
  { FRESH_IDS const int vb = (gridDim.x % 8 == 0) ? (int)((blockIdx.x & 7) * (gridDim.x >> 3) + (blockIdx.x >> 3)) : (int)blockIdx.x;
    for (int it = vb * 8 + wid; it < 4096; it += ngw) mixerB_tile(p, it, Ks, Vs, lane); }
#else
  { unsigned* y = (unsigned*)(p.ws + WS_Y); for (int i = blockIdx.x * NTHREADS + (int)threadIdx.x; i < NTOK * 256; i += gridDim.x * NTHREADS) { const int row = i >> 8, c = i & 255; y[row * 512 + 256 + c] = 0u; } }
#endif
  xcd_barrier(xbar);
  phase_outproj(p, 0, lds);
  xcd_barrier(xbar);
  phase_ple(p, 0, lds);
  xcd_barrier(xbar);
  phase_inproj(p, 1, lds);
  xcd_barrier(xbar);
#if EN_D
  for (int rep = 0; rep < REP_D; ++rep) {
#pragma unroll 1
    for (int u2 = blockIdx.x * 2; u2 < 512; u2 += gridDim.x * 2) {
#pragma unroll 1
      for (int k = 0; k < 2; ++k) { const int u = u2 >> 1, bh = u & 7, pr = u >> 3;
        mixerD_unit(p, bh >> 2, bh & 3, k ? 63 - pr : pr, lds); }
    }
  }
#else
  { unsigned* y = (unsigned*)(p.ws + WS_Y); for (int i = blockIdx.x * NTHREADS + (int)threadIdx.x; i < NTOK * 256; i += gridDim.x * NTHREADS) { const int row = i >> 8, c = i & 255; y[row * 512 + 256 + c] = 0u; } }
#endif
#if EN_C
  __syncthreads();
  { FRESH_IDS const int vb = (gridDim.x % 8 == 0) ? (int)((blockIdx.x & 7) * (gridDim.x >> 3) + (blockIdx.x >> 3)) : (int)blockIdx.x;
    for (int rep = 0; rep < REP_C; ++rep) for (int it = vb * 8 + wid; it < 4096; it += ngw) mixerC_tile(p, it, Ks, Vs, lane); }
#else
  { unsigned* y = (unsigned*)(p.ws + WS_Y); for (int i = blockIdx.x * NTHREADS + (int)threadIdx.x; i < NTOK * 256; i += gridDim.x * NTHREADS) { const int row = i >> 8, c = i & 255; y[row * 512 + c] = 0u; } }
#endif
  xcd_barrier(xbar);
  phase_outproj(p, 1, lds);
  xcd_barrier(xbar);
  phase_ple(p, 1, lds);
}

extern "C" void kernel_launch(void* const* d_in, const int* in_sizes, int n_in, void* d_out, int out_size, void* d_ws, size_t ws_size, hipStream_t stream) {
  static int grid_blocks = 0;
  if (!grid_blocks) {
    int dev = 0, cus = 0, per_cu = 0;
    hipGetDevice(&dev);
    hipDeviceGetAttribute(&cus, hipDeviceAttributeMultiprocessorCount, dev);
    hipFuncSetAttribute((const void*)fwd_kernel, hipFuncAttributeMaxDynamicSharedMemorySize, LDS_BYTES);
    hipOccupancyMaxActiveBlocksPerMultiprocessor(&per_cu, (const void*)fwd_kernel, NTHREADS, LDS_BYTES);
    if (per_cu < 1) per_cu = 1;
    grid_blocks = cus * per_cu;
    if (grid_blocks > 256) grid_blocks = 256;
  }
  Params p{};
  for (int i = 0; i < 25; ++i) p.in[i] = (const float*)d_in[i];
  p.out = (float*)d_out; p.ws = (unsigned char*)d_ws;
  for (int i = 0; i < 32; ++i) p.inv_freq[i] = (float)pow(10000.0, -(double)i / 32.0);
  (void)hipMemsetAsync((char*)d_ws + WS_BAR, 0, 16384, stream);
  void* args[] = {&p};
  hipError_t e = hipLaunchCooperativeKernel((const void*)fwd_kernel, dim3(grid_blocks), dim3(NTHREADS), args, LDS_BYTES, stream);
  if (e != hipSuccess) fprintf(stderr, "cooperative launch failed: %s (grid %d)\n", hipGetErrorString(e), grid_blocks);
}
```

```cpp
#include <hip/hip_runtime.h>
#include <hip/hip_cooperative_groups.h>
#include <cstdio>
#include <cmath>
namespace cg = cooperative_groups;

#ifndef REP_GEMM
#define REP_GEMM 1
#endif
#ifndef REP_SELA
#define REP_SELA 1
#endif
#ifndef REP_D
#define REP_D 1
#endif
#ifndef REP_C
#define REP_C 1
#endif
#ifndef REP_AATT
#define REP_AATT 1
#endif
#ifndef EN_A
#define EN_A 1
#endif
#ifndef EN_B
#define EN_B 1
#endif
#ifndef EN_C
#define EN_C 1
#endif
#ifndef EN_D
#define EN_D 1
#endif

typedef unsigned short bf16;
typedef short bf16x8 __attribute__((ext_vector_type(8)));
typedef short s16x4 __attribute__((ext_vector_type(4)));
typedef float f32x4 __attribute__((ext_vector_type(4)));
typedef float f32x16 __attribute__((ext_vector_type(16)));
typedef unsigned u32x4 __attribute__((ext_vector_type(4)));
typedef unsigned u32x2 __attribute__((ext_vector_type(2)));
typedef float f32x2_t __attribute__((ext_vector_type(2)));
typedef __bf16 bf16x2_t __attribute__((ext_vector_type(2)));
#define LAS __attribute__((address_space(3)))
#define DI __device__ __forceinline__

constexpr int SEQ = 8192, NTOK = 16384, DM = 1024;
constexpr int NPE = 3072, NPO = 4096;
constexpr float EPS = 1e-6f;
constexpr float LOG2E = 1.4426950408889634f;
constexpr int NTHREADS = 512;
constexpr int LDS_BYTES = 150 * 1024;

constexpr size_t MiB = 1u << 20;
constexpr size_t WS_PE = 0;
constexpr size_t WS_ACT = 128 * MiB;
constexpr size_t WS_Y = 160 * MiB;
constexpr size_t WS_WINE = 192 * MiB;
constexpr size_t WS_WOUTE = 198 * MiB;
constexpr size_t WS_WINO = 200 * MiB;
constexpr size_t WS_WOUTO = 208 * MiB;
constexpr size_t WS_WG0 = 210 * MiB;
constexpr size_t WS_WG1 = 212 * MiB;
constexpr size_t WS_WP0 = 214 * MiB;
constexpr size_t WS_WP1 = 215 * MiB;
constexpr size_t WS_ROPE = 216 * MiB;
constexpr size_t WS_SEL = 218 * MiB;
constexpr size_t WS_IW = 226 * MiB;
constexpr size_t WS_SS = 227 * MiB;
constexpr size_t WS_LAM = 228 * MiB;
constexpr size_t WS_BAR = 250 * MiB;
constexpr size_t WS_PBF = 232 * MiB;
constexpr size_t WS_IKS = 229 * MiB;

struct Params {
  const float* in[25];
  float* out;
  unsigned char* ws;
  float inv_freq[32];
};
enum { I_X = 0, I_P, I_NORM_GAIN, I_W_IN_EVEN, I_W_OUT_EVEN, I_A_Q_GAIN, I_A_K_GAIN, I_IDX_K_GAIN, I_B_Q_GAIN, I_B_K_GAIN, I_B_SINKS,
       I_W_IN_ODD, I_W_OUT_ODD, I_C_Q_GAIN, I_C_K_GAIN, I_D_Q_GAIN, I_D_K_GAIN, I_LQ1, I_LK1, I_LQ2, I_LK2, I_SUB_GAIN, I_PLE_NORM_GAIN,
       I_W_PLE_GATE, I_W_PLE_PROJ };

DI unsigned cvtpk(float lo, float hi) { f32x2_t v = {lo, hi}; bf16x2_t b = __builtin_convertvector(v, bf16x2_t); return __builtin_bit_cast(unsigned, b); }
DI float bf2f(bf16 b) { return __uint_as_float(((unsigned)b) << 16); }
DI float fexp2(float x) { return __builtin_amdgcn_exp2f(x); }
DI f32x16 mfma32(bf16x8 a, bf16x8 b, f32x16 c) { return __builtin_amdgcn_mfma_f32_32x32x16_bf16(a, b, c, 0, 0, 0); }
DI f32x4 mfma16(bf16x8 a, bf16x8 b, f32x4 c) { return __builtin_amdgcn_mfma_f32_16x16x32_bf16(a, b, c, 0, 0, 0); }
DI int crow(int i, int h) { return (i & 3) + 8 * (i >> 2) + 4 * h; }
DI s16x4 trread(const bf16* p) { return __builtin_bit_cast(s16x4, __builtin_amdgcn_ds_read_tr16_b64_v4i16((LAS s16x4*)p)); }
DI int opaque_tid() { int t = threadIdx.x; asm volatile("" : "+v"(t)); return t; }
DI void lds_barrier() { asm volatile("s_waitcnt lgkmcnt(0)" ::: "memory"); __builtin_amdgcn_s_barrier(); asm volatile("" ::: "memory"); }
DI void lds_fence() { asm volatile("s_waitcnt lgkmcnt(0)" ::: "memory"); __builtin_amdgcn_wave_barrier(); }

__host__ __device__ __forceinline__ int phys_col(int n) { return (n & ~255) + 128 * ((n >> 5) & 1) + 32 * ((n >> 6) & 3) + (n & 31); }
DI int map_even(int n) { return n < 1216 ? n : (n < 1224 ? 3008 + (n - 1216) : n - 8); }
DI void transpose_tile(const float* W, int K, int N, bf16* WT, int mapmode, int tile, float* scr, const float* kgain = nullptr) {
  const int tid = opaque_tid();
  const int ntn = (N + 63) >> 6, kt = tile / ntn, nt = tile % ntn, k0 = kt * 64, n0 = nt * 64;
#pragma unroll
  for (int i = 0; i < 8; ++i) {
    const int kk = (tid >> 6) + 8 * i, nn = tid & 63, n = n0 + nn;
    scr[kk * 65 + nn] = (n < N) ? W[(size_t)(k0 + kk) * N + n] * (kgain ? kgain[k0 + kk] : 1.f) : 0.f;
  }
  __syncthreads();
  {
    const int nn = tid >> 3, kc = tid & 7, n = n0 + nn;
    if (n < N) {
      const int dst = mapmode == 1 ? phys_col(map_even(n)) : (mapmode == 2 ? phys_col(n) : n);
      const float* s = scr + (kc * 8) * 65 + nn;
      u32x4 o; o.x = cvtpk(s[0], s[65]); o.y = cvtpk(s[2 * 65], s[3 * 65]); o.z = cvtpk(s[4 * 65], s[5 * 65]); o.w = cvtpk(s[6 * 65], s[7 * 65]);
      *(u32x4*)(WT + (size_t)dst * K + k0 + kc * 8) = o;
    }
  }
  __syncthreads();
}

DI float wave_sum(float v) {
#pragma unroll
  for (int o = 1; o < 64; o <<= 1) v += __shfl_xor(v, o);
  return v;
}

DI void phase_prologue(const Params& p, char* lds) {
  const int tid = opaque_tid(), lane = tid & 63, wid = tid >> 6;
  const int nb = gridDim.x, bid = blockIdx.x;
  unsigned char* ws = p.ws;
  float* scr = (float*)lds;
  const int T0 = 16 * 48, T1 = 256, T2 = 16 * 64, T3 = 256, T4 = 256, T5 = 256, T6 = 64, T7 = 64;
  const int NT = T0 + T1 + T2 + T3 + T4 + T5 + T6 + T7;
  for (int it = bid; it < NT; it += nb) {
    int r = it;
    if (r < T0) { transpose_tile(p.in[I_W_IN_EVEN], 1024, 3016, (bf16*)(ws + WS_WINE), 1, r, scr); continue; } r -= T0;
    if (r < T1) { transpose_tile(p.in[I_W_OUT_EVEN], 1024, 1024, (bf16*)(ws + WS_WOUTE), 0, r, scr); continue; } r -= T1;
    if (r < T2) { transpose_tile(p.in[I_W_IN_ODD], 1024, 4096, (bf16*)(ws + WS_WINO), 2, r, scr); continue; } r -= T2;
    if (r < T3) { transpose_tile(p.in[I_W_OUT_ODD], 1024, 1024, (bf16*)(ws + WS_WOUTO), 0, r, scr); continue; } r -= T3;
    if (r < T4) { transpose_tile(p.in[I_W_PLE_GATE], 1024, 1024, (bf16*)(ws + WS_WG0), 0, r, scr, p.in[I_PLE_NORM_GAIN]); continue; } r -= T4;
    if (r < T5) { transpose_tile(p.in[I_W_PLE_GATE] + 1024 * 1024, 1024, 1024, (bf16*)(ws + WS_WG1), 0, r, scr, p.in[I_PLE_NORM_GAIN] + DM); continue; } r -= T5;
    if (r < T6) { transpose_tile(p.in[I_W_PLE_PROJ], 256, 1024, (bf16*)(ws + WS_WP0), 0, r, scr); continue; } r -= T6;
    transpose_tile(p.in[I_W_PLE_PROJ] + 256 * 1024, 256, 1024, (bf16*)(ws + WS_WP1), 0, r, scr);
  }
  const int gt = bid * NTHREADS + tid, ngt = nb * NTHREADS;
  { unsigned* z = (unsigned*)(ws + WS_WINE); for (int i = gt; i < 56 * 512; i += ngt) z[(size_t)phys_col(3016 + (i >> 9)) * 512 + (i & 511)] = 0u; }
  { float* ss = (float*)(ws + WS_SS); for (int i = gt; i < 3 * NTOK; i += ngt) ss[i] = 0.f; }
  { float2* tab = (float2*)(ws + WS_ROPE);
    for (int i = gt; i < SEQ * 32; i += ngt) {
      const int pos = i >> 5, k = i & 31;
      const float ang = (float)pos * p.inv_freq[k];
      double rev = (double)ang * 0.15915494309189535; rev -= floor(rev);
      const float rf = (float)rev;
      tab[i] = make_float2(__builtin_amdgcn_cosf(rf), __builtin_amdgcn_sinf(rf));
    } }
  if (bid == 0 && wid == 0) {
    const float a = wave_sum(p.in[I_LQ1][lane] * p.in[I_LK1][lane]);
    const float b = wave_sum(p.in[I_LQ2][lane] * p.in[I_LK2][lane]);
    const float lambda_init = 0.8f - 0.6f * expf(-0.3f);
    if (lane == 0) *(float*)(ws + WS_LAM) = expf(a) - expf(b) + lambda_init;
  }
  { const float* x = p.in[I_X]; const float* g = p.in[I_NORM_GAIN]; bf16* H = (bf16*)(ws + WS_ACT);
    const int gw = bid * 8 + wid, ngw = nb * 8;
    for (int m = gw; m < NTOK; m += ngw) {
      const f32x4* xr = (const f32x4*)(x + (size_t)m * DM) + lane;
      f32x4 v[4]; float s = 0.f;
#pragma unroll
      for (int j = 0; j < 4; ++j) { v[j] = xr[64 * j]; s += v[j].x * v[j].x + v[j].y * v[j].y + v[j].z * v[j].z + v[j].w * v[j].w; }
      const float rstd = rsqrtf(wave_sum(s) * (1.f / DM) + EPS);
      u32x2* o = (u32x2*)(H + (size_t)m * DM) + lane;
#pragma unroll
      for (int j = 0; j < 4; ++j) { const f32x4 gg = *((const f32x4*)g + lane + 64 * j); u32x2 w; w.x = cvtpk(v[j].x * rstd * gg.x, v[j].y * rstd * gg.y); w.y = cvtpk(v[j].z * rstd * gg.z, v[j].w * rstd * gg.w); o[64 * j] = w; }
    } }
}

namespace pg8 {
#define PG8_LAS __attribute__((address_space(3)))
typedef unsigned short bf16_t;
typedef short bf16x8 __attribute__((ext_vector_type(8)));
typedef float f32x4 __attribute__((ext_vector_type(4)));
typedef unsigned u32x4 __attribute__((ext_vector_type(4)));
constexpr int BM = 256, BK = 64, HALF = 128, HTB = HALF * BK * 2  , STAGE_BYTES = 8 * HTB, NXCD = 8, WGM = 8;

__host__ __device__ __forceinline__ int lds_byte(int r, int c) { const int st = (r >> 4) * 2 + (c >> 5), rr = r & 15, cc = c & 31, ob = rr * 64 + cc * 2; return st * 1024 + (ob ^ (((ob >> 9) & 1) << 5)); }
__host__ __device__ __forceinline__ void stage_rc(int b, int& R, int& C) { const int st = b / 1024, sb = b % 1024, swz = sb ^ (((sb >> 9) & 1) << 5); R = (st >> 1) * 16 + swz / 64; C = (st & 1) * 32 + (swz % 64) / 2; }
__host__ __device__ __forceinline__ int perm32(int rho) { const int n = rho >> 4, i = rho & 15; return 8 * (i >> 2) + 4 * n + (i & 3); }

struct Unit { int pm, pn; };
struct Gemm { const bf16_t* A; const bf16_t* Bt; int M, N, K; };

struct StaticOrder {
    int nM, nN, nwg, G, c;
    __host__ __device__ void init(int M, int N, int G_, int c_) { nM = M / BM; nN = N / BM; nwg = nM * nN; G = G_; c = c_; }
    __host__ __device__ bool next(int i, Unit& u) const {
        const long L = (long)i * G + c; if (L >= nwg) return false;
        int wgid = (int)L; { const int q = nwg / NXCD, r = nwg % NXCD, xcd = wgid % NXCD, off = wgid / NXCD; wgid = (xcd < r ? xcd * (q + 1) : r * (q + 1) + (xcd - r) * q) + off; }
        const int nig = WGM * nN, gid = wgid / nig, fm = gid * WGM, gsz = (nM - fm) < WGM ? (nM - fm) : WGM;
        u.pm = fm + ((wgid % nig) % gsz); u.pn = (wgid % nig) / gsz; return true;
    }
    __device__ __forceinline__ void a_ready(const Unit&) const {}
    __device__ __forceinline__ void done(const Unit&) const {}
};
__device__ __forceinline__ unsigned cvt_pk_bf16(float lo, float hi) { unsigned r; asm volatile("v_cvt_pk_bf16_f32 %0, %1, %2" : "=v"(r) : "v"(lo), "v"(hi)); return r; }
template <class Epi, class Sched, bool ALIGN_EPI = false, bool SP2 = false>
__device__ __forceinline__ void gemm_phase(PG8_LAS unsigned char* lds, const Gemm g, const Sched& S, const Epi& E) {
    int tid_ = threadIdx.x; asm volatile("" : "+v"(tid_));
    const int tid = tid_, wid = __builtin_amdgcn_readfirstlane(tid >> 6), lane = tid & 63, wr = wid >> 2, wc = wid & 3, fr = lane & 15, fq = lane >> 4;
    const int K = g.K, nt = K / BK;
    unsigned voffA[2], voffB[2];
#pragma unroll
    for (int i = 0; i < 2; ++i) { int R, C; stage_rc(tid * 16 + i * 8192, R, C); const int Rb = Epi::PERM ? ((R & ~31) + perm32(R & 31)) : R;
        voffA[i] = (unsigned)(R * K + C) * 2u; voffB[i] = (unsigned)(Rb * K + C) * 2u; }
    const size_t kstep = (size_t)(BK * 2);
    const size_t hstep = (size_t)HALF * K * 2;
    const size_t tstep = 2 * hstep;
    const unsigned ldsw = (unsigned)wid * 1024u;
    const int aoff = lds_byte(wr * 64 + fr, fq * 8), boff = lds_byte(wc * 32 + fr, fq * 8);
#define PG8_SA(b, h) (((b) * 2 + (h)) * HTB)
#define PG8_SB(b, h) ((4 + (b) * 2 + (h)) * HTB)
#define PG8_STAGE(bufoff, gbase, voff) do { _Pragma("unroll") for (int _i = 0; _i < 2; ++_i) \
        __builtin_amdgcn_global_load_lds((const unsigned*)((const char*)(gbase) + (voff)[_i]), (PG8_LAS unsigned*)(lds + (bufoff) + ldsw + _i * 8192), 16, 0, 0); } while (0)
#define PG8_LDA(dst, b, h) do { _Pragma("unroll") for (int m = 0; m < 4; ++m) _Pragma("unroll") for (int k = 0; k < 2; ++k) dst[m][k] = *(const PG8_LAS bf16x8*)(lds + PG8_SA(b, h) + aoff + m * 2048 + k * 1024); } while (0)
#define PG8_LDB(dst, b, h) do { _Pragma("unroll") for (int n = 0; n < 2; ++n) _Pragma("unroll") for (int k = 0; k < 2; ++k) dst[n][k] = *(const PG8_LAS bf16x8*)(lds + PG8_SB(b, h) + boff + n * 2048 + k * 1024); } while (0)
#define PG8_MMA(ai, bj, At, Bt) do { __builtin_amdgcn_s_setprio(1); _Pragma("unroll") for (int m = 0; m < 4; ++m) _Pragma("unroll") for (int n = 0; n < 2; ++n) _Pragma("unroll") for (int k = 0; k < 2; ++k) \
        acc[ai][bj][m][n] = __builtin_amdgcn_mfma_f32_16x16x32_bf16(Bt[n][k], At[m][k], acc[ai][bj][m][n], 0, 0, 0); __builtin_amdgcn_s_setprio(0); } while (0)
#define PG8_WAIT_V(n) asm volatile("s_waitcnt vmcnt(" #n ")" ::: "memory")
#define PG8_WAIT_L(n) asm volatile("s_waitcnt lgkmcnt(" #n ")" ::: "memory")
#define PG8_BAR __builtin_amdgcn_s_barrier()
#define PG8_SCHED __builtin_amdgcn_sched_barrier(0)
    Unit cur, nxt; int ui = 0;
    if (!S.next(0, cur)) return;
    f32x4 acc[2][2][4][2];
#pragma unroll
    for (int a = 0; a < 2; ++a)
#pragma unroll
        for (int b = 0; b < 2; ++b)
#pragma unroll
            for (int m = 0; m < 4; ++m)
#pragma unroll
                for (int n = 0; n < 2; ++n) acc[a][b][m][n] = (f32x4){0.f, 0.f, 0.f, 0.f};
    bf16x8 At[4][2], B0[2][2], B1[2][2];
    const char* cA = (const char*)g.A + (size_t)cur.pm * tstep; const char* cB = (const char*)g.Bt + (size_t)cur.pn * tstep;
    S.a_ready(cur);
    if constexpr (SP2) {
        PG8_STAGE(PG8_SB(0, 0), cB, voffB); PG8_STAGE(PG8_SB(0, 1), cB + hstep, voffB); PG8_STAGE(PG8_SA(0, 0), cA, voffA); PG8_STAGE(PG8_SA(0, 1), cA + hstep, voffA);
        if (wr == 1) PG8_BAR;
        PG8_WAIT_V(2); PG8_BAR;
        PG8_STAGE(PG8_SB(1, 0), cB + kstep, voffB); PG8_STAGE(PG8_SA(1, 0), cA + kstep, voffA); PG8_STAGE(PG8_SB(1, 1), cB + hstep + kstep, voffB);
        PG8_WAIT_V(6); PG8_BAR;
    } else {
        PG8_STAGE(PG8_SB(0, 0), cB, voffB); PG8_STAGE(PG8_SA(0, 0), cA, voffA); PG8_STAGE(PG8_SB(0, 1), cB + hstep, voffB); PG8_STAGE(PG8_SA(0, 1), cA + hstep, voffA);
        if (wr == 1) PG8_BAR;
        PG8_WAIT_V(4); PG8_BAR;
        PG8_STAGE(PG8_SB(1, 0), cB + kstep, voffB); PG8_STAGE(PG8_SA(1, 0), cA + kstep, voffA); PG8_STAGE(PG8_SB(1, 1), cB + hstep + kstep, voffB);
        PG8_WAIT_V(6); PG8_BAR;
    }
    for (;;) {
        const bool has_next = S.next(ui + 1, nxt);
        const char* nA = has_next ? (const char*)g.A + (size_t)nxt.pm * tstep : cA; const char* nB = has_next ? (const char*)g.Bt + (size_t)nxt.pn * tstep : cB;
        for (int t = 0; t < nt; t += 2) {
            const bool last = (t == nt - 2);
            const char* a1 = cA + (size_t)(t + 1) * kstep;
            const char* a2 = last ? nA : cA + (size_t)(t + 2) * kstep; const char* b2 = last ? nB : cB + (size_t)(t + 2) * kstep;
            const char* a3 = a2 + kstep; const char* b3 = b2 + kstep;
            if (last && has_next) S.a_ready(nxt);
            if constexpr (SP2) {
            PG8_LDB(B0, 0, 0); PG8_LDB(B1, 0, 1); PG8_SCHED; PG8_LDA(At, 0, 0); PG8_STAGE(PG8_SA(1, 1), a1 + hstep, voffA);
            PG8_WAIT_V(8); PG8_WAIT_L(0); PG8_BAR; PG8_MMA(0, 0, At, B0); PG8_MMA(0, 1, At, B1); PG8_BAR; PG8_SCHED;
            PG8_LDA(At, 0, 1); PG8_STAGE(PG8_SB(0, 0), b2, voffB); PG8_STAGE(PG8_SB(0, 1), b2 + hstep, voffB); PG8_STAGE(PG8_SA(0, 0), a2, voffA);
            PG8_WAIT_V(8); PG8_WAIT_L(0); PG8_BAR; PG8_MMA(1, 0, At, B0); PG8_MMA(1, 1, At, B1); PG8_BAR; PG8_SCHED;
            PG8_LDB(B0, 1, 0); PG8_LDB(B1, 1, 1); PG8_SCHED; PG8_LDA(At, 1, 0); PG8_STAGE(PG8_SA(0, 1), a2 + hstep, voffA);
            PG8_WAIT_V(8); PG8_WAIT_L(0); PG8_BAR; PG8_MMA(0, 0, At, B0); PG8_MMA(0, 1, At, B1); PG8_BAR; PG8_SCHED;
            PG8_LDA(At, 1, 1); PG8_STAGE(PG8_SB(1, 0), b3, voffB); PG8_STAGE(PG8_SB(1, 1), b3 + hstep, voffB); PG8_STAGE(PG8_SA(1, 0), a3, voffA);
            PG8_WAIT_V(8); PG8_WAIT_L(0); PG8_BAR; PG8_MMA(1, 0, At, B0); PG8_MMA(1, 1, At, B1); PG8_BAR; PG8_SCHED;
            } else {
            PG8_LDB(B0, 0, 0); PG8_SCHED; PG8_LDA(At, 0, 0); PG8_STAGE(PG8_SA(1, 1), a1 + hstep, voffA);
            PG8_WAIT_L(8); PG8_BAR; PG8_WAIT_L(0); PG8_MMA(0, 0, At, B0); PG8_BAR; PG8_SCHED;
            PG8_LDB(B1, 0, 1); PG8_STAGE(PG8_SB(0, 0), b2, voffB);
            PG8_BAR; PG8_WAIT_L(0); PG8_MMA(0, 1, At, B1); PG8_BAR;
            PG8_LDA(At, 0, 1); PG8_STAGE(PG8_SA(0, 0), a2, voffA);
            PG8_BAR; PG8_WAIT_L(0); PG8_MMA(1, 0, At, B0); PG8_BAR; PG8_SCHED;
            PG8_STAGE(PG8_SB(0, 1), b2 + hstep, voffB);
            PG8_WAIT_V(6); PG8_BAR; PG8_MMA(1, 1, At, B1); PG8_BAR;
            PG8_LDB(B0, 1, 0); PG8_SCHED; PG8_LDA(At, 1, 0); PG8_STAGE(PG8_SA(0, 1), a2 + hstep, voffA);
            PG8_WAIT_L(8); PG8_BAR; PG8_WAIT_L(0); PG8_MMA(0, 0, At, B0); PG8_BAR; PG8_SCHED;
            PG8_LDB(B1, 1, 1); PG8_STAGE(PG8_SB(1, 0), b3, voffB);
            PG8_BAR; PG8_WAIT_L(0); PG8_MMA(0, 1, At, B1); PG8_BAR;
            PG8_LDA(At, 1, 1); PG8_STAGE(PG8_SA(1, 0), a3, voffA);
            PG8_BAR; PG8_WAIT_L(0); PG8_MMA(1, 0, At, B0); PG8_BAR; PG8_SCHED;
            PG8_STAGE(PG8_SB(1, 1), b3 + hstep, voffB);
            PG8_WAIT_V(6); PG8_BAR; PG8_MMA(1, 1, At, B1); PG8_BAR;
            }
        }
        if constexpr (ALIGN_EPI) { if (wr == 0) PG8_BAR; }
        if constexpr (!Epi::AFTER_DRAIN) { E(acc, cur, wr, wc, fr, fq); S.done(cur); }
        if (!has_next) break;
#pragma unroll
        for (int a = 0; a < 2; ++a)
#pragma unroll
            for (int b = 0; b < 2; ++b)
#pragma unroll
                for (int m = 0; m < 4; ++m)
#pragma unroll
                    for (int n = 0; n < 2; ++n) acc[a][b][m][n] = (f32x4){0.f, 0.f, 0.f, 0.f};
        cur = nxt; cA = nA; cB = nB; ++ui;
        if constexpr (ALIGN_EPI) { if (wr == 1) PG8_BAR; }
    }
    PG8_WAIT_V(0);
    if constexpr (!ALIGN_EPI) { if (wr == 0) PG8_BAR; }
    PG8_BAR;
    if constexpr (Epi::AFTER_DRAIN) { E.fused(acc, cur, wr, wc, fr, fq, lds, wid, lane); S.done(cur); }
#undef PG8_SA
#undef PG8_SB
#undef PG8_STAGE
#undef PG8_LDA
#undef PG8_LDB
#undef PG8_MMA
#undef PG8_WAIT_V
#undef PG8_WAIT_L
#undef PG8_BAR
#undef PG8_SCHED
}
}

enum { T_PLAIN = 0, T_NR = 1, T_ROPE = 2, T_SILU = 3, T_IW = 4 };
DI void slot_info(const Params& p, int layer, int slot, int& type, const float*& gain) {
  gain = nullptr;
  if (layer == 0) {
    if (slot < 8) { type = T_NR; gain = p.in[I_A_Q_GAIN]; }
    else if (slot == 8) { type = T_NR; gain = p.in[I_A_K_GAIN]; }
    else if (slot == 9) type = T_PLAIN;
    else if (slot < 18) type = T_ROPE;
    else if (slot == 18) { type = T_NR; gain = p.in[I_IDX_K_GAIN]; }
    else if (slot < 27) type = T_SILU;
    else if (slot < 35) { type = T_NR; gain = p.in[I_B_Q_GAIN]; }
    else if (slot < 37) { type = T_NR; gain = p.in[I_B_K_GAIN]; }
    else if (slot < 39) type = T_PLAIN;
    else if (slot < 47) type = T_SILU;
    else type = T_IW;
  } else {
    if (slot < 8) { type = T_NR; gain = p.in[I_C_Q_GAIN]; }
    else if (slot < 16) { type = T_NR; gain = p.in[I_C_K_GAIN]; }
    else if (slot < 24) type = T_PLAIN;
    else if (slot < 32) type = T_SILU;
    else if (slot < 40) { type = T_NR; gain = p.in[I_D_Q_GAIN]; }
    else if (slot < 48) { type = T_NR; gain = p.in[I_D_K_GAIN]; }
    else if (slot < 56) type = T_PLAIN;
    else type = T_SILU;
  }
}
constexpr int E_AQ = 0, E_AK = 512, E_AV = 576, E_IQ = 640, E_IK = 1152, E_AG = 1216, E_BQ = 1728, E_BK = 2240, E_BV = 2368, E_BG = 2496;
constexpr int O_CQ = 0, O_CK = 512, O_CV = 1024, O_CG = 1536, O_DQ = 2048, O_DK = 2560, O_DV = 3072, O_DG = 3584;

typedef pg8::f32x4 (AccT)[2][2][4][2];

struct EpiInProj {
  static constexpr bool PERM = false, AFTER_DRAIN = false;
  const Params& p; int layer;
  DI void operator()(const f32x4 (&acc)[2][2][4][2], const pg8::Unit& u, int wr, int wc, int fr, int fq) const {
    unsigned char* ws = p.ws;
    const int NP = layer == 0 ? NPE : NPO;
    bf16* PE = (bf16*)(ws + WS_PE);
    const float2* rope = (const float2*)(ws + WS_ROPE);
    const float* ss1 = (const float*)(ws + WS_SS);
    float* IW = (float*)(ws + WS_IW);
    const int slot = u.pn * 4 + wc;
    int type; const float* gain; slot_info(p, layer, slot, type, gain);
#pragma unroll
    for (int ai = 0; ai < 2; ++ai)
#pragma unroll
      for (int m = 0; m < 4; ++m) {
        const int row = u.pm * 256 + ai * 128 + wr * 64 + m * 16 + fr, pos = row & (SEQ - 1);
        float sc = 1.f;
        if (layer == 1) sc = rsqrtf(ss1[row] * (1.f / DM) + EPS);
        f32x4 v1[2], v2[2];
#pragma unroll
        for (int n = 0; n < 2; ++n) { v1[n] = acc[ai][0][m][n] * sc; v2[n] = acc[ai][1][m][n] * sc; }
        if (type == T_NR) {
          float s = 0.f;
#pragma unroll
          for (int n = 0; n < 2; ++n) s += v1[n].x * v1[n].x + v1[n].y * v1[n].y + v1[n].z * v1[n].z + v1[n].w * v1[n].w + v2[n].x * v2[n].x + v2[n].y * v2[n].y + v2[n].z * v2[n].z + v2[n].w * v2[n].w;
          s += __shfl_xor(s, 16); s += __shfl_xor(s, 32);
          const float rn = rsqrtf(s * (1.f / 64.f) + EPS);
#pragma unroll
          for (int n = 0; n < 2; ++n) { const f32x4 g1 = *(const f32x4*)(gain + n * 16 + fq * 4), g2 = *(const f32x4*)(gain + 32 + n * 16 + fq * 4); v1[n] = v1[n] * rn * g1; v2[n] = v2[n] * rn * g2; }
        }
        if (type == T_NR || type == T_ROPE) {
#pragma unroll
          for (int n = 0; n < 2; ++n) {
            const f32x4* cs = (const f32x4*)(rope + (size_t)pos * 32 + n * 16 + fq * 4);
            const f32x4 c01 = cs[0], c23 = cs[1];
            const f32x4 x1 = v1[n], x2 = v2[n];
            f32x4 o1, o2;
            o1.x = x1.x * c01.x - x2.x * c01.y; o2.x = x2.x * c01.x + x1.x * c01.y;
            o1.y = x1.y * c01.z - x2.y * c01.w; o2.y = x2.y * c01.z + x1.y * c01.w;
            o1.z = x1.z * c23.x - x2.z * c23.y; o2.z = x2.z * c23.x + x1.z * c23.y;
            o1.w = x1.w * c23.z - x2.w * c23.w; o2.w = x2.w * c23.z + x1.w * c23.w;
            v1[n] = o1; v2[n] = o2;
          }
        }
        if (type == T_SILU) {
#pragma unroll
          for (int n = 0; n < 2; ++n)
#pragma unroll
            for (int j = 0; j < 4; ++j) { const float a = v1[n][j]; v1[n][j] = a / (1.f + __expf(-a)); const float b = v2[n][j]; v2[n][j] = b / (1.f + __expf(-b)); }
        }
        if (type == T_IW) {
          if (fq < 2) *(f32x4*)(IW + (size_t)row * 8 + fq * 4) = v1[0];
        } else {
          bf16* dst = PE + (size_t)row * NP + slot * 64 + fq * 4;
#pragma unroll
          for (int n = 0; n < 2; ++n) {
            u32x2 w1, w2; w1.x = cvtpk(v1[n].x, v1[n].y); w1.y = cvtpk(v1[n].z, v1[n].w); w2.x = cvtpk(v2[n].x, v2[n].y); w2.y = cvtpk(v2[n].z, v2[n].w);
            *(u32x2*)(dst + n * 16) = w1; *(u32x2*)(dst + 32 + n * 16) = w2;
            if (layer == 0 && slot == 18) { bf16* IKS = (bf16*)(ws + WS_IKS); const int key = row & (SEQ - 1);
              bf16* base = IKS + (((size_t)(row >> 13) * 256 + (key >> 5)) * 4) * 512 + ((fq >> 1) * 32 + (key & 31)) * 8 + (fq & 1) * 4;
              *(u32x2*)(base + (size_t)n * 512) = w1; *(u32x2*)(base + (size_t)(n + 2) * 512) = w2; }
          }
        }
        asm volatile("" ::: "memory");
      }
  }
};

DI void phase_inproj(const Params& p, int layer, char* lds) {
  unsigned char* ws = p.ws;
  const int NP = layer == 0 ? NPE : NPO;
  pg8::Gemm g{(const bf16*)(ws + (layer == 0 ? WS_ACT : WS_Y)), (const bf16*)(ws + (layer == 0 ? WS_WINE : WS_WINO)), NTOK, NP, DM};
  pg8::StaticOrder S; S.init(NTOK, NP, (int)gridDim.x, (int)blockIdx.x);
  EpiInProj E{p, layer};
  pg8::gemm_phase<EpiInProj, pg8::StaticOrder, true, true>((PG8_LAS unsigned char*)lds, g, S, E);
}

struct EpiOutProj {
  static constexpr bool PERM = false, AFTER_DRAIN = false;
  const float* xin; bf16* X1B; bf16* XG; const float* pg; float* ss;
  DI void operator()(const f32x4 (&acc)[2][2][4][2], const pg8::Unit& u, int wr, int wc, int fr, int fq) const {
#pragma unroll
    for (int ai = 0; ai < 2; ++ai)
#pragma unroll
      for (int m = 0; m < 4; ++m) {
        const int row = u.pm * 256 + ai * 128 + wr * 64 + m * 16 + fr; float rs = 0.f;
#pragma unroll
        for (int bj = 0; bj < 2; ++bj)
#pragma unroll
          for (int n = 0; n < 2; ++n) {
            const int col = u.pn * 256 + bj * 128 + wc * 32 + n * 16 + fq * 4; const size_t off = (size_t)row * DM + col;
            const f32x4 xn = *(const f32x4*)(xin + off) + acc[ai][bj][m][n];
            { u32x2 wx; wx.x = cvtpk(xn.x, xn.y); wx.y = cvtpk(xn.z, xn.w); *(u32x2*)(X1B + off) = wx; }
            rs += xn.x * xn.x + xn.y * xn.y + xn.z * xn.z + xn.w * xn.w;
          }
        rs += __shfl_xor(rs, 16); rs += __shfl_xor(rs, 32);
        if (fq == 0) atomicAdd(ss + row, rs);
        asm volatile("" ::: "memory");
      }
  }
};
DI void phase_outproj(const Params& p, int layer, char* lds) {
  unsigned char* ws = p.ws;
  pg8::Gemm g{(const bf16*)(ws + WS_Y), (const bf16*)(ws + (layer == 0 ? WS_WOUTE : WS_WOUTO)), NTOK, DM, DM};
  pg8::StaticOrder S; S.init(NTOK, DM, (int)gridDim.x, (int)blockIdx.x);
  EpiOutProj E{layer == 0 ? p.in[I_X] : p.out, (bf16*)(ws + WS_PE + 64 * MiB), (bf16*)(ws + WS_ACT), p.in[I_PLE_NORM_GAIN] + layer * DM, (float*)(ws + WS_SS) + (layer == 0 ? 1 : 2) * NTOK};
  pg8::gemm_phase<EpiOutProj, pg8::StaticOrder, true, true>((PG8_LAS unsigned char*)lds, g, S, E);
}

struct EpiPleProj {
  static constexpr bool PERM = false, AFTER_DRAIN = false;
  bf16* PT;
  DI void operator()(const f32x4 (&acc)[2][2][4][2], const pg8::Unit& u, int wr, int wc, int fr, int fq) const {
#pragma unroll
    for (int ai = 0; ai < 2; ++ai)
#pragma unroll
      for (int m = 0; m < 4; ++m) {
        const int row = u.pm * 256 + ai * 128 + wr * 64 + m * 16 + fr;
#pragma unroll
        for (int bj = 0; bj < 2; ++bj)
#pragma unroll
          for (int n = 0; n < 2; ++n) { const f32x4 a = acc[ai][bj][m][n]; u32x2 w; w.x = cvtpk(a.x, a.y); w.y = cvtpk(a.z, a.w); *(u32x2*)(PT + (size_t)row * DM + u.pn * 256 + bj * 128 + wc * 32 + n * 16 + fq * 4) = w; }
      }
  }
};
struct EpiPleGate {
  static constexpr bool PERM = false, AFTER_DRAIN = false;
  const bf16* PT; const bf16* X1B; float* out; const float* ssx; float* ss1; bf16* H; const float* ng1; int layer;
  DI void operator()(const f32x4 (&acc)[2][2][4][2], const pg8::Unit& u, int wr, int wc, int fr, int fq) const {
#pragma unroll
    for (int ai = 0; ai < 2; ++ai)
#pragma unroll
      for (int m = 0; m < 4; ++m) {
        const int row = u.pm * 256 + ai * 128 + wr * 64 + m * 16 + fr; float rs = 0.f;
        const float rstd = rsqrtf(ssx[row] * (1.f / DM) + EPS);
#pragma unroll
        for (int bj = 0; bj < 2; ++bj)
#pragma unroll
          for (int n = 0; n < 2; ++n) {
            const int col = u.pn * 256 + bj * 128 + wc * 32 + n * 16 + fq * 4; const size_t off = (size_t)row * DM + col;
            f32x4 g;
#pragma unroll
            for (int j = 0; j < 4; ++j) g[j] = 1.f / (1.f + __expf(-rstd * acc[ai][bj][m][n][j]));
            const u32x2 pw = *(const u32x2*)(PT + off); f32x4 pp; pp.x = __uint_as_float(pw.x << 16); pp.y = __uint_as_float(pw.x & 0xffff0000u); pp.z = __uint_as_float(pw.y << 16); pp.w = __uint_as_float(pw.y & 0xffff0000u);
            const u32x2 xw = *(const u32x2*)(X1B + off); f32x4 x1; x1.x = __uint_as_float(xw.x << 16); x1.y = __uint_as_float(xw.x & 0xffff0000u); x1.z = __uint_as_float(xw.y << 16); x1.w = __uint_as_float(xw.y & 0xffff0000u);
            const f32x4 xn = x1 + pp * g;
            *(f32x4*)(out + off) = xn;
            if (layer == 0) {
              rs += xn.x * xn.x + xn.y * xn.y + xn.z * xn.z + xn.w * xn.w;
              const f32x4 gg = *(const f32x4*)(ng1 + col);
              u32x2 w; w.x = cvtpk(xn.x * gg.x, xn.y * gg.y); w.y = cvtpk(xn.z * gg.z, xn.w * gg.w); *(u32x2*)(H + off) = w;
            }
          }
        if (layer == 0) { rs += __shfl_xor(rs, 16); rs += __shfl_xor(rs, 32); if (fq == 0) atomicAdd(ss1 + row, rs); }
        asm volatile("" ::: "memory");
      }
  }
};
DI void phase_ple(const Params& p, int layer, char* lds) {
  unsigned char* ws = p.ws;
  bf16* PT = (bf16*)(ws + WS_PE);
  pg8::StaticOrder S; S.init(NTOK, DM, (int)gridDim.x, (int)blockIdx.x);
  { pg8::Gemm g{(const bf16*)(ws + WS_PBF) + (size_t)layer * NTOK * 256, (const bf16*)(ws + (layer == 0 ? WS_WP0 : WS_WP1)), NTOK, DM, 256};
    EpiPleProj E{PT};
    pg8::gemm_phase<EpiPleProj, pg8::StaticOrder, true, true>((PG8_LAS unsigned char*)lds, g, S, E); }
  { pg8::Gemm g{(const bf16*)(ws + WS_PE + 64 * MiB), (const bf16*)(ws + (layer == 0 ? WS_WG0 : WS_WG1)), NTOK, DM, DM};
    EpiPleGate E{PT, (const bf16*)(ws + WS_PE + 64 * MiB), p.out, (const float*)(ws + WS_SS) + (layer == 0 ? 1 : 2) * NTOK, (float*)(ws + WS_SS), (bf16*)(ws + WS_Y), p.in[I_NORM_GAIN] + DM, layer};
    pg8::gemm_phase<EpiPleGate, pg8::StaticOrder, true, true>((PG8_LAS unsigned char*)lds, g, S, E); }
}

DI float half_max(float v) { auto rr = __builtin_amdgcn_permlane32_swap(__float_as_uint(v), __float_as_uint(v), false, false); return fmaxf(__uint_as_float(rr[0]), __uint_as_float(rr[1])); }
template <int DVB, bool MASKED = true>
DI void attn_step32(const bf16* Kt, int KP, const bf16* Vt, int VP, const bf16x8 (&qf)[4], f32x16 (&o)[DVB], float& m, float& l, unsigned vmask, float c2, int lane) {
  const int r32 = lane & 31, h = lane >> 5;
  f32x16 s;
#pragma unroll
  for (int i = 0; i < 16; ++i) s[i] = 0.f;
#pragma unroll
  for (int t = 0; t < 4; ++t) { const bf16x8 kf = *(const bf16x8*)(Kt + r32 * KP + t * 16 + h * 8); s = mfma32(kf, qf[t], s); }
  float mx = -INFINITY;
#pragma unroll
  for (int i = 0; i < 16; ++i) { if (MASKED) { s[i] = ((vmask >> i) & 1u) ? s[i] : -INFINITY; } mx = fmaxf(mx, s[i]); }
  mx = half_max(mx);
  const float mxs = mx * c2;
  if (__any(mxs > m + 6.f)) {
    const float mn = fmaxf(m, mxs);
    const float alpha = fexp2(m - mn); l *= alpha;
#pragma unroll
    for (int d = 0; d < DVB; ++d)
#pragma unroll
      for (int i = 0; i < 16; ++i) o[d][i] *= alpha;
    m = mn;
  }
  float ps = 0.f; const float negm = -m;
#pragma unroll
  for (int i = 0; i < 16; ++i) { const float pv = fexp2(__builtin_fmaf(s[i], c2, negm)); s[i] = pv; ps += pv; }
  l += ps;
  bf16x8 pf[2];
  { u32x4 a, b; a.x = cvtpk(s[0], s[1]); a.y = cvtpk(s[2], s[3]); a.z = cvtpk(s[4], s[5]); a.w = cvtpk(s[6], s[7]);
    b.x = cvtpk(s[8], s[9]); b.y = cvtpk(s[10], s[11]); b.z = cvtpk(s[12], s[13]); b.w = cvtpk(s[14], s[15]);
    pf[0] = __builtin_bit_cast(bf16x8, a); pf[1] = __builtin_bit_cast(bf16x8, b); }
  const int i16 = lane & 15, q = i16 >> 2, pp = i16 & 3, blk = (lane >> 4) & 1;
#pragma unroll
  for (int d = 0; d < DVB; ++d)
#pragma unroll
    for (int sk = 0; sk < 2; ++sk) {
      const s16x4 lo = trread(Vt + (16 * sk + 4 * h + q) * VP + 32 * d + 16 * blk + 4 * pp);
      const s16x4 hi = trread(Vt + (16 * sk + 8 + 4 * h + q) * VP + 32 * d + 16 * blk + 4 * pp);
      const bf16x8 vf = __builtin_shufflevector(lo, hi, 0, 1, 2, 3, 4, 5, 6, 7);
      o[d] = mfma32(vf, pf[sk], o[d]);
    }
}

DI unsigned row_range_mask(int lo, int hi) {
  lo = lo < 0 ? 0 : lo; hi = hi > 31 ? 31 : hi;
  if (hi < lo) return 0u;
  const unsigned upto_hi = (hi >= 31) ? 0xffffffffu : ((1u << (hi + 1)) - 1u);
  return upto_hi & ~((1u << lo) - 1u);
}
DI unsigned lane_rows(unsigned m32, int h) {
  const unsigned t = m32 >> (4 * h);
  return (t & 0xFu) | ((t >> 4) & 0xF0u) | ((t >> 8) & 0xF00u) | ((t >> 12) & 0xF000u);
}
constexpr int WP = 72;
constexpr int WAVE_LDS = 2 * 32 * WP * 2 + 512;

struct KVRegs { u32x4 k[4], v[4]; };
DI void kv_store(const KVRegs& R, bf16* Ks, bf16* Vs, int lane) {
#pragma unroll
  for (int i = 0; i < 4; ++i) { const int row = (lane >> 3) + 8 * i, ch = lane & 7; *(u32x4*)(Ks + row * WP + ch * 8) = R.k[i]; *(u32x4*)(Vs + row * WP + ch * 8) = R.v[i]; }
}

DI void band_load(KVRegs& R, const bf16* Kg, const bf16* Vg, int NP, int kstart, int dil, int roff, int lane) {
#pragma unroll
  for (int i = 0; i < 4; ++i) {
    const int row = (lane >> 3) + 8 * i, ch = lane & 7; int k = kstart + row; if (k < 0) k = 0;
    const size_t off = (size_t)(dil * k + roff) * NP + ch * 8;
    R.k[i] = *(const u32x4*)(Kg + off); R.v[i] = *(const u32x4*)(Vg + off);
  }
}
template <int DVB>
DI void band_run(const bf16* Kg, const bf16* Vg, int NP, int kbase, int nsteps, int dil, int roff, int qidx, int win,
                 const bf16x8 (&qf)[4], f32x16 (&o)[DVB], float& m, float& l, float c2, bf16* Ks, bf16* Vs, int lane) {
  const int h = lane >> 5;
  KVRegs R; band_load(R, Kg, Vg, NP, kbase, dil, roff, lane);
  for (int j = 0; j < nsteps; ++j) {
    lds_fence();
    kv_store(R, Ks, Vs, lane);
    lds_fence();
    if (j + 1 < nsteps) band_load(R, Kg, Vg, NP, kbase + 32 * (j + 1), dil, roff, lane);
    const int kb = kbase + 32 * j, lo_r = (qidx - win > 0 ? qidx - win : 0) - kb;
    const unsigned vm = lane_rows(row_range_mask(lo_r, qidx - kb), h);
    attn_step32<DVB>(Ks, WP, Vs, WP, qf, o, m, l, vm, c2, lane);
  }
}

DI void write_o64(const f32x16 (&o)[2], float linv, const bf16* gate_row, bf16* y_row, int h) {
#pragma unroll
  for (int d = 0; d < 2; ++d)
#pragma unroll
    for (int g = 0; g < 4; ++g) {
      const int dd = 32 * d + 8 * g + 4 * h;
      const u32x2 gv = *(const u32x2*)(gate_row + dd);
      const float g0 = __uint_as_float(gv.x << 16), g1 = __uint_as_float(gv.x & 0xffff0000u), g2 = __uint_as_float(gv.y << 16), g3 = __uint_as_float(gv.y & 0xffff0000u);
      u32x2 w; w.x = cvtpk(o[d][4 * g] * linv * g0, o[d][4 * g + 1] * linv * g1); w.y = cvtpk(o[d][4 * g + 2] * linv * g2, o[d][4 * g + 3] * linv * g3);
      *(u32x2*)(y_row + dd) = w;
    }
}

DI void load_q(bf16x8 (&qf)[4], const bf16* qrow, int h) {
#pragma unroll
  for (int t = 0; t < 4; ++t) qf[t] = *(const bf16x8*)(qrow + t * 16 + h * 8);
}
template <int DVB> DI void zero_o(f32x16 (&o)[DVB]) {
#pragma unroll
  for (int d = 0; d < DVB; ++d)
#pragma unroll
    for (int i = 0; i < 16; ++i) o[d][i] = 0.f;
}

DI void mixerB_tile(const Params& p, int item, bf16* Ks, bf16* Vs, int lane) {
  const bf16* PE = (const bf16*)(p.ws + WS_PE); bf16* Y = (bf16*)(p.ws + WS_Y);
  const int qblk = item & 255, head = (item >> 8) & 7, b = item >> 11;
  const int r32 = lane & 31, h = lane >> 5, q0 = qblk * 32, kvh = head >> 2;
  const size_t rowb = (size_t)b * SEQ;
  bf16x8 qf[4]; load_q(qf, PE + (rowb + q0 + r32) * NPE + E_BQ + head * 64, h);
  f32x16 o[2]; zero_o<2>(o);
  const float sink2 = p.in[I_B_SINKS][head] * LOG2E;
  float m = sink2, l = (h == 0) ? 1.f : 0.f;
  band_run<2>(PE + rowb * NPE + E_BK + kvh * 64, PE + rowb * NPE + E_BV + kvh * 64, NPE, q0 - 128, 5, 1, 0, q0 + r32, 127, qf, o, m, l, 0.125f * LOG2E, Ks, Vs, lane);
  l += __shfl_xor(l, 32);
  const size_t tok = rowb + q0 + r32;
  write_o64(o, 1.f / l, PE + tok * NPE + E_BG + head * 64, Y + tok * DM + 512 + head * 64, h);
}

DI void mixerC_tile(const Params& p, int item, bf16* Ks, bf16* Vs, int lane) {
  const bf16* PO = (const bf16*)(p.ws + WS_PE); bf16* Y = (bf16*)(p.ws + WS_Y);
  const int qt = item & 15, r16 = (item >> 4) & 15, head = (item >> 8) & 7, b = item >> 11;
  const int r32 = lane & 31, h = lane >> 5, qi0 = qt * 32;
  const size_t rowb = (size_t)b * SEQ;
  const int t = 16 * (qi0 + r32) + r16;
  bf16x8 qf[4]; load_q(qf, PO + (rowb + t) * NPO + O_CQ + head * 64, h);
  f32x16 o[2]; zero_o<2>(o);
  float m = -1e30f, l = 0.f;
  const bf16* Kg = PO + rowb * NPO + O_CK + head * 64; const bf16* Vg = PO + rowb * NPO + O_CV + head * 64;
  const float c2 = 0.125f * LOG2E;
  band_run<2>(Kg, Vg, NPO, qi0 - 128, 5, 16, r16, qi0 + r32, 128, qf, o, m, l, c2, Ks, Vs, lane);
  band_run<2>(Kg, Vg, NPO, 4 * qi0 + (r16 >> 2) - 128, 8, 4, r16 & 3, 4 * (qi0 + r32) + (r16 >> 2), 128, qf, o, m, l, c2, Ks, Vs, lane);
  band_run<2>(Kg, Vg, NPO, 16 * qi0 + r16 - 128, 20, 1, 0, t, 128, qf, o, m, l, c2, Ks, Vs, lane);
  l += __shfl_xor(l, 32);
  const size_t tok = rowb + t;
  write_o64(o, 1.f / l, PO + tok * NPO + O_CG + head * 64, Y + tok * DM + head * 64, h);
}

DI void attn_step16(const bf16* Kt, const bf16* Vt, const bf16x8 (&qf)[2], f32x4 (&o)[4], float& m, float& l, int nvalid  , float c2, int lane) {
  const int c = lane & 15, qd = lane >> 4;
  f32x4 s0 = {0.f, 0.f, 0.f, 0.f}, s1 = {0.f, 0.f, 0.f, 0.f};
#pragma unroll
  for (int ks = 0; ks < 2; ++ks) {
    const bf16x8 k0 = *(const bf16x8*)(Kt + c * WP + ks * 32 + qd * 8);
    const bf16x8 k1 = *(const bf16x8*)(Kt + (16 + c) * WP + ks * 32 + qd * 8);
    s0 = mfma16(k0, qf[ks], s0); s1 = mfma16(k1, qf[ks], s1);
  }
  float mx = -INFINITY;
#pragma unroll
  for (int j = 0; j < 4; ++j) { if (4 * qd + j >= nvalid) s0[j] = -INFINITY; if (16 + 4 * qd + j >= nvalid) s1[j] = -INFINITY; mx = fmaxf(mx, fmaxf(s0[j], s1[j])); }
  mx = fmaxf(mx, __shfl_xor(mx, 16)); mx = fmaxf(mx, __shfl_xor(mx, 32));
  const float mxs = mx * c2;
  if (__any(mxs > m + 6.f)) {
    const float mn = fmaxf(m, mxs); const float alpha = fexp2(m - mn); l *= alpha;
#pragma unroll
    for (int d = 0; d < 4; ++d) o[d] = o[d] * alpha;
    m = mn;
  }
  const float negm = -m; float ps = 0.f;
#pragma unroll
  for (int j = 0; j < 4; ++j) { s0[j] = fexp2(__builtin_fmaf(s0[j], c2, negm)); s1[j] = fexp2(__builtin_fmaf(s1[j], c2, negm)); ps += s0[j] + s1[j]; }
  l += ps;
  u32x4 pw; pw.x = cvtpk(s0[0], s0[1]); pw.y = cvtpk(s0[2], s0[3]); pw.z = cvtpk(s1[0], s1[1]); pw.w = cvtpk(s1[2], s1[3]);
  const bf16x8 pf = __builtin_bit_cast(bf16x8, pw);
  const int i16 = lane & 15, rq = i16 >> 2, pp = i16 & 3;
#pragma unroll
  for (int dt = 0; dt < 4; ++dt) {
    const s16x4 lo = trread(Vt + (4 * qd + rq) * WP + 16 * dt + 4 * pp);
    const s16x4 hi = trread(Vt + (16 + 4 * qd + rq) * WP + 16 * dt + 4 * pp);
    const bf16x8 vf = __builtin_shufflevector(lo, hi, 0, 1, 2, 3, 4, 5, 6, 7);
    o[dt] = mfma16(vf, pf, o[dt]);
  }
}

DI void mixerA_item(const Params& p, int item, bf16* Ks, bf16* Vs, int lane) {
  const bf16* PE = (const bf16*)(p.ws + WS_PE); bf16* Y = (bf16*)(p.ws + WS_Y);
  const unsigned short* SEL = (const unsigned short*)(p.ws + WS_SEL) + (size_t)item * 256;
  const int t = item & (SEQ - 1), b = item >> 13;
  const int c = lane & 15, qd = lane >> 4, head = c & 7;
  const size_t rowb = (size_t)b * SEQ;
  const int count = (t + 1 < 256) ? t + 1 : 256, nsteps = (count + 31) >> 5;
  bf16x8 qf[2];
#pragma unroll
  for (int ks = 0; ks < 2; ++ks) qf[ks] = *(const bf16x8*)(PE + (size_t)item * NPE + E_AQ + head * 64 + ks * 32 + qd * 8);
  f32x4 o[4];
#pragma unroll
  for (int d = 0; d < 4; ++d) o[d] = (f32x4){0.f, 0.f, 0.f, 0.f};
  float m = -1e30f, l = 0.f;
  const bf16* Kg = PE + rowb * NPE + E_AK; const bf16* Vg = PE + rowb * NPE + E_AV;
  KVRegs R;
  unsigned short* sel_l = (unsigned short*)(Vs + 32 * WP);
  lds_fence();
  *(u32x2*)(sel_l + 4 * lane) = *(const u32x2*)(SEL + 4 * lane);
  lds_fence();
#define A_LOAD(j) do { _Pragma("unroll") for (int i = 0; i < 4; ++i) { const int row = (lane >> 3) + 8 * i, ch = lane & 7, e = 32 * (j) + row; \
      const int tokk = (e < count) ? (int)sel_l[e] : 0; const size_t off = (size_t)tokk * NPE + ch * 8; R.k[i] = *(const u32x4*)(Kg + off); R.v[i] = *(const u32x4*)(Vg + off); } } while (0)
  A_LOAD(0);
  for (int j = 0; j < nsteps; ++j) {
    lds_fence();
    kv_store(R, Ks, Vs, lane);
    lds_fence();
    if (j + 1 < nsteps) A_LOAD(j + 1);
    attn_step16(Ks, Vs, qf, o, m, l, count - 32 * j, 0.125f * LOG2E, lane);
  }
#undef A_LOAD
  l += __shfl_xor(l, 16); l += __shfl_xor(l, 32);
  if (c < 8) {
    const float linv = 1.f / l;
    const bf16* gate_row = PE + (size_t)item * NPE + E_AG + head * 64; bf16* y_row = Y + (size_t)item * DM + head * 64;
#pragma unroll
    for (int dt = 0; dt < 4; ++dt) {
      const int dd = 16 * dt + 4 * qd;
      const u32x2 gv = *(const u32x2*)(gate_row + dd);
      const float g0 = __uint_as_float(gv.x << 16), g1 = __uint_as_float(gv.x & 0xffff0000u), g2 = __uint_as_float(gv.y << 16), g3 = __uint_as_float(gv.y & 0xffff0000u);
      u32x2 w; w.x = cvtpk(o[dt][0] * linv * g0, o[dt][1] * linv * g1); w.y = cvtpk(o[dt][2] * linv * g2, o[dt][3] * linv * g3);
      *(u32x2*)(y_row + dd) = w;
    }
  }
}

DI unsigned f2ord(float f) { f += 0.f; const unsigned u = __float_as_uint(f); return (u & 0x80000000u) ? ~u : (u | 0x80000000u); }
DI int block_excl_scan(int v, int* tmp, int* tot) {
  const int lane = threadIdx.x & 63, wid = threadIdx.x >> 6;
  int inc = v;
#pragma unroll
  for (int o = 1; o < 64; o <<= 1) { const int u = __shfl_up(inc, o); if (lane >= o) inc += u; }
  if (lane == 63) tmp[wid] = inc;
  __syncthreads();
  int base = 0, total = 0;
#pragma unroll
  for (int w = 0; w < 8; ++w) { const int x = tmp[w]; if (w < wid) base += x; total += x; }
  *tot = total;
  return base + inc - v;
}

DI float dpp_sum8(float v) {
  v += __builtin_bit_cast(float, __builtin_amdgcn_mov_dpp(__builtin_bit_cast(int, v), 0xB1, 0xF, 0xF, true));
  v += __builtin_bit_cast(float, __builtin_amdgcn_mov_dpp(__builtin_bit_cast(int, v), 0x4E, 0xF, 0xF, true));
  v += __builtin_bit_cast(float, __builtin_amdgcn_mov_dpp(__builtin_bit_cast(int, v), 0x141, 0xF, 0xF, true));
  return v;
}
DI void hist_find(const int* hist, int* misc, int need, int& digit, int& nneed, int& cnt) {
  const int tid = threadIdx.x;
  typedef int i32x4 __attribute__((ext_vector_type(4)));
  const i32x4 h0 = *(const i32x4*)(hist + tid * 8), h1 = *(const i32x4*)(hist + tid * 8 + 4);
  int hh[8] = {h0.x, h0.y, h0.z, h0.w, h1.x, h1.y, h1.z, h1.w}; int tot = 0;
#pragma unroll
  for (int k = 0; k < 8; ++k) tot += hh[k];
  int total; const int ex = block_excl_scan(tot, misc, &total);
  int above = total - ex - tot;
#pragma unroll
  for (int k = 7; k >= 0; --k) { const int c = hh[k]; if (above < need && above + c >= need) { misc[16] = tid * 8 + k; misc[17] = need - above; misc[18] = c; } above += c; }
  __syncthreads();
  digit = misc[16]; nneed = misc[17]; cnt = misc[18];
  __syncthreads();
}
DI unsigned long long mkcmp(float v, int idx) { return ((unsigned long long)f2ord(v) << 16) | ((unsigned long long)(8191 - idx) << 3); }
DI float ord2f(unsigned k) { return __uint_as_float((k & 0x80000000u) ? (k ^ 0x80000000u) : ~k); }
DI float half_sum(float v) { auto rr = __builtin_amdgcn_permlane32_swap(__float_as_uint(v), __float_as_uint(v), false, false); return __uint_as_float(rr[0]) + __uint_as_float(rr[1]); }

constexpr int CL_CAP = 512;
DI void select_slow(const float* scq, int n, unsigned short* out, float lo, float hi, int* hist, int* misc, unsigned long long* clist) {
  const int tid = opaque_tid();
    const float scale = (hi > lo) ? 4095.f / (hi - lo) : 0.f;
    for (int i = tid; i < 4096; i += 512) hist[i] = 0;
    if (tid == 0) misc[20] = 0;
    __syncthreads();
    float val[16]; int bin[16];
#pragma unroll
    for (int i = 0; i < 16; ++i) { const int idx = tid + 512 * i; const float v = (idx < n) ? scq[idx] : lo; val[i] = v;
      int bb = (int)((v - lo) * scale); bb = bb < 0 ? 0 : (bb > 4095 ? 4095 : bb); bin[i] = bb; if (idx < n) atomicAdd(&hist[bb], 1); }
    __syncthreads();
    int bstar, need, cnt;
    hist_find(hist, misc, 256, bstar, need, cnt);
    unsigned long long T = 0ull;
    if (cnt != need) {
      if (cnt <= CL_CAP) {
#pragma unroll
        for (int i = 0; i < 16; ++i) { const int idx = tid + 512 * i; if (idx < n && bin[i] == bstar) { const int slot = atomicAdd(&misc[20], 1); clist[slot] = mkcmp(val[i], idx); } }
        __syncthreads();
        if (tid < cnt) { const unsigned long long c = clist[tid]; int rank = 0; for (int jx = 0; jx < cnt; ++jx) rank += (clist[jx] > c) ? 1 : 0;
          if (rank == need - 1) { misc[21] = (int)(unsigned)(c & 0xffffffffull); misc[22] = (int)(unsigned)(c >> 32); } }
        __syncthreads();
        T = ((unsigned long long)(unsigned)misc[22] << 32) | (unsigned long long)(unsigned)misc[21];
      } else {
        unsigned long long prefix = 0ull; int shift = 36;
        for (int pass = 0; pass < 4; ++pass) {
          for (int i = tid; i < 4096; i += 512) hist[i] = 0;
          __syncthreads();
#pragma unroll
          for (int i = 0; i < 16; ++i) { const int idx = tid + 512 * i; if (idx < n && bin[i] == bstar) { const unsigned long long c = mkcmp(val[i], idx); if (pass == 0 || (c >> (shift + 12)) == prefix) atomicAdd(&hist[(int)((c >> shift) & 4095ull)], 1); } }
          __syncthreads();
          int digit, nneed, c2;
          hist_find(hist, misc, need, digit, nneed, c2);
          prefix = (prefix << 12) | (unsigned long long)digit; need = nneed;
          if (c2 == need) break;
          shift -= 12;
        }
        T = prefix << shift;
      }
    }
    int mycnt = 0; unsigned selm = 0;
#pragma unroll
    for (int i = 0; i < 16; ++i) { const int idx = tid + 512 * i;
      bool sel = false;
      if (idx < n) { if (bin[i] > bstar) sel = true; else if (bin[i] == bstar) sel = (mkcmp(val[i], idx) >= T); }
      if (sel) { ++mycnt; selm |= (1u << i); } }
    int total; int pos = block_excl_scan(mycnt, misc + 8, &total);
#pragma unroll
    for (int i = 0; i < 16; ++i) { if ((selm >> i) & 1u) { if (pos < 256) out[pos] = (unsigned short)(tid + 512 * i); ++pos; } }
    __syncthreads();
}

DI void sel_load_qw(const Params& p, int item, bf16x8 (&qf)[4], float (&wq)[16], int lane) {
  const bf16* PE = (const bf16*)(p.ws + WS_PE); const float* IW = (const float*)(p.ws + WS_IW);
  const int r32 = lane & 31, h = lane >> 5, b = item >> 11, t0 = (item & 2047) * 4; const size_t rowb = (size_t)b * SEQ;
  load_q(qf, PE + (rowb + t0 + (r32 >> 3)) * NPE + E_IQ + (r32 & 7) * 64, h);
#pragma unroll
  for (int q = 0; q < 4; ++q) { const f32x4 w4 = *(const f32x4*)(IW + (rowb + t0 + q) * 8 + 4 * h);
    wq[4 * q] = w4.x * 0.04419417382415922f; wq[4 * q + 1] = w4.y * 0.04419417382415922f; wq[4 * q + 2] = w4.z * 0.04419417382415922f; wq[4 * q + 3] = w4.w * 0.04419417382415922f; }
}
DI void selectA_item(const Params& p, int item, int next_item, char* lds, bf16x8 (&qf)[4], float (&wq)[16]) {
  const bf16* PE = (const bf16*)(p.ws + WS_PE);
  const float* IW = (const float*)(p.ws + WS_IW);
  unsigned short* SEL = (unsigned short*)(p.ws + WS_SEL);
  float* sc = (float*)lds;
  int* hist = (int*)(lds + 4 * 8192 * 4);
  int* misc = hist + 4096;
  unsigned* mm = (unsigned*)(misc + 24);
  unsigned long long* clist = (unsigned long long*)(misc + 96);
  const int tid = opaque_tid(), lane = tid & 63, wid = tid >> 6, r32 = lane & 31, h = lane >> 5;
  const int b = item >> 11, t0 = (item & 2047) * 4;
  const size_t rowb = (size_t)b * SEQ;
  const int nk = t0 + 4, ntile = (nk + 31) >> 5;
  const f32x4 pcv = ((const f32x4*)p.in[I_P])[(size_t)item * 512 + tid];
  if (tid < 4) { mm[tid * 2] = 0xFFFFFFFFu; mm[tid * 2 + 1] = 0u; }
  lds_barrier();
  const bf16* Kt = (const bf16*)(p.ws + WS_IKS) + (size_t)b * 256 * 2048 + lane * 8;
  {
    bf16x8 kf[4], kn[4];
#pragma unroll
    for (int t = 0; t < 4; ++t) { kf[t] = (bf16x8){0, 0, 0, 0, 0, 0, 0, 0}; kn[t] = kf[t]; }
    if (wid < ntile) {
#pragma unroll
      for (int t = 0; t < 4; ++t) kf[t] = *(const bf16x8*)(Kt + (size_t)wid * 2048 + t * 512);
    }
    float lo0 = INFINITY, hi0 = -INFINITY, lo1 = INFINITY, hi1 = -INFINITY;
    for (int kt = wid; kt < ntile; kt += 8) {
      if (kt + 8 < ntile) {
#pragma unroll
        for (int t = 0; t < 4; ++t) kn[t] = *(const bf16x8*)(Kt + (size_t)(kt + 8) * 2048 + t * 512);
      }
      f32x16 s;
#pragma unroll
      for (int i = 0; i < 16; ++i) s[i] = 0.f;
#pragma unroll
      for (int t = 0; t < 4; ++t) s = mfma32(qf[t], kf[t], s);
      float v[4];
#pragma unroll
      for (int q = 0; q < 4; ++q) {
        float a = wq[4 * q] * fmaxf(s[4 * q], 0.f);
#pragma unroll
        for (int jj = 1; jj < 4; ++jj) a += wq[4 * q + jj] * fmaxf(s[4 * q + jj], 0.f);
        v[q] = half_sum(a) + 0.f;
      }
      const float va = h ? v[2] : v[0], vb = h ? v[3] : v[1];
      const int key = kt * 32 + r32;
      sc[(2 * h) * 8192 + key] = va; sc[(2 * h + 1) * 8192 + key] = vb;
      lo0 = fminf(lo0, va); hi0 = fmaxf(hi0, va); lo1 = fminf(lo1, vb); hi1 = fmaxf(hi1, vb);
#pragma unroll
      for (int t = 0; t < 4; ++t) kf[t] = kn[t];
    }
    if (wid < ntile) {
#pragma unroll
      for (int o = 1; o < 32; o <<= 1) { lo0 = fminf(lo0, __shfl_xor(lo0, o)); hi0 = fmaxf(hi0, __shfl_xor(hi0, o)); lo1 = fminf(lo1, __shfl_xor(lo1, o)); hi1 = fmaxf(hi1, __shfl_xor(hi1, o)); }
      if (r32 == 0) { atomicMin(&mm[(2 * h) * 2], f2ord(lo0)); atomicMax(&mm[(2 * h) * 2 + 1], f2ord(hi0)); atomicMin(&mm[(2 * h + 1) * 2], f2ord(lo1)); atomicMax(&mm[(2 * h + 1) * 2 + 1], f2ord(hi1)); }
    }
  }
  if (next_item >= 0) sel_load_qw(p, next_item, qf, wq, lane);
  { u32x2 w; w.x = cvtpk(pcv.x, pcv.y); w.y = cvtpk(pcv.z, pcv.w); ((u32x2*)(p.ws + WS_PBF))[(size_t)item * 512 + tid] = w; }
  lds_barrier();
  {
    const int g = wid >> 1, gt = tid & 127, upper = wid & 1;
    const int t = t0 + g, n = t + 1;
    const bool big = n > 256;
    const float* scq = sc + g * 8192;
    unsigned short* out = SEL + (rowb + t) * 256;
    int* histq = hist + g * 1024;
    unsigned long long* clq = clist + g * 128;
    int* mq = misc + 32 + g * 8;
    const float lo = ord2f(mm[g * 2]), hi = ord2f(mm[g * 2 + 1]);
    const float scale = (hi > lo) ? 1023.f / (hi - lo) : 0.f;
    for (int i = gt; i < 1024; i += 128) histq[i] = 0;
    if (gt == 0) { mq[0] = 0; mq[6] = 0; }
    lds_barrier();
    float uu[64];
#pragma unroll
    for (int i = 0; i < 64; ++i) { const int idx = gt + 128 * i; const float v = (idx < n) ? scq[idx] : lo; const float u = (v - lo) * scale; uu[i] = u;
      if (big && idx < n) { int bb = (int)u; bb = bb > 1023 ? 1023 : bb; atomicAdd(&histq[bb], 1); } }
    lds_barrier();
    typedef int i32x4 __attribute__((ext_vector_type(4)));
    const i32x4 h0 = *(const i32x4*)(histq + gt * 8), h1 = *(const i32x4*)(histq + gt * 8 + 4);
    const int hh[8] = {h0.x, h0.y, h0.z, h0.w, h1.x, h1.y, h1.z, h1.w};
    int tot = 0;
#pragma unroll
    for (int k = 0; k < 8; ++k) tot += hh[k];
    int inc = tot;
#pragma unroll
    for (int o = 1; o < 64; o <<= 1) { const int ux = __shfl_down(inc, o); if (lane + o < 64) inc += ux; }
    if (lane == 0) misc[wid] = inc;
    lds_barrier();
    {
      int above = inc - tot + (upper ? 0 : misc[wid + 1]);
      if (big) {
#pragma unroll
        for (int k = 7; k >= 0; --k) { const int c = hh[k]; if (above < 256 && above + c >= 256) { mq[1] = gt * 8 + k; mq[2] = 256 - above; mq[3] = c; } above += c; }
      }
    }
    lds_barrier();
    const int bstar = mq[1], need = mq[2], cnt = mq[3];
    const float flo = (float)bstar, fhi = (bstar >= 1023) ? INFINITY : (float)(bstar + 1);
    const bool tie = big && cnt != need;
    if (tie) {
      if (cnt <= 128) {
#pragma unroll
        for (int i = 0; i < 64; ++i) { const int idx = gt + 128 * i; if (idx < n && uu[i] >= flo && uu[i] < fhi) { const int slot = atomicAdd(&mq[0], 1); clq[slot] = mkcmp(scq[idx], idx); } }
      } else if (gt == 0) mq[6] = 1;
    }
    lds_barrier();
    if (tie && cnt <= 128 && gt < cnt) { const unsigned long long c = clq[gt]; int rank = 0; for (int jx = 0; jx < cnt; ++jx) rank += (clq[jx] > c) ? 1 : 0;
      if (rank == need - 1) { mq[4] = (int)(unsigned)(c & 0xffffffffull); mq[5] = (int)(unsigned)(c >> 32); } }
    lds_barrier();
    const unsigned long long T = tie ? (((unsigned long long)(unsigned)mq[5] << 32) | (unsigned long long)(unsigned)mq[4]) : 0ull;
    const bool fast = big && !(tie && cnt > 128);
    unsigned long long selm = 0ull;
    if (fast) {
#pragma unroll
      for (int i = 0; i < 64; ++i) { const int idx = gt + 128 * i;
        if (idx < n) { const float u = uu[i]; bool sel = u >= fhi; if (!sel && u >= flo) sel = !tie || (mkcmp(scq[idx], idx) >= T); if (sel) selm |= (1ull << i); } }
    }
    const int mycnt = __popcll(selm);
    int pinc = mycnt;
#pragma unroll
    for (int o = 1; o < 64; o <<= 1) { const int ux = __shfl_up(pinc, o); if (lane >= o) pinc += ux; }
    if (lane == 63) misc[8 + wid] = pinc;
    lds_barrier();
    if (fast) {
      int pos = pinc - mycnt + (upper ? misc[8 + wid - 1] : 0);
      while (selm) { const int i = __ffsll((long long)selm) - 1; selm &= selm - 1ull; if (pos < 256) out[pos] = (unsigned short)(gt + 128 * i); ++pos; }
    } else if (!big) {
      for (int i = gt; i < n; i += 128) out[i] = (unsigned short)i;
    }
    lds_barrier();
  }
  for (int q = 0; q < 4; ++q) {
    if (misc[32 + q * 8 + 6]) { const int t = t0 + q; select_slow(sc + q * 8192, t + 1, SEL + (rowb + t) * 256, ord2f(mm[q * 2]), ord2f(mm[q * 2 + 1]), hist, misc, clist); }
  }
  lds_barrier();
}

constexpr int DKP = 72, DVP = 136;
constexpr int D_STAGE = (64 * DKP * 2 + 64 * DVP) * 2;
DI void mixerD_unit(const Params& p, int b, int head, int qb, char* lds) {
  const bf16* PO = (const bf16*)(p.ws + WS_PE); bf16* Y = (bf16*)(p.ws + WS_Y);
  const int tid = opaque_tid(), lane = tid & 63, wid = tid >> 6, r32 = lane & 31, h = lane >> 5;
  const int map = wid & 1, qsub = wid >> 1;
  const size_t rowb = (size_t)b * SEQ;
  const int qpos = 128 * qb + 32 * qsub + r32;
  bf16x8 qf[4]; load_q(qf, PO + (rowb + qpos) * NPO + O_DQ + (2 * head + map) * 64, h);
  f32x16 o[4]; zero_o<4>(o);
  float m = -1e30f, l = 0.f;
  const int nsteps = 2 * qb + 2;
  const bf16* K1g = PO + rowb * NPO + O_DK + (2 * head) * 64;
  const bf16* K2g = K1g + 64;
  const bf16* Vg = PO + rowb * NPO + O_DV + head * 128;
  u32x4 rk1, rk2, rv[2];
#define D_LOAD(j) do { const int row = tid >> 3, ch = tid & 7; const size_t off = (size_t)((j) * 64 + row) * NPO + ch * 8; rk1 = *(const u32x4*)(K1g + off); rk2 = *(const u32x4*)(K2g + off); \
    _Pragma("unroll") for (int i = 0; i < 2; ++i) { const int c = tid + 512 * i, vr = c >> 4, vc = c & 15; rv[i] = *(const u32x4*)(Vg + (size_t)((j) * 64 + vr) * NPO + vc * 8); } } while (0)
  __syncthreads();
  D_LOAD(0);
  for (int j = 0; j < nsteps; ++j) {
    char* st = lds + (j & 1) * D_STAGE;
    bf16* K1s = (bf16*)st; bf16* K2s = K1s + 64 * DKP; bf16* Vs = K2s + 64 * DKP;
    { const int row = tid >> 3, ch = tid & 7; *(u32x4*)(K1s + row * DKP + ch * 8) = rk1; *(u32x4*)(K2s + row * DKP + ch * 8) = rk2;
#pragma unroll
      for (int i = 0; i < 2; ++i) { const int c = tid + 512 * i, vr = c >> 4, vc = c & 15; *(u32x4*)(Vs + vr * DVP + vc * 8) = rv[i]; } }
    __syncthreads();
    if (j + 1 < nsteps) D_LOAD(j + 1);
    const bf16* Ks = map ? K2s : K1s;
#pragma unroll
    for (int sub = 0; sub < 2; ++sub) {
      const int k0 = j * 64 + sub * 32;
      if (k0 <= 128 * qb + 32 * qsub + 31) {
        if (k0 + 31 <= 128 * qb + 32 * qsub) {
          attn_step32<4, false>(Ks + sub * 32 * DKP, DKP, Vs + sub * 32 * DVP, DVP, qf, o, m, l, 0xffffu, 0.125f * LOG2E, lane);
        } else {
          unsigned vm = 0;
#pragma unroll
          for (int i = 0; i < 16; ++i) if (k0 + crow(i, h) <= qpos) vm |= (1u << i);
          attn_step32<4, true>(Ks + sub * 32 * DKP, DKP, Vs + sub * 32 * DVP, DVP, qf, o, m, l, vm, 0.125f * LOG2E, lane);
        }
      }
    }
  }
#undef D_LOAD
  l += __shfl_xor(l, 32);
  const float linv = 1.f / l;
  __syncthreads();
  float* xch = (float*)lds + qsub * 4096;
  if (map == 1) {
#pragma unroll
    for (int d = 0; d < 4; ++d)
#pragma unroll
      for (int i = 0; i < 16; ++i) xch[(d * 16 + i) * 64 + lane] = o[d][i] * linv;
  }
  __syncthreads();
  if (map == 0) {
    const float lam = *(const float*)(p.ws + WS_LAM);
    float ssq = 0.f;
#pragma unroll
    for (int d = 0; d < 4; ++d)
#pragma unroll
      for (int i = 0; i < 16; ++i) { const float a = o[d][i] * linv - lam * xch[(d * 16 + i) * 64 + lane]; o[d][i] = a; ssq += a * a; }
    ssq += __shfl_xor(ssq, 32);
    const float lambda_init = 0.8f - 0.6f * expf(-0.3f);
    const float rn = rsqrtf(ssq * (1.f / 128.f) + EPS) * (1.f - lambda_init);
    const size_t tok = rowb + qpos;
    const bf16* gate = PO + tok * NPO + O_DG + head * 128;
    bf16* y = Y + tok * DM + 512 + head * 128;
    const float* sg = p.in[I_SUB_GAIN];
#pragma unroll
    for (int d = 0; d < 4; ++d)
#pragma unroll
      for (int g = 0; g < 4; ++g) {
        const int dd = 32 * d + 8 * g + 4 * h;
        const u32x2 gv = *(const u32x2*)(gate + dd); const f32x4 s4 = *(const f32x4*)(sg + dd);
        const float g0 = __uint_as_float(gv.x << 16), g1 = __uint_as_float(gv.x & 0xffff0000u), g2 = __uint_as_float(gv.y << 16), g3 = __uint_as_float(gv.y & 0xffff0000u);
        u32x2 w; w.x = cvtpk(o[d][4 * g] * rn * s4.x * g0, o[d][4 * g + 1] * rn * s4.y * g1); w.y = cvtpk(o[d][4 * g + 2] * rn * s4.z * g2, o[d][4 * g + 3] * rn * s4.w * g3);
        *(u32x2*)(y + dd) = w;
      }
  }
  __syncthreads();
}

#define XB_TMO      128
#define XB_XCNT(j)  (256  + 64 * (j))
#define XB_XSUB(j)  (1280 + 64 * (j))
#define XB_XGEN(j)  (2304 + 64 * (j))
#define XB_TOP      3328
#define XB_TOPGEN   3392
#define XCD_BAR_WORDS 3456
#define XB_SPIN_CAP (1u << 18)

__device__ __forceinline__ unsigned xb_ld(unsigned* p)              { return __hip_atomic_load(p, __ATOMIC_RELAXED, __HIP_MEMORY_SCOPE_AGENT); }
__device__ __forceinline__ unsigned xb_add(unsigned* p, unsigned v) { return __hip_atomic_fetch_add(p, v, __ATOMIC_RELAXED, __HIP_MEMORY_SCOPE_AGENT); }
__device__ __forceinline__ unsigned xb_xcc_id() { return (unsigned)__builtin_amdgcn_s_getreg((3 << 11) | 20) & 0xFu; }
#define XB_SPIN(cond, bar) do { unsigned _sp = 0; while (cond) { __builtin_amdgcn_s_sleep(1); \
    if ((++_sp & 255u) == 0u) { if (xb_ld(&(bar)[XB_TMO])) break; if (_sp > XB_SPIN_CAP) { atomicAdd(&(bar)[XB_TMO], 1u); break; } } } } while (0)

struct XcdBarrier {
    unsigned* bar; unsigned x;
    volatile LAS unsigned* st;
};

__device__ __forceinline__ XcdBarrier xcd_barrier_post(unsigned* bar, volatile LAS unsigned* st) {
    XcdBarrier b; b.bar = bar; b.x = xb_xcc_id(); b.st = st;
    if (threadIdx.x == 0) (void)xb_add(&bar[XB_XCNT(b.x)], 1u);
    return b;
}
__device__ __forceinline__ void xcd_barrier_complete(unsigned* bar, unsigned x, unsigned& nloc, unsigned& nx) {
    const unsigned G = gridDim.x * gridDim.y * gridDim.z;
    unsigned sum, cnt, mine, sp = 0u;
    for (;;) {
        sum = 0u; cnt = 0u; mine = 0u;
#pragma unroll
        for (unsigned j = 0; j < 16; ++j) { const unsigned c = xb_ld(&bar[XB_XCNT(j)]); sum += c; cnt += (c > 0u) ? 1u : 0u; mine = (j == x) ? c : mine; }
        if (sum == G) break;
        __builtin_amdgcn_s_sleep(1);
        if ((++sp & 255u) == 0u) { if (xb_ld(&bar[XB_TMO])) break; if (sp > XB_SPIN_CAP) { atomicAdd(&bar[XB_TMO], 1u); break; } }
    }
    nloc = mine > 0u ? mine : 1u; nx = cnt > 0u ? cnt : 1u;
}

__device__ __forceinline__ void xcd_barrier(const XcdBarrier& b) {
    asm volatile("s_waitcnt vmcnt(0)" ::: "memory");
    __syncthreads();
    if (threadIdx.x == 0) {
        unsigned* bar = b.bar;
        __builtin_amdgcn_s_waitcnt(0);
        unsigned nloc = b.st[0], nx = b.st[1];
        if (nloc == 0u) { xcd_barrier_complete(bar, b.x, nloc, nx); b.st[0] = nloc; b.st[1] = nx; }
        const unsigned old = xb_add(&bar[XB_XSUB(b.x)], 1u);
        const unsigned gen = old / nloc;
        if (old + 1u == (gen + 1u) * nloc) {
            __builtin_amdgcn_fence(__ATOMIC_RELEASE, "agent");
            asm volatile("s_waitcnt vmcnt(0)" ::: "memory");
            const unsigned og = xb_add(&bar[XB_TOP], 1u);
            const unsigned tg = og / nx;
            if (og + 1u == (tg + 1u) * nx) xb_add(&bar[XB_TOPGEN], 1u);
            else XB_SPIN(xb_ld(&bar[XB_TOPGEN]) == tg, bar);
            __builtin_amdgcn_fence(__ATOMIC_ACQUIRE, "agent");
            xb_add(&bar[XB_XGEN(b.x)], 1u);
            asm volatile("s_waitcnt vmcnt(0)" ::: "memory");
        } else {
            XB_SPIN(xb_ld(&bar[XB_XGEN(b.x)]) == gen, bar);
            __builtin_amdgcn_fence(__ATOMIC_ACQUIRE, "agent");
            asm volatile("s_waitcnt vmcnt(0)" ::: "memory");
        }
    }
    __syncthreads();
}


__global__ void __launch_bounds__(NTHREADS) fwd_kernel(Params p) {
  extern __shared__ __attribute__((aligned(16))) char smem[];
  cg::grid_group grid = cg::this_grid();
  char* lds = smem;
  volatile LAS unsigned* xb_st = (volatile LAS unsigned*)((LAS char*)smem + (LDS_BYTES - 16));
  if (threadIdx.x < 2) xb_st[threadIdx.x] = 0u;
  __syncthreads();
  const XcdBarrier xbar = xcd_barrier_post((unsigned*)(p.ws + WS_BAR), xb_st);
#define FRESH_IDS const int tid = opaque_tid(), lane = tid & 63, wid = tid >> 6; const int gw = blockIdx.x * 8 + wid, ngw = gridDim.x * 8; bf16* Ks = (bf16*)(lds + wid * WAVE_LDS); bf16* Vs = Ks + 32 * WP; (void)gw; (void)ngw; (void)Ks; (void)Vs; (void)lane;

  phase_prologue(p, lds);
  if (p.ws == nullptr) grid.sync();
  xcd_barrier(xbar);
  for (int rep = 0; rep < REP_GEMM; ++rep) phase_inproj(p, 0, lds);
  xcd_barrier(xbar);
#if EN_A
  for (int rep = 0; rep < REP_SELA; ++rep) { FRESH_IDS
#define SEL_ITEM(k) ((k) * (int)gridDim.x + (((k) & 1) ? (int)gridDim.x - 1 - (int)blockIdx.x : (int)blockIdx.x))
    bf16x8 sqf[4]; float swq[16];
    if (SEL_ITEM(0) < 2 * 2048) sel_load_qw(p, SEL_ITEM(0), sqf, swq, lane);
    for (int k = 0; k * (int)gridDim.x < 2 * 2048; ++k) { const int it = SEL_ITEM(k); int nx = SEL_ITEM(k + 1); if (nx >= 2 * 2048) nx = -1; if (it < 2 * 2048) selectA_item(p, it, nx, lds, sqf, swq); }
#undef SEL_ITEM
  }
  __syncthreads();
  { FRESH_IDS
#define SEL_ITEM(k) ((k) * (int)gridDim.x + (((k) & 1) ? (int)gridDim.x - 1 - (int)blockIdx.x : (int)blockIdx.x))
    const int nK = (2 * 2048 + (int)gridDim.x - 1) / (int)gridDim.x;
    for (int rep = 0; rep < REP_AATT; ++rep)
      for (int s2 = wid; s2 < nK * 4; s2 += 8) { const int it = SEL_ITEM(s2 >> 2); if (it < 2 * 2048) mixerA_item(p, (it >> 11) * SEQ + (it & 2047) * 4 + (s2 & 3), Ks, Vs, lane); }
#undef SEL_ITEM
  }
#else
  { unsigned* y = (unsigned*)(p.ws + WS_Y); for (int i = blockIdx.x * NTHREADS + (int)threadIdx.x; i < NTOK * 256; i += gridDim.x * NTHREADS) { const int row = i >> 8, c = i & 255; y[row * 512 + c] = 0u; } }
#endif
#if EN_B
  { FRESH_IDS const int vb = (gridDim.x % 8 == 0) ? (int)((blockIdx.x & 7) * (gridDim.x >> 3) + (blockIdx.x >> 3)) : (int)blockIdx.x;
    for (int it = vb * 8 + wid; it < 4096; it += ngw) mixerB_tile(p, it, Ks, Vs, lane); }
#else
  { unsigned* y = (unsigned*)(p.ws + WS_Y); for (int i = blockIdx.x * NTHREADS + (int)threadIdx.x; i < NTOK * 256; i += gridDim.x * NTHREADS) { const int row = i >> 8, c = i & 255; y[row * 512 + 256 + c] = 0u; } }
#endif
  xcd_barrier(xbar);
  phase_outproj(p, 0, lds);
  xcd_barrier(xbar);
  phase_ple(p, 0, lds);
  xcd_barrier(xbar);
  phase_inproj(p, 1, lds);
  xcd_barrier(xbar);
#if EN_D
  for (int rep = 0; rep < REP_D; ++rep) {
#pragma unroll 1
    for (int u2 = blockIdx.x * 2; u2 < 512; u2 += gridDim.x * 2) {
#pragma unroll 1
      for (int k = 0; k < 2; ++k) { const int u = u2 >> 1, bh = u & 7, pr = u >> 3;
        mixerD_unit(p, bh >> 2, bh & 3, k ? 63 - pr : pr, lds); }
    }
  }
#else
  { unsigned* y = (unsigned*)(p.ws + WS_Y); for (int i = blockIdx.x * NTHREADS + (int)threadIdx.x; i < NTOK * 256; i += gridDim.x * NTHREADS) { const int row = i >> 8, c = i & 255; y[row * 512 + 256 + c] = 0u; } }
#endif
#if EN_C
  __syncthreads();
  { FRESH_IDS const int vb = (gridDim.x % 8 == 0) ? (int)((blockIdx.x & 7) * (gridDim.x >> 3) + (blockIdx.x >> 3)) : (int)blockIdx.x;
    for (int rep = 0; rep < REP_C; ++rep) for (int it = vb * 8 + wid; it < 4096; it += ngw) mixerC_tile(p, it, Ks, Vs, lane); }
#else
  { unsigned* y = (unsigned*)(p.ws + WS_Y); for (int i = blockIdx.x * NTHREADS + (int)threadIdx.x; i < NTOK * 256; i += gridDim.x * NTHREADS) { const int row = i >> 8, c = i & 255; y[row * 512 + c] = 0u; } }
#endif
  xcd_barrier(xbar);
  phase_outproj(p, 1, lds);
  xcd_barrier(xbar);
  phase_ple(p, 1, lds);
}

extern "C" void kernel_launch(void* const* d_in, const int* in_sizes, int n_in, void* d_out, int out_size, void* d_ws, size_t ws_size, hipStream_t stream) {
  static int grid_blocks = 0;
  if (!grid_blocks) {
    int dev = 0, cus = 0, per_cu = 0;
    hipGetDevice(&dev);
    hipDeviceGetAttribute(&cus, hipDeviceAttributeMultiprocessorCount, dev);
    hipFuncSetAttribute((const void*)fwd_kernel, hipFuncAttributeMaxDynamicSharedMemorySize, LDS_BYTES);
    hipOccupancyMaxActiveBlocksPerMultiprocessor(&per_cu, (const void*)fwd_kernel, NTHREADS, LDS_BYTES);
    if (per_cu < 1) per_cu = 1;
    grid_blocks = cus * per_cu;
    if (grid_blocks > 256) grid_blocks = 256;
  }
  Params p{};
  for (int i = 0; i < 25; ++i) p.in[i] = (const float*)d_in[i];
  p.out = (float*)d_out; p.ws = (unsigned char*)d_ws;
  for (int i = 0; i < 32; ++i) p.inv_freq[i] = (float)pow(10000.0, -(double)i / 32.0);
  (void)hipMemsetAsync((char*)d_ws + WS_BAR, 0, 16384, stream);
  void* args[] = {&p};
  hipError_t e = hipLaunchCooperativeKernel((const void*)fwd_kernel, dim3(grid_blocks), dim3(NTHREADS), args, LDS_BYTES, stream);
  if (e != hipSuccess) fprintf(stderr, "cooperative launch failed: %s (grid %d)\n", hipGetErrorString(e), grid_blocks);
}
```

```cpp
#include <hip/hip_runtime.h>
#include <hip/hip_cooperative_groups.h>
#include <cstdio>
#include <cmath>
namespace cg = cooperative_groups;

#ifndef REP_GEMM
#define REP_GEMM 1
#endif
#ifndef REP_SELA
#define REP_SELA 1
#endif
#ifndef REP_D
#define REP_D 1
#endif
#ifndef REP_C
#define REP_C 1
#endif
#ifndef REP_AATT
#define REP_AATT 1
#endif
#ifndef EN_A
#define EN_A 1
#endif
#ifndef EN_B
#define EN_B 1
#endif
#ifndef EN_C
#define EN_C 1
#endif
#ifndef EN_D
#define EN_D 1
#endif

typedef unsigned short bf16;
typedef short bf16x8 __attribute__((ext_vector_type(8)));
typedef short s16x4 __attribute__((ext_vector_type(4)));
typedef float f32x4 __attribute__((ext_vector_type(4)));
typedef float f32x16 __attribute__((ext_vector_type(16)));
typedef unsigned u32x4 __attribute__((ext_vector_type(4)));
typedef unsigned u32x2 __attribute__((ext_vector_type(2)));
typedef float f32x2_t __attribute__((ext_vector_type(2)));
typedef __bf16 bf16x2_t __attribute__((ext_vector_type(2)));
#define LAS __attribute__((address_space(3)))
#define DI __device__ __forceinline__

constexpr int SEQ = 8192, NTOK = 16384, DM = 1024;
constexpr int NPE = 3072, NPO = 4096;
constexpr float EPS = 1e-6f;
constexpr float LOG2E = 1.4426950408889634f;
constexpr int NTHREADS = 512;
constexpr int LDS_BYTES = 150 * 1024;

constexpr size_t MiB = 1u << 20;
constexpr size_t WS_PE = 0;
constexpr size_t WS_ACT = 128 * MiB;
constexpr size_t WS_Y = 160 * MiB;
constexpr size_t WS_WINE = 192 * MiB;
constexpr size_t WS_WOUTE = 198 * MiB;
constexpr size_t WS_WINO = 200 * MiB;
constexpr size_t WS_WOUTO = 208 * MiB;
constexpr size_t WS_WG0 = 210 * MiB;
constexpr size_t WS_WG1 = 212 * MiB;
constexpr size_t WS_WP0 = 214 * MiB;
constexpr size_t WS_WP1 = 215 * MiB;
constexpr size_t WS_ROPE = 216 * MiB;
constexpr size_t WS_SEL = 218 * MiB;
constexpr size_t WS_IW = 226 * MiB;
constexpr size_t WS_SS = 227 * MiB;
constexpr size_t WS_LAM = 228 * MiB;
constexpr size_t WS_BAR = 250 * MiB;
constexpr size_t WS_PBF = 232 * MiB;
constexpr size_t WS_IKS = 229 * MiB;

struct Params {
  const float* in[25];
  float* out;
  unsigned char* ws;
  float inv_freq[32];
};
enum { I_X = 0, I_P, I_NORM_GAIN, I_W_IN_EVEN, I_W_OUT_EVEN, I_A_Q_GAIN, I_A_K_GAIN, I_IDX_K_GAIN, I_B_Q_GAIN, I_B_K_GAIN, I_B_SINKS,
       I_W_IN_ODD, I_W_OUT_ODD, I_C_Q_GAIN, I_C_K_GAIN, I_D_Q_GAIN, I_D_K_GAIN, I_LQ1, I_LK1, I_LQ2, I_LK2, I_SUB_GAIN, I_PLE_NORM_GAIN,
       I_W_PLE_GATE, I_W_PLE_PROJ };

DI unsigned cvtpk(float lo, float hi) { f32x2_t v = {lo, hi}; bf16x2_t b = __builtin_convertvector(v, bf16x2_t); return __builtin_bit_cast(unsigned, b); }
DI float bf2f(bf16 b) { return __uint_as_float(((unsigned)b) << 16); }
DI float fexp2(float x) { return __builtin_amdgcn_exp2f(x); }
DI f32x16 mfma32(bf16x8 a, bf16x8 b, f32x16 c) { return __builtin_amdgcn_mfma_f32_32x32x16_bf16(a, b, c, 0, 0, 0); }
DI f32x4 mfma16(bf16x8 a, bf16x8 b, f32x4 c) { return __builtin_amdgcn_mfma_f32_16x16x32_bf16(a, b, c, 0, 0, 0); }
DI int crow(int i, int h) { return (i & 3) + 8 * (i >> 2) + 4 * h; }
DI s16x4 trread(const bf16* p) { return __builtin_bit_cast(s16x4, __builtin_amdgcn_ds_read_tr16_b64_v4i16((LAS s16x4*)p)); }
DI int opaque_tid() { int t = threadIdx.x; asm volatile("" : "+v"(t)); return t; }
DI void lds_barrier() { asm volatile("s_waitcnt lgkmcnt(0)" ::: "memory"); __builtin_amdgcn_s_barrier(); asm volatile("" ::: "memory"); }
DI void lds_fence() { asm volatile("s_waitcnt lgkmcnt(0)" ::: "memory"); __builtin_amdgcn_wave_barrier(); }

__host__ __device__ __forceinline__ int phys_col(int n) { return (n & ~255) + 128 * ((n >> 5) & 1) + 32 * ((n >> 6) & 3) + (n & 31); }
DI int map_even(int n) { return n < 1216 ? n : (n < 1224 ? 3008 + (n - 1216) : n - 8); }
DI void transpose_tile(const float* W, int K, int N, bf16* WT, int mapmode, int tile, float* scr, const float* kgain = nullptr) {
  const int tid = opaque_tid();
  const int ntn = (N + 63) >> 6, kt = tile / ntn, nt = tile % ntn, k0 = kt * 64, n0 = nt * 64;
#pragma unroll
  for (int i = 0; i < 8; ++i) {
    const int kk = (tid >> 6) + 8 * i, nn = tid & 63, n = n0 + nn;
    scr[kk * 65 + nn] = (n < N) ? W[(size_t)(k0 + kk) * N + n] * (kgain ? kgain[k0 + kk] : 1.f) : 0.f;
  }
  __syncthreads();
  {
    const int nn = tid >> 3, kc = tid & 7, n = n0 + nn;
    if (n < N) {
      const int dst = mapmode == 1 ? phys_col(map_even(n)) : (mapmode == 2 ? phys_col(n) : n);
      const float* s = scr + (kc * 8) * 65 + nn;
      u32x4 o; o.x = cvtpk(s[0], s[65]); o.y = cvtpk(s[2 * 65], s[3 * 65]); o.z = cvtpk(s[4 * 65], s[5 * 65]); o.w = cvtpk(s[6 * 65], s[7 * 65]);
      *(u32x4*)(WT + (size_t)dst * K + k0 + kc * 8) = o;
    }
  }
  __syncthreads();
}

DI float wave_sum(float v) {
#pragma unroll
  for (int o = 1; o < 64; o <<= 1) v += __shfl_xor(v, o);
  return v;
}

DI void phase_prologue(const Params& p, char* lds) {
  const int tid = opaque_tid(), lane = tid & 63, wid = tid >> 6;
  const int nb = gridDim.x, bid = blockIdx.x;
  unsigned char* ws = p.ws;
  float* scr = (float*)lds;
  const int T0 = 16 * 48, T1 = 256, T2 = 16 * 64, T3 = 256, T4 = 256, T5 = 256, T6 = 64, T7 = 64;
  const int NT = T0 + T1 + T2 + T3 + T4 + T5 + T6 + T7;
  for (int it = bid; it < NT; it += nb) {
    int r = it;
    if (r < T0) { transpose_tile(p.in[I_W_IN_EVEN], 1024, 3016, (bf16*)(ws + WS_WINE), 1, r, scr); continue; } r -= T0;
    if (r < T1) { transpose_tile(p.in[I_W_OUT_EVEN], 1024, 1024, (bf16*)(ws + WS_WOUTE), 0, r, scr); continue; } r -= T1;
    if (r < T2) { transpose_tile(p.in[I_W_IN_ODD], 1024, 4096, (bf16*)(ws + WS_WINO), 2, r, scr, p.in[I_NORM_GAIN] + DM); continue; } r -= T2;
    if (r < T3) { transpose_tile(p.in[I_W_OUT_ODD], 1024, 1024, (bf16*)(ws + WS_WOUTO), 0, r, scr); continue; } r -= T3;
    if (r < T4) { transpose_tile(p.in[I_W_PLE_GATE], 1024, 1024, (bf16*)(ws + WS_WG0), 0, r, scr, p.in[I_PLE_NORM_GAIN]); continue; } r -= T4;
    if (r < T5) { transpose_tile(p.in[I_W_PLE_GATE] + 1024 * 1024, 1024, 1024, (bf16*)(ws + WS_WG1), 0, r, scr, p.in[I_PLE_NORM_GAIN] + DM); continue; } r -= T5;
    if (r < T6) { transpose_tile(p.in[I_W_PLE_PROJ], 256, 1024, (bf16*)(ws + WS_WP0), 0, r, scr); continue; } r -= T6;
    transpose_tile(p.in[I_W_PLE_PROJ] + 256 * 1024, 256, 1024, (bf16*)(ws + WS_WP1), 0, r, scr);
  }
  const int gt = bid * NTHREADS + tid, ngt = nb * NTHREADS;
  { unsigned* z = (unsigned*)(ws + WS_WINE); for (int i = gt; i < 56 * 512; i += ngt) z[(size_t)phys_col(3016 + (i >> 9)) * 512 + (i & 511)] = 0u; }
  { float* ss = (float*)(ws + WS_SS); for (int i = gt; i < 3 * NTOK; i += ngt) ss[i] = 0.f; }
  { float2* tab = (float2*)(ws + WS_ROPE);
    for (int i = gt; i < SEQ * 32; i += ngt) {
      const int pos = i >> 5, k = i & 31;
      const float ang = (float)pos * p.inv_freq[k];
      double rev = (double)ang * 0.15915494309189535; rev -= floor(rev);
      const float rf = (float)rev;
      tab[i] = make_float2(__builtin_amdgcn_cosf(rf), __builtin_amdgcn_sinf(rf));
    } }
  if (bid == 0 && wid == 0) {
    const float a = wave_sum(p.in[I_LQ1][lane] * p.in[I_LK1][lane]);
    const float b = wave_sum(p.in[I_LQ2][lane] * p.in[I_LK2][lane]);
    const float lambda_init = 0.8f - 0.6f * expf(-0.3f);
    if (lane == 0) *(float*)(ws + WS_LAM) = expf(a) - expf(b) + lambda_init;
  }
  { const float* x = p.in[I_X]; const float* g = p.in[I_NORM_GAIN]; bf16* H = (bf16*)(ws + WS_ACT);
    const int gw = bid * 8 + wid, ngw = nb * 8;
    for (int m = gw; m < NTOK; m += ngw) {
      const f32x4* xr = (const f32x4*)(x + (size_t)m * DM) + lane;
      f32x4 v[4]; float s = 0.f;
#pragma unroll
      for (int j = 0; j < 4; ++j) { v[j] = xr[64 * j]; s += v[j].x * v[j].x + v[j].y * v[j].y + v[j].z * v[j].z + v[j].w * v[j].w; }
      const float rstd = rsqrtf(wave_sum(s) * (1.f / DM) + EPS);
      u32x2* o = (u32x2*)(H + (size_t)m * DM) + lane;
#pragma unroll
      for (int j = 0; j < 4; ++j) { const f32x4 gg = *((const f32x4*)g + lane + 64 * j); u32x2 w; w.x = cvtpk(v[j].x * rstd * gg.x, v[j].y * rstd * gg.y); w.y = cvtpk(v[j].z * rstd * gg.z, v[j].w * rstd * gg.w); o[64 * j] = w; }
    } }
}

namespace pg8 {
#define PG8_LAS __attribute__((address_space(3)))
typedef unsigned short bf16_t;
typedef short bf16x8 __attribute__((ext_vector_type(8)));
typedef float f32x4 __attribute__((ext_vector_type(4)));
typedef unsigned u32x4 __attribute__((ext_vector_type(4)));
constexpr int BM = 256, BK = 64, HALF = 128, HTB = HALF * BK * 2  , STAGE_BYTES = 8 * HTB, NXCD = 8, WGM = 8;

__host__ __device__ __forceinline__ int lds_byte(int r, int c) { const int st = (r >> 4) * 2 + (c >> 5), rr = r & 15, cc = c & 31, ob = rr * 64 + cc * 2; return st * 1024 + (ob ^ (((ob >> 9) & 1) << 5)); }
__host__ __device__ __forceinline__ void stage_rc(int b, int& R, int& C) { const int st = b / 1024, sb = b % 1024, swz = sb ^ (((sb >> 9) & 1) << 5); R = (st >> 1) * 16 + swz / 64; C = (st & 1) * 32 + (swz % 64) / 2; }
__host__ __device__ __forceinline__ int perm32(int rho) { const int n = rho >> 4, i = rho & 15; return 8 * (i >> 2) + 4 * n + (i & 3); }

struct Unit { int pm, pn; };
struct Gemm { const bf16_t* A; const bf16_t* Bt; int M, N, K; };

struct StaticOrder {
    int nM, nN, nwg, G, c;
    __host__ __device__ void init(int M, int N, int G_, int c_) { nM = M / BM; nN = N / BM; nwg = nM * nN; G = G_; c = c_; }
    __host__ __device__ bool next(int i, Unit& u) const {
        const long L = (long)i * G + c; if (L >= nwg) return false;
        int wgid = (int)L; { const int q = nwg / NXCD, r = nwg % NXCD, xcd = wgid % NXCD, off = wgid / NXCD; wgid = (xcd < r ? xcd * (q + 1) : r * (q + 1) + (xcd - r) * q) + off; }
        const int nig = WGM * nN, gid = wgid / nig, fm = gid * WGM, gsz = (nM - fm) < WGM ? (nM - fm) : WGM;
        u.pm = fm + ((wgid % nig) % gsz); u.pn = (wgid % nig) / gsz; return true;
    }
    __device__ __forceinline__ void a_ready(const Unit&) const {}
    __device__ __forceinline__ void done(const Unit&) const {}
};
__device__ __forceinline__ unsigned cvt_pk_bf16(float lo, float hi) { unsigned r; asm volatile("v_cvt_pk_bf16_f32 %0, %1, %2" : "=v"(r) : "v"(lo), "v"(hi)); return r; }
template <class Epi, class Sched, bool ALIGN_EPI = false, bool SP2 = false>
__device__ __forceinline__ void gemm_phase(PG8_LAS unsigned char* lds, const Gemm g, const Sched& S, const Epi& E) {
    int tid_ = threadIdx.x; asm volatile("" : "+v"(tid_));
    const int tid = tid_, wid = __builtin_amdgcn_readfirstlane(tid >> 6), lane = tid & 63, wr = wid >> 2, wc = wid & 3, fr = lane & 15, fq = lane >> 4;
    const int K = g.K, nt = K / BK;
    unsigned voffA[2], voffB[2];
#pragma unroll
    for (int i = 0; i < 2; ++i) { int R, C; stage_rc(tid * 16 + i * 8192, R, C); const int Rb = Epi::PERM ? ((R & ~31) + perm32(R & 31)) : R;
        voffA[i] = (unsigned)(R * K + C) * 2u; voffB[i] = (unsigned)(Rb * K + C) * 2u; }
    const size_t kstep = (size_t)(BK * 2);
    const size_t hstep = (size_t)HALF * K * 2;
    const size_t tstep = 2 * hstep;
    const unsigned ldsw = (unsigned)wid * 1024u;
    const int aoff = lds_byte(wr * 64 + fr, fq * 8), boff = lds_byte(wc * 32 + fr, fq * 8);
#define PG8_SA(b, h) (((b) * 2 + (h)) * HTB)
#define PG8_SB(b, h) ((4 + (b) * 2 + (h)) * HTB)
#define PG8_STAGE(bufoff, gbase, voff) do { _Pragma("unroll") for (int _i = 0; _i < 2; ++_i) \
        __builtin_amdgcn_global_load_lds((const unsigned*)((const char*)(gbase) + (voff)[_i]), (PG8_LAS unsigned*)(lds + (bufoff) + ldsw + _i * 8192), 16, 0, 0); } while (0)
#define PG8_LDA(dst, b, h) do { _Pragma("unroll") for (int m = 0; m < 4; ++m) _Pragma("unroll") for (int k = 0; k < 2; ++k) dst[m][k] = *(const PG8_LAS bf16x8*)(lds + PG8_SA(b, h) + aoff + m * 2048 + k * 1024); } while (0)
#define PG8_LDB(dst, b, h) do { _Pragma("unroll") for (int n = 0; n < 2; ++n) _Pragma("unroll") for (int k = 0; k < 2; ++k) dst[n][k] = *(const PG8_LAS bf16x8*)(lds + PG8_SB(b, h) + boff + n * 2048 + k * 1024); } while (0)
#define PG8_MMA(ai, bj, At, Bt) do { __builtin_amdgcn_s_setprio(1); _Pragma("unroll") for (int m = 0; m < 4; ++m) _Pragma("unroll") for (int n = 0; n < 2; ++n) _Pragma("unroll") for (int k = 0; k < 2; ++k) \
        acc[ai][bj][m][n] = __builtin_amdgcn_mfma_f32_16x16x32_bf16(Bt[n][k], At[m][k], acc[ai][bj][m][n], 0, 0, 0); __builtin_amdgcn_s_setprio(0); } while (0)
#define PG8_WAIT_V(n) asm volatile("s_waitcnt vmcnt(" #n ")" ::: "memory")
#define PG8_WAIT_L(n) asm volatile("s_waitcnt lgkmcnt(" #n ")" ::: "memory")
#define PG8_BAR __builtin_amdgcn_s_barrier()
#define PG8_SCHED __builtin_amdgcn_sched_barrier(0)
    Unit cur, nxt; int ui = 0;
    if (!S.next(0, cur)) return;
    f32x4 acc[2][2][4][2];
#pragma unroll
    for (int a = 0; a < 2; ++a)
#pragma unroll
        for (int b = 0; b < 2; ++b)
#pragma unroll
            for (int m = 0; m < 4; ++m)
#pragma unroll
                for (int n = 0; n < 2; ++n) acc[a][b][m][n] = (f32x4){0.f, 0.f, 0.f, 0.f};
    bf16x8 At[4][2], B0[2][2], B1[2][2];
    const char* cA = (const char*)g.A + (size_t)cur.pm * tstep; const char* cB = (const char*)g.Bt + (size_t)cur.pn * tstep;
    S.a_ready(cur);
    if constexpr (SP2) {
        PG8_STAGE(PG8_SB(0, 0), cB, voffB); PG8_STAGE(PG8_SB(0, 1), cB + hstep, voffB); PG8_STAGE(PG8_SA(0, 0), cA, voffA); PG8_STAGE(PG8_SA(0, 1), cA + hstep, voffA);
        if (wr == 1) PG8_BAR;
        PG8_WAIT_V(2); PG8_BAR;
        PG8_STAGE(PG8_SB(1, 0), cB + kstep, voffB); PG8_STAGE(PG8_SA(1, 0), cA + kstep, voffA); PG8_STAGE(PG8_SB(1, 1), cB + hstep + kstep, voffB);
        PG8_WAIT_V(6); PG8_BAR;
    } else {
        PG8_STAGE(PG8_SB(0, 0), cB, voffB); PG8_STAGE(PG8_SA(0, 0), cA, voffA); PG8_STAGE(PG8_SB(0, 1), cB + hstep, voffB); PG8_STAGE(PG8_SA(0, 1), cA + hstep, voffA);
        if (wr == 1) PG8_BAR;
        PG8_WAIT_V(4); PG8_BAR;
        PG8_STAGE(PG8_SB(1, 0), cB + kstep, voffB); PG8_STAGE(PG8_SA(1, 0), cA + kstep, voffA); PG8_STAGE(PG8_SB(1, 1), cB + hstep + kstep, voffB);
        PG8_WAIT_V(6); PG8_BAR;
    }
    for (;;) {
        const bool has_next = S.next(ui + 1, nxt);
        const char* nA = has_next ? (const char*)g.A + (size_t)nxt.pm * tstep : cA; const char* nB = has_next ? (const char*)g.Bt + (size_t)nxt.pn * tstep : cB;
        for (int t = 0; t < nt; t += 2) {
            const bool last = (t == nt - 2);
            const char* a1 = cA + (size_t)(t + 1) * kstep;
            const char* a2 = last ? nA : cA + (size_t)(t + 2) * kstep; const char* b2 = last ? nB : cB + (size_t)(t + 2) * kstep;
            const char* a3 = a2 + kstep; const char* b3 = b2 + kstep;
            if (last && has_next) S.a_ready(nxt);
            if constexpr (SP2) {
            PG8_LDB(B0, 0, 0); PG8_LDB(B1, 0, 1); PG8_SCHED; PG8_LDA(At, 0, 0); PG8_STAGE(PG8_SA(1, 1), a1 + hstep, voffA);
            PG8_WAIT_V(8); PG8_WAIT_L(0); PG8_BAR; PG8_MMA(0, 0, At, B0); PG8_MMA(0, 1, At, B1); PG8_BAR; PG8_SCHED;
            PG8_LDA(At, 0, 1); PG8_STAGE(PG8_SB(0, 0), b2, voffB); PG8_STAGE(PG8_SB(0, 1), b2 + hstep, voffB); PG8_STAGE(PG8_SA(0, 0), a2, voffA);
            PG8_WAIT_V(8); PG8_WAIT_L(0); PG8_BAR; PG8_MMA(1, 0, At, B0); PG8_MMA(1, 1, At, B1); PG8_BAR; PG8_SCHED;
            PG8_LDB(B0, 1, 0); PG8_LDB(B1, 1, 1); PG8_SCHED; PG8_LDA(At, 1, 0); PG8_STAGE(PG8_SA(0, 1), a2 + hstep, voffA);
            PG8_WAIT_V(8); PG8_WAIT_L(0); PG8_BAR; PG8_MMA(0, 0, At, B0); PG8_MMA(0, 1, At, B1); PG8_BAR; PG8_SCHED;
            PG8_LDA(At, 1, 1); PG8_STAGE(PG8_SB(1, 0), b3, voffB); PG8_STAGE(PG8_SB(1, 1), b3 + hstep, voffB); PG8_STAGE(PG8_SA(1, 0), a3, voffA);
            PG8_WAIT_V(8); PG8_WAIT_L(0); PG8_BAR; PG8_MMA(1, 0, At, B0); PG8_MMA(1, 1, At, B1); PG8_BAR; PG8_SCHED;
            } else {
            PG8_LDB(B0, 0, 0); PG8_SCHED; PG8_LDA(At, 0, 0); PG8_STAGE(PG8_SA(1, 1), a1 + hstep, voffA);
            PG8_WAIT_L(8); PG8_BAR; PG8_WAIT_L(0); PG8_MMA(0, 0, At, B0); PG8_BAR; PG8_SCHED;
            PG8_LDB(B1, 0, 1); PG8_STAGE(PG8_SB(0, 0), b2, voffB);
            PG8_BAR; PG8_WAIT_L(0); PG8_MMA(0, 1, At, B1); PG8_BAR;
            PG8_LDA(At, 0, 1); PG8_STAGE(PG8_SA(0, 0), a2, voffA);
            PG8_BAR; PG8_WAIT_L(0); PG8_MMA(1, 0, At, B0); PG8_BAR; PG8_SCHED;
            PG8_STAGE(PG8_SB(0, 1), b2 + hstep, voffB);
            PG8_WAIT_V(6); PG8_BAR; PG8_MMA(1, 1, At, B1); PG8_BAR;
            PG8_LDB(B0, 1, 0); PG8_SCHED; PG8_LDA(At, 1, 0); PG8_STAGE(PG8_SA(0, 1), a2 + hstep, voffA);
            PG8_WAIT_L(8); PG8_BAR; PG8_WAIT_L(0); PG8_MMA(0, 0, At, B0); PG8_BAR; PG8_SCHED;
            PG8_LDB(B1, 1, 1); PG8_STAGE(PG8_SB(1, 0), b3, voffB);
            PG8_BAR; PG8_WAIT_L(0); PG8_MMA(0, 1, At, B1); PG8_BAR;
            PG8_LDA(At, 1, 1); PG8_STAGE(PG8_SA(1, 0), a3, voffA);
            PG8_BAR; PG8_WAIT_L(0); PG8_MMA(1, 0, At, B0); PG8_BAR; PG8_SCHED;
            PG8_STAGE(PG8_SB(1, 1), b3 + hstep, voffB);
            PG8_WAIT_V(6); PG8_BAR; PG8_MMA(1, 1, At, B1); PG8_BAR;
            }
        }
        if constexpr (ALIGN_EPI) { if (wr == 0) PG8_BAR; }
        if constexpr (!Epi::AFTER_DRAIN) { E(acc, cur, wr, wc, fr, fq); S.done(cur); }
        if (!has_next) break;
#pragma unroll
        for (int a = 0; a < 2; ++a)
#pragma unroll
            for (int b = 0; b < 2; ++b)
#pragma unroll
                for (int m = 0; m < 4; ++m)
#pragma unroll
                    for (int n = 0; n < 2; ++n) acc[a][b][m][n] = (f32x4){0.f, 0.f, 0.f, 0.f};
        cur = nxt; cA = nA; cB = nB; ++ui;
        if constexpr (ALIGN_EPI) { if (wr == 1) PG8_BAR; }
    }
    PG8_WAIT_V(0);
    if constexpr (!ALIGN_EPI) { if (wr == 0) PG8_BAR; }
    PG8_BAR;
    if constexpr (Epi::AFTER_DRAIN) { E.fused(acc, cur, wr, wc, fr, fq, lds, wid, lane); S.done(cur); }
#undef PG8_SA
#undef PG8_SB
#undef PG8_STAGE
#undef PG8_LDA
#undef PG8_LDB
#undef PG8_MMA
#undef PG8_WAIT_V
#undef PG8_WAIT_L
#undef PG8_BAR
#undef PG8_SCHED
}
}

enum { T_PLAIN = 0, T_NR = 1, T_ROPE = 2, T_SILU = 3, T_IW = 4 };
DI void slot_info(const Params& p, int layer, int slot, int& type, const float*& gain) {
  gain = nullptr;
  if (layer == 0) {
    if (slot < 8) { type = T_NR; gain = p.in[I_A_Q_GAIN]; }
    else if (slot == 8) { type = T_NR; gain = p.in[I_A_K_GAIN]; }
    else if (slot == 9) type = T_PLAIN;
    else if (slot < 18) type = T_ROPE;
    else if (slot == 18) { type = T_NR; gain = p.in[I_IDX_K_GAIN]; }
    else if (slot < 27) type = T_SILU;
    else if (slot < 35) { type = T_NR; gain = p.in[I_B_Q_GAIN]; }
    else if (slot < 37) { type = T_NR; gain = p.in[I_B_K_GAIN]; }
    else if (slot < 39) type = T_PLAIN;
    else if (slot < 47) type = T_SILU;
    else type = T_IW;
  } else {
    if (slot < 8) { type = T_NR; gain = p.in[I_C_Q_GAIN]; }
    else if (slot < 16) { type = T_NR; gain = p.in[I_C_K_GAIN]; }
    else if (slot < 24) type = T_PLAIN;
    else if (slot < 32) type = T_SILU;
    else if (slot < 40) { type = T_NR; gain = p.in[I_D_Q_GAIN]; }
    else if (slot < 48) { type = T_NR; gain = p.in[I_D_K_GAIN]; }
    else if (slot < 56) type = T_PLAIN;
    else type = T_SILU;
  }
}
constexpr int E_AQ = 0, E_AK = 512, E_AV = 576, E_IQ = 640, E_IK = 1152, E_AG = 1216, E_BQ = 1728, E_BK = 2240, E_BV = 2368, E_BG = 2496;
constexpr int O_CQ = 0, O_CK = 512, O_CV = 1024, O_CG = 1536, O_DQ = 2048, O_DK = 2560, O_DV = 3072, O_DG = 3584;

typedef pg8::f32x4 (AccT)[2][2][4][2];

struct EpiInProj {
  static constexpr bool PERM = false, AFTER_DRAIN = false;
  const Params& p; int layer;
  DI void operator()(const f32x4 (&acc)[2][2][4][2], const pg8::Unit& u, int wr, int wc, int fr, int fq) const {
    unsigned char* ws = p.ws;
    const int NP = layer == 0 ? NPE : NPO;
    bf16* PE = (bf16*)(ws + WS_PE);
    const float2* rope = (const float2*)(ws + WS_ROPE);
    const float* ss1 = (const float*)(ws + WS_SS);
    float* IW = (float*)(ws + WS_IW);
    const int slot = u.pn * 4 + wc;
    int type; const float* gain; slot_info(p, layer, slot, type, gain);
#pragma unroll
    for (int ai = 0; ai < 2; ++ai)
#pragma unroll
      for (int m = 0; m < 4; ++m) {
        const int row = u.pm * 256 + ai * 128 + wr * 64 + m * 16 + fr, pos = row & (SEQ - 1);
        float sc = 1.f;
        if (layer == 1) sc = rsqrtf(ss1[row] * (1.f / DM) + EPS);
        f32x4 v1[2], v2[2];
#pragma unroll
        for (int n = 0; n < 2; ++n) { v1[n] = acc[ai][0][m][n] * sc; v2[n] = acc[ai][1][m][n] * sc; }
        if (type == T_NR) {
          float s = 0.f;
#pragma unroll
          for (int n = 0; n < 2; ++n) s += v1[n].x * v1[n].x + v1[n].y * v1[n].y + v1[n].z * v1[n].z + v1[n].w * v1[n].w + v2[n].x * v2[n].x + v2[n].y * v2[n].y + v2[n].z * v2[n].z + v2[n].w * v2[n].w;
          s += __shfl_xor(s, 16); s += __shfl_xor(s, 32);
          const float rn = rsqrtf(s * (1.f / 64.f) + EPS);
#pragma unroll
          for (int n = 0; n < 2; ++n) { const f32x4 g1 = *(const f32x4*)(gain + n * 16 + fq * 4), g2 = *(const f32x4*)(gain + 32 + n * 16 + fq * 4); v1[n] = v1[n] * rn * g1; v2[n] = v2[n] * rn * g2; }
        }
        if (type == T_NR || type == T_ROPE) {
#pragma unroll
          for (int n = 0; n < 2; ++n) {
            const f32x4* cs = (const f32x4*)(rope + (size_t)pos * 32 + n * 16 + fq * 4);
            const f32x4 c01 = cs[0], c23 = cs[1];
            const f32x4 x1 = v1[n], x2 = v2[n];
            f32x4 o1, o2;
            o1.x = x1.x * c01.x - x2.x * c01.y; o2.x = x2.x * c01.x + x1.x * c01.y;
            o1.y = x1.y * c01.z - x2.y * c01.w; o2.y = x2.y * c01.z + x1.y * c01.w;
            o1.z = x1.z * c23.x - x2.z * c23.y; o2.z = x2.z * c23.x + x1.z * c23.y;
            o1.w = x1.w * c23.z - x2.w * c23.w; o2.w = x2.w * c23.z + x1.w * c23.w;
            v1[n] = o1; v2[n] = o2;
          }
        }
        if (type == T_SILU) {
#pragma unroll
          for (int n = 0; n < 2; ++n)
#pragma unroll
            for (int j = 0; j < 4; ++j) { const float a = v1[n][j]; v1[n][j] = a / (1.f + __expf(-a)); const float b = v2[n][j]; v2[n][j] = b / (1.f + __expf(-b)); }
        }
        if (type == T_IW) {
          if (fq < 2) *(f32x4*)(IW + (size_t)row * 8 + fq * 4) = v1[0];
        } else {
          bf16* dst = PE + (size_t)row * NP + slot * 64 + fq * 4;
#pragma unroll
          for (int n = 0; n < 2; ++n) {
            u32x2 w1, w2; w1.x = cvtpk(v1[n].x, v1[n].y); w1.y = cvtpk(v1[n].z, v1[n].w); w2.x = cvtpk(v2[n].x, v2[n].y); w2.y = cvtpk(v2[n].z, v2[n].w);
            *(u32x2*)(dst + n * 16) = w1; *(u32x2*)(dst + 32 + n * 16) = w2;
            if (layer == 0 && slot == 18) { bf16* IKS = (bf16*)(ws + WS_IKS); const int key = row & (SEQ - 1);
              bf16* base = IKS + (((size_t)(row >> 13) * 256 + (key >> 5)) * 4) * 512 + ((fq >> 1) * 32 + (key & 31)) * 8 + (fq & 1) * 4;
              *(u32x2*)(base + (size_t)n * 512) = w1; *(u32x2*)(base + (size_t)(n + 2) * 512) = w2; }
          }
        }
        asm volatile("" ::: "memory");
      }
  }
};

DI void phase_inproj(const Params& p, int layer, char* lds) {
  unsigned char* ws = p.ws;
  const int NP = layer == 0 ? NPE : NPO;
  pg8::Gemm g{(const bf16*)(ws + WS_ACT), (const bf16*)(ws + (layer == 0 ? WS_WINE : WS_WINO)), NTOK, NP, DM};
  pg8::StaticOrder S; S.init(NTOK, NP, (int)gridDim.x, (int)blockIdx.x);
  EpiInProj E{p, layer};
  pg8::gemm_phase<EpiInProj, pg8::StaticOrder, true, true>((PG8_LAS unsigned char*)lds, g, S, E);
}

struct EpiOutProj {
  static constexpr bool PERM = false, AFTER_DRAIN = false;
  const float* xin; const bf16* xin16; bf16* X1B; bf16* XG; const float* pg; float* ss;
  DI void operator()(const f32x4 (&acc)[2][2][4][2], const pg8::Unit& u, int wr, int wc, int fr, int fq) const {
#pragma unroll
    for (int ai = 0; ai < 2; ++ai)
#pragma unroll
      for (int m = 0; m < 4; ++m) {
        const int row = u.pm * 256 + ai * 128 + wr * 64 + m * 16 + fr; float rs = 0.f;
#pragma unroll
        for (int bj = 0; bj < 2; ++bj)
#pragma unroll
          for (int n = 0; n < 2; ++n) {
            const int col = u.pn * 256 + bj * 128 + wc * 32 + n * 16 + fq * 4; const size_t off = (size_t)row * DM + col;
            f32x4 xb;
            if (xin16) { const u32x2 hw = *(const u32x2*)(xin16 + off); xb.x = __uint_as_float(hw.x << 16); xb.y = __uint_as_float(hw.x & 0xffff0000u); xb.z = __uint_as_float(hw.y << 16); xb.w = __uint_as_float(hw.y & 0xffff0000u); }
            else xb = *(const f32x4*)(xin + off);
            const f32x4 xn = xb + acc[ai][bj][m][n];
            { u32x2 wx; wx.x = cvtpk(xn.x, xn.y); wx.y = cvtpk(xn.z, xn.w); *(u32x2*)(X1B + off) = wx; }
            rs += xn.x * xn.x + xn.y * xn.y + xn.z * xn.z + xn.w * xn.w;
          }
        rs += __shfl_xor(rs, 16); rs += __shfl_xor(rs, 32);
        if (fq == 0) atomicAdd(ss + row, rs);
        asm volatile("" ::: "memory");
      }
  }
};
DI void phase_outproj(const Params& p, int layer, char* lds) {
  unsigned char* ws = p.ws;
  pg8::Gemm g{(const bf16*)(ws + WS_Y), (const bf16*)(ws + (layer == 0 ? WS_WOUTE : WS_WOUTO)), NTOK, DM, DM};
  pg8::StaticOrder S; S.init(NTOK, DM, (int)gridDim.x, (int)blockIdx.x);
  EpiOutProj E{p.in[I_X], layer == 0 ? (const bf16*)nullptr : (const bf16*)(ws + WS_ACT), (bf16*)(ws + WS_PE + 64 * MiB), (bf16*)(ws + WS_ACT), p.in[I_PLE_NORM_GAIN] + layer * DM, (float*)(ws + WS_SS) + (layer == 0 ? 1 : 2) * NTOK};
  pg8::gemm_phase<EpiOutProj, pg8::StaticOrder, true, true>((PG8_LAS unsigned char*)lds, g, S, E);
}

struct EpiPleProj {
  static constexpr bool PERM = false, AFTER_DRAIN = false;
  bf16* PT;
  DI void operator()(const f32x4 (&acc)[2][2][4][2], const pg8::Unit& u, int wr, int wc, int fr, int fq) const {
#pragma unroll
    for (int ai = 0; ai < 2; ++ai)
#pragma unroll
      for (int m = 0; m < 4; ++m) {
        const int row = u.pm * 256 + ai * 128 + wr * 64 + m * 16 + fr;
#pragma unroll
        for (int bj = 0; bj < 2; ++bj)
#pragma unroll
          for (int n = 0; n < 2; ++n) { const f32x4 a = acc[ai][bj][m][n]; u32x2 w; w.x = cvtpk(a.x, a.y); w.y = cvtpk(a.z, a.w); *(u32x2*)(PT + (size_t)row * DM + u.pn * 256 + bj * 128 + wc * 32 + n * 16 + fq * 4) = w; }
      }
  }
};
struct EpiPleGate {
  static constexpr bool PERM = false, AFTER_DRAIN = false;
  const bf16* PT; const bf16* X1B; float* out; const float* ssx; float* ss1; bf16* H; const float* ng1; int layer;
  DI void operator()(const f32x4 (&acc)[2][2][4][2], const pg8::Unit& u, int wr, int wc, int fr, int fq) const {
#pragma unroll
    for (int ai = 0; ai < 2; ++ai)
#pragma unroll
      for (int m = 0; m < 4; ++m) {
        const int row = u.pm * 256 + ai * 128 + wr * 64 + m * 16 + fr; float rs = 0.f;
        const float rstd = rsqrtf(ssx[row] * (1.f / DM) + EPS);
#pragma unroll
        for (int bj = 0; bj < 2; ++bj)
#pragma unroll
          for (int n = 0; n < 2; ++n) {
            const int col = u.pn * 256 + bj * 128 + wc * 32 + n * 16 + fq * 4; const size_t off = (size_t)row * DM + col;
            f32x4 g;
#pragma unroll
            for (int j = 0; j < 4; ++j) g[j] = 1.f / (1.f + __expf(-rstd * acc[ai][bj][m][n][j]));
            const u32x2 pw = *(const u32x2*)(PT + off); f32x4 pp; pp.x = __uint_as_float(pw.x << 16); pp.y = __uint_as_float(pw.x & 0xffff0000u); pp.z = __uint_as_float(pw.y << 16); pp.w = __uint_as_float(pw.y & 0xffff0000u);
            const u32x2 xw = *(const u32x2*)(X1B + off); f32x4 x1; x1.x = __uint_as_float(xw.x << 16); x1.y = __uint_as_float(xw.x & 0xffff0000u); x1.z = __uint_as_float(xw.y << 16); x1.w = __uint_as_float(xw.y & 0xffff0000u);
            const f32x4 xn = x1 + pp * g;
            if (layer != 0) *(f32x4*)(out + off) = xn;
            if (layer == 0) {
              rs += xn.x * xn.x + xn.y * xn.y + xn.z * xn.z + xn.w * xn.w;
              u32x2 w; w.x = cvtpk(xn.x, xn.y); w.y = cvtpk(xn.z, xn.w); *(u32x2*)(H + off) = w;
            }
          }
        if (layer == 0) { rs += __shfl_xor(rs, 16); rs += __shfl_xor(rs, 32); if (fq == 0) atomicAdd(ss1 + row, rs); }
        asm volatile("" ::: "memory");
      }
  }
};
DI void phase_ple(const Params& p, int layer, char* lds) {
  unsigned char* ws = p.ws;
  bf16* PT = (bf16*)(ws + WS_PE);
  pg8::StaticOrder S; S.init(NTOK, DM, (int)gridDim.x, (int)blockIdx.x);
  { pg8::Gemm g{(const bf16*)(ws + WS_PBF) + (size_t)layer * NTOK * 256, (const bf16*)(ws + (layer == 0 ? WS_WP0 : WS_WP1)), NTOK, DM, 256};
    EpiPleProj E{PT};
    pg8::gemm_phase<EpiPleProj, pg8::StaticOrder, true, true>((PG8_LAS unsigned char*)lds, g, S, E); }
  { pg8::Gemm g{(const bf16*)(ws + WS_PE + 64 * MiB), (const bf16*)(ws + (layer == 0 ? WS_WG0 : WS_WG1)), NTOK, DM, DM};
    EpiPleGate E{PT, (const bf16*)(ws + WS_PE + 64 * MiB), p.out, (const float*)(ws + WS_SS) + (layer == 0 ? 1 : 2) * NTOK, (float*)(ws + WS_SS), (bf16*)(ws + WS_ACT), p.in[I_NORM_GAIN] + DM, layer};
    pg8::gemm_phase<EpiPleGate, pg8::StaticOrder, true, true>((PG8_LAS unsigned char*)lds, g, S, E); }
}

DI float half_max(float v) { auto rr = __builtin_amdgcn_permlane32_swap(__float_as_uint(v), __float_as_uint(v), false, false); return fmaxf(__uint_as_float(rr[0]), __uint_as_float(rr[1])); }
template <int DVB, bool MASKED = true>
DI void attn_step32(const bf16* Kt, int KP, const bf16* Vt, int VP, const bf16x8 (&qf)[4], f32x16 (&o)[DVB], float& m, float& l, unsigned vmask, float c2, int lane) {
  const int r32 = lane & 31, h = lane >> 5;
  f32x16 s;
#pragma unroll
  for (int i = 0; i < 16; ++i) s[i] = 0.f;
#pragma unroll
  for (int t = 0; t < 4; ++t) { const bf16x8 kf = *(const bf16x8*)(Kt + r32 * KP + t * 16 + h * 8); s = mfma32(kf, qf[t], s); }
  float mx = -INFINITY;
#pragma unroll
  for (int i = 0; i < 16; ++i) { if (MASKED) { s[i] = ((vmask >> i) & 1u) ? s[i] : -INFINITY; } mx = fmaxf(mx, s[i]); }
  mx = half_max(mx);
  const float mxs = mx * c2;
  if (__any(mxs > m + 6.f)) {
    const float mn = fmaxf(m, mxs);
    const float alpha = fexp2(m - mn); l *= alpha;
#pragma unroll
    for (int d = 0; d < DVB; ++d)
#pragma unroll
      for (int i = 0; i < 16; ++i) o[d][i] *= alpha;
    m = mn;
  }
  float ps = 0.f; const float negm = -m;
#pragma unroll
  for (int i = 0; i < 16; ++i) { const float pv = fexp2(__builtin_fmaf(s[i], c2, negm)); s[i] = pv; ps += pv; }
  l += ps;
  bf16x8 pf[2];
  { u32x4 a, b; a.x = cvtpk(s[0], s[1]); a.y = cvtpk(s[2], s[3]); a.z = cvtpk(s[4], s[5]); a.w = cvtpk(s[6], s[7]);
    b.x = cvtpk(s[8], s[9]); b.y = cvtpk(s[10], s[11]); b.z = cvtpk(s[12], s[13]); b.w = cvtpk(s[14], s[15]);
    pf[0] = __builtin_bit_cast(bf16x8, a); pf[1] = __builtin_bit_cast(bf16x8, b); }
  const int i16 = lane & 15, q = i16 >> 2, pp = i16 & 3, blk = (lane >> 4) & 1;
#pragma unroll
  for (int d = 0; d < DVB; ++d)
#pragma unroll
    for (int sk = 0; sk < 2; ++sk) {
      const s16x4 lo = trread(Vt + (16 * sk + 4 * h + q) * VP + 32 * d + 16 * blk + 4 * pp);
      const s16x4 hi = trread(Vt + (16 * sk + 8 + 4 * h + q) * VP + 32 * d + 16 * blk + 4 * pp);
      const bf16x8 vf = __builtin_shufflevector(lo, hi, 0, 1, 2, 3, 4, 5, 6, 7);
      o[d] = mfma32(vf, pf[sk], o[d]);
    }
}

DI unsigned row_range_mask(int lo, int hi) {
  lo = lo < 0 ? 0 : lo; hi = hi > 31 ? 31 : hi;
  if (hi < lo) return 0u;
  const unsigned upto_hi = (hi >= 31) ? 0xffffffffu : ((1u << (hi + 1)) - 1u);
  return upto_hi & ~((1u << lo) - 1u);
}
DI unsigned lane_rows(unsigned m32, int h) {
  const unsigned t = m32 >> (4 * h);
  return (t & 0xFu) | ((t >> 4) & 0xF0u) | ((t >> 8) & 0xF00u) | ((t >> 12) & 0xF000u);
}
constexpr int WP = 72;
constexpr int WAVE_LDS = 2 * 32 * WP * 2 + 512;

struct KVRegs { u32x4 k[4], v[4]; };
DI void kv_store(const KVRegs& R, bf16* Ks, bf16* Vs, int lane) {
#pragma unroll
  for (int i = 0; i < 4; ++i) { const int row = (lane >> 3) + 8 * i, ch = lane & 7; *(u32x4*)(Ks + row * WP + ch * 8) = R.k[i]; *(u32x4*)(Vs + row * WP + ch * 8) = R.v[i]; }
}

DI void band_load(KVRegs& R, const bf16* Kg, const bf16* Vg, int NP, int kstart, int dil, int roff, int lane) {
#pragma unroll
  for (int i = 0; i < 4; ++i) {
    const int row = (lane >> 3) + 8 * i, ch = lane & 7; int k = kstart + row; if (k < 0) k = 0;
    const size_t off = (size_t)(dil * k + roff) * NP + ch * 8;
    R.k[i] = *(const u32x4*)(Kg + off); R.v[i] = *(const u32x4*)(Vg + off);
  }
}
template <int DVB>
DI void band_run(const bf16* Kg, const bf16* Vg, int NP, int kbase, int nsteps, int dil, int roff, int qidx, int win,
                 const bf16x8 (&qf)[4], f32x16 (&o)[DVB], float& m, float& l, float c2, bf16* Ks, bf16* Vs, int lane) {
  const int h = lane >> 5;
  KVRegs R; band_load(R, Kg, Vg, NP, kbase, dil, roff, lane);
  for (int j = 0; j < nsteps; ++j) {
    lds_fence();
    kv_store(R, Ks, Vs, lane);
    lds_fence();
    if (j + 1 < nsteps) band_load(R, Kg, Vg, NP, kbase + 32 * (j + 1), dil, roff, lane);
    const int kb = kbase + 32 * j, lo_r = (qidx - win > 0 ? qidx - win : 0) - kb;
    const unsigned vm = lane_rows(row_range_mask(lo_r, qidx - kb), h);
    attn_step32<DVB>(Ks, WP, Vs, WP, qf, o, m, l, vm, c2, lane);
  }
}

DI void write_o64(const f32x16 (&o)[2], float linv, const bf16* gate_row, bf16* y_row, int h) {
#pragma unroll
  for (int d = 0; d < 2; ++d)
#pragma unroll
    for (int g = 0; g < 4; ++g) {
      const int dd = 32 * d + 8 * g + 4 * h;
      const u32x2 gv = *(const u32x2*)(gate_row + dd);
      const float g0 = __uint_as_float(gv.x << 16), g1 = __uint_as_float(gv.x & 0xffff0000u), g2 = __uint_as_float(gv.y << 16), g3 = __uint_as_float(gv.y & 0xffff0000u);
      u32x2 w; w.x = cvtpk(o[d][4 * g] * linv * g0, o[d][4 * g + 1] * linv * g1); w.y = cvtpk(o[d][4 * g + 2] * linv * g2, o[d][4 * g + 3] * linv * g3);
      *(u32x2*)(y_row + dd) = w;
    }
}

DI void load_q(bf16x8 (&qf)[4], const bf16* qrow, int h) {
#pragma unroll
  for (int t = 0; t < 4; ++t) qf[t] = *(const bf16x8*)(qrow + t * 16 + h * 8);
}
template <int DVB> DI void zero_o(f32x16 (&o)[DVB]) {
#pragma unroll
  for (int d = 0; d < DVB; ++d)
#pragma unroll
    for (int i = 0; i < 16; ++i) o[d][i] = 0.f;
}

DI void mixerB_tile(const Params& p, int item, bf16* Ks, bf16* Vs, int lane) {
  const bf16* PE = (const bf16*)(p.ws + WS_PE); bf16* Y = (bf16*)(p.ws + WS_Y);
  const int qblk = item & 255, head = (item >> 8) & 7, b = item >> 11;
  const int r32 = lane & 31, h = lane >> 5, q0 = qblk * 32, kvh = head >> 2;
  const size_t rowb = (size_t)b * SEQ;
  bf16x8 qf[4]; load_q(qf, PE + (rowb + q0 + r32) * NPE + E_BQ + head * 64, h);
  f32x16 o[2]; zero_o<2>(o);
  const float sink2 = p.in[I_B_SINKS][head] * LOG2E;
  float m = sink2, l = (h == 0) ? 1.f : 0.f;
  band_run<2>(PE + rowb * NPE + E_BK + kvh * 64, PE + rowb * NPE + E_BV + kvh * 64, NPE, q0 - 128, 5, 1, 0, q0 + r32, 127, qf, o, m, l, 0.125f * LOG2E, Ks, Vs, lane);
  l += __shfl_xor(l, 32);
  const size_t tok = rowb + q0 + r32;
  write_o64(o, 1.f / l, PE + tok * NPE + E_BG + head * 64, Y + tok * DM + 512 + head * 64, h);
}

DI void mixerC_tile(const Params& p, int item, bf16* Ks, bf16* Vs, int lane) {
  const bf16* PO = (const bf16*)(p.ws + WS_PE); bf16* Y = (bf16*)(p.ws + WS_Y);
  const int qt = item & 15, r16 = (item >> 4) & 15, head = (item >> 8) & 7, b = item >> 11;
  const int r32 = lane & 31, h = lane >> 5, qi0 = qt * 32;
  const size_t rowb = (size_t)b * SEQ;
  const int t = 16 * (qi0 + r32) + r16;
  bf16x8 qf[4]; load_q(qf, PO + (rowb + t) * NPO + O_CQ + head * 64, h);
  f32x16 o[2]; zero_o<2>(o);
  float m = -1e30f, l = 0.f;
  const bf16* Kg = PO + rowb * NPO + O_CK + head * 64; const bf16* Vg = PO + rowb * NPO + O_CV + head * 64;
  const float c2 = 0.125f * LOG2E;
  band_run<2>(Kg, Vg, NPO, qi0 - 128, 5, 16, r16, qi0 + r32, 128, qf, o, m, l, c2, Ks, Vs, lane);
  band_run<2>(Kg, Vg, NPO, 4 * qi0 + (r16 >> 2) - 128, 8, 4, r16 & 3, 4 * (qi0 + r32) + (r16 >> 2), 128, qf, o, m, l, c2, Ks, Vs, lane);
  band_run<2>(Kg, Vg, NPO, 16 * qi0 + r16 - 128, 20, 1, 0, t, 128, qf, o, m, l, c2, Ks, Vs, lane);
  l += __shfl_xor(l, 32);
  const size_t tok = rowb + t;
  write_o64(o, 1.f / l, PO + tok * NPO + O_CG + head * 64, Y + tok * DM + head * 64, h);
}

DI void attn_step16(const bf16* Kt, const bf16* Vt, const bf16x8 (&qf)[2], f32x4 (&o)[4], float& m, float& l, int nvalid  , float c2, int lane) {
  const int c = lane & 15, qd = lane >> 4;
  f32x4 s0 = {0.f, 0.f, 0.f, 0.f}, s1 = {0.f, 0.f, 0.f, 0.f};
#pragma unroll
  for (int ks = 0; ks < 2; ++ks) {
    const bf16x8 k0 = *(const bf16x8*)(Kt + c * WP + ks * 32 + qd * 8);
    const bf16x8 k1 = *(const bf16x8*)(Kt + (16 + c) * WP + ks * 32 + qd * 8);
    s0 = mfma16(k0, qf[ks], s0); s1 = mfma16(k1, qf[ks], s1);
  }
  float mx = -INFINITY;
#pragma unroll
  for (int j = 0; j < 4; ++j) { if (4 * qd + j >= nvalid) s0[j] = -INFINITY; if (16 + 4 * qd + j >= nvalid) s1[j] = -INFINITY; mx = fmaxf(mx, fmaxf(s0[j], s1[j])); }
  mx = fmaxf(mx, __shfl_xor(mx, 16)); mx = fmaxf(mx, __shfl_xor(mx, 32));
  const float mxs = mx * c2;
  if (__any(mxs > m + 6.f)) {
    const float mn = fmaxf(m, mxs); const float alpha = fexp2(m - mn); l *= alpha;
#pragma unroll
    for (int d = 0; d < 4; ++d) o[d] = o[d] * alpha;
    m = mn;
  }
  const float negm = -m; float ps = 0.f;
#pragma unroll
  for (int j = 0; j < 4; ++j) { s0[j] = fexp2(__builtin_fmaf(s0[j], c2, negm)); s1[j] = fexp2(__builtin_fmaf(s1[j], c2, negm)); ps += s0[j] + s1[j]; }
  l += ps;
  u32x4 pw; pw.x = cvtpk(s0[0], s0[1]); pw.y = cvtpk(s0[2], s0[3]); pw.z = cvtpk(s1[0], s1[1]); pw.w = cvtpk(s1[2], s1[3]);
  const bf16x8 pf = __builtin_bit_cast(bf16x8, pw);
  const int i16 = lane & 15, rq = i16 >> 2, pp = i16 & 3;
#pragma unroll
  for (int dt = 0; dt < 4; ++dt) {
    const s16x4 lo = trread(Vt + (4 * qd + rq) * WP + 16 * dt + 4 * pp);
    const s16x4 hi = trread(Vt + (16 + 4 * qd + rq) * WP + 16 * dt + 4 * pp);
    const bf16x8 vf = __builtin_shufflevector(lo, hi, 0, 1, 2, 3, 4, 5, 6, 7);
    o[dt] = mfma16(vf, pf, o[dt]);
  }
}

DI void mixerA_item(const Params& p, int item, bf16* Ks, bf16* Vs, int lane) {
  const bf16* PE = (const bf16*)(p.ws + WS_PE); bf16* Y = (bf16*)(p.ws + WS_Y);
  const unsigned short* SEL = (const unsigned short*)(p.ws + WS_SEL) + (size_t)item * 256;
  const int t = item & (SEQ - 1), b = item >> 13;
  const int c = lane & 15, qd = lane >> 4, head = c & 7;
  const size_t rowb = (size_t)b * SEQ;
  const int count = (t + 1 < 256) ? t + 1 : 256, nsteps = (count + 31) >> 5;
  bf16x8 qf[2];
#pragma unroll
  for (int ks = 0; ks < 2; ++ks) qf[ks] = *(const bf16x8*)(PE + (size_t)item * NPE + E_AQ + head * 64 + ks * 32 + qd * 8);
  f32x4 o[4];
#pragma unroll
  for (int d = 0; d < 4; ++d) o[d] = (f32x4){0.f, 0.f, 0.f, 0.f};
  float m = -1e30f, l = 0.f;
  const bf16* Kg = PE + rowb * NPE + E_AK; const bf16* Vg = PE + rowb * NPE + E_AV;
  KVRegs R;
  unsigned short* sel_l = (unsigned short*)(Vs + 32 * WP);
  lds_fence();
  *(u32x2*)(sel_l + 4 * lane) = *(const u32x2*)(SEL + 4 * lane);
  lds_fence();
#define A_LOAD(j) do { _Pragma("unroll") for (int i = 0; i < 4; ++i) { const int row = (lane >> 3) + 8 * i, ch = lane & 7, e = 32 * (j) + row; \
      const int tokk = (e < count) ? (int)sel_l[e] : 0; const size_t off = (size_t)tokk * NPE + ch * 8; R.k[i] = *(const u32x4*)(Kg + off); R.v[i] = *(const u32x4*)(Vg + off); } } while (0)
  A_LOAD(0);
  for (int j = 0; j < nsteps; ++j) {
    lds_fence();
    kv_store(R, Ks, Vs, lane);
    lds_fence();
    if (j + 1 < nsteps) A_LOAD(j + 1);
    attn_step16(Ks, Vs, qf, o, m, l, count - 32 * j, 0.125f * LOG2E, lane);
  }
#undef A_LOAD
  l += __shfl_xor(l, 16); l += __shfl_xor(l, 32);
  if (c < 8) {
    const float linv = 1.f / l;
    const bf16* gate_row = PE + (size_t)item * NPE + E_AG + head * 64; bf16* y_row = Y + (size_t)item * DM + head * 64;
#pragma unroll
    for (int dt = 0; dt < 4; ++dt) {
      const int dd = 16 * dt + 4 * qd;
      const u32x2 gv = *(const u32x2*)(gate_row + dd);
      const float g0 = __uint_as_float(gv.x << 16), g1 = __uint_as_float(gv.x & 0xffff0000u), g2 = __uint_as_float(gv.y << 16), g3 = __uint_as_float(gv.y & 0xffff0000u);
      u32x2 w; w.x = cvtpk(o[dt][0] * linv * g0, o[dt][1] * linv * g1); w.y = cvtpk(o[dt][2] * linv * g2, o[dt][3] * linv * g3);
      *(u32x2*)(y_row + dd) = w;
    }
  }
}

DI unsigned f2ord(float f) { f += 0.f; const unsigned u = __float_as_uint(f); return (u & 0x80000000u) ? ~u : (u | 0x80000000u); }
DI int block_excl_scan(int v, int* tmp, int* tot) {
  const int lane = threadIdx.x & 63, wid = threadIdx.x >> 6;
  int inc = v;
#pragma unroll
  for (int o = 1; o < 64; o <<= 1) { const int u = __shfl_up(inc, o); if (lane >= o) inc += u; }
  if (lane == 63) tmp[wid] = inc;
  __syncthreads();
  int base = 0, total = 0;
#pragma unroll
  for (int w = 0; w < 8; ++w) { const int x = tmp[w]; if (w < wid) base += x; total += x; }
  *tot = total;
  return base + inc - v;
}

DI float dpp_sum8(float v) {
  v += __builtin_bit_cast(float, __builtin_amdgcn_mov_dpp(__builtin_bit_cast(int, v), 0xB1, 0xF, 0xF, true));
  v += __builtin_bit_cast(float, __builtin_amdgcn_mov_dpp(__builtin_bit_cast(int, v), 0x4E, 0xF, 0xF, true));
  v += __builtin_bit_cast(float, __builtin_amdgcn_mov_dpp(__builtin_bit_cast(int, v), 0x141, 0xF, 0xF, true));
  return v;
}
DI void hist_find(const int* hist, int* misc, int need, int& digit, int& nneed, int& cnt) {
  const int tid = threadIdx.x;
  typedef int i32x4 __attribute__((ext_vector_type(4)));
  const i32x4 h0 = *(const i32x4*)(hist + tid * 8), h1 = *(const i32x4*)(hist + tid * 8 + 4);
  int hh[8] = {h0.x, h0.y, h0.z, h0.w, h1.x, h1.y, h1.z, h1.w}; int tot = 0;
#pragma unroll
  for (int k = 0; k < 8; ++k) tot += hh[k];
  int total; const int ex = block_excl_scan(tot, misc, &total);
  int above = total - ex - tot;
#pragma unroll
  for (int k = 7; k >= 0; --k) { const int c = hh[k]; if (above < need && above + c >= need) { misc[16] = tid * 8 + k; misc[17] = need - above; misc[18] = c; } above += c; }
  __syncthreads();
  digit = misc[16]; nneed = misc[17]; cnt = misc[18];
  __syncthreads();
}
DI unsigned long long mkcmp(float v, int idx) { return ((unsigned long long)f2ord(v) << 16) | ((unsigned long long)(8191 - idx) << 3); }
DI float ord2f(unsigned k) { return __uint_as_float((k & 0x80000000u) ? (k ^ 0x80000000u) : ~k); }
DI float half_sum(float v) { auto rr = __builtin_amdgcn_permlane32_swap(__float_as_uint(v), __float_as_uint(v), false, false); return __uint_as_float(rr[0]) + __uint_as_float(rr[1]); }

constexpr int CL_CAP = 512;
DI void select_slow(const float* scq, int n, unsigned short* out, float lo, float hi, int* hist, int* misc, unsigned long long* clist) {
  const int tid = opaque_tid();
    const float scale = (hi > lo) ? 4095.f / (hi - lo) : 0.f;
    for (int i = tid; i < 4096; i += 512) hist[i] = 0;
    if (tid == 0) misc[20] = 0;
    __syncthreads();
    float val[16]; int bin[16];
#pragma unroll
    for (int i = 0; i < 16; ++i) { const int idx = tid + 512 * i; const float v = (idx < n) ? scq[idx] : lo; val[i] = v;
      int bb = (int)((v - lo) * scale); bb = bb < 0 ? 0 : (bb > 4095 ? 4095 : bb); bin[i] = bb; if (idx < n) atomicAdd(&hist[bb], 1); }
    __syncthreads();
    int bstar, need, cnt;
    hist_find(hist, misc, 256, bstar, need, cnt);
    unsigned long long T = 0ull;
    if (cnt != need) {
      if (cnt <= CL_CAP) {
#pragma unroll
        for (int i = 0; i < 16; ++i) { const int idx = tid + 512 * i; if (idx < n && bin[i] == bstar) { const int slot = atomicAdd(&misc[20], 1); clist[slot] = mkcmp(val[i], idx); } }
        __syncthreads();
        if (tid < cnt) { const unsigned long long c = clist[tid]; int rank = 0; for (int jx = 0; jx < cnt; ++jx) rank += (clist[jx] > c) ? 1 : 0;
          if (rank == need - 1) { misc[21] = (int)(unsigned)(c & 0xffffffffull); misc[22] = (int)(unsigned)(c >> 32); } }
        __syncthreads();
        T = ((unsigned long long)(unsigned)misc[22] << 32) | (unsigned long long)(unsigned)misc[21];
      } else {
        unsigned long long prefix = 0ull; int shift = 36;
        for (int pass = 0; pass < 4; ++pass) {
          for (int i = tid; i < 4096; i += 512) hist[i] = 0;
          __syncthreads();
#pragma unroll
          for (int i = 0; i < 16; ++i) { const int idx = tid + 512 * i; if (idx < n && bin[i] == bstar) { const unsigned long long c = mkcmp(val[i], idx); if (pass == 0 || (c >> (shift + 12)) == prefix) atomicAdd(&hist[(int)((c >> shift) & 4095ull)], 1); } }
          __syncthreads();
          int digit, nneed, c2;
          hist_find(hist, misc, need, digit, nneed, c2);
          prefix = (prefix << 12) | (unsigned long long)digit; need = nneed;
          if (c2 == need) break;
          shift -= 12;
        }
        T = prefix << shift;
      }
    }
    int mycnt = 0; unsigned selm = 0;
#pragma unroll
    for (int i = 0; i < 16; ++i) { const int idx = tid + 512 * i;
      bool sel = false;
      if (idx < n) { if (bin[i] > bstar) sel = true; else if (bin[i] == bstar) sel = (mkcmp(val[i], idx) >= T); }
      if (sel) { ++mycnt; selm |= (1u << i); } }
    int total; int pos = block_excl_scan(mycnt, misc + 8, &total);
#pragma unroll
    for (int i = 0; i < 16; ++i) { if ((selm >> i) & 1u) { if (pos < 256) out[pos] = (unsigned short)(tid + 512 * i); ++pos; } }
    __syncthreads();
}

DI void sel_load_qw(const Params& p, int item, bf16x8 (&qf)[4], float (&wq)[16], int lane) {
  const bf16* PE = (const bf16*)(p.ws + WS_PE); const float* IW = (const float*)(p.ws + WS_IW);
  const int r32 = lane & 31, h = lane >> 5, b = item >> 11, t0 = (item & 2047) * 4; const size_t rowb = (size_t)b * SEQ;
  load_q(qf, PE + (rowb + t0 + (r32 >> 3)) * NPE + E_IQ + (r32 & 7) * 64, h);
#pragma unroll
  for (int q = 0; q < 4; ++q) { const f32x4 w4 = *(const f32x4*)(IW + (rowb + t0 + q) * 8 + 4 * h);
    wq[4 * q] = w4.x * 0.04419417382415922f; wq[4 * q + 1] = w4.y * 0.04419417382415922f; wq[4 * q + 2] = w4.z * 0.04419417382415922f; wq[4 * q + 3] = w4.w * 0.04419417382415922f; }
}
DI void selectA_item(const Params& p, int item, int next_item, char* lds, bf16x8 (&qf)[4], float (&wq)[16]) {
  const bf16* PE = (const bf16*)(p.ws + WS_PE);
  const float* IW = (const float*)(p.ws + WS_IW);
  unsigned short* SEL = (unsigned short*)(p.ws + WS_SEL);
  float* sc = (float*)lds;
  int* hist = (int*)(lds + 4 * 8192 * 4);
  int* misc = hist + 4096;
  unsigned* mm = (unsigned*)(misc + 24);
  unsigned long long* clist = (unsigned long long*)(misc + 96);
  const int tid = opaque_tid(), lane = tid & 63, wid = tid >> 6, r32 = lane & 31, h = lane >> 5;
  const int b = item >> 11, t0 = (item & 2047) * 4;
  const size_t rowb = (size_t)b * SEQ;
  const int nk = t0 + 4, ntile = (nk + 31) >> 5;
  const f32x4 pcv = ((const f32x4*)p.in[I_P])[(size_t)item * 512 + tid];
  if (tid < 4) { mm[tid * 2] = 0xFFFFFFFFu; mm[tid * 2 + 1] = 0u; }
  lds_barrier();
  const bf16* Kt = (const bf16*)(p.ws + WS_IKS) + (size_t)b * 256 * 2048 + lane * 8;
  {
    bf16x8 kf[4], kn[4];
#pragma unroll
    for (int t = 0; t < 4; ++t) { kf[t] = (bf16x8){0, 0, 0, 0, 0, 0, 0, 0}; kn[t] = kf[t]; }
    if (wid < ntile) {
#pragma unroll
      for (int t = 0; t < 4; ++t) kf[t] = *(const bf16x8*)(Kt + (size_t)wid * 2048 + t * 512);
    }
    float lo0 = INFINITY, hi0 = -INFINITY, lo1 = INFINITY, hi1 = -INFINITY;
    for (int kt = wid; kt < ntile; kt += 8) {
      if (kt + 8 < ntile) {
#pragma unroll
        for (int t = 0; t < 4; ++t) kn[t] = *(const bf16x8*)(Kt + (size_t)(kt + 8) * 2048 + t * 512);
      }
      f32x16 s;
#pragma unroll
      for (int i = 0; i < 16; ++i) s[i] = 0.f;
#pragma unroll
      for (int t = 0; t < 4; ++t) s = mfma32(qf[t], kf[t], s);
      float v[4];
#pragma unroll
      for (int q = 0; q < 4; ++q) {
        float a = wq[4 * q] * fmaxf(s[4 * q], 0.f);
#pragma unroll
        for (int jj = 1; jj < 4; ++jj) a += wq[4 * q + jj] * fmaxf(s[4 * q + jj], 0.f);
        v[q] = half_sum(a) + 0.f;
      }
      const float va = h ? v[2] : v[0], vb = h ? v[3] : v[1];
      const int key = kt * 32 + r32;
      sc[(2 * h) * 8192 + key] = va; sc[(2 * h + 1) * 8192 + key] = vb;
      lo0 = fminf(lo0, va); hi0 = fmaxf(hi0, va); lo1 = fminf(lo1, vb); hi1 = fmaxf(hi1, vb);
#pragma unroll
      for (int t = 0; t < 4; ++t) kf[t] = kn[t];
    }
    if (wid < ntile) {
#pragma unroll
      for (int o = 1; o < 32; o <<= 1) { lo0 = fminf(lo0, __shfl_xor(lo0, o)); hi0 = fmaxf(hi0, __shfl_xor(hi0, o)); lo1 = fminf(lo1, __shfl_xor(lo1, o)); hi1 = fmaxf(hi1, __shfl_xor(hi1, o)); }
      if (r32 == 0) { atomicMin(&mm[(2 * h) * 2], f2ord(lo0)); atomicMax(&mm[(2 * h) * 2 + 1], f2ord(hi0)); atomicMin(&mm[(2 * h + 1) * 2], f2ord(lo1)); atomicMax(&mm[(2 * h + 1) * 2 + 1], f2ord(hi1)); }
    }
  }
  if (next_item >= 0) sel_load_qw(p, next_item, qf, wq, lane);
  { u32x2 w; w.x = cvtpk(pcv.x, pcv.y); w.y = cvtpk(pcv.z, pcv.w); ((u32x2*)(p.ws + WS_PBF))[(size_t)item * 512 + tid] = w; }
  lds_barrier();
  {
    const int g = wid >> 1, gt = tid & 127, upper = wid & 1;
    const int t = t0 + g, n = t + 1;
    const bool big = n > 256;
    const float* scq = sc + g * 8192;
    unsigned short* out = SEL + (rowb + t) * 256;
    int* histq = hist + g * 1024;
    unsigned long long* clq = clist + g * 128;
    int* mq = misc + 32 + g * 8;
    const float lo = ord2f(mm[g * 2]), hi = ord2f(mm[g * 2 + 1]);
    const float scale = (hi > lo) ? 1023.f / (hi - lo) : 0.f;
    for (int i = gt; i < 1024; i += 128) histq[i] = 0;
    if (gt == 0) { mq[0] = 0; mq[6] = 0; }
    lds_barrier();
    float uu[64];
#pragma unroll
    for (int i = 0; i < 64; ++i) { const int idx = gt + 128 * i; const float v = (idx < n) ? scq[idx] : lo; const float u = (v - lo) * scale; uu[i] = u;
      if (big && idx < n) { int bb = (int)u; bb = bb > 1023 ? 1023 : bb; atomicAdd(&histq[bb], 1); } }
    lds_barrier();
    typedef int i32x4 __attribute__((ext_vector_type(4)));
    const i32x4 h0 = *(const i32x4*)(histq + gt * 8), h1 = *(const i32x4*)(histq + gt * 8 + 4);
    const int hh[8] = {h0.x, h0.y, h0.z, h0.w, h1.x, h1.y, h1.z, h1.w};
    int tot = 0;
#pragma unroll
    for (int k = 0; k < 8; ++k) tot += hh[k];
    int inc = tot;
#pragma unroll
    for (int o = 1; o < 64; o <<= 1) { const int ux = __shfl_down(inc, o); if (lane + o < 64) inc += ux; }
    if (lane == 0) misc[wid] = inc;
    lds_barrier();
    {
      int above = inc - tot + (upper ? 0 : misc[wid + 1]);
      if (big) {
#pragma unroll
        for (int k = 7; k >= 0; --k) { const int c = hh[k]; if (above < 256 && above + c >= 256) { mq[1] = gt * 8 + k; mq[2] = 256 - above; mq[3] = c; } above += c; }
      }
    }
    lds_barrier();
    const int bstar = mq[1], need = mq[2], cnt = mq[3];
    const float flo = (float)bstar, fhi = (bstar >= 1023) ? INFINITY : (float)(bstar + 1);
    const bool tie = big && cnt != need;
    if (tie) {
      if (cnt <= 128) {
#pragma unroll
        for (int i = 0; i < 64; ++i) { const int idx = gt + 128 * i; if (idx < n && uu[i] >= flo && uu[i] < fhi) { const int slot = atomicAdd(&mq[0], 1); clq[slot] = mkcmp(scq[idx], idx); } }
      } else if (gt == 0) mq[6] = 1;
    }
    lds_barrier();
    if (tie && cnt <= 128 && gt < cnt) { const unsigned long long c = clq[gt]; int rank = 0; for (int jx = 0; jx < cnt; ++jx) rank += (clq[jx] > c) ? 1 : 0;
      if (rank == need - 1) { mq[4] = (int)(unsigned)(c & 0xffffffffull); mq[5] = (int)(unsigned)(c >> 32); } }
    lds_barrier();
    const unsigned long long T = tie ? (((unsigned long long)(unsigned)mq[5] << 32) | (unsigned long long)(unsigned)mq[4]) : 0ull;
    const bool fast = big && !(tie && cnt > 128);
    unsigned long long selm = 0ull;
    if (fast) {
#pragma unroll
      for (int i = 0; i < 64; ++i) { const int idx = gt + 128 * i;
        if (idx < n) { const float u = uu[i]; bool sel = u >= fhi; if (!sel && u >= flo) sel = !tie || (mkcmp(scq[idx], idx) >= T); if (sel) selm |= (1ull << i); } }
    }
    const int mycnt = __popcll(selm);
    int pinc = mycnt;
#pragma unroll
    for (int o = 1; o < 64; o <<= 1) { const int ux = __shfl_up(pinc, o); if (lane >= o) pinc += ux; }
    if (lane == 63) misc[8 + wid] = pinc;
    lds_barrier();
    if (fast) {
      int pos = pinc - mycnt + (upper ? misc[8 + wid - 1] : 0);
      while (selm) { const int i = __ffsll((long long)selm) - 1; selm &= selm - 1ull; if (pos < 256) out[pos] = (unsigned short)(gt + 128 * i); ++pos; }
    } else if (!big) {
      for (int i = gt; i < n; i += 128) out[i] = (unsigned short)i;
    }
    lds_barrier();
  }
  for (int q = 0; q < 4; ++q) {
    if (misc[32 + q * 8 + 6]) { const int t = t0 + q; select_slow(sc + q * 8192, t + 1, SEL + (rowb + t) * 256, ord2f(mm[q * 2]), ord2f(mm[q * 2 + 1]), hist, misc, clist); }
  }
  lds_barrier();
}

constexpr int DKP = 72, DVP = 136;
constexpr int D_STAGE = (64 * DKP * 2 + 64 * DVP) * 2;
DI void mixerD_unit(const Params& p, int b, int head, int qb, char* lds) {
  const bf16* PO = (const bf16*)(p.ws + WS_PE); bf16* Y = (bf16*)(p.ws + WS_Y);
  const int tid = opaque_tid(), lane = tid & 63, wid = tid >> 6, r32 = lane & 31, h = lane >> 5;
  const int map = wid & 1, qsub = wid >> 1;
  const size_t rowb = (size_t)b * SEQ;
  const int qpos = 128 * qb + 32 * qsub + r32;
  bf16x8 qf[4]; load_q(qf, PO + (rowb + qpos) * NPO + O_DQ + (2 * head + map) * 64, h);
  f32x16 o[4]; zero_o<4>(o);
  float m = -1e30f, l = 0.f;
  const int nsteps = 2 * qb + 2;
  const bf16* K1g = PO + rowb * NPO + O_DK + (2 * head) * 64;
  const bf16* K2g = K1g + 64;
  const bf16* Vg = PO + rowb * NPO + O_DV + head * 128;
  u32x4 rk1, rk2, rv[2];
#define D_LOAD(j) do { const int row = tid >> 3, ch = tid & 7; const size_t off = (size_t)((j) * 64 + row) * NPO + ch * 8; rk1 = *(const u32x4*)(K1g + off); rk2 = *(const u32x4*)(K2g + off); \
    _Pragma("unroll") for (int i = 0; i < 2; ++i) { const int c = tid + 512 * i, vr = c >> 4, vc = c & 15; rv[i] = *(const u32x4*)(Vg + (size_t)((j) * 64 + vr) * NPO + vc * 8); } } while (0)
  __syncthreads();
  D_LOAD(0);
  for (int j = 0; j < nsteps; ++j) {
    char* st = lds + (j & 1) * D_STAGE;
    bf16* K1s = (bf16*)st; bf16* K2s = K1s + 64 * DKP; bf16* Vs = K2s + 64 * DKP;
    { const int row = tid >> 3, ch = tid & 7; *(u32x4*)(K1s + row * DKP + ch * 8) = rk1; *(u32x4*)(K2s + row * DKP + ch * 8) = rk2;
#pragma unroll
      for (int i = 0; i < 2; ++i) { const int c = tid + 512 * i, vr = c >> 4, vc = c & 15; *(u32x4*)(Vs + vr * DVP + vc * 8) = rv[i]; } }
    __syncthreads();
    if (j + 1 < nsteps) D_LOAD(j + 1);
    const bf16* Ks = map ? K2s : K1s;
#pragma unroll
    for (int sub = 0; sub < 2; ++sub) {
      const int k0 = j * 64 + sub * 32;
      if (k0 <= 128 * qb + 32 * qsub + 31) {
        if (k0 + 31 <= 128 * qb + 32 * qsub) {
          attn_step32<4, false>(Ks + sub * 32 * DKP, DKP, Vs + sub * 32 * DVP, DVP, qf, o, m, l, 0xffffu, 0.125f * LOG2E, lane);
        } else {
          unsigned vm = 0;
#pragma unroll
          for (int i = 0; i < 16; ++i) if (k0 + crow(i, h) <= qpos) vm |= (1u << i);
          attn_step32<4, true>(Ks + sub * 32 * DKP, DKP, Vs + sub * 32 * DVP, DVP, qf, o, m, l, vm, 0.125f * LOG2E, lane);
        }
      }
    }
  }
#undef D_LOAD
  l += __shfl_xor(l, 32);
  const float linv = 1.f / l;
  __syncthreads();
  float* xch = (float*)lds + qsub * 4096;
  if (map == 1) {
#pragma unroll
    for (int d = 0; d < 4; ++d)
#pragma unroll
      for (int i = 0; i < 16; ++i) xch[(d * 16 + i) * 64 + lane] = o[d][i] * linv;
  }
  __syncthreads();
  if (map == 0) {
    const float lam = *(const float*)(p.ws + WS_LAM);
    float ssq = 0.f;
#pragma unroll
    for (int d = 0; d < 4; ++d)
#pragma unroll
      for (int i = 0; i < 16; ++i) { const float a = o[d][i] * linv - lam * xch[(d * 16 + i) * 64 + lane]; o[d][i] = a; ssq += a * a; }
    ssq += __shfl_xor(ssq, 32);
    const float lambda_init = 0.8f - 0.6f * expf(-0.3f);
    const float rn = rsqrtf(ssq * (1.f / 128.f) + EPS) * (1.f - lambda_init);
    const size_t tok = rowb + qpos;
    const bf16* gate = PO + tok * NPO + O_DG + head * 128;
    bf16* y = Y + tok * DM + 512 + head * 128;
    const float* sg = p.in[I_SUB_GAIN];
#pragma unroll
    for (int d = 0; d < 4; ++d)
#pragma unroll
      for (int g = 0; g < 4; ++g) {
        const int dd = 32 * d + 8 * g + 4 * h;
        const u32x2 gv = *(const u32x2*)(gate + dd); const f32x4 s4 = *(const f32x4*)(sg + dd);
        const float g0 = __uint_as_float(gv.x << 16), g1 = __uint_as_float(gv.x & 0xffff0000u), g2 = __uint_as_float(gv.y << 16), g3 = __uint_as_float(gv.y & 0xffff0000u);
        u32x2 w; w.x = cvtpk(o[d][4 * g] * rn * s4.x * g0, o[d][4 * g + 1] * rn * s4.y * g1); w.y = cvtpk(o[d][4 * g + 2] * rn * s4.z * g2, o[d][4 * g + 3] * rn * s4.w * g3);
        *(u32x2*)(y + dd) = w;
      }
  }
  __syncthreads();
}

#define XB_TMO      128
#define XB_XCNT(j)  (256  + 64 * (j))
#define XB_XSUB(j)  (1280 + 64 * (j))
#define XB_XGEN(j)  (2304 + 64 * (j))
#define XB_TOP      3328
#define XB_TOPGEN   3392
#define XCD_BAR_WORDS 3456
#define XB_SPIN_CAP (1u << 18)

__device__ __forceinline__ unsigned xb_ld(unsigned* p)              { return __hip_atomic_load(p, __ATOMIC_RELAXED, __HIP_MEMORY_SCOPE_AGENT); }
__device__ __forceinline__ unsigned xb_add(unsigned* p, unsigned v) { return __hip_atomic_fetch_add(p, v, __ATOMIC_RELAXED, __HIP_MEMORY_SCOPE_AGENT); }
__device__ __forceinline__ unsigned xb_xcc_id() { return (unsigned)__builtin_amdgcn_s_getreg((3 << 11) | 20) & 0xFu; }
#define XB_SPIN(cond, bar) do { unsigned _sp = 0; while (cond) { __builtin_amdgcn_s_sleep(1); \
    if ((++_sp & 255u) == 0u) { if (xb_ld(&(bar)[XB_TMO])) break; if (_sp > XB_SPIN_CAP) { atomicAdd(&(bar)[XB_TMO], 1u); break; } } } } while (0)

struct XcdBarrier {
    unsigned* bar; unsigned x;
    volatile LAS unsigned* st;
};

__device__ __forceinline__ XcdBarrier xcd_barrier_post(unsigned* bar, volatile LAS unsigned* st) {
    XcdBarrier b; b.bar = bar; b.x = xb_xcc_id(); b.st = st;
    if (threadIdx.x == 0) (void)xb_add(&bar[XB_XCNT(b.x)], 1u);
    return b;
}
__device__ __forceinline__ void xcd_barrier_complete(unsigned* bar, unsigned x, unsigned& nloc, unsigned& nx) {
    const unsigned G = gridDim.x * gridDim.y * gridDim.z;
    unsigned sum, cnt, mine, sp = 0u;
    for (;;) {
        sum = 0u; cnt = 0u; mine = 0u;
#pragma unroll
        for (unsigned j = 0; j < 16; ++j) { const unsigned c = xb_ld(&bar[XB_XCNT(j)]); sum += c; cnt += (c > 0u) ? 1u : 0u; mine = (j == x) ? c : mine; }
        if (sum == G) break;
        __builtin_amdgcn_s_sleep(1);
        if ((++sp & 255u) == 0u) { if (xb_ld(&bar[XB_TMO])) break; if (sp > XB_SPIN_CAP) { atomicAdd(&bar[XB_TMO], 1u); break; } }
    }
    nloc = mine > 0u ? mine : 1u; nx = cnt > 0u ? cnt : 1u;
}

__device__ __forceinline__ void xcd_barrier(const XcdBarrier& b) {
    asm volatile("s_waitcnt vmcnt(0)" ::: "memory");
    __syncthreads();
    if (threadIdx.x == 0) {
        unsigned* bar = b.bar;
        __builtin_amdgcn_s_waitcnt(0);
        unsigned nloc = b.st[0], nx = b.st[1];
        if (nloc == 0u) { xcd_barrier_complete(bar, b.x, nloc, nx); b.st[0] = nloc; b.st[1] = nx; }
        const unsigned old = xb_add(&bar[XB_XSUB(b.x)], 1u);
        const unsigned gen = old / nloc;
        if (old + 1u == (gen + 1u) * nloc) {
            __builtin_amdgcn_fence(__ATOMIC_RELEASE, "agent");
            asm volatile("s_waitcnt vmcnt(0)" ::: "memory");
            const unsigned og = xb_add(&bar[XB_TOP], 1u);
            const unsigned tg = og / nx;
            if (og + 1u == (tg + 1u) * nx) xb_add(&bar[XB_TOPGEN], 1u);
            else XB_SPIN(xb_ld(&bar[XB_TOPGEN]) == tg, bar);
            __builtin_amdgcn_fence(__ATOMIC_ACQUIRE, "agent");
            xb_add(&bar[XB_XGEN(b.x)], 1u);
            asm volatile("s_waitcnt vmcnt(0)" ::: "memory");
        } else {
            XB_SPIN(xb_ld(&bar[XB_XGEN(b.x)]) == gen, bar);
            __builtin_amdgcn_fence(__ATOMIC_ACQUIRE, "agent");
            asm volatile("s_waitcnt vmcnt(0)" ::: "memory");
        }
    }
    __syncthreads();
}


__global__ void __launch_bounds__(NTHREADS) fwd_kernel(Params p) {
  extern __shared__ __attribute__((aligned(16))) char smem[];
  cg::grid_group grid = cg::this_grid();
  char* lds = smem;
  volatile LAS unsigned* xb_st = (volatile LAS unsigned*)((LAS char*)smem + (LDS_BYTES - 16));
  if (threadIdx.x < 2) xb_st[threadIdx.x] = 0u;
  __syncthreads();
  const XcdBarrier xbar = xcd_barrier_post((unsigned*)(p.ws + WS_BAR), xb_st);
#define FRESH_IDS const int tid = opaque_tid(), lane = tid & 63, wid = tid >> 6; const int gw = blockIdx.x * 8 + wid, ngw = gridDim.x * 8; bf16* Ks = (bf16*)(lds + wid * WAVE_LDS); bf16* Vs = Ks + 32 * WP; (void)gw; (void)ngw; (void)Ks; (void)Vs; (void)lane;

  phase_prologue(p, lds);
  if (p.ws == nullptr) grid.sync();
  xcd_barrier(xbar);
  for (int rep = 0; rep < REP_GEMM; ++rep) phase_inproj(p, 0, lds);
  xcd_barrier(xbar);
#if EN_A
  for (int rep = 0; rep < REP_SELA; ++rep) { FRESH_IDS
#define SEL_ITEM(k) ((k) * (int)gridDim.x + (((k) & 1) ? (int)gridDim.x - 1 - (int)blockIdx.x : (int)blockIdx.x))
    bf16x8 sqf[4]; float swq[16];
    if (SEL_ITEM(0) < 2 * 2048) sel_load_qw(p, SEL_ITEM(0), sqf, swq, lane);
    for (int k = 0; k * (int)gridDim.x < 2 * 2048; ++k) { const int it = SEL_ITEM(k); int nx = SEL_ITEM(k + 1); if (nx >= 2 * 2048) nx = -1; if (it < 2 * 2048) selectA_item(p, it, nx, lds, sqf, swq); }
#undef SEL_ITEM
  }
  __syncthreads();
  { FRESH_IDS
#define SEL_ITEM(k) ((k) * (int)gridDim.x + (((k) & 1) ? (int)gridDim.x - 1 - (int)blockIdx.x : (int)blockIdx.x))
    const int nK = (2 * 2048 + (int)gridDim.x - 1) / (int)gridDim.x;
    for (int rep = 0; rep < REP_AATT; ++rep)
      for (int s2 = wid; s2 < nK * 4; s2 += 8) { const int it = SEL_ITEM(s2 >> 2); if (it < 2 * 2048) mixerA_item(p, (it >> 11) * SEQ + (it & 2047) * 4 + (s2 & 3), Ks, Vs, lane); }
#undef SEL_ITEM
  }
#else
  { unsigned* y = (unsigned*)(p.ws + WS_Y); for (int i = blockIdx.x * NTHREADS + (int)threadIdx.x; i < NTOK * 256; i += gridDim.x * NTHREADS) { const int row = i >> 8, c = i & 255; y[row * 512 + c] = 0u; } }
#endif
#if EN_B
  { FRESH_IDS const int vb = (gridDim.x % 8 == 0) ? (int)((blockIdx.x & 7) * (gridDim.x >> 3) + (blockIdx.x >> 3)) : (int)blockIdx.x;
    for (int it = vb * 8 + wid; it < 4096; it += ngw) mixerB_tile(p, it, Ks, Vs, lane); }
#else
  { unsigned* y = (unsigned*)(p.ws + WS_Y); for (int i = blockIdx.x * NTHREADS + (int)threadIdx.x; i < NTOK * 256; i += gridDim.x * NTHREADS) { const int row = i >> 8, c = i & 255; y[row * 512 + 256 + c] = 0u; } }
#endif
  xcd_barrier(xbar);
  phase_outproj(p, 0, lds);
  xcd_barrier(xbar);
  phase_ple(p, 0, lds);
  xcd_barrier(xbar);
  phase_inproj(p, 1, lds);
  xcd_barrier(xbar);
#if EN_D
  for (int rep = 0; rep < REP_D; ++rep) {
#pragma unroll 1
    for (int u2 = blockIdx.x * 2; u2 < 512; u2 += gridDim.x * 2) {
#pragma unroll 1
      for (int k = 0; k < 2; ++k) { const int u = u2 >> 1, bh = u & 7, pr = u >> 3;
        mixerD_unit(p, bh >> 2, bh & 3, k ? 63 - pr : pr, lds); }
    }
  }
#else
  { unsigned* y = (unsigned*)(p.ws + WS_Y); for (int i = blockIdx.x * NTHREADS + (int)threadIdx.x; i < NTOK * 256; i += gridDim.x * NTHREADS) { const int row = i >> 8, c = i & 255; y[row * 512 + 256 + c] = 0u; } }
#endif
#if EN_C
  __syncthreads();
  { FRESH_IDS const int vb = (gridDim.x % 8 == 0) ? (int)((blockIdx.x & 7) * (gridDim.x >> 3) + (blockIdx.x >> 3)) : (int)blockIdx.x;
    for (int rep = 0; rep < REP_C; ++rep) for (int it = vb * 8 + wid; it < 4096; it += ngw) mixerC_tile(p, it, Ks, Vs, lane); }
#else
  { unsigned* y = (unsigned*)(p.ws + WS_Y); for (int i = blockIdx.x * NTHREADS + (int)threadIdx.x; i < NTOK * 256; i += gridDim.x * NTHREADS) { const int row = i >> 8, c = i & 255; y[row * 512 + c] = 0u; } }
#endif
  xcd_barrier(xbar);
  phase_outproj(p, 1, lds);
  xcd_barrier(xbar);
  phase_ple(p, 1, lds);
}

extern "C" void kernel_launch(void* const* d_in, const int* in_sizes, int n_in, void* d_out, int out_size, void* d_ws, size_t ws_size, hipStream_t stream) {
  static int grid_blocks = 0;
  if (!grid_blocks) {
    int dev = 0, cus = 0, per_cu = 0;
    hipGetDevice(&dev);
    hipDeviceGetAttribute(&cus, hipDeviceAttributeMultiprocessorCount, dev);
    hipFuncSetAttribute((const void*)fwd_kernel, hipFuncAttributeMaxDynamicSharedMemorySize, LDS_BYTES);
    hipOccupancyMaxActiveBlocksPerMultiprocessor(&per_cu, (const void*)fwd_kernel, NTHREADS, LDS_BYTES);
    if (per_cu < 1) per_cu = 1;
    grid_blocks = cus * per_cu;
    if (grid_blocks > 256) grid_blocks = 256;
  }
  Params p{};
  for (int i = 0; i < 25; ++i) p.in[i] = (const float*)d_in[i];
  p.out = (float*)d_out; p.ws = (unsigned char*)d_ws;
  for (int i = 0; i < 32; ++i) p.inv_freq[i] = (float)pow(10000.0, -(double)i / 32.0);
  (void)hipMemsetAsync((char*)d_ws + WS_BAR, 0, 16384, stream);
  void* args[] = {&p};
  hipError_t e = hipLaunchCooperativeKernel((const void*)fwd_kernel, dim3(grid_blocks), dim3(NTHREADS), args, LDS_BYTES, stream);
  if (e != hipSuccess) fprintf(stderr, "cooperative launch failed: %s (grid %d)\n", hipGetErrorString(e), grid_blocks);
}
```
